# Optimizing an MI355X kernel written in HIP

```python
import jax, jax.numpy as jnp
from jax import lax
import numpy as np

D_MODEL = 1024
BATCH = 32
SEQ = 2048
DEPTH = 4

A_HEADS = 4
A_DK = 128
A_DV = 128
CONV_K = 4
B_HEADS = 4
B_DK = 128
B_DV = 128
CHUNK = 64
C_HEADS = 16
C_KV_HEADS = 4
C_GROUP = C_HEADS // C_KV_HEADS
C_HD = 64
WINDOW = 128
ROPE_THETA = 10000.0
D_FF = 4 * D_MODEL
PLE_DIM = 256
EPS = 1e-6
N_EVEN = (DEPTH + 1) // 2
N_ODD = DEPTH // 2

A_QK = A_HEADS * A_DK
A_V = A_HEADS * A_DV
B_QK = B_HEADS * B_DK
B_V = B_HEADS * B_DV
A_CONV_CH = 2 * A_QK + A_V
A_COLS = 2 * A_QK + A_V + 2 * A_HEADS + A_V
B_COLS = 2 * B_QK + B_V + 2 * B_HEADS + B_V
IN_COLS = A_COLS + B_COLS
MIX_AB = A_V + B_V
C_Q = C_HEADS * C_HD
C_KV = C_KV_HEADS * C_HD
C_COLS = C_Q + 2 * C_KV

kernel_name = "hybrid_deltanet_mlstm_swa_trunk"

F32 = jnp.float32


def rmsnorm(x, g):
    xf = x.astype(F32)
    y = xf * lax.rsqrt(jnp.mean(xf * xf, -1, keepdims=True) + EPS)
    return (y * g.astype(F32)).astype(x.dtype)


def l2norm(x):
    return x * lax.rsqrt(jnp.sum(x * x, -1, keepdims=True) + EPS)


def causal_conv(x, w):
    k_taps = w.shape[0]
    s = x.shape[1]
    xp = jnp.pad(x, ((0, 0), (k_taps - 1, 0), (0, 0)))
    return sum(xp[:, k:k + s] * w[k] for k in range(k_taps))


def to_chunks(x):
    b, s, h = x.shape[:3]
    x = x.reshape((b, s // CHUNK, CHUNK, h) + x.shape[3:])
    return jnp.moveaxis(x, (1, 3), (0, 2))


def from_chunks(x):
    x = jnp.moveaxis(x, (0, 2), (1, 3))
    b, n, c, h, d = x.shape
    return x.reshape(b, n * c, h, d)


def gated_delta_rule(q, k, v, g, beta):
    b, s, h, dk = q.shape
    dv = v.shape[-1]
    qc, kc, vc = to_chunks(q), to_chunks(k), to_chunks(v)
    gcum = jnp.cumsum(to_chunks(g), -1)
    bc = to_chunks(beta)
    causal = jnp.tril(jnp.ones((CHUNK, CHUNK), bool))
    strict = jnp.tril(jnp.ones((CHUNK, CHUNK), bool), -1)
    diff = gcum[..., :, None] - gcum[..., None, :]
    decay = jnp.where(causal, jnp.exp(jnp.where(causal, diff, 0.0)), 0.0)
    kb = kc * bc[..., None]
    vb = vc * bc[..., None]
    lmat = jnp.where(strict, jnp.einsum('nbhcd,nbhed->nbhce', kb, kc) * decay, 0.0)
    eye = jnp.eye(CHUNK, dtype=lmat.dtype)
    rhs = jnp.concatenate([vb, kb * jnp.exp(gcum)[..., None]], -1)
    uw = lax.linalg.triangular_solve(lmat + eye, rhs, left_side=True, lower=True,
                                     unit_diagonal=True)
    u, w = uw[..., :dv], uw[..., dv:]
    attn_intra = jnp.einsum('nbhcd,nbhed->nbhce', qc, kc) * decay
    q_dec = qc * jnp.exp(gcum)[..., None]
    g_last = gcum[..., -1]
    k_dec = kc * jnp.exp(g_last[..., None] - gcum)[..., None]

    def step(state, xs):
        u_, w_, a_, qd, kd, gl = xs
        v_new = u_ - jnp.einsum('bhcd,bhde->bhce', w_, state)
        o = (jnp.einsum('bhcd,bhde->bhce', qd, state)
             + jnp.einsum('bhcs,bhse->bhce', a_, v_new))
        state = (state * jnp.exp(gl)[..., None, None]
                 + jnp.einsum('bhcd,bhce->bhde', kd, v_new))
        return state, o

    s0 = jnp.zeros((b, h, dk, dv), F32)
    _, o = lax.scan(step, s0, (u, w, attn_intra, q_dec, k_dec, g_last))
    return from_chunks(o)


def mlstm_chunkwise(q, k, v, i_log, f_log):
    b, s, h, dk = q.shape
    dv = v.shape[-1]
    qc, kc, vc = to_chunks(q), to_chunks(k), to_chunks(v)
    ic = to_chunks(i_log)
    bcum = jnp.cumsum(to_chunks(f_log), -1)
    causal = jnp.tril(jnp.ones((CHUNK, CHUNK), bool))
    dmat = bcum[..., :, None] - bcum[..., None, :] + ic[..., None, :]
    dmat = jnp.where(causal, dmat, -jnp.inf)
    m_intra = jnp.max(dmat, -1)
    b_last = bcum[..., -1]
    w_state = b_last[..., None] - bcum + ic
    qk = jnp.einsum('nbhtd,nbhsd->nbhts', qc, kc)

    def step(carry, xs):
        c_st, n_st, m = carry
        q_, k_, v_, qk_, d_, mi, bc_, ws, bl = xs
        a = bc_ + m[..., None]
        mt = jnp.maximum(a, mi)
        inter = jnp.exp(a - mt)
        pmat = qk_ * jnp.exp(d_ - mt[..., None])
        num = (inter[..., None] * jnp.einsum('bhcd,bhde->bhce', q_, c_st)
               + jnp.einsum('bhts,bhse->bhte', pmat, v_))
        den = inter * jnp.einsum('bhcd,bhd->bhc', q_, n_st) + jnp.sum(pmat, -1)
        hout = num / jnp.maximum(jnp.abs(den), jnp.exp(-mt))[..., None]
        m_new = jnp.maximum(bl + m, jnp.max(ws, -1))
        sc = jnp.exp(bl + m - m_new)
        kw = k_ * jnp.exp(ws - m_new[..., None])[..., None]
        c_st = sc[..., None, None] * c_st + jnp.einsum('bhcd,bhce->bhde', kw, v_)
        n_st = sc[..., None] * n_st + jnp.sum(kw, -2)
        return (c_st, n_st, m_new), hout

    carry0 = (jnp.zeros((b, h, dk, dv), F32), jnp.zeros((b, h, dk), F32), jnp.zeros((b, h), F32))
    _, o = lax.scan(step, carry0, (qc, kc, vc, qk, dmat, m_intra, bcum, w_state, b_last))
    return from_chunks(o)


def mixer_ab(hn, w_in, conv_w, a_log, dt_bias, norm_a, i_bias, f_bias, norm_b, w_out):
    b, s, _ = hn.shape
    proj = hn @ w_in
    pa, pb = proj[..., :A_COLS], proj[..., A_COLS:]
    qkv = jax.nn.silu(causal_conv(pa[..., :A_CONV_CH], conv_w)).astype(F32)
    qa = l2norm(qkv[..., :A_QK].reshape(b, s, A_HEADS, A_DK)) * (A_DK ** -0.5)
    ka = l2norm(qkv[..., A_QK:2 * A_QK].reshape(b, s, A_HEADS, A_DK))
    va = qkv[..., 2 * A_QK:].reshape(b, s, A_HEADS, A_DV)
    off = A_CONV_CH
    beta = jax.nn.sigmoid(pa[..., off:off + A_HEADS].astype(F32))
    alpha_pre = pa[..., off + A_HEADS:off + 2 * A_HEADS].astype(F32) + dt_bias.astype(F32)
    g = -jnp.exp(a_log.astype(F32)) * jax.nn.softplus(alpha_pre)
    z = pa[..., off + 2 * A_HEADS:].astype(F32).reshape(b, s, A_HEADS, A_DV)
    oa = gated_delta_rule(qa, ka, va, g, beta)
    oa = rmsnorm(oa, norm_a) * jax.nn.silu(z)
    pbf = pb.astype(F32)
    qb = pbf[..., :B_QK].reshape(b, s, B_HEADS, B_DK) * (B_DK ** -0.5)
    kb = pbf[..., B_QK:2 * B_QK].reshape(b, s, B_HEADS, B_DK)
    vb = pbf[..., 2 * B_QK:2 * B_QK + B_V].reshape(b, s, B_HEADS, B_DV)
    off = 2 * B_QK + B_V
    i_log = pbf[..., off:off + B_HEADS] + i_bias.astype(F32)
    f_log = jax.nn.log_sigmoid(pbf[..., off + B_HEADS:off + 2 * B_HEADS] + f_bias.astype(F32))
    o_gate = jax.nn.sigmoid(pbf[..., off + 2 * B_HEADS:]).reshape(b, s, B_HEADS, B_DV)
    ob = mlstm_chunkwise(qb, kb, vb, i_log, f_log)
    ob = rmsnorm(ob, norm_b) * o_gate
    mixed = jnp.concatenate([oa.reshape(b, s, A_V), ob.reshape(b, s, B_V)], -1)
    return mixed.astype(hn.dtype) @ w_out


def rope(x, pos):
    half = x.shape[-1] // 2
    inv = ROPE_THETA ** (-jnp.arange(half, dtype=F32) / half)
    ang = pos.astype(F32)[..., None] * inv
    cos = jnp.cos(ang)[:, :, None, :]
    sin = jnp.sin(ang)[:, :, None, :]
    x1, x2 = x[..., :half], x[..., half:]
    return jnp.concatenate([x1 * cos - x2 * sin, x2 * cos + x1 * sin], -1)


def mixer_c(hn, pos, w_qkv, b_qkv, sinks, w_o, b_o):
    b, s, _ = hn.shape
    nb = s // WINDOW
    proj = (hn @ w_qkv + b_qkv).astype(F32)
    q = rope(proj[..., :C_Q].reshape(b, s, C_HEADS, C_HD), pos)
    q = q.reshape(b, nb, WINDOW, C_KV_HEADS, C_GROUP, C_HD)
    q = jnp.moveaxis(q, 1, 0)
    k = rope(proj[..., C_Q:C_Q + C_KV].reshape(b, s, C_KV_HEADS, C_HD), pos)
    v = proj[..., C_Q + C_KV:].reshape(b, s, C_KV_HEADS, C_HD)
    kp = jnp.pad(k, ((0, 0), (WINDOW, 0), (0, 0), (0, 0)))
    vp = jnp.pad(v, ((0, 0), (WINDOW, 0), (0, 0), (0, 0)))
    t_idx = jnp.arange(WINDOW)[:, None]
    s_idx = jnp.arange(2 * WINDOW)[None, :]
    band = (s_idx > t_idx) & (s_idx <= t_idx + WINDOW)
    sink = sinks.astype(F32).reshape(C_KV_HEADS, C_GROUP)[None, :, :, None]
    scale = C_HD ** -0.5

    def block(args):
        j, qj = args
        kj = lax.dynamic_slice_in_dim(kp, j * WINDOW, 2 * WINDOW, axis=1)
        vj = lax.dynamic_slice_in_dim(vp, j * WINDOW, 2 * WINDOW, axis=1)
        valid = band & (j * WINDOW - WINDOW + s_idx >= 0)
        sc = jnp.einsum('btkgd,bskd->bkgts', qj, kj) * scale
        sc = jnp.where(valid, sc, -jnp.inf)
        m = jnp.maximum(jnp.max(sc, -1), sink)
        pr = jnp.exp(sc - m[..., None])
        den = jnp.sum(pr, -1) + jnp.exp(sink - m)
        pr = pr / den[..., None]
        return jnp.einsum('bkgts,bskd->btkgd', pr, vj)

    o = lax.map(block, (jnp.arange(nb), q))
    o = jnp.moveaxis(o, 0, 1).reshape(b, s, C_Q)
    return o.astype(hn.dtype) @ w_o + b_o


def setup_inputs(seed: int = 0) -> dict:
    key = jax.random.key(seed)
    ks = jax.random.split(key, 24)
    nrm = jax.random.normal
    x = nrm(ks[0], (BATCH, SEQ, D_MODEL), F32)
    p = nrm(ks[1], (DEPTH, BATCH, SEQ, PLE_DIM), F32)
    positions = jnp.broadcast_to(jnp.arange(SEQ, dtype=jnp.int32), (BATCH, SEQ))
    norm_gains = 1.0 + 0.05 * nrm(ks[2], (DEPTH, 4, D_MODEL), F32)
    w_in_ab = nrm(ks[3], (N_EVEN, D_MODEL, IN_COLS), F32) * D_MODEL ** -0.5
    conv_a = nrm(ks[4], (N_EVEN, CONV_K, A_CONV_CH), F32) * CONV_K ** -0.5
    a_log = jnp.log(jax.random.uniform(ks[5], (N_EVEN, A_HEADS), F32, 1.0, 16.0))
    dt = jnp.exp(jax.random.uniform(ks[6], (N_EVEN, A_HEADS), F32, np.log(1e-3), np.log(1e-1)))
    dt_bias = dt + jnp.log(-jnp.expm1(-dt))
    norm_a = 1.0 + 0.05 * nrm(ks[7], (N_EVEN, A_DV), F32)
    i_bias_b = 0.1 * nrm(ks[8], (N_EVEN, B_HEADS), F32)
    f_bias_b = 3.0 + 0.5 * nrm(ks[9], (N_EVEN, B_HEADS), F32)
    norm_b = 1.0 + 0.05 * nrm(ks[10], (N_EVEN, B_HEADS, B_DV), F32)
    w_out_ab = nrm(ks[11], (N_EVEN, MIX_AB, D_MODEL), F32) * MIX_AB ** -0.5
    w_qkv_c = nrm(ks[12], (N_ODD, D_MODEL, C_COLS), F32) * D_MODEL ** -0.5
    b_qkv_c = 0.02 * nrm(ks[13], (N_ODD, C_COLS), F32)
    sinks_c = nrm(ks[14], (N_ODD, C_HEADS), F32)
    w_o_c = nrm(ks[15], (N_ODD, C_Q, D_MODEL), F32) * C_Q ** -0.5
    b_o_c = 0.02 * nrm(ks[16], (N_ODD, D_MODEL), F32)
    w_up = nrm(ks[17], (DEPTH, D_MODEL, D_FF), F32) * D_MODEL ** -0.5
    w_down = nrm(ks[18], (DEPTH, D_FF, D_MODEL), F32) * D_FF ** -0.5
    w_ple = nrm(ks[19], (DEPTH, PLE_DIM, D_MODEL), F32) * PLE_DIM ** -0.5
    w_ple_gate = nrm(ks[20], (DEPTH, D_MODEL, D_MODEL), F32) * D_MODEL ** -0.5
    return {"x": x, "p": p, "positions": positions, "norm_gains": norm_gains,
            "w_in_ab": w_in_ab, "conv_a": conv_a, "a_log": a_log, "dt_bias": dt_bias,
            "norm_a": norm_a, "i_bias_b": i_bias_b, "f_bias_b": f_bias_b, "norm_b": norm_b,
            "w_out_ab": w_out_ab, "w_qkv_c": w_qkv_c, "b_qkv_c": b_qkv_c, "sinks_c": sinks_c,
            "w_o_c": w_o_c, "b_o_c": b_o_c, "w_up": w_up, "w_down": w_down,
            "w_ple": w_ple, "w_ple_gate": w_ple_gate}


def reference(x, p, positions, norm_gains, w_in_ab, conv_a, a_log, dt_bias, norm_a,
              i_bias_b, f_bias_b, norm_b, w_out_ab, w_qkv_c, b_qkv_c, sinks_c, w_o_c, b_o_c,
              w_up, w_down, w_ple, w_ple_gate):
    h = x
    for layer in range(DEPTH):
        gains = norm_gains[layer]
        hn = rmsnorm(h, gains[0])
        if layer % 2 == 0:
            e = layer // 2
            mix = mixer_ab(hn, w_in_ab[e], conv_a[e], a_log[e], dt_bias[e], norm_a[e],
                           i_bias_b[e], f_bias_b[e], norm_b[e], w_out_ab[e])
        else:
            o = layer // 2
            mix = mixer_c(hn, positions, w_qkv_c[o], b_qkv_c[o], sinks_c[o], w_o_c[o], b_o_c[o])
        h = h + rmsnorm(mix, gains[1])
        hn = rmsnorm(h, gains[2])
        ff = jnp.square(jax.nn.relu(hn @ w_up[layer])) @ w_down[layer]
        h = h + rmsnorm(ff, gains[3])
        gate = jax.nn.sigmoid(h @ w_ple_gate[layer])
        h = h + gate * (p[layer] @ w_ple[layer])
    return h
```

```cpp
#include <hip/hip_runtime.h>
#include <cstdio>
#include <cstdint>
#define N_LAUNCH_MODE 1
namespace pg8 {
#define PG8_LAS __attribute__((address_space(3)))
typedef unsigned short bf16_t;
typedef short bf16x8 __attribute__((ext_vector_type(8)));
typedef float f32x4 __attribute__((ext_vector_type(4)));
typedef unsigned u32x4 __attribute__((ext_vector_type(4)));
constexpr int BM = 256, BK = 64, HALF = 128, HTB = HALF * BK * 2  , STAGE_BYTES = 8 * HTB, NXCD = 8, WGM = 8;

__host__ __device__ __forceinline__ int lds_byte(int r, int c) { const int st = (r >> 4) * 2 + (c >> 5), rr = r & 15, cc = c & 31, ob = rr * 64 + cc * 2; return st * 1024 + (ob ^ (((ob >> 9) & 1) << 5)); }
__host__ __device__ __forceinline__ void stage_rc(int b, int& R, int& C) { const int st = b / 1024, sb = b % 1024, swz = sb ^ (((sb >> 9) & 1) << 5); R = (st >> 1) * 16 + swz / 64; C = (st & 1) * 32 + (swz % 64) / 2; }
__host__ __device__ __forceinline__ int perm32(int rho) { const int n = rho >> 4, i = rho & 15; return 8 * (i >> 2) + 4 * n + (i & 3); }

struct Unit { int pm, pn; };
struct Gemm { const bf16_t* A; const bf16_t* Bt; int M, N, K; };

struct StaticOrder {
    int nM, nN, nwg, G, c;
    __host__ __device__ void init(int M, int N, int G_, int c_) { nM = M / BM; nN = N / BM; nwg = nM * nN; G = G_; c = c_; }
    __host__ __device__ bool next(int i, Unit& u) const {
        const long L = (long)i * G + c; if (L >= nwg) return false;
        int wgid = (int)L; { const int q = nwg / NXCD, r = nwg % NXCD, xcd = wgid % NXCD, off = wgid / NXCD; wgid = (xcd < r ? xcd * (q + 1) : r * (q + 1) + (xcd - r) * q) + off; }
        const int nig = WGM * nN, gid = wgid / nig, fm = gid * WGM, gsz = (nM - fm) < WGM ? (nM - fm) : WGM;
        u.pm = fm + ((wgid % nig) % gsz); u.pn = (wgid % nig) / gsz; return true;
    }
    __device__ __forceinline__ void a_ready(const Unit&) const {}
    __device__ __forceinline__ void done(const Unit&) const {}
};

__device__ __forceinline__ unsigned cvt_pk_bf16(float lo, float hi) { unsigned r; asm volatile("v_cvt_pk_bf16_f32 %0, %1, %2" : "=v"(r) : "v"(lo), "v"(hi)); return r; }
typedef float f32x2 __attribute__((ext_vector_type(2)));
typedef unsigned u32x2 __attribute__((ext_vector_type(2)));

template <int ACT  > struct EpiBf16 {
    static constexpr bool PERM = true, AFTER_DRAIN = false;
    bf16_t* O; int ldc; const float* bias;
    __device__ __forceinline__ void operator()(const f32x4 (&acc)[2][2][4][2], const Unit& u, int wr, int wc, int fr, int fq) const {
        const int row0 = u.pm * BM + wr * 64 + fr; const int col0 = u.pn * BM + wc * 32 + 8 * fq;
        f32x4 bv[2][2];
#pragma unroll
        for (int bj = 0; bj < 2; ++bj)
#pragma unroll
            for (int n = 0; n < 2; ++n) bv[bj][n] = bias ? *(const f32x4*)(bias + col0 + bj * HALF + 4 * n) : (f32x4){0.f, 0.f, 0.f, 0.f};
#pragma unroll
        for (int ai = 0; ai < 2; ++ai)
#pragma unroll
            for (int m = 0; m < 4; ++m) { bf16_t* rowp = O + (size_t)(row0 + ai * HALF + m * 16) * ldc + col0;
#pragma unroll
                for (int bj = 0; bj < 2; ++bj) { f32x4 v0 = acc[ai][bj][m][0] + bv[bj][0], v1 = acc[ai][bj][m][1] + bv[bj][1];
                    if (ACT == 1) {
#pragma unroll
                        for (int i = 0; i < 4; ++i) { const float a = fmaxf(v0[i], 0.f), b = fmaxf(v1[i], 0.f); v0[i] = a * a; v1[i] = b * b; } }
                    u32x4 w; w.x = cvt_pk_bf16(v0[0], v0[1]); w.y = cvt_pk_bf16(v0[2], v0[3]); w.z = cvt_pk_bf16(v1[0], v1[1]); w.w = cvt_pk_bf16(v1[2], v1[3]);
                    *(u32x4*)(rowp + bj * HALF) = w; } }
    }
};
struct EpiF32 {
    static constexpr bool PERM = false, AFTER_DRAIN = false;
    float* C; int ldc; const float* bias;
    __device__ __forceinline__ void operator()(const f32x4 (&acc)[2][2][4][2], const Unit& u, int wr, int wc, int fr, int fq) const {
        const int row0 = u.pm * BM + wr * 64 + fr, col0 = u.pn * BM + wc * 32 + 4 * fq;
        f32x4 bv[2][2];
#pragma unroll
        for (int bj = 0; bj < 2; ++bj)
#pragma unroll
            for (int n = 0; n < 2; ++n) bv[bj][n] = bias ? *(const f32x4*)(bias + col0 + bj * HALF + n * 16) : (f32x4){0.f, 0.f, 0.f, 0.f};
#pragma unroll
        for (int ai = 0; ai < 2; ++ai)
#pragma unroll
            for (int m = 0; m < 4; ++m) { float* rowp = C + (size_t)(row0 + ai * HALF + m * 16) * ldc + col0;
#pragma unroll
                for (int bj = 0; bj < 2; ++bj)
#pragma unroll
                    for (int n = 0; n < 2; ++n) *(f32x4*)(rowp + bj * HALF + n * 16) = acc[ai][bj][m][n] + bv[bj][n]; }
    }
};
__device__ __forceinline__ float bf_lo(unsigned w) { return __builtin_bit_cast(float, w << 16); }
__device__ __forceinline__ float bf_hi(unsigned w) { return __builtin_bit_cast(float, w & 0xffff0000u); }
struct EpiGate {
    static constexpr bool PERM = false, AFTER_DRAIN = false;
    float* H; const bf16_t* PP; int ldc;
    __device__ __forceinline__ void operator()(const f32x4 (&acc)[2][2][4][2], const Unit& u, int wr, int wc, int fr, int fq) const {
        const int row0 = u.pm * BM + wr * 64 + fr, col0 = u.pn * BM + wc * 32 + 4 * fq;
#pragma unroll
        for (int ai = 0; ai < 2; ++ai)
#pragma unroll
            for (int m = 0; m < 4; ++m) { const size_t ro = (size_t)(row0 + ai * HALF + m * 16) * ldc + col0;
#pragma unroll
                for (int bj = 0; bj < 2; ++bj)
#pragma unroll
                    for (int n = 0; n < 2; ++n) { const size_t off = ro + bj * HALF + n * 16;
                        f32x4 hv = *(const f32x4*)(H + off); const u32x2 pv = *(const u32x2*)(PP + off); const f32x4 a = acc[ai][bj][m][n];
                        const float p0 = bf_lo(pv.x), p1 = bf_hi(pv.x), p2 = bf_lo(pv.y), p3 = bf_hi(pv.y);
                        hv[0] += p0 / (1.f + __expf(-a[0])); hv[1] += p1 / (1.f + __expf(-a[1])); hv[2] += p2 / (1.f + __expf(-a[2])); hv[3] += p3 / (1.f + __expf(-a[3]));
                        *(f32x4*)(H + off) = hv; } }
    }
};

template <class Epi, class Sched, bool ALIGN_EPI = false, bool SP2 = false>
__device__ __forceinline__ void gemm_phase(PG8_LAS unsigned char* lds, const Gemm g, const Sched& S, const Epi& E) {
    int tid_l = threadIdx.x; asm volatile("" : "+v"(tid_l));
    const int tid = tid_l, wid = __builtin_amdgcn_readfirstlane(tid >> 6), lane = tid & 63, wr = wid >> 2, wc = wid & 3, fr = lane & 15, fq = lane >> 4;
    const int K = g.K, nt = K / BK;
    unsigned voffA[2], voffB[2];
#pragma unroll
    for (int i = 0; i < 2; ++i) { int R, C; stage_rc(tid * 16 + i * 8192, R, C); const int Rb = Epi::PERM ? ((R & ~31) + perm32(R & 31)) : R;
        voffA[i] = (unsigned)(R * K + C) * 2u; voffB[i] = (unsigned)(Rb * K + C) * 2u; }
    const size_t kstep = (size_t)(BK * 2);
    const size_t hstep = (size_t)HALF * K * 2;
    const size_t tstep = 2 * hstep;
    const unsigned ldsw = (unsigned)wid * 1024u;
    const int aoff = lds_byte(wr * 64 + fr, fq * 8), boff = lds_byte(wc * 32 + fr, fq * 8);
#define PG8_SA(b, h) (((b) * 2 + (h)) * HTB)
#define PG8_SB(b, h) ((4 + (b) * 2 + (h)) * HTB)
#define PG8_STAGE(bufoff, gbase, voff) do { _Pragma("unroll") for (int _i = 0; _i < 2; ++_i) \
        __builtin_amdgcn_global_load_lds((const unsigned*)((const char*)(gbase) + (voff)[_i]), (PG8_LAS unsigned*)(lds + (bufoff) + ldsw + _i * 8192), 16, 0, 0); } while (0)
#define PG8_LDA(dst, b, h) do { _Pragma("unroll") for (int m = 0; m < 4; ++m) _Pragma("unroll") for (int k = 0; k < 2; ++k) dst[m][k] = *(const PG8_LAS bf16x8*)(lds + PG8_SA(b, h) + aoff + m * 2048 + k * 1024); } while (0)
#define PG8_LDB(dst, b, h) do { _Pragma("unroll") for (int n = 0; n < 2; ++n) _Pragma("unroll") for (int k = 0; k < 2; ++k) dst[n][k] = *(const PG8_LAS bf16x8*)(lds + PG8_SB(b, h) + boff + n * 2048 + k * 1024); } while (0)
#define PG8_MMA(ai, bj, At, Bt) do { __builtin_amdgcn_s_setprio(1); _Pragma("unroll") for (int m = 0; m < 4; ++m) _Pragma("unroll") for (int n = 0; n < 2; ++n) _Pragma("unroll") for (int k = 0; k < 2; ++k) \
        acc[ai][bj][m][n] = __builtin_amdgcn_mfma_f32_16x16x32_bf16(Bt[n][k], At[m][k], acc[ai][bj][m][n], 0, 0, 0); __builtin_amdgcn_s_setprio(0); } while (0)
#define PG8_WAIT_V(n) asm volatile("s_waitcnt vmcnt(" #n ")" ::: "memory")
#define PG8_WAIT_L(n) asm volatile("s_waitcnt lgkmcnt(" #n ")" ::: "memory")
#define PG8_BAR __builtin_amdgcn_s_barrier()
#define PG8_SCHED __builtin_amdgcn_sched_barrier(0)
    Unit cur, nxt; int ui = 0;
    if (!S.next(0, cur)) return;
    f32x4 acc[2][2][4][2];
#pragma unroll
    for (int a = 0; a < 2; ++a)
#pragma unroll
        for (int b = 0; b < 2; ++b)
#pragma unroll
            for (int m = 0; m < 4; ++m)
#pragma unroll
                for (int n = 0; n < 2; ++n) acc[a][b][m][n] = (f32x4){0.f, 0.f, 0.f, 0.f};
    bf16x8 At[4][2], B0[2][2], B1[2][2];
    const char* cA = (const char*)g.A + (size_t)cur.pm * tstep; const char* cB = (const char*)g.Bt + (size_t)cur.pn * tstep;
    S.a_ready(cur);
    if constexpr (SP2) {
        PG8_STAGE(PG8_SB(0, 0), cB, voffB); PG8_STAGE(PG8_SB(0, 1), cB + hstep, voffB); PG8_STAGE(PG8_SA(0, 0), cA, voffA); PG8_STAGE(PG8_SA(0, 1), cA + hstep, voffA);
        if (wr == 1) PG8_BAR;
        PG8_WAIT_V(2); PG8_BAR;
        PG8_STAGE(PG8_SB(1, 0), cB + kstep, voffB); PG8_STAGE(PG8_SA(1, 0), cA + kstep, voffA); PG8_STAGE(PG8_SB(1, 1), cB + hstep + kstep, voffB);
        PG8_WAIT_V(6); PG8_BAR;
    } else {
        PG8_STAGE(PG8_SB(0, 0), cB, voffB); PG8_STAGE(PG8_SA(0, 0), cA, voffA); PG8_STAGE(PG8_SB(0, 1), cB + hstep, voffB); PG8_STAGE(PG8_SA(0, 1), cA + hstep, voffA);
        if (wr == 1) PG8_BAR;
        PG8_WAIT_V(4); PG8_BAR;
        PG8_STAGE(PG8_SB(1, 0), cB + kstep, voffB); PG8_STAGE(PG8_SA(1, 0), cA + kstep, voffA); PG8_STAGE(PG8_SB(1, 1), cB + hstep + kstep, voffB);
        PG8_WAIT_V(6); PG8_BAR;
    }
    for (;;) {
        const bool has_next = S.next(ui + 1, nxt);
        const char* nA = has_next ? (const char*)g.A + (size_t)nxt.pm * tstep : cA; const char* nB = has_next ? (const char*)g.Bt + (size_t)nxt.pn * tstep : cB;
        for (int t = 0; t < nt; t += 2) {
            const bool last = (t == nt - 2);
            const char* a1 = cA + (size_t)(t + 1) * kstep;
            const char* a2 = last ? nA : cA + (size_t)(t + 2) * kstep; const char* b2 = last ? nB : cB + (size_t)(t + 2) * kstep;
            const char* a3 = a2 + kstep; const char* b3 = b2 + kstep;
            if (last && has_next) S.a_ready(nxt);
            if constexpr (SP2) {
            PG8_LDB(B0, 0, 0); PG8_LDB(B1, 0, 1); PG8_SCHED; PG8_LDA(At, 0, 0); PG8_STAGE(PG8_SA(1, 1), a1 + hstep, voffA);
            PG8_WAIT_V(8); PG8_WAIT_L(0); PG8_BAR; PG8_MMA(0, 0, At, B0); PG8_MMA(0, 1, At, B1); PG8_BAR; PG8_SCHED;
            PG8_LDA(At, 0, 1); PG8_STAGE(PG8_SB(0, 0), b2, voffB); PG8_STAGE(PG8_SB(0, 1), b2 + hstep, voffB); PG8_STAGE(PG8_SA(0, 0), a2, voffA);
            PG8_WAIT_V(8); PG8_WAIT_L(0); PG8_BAR; PG8_MMA(1, 0, At, B0); PG8_MMA(1, 1, At, B1); PG8_BAR; PG8_SCHED;
            PG8_LDB(B0, 1, 0); PG8_LDB(B1, 1, 1); PG8_SCHED; PG8_LDA(At, 1, 0); PG8_STAGE(PG8_SA(0, 1), a2 + hstep, voffA);
            PG8_WAIT_V(8); PG8_WAIT_L(0); PG8_BAR; PG8_MMA(0, 0, At, B0); PG8_MMA(0, 1, At, B1); PG8_BAR; PG8_SCHED;
            PG8_LDA(At, 1, 1); PG8_STAGE(PG8_SB(1, 0), b3, voffB); PG8_STAGE(PG8_SB(1, 1), b3 + hstep, voffB); PG8_STAGE(PG8_SA(1, 0), a3, voffA);
            PG8_WAIT_V(8); PG8_WAIT_L(0); PG8_BAR; PG8_MMA(1, 0, At, B0); PG8_MMA(1, 1, At, B1); PG8_BAR; PG8_SCHED;
            } else {
            PG8_LDB(B0, 0, 0); PG8_SCHED; PG8_LDA(At, 0, 0); PG8_STAGE(PG8_SA(1, 1), a1 + hstep, voffA);
            PG8_WAIT_L(8); PG8_BAR; PG8_WAIT_L(0); PG8_MMA(0, 0, At, B0); PG8_BAR; PG8_SCHED;
            PG8_LDB(B1, 0, 1); PG8_STAGE(PG8_SB(0, 0), b2, voffB);
            PG8_BAR; PG8_WAIT_L(0); PG8_MMA(0, 1, At, B1); PG8_BAR;
            PG8_LDA(At, 0, 1); PG8_STAGE(PG8_SA(0, 0), a2, voffA);
            PG8_BAR; PG8_WAIT_L(0); PG8_MMA(1, 0, At, B0); PG8_BAR; PG8_SCHED;
            PG8_STAGE(PG8_SB(0, 1), b2 + hstep, voffB);
            PG8_WAIT_V(6); PG8_BAR; PG8_MMA(1, 1, At, B1); PG8_BAR;
            PG8_LDB(B0, 1, 0); PG8_SCHED; PG8_LDA(At, 1, 0); PG8_STAGE(PG8_SA(0, 1), a2 + hstep, voffA);
            PG8_WAIT_L(8); PG8_BAR; PG8_WAIT_L(0); PG8_MMA(0, 0, At, B0); PG8_BAR; PG8_SCHED;
            PG8_LDB(B1, 1, 1); PG8_STAGE(PG8_SB(1, 0), b3, voffB);
            PG8_BAR; PG8_WAIT_L(0); PG8_MMA(0, 1, At, B1); PG8_BAR;
            PG8_LDA(At, 1, 1); PG8_STAGE(PG8_SA(1, 0), a3, voffA);
            PG8_BAR; PG8_WAIT_L(0); PG8_MMA(1, 0, At, B0); PG8_BAR; PG8_SCHED;
            PG8_STAGE(PG8_SB(1, 1), b3 + hstep, voffB);
            PG8_WAIT_V(6); PG8_BAR; PG8_MMA(1, 1, At, B1); PG8_BAR;
            }
        }
        if constexpr (ALIGN_EPI) { if (wr == 0) PG8_BAR; }
        if constexpr (!Epi::AFTER_DRAIN) { E(acc, cur, wr, wc, fr, fq); S.done(cur); }
        if (!has_next) break;
#pragma unroll
        for (int a = 0; a < 2; ++a)
#pragma unroll
            for (int b = 0; b < 2; ++b)
#pragma unroll
                for (int m = 0; m < 4; ++m)
#pragma unroll
                    for (int n = 0; n < 2; ++n) acc[a][b][m][n] = (f32x4){0.f, 0.f, 0.f, 0.f};
        cur = nxt; cA = nA; cB = nB; ++ui;
        if constexpr (ALIGN_EPI) { if (wr == 1) PG8_BAR; }
    }
    PG8_WAIT_V(0);
    if constexpr (!ALIGN_EPI) { if (wr == 0) PG8_BAR; }
    PG8_BAR;
    if constexpr (Epi::AFTER_DRAIN) { E.fused(acc, cur, wr, wc, fr, fq, lds, wid, lane); S.done(cur); }
#undef PG8_SA
#undef PG8_SB
#undef PG8_STAGE
#undef PG8_LDA
#undef PG8_LDB
#undef PG8_MMA
#undef PG8_WAIT_V
#undef PG8_WAIT_L
#undef PG8_BAR
#undef PG8_SCHED
}
}
constexpr int BATCH = 32, SEQ = 2048, DM = 1024, DEPTH = 4, M = BATCH * SEQ;
constexpr int FF = 4096, PLE = 256, NIN = 4112;
constexpr float EPS = 1e-6f;
constexpr int NWAVES = 8, NTHR = NWAVES * 64;
constexpr int PH_PER_LAYER = 11, NPHASE = 1 + DEPTH * PH_PER_LAYER;
constexpr size_t MiB = 1u << 20;
constexpr size_t WS_CTL = 0, CTL_ZERO_BYTES = 1 * MiB;
constexpr size_t WS_WIN = 1 * MiB, WS_WOUT = 17 * MiB, WS_WQKV = 21 * MiB, WS_WO = 27 * MiB, WS_WUP = 31 * MiB, WS_WDN = 63 * MiB, WS_WPLE = 95 * MiB, WS_WG = 97 * MiB;
constexpr size_t WS_WGATES = 105 * MiB, WS_GT = 106 * MiB, WS_ROPE = 110 * MiB;
constexpr size_t WS_RA = 128 * MiB, WS_RB = 256 * MiB, WS_RC = 384 * MiB, WS_RD = 896 * MiB, WS_END = 1024 * MiB;
constexpr int CW_BAR = 4096;
constexpr int RING_BYTES = 131072, MISC_OFF = RING_BYTES, LDS_BYTES = RING_BYTES + 1024;

#define GAS __attribute__((address_space(1)))
#define LAS __attribute__((address_space(3)))
typedef unsigned short bf16;
typedef float f32x4 __attribute__((ext_vector_type(4)));
typedef float f32x2 __attribute__((ext_vector_type(2)));
typedef unsigned u32x4 __attribute__((ext_vector_type(4)));
typedef unsigned u32x2 __attribute__((ext_vector_type(2)));
#define LDS_WAIT() asm volatile("s_waitcnt lgkmcnt(0)" ::: "memory")
#define VM_WAIT() asm volatile("s_waitcnt vmcnt(0)" ::: "memory")
using pg8::bf_lo; using pg8::bf_hi;
__device__ __forceinline__ unsigned pk2(float lo, float hi) { return pg8::cvt_pk_bf16(lo, hi); }
__device__ __forceinline__ float wave_sum(float v) {
#pragma unroll
    for (int o = 1; o < 64; o <<= 1) v += __shfl_xor(v, o);
    return v;
}
__device__ __forceinline__ float dot4(f32x4 a, f32x4 b) { return (a.x * b.x + a.y * b.y) + (a.z * b.z + a.w * b.w); }
__device__ __forceinline__ float sigmoid_f(float x) { return 1.f / (1.f + __expf(-x)); }
__device__ __forceinline__ float softplus_f(float x) { return x > 20.f ? x : log1pf(expf(x)); }

#define XB_TMO      128
#define XB_XCNT(j)  (256  + 64 * (j))
#define XB_XSUB(j)  (1280 + 64 * (j))
#define XB_XGEN(j)  (2304 + 64 * (j))
#define XB_TOP      3328
#define XB_TOPGEN   3392
#define XCD_BAR_WORDS 3456
#define XB_SPIN_CAP (1u << 18)

__device__ __forceinline__ unsigned xb_ld(unsigned* p)              { return __hip_atomic_load(p, __ATOMIC_RELAXED, __HIP_MEMORY_SCOPE_AGENT); }
__device__ __forceinline__ unsigned xb_add(unsigned* p, unsigned v) { return __hip_atomic_fetch_add(p, v, __ATOMIC_RELAXED, __HIP_MEMORY_SCOPE_AGENT); }
__device__ __forceinline__ unsigned xb_xcc_id() { return (unsigned)__builtin_amdgcn_s_getreg((3 << 11) | 20) & 0xFu; }
#define XB_SPIN(cond, bar) do { unsigned _sp = 0; while (cond) { __builtin_amdgcn_s_sleep(1); \
    if ((++_sp & 255u) == 0u) { if (xb_ld(&(bar)[XB_TMO])) break; if (_sp > XB_SPIN_CAP) { atomicAdd(&(bar)[XB_TMO], 1u); break; } } } } while (0)

struct XcdBarrier {
    unsigned* bar; unsigned x;
    volatile LAS unsigned* st;
};

__device__ __forceinline__ XcdBarrier xcd_barrier_post(unsigned* bar, volatile LAS unsigned* st) {
    XcdBarrier b; b.bar = bar; b.x = xb_xcc_id(); b.st = st;
    if (threadIdx.x == 0) (void)xb_add(&bar[XB_XCNT(b.x)], 1u);
    return b;
}
__device__ __forceinline__ void xcd_barrier_complete(unsigned* bar, unsigned x, unsigned& nloc, unsigned& nx) {
    const unsigned G = gridDim.x * gridDim.y * gridDim.z;
    unsigned sum, cnt, mine, sp = 0u;
    for (;;) {
        sum = 0u; cnt = 0u; mine = 0u;
#pragma unroll
        for (unsigned j = 0; j < 16; ++j) { const unsigned c = xb_ld(&bar[XB_XCNT(j)]); sum += c; cnt += (c > 0u) ? 1u : 0u; mine = (j == x) ? c : mine; }
        if (sum == G) break;
        __builtin_amdgcn_s_sleep(1);
        if ((++sp & 255u) == 0u) { if (xb_ld(&bar[XB_TMO])) break; if (sp > XB_SPIN_CAP) { atomicAdd(&bar[XB_TMO], 1u); break; } }
    }
    nloc = mine > 0u ? mine : 1u; nx = cnt > 0u ? cnt : 1u;
}

__device__ __forceinline__ void xcd_barrier(const XcdBarrier& b) {
    asm volatile("s_waitcnt vmcnt(0)" ::: "memory");
    __syncthreads();
    if (threadIdx.x == 0) {
        unsigned* bar = b.bar;
        __builtin_amdgcn_s_waitcnt(0);
        unsigned nloc = b.st[0], nx = b.st[1];
        if (nloc == 0u) { xcd_barrier_complete(bar, b.x, nloc, nx); b.st[0] = nloc; b.st[1] = nx; }
        const unsigned old = xb_add(&bar[XB_XSUB(b.x)], 1u);
        const unsigned gen = old / nloc;
        if (old + 1u == (gen + 1u) * nloc) {
            __builtin_amdgcn_fence(__ATOMIC_RELEASE, "agent");
            asm volatile("s_waitcnt vmcnt(0)" ::: "memory");
            const unsigned og = xb_add(&bar[XB_TOP], 1u);
            const unsigned tg = og / nx;
            if (og + 1u == (tg + 1u) * nx) xb_add(&bar[XB_TOPGEN], 1u);
            else XB_SPIN(xb_ld(&bar[XB_TOPGEN]) == tg, bar);
            __builtin_amdgcn_fence(__ATOMIC_ACQUIRE, "agent");
            xb_add(&bar[XB_XGEN(b.x)], 1u);
            asm volatile("s_waitcnt vmcnt(0)" ::: "memory");
        } else {
            XB_SPIN(xb_ld(&bar[XB_XGEN(b.x)]) == gen, bar);
            __builtin_amdgcn_fence(__ATOMIC_ACQUIRE, "agent");
            asm volatile("s_waitcnt vmcnt(0)" ::: "memory");
        }
    }
    __syncthreads();
}
struct Args {
    const float *x, *p; const int* pos; const float *gains, *w_in, *conv, *a_log, *dt_bias, *norm_a, *i_bias, *f_bias, *norm_b, *w_out, *w_qkv, *b_qkv, *sinks, *w_o, *b_o, *w_up, *w_down, *w_ple, *w_gate;
    float* out; unsigned char* ws;
    int ph_lo, ph_hi;
};

__device__ __forceinline__ void transpose_item(const float* src, int ld, int K, bf16* dst, LAS float* scr, int item, int nblk, int lane) {
    const int kb = item / nblk, nb = item % nblk, k0 = 64 * kb, n0 = 32 * nb;
#pragma unroll 8
    for (int i = 0; i < 32; ++i) { const int kk = 2 * i + (lane >> 5); scr[kk * 33 + (lane & 31)] = src[(size_t)(k0 + kk) * ld + n0 + (lane & 31)]; }
    LDS_WAIT(); asm volatile("" ::: "memory");
    const int c = lane & 7;
#pragma unroll
    for (int j = 0; j < 4; ++j) { const int n = (lane >> 3) + 8 * j; const LAS float* s = scr + (8 * c) * 33 + n;
        u32x4 o; o.x = pk2(s[0 * 33], s[1 * 33]); o.y = pk2(s[2 * 33], s[3 * 33]); o.z = pk2(s[4 * 33], s[5 * 33]); o.w = pk2(s[6 * 33], s[7 * 33]);
        *(u32x4*)(dst + (size_t)(n0 + n) * K + k0 + 8 * c) = o; }
    LDS_WAIT(); asm volatile("" ::: "memory");
}
__device__ __forceinline__ int gate_col(int c) { return c < 8 ? 1536 + c : 3592 + (c - 8); }

typedef const __attribute__((address_space(4))) Args* KArgs;
__device__ __forceinline__ KArgs kargs() { KArgs p = (KArgs)__builtin_amdgcn_kernarg_segment_ptr(); asm volatile("" : "+s"(p)); return p; }
__device__ __forceinline__ int fresh_tid() { int t = threadIdx.x; asm volatile("" : "+v"(t)); return t; }
__device__ __forceinline__ void prologue_phase(KArgs a, LAS unsigned char* lds, int gw, int NGW, int wave, int lane, int gtid, int NGT) {
    LAS float* scr = (LAS float*)(lds + wave * 16384);
    constexpr int I_IN = 16 * 16, I_SQ = 16 * 32, I_QKV = 16 * 48, I_UP = 16 * 128, I_DN = 64 * 32, I_PLE = 4 * 32;
    constexpr int NITEMS = 16 * I_IN + 2 * I_SQ + 2 * I_QKV + 2 * I_SQ + 4 * I_UP + 4 * I_DN + 4 * I_PLE + 4 * I_SQ;
    unsigned char* ws = a->ws;
    for (int it = gw; it < NITEMS; it += NGW) {
        int r = it;
        if (r < 16 * I_IN) { const int j = r / I_IN, e = j >> 3, s = j & 7, col0 = 512 * s + (s >= 3 ? 8 : 0) + (s >= 7 ? 8 : 0);
            transpose_item(a->w_in + (size_t)e * DM * NIN + col0, NIN, DM, (bf16*)(ws + WS_WIN) + ((size_t)e * 4096 + s * 512) * DM, scr, r % I_IN, 16, lane); continue; } r -= 16 * I_IN;
        if (r < 2 * I_SQ) { const int e = r / I_SQ; transpose_item(a->w_out + (size_t)e * DM * DM, DM, DM, (bf16*)(ws + WS_WOUT) + (size_t)e * DM * DM, scr, r % I_SQ, 32, lane); continue; } r -= 2 * I_SQ;
        if (r < 2 * I_QKV) { const int e = r / I_QKV; transpose_item(a->w_qkv + (size_t)e * DM * 1536, 1536, DM, (bf16*)(ws + WS_WQKV) + (size_t)e * 1536 * DM, scr, r % I_QKV, 48, lane); continue; } r -= 2 * I_QKV;
        if (r < 2 * I_SQ) { const int e = r / I_SQ; transpose_item(a->w_o + (size_t)e * DM * DM, DM, DM, (bf16*)(ws + WS_WO) + (size_t)e * DM * DM, scr, r % I_SQ, 32, lane); continue; } r -= 2 * I_SQ;
        if (r < 4 * I_UP) { const int l = r / I_UP; transpose_item(a->w_up + (size_t)l * DM * FF, FF, DM, (bf16*)(ws + WS_WUP) + (size_t)l * FF * DM, scr, r % I_UP, 128, lane); continue; } r -= 4 * I_UP;
        if (r < 4 * I_DN) { const int l = r / I_DN; transpose_item(a->w_down + (size_t)l * FF * DM, DM, FF, (bf16*)(ws + WS_WDN) + (size_t)l * DM * FF, scr, r % I_DN, 32, lane); continue; } r -= 4 * I_DN;
        if (r < 4 * I_PLE) { const int l = r / I_PLE; transpose_item(a->w_ple + (size_t)l * PLE * DM, DM, PLE, (bf16*)(ws + WS_WPLE) + (size_t)l * DM * PLE, scr, r % I_PLE, 32, lane); continue; } r -= 4 * I_PLE;
        { const int l = r / I_SQ; transpose_item(a->w_gate + (size_t)l * DM * DM, DM, DM, (bf16*)(ws + WS_WG) + (size_t)l * DM * DM, scr, r % I_SQ, 32, lane); }
    }
    float* Wg = (float*)(a->ws + WS_WGATES);
    for (int i = gtid; i < 2 * 16 * 1024; i += NGT) { const int e = i >> 14, c = (i >> 10) & 15, k = i & 1023; Wg[i] = a->w_in[((size_t)e * 1024 + k) * NIN + gate_col(c)]; }
    f32x2* rope = (f32x2*)(a->ws + WS_ROPE);
    for (int i = gtid; i < M * 32; i += NGT) { const int m = i >> 5, d = i & 31;
        const float inv = (float)pow(10000.0, -(double)d / 32.0); const float ang = (float)a->pos[m] * inv; float sn, cs; sincosf(ang, &sn, &cs); rope[i] = (f32x2){cs, sn}; }
}

__device__ __forceinline__ void norm_phase(LAS unsigned char* lds, const float* hin, const float* g0, bf16* HN, bool even, const float* Wg, float* Gt, int gw, int NGW, int tid, int lane) {
    LAS f32x4* wl = (LAS f32x4*)lds;
    if (even) { for (int i = tid; i < 4096; i += NTHR) wl[i] = ((const f32x4*)Wg)[i]; __syncthreads(); }
    f32x4 gv[4];
#pragma unroll
    for (int j = 0; j < 4; ++j) gv[j] = ((const f32x4*)g0)[lane + 64 * j];
    for (int m = gw; m < M; m += NGW) {
        const f32x4* xr = (const f32x4*)(hin + (size_t)m * DM) + lane;
        f32x4 v[4]; float s = 0.f;
#pragma unroll
        for (int j = 0; j < 4; ++j) { v[j] = xr[64 * j]; s += dot4(v[j], v[j]); }
        const float rstd = rsqrtf(wave_sum(s) * (1.f / DM) + EPS);
        u32x2* o8 = (u32x2*)(HN + (size_t)m * DM) + lane;
#pragma unroll
        for (int j = 0; j < 4; ++j) { v[j] = v[j] * rstd * gv[j]; o8[64 * j] = (u32x2){pk2(v[j].x, v[j].y), pk2(v[j].z, v[j].w)}; }
        if (even) {
            float keep = 0.f;
#pragma unroll
            for (int c = 0; c < 16; ++c) { float d = 0.f;
#pragma unroll
                for (int j = 0; j < 4; ++j) d += dot4(v[j], wl[c * 256 + lane + 64 * j]);
                d = wave_sum(d); if (lane == c) keep = d; }
            if (lane < 16) Gt[(size_t)m * 16 + lane] = keep;
        }
    }
    if (even) __syncthreads();
}
__device__ __forceinline__ void resid_a_phase(const float* mix, const float* hin, float* out, const float* g1, const float* g2, bf16* HN, int gw, int NGW, int lane) {
    f32x4 ga[4], gb[4];
#pragma unroll
    for (int j = 0; j < 4; ++j) { ga[j] = ((const f32x4*)g1)[lane + 64 * j]; gb[j] = ((const f32x4*)g2)[lane + 64 * j]; }
    for (int m = gw; m < M; m += NGW) {
        const f32x4* xr = (const f32x4*)(mix + (size_t)m * DM) + lane; const f32x4* hr = (const f32x4*)(hin + (size_t)m * DM) + lane;
        f32x4 v[4], h[4]; float s = 0.f;
#pragma unroll
        for (int j = 0; j < 4; ++j) { v[j] = xr[64 * j]; h[j] = hr[64 * j]; s += dot4(v[j], v[j]); }
        const float r1 = rsqrtf(wave_sum(s) * (1.f / DM) + EPS); float s2 = 0.f;
        f32x4* orow = (f32x4*)(out + (size_t)m * DM) + lane;
#pragma unroll
        for (int j = 0; j < 4; ++j) { h[j] = h[j] + v[j] * r1 * ga[j]; orow[64 * j] = h[j]; s2 += dot4(h[j], h[j]); }
        const float r2 = rsqrtf(wave_sum(s2) * (1.f / DM) + EPS);
        u32x2* o8 = (u32x2*)(HN + (size_t)m * DM) + lane;
#pragma unroll
        for (int j = 0; j < 4; ++j) { const f32x4 y = h[j] * r2 * gb[j]; o8[64 * j] = (u32x2){pk2(y.x, y.y), pk2(y.z, y.w)}; }
    }
}
__device__ __forceinline__ void resid_b_phase(const float* ff, float* out, const float* g3, bf16* HB, const float* pl, bf16* PB, int gw, int NGW, int lane, int gtid, int NGT) {
    f32x4 ga[4];
#pragma unroll
    for (int j = 0; j < 4; ++j) ga[j] = ((const f32x4*)g3)[lane + 64 * j];
    for (int m = gw; m < M; m += NGW) {
        const f32x4* xr = (const f32x4*)(ff + (size_t)m * DM) + lane; f32x4* hr = (f32x4*)(out + (size_t)m * DM) + lane;
        f32x4 v[4], h[4]; float s = 0.f;
#pragma unroll
        for (int j = 0; j < 4; ++j) { v[j] = xr[64 * j]; h[j] = hr[64 * j]; s += dot4(v[j], v[j]); }
        const float r1 = rsqrtf(wave_sum(s) * (1.f / DM) + EPS);
        u32x2* o8 = (u32x2*)(HB + (size_t)m * DM) + lane;
#pragma unroll
        for (int j = 0; j < 4; ++j) { h[j] = h[j] + v[j] * r1 * ga[j]; hr[64 * j] = h[j]; o8[64 * j] = (u32x2){pk2(h[j].x, h[j].y), pk2(h[j].z, h[j].w)}; }
    }
    for (int i = gtid; i < M * PLE / 8; i += NGT) { const f32x4 a = ((const f32x4*)pl)[2 * i], b = ((const f32x4*)pl)[2 * i + 1];
        ((u32x4*)PB)[i] = (u32x4){pk2(a.x, a.y), pk2(a.z, a.w), pk2(b.x, b.y), pk2(b.z, b.w)}; }
}
__device__ __forceinline__ void conv_phase(const bf16* BIG, const float* convw  , bf16* QKVA, int gw, int NGW, int lane) {
    for (int m = gw; m < M; m += NGW) {
        const int s = m & (SEQ - 1);
#pragma unroll
        for (int j = 0; j < 3; ++j) {
            const int col = j * 512 + lane * 8; float acc[8];
#pragma unroll
            for (int i = 0; i < 8; ++i) acc[i] = 0.f;
#pragma unroll
            for (int kk = 0; kk < 4; ++kk) if (s - 3 + kk >= 0) {
                const u32x4 xv = *(const u32x4*)(BIG + (size_t)(m - 3 + kk) * 4096 + col); const f32x4 w0 = *(const f32x4*)(convw + kk * 1536 + col), w1 = *(const f32x4*)(convw + kk * 1536 + col + 4);
                acc[0] += bf_lo(xv.x) * w0.x; acc[1] += bf_hi(xv.x) * w0.y; acc[2] += bf_lo(xv.y) * w0.z; acc[3] += bf_hi(xv.y) * w0.w;
                acc[4] += bf_lo(xv.z) * w1.x; acc[5] += bf_hi(xv.z) * w1.y; acc[6] += bf_lo(xv.w) * w1.z; acc[7] += bf_hi(xv.w) * w1.w; }
            float ss = 0.f;
#pragma unroll
            for (int i = 0; i < 8; ++i) { acc[i] = acc[i] / (1.f + __expf(-acc[i])); ss += acc[i] * acc[i]; }
            if (j < 2) { ss += __shfl_xor(ss, 1); ss += __shfl_xor(ss, 2); ss += __shfl_xor(ss, 4); ss += __shfl_xor(ss, 8);
                const float sc = rsqrtf(ss + EPS) * (j == 0 ? 0.08838834764831845f : 1.f);
#pragma unroll
                for (int i = 0; i < 8; ++i) acc[i] *= sc; }
            *(u32x4*)(QKVA + (size_t)m * 1536 + col) = (u32x4){pk2(acc[0], acc[1]), pk2(acc[2], acc[3]), pk2(acc[4], acc[5]), pk2(acc[6], acc[7])};
        }
    }
}
__device__ __forceinline__ void rope_phase(bf16* QKV, const f32x2* rope, int gw, int NGW, int lane) {
    for (int m = gw; m < M; m += NGW) {
        const int grp = lane & 7; const f32x4* tb = (const f32x4*)(rope + (size_t)m * 32 + grp * 4); const f32x4 t0 = tb[0], t1 = tb[1];
        const float cs[4] = {t0.x, t0.z, t1.x, t1.z}, sn[4] = {t0.y, t0.w, t1.y, t1.w};
#pragma unroll
        for (int k = 0; k < 3; ++k) {
            if (k == 2 && lane >= 32) break;
            const int hh = (k < 2) ? ((lane + 64 * k) >> 3) : (lane >> 3); const float scale = (k < 2) ? 0.125f : 1.f;
            bf16* base = QKV + (size_t)m * 1536 + (k < 2 ? 0 : 1024) + hh * 64 + grp * 4;
            const u32x2 a = *(const u32x2*)base, b = *(const u32x2*)(base + 32);
            const float x1[4] = {bf_lo(a.x), bf_hi(a.x), bf_lo(a.y), bf_hi(a.y)}, x2[4] = {bf_lo(b.x), bf_hi(b.x), bf_lo(b.y), bf_hi(b.y)};
            float o1[4], o2[4];
#pragma unroll
            for (int i = 0; i < 4; ++i) { o1[i] = (x1[i] * cs[i] - x2[i] * sn[i]) * scale; o2[i] = (x2[i] * cs[i] + x1[i] * sn[i]) * scale; }
            *(u32x2*)base = (u32x2){pk2(o1[0], o1[1]), pk2(o1[2], o1[3])}; *(u32x2*)(base + 32) = (u32x2){pk2(o2[0], o2[1]), pk2(o2[2], o2[3])};
        }
    }
}
__device__ __forceinline__ void scan_slow_phase(LAS unsigned char* lds, int tid, const bf16* QKVA, const bf16* BIG, const float* Gt,
        const float* a_log, const float* dt_bias, const float* norm_a, const float* i_bias, const float* f_bias, const float* norm_b, bf16* MIXED, int G, int bid) {
    LAS float* qL = (LAS float*)lds; LAS float* kL = qL + 32 * 144; LAS float* vL = kL + 32 * 144; LAS float* oL = vL + 32 * 128; LAS float* g0L = oL + 32 * 128; LAS float* g1L = g0L + 32;
    const int e = tid >> 2, p = tid & 3, lane = tid & 63, wave = tid >> 6;
    for (int u = bid; u < 256; u += G) {
        const int mixer = u >> 7, b = (u & 127) >> 2, h = u & 3;
        float S[32], N[32]; float mrun = 0.f;
#pragma unroll
        for (int d = 0; d < 32; ++d) { S[d] = 0.f; N[d] = 0.f; }
#pragma unroll 1
        for (int c = 0; c < SEQ / 32; ++c) {
            const int m0 = b * SEQ + c * 32;
            { const int r = tid >> 4, ch = tid & 15;
              const bf16* base = (mixer == 0) ? QKVA + (size_t)(m0 + r) * 1536 + h * 128 + ch * 8 : BIG + (size_t)(m0 + r) * 4096 + 2048 + h * 128 + ch * 8;
              const u32x4 qv = *(const u32x4*)base, kv = *(const u32x4*)(base + 512), vv = *(const u32x4*)(base + 1024);
              const float qs = (mixer == 0) ? 1.f : 0.08838834764831845f;
              const int o = r * 144 + (ch >> 2) * 36 + (ch & 3) * 8;
              *(LAS f32x4*)(qL + o) = (f32x4){bf_lo(qv.x) * qs, bf_hi(qv.x) * qs, bf_lo(qv.y) * qs, bf_hi(qv.y) * qs}; *(LAS f32x4*)(qL + o + 4) = (f32x4){bf_lo(qv.z) * qs, bf_hi(qv.z) * qs, bf_lo(qv.w) * qs, bf_hi(qv.w) * qs};
              *(LAS f32x4*)(kL + o) = (f32x4){bf_lo(kv.x), bf_hi(kv.x), bf_lo(kv.y), bf_hi(kv.y)}; *(LAS f32x4*)(kL + o + 4) = (f32x4){bf_lo(kv.z), bf_hi(kv.z), bf_lo(kv.w), bf_hi(kv.w)};
              *(LAS f32x4*)(vL + r * 128 + ch * 8) = (f32x4){bf_lo(vv.x), bf_hi(vv.x), bf_lo(vv.y), bf_hi(vv.y)}; *(LAS f32x4*)(vL + r * 128 + ch * 8 + 4) = (f32x4){bf_lo(vv.z), bf_hi(vv.z), bf_lo(vv.w), bf_hi(vv.w)}; }
            if (tid < 32) { const float* gr = Gt + (size_t)(m0 + tid) * 16;
                if (mixer == 0) { const float bt = 1.f / (1.f + expf(-gr[h])); const float g = -expf(a_log[h]) * softplus_f(gr[4 + h] + dt_bias[h]); g0L[tid] = expf(g); g1L[tid] = bt; }
                else { const float il = gr[8 + h] + i_bias[h]; const float fl = -softplus_f(-(gr[12 + h] + f_bias[h])); g0L[tid] = fl; g1L[tid] = il; } }
            __syncthreads();
#pragma unroll 1
            for (int t = 0; t < 32; ++t) {
                const LAS f32x4* kr = (const LAS f32x4*)(kL + t * 144 + p * 36); const LAS f32x4* qr = (const LAS f32x4*)(qL + t * 144 + p * 36);
                const float vt = vL[t * 128 + e], x0 = g0L[t], x1 = g1L[t];
                float kk[32], qq[32];
#pragma unroll
                for (int i = 0; i < 8; ++i) { const f32x4 a = kr[i], bq = qr[i]; kk[4 * i] = a.x; kk[4 * i + 1] = a.y; kk[4 * i + 2] = a.z; kk[4 * i + 3] = a.w; qq[4 * i] = bq.x; qq[4 * i + 1] = bq.y; qq[4 * i + 2] = bq.z; qq[4 * i + 3] = bq.w; }
                float res;
                if (mixer == 0) {
                    float ks = 0.f;
#pragma unroll
                    for (int d = 0; d < 32; ++d) ks += kk[d] * S[d];
                    ks += __shfl_xor(ks, 1); ks += __shfl_xor(ks, 2);
                    const float vn = x1 * (vt - x0 * ks); float o = 0.f;
#pragma unroll
                    for (int d = 0; d < 32; ++d) { S[d] = x0 * S[d] + kk[d] * vn; o += qq[d] * S[d]; }
                    o += __shfl_xor(o, 1); o += __shfl_xor(o, 2); res = o;
                } else {
                    const float mn = fmaxf(x0 + mrun, x1); const float fs = __expf(x0 + mrun - mn), is = __expf(x1 - mn); mrun = mn;
                    const float iv = is * vt; float num = 0.f, den = 0.f;
#pragma unroll
                    for (int d = 0; d < 32; ++d) { S[d] = fs * S[d] + kk[d] * iv; N[d] = fs * N[d] + kk[d] * is; num += qq[d] * S[d]; den += qq[d] * N[d]; }
                    num += __shfl_xor(num, 1); num += __shfl_xor(num, 2); den += __shfl_xor(den, 1); den += __shfl_xor(den, 2);
                    res = num / fmaxf(fabsf(den), __expf(-mn));
                }
                if (p == 0) oL[t * 128 + e] = res;
            }
            __syncthreads();
            for (int tt = wave; tt < 32; tt += 8) {
                const f32x2 o2 = *(const LAS f32x2*)(oL + tt * 128 + 2 * lane);
                const float rstd = rsqrtf(wave_sum(o2.x * o2.x + o2.y * o2.y) * (1.f / 128.f) + EPS);
                const size_t m = (size_t)(m0 + tt); float y0, y1;
                if (mixer == 0) { const f32x2 gn = *(const f32x2*)(norm_a + 2 * lane); const unsigned zz = *(const unsigned*)(BIG + m * 4096 + 1536 + h * 128 + 2 * lane);
                    const float z0 = bf_lo(zz), z1 = bf_hi(zz); y0 = o2.x * rstd * gn.x * (z0 * sigmoid_f(z0)); y1 = o2.y * rstd * gn.y * (z1 * sigmoid_f(z1)); }
                else { const f32x2 gn = *(const f32x2*)(norm_b + h * 128 + 2 * lane); const unsigned zz = *(const unsigned*)(BIG + m * 4096 + 3584 + h * 128 + 2 * lane);
                    y0 = o2.x * rstd * gn.x * sigmoid_f(bf_lo(zz)); y1 = o2.y * rstd * gn.y * sigmoid_f(bf_hi(zz)); }
                *(unsigned*)(MIXED + m * 1024 + mixer * 512 + h * 128 + 2 * lane) = pk2(y0, y1);
            }
            __syncthreads();
        }
    }
}
__device__ __forceinline__ void attn_slow_phase(LAS unsigned char* lds, int tid, const bf16* QKV, const float* sinks, bf16* O, int G, int bid) {
    LAS unsigned* KL = (LAS unsigned*)lds; LAS unsigned* VL = KL + 256 * 33;
    const int g = tid >> 7, t = tid & 127;
    for (int u = bid; u < BATCH * 4 * 16; u += G) {
        const int b = u >> 6, kvh = (u >> 4) & 3, jb = u & 15;
#pragma unroll
        for (int i = 0; i < 4; ++i) { const int item = tid + 512 * i, r = item >> 3, ch = item & 7, sk = (jb - 1) * 128 + r;
            u32x4 kv = (u32x4){0u, 0u, 0u, 0u}, vv = kv;
            if (sk >= 0) { const bf16* src = QKV + (size_t)(b * SEQ + sk) * 1536 + 1024 + kvh * 64 + ch * 8; kv = *(const u32x4*)src; vv = *(const u32x4*)(src + 256); }
            LAS unsigned* kd = KL + r * 33 + ch * 4; LAS unsigned* vd = VL + r * 33 + ch * 4;
            kd[0] = kv.x; kd[1] = kv.y; kd[2] = kv.z; kd[3] = kv.w; vd[0] = vv.x; vd[1] = vv.y; vd[2] = vv.z; vd[3] = vv.w; }
        __syncthreads();
        const int hq = kvh * 4 + g; const size_t m = (size_t)b * SEQ + jb * 128 + t;
        float q[64], acc[64];
#pragma unroll
        for (int i = 0; i < 8; ++i) { const u32x4 w = *(const u32x4*)(QKV + m * 1536 + hq * 64 + i * 8);
            q[8 * i] = bf_lo(w.x); q[8 * i + 1] = bf_hi(w.x); q[8 * i + 2] = bf_lo(w.y); q[8 * i + 3] = bf_hi(w.y); q[8 * i + 4] = bf_lo(w.z); q[8 * i + 5] = bf_hi(w.z); q[8 * i + 6] = bf_lo(w.w); q[8 * i + 7] = bf_hi(w.w); }
#pragma unroll
        for (int d = 0; d < 64; ++d) acc[d] = 0.f;
        float mx = sinks[hq], l = 1.f;
#pragma unroll 1
        for (int jj = 0; jj < 128; ++jj) {
            const int r = t + 1 + jj;
            if ((jb - 1) * 128 + r >= 0) {
                const LAS unsigned* kr = KL + r * 33; const LAS unsigned* vr = VL + r * 33; float s = 0.f;
#pragma unroll
                for (int d = 0; d < 32; ++d) { const unsigned w = kr[d]; s += q[2 * d] * bf_lo(w) + q[2 * d + 1] * bf_hi(w); }
                if (s > mx) { const float sc = __expf(mx - s); l *= sc;
#pragma unroll
                    for (int d = 0; d < 64; ++d) acc[d] *= sc;
                    mx = s; }
                const float pp = __expf(s - mx); l += pp;
#pragma unroll
                for (int d = 0; d < 32; ++d) { const unsigned w = vr[d]; acc[2 * d] += pp * bf_lo(w); acc[2 * d + 1] += pp * bf_hi(w); }
            }
        }
        const float inv = 1.f / l;
#pragma unroll
        for (int i = 0; i < 8; ++i) *(u32x4*)(O + m * 1024 + hq * 64 + i * 8) = (u32x4){pk2(acc[8 * i] * inv, acc[8 * i + 1] * inv), pk2(acc[8 * i + 2] * inv, acc[8 * i + 3] * inv), pk2(acc[8 * i + 4] * inv, acc[8 * i + 5] * inv), pk2(acc[8 * i + 6] * inv, acc[8 * i + 7] * inv)};
        __syncthreads();
    }
}
#ifndef N_LAUNCH_MODE
#define N_LAUNCH_MODE 0
#endif
__global__ void __launch_bounds__(NTHR, 2) trunk_fwd(Args a_unused) {
    extern __shared__ __attribute__((aligned(16))) unsigned char lds_raw[];
    LAS unsigned char* lds = (LAS unsigned char*)lds_raw;
    volatile LAS unsigned* MISC = (volatile LAS unsigned*)(lds + MISC_OFF);
    if (threadIdx.x < 64) MISC[threadIdx.x] = 0u;
    __syncthreads();
    int lo, hi; XcdBarrier bar;
    { KArgs a = kargs(); lo = a->ph_lo; hi = a->ph_hi; unsigned* ctl = (unsigned*)(a->ws + WS_CTL);
      bar.bar = ctl + CW_BAR; bar.x = 0; bar.st = MISC + 8;
      if (hi - lo > 1) bar = xcd_barrier_post(ctl + CW_BAR, MISC + 8); }
#define IN(k) (lo <= (k) && (k) < hi)
#define SEAM(k) do { if (IN(k) && IN((k) + 1)) xcd_barrier(bar); } while (0)
#define ENV KArgs a = kargs(); const int tid = fresh_tid(), lane = tid & 63, wave = __builtin_amdgcn_readfirstlane(tid >> 6); const int G = gridDim.x, bid = blockIdx.x, gw = bid * NWAVES + wave, NGW = G * NWAVES, gtid = bid * NTHR + tid, NGT = G * NTHR; \
    unsigned char* ws = a->ws; bf16* RA = (bf16*)(ws + WS_RA); bf16* RB = (bf16*)(ws + WS_RB); bf16* RC = (bf16*)(ws + WS_RC); bf16* RD = (bf16*)(ws + WS_RD); float* Gt = (float*)(ws + WS_GT); \
    (void)lane; (void)wave; (void)gw; (void)NGW; (void)gtid; (void)NGT; (void)RA; (void)RB; (void)RC; (void)RD; (void)Gt; (void)G; (void)bid

    if (IN(0)) { ENV; prologue_phase(a, lds, gw, NGW, wave, lane, gtid, NGT); }
    SEAM(0);
#pragma unroll 1
    for (int L = 0; L < DEPTH; ++L) {
        const int pb = 1 + L * PH_PER_LAYER; const bool even = (L & 1) == 0; const int e = L >> 1;
        if (IN(pb + 0)) { ENV; const float* hin = (L == 0) ? a->x : a->out;
            norm_phase(lds, hin, a->gains + (size_t)L * 4 * DM, RA, even, (const float*)(ws + WS_WGATES) + (size_t)e * 16 * 1024, Gt, gw, NGW, tid, lane); }
        SEAM(pb + 0);
        if (IN(pb + 1)) { ENV;
            const int N = even ? 4096 : 1536;
            pg8::Gemm g{RA, even ? (const bf16*)(ws + WS_WIN) + (size_t)e * 4096 * 1024 : (const bf16*)(ws + WS_WQKV) + (size_t)e * 1536 * 1024, M, N, DM};
            pg8::StaticOrder S; S.init(M, N, G, bid);
            pg8::EpiBf16<0> E{RC, N, even ? nullptr : a->b_qkv + (size_t)e * 1536};
            pg8::gemm_phase<pg8::EpiBf16<0>, pg8::StaticOrder, true, true>(lds, g, S, E);
        }
        SEAM(pb + 1);
        if (IN(pb + 2)) { ENV; if (even) conv_phase(RC, a->conv + (size_t)e * 4 * 1536, RA, gw, NGW, lane); else rope_phase(RC, (const f32x2*)(ws + WS_ROPE), gw, NGW, lane); }
        SEAM(pb + 2);
        if (IN(pb + 3)) { ENV;
            if (even) scan_slow_phase(lds, tid, RA, RC, Gt, a->a_log + e * 4, a->dt_bias + e * 4, a->norm_a + e * 128, a->i_bias + e * 4, a->f_bias + e * 4, a->norm_b + e * 512, RD, G, bid);
            else attn_slow_phase(lds, tid, RC, a->sinks + e * 16, RD, G, bid);
        }
        SEAM(pb + 3);
        if (IN(pb + 4)) { ENV;
            pg8::Gemm g{RD, even ? (const bf16*)(ws + WS_WOUT) + (size_t)e * DM * DM : (const bf16*)(ws + WS_WO) + (size_t)e * DM * DM, M, DM, DM};
            pg8::StaticOrder S; S.init(M, DM, G, bid);
            pg8::EpiF32 E{(float*)RC, DM, even ? nullptr : a->b_o + (size_t)e * DM};
            pg8::gemm_phase<pg8::EpiF32, pg8::StaticOrder, true, true>(lds, g, S, E);
        }
        SEAM(pb + 4);
        if (IN(pb + 5)) { ENV; const float* hin = (L == 0) ? a->x : a->out; const float* gains = a->gains + (size_t)L * 4 * DM;
            resid_a_phase((const float*)RC, hin, a->out, gains + DM, gains + 2 * DM, RA, gw, NGW, lane); }
        SEAM(pb + 5);
        if (IN(pb + 6)) { ENV;
            pg8::Gemm g{RA, (const bf16*)(ws + WS_WUP) + (size_t)L * FF * DM, M, FF, DM};
            pg8::StaticOrder S; S.init(M, FF, G, bid);
            pg8::EpiBf16<1> E{RC, FF, nullptr};
            pg8::gemm_phase<pg8::EpiBf16<1>, pg8::StaticOrder, true, true>(lds, g, S, E);
        }
        SEAM(pb + 6);
        if (IN(pb + 7)) { ENV;
            pg8::Gemm g{RC, (const bf16*)(ws + WS_WDN) + (size_t)L * DM * FF, M, DM, FF};
            pg8::StaticOrder S; S.init(M, DM, G, bid);
            pg8::EpiF32 E{(float*)RA, DM, nullptr};
            pg8::gemm_phase<pg8::EpiF32, pg8::StaticOrder, true, true>(lds, g, S, E);
        }
        SEAM(pb + 7);
        if (IN(pb + 8)) { ENV; resid_b_phase((const float*)RA, a->out, a->gains + (size_t)L * 4 * DM + 3 * DM, RD, a->p + (size_t)L * M * PLE, RC, gw, NGW, lane, gtid, NGT); }
        SEAM(pb + 8);
        if (IN(pb + 9)) { ENV;
            pg8::Gemm g{RC, (const bf16*)(ws + WS_WPLE) + (size_t)L * DM * PLE, M, DM, PLE};
            pg8::StaticOrder S; S.init(M, DM, G, bid);
            pg8::EpiBf16<0> E{RB, DM, nullptr};
            pg8::gemm_phase<pg8::EpiBf16<0>, pg8::StaticOrder, true, true>(lds, g, S, E);
        }
        SEAM(pb + 9);
        if (IN(pb + 10)) { ENV;
            pg8::Gemm g{RD, (const bf16*)(ws + WS_WG) + (size_t)L * DM * DM, M, DM, DM};
            pg8::StaticOrder S; S.init(M, DM, G, bid);
            pg8::EpiGate E{a->out, RB, DM};
            pg8::gemm_phase<pg8::EpiGate, pg8::StaticOrder, true, true>(lds, g, S, E);
        }
        SEAM(pb + 10);
    }
#undef IN
#undef SEAM
#undef ENV
}

extern "C" void kernel_launch(void* const* d_in, const int* in_sizes, int n_in, void* d_out, int out_size, void* d_ws, size_t ws_size, hipStream_t stream) {
    static int grid = 0;
    if (grid == 0) {
        if (n_in != 22 || in_sizes[0] != M * DM || out_size != M * DM || ws_size < WS_END) {
            fprintf(stderr, "kernel_launch: unexpected shapes (n_in %d, in0 %d, out %d, ws %zu; need ws >= %zu); nothing launched\n", n_in, n_in > 0 ? in_sizes[0] : -1, out_size, ws_size, (size_t)WS_END); grid = -1; return; }
        int dev = 0, cus = 0, per_cu = 0;
        if (hipGetDevice(&dev) != hipSuccess || hipDeviceGetAttribute(&cus, hipDeviceAttributeMultiprocessorCount, dev) != hipSuccess) { fprintf(stderr, "kernel_launch: device query failed\n"); grid = -1; return; }
        if (hipFuncSetAttribute((const void*)trunk_fwd, hipFuncAttributeMaxDynamicSharedMemorySize, LDS_BYTES) != hipSuccess) { fprintf(stderr, "kernel_launch: hipFuncSetAttribute failed\n"); grid = -1; return; }
        if (hipOccupancyMaxActiveBlocksPerMultiprocessor(&per_cu, (const void*)trunk_fwd, NTHR, LDS_BYTES) != hipSuccess || per_cu < 1) fprintf(stderr, "kernel_launch: note: occupancy query reports %d\n", per_cu);
        (void)hipGetLastError();
        grid = cus;
    }
    if (grid < 0) return;
    Args a{};
    a.x = (const float*)d_in[0]; a.p = (const float*)d_in[1]; a.pos = (const int*)d_in[2]; a.gains = (const float*)d_in[3]; a.w_in = (const float*)d_in[4]; a.conv = (const float*)d_in[5];
    a.a_log = (const float*)d_in[6]; a.dt_bias = (const float*)d_in[7]; a.norm_a = (const float*)d_in[8]; a.i_bias = (const float*)d_in[9]; a.f_bias = (const float*)d_in[10]; a.norm_b = (const float*)d_in[11];
    a.b_qkv = (const float*)d_in[14]; a.sinks = (const float*)d_in[15]; a.b_o = (const float*)d_in[17];
    a.out = (float*)d_out; a.ws = (unsigned char*)d_ws;
    a.w_out = (const float*)d_in[12]; a.w_qkv = (const float*)d_in[13]; a.w_o = (const float*)d_in[16]; a.w_up = (const float*)d_in[18]; a.w_down = (const float*)d_in[19]; a.w_ple = (const float*)d_in[20]; a.w_gate = (const float*)d_in[21];
#if N_LAUNCH_MODE == 0
    if (hipMemsetAsync((char*)d_ws + WS_CTL, 0, CTL_ZERO_BYTES, stream) != hipSuccess) { fprintf(stderr, "kernel_launch: memset failed\n"); return; }
    a.ph_lo = 0; a.ph_hi = NPHASE;
    hipLaunchKernelGGL(trunk_fwd, dim3(grid), dim3(NTHR), LDS_BYTES, stream, a);
#else
    for (int ph = 0; ph < NPHASE; ++ph) { a.ph_lo = ph; a.ph_hi = ph + 1; hipLaunchKernelGGL(trunk_fwd, dim3(grid), dim3(NTHR), LDS_BYTES, stream, a); }
#endif
    const hipError_t le = hipPeekAtLastError();
    if (le != hipSuccess) fprintf(stderr, "kernel_launch: launch failed: %s\n", hipGetErrorName(le));
}
```

```cpp
#include <hip/hip_runtime.h>
#include <cstdio>
#include <cstdint>
#define N_LAUNCH_MODE 0
namespace pg8 {
#define PG8_LAS __attribute__((address_space(3)))
typedef unsigned short bf16_t;
typedef short bf16x8 __attribute__((ext_vector_type(8)));
typedef float f32x4 __attribute__((ext_vector_type(4)));
typedef unsigned u32x4 __attribute__((ext_vector_type(4)));
constexpr int BM = 256, BK = 64, HALF = 128, HTB = HALF * BK * 2  , STAGE_BYTES = 8 * HTB, NXCD = 8, WGM = 8;

__host__ __device__ __forceinline__ int lds_byte(int r, int c) { const int st = (r >> 4) * 2 + (c >> 5), rr = r & 15, cc = c & 31, ob = rr * 64 + cc * 2; return st * 1024 + (ob ^ (((ob >> 9) & 1) << 5)); }
__host__ __device__ __forceinline__ void stage_rc(int b, int& R, int& C) { const int st = b / 1024, sb = b % 1024, swz = sb ^ (((sb >> 9) & 1) << 5); R = (st >> 1) * 16 + swz / 64; C = (st & 1) * 32 + (swz % 64) / 2; }
__host__ __device__ __forceinline__ int perm32(int rho) { const int n = rho >> 4, i = rho & 15; return 8 * (i >> 2) + 4 * n + (i & 3); }

struct Unit { int pm, pn; };
struct Gemm { const bf16_t* A; const bf16_t* Bt; int M, N, K; };

struct StaticOrder {
    int nM, nN, nwg, G, c;
    __host__ __device__ void init(int M, int N, int G_, int c_) { nM = M / BM; nN = N / BM; nwg = nM * nN; G = G_; c = c_; }
    __host__ __device__ bool next(int i, Unit& u) const {
        const long L = (long)i * G + c; if (L >= nwg) return false;
        int wgid = (int)L; { const int q = nwg / NXCD, r = nwg % NXCD, xcd = wgid % NXCD, off = wgid / NXCD; wgid = (xcd < r ? xcd * (q + 1) : r * (q + 1) + (xcd - r) * q) + off; }
        const int nig = WGM * nN, gid = wgid / nig, fm = gid * WGM, gsz = (nM - fm) < WGM ? (nM - fm) : WGM;
        u.pm = fm + ((wgid % nig) % gsz); u.pn = (wgid % nig) / gsz; return true;
    }
    __device__ __forceinline__ void a_ready(const Unit&) const {}
    __device__ __forceinline__ void done(const Unit&) const {}
};

__device__ __forceinline__ unsigned cvt_pk_bf16(float lo, float hi) { unsigned r; asm volatile("v_cvt_pk_bf16_f32 %0, %1, %2" : "=v"(r) : "v"(lo), "v"(hi)); return r; }
typedef float f32x2 __attribute__((ext_vector_type(2)));
typedef unsigned u32x2 __attribute__((ext_vector_type(2)));

template <int ACT  > struct EpiBf16 {
    static constexpr bool PERM = true, AFTER_DRAIN = false;
    bf16_t* O; int ldc; const float* bias; bf16_t* O2; int split_col, ldc2;
    __device__ __forceinline__ void operator()(const f32x4 (&acc)[2][2][4][2], const Unit& u, int wr, int wc, int fr, int fq) const {
        const int row0 = u.pm * BM + wr * 64 + fr; const int col0 = u.pn * BM + wc * 32 + 8 * fq;
        const bool second = u.pn * BM >= split_col; bf16_t* const ob = second ? O2 : O; const int ld = second ? ldc2 : ldc, oc0 = second ? col0 - split_col : col0;
        f32x4 bv[2][2];
#pragma unroll
        for (int bj = 0; bj < 2; ++bj)
#pragma unroll
            for (int n = 0; n < 2; ++n) bv[bj][n] = bias ? *(const f32x4*)(bias + col0 + bj * HALF + 4 * n) : (f32x4){0.f, 0.f, 0.f, 0.f};
#pragma unroll
        for (int ai = 0; ai < 2; ++ai)
#pragma unroll
            for (int m = 0; m < 4; ++m) { bf16_t* rowp = ob + (size_t)(row0 + ai * HALF + m * 16) * ld + oc0;
#pragma unroll
                for (int bj = 0; bj < 2; ++bj) { f32x4 v0 = acc[ai][bj][m][0] + bv[bj][0], v1 = acc[ai][bj][m][1] + bv[bj][1];
                    if (ACT == 1) {
#pragma unroll
                        for (int i = 0; i < 4; ++i) { const float a = fmaxf(v0[i], 0.f), b = fmaxf(v1[i], 0.f); v0[i] = a * a; v1[i] = b * b; } }
                    u32x4 w; w.x = cvt_pk_bf16(v0[0], v0[1]); w.y = cvt_pk_bf16(v0[2], v0[3]); w.z = cvt_pk_bf16(v1[0], v1[1]); w.w = cvt_pk_bf16(v1[2], v1[3]);
                    *(u32x4*)(rowp + bj * HALF) = w; } }
    }
};
struct EpiF32 {
    static constexpr bool PERM = false, AFTER_DRAIN = false;
    float* C; int ldc; const float* bias;
    __device__ __forceinline__ void operator()(const f32x4 (&acc)[2][2][4][2], const Unit& u, int wr, int wc, int fr, int fq) const {
        const int row0 = u.pm * BM + wr * 64 + fr, col0 = u.pn * BM + wc * 32 + 4 * fq;
        f32x4 bv[2][2];
#pragma unroll
        for (int bj = 0; bj < 2; ++bj)
#pragma unroll
            for (int n = 0; n < 2; ++n) bv[bj][n] = bias ? *(const f32x4*)(bias + col0 + bj * HALF + n * 16) : (f32x4){0.f, 0.f, 0.f, 0.f};
#pragma unroll
        for (int ai = 0; ai < 2; ++ai)
#pragma unroll
            for (int m = 0; m < 4; ++m) { float* rowp = C + (size_t)(row0 + ai * HALF + m * 16) * ldc + col0;
#pragma unroll
                for (int bj = 0; bj < 2; ++bj)
#pragma unroll
                    for (int n = 0; n < 2; ++n) *(f32x4*)(rowp + bj * HALF + n * 16) = acc[ai][bj][m][n] + bv[bj][n]; }
    }
};
__device__ __forceinline__ float bf_lo(unsigned w) { return __builtin_bit_cast(float, w << 16); }
__device__ __forceinline__ float bf_hi(unsigned w) { return __builtin_bit_cast(float, w & 0xffff0000u); }
struct EpiGate {
    static constexpr bool PERM = false, AFTER_DRAIN = false;
    float* H; const bf16_t* PP; int ldc;
    __device__ __forceinline__ void operator()(const f32x4 (&acc)[2][2][4][2], const Unit& u, int wr, int wc, int fr, int fq) const {
        const int row0 = u.pm * BM + wr * 64 + fr, col0 = u.pn * BM + wc * 32 + 4 * fq;
#pragma unroll
        for (int ai = 0; ai < 2; ++ai)
#pragma unroll
            for (int m = 0; m < 4; ++m) { const size_t ro = (size_t)(row0 + ai * HALF + m * 16) * ldc + col0;
#pragma unroll
                for (int bj = 0; bj < 2; ++bj)
#pragma unroll
                    for (int n = 0; n < 2; ++n) { const size_t off = ro + bj * HALF + n * 16;
                        f32x4 hv = *(const f32x4*)(H + off); const u32x2 pv = *(const u32x2*)(PP + off); const f32x4 a = acc[ai][bj][m][n];
                        const float p0 = bf_lo(pv.x), p1 = bf_hi(pv.x), p2 = bf_lo(pv.y), p3 = bf_hi(pv.y);
                        hv[0] += p0 / (1.f + __expf(-a[0])); hv[1] += p1 / (1.f + __expf(-a[1])); hv[2] += p2 / (1.f + __expf(-a[2])); hv[3] += p3 / (1.f + __expf(-a[3]));
                        *(f32x4*)(H + off) = hv; } }
    }
};

template <class Epi, class Sched, bool ALIGN_EPI = false, bool SP2 = false>
__device__ __forceinline__ void gemm_phase(PG8_LAS unsigned char* lds, const Gemm g, const Sched& S, const Epi& E) {
    int tid_l = threadIdx.x; asm volatile("" : "+v"(tid_l));
    const int tid = tid_l, wid = __builtin_amdgcn_readfirstlane(tid >> 6), lane = tid & 63, wr = wid >> 2, wc = wid & 3, fr = lane & 15, fq = lane >> 4;
    const int K = g.K, nt = K / BK;
    unsigned voffA[2], voffB[2];
#pragma unroll
    for (int i = 0; i < 2; ++i) { int R, C; stage_rc(tid * 16 + i * 8192, R, C); const int Rb = Epi::PERM ? ((R & ~31) + perm32(R & 31)) : R;
        voffA[i] = (unsigned)(R * K + C) * 2u; voffB[i] = (unsigned)(Rb * K + C) * 2u; }
    const size_t kstep = (size_t)(BK * 2);
    const size_t hstep = (size_t)HALF * K * 2;
    const size_t tstep = 2 * hstep;
    const unsigned ldsw = (unsigned)wid * 1024u;
    const int aoff = lds_byte(wr * 64 + fr, fq * 8), boff = lds_byte(wc * 32 + fr, fq * 8);
#define PG8_SA(b, h) (((b) * 2 + (h)) * HTB)
#define PG8_SB(b, h) ((4 + (b) * 2 + (h)) * HTB)
#define PG8_STAGE(bufoff, gbase, voff) do { _Pragma("unroll") for (int _i = 0; _i < 2; ++_i) \
        __builtin_amdgcn_global_load_lds((const unsigned*)((const char*)(gbase) + (voff)[_i]), (PG8_LAS unsigned*)(lds + (bufoff) + ldsw + _i * 8192), 16, 0, 0); } while (0)
#define PG8_LDA(dst, b, h) do { _Pragma("unroll") for (int m = 0; m < 4; ++m) _Pragma("unroll") for (int k = 0; k < 2; ++k) dst[m][k] = *(const PG8_LAS bf16x8*)(lds + PG8_SA(b, h) + aoff + m * 2048 + k * 1024); } while (0)
#define PG8_LDB(dst, b, h) do { _Pragma("unroll") for (int n = 0; n < 2; ++n) _Pragma("unroll") for (int k = 0; k < 2; ++k) dst[n][k] = *(const PG8_LAS bf16x8*)(lds + PG8_SB(b, h) + boff + n * 2048 + k * 1024); } while (0)
#define PG8_MMA(ai, bj, At, Bt) do { __builtin_amdgcn_s_setprio(1); _Pragma("unroll") for (int m = 0; m < 4; ++m) _Pragma("unroll") for (int n = 0; n < 2; ++n) _Pragma("unroll") for (int k = 0; k < 2; ++k) \
        acc[ai][bj][m][n] = __builtin_amdgcn_mfma_f32_16x16x32_bf16(Bt[n][k], At[m][k], acc[ai][bj][m][n], 0, 0, 0); __builtin_amdgcn_s_setprio(0); } while (0)
#define PG8_WAIT_V(n) asm volatile("s_waitcnt vmcnt(" #n ")" ::: "memory")
#define PG8_WAIT_L(n) asm volatile("s_waitcnt lgkmcnt(" #n ")" ::: "memory")
#define PG8_BAR __builtin_amdgcn_s_barrier()
#define PG8_SCHED __builtin_amdgcn_sched_barrier(0)
    Unit cur, nxt; int ui = 0;
    if (!S.next(0, cur)) return;
    f32x4 acc[2][2][4][2];
#pragma unroll
    for (int a = 0; a < 2; ++a)
#pragma unroll
        for (int b = 0; b < 2; ++b)
#pragma unroll
            for (int m = 0; m < 4; ++m)
#pragma unroll
                for (int n = 0; n < 2; ++n) acc[a][b][m][n] = (f32x4){0.f, 0.f, 0.f, 0.f};
    bf16x8 At[4][2], B0[2][2], B1[2][2];
    const char* cA = (const char*)g.A + (size_t)cur.pm * tstep; const char* cB = (const char*)g.Bt + (size_t)cur.pn * tstep;
    S.a_ready(cur);
    if constexpr (SP2) {
        PG8_STAGE(PG8_SB(0, 0), cB, voffB); PG8_STAGE(PG8_SB(0, 1), cB + hstep, voffB); PG8_STAGE(PG8_SA(0, 0), cA, voffA); PG8_STAGE(PG8_SA(0, 1), cA + hstep, voffA);
        if (wr == 1) PG8_BAR;
        PG8_WAIT_V(2); PG8_BAR;
        PG8_STAGE(PG8_SB(1, 0), cB + kstep, voffB); PG8_STAGE(PG8_SA(1, 0), cA + kstep, voffA); PG8_STAGE(PG8_SB(1, 1), cB + hstep + kstep, voffB);
        PG8_WAIT_V(6); PG8_BAR;
    } else {
        PG8_STAGE(PG8_SB(0, 0), cB, voffB); PG8_STAGE(PG8_SA(0, 0), cA, voffA); PG8_STAGE(PG8_SB(0, 1), cB + hstep, voffB); PG8_STAGE(PG8_SA(0, 1), cA + hstep, voffA);
        if (wr == 1) PG8_BAR;
        PG8_WAIT_V(4); PG8_BAR;
        PG8_STAGE(PG8_SB(1, 0), cB + kstep, voffB); PG8_STAGE(PG8_SA(1, 0), cA + kstep, voffA); PG8_STAGE(PG8_SB(1, 1), cB + hstep + kstep, voffB);
        PG8_WAIT_V(6); PG8_BAR;
    }
    for (;;) {
        const bool has_next = S.next(ui + 1, nxt);
        const char* nA = has_next ? (const char*)g.A + (size_t)nxt.pm * tstep : cA; const char* nB = has_next ? (const char*)g.Bt + (size_t)nxt.pn * tstep : cB;
        for (int t = 0; t < nt; t += 2) {
            const bool last = (t == nt - 2);
            const char* a1 = cA + (size_t)(t + 1) * kstep;
            const char* a2 = last ? nA : cA + (size_t)(t + 2) * kstep; const char* b2 = last ? nB : cB + (size_t)(t + 2) * kstep;
            const char* a3 = a2 + kstep; const char* b3 = b2 + kstep;
            if (last && has_next) S.a_ready(nxt);
            if constexpr (SP2) {
            PG8_LDB(B0, 0, 0); PG8_LDB(B1, 0, 1); PG8_SCHED; PG8_LDA(At, 0, 0); PG8_STAGE(PG8_SA(1, 1), a1 + hstep, voffA);
            PG8_WAIT_V(8); PG8_WAIT_L(0); PG8_BAR; PG8_MMA(0, 0, At, B0); PG8_MMA(0, 1, At, B1); PG8_BAR; PG8_SCHED;
            PG8_LDA(At, 0, 1); PG8_STAGE(PG8_SB(0, 0), b2, voffB); PG8_STAGE(PG8_SB(0, 1), b2 + hstep, voffB); PG8_STAGE(PG8_SA(0, 0), a2, voffA);
            PG8_WAIT_V(8); PG8_WAIT_L(0); PG8_BAR; PG8_MMA(1, 0, At, B0); PG8_MMA(1, 1, At, B1); PG8_BAR; PG8_SCHED;
            PG8_LDB(B0, 1, 0); PG8_LDB(B1, 1, 1); PG8_SCHED; PG8_LDA(At, 1, 0); PG8_STAGE(PG8_SA(0, 1), a2 + hstep, voffA);
            PG8_WAIT_V(8); PG8_WAIT_L(0); PG8_BAR; PG8_MMA(0, 0, At, B0); PG8_MMA(0, 1, At, B1); PG8_BAR; PG8_SCHED;
            PG8_LDA(At, 1, 1); PG8_STAGE(PG8_SB(1, 0), b3, voffB); PG8_STAGE(PG8_SB(1, 1), b3 + hstep, voffB); PG8_STAGE(PG8_SA(1, 0), a3, voffA);
            PG8_WAIT_V(8); PG8_WAIT_L(0); PG8_BAR; PG8_MMA(1, 0, At, B0); PG8_MMA(1, 1, At, B1); PG8_BAR; PG8_SCHED;
            } else {
            PG8_LDB(B0, 0, 0); PG8_SCHED; PG8_LDA(At, 0, 0); PG8_STAGE(PG8_SA(1, 1), a1 + hstep, voffA);
            PG8_WAIT_L(8); PG8_BAR; PG8_WAIT_L(0); PG8_MMA(0, 0, At, B0); PG8_BAR; PG8_SCHED;
            PG8_LDB(B1, 0, 1); PG8_STAGE(PG8_SB(0, 0), b2, voffB);
            PG8_BAR; PG8_WAIT_L(0); PG8_MMA(0, 1, At, B1); PG8_BAR;
            PG8_LDA(At, 0, 1); PG8_STAGE(PG8_SA(0, 0), a2, voffA);
            PG8_BAR; PG8_WAIT_L(0); PG8_MMA(1, 0, At, B0); PG8_BAR; PG8_SCHED;
            PG8_STAGE(PG8_SB(0, 1), b2 + hstep, voffB);
            PG8_WAIT_V(6); PG8_BAR; PG8_MMA(1, 1, At, B1); PG8_BAR;
            PG8_LDB(B0, 1, 0); PG8_SCHED; PG8_LDA(At, 1, 0); PG8_STAGE(PG8_SA(0, 1), a2 + hstep, voffA);
            PG8_WAIT_L(8); PG8_BAR; PG8_WAIT_L(0); PG8_MMA(0, 0, At, B0); PG8_BAR; PG8_SCHED;
            PG8_LDB(B1, 1, 1); PG8_STAGE(PG8_SB(1, 0), b3, voffB);
            PG8_BAR; PG8_WAIT_L(0); PG8_MMA(0, 1, At, B1); PG8_BAR;
            PG8_LDA(At, 1, 1); PG8_STAGE(PG8_SA(1, 0), a3, voffA);
            PG8_BAR; PG8_WAIT_L(0); PG8_MMA(1, 0, At, B0); PG8_BAR; PG8_SCHED;
            PG8_STAGE(PG8_SB(1, 1), b3 + hstep, voffB);
            PG8_WAIT_V(6); PG8_BAR; PG8_MMA(1, 1, At, B1); PG8_BAR;
            }
        }
        if constexpr (ALIGN_EPI) { if (wr == 0) PG8_BAR; }
        if constexpr (!Epi::AFTER_DRAIN) { E(acc, cur, wr, wc, fr, fq); S.done(cur); }
        if (!has_next) break;
#pragma unroll
        for (int a = 0; a < 2; ++a)
#pragma unroll
            for (int b = 0; b < 2; ++b)
#pragma unroll
                for (int m = 0; m < 4; ++m)
#pragma unroll
                    for (int n = 0; n < 2; ++n) acc[a][b][m][n] = (f32x4){0.f, 0.f, 0.f, 0.f};
        cur = nxt; cA = nA; cB = nB; ++ui;
        if constexpr (ALIGN_EPI) { if (wr == 1) PG8_BAR; }
    }
    PG8_WAIT_V(0);
    if constexpr (!ALIGN_EPI) { if (wr == 0) PG8_BAR; }
    PG8_BAR;
    if constexpr (Epi::AFTER_DRAIN) { E.fused(acc, cur, wr, wc, fr, fq, lds, wid, lane); S.done(cur); }
#undef PG8_SA
#undef PG8_SB
#undef PG8_STAGE
#undef PG8_LDA
#undef PG8_LDB
#undef PG8_MMA
#undef PG8_WAIT_V
#undef PG8_WAIT_L
#undef PG8_BAR
#undef PG8_SCHED
}
}
constexpr int BATCH = 32, SEQ = 2048, DM = 1024, DEPTH = 4, M = BATCH * SEQ;
constexpr int FF = 4096, PLE = 256, NIN = 4112;
constexpr float EPS = 1e-6f;
constexpr int NWAVES = 8, NTHR = NWAVES * 64;
constexpr int PH_PER_LAYER = 13, NPHASE = 1 + DEPTH * PH_PER_LAYER;
constexpr size_t MiB = 1u << 20;
constexpr size_t WS_CTL = 0, CTL_ZERO_BYTES = 1 * MiB;
constexpr size_t WS_WIN = 1 * MiB, WS_WOUT = 17 * MiB, WS_WQKV = 21 * MiB, WS_WO = 27 * MiB, WS_WUP = 31 * MiB, WS_WDN = 63 * MiB, WS_WPLE = 95 * MiB, WS_WG = 97 * MiB;
constexpr size_t WS_WGATES = 105 * MiB, WS_GT = 106 * MiB, WS_ROPE = 110 * MiB;
constexpr size_t WS_DEN = 126 * MiB;
constexpr size_t WS_RA = 128 * MiB, WS_RB = 256 * MiB, WS_RC = 384 * MiB, WS_RD = 896 * MiB, WS_END = 1024 * MiB;
constexpr size_t WS_QKVA = 128 * MiB, WS_KWT = 320 * MiB, WS_X1 = 384 * MiB, WS_KT = 384 * MiB, WS_UT = 448 * MiB, WS_NW = 512 * MiB, WS_X2 = 576 * MiB, WS_VT = 896 * MiB, WS_ATT = 960 * MiB, WS_PT = 992 * MiB, WS_MIXED = 384 * MiB;
constexpr int CW_BAR = 4096;
constexpr int RING_BYTES = 131072, MISC_OFF = RING_BYTES, LDS_BYTES = RING_BYTES + 1024;

#define GAS __attribute__((address_space(1)))
#define LAS __attribute__((address_space(3)))
typedef unsigned short bf16;
typedef float f32x4 __attribute__((ext_vector_type(4)));
typedef float f32x2 __attribute__((ext_vector_type(2)));
typedef unsigned u32x4 __attribute__((ext_vector_type(4)));
typedef unsigned u32x2 __attribute__((ext_vector_type(2)));
#define LDS_WAIT() asm volatile("s_waitcnt lgkmcnt(0)" ::: "memory")
#define VM_WAIT() asm volatile("s_waitcnt vmcnt(0)" ::: "memory")
using pg8::bf_lo; using pg8::bf_hi;
typedef __bf16 bf16x2_t __attribute__((ext_vector_type(2)));
__device__ __forceinline__ unsigned pk2(float lo, float hi) { return pg8::cvt_pk_bf16(lo, hi); }
__device__ __forceinline__ unsigned pk2v(float lo, float hi) { const f32x2 v = {lo, hi}; const bf16x2_t b = __builtin_convertvector(v, bf16x2_t); return __builtin_bit_cast(unsigned, b); }
__device__ __forceinline__ float wave_sum(float v) {
#pragma unroll
    for (int o = 1; o < 64; o <<= 1) v += __shfl_xor(v, o);
    return v;
}
__device__ __forceinline__ float dot4(f32x4 a, f32x4 b) { return (a.x * b.x + a.y * b.y) + (a.z * b.z + a.w * b.w); }
__device__ __forceinline__ float sigmoid_f(float x) { return 1.f / (1.f + __expf(-x)); }
__device__ __forceinline__ float softplus_f(float x) { return x > 20.f ? x : log1pf(expf(x)); }

#define XB_TMO      128
#define XB_XCNT(j)  (256  + 64 * (j))
#define XB_XSUB(j)  (1280 + 64 * (j))
#define XB_XGEN(j)  (2304 + 64 * (j))
#define XB_TOP      3328
#define XB_TOPGEN   3392
#define XCD_BAR_WORDS 3456
#define XB_SPIN_CAP (1u << 18)

__device__ __forceinline__ unsigned xb_ld(unsigned* p)              { return __hip_atomic_load(p, __ATOMIC_RELAXED, __HIP_MEMORY_SCOPE_AGENT); }
__device__ __forceinline__ unsigned xb_add(unsigned* p, unsigned v) { return __hip_atomic_fetch_add(p, v, __ATOMIC_RELAXED, __HIP_MEMORY_SCOPE_AGENT); }
__device__ __forceinline__ unsigned xb_xcc_id() { return (unsigned)__builtin_amdgcn_s_getreg((3 << 11) | 20) & 0xFu; }
#define XB_SPIN(cond, bar) do { unsigned _sp = 0; while (cond) { __builtin_amdgcn_s_sleep(1); \
    if ((++_sp & 255u) == 0u) { if (xb_ld(&(bar)[XB_TMO])) break; if (_sp > XB_SPIN_CAP) { atomicAdd(&(bar)[XB_TMO], 1u); break; } } } } while (0)

struct XcdBarrier {
    unsigned* bar; unsigned x;
    volatile LAS unsigned* st;
};

__device__ __forceinline__ XcdBarrier xcd_barrier_post(unsigned* bar, volatile LAS unsigned* st) {
    XcdBarrier b; b.bar = bar; b.x = xb_xcc_id(); b.st = st;
    if (threadIdx.x == 0) (void)xb_add(&bar[XB_XCNT(b.x)], 1u);
    return b;
}
__device__ __forceinline__ void xcd_barrier_complete(unsigned* bar, unsigned x, unsigned& nloc, unsigned& nx) {
    const unsigned G = gridDim.x * gridDim.y * gridDim.z;
    unsigned sum, cnt, mine, sp = 0u;
    for (;;) {
        sum = 0u; cnt = 0u; mine = 0u;
#pragma unroll
        for (unsigned j = 0; j < 16; ++j) { const unsigned c = xb_ld(&bar[XB_XCNT(j)]); sum += c; cnt += (c > 0u) ? 1u : 0u; mine = (j == x) ? c : mine; }
        if (sum == G) break;
        __builtin_amdgcn_s_sleep(1);
        if ((++sp & 255u) == 0u) { if (xb_ld(&bar[XB_TMO])) break; if (sp > XB_SPIN_CAP) { atomicAdd(&bar[XB_TMO], 1u); break; } }
    }
    nloc = mine > 0u ? mine : 1u; nx = cnt > 0u ? cnt : 1u;
}

__device__ __forceinline__ void xcd_barrier(const XcdBarrier& b) {
    asm volatile("s_waitcnt vmcnt(0)" ::: "memory");
    __syncthreads();
    if (threadIdx.x == 0) {
        unsigned* bar = b.bar;
        __builtin_amdgcn_s_waitcnt(0);
        unsigned nloc = b.st[0], nx = b.st[1];
        if (nloc == 0u) { xcd_barrier_complete(bar, b.x, nloc, nx); b.st[0] = nloc; b.st[1] = nx; }
        const unsigned old = xb_add(&bar[XB_XSUB(b.x)], 1u);
        const unsigned gen = old / nloc;
        if (old + 1u == (gen + 1u) * nloc) {
            __builtin_amdgcn_fence(__ATOMIC_RELEASE, "agent");
            asm volatile("s_waitcnt vmcnt(0)" ::: "memory");
            const unsigned og = xb_add(&bar[XB_TOP], 1u);
            const unsigned tg = og / nx;
            if (og + 1u == (tg + 1u) * nx) xb_add(&bar[XB_TOPGEN], 1u);
            else XB_SPIN(xb_ld(&bar[XB_TOPGEN]) == tg, bar);
            __builtin_amdgcn_fence(__ATOMIC_ACQUIRE, "agent");
            xb_add(&bar[XB_XGEN(b.x)], 1u);
            asm volatile("s_waitcnt vmcnt(0)" ::: "memory");
        } else {
            XB_SPIN(xb_ld(&bar[XB_XGEN(b.x)]) == gen, bar);
            __builtin_amdgcn_fence(__ATOMIC_ACQUIRE, "agent");
            asm volatile("s_waitcnt vmcnt(0)" ::: "memory");
        }
    }
    __syncthreads();
}
struct Args {
    const float *x, *p; const int* pos; const float *gains, *w_in, *conv, *a_log, *dt_bias, *norm_a, *i_bias, *f_bias, *norm_b, *w_out, *w_qkv, *b_qkv, *sinks, *w_o, *b_o, *w_up, *w_down, *w_ple, *w_gate;
    float* out; unsigned char* ws;
    int ph_lo, ph_hi;
};

__device__ __forceinline__ void transpose_item(const float* src, int ld, int K, bf16* dst, LAS float* scr, int item, int nblk, int lane) {
    const int kb = item / nblk, nb = item % nblk, k0 = 64 * kb, n0 = 32 * nb;
#pragma unroll 8
    for (int i = 0; i < 32; ++i) { const int kk = 2 * i + (lane >> 5); scr[kk * 33 + (lane & 31)] = src[(size_t)(k0 + kk) * ld + n0 + (lane & 31)]; }
    LDS_WAIT(); asm volatile("" ::: "memory");
    const int c = lane & 7;
#pragma unroll
    for (int j = 0; j < 4; ++j) { const int n = (lane >> 3) + 8 * j; const LAS float* s = scr + (8 * c) * 33 + n;
        u32x4 o; o.x = pk2(s[0 * 33], s[1 * 33]); o.y = pk2(s[2 * 33], s[3 * 33]); o.z = pk2(s[4 * 33], s[5 * 33]); o.w = pk2(s[6 * 33], s[7 * 33]);
        *(u32x4*)(dst + (size_t)(n0 + n) * K + k0 + 8 * c) = o; }
    LDS_WAIT(); asm volatile("" ::: "memory");
}
__device__ __forceinline__ int gate_col(int c) { return c < 8 ? 1536 + c : 3592 + (c - 8); }

typedef const __attribute__((address_space(4))) Args* KArgs;
__device__ __forceinline__ KArgs kargs() { KArgs p = (KArgs)__builtin_amdgcn_kernarg_segment_ptr(); asm volatile("" : "+s"(p)); return p; }
__device__ __forceinline__ int fresh_tid() { int t = threadIdx.x; asm volatile("" : "+v"(t)); return t; }
__device__ __forceinline__ void prologue_phase(KArgs a, LAS unsigned char* lds, int gw, int NGW, int wave, int lane, int gtid, int NGT) {
    LAS float* scr = (LAS float*)(lds + wave * 16384);
    constexpr int I_IN = 16 * 16, I_SQ = 16 * 32, I_QKV = 16 * 48, I_UP = 16 * 128, I_DN = 64 * 32, I_PLE = 4 * 32;
    constexpr int NITEMS = 16 * I_IN + 2 * I_SQ + 2 * I_QKV + 2 * I_SQ + 4 * I_UP + 4 * I_DN + 4 * I_PLE + 4 * I_SQ;
    unsigned char* ws = a->ws;
    for (int it = gw; it < NITEMS; it += NGW) {
        int r = it;
        if (r < 16 * I_IN) { const int j = r / I_IN, e = j >> 3, s = j & 7, col0 = 512 * s + (s >= 3 ? 8 : 0) + (s >= 7 ? 8 : 0);
            transpose_item(a->w_in + (size_t)e * DM * NIN + col0, NIN, DM, (bf16*)(ws + WS_WIN) + ((size_t)e * 4096 + s * 512) * DM, scr, r % I_IN, 16, lane); continue; } r -= 16 * I_IN;
        if (r < 2 * I_SQ) { const int e = r / I_SQ; transpose_item(a->w_out + (size_t)e * DM * DM, DM, DM, (bf16*)(ws + WS_WOUT) + (size_t)e * DM * DM, scr, r % I_SQ, 32, lane); continue; } r -= 2 * I_SQ;
        if (r < 2 * I_QKV) { const int e = r / I_QKV; transpose_item(a->w_qkv + (size_t)e * DM * 1536, 1536, DM, (bf16*)(ws + WS_WQKV) + (size_t)e * 1536 * DM, scr, r % I_QKV, 48, lane); continue; } r -= 2 * I_QKV;
        if (r < 2 * I_SQ) { const int e = r / I_SQ; transpose_item(a->w_o + (size_t)e * DM * DM, DM, DM, (bf16*)(ws + WS_WO) + (size_t)e * DM * DM, scr, r % I_SQ, 32, lane); continue; } r -= 2 * I_SQ;
        if (r < 4 * I_UP) { const int l = r / I_UP; transpose_item(a->w_up + (size_t)l * DM * FF, FF, DM, (bf16*)(ws + WS_WUP) + (size_t)l * FF * DM, scr, r % I_UP, 128, lane); continue; } r -= 4 * I_UP;
        if (r < 4 * I_DN) { const int l = r / I_DN; transpose_item(a->w_down + (size_t)l * FF * DM, DM, FF, (bf16*)(ws + WS_WDN) + (size_t)l * DM * FF, scr, r % I_DN, 32, lane); continue; } r -= 4 * I_DN;
        if (r < 4 * I_PLE) { const int l = r / I_PLE; transpose_item(a->w_ple + (size_t)l * PLE * DM, DM, PLE, (bf16*)(ws + WS_WPLE) + (size_t)l * DM * PLE, scr, r % I_PLE, 32, lane); continue; } r -= 4 * I_PLE;
        { const int l = r / I_SQ; transpose_item(a->w_gate + (size_t)l * DM * DM, DM, DM, (bf16*)(ws + WS_WG) + (size_t)l * DM * DM, scr, r % I_SQ, 32, lane); }
    }
    float* Wg = (float*)(a->ws + WS_WGATES);
    for (int i = gtid; i < 2 * 16 * 1024; i += NGT) { const int e = i >> 14, c = (i >> 10) & 15, k = i & 1023; Wg[i] = a->w_in[((size_t)e * 1024 + k) * NIN + gate_col(c)]; }
    f32x2* rope = (f32x2*)(a->ws + WS_ROPE);
    for (int i = gtid; i < M * 32; i += NGT) { const int m = i >> 5, d = i & 31;
        const float inv = (float)pow(10000.0, -(double)d / 32.0); const float ang = (float)a->pos[m] * inv; float sn, cs; sincosf(ang, &sn, &cs); rope[i] = (f32x2){cs, sn}; }
}

__device__ __forceinline__ void norm_phase(LAS unsigned char* lds, const float* hin, const float* g0, bf16* HN, bool even, const float* Wg, float* Gt, int gw, int NGW, int tid, int lane) {
    LAS f32x4* wl = (LAS f32x4*)lds;
    if (even) { for (int i = tid; i < 4096; i += NTHR) wl[i] = ((const f32x4*)Wg)[i]; __syncthreads(); }
    f32x4 gv[4];
#pragma unroll
    for (int j = 0; j < 4; ++j) gv[j] = ((const f32x4*)g0)[lane + 64 * j];
    for (int m = gw; m < M; m += NGW) {
        const f32x4* xr = (const f32x4*)(hin + (size_t)m * DM) + lane;
        f32x4 v[4]; float s = 0.f;
#pragma unroll
        for (int j = 0; j < 4; ++j) { v[j] = xr[64 * j]; s += dot4(v[j], v[j]); }
        const float rstd = rsqrtf(wave_sum(s) * (1.f / DM) + EPS);
        u32x2* o8 = (u32x2*)(HN + (size_t)m * DM) + lane;
#pragma unroll
        for (int j = 0; j < 4; ++j) { v[j] = v[j] * rstd * gv[j]; o8[64 * j] = (u32x2){pk2(v[j].x, v[j].y), pk2(v[j].z, v[j].w)}; }
        if (even) {
            float keep = 0.f;
#pragma unroll
            for (int c = 0; c < 16; ++c) { float d = 0.f;
#pragma unroll
                for (int j = 0; j < 4; ++j) d += dot4(v[j], wl[c * 256 + lane + 64 * j]);
                d = wave_sum(d); if (lane == c) keep = d; }
            if (lane < 16) Gt[(size_t)m * 16 + lane] = keep;
        }
    }
    if (even) __syncthreads();
}
__device__ __forceinline__ void resid_a_phase(const float* mix, const float* hin, float* out, const float* g1, const float* g2, bf16* HN, int gw, int NGW, int lane) {
    f32x4 ga[4], gb[4];
#pragma unroll
    for (int j = 0; j < 4; ++j) { ga[j] = ((const f32x4*)g1)[lane + 64 * j]; gb[j] = ((const f32x4*)g2)[lane + 64 * j]; }
    for (int m = gw; m < M; m += NGW) {
        const f32x4* xr = (const f32x4*)(mix + (size_t)m * DM) + lane; const f32x4* hr = (const f32x4*)(hin + (size_t)m * DM) + lane;
        f32x4 v[4], h[4]; float s = 0.f;
#pragma unroll
        for (int j = 0; j < 4; ++j) { v[j] = xr[64 * j]; h[j] = hr[64 * j]; s += dot4(v[j], v[j]); }
        const float r1 = rsqrtf(wave_sum(s) * (1.f / DM) + EPS); float s2 = 0.f;
        f32x4* orow = (f32x4*)(out + (size_t)m * DM) + lane;
#pragma unroll
        for (int j = 0; j < 4; ++j) { h[j] = h[j] + v[j] * r1 * ga[j]; orow[64 * j] = h[j]; s2 += dot4(h[j], h[j]); }
        const float r2 = rsqrtf(wave_sum(s2) * (1.f / DM) + EPS);
        u32x2* o8 = (u32x2*)(HN + (size_t)m * DM) + lane;
#pragma unroll
        for (int j = 0; j < 4; ++j) { const f32x4 y = h[j] * r2 * gb[j]; o8[64 * j] = (u32x2){pk2(y.x, y.y), pk2(y.z, y.w)}; }
    }
}
__device__ __forceinline__ void resid_b_phase(const float* ff, float* out, const float* g3, bf16* HB, const float* pl, bf16* PB, int gw, int NGW, int lane, int gtid, int NGT) {
    f32x4 ga[4];
#pragma unroll
    for (int j = 0; j < 4; ++j) ga[j] = ((const f32x4*)g3)[lane + 64 * j];
    for (int m = gw; m < M; m += NGW) {
        const f32x4* xr = (const f32x4*)(ff + (size_t)m * DM) + lane; f32x4* hr = (f32x4*)(out + (size_t)m * DM) + lane;
        f32x4 v[4], h[4]; float s = 0.f;
#pragma unroll
        for (int j = 0; j < 4; ++j) { v[j] = xr[64 * j]; h[j] = hr[64 * j]; s += dot4(v[j], v[j]); }
        const float r1 = rsqrtf(wave_sum(s) * (1.f / DM) + EPS);
        u32x2* o8 = (u32x2*)(HB + (size_t)m * DM) + lane;
#pragma unroll
        for (int j = 0; j < 4; ++j) { h[j] = h[j] + v[j] * r1 * ga[j]; hr[64 * j] = h[j]; o8[64 * j] = (u32x2){pk2(h[j].x, h[j].y), pk2(h[j].z, h[j].w)}; }
    }
    for (int i = gtid; i < M * PLE / 8; i += NGT) { const f32x4 a = ((const f32x4*)pl)[2 * i], b = ((const f32x4*)pl)[2 * i + 1];
        ((u32x4*)PB)[i] = (u32x4){pk2(a.x, a.y), pk2(a.z, a.w), pk2(b.x, b.y), pk2(b.z, b.w)}; }
}
__device__ __forceinline__ void conv_phase(const bf16* BIG, const float* convw  , bf16* QKVA, int gw, int NGW, int lane) {
    for (int m = gw; m < M; m += NGW) {
        const int s = m & (SEQ - 1);
#pragma unroll
        for (int j = 0; j < 3; ++j) {
            const int col = j * 512 + lane * 8; float acc[8];
#pragma unroll
            for (int i = 0; i < 8; ++i) acc[i] = 0.f;
#pragma unroll
            for (int kk = 0; kk < 4; ++kk) if (s - 3 + kk >= 0) {
                const u32x4 xv = *(const u32x4*)(BIG + (size_t)(m - 3 + kk) * 1536 + col); const f32x4 w0 = *(const f32x4*)(convw + kk * 1536 + col), w1 = *(const f32x4*)(convw + kk * 1536 + col + 4);
                acc[0] += bf_lo(xv.x) * w0.x; acc[1] += bf_hi(xv.x) * w0.y; acc[2] += bf_lo(xv.y) * w0.z; acc[3] += bf_hi(xv.y) * w0.w;
                acc[4] += bf_lo(xv.z) * w1.x; acc[5] += bf_hi(xv.z) * w1.y; acc[6] += bf_lo(xv.w) * w1.z; acc[7] += bf_hi(xv.w) * w1.w; }
            float ss = 0.f;
#pragma unroll
            for (int i = 0; i < 8; ++i) { acc[i] = acc[i] / (1.f + __expf(-acc[i])); ss += acc[i] * acc[i]; }
            if (j < 2) { ss += __shfl_xor(ss, 1); ss += __shfl_xor(ss, 2); ss += __shfl_xor(ss, 4); ss += __shfl_xor(ss, 8);
                const float sc = rsqrtf(ss + EPS) * (j == 0 ? 0.08838834764831845f : 1.f);
#pragma unroll
                for (int i = 0; i < 8; ++i) acc[i] *= sc; }
            *(u32x4*)(QKVA + (size_t)m * 1536 + col) = (u32x4){pk2(acc[0], acc[1]), pk2(acc[2], acc[3]), pk2(acc[4], acc[5]), pk2(acc[6], acc[7])};
        }
    }
}
__device__ __forceinline__ void rope_phase(bf16* QKV, const f32x2* rope, int gw, int NGW, int lane) {
    for (int m = gw; m < M; m += NGW) {
        const int grp = lane & 7; const f32x4* tb = (const f32x4*)(rope + (size_t)m * 32 + grp * 4); const f32x4 t0 = tb[0], t1 = tb[1];
        const float cs[4] = {t0.x, t0.z, t1.x, t1.z}, sn[4] = {t0.y, t0.w, t1.y, t1.w};
#pragma unroll
        for (int k = 0; k < 3; ++k) {
            if (k == 2 && lane >= 32) break;
            const int hh = (k < 2) ? ((lane + 64 * k) >> 3) : (lane >> 3); const float scale = (k < 2) ? 0.125f : 1.f;
            bf16* base = QKV + (size_t)m * 1536 + (k < 2 ? 0 : 1024) + hh * 64 + grp * 4;
            const u32x2 a = *(const u32x2*)base, b = *(const u32x2*)(base + 32);
            const float x1[4] = {bf_lo(a.x), bf_hi(a.x), bf_lo(a.y), bf_hi(a.y)}, x2[4] = {bf_lo(b.x), bf_hi(b.x), bf_lo(b.y), bf_hi(b.y)};
            float o1[4], o2[4];
#pragma unroll
            for (int i = 0; i < 4; ++i) { o1[i] = (x1[i] * cs[i] - x2[i] * sn[i]) * scale; o2[i] = (x2[i] * cs[i] + x1[i] * sn[i]) * scale; }
            *(u32x2*)base = (u32x2){pk2(o1[0], o1[1]), pk2(o1[2], o1[3])}; *(u32x2*)(base + 32) = (u32x2){pk2(o2[0], o2[1]), pk2(o2[2], o2[3])};
        }
    }
}
typedef short bf16x8 __attribute__((ext_vector_type(8)));
#define MFMA16(a, b, c) __builtin_amdgcn_mfma_f32_16x16x32_bf16(a, b, c, 0, 0, 0)
__device__ __forceinline__ bf16x8 pack8(f32x4 a, f32x4 b) { const u32x4 w = {pk2v(a.x, a.y), pk2v(a.z, a.w), pk2v(b.x, b.y), pk2v(b.z, b.w)}; return __builtin_bit_cast(bf16x8, w); }
__device__ __forceinline__ float bf2f(unsigned short v) { return __builtin_bit_cast(float, (unsigned)v << 16); }
__device__ __forceinline__ float rdlane(float v, int i) { return __builtin_bit_cast(float, __builtin_amdgcn_readlane(__builtin_bit_cast(int, v), i)); }
__device__ __forceinline__ float scan_add(float v, int lane) {
#pragma unroll
    for (int o = 1; o < 64; o <<= 1) { const float t = __shfl_up(v, o); if (lane >= o) v += t; }
    return v; }
__device__ __forceinline__ float scan_max(float v, int lane) {
#pragma unroll
    for (int o = 1; o < 64; o <<= 1) { const float t = __shfl_up(v, o); if (lane >= o) v = fmaxf(v, t); }
    return v; }
__device__ __forceinline__ int kperm(int ks, int q, int jj) { return 32 * ks + (jj < 4 ? 4 * q + jj : 16 + 4 * q + jj - 4); }
template <bool SCALE> __device__ __forceinline__ u32x4 tr_gather(const bf16* src  , int ld, int ks, int q, float esc_lane) {
    unsigned w[4];
#pragma unroll
    for (int j2 = 0; j2 < 4; ++j2) { const int r0 = kperm(ks, q, 2 * j2), r1 = r0 + 1; const unsigned short a = src[(size_t)r0 * ld], b = src[(size_t)r1 * ld];
        if (SCALE) { const float s0 = __shfl(esc_lane, r0), s1 = __shfl(esc_lane, r1); w[j2] = pk2(bf2f(a) * s0, bf2f(b) * s1); } else w[j2] = (unsigned)a | ((unsigned)b << 16); }
    return (u32x4){w[0], w[1], w[2], w[3]};
}
struct ScanBufs {
    bf16* QKVA;
    bf16* X2;
    float* Gt;
    bf16 *KT, *UT, *NW, *ATT;
    bf16 *KWT, *VT, *PT;
    float* DEN;
};
__device__ __forceinline__ void local_phase(LAS unsigned char* lds, const ScanBufs sb, const float* a_log, const float* dt_bias, const float* i_bias, const float* f_bias, int gw, int NGW, int wave, int lane) {
    LAS float* Lw = (LAS float*)(lds + wave * 16384);
    const int njobs = 2 * BATCH * 4 * (SEQ / 64), per = (njobs + NGW - 1) / NGW; const int lane_in = lane;
#pragma unroll 1
    for (int rj = 0; rj < per; ++rj) {
        const int job = gw * per + rj; if (job >= njobs) break;
        int lane = lane_in; asm volatile("" : "+v"(lane));
        const int x = lane & 15, q = lane >> 4;
        const int mixer = job & 1, cidx = job >> 1, c = cidx & 31, h = (cidx >> 5) & 3, b = cidx >> 7;
        const int m0 = b * SEQ + c * 64; const size_t cid = (size_t)cidx;
        float* gr = sb.Gt + (size_t)(m0 + lane) * 16;
        if (mixer == 0) {
            const float beta = 1.f / (1.f + expf(-gr[h])); const float g = -expf(a_log[h]) * softplus_f(gr[4 + h] + dt_bias[h]);
            const float gcum = scan_add(g, lane), eg = expf(gcum), glast = __shfl(gcum, 63);
            const bf16* kb = sb.QKVA + (size_t)m0 * 1536 + 512 + h * 128; const bf16* qb = sb.QKVA + (size_t)m0 * 1536 + h * 128; const bf16* vb = kb + 512;
            bf16x8 Kf[4][4], Qf[4][4];
#pragma unroll
            for (int t = 0; t < 4; ++t)
#pragma unroll
                for (int ks = 0; ks < 4; ++ks) { Kf[t][ks] = *(const bf16x8*)(kb + (size_t)(16 * t + x) * 1536 + 32 * ks + 8 * q); Qf[t][ks] = *(const bf16x8*)(qb + (size_t)(16 * t + x) * 1536 + 32 * ks + 8 * q); }
            float gj[4][4];
#pragma unroll
            for (int jt = 0; jt < 4; ++jt)
#pragma unroll
                for (int r = 0; r < 4; ++r) gj[jt][r] = __shfl(gcum, 16 * jt + 4 * q + r);
            bf16* attp = sb.ATT + cid * 4096;
#pragma unroll
            for (int it = 0; it < 4; ++it) {
                const float gi = __shfl(gcum, 16 * it + x), bi = __shfl(beta, 16 * it + x); f32x4 d2s[4];
#pragma unroll
                for (int jt = 0; jt < 4; ++jt) {
                    if (jt <= it) { f32x4 D1 = {0.f, 0.f, 0.f, 0.f}, D2 = D1;
#pragma unroll
                        for (int ks = 0; ks < 4; ++ks) { D1 = MFMA16(Kf[jt][ks], Kf[it][ks], D1); D2 = MFMA16(Kf[jt][ks], Qf[it][ks], D2); }
                        f32x4 lv;
#pragma unroll
                        for (int r = 0; r < 4; ++r) { const int j = 16 * jt + 4 * q + r, i = 16 * it + x; const float dec = __expf(fminf(gi - gj[jt][r], 0.f));
                            lv[r] = (j < i) ? bi * D1[r] * dec : 0.f; d2s[jt][r] = (j <= i) ? D2[r] * dec : 0.f; }
                        *(LAS f32x4*)(Lw + (16 * it + x) * 64 + 16 * jt + 4 * q) = lv;
                    } else d2s[jt] = (f32x4){0.f, 0.f, 0.f, 0.f};
                }
#pragma unroll
                for (int kp = 0; kp < 2; ++kp) if (it >= 2 || kp == 0) *(bf16x8*)(attp + ((it * 2 + kp) * 64 + lane) * 8) = pack8(d2s[2 * kp], d2s[2 * kp + 1]);
            }
            { float* tab = (float*)(attp + 512); tab[lane] = eg; tab[64 + lane] = expf(glast - gcum); }
            bf16* ktp = sb.KT + cid * 8192;
#pragma unroll 1
            for (int dt = 0; dt < 8; ++dt)
#pragma unroll
                for (int kp = 0; kp < 2; ++kp) *(u32x4*)(ktp + ((dt * 2 + kp) * 64 + lane) * 8) = tr_gather<false>(kb + 16 * dt + x, 1536, kp, q, 0.f);
            LDS_WAIT();
            const float be = beta * eg;
#pragma unroll 1
            for (int p = 0; p < 4; ++p) {
                const int col = 64 * (p & 1) + lane; const bf16* src = (p < 2 ? vb : kb) + col; const float scl = p < 2 ? beta : be;
                float xv[64];
#pragma unroll
                for (int i = 0; i < 64; ++i) {
                    float a0 = 0.f, a1 = 0.f, a2 = 0.f, a3 = 0.f;
#pragma unroll
                    for (int g4 = 0; g4 < (i + 3) / 4; ++g4) { const f32x4 lr = *(const LAS f32x4*)(Lw + i * 64 + 4 * g4);
                        if (4 * g4 + 0 < i) a0 += lr.x * xv[4 * g4 + 0]; if (4 * g4 + 1 < i) a1 += lr.y * xv[4 * g4 + 1]; if (4 * g4 + 2 < i) a2 += lr.z * xv[4 * g4 + 2]; if (4 * g4 + 3 < i) a3 += lr.w * xv[4 * g4 + 3]; }
                    xv[i] = rdlane(scl, i) * bf2f(src[(size_t)i * 1536]) - ((a0 + a1) + (a2 + a3));
                }
                if (p < 2) { bf16* ut = sb.UT + cid * 8192 + (size_t)col * 64;
#pragma unroll
                    for (int k8 = 0; k8 < 8; ++k8) *(u32x4*)(ut + 8 * k8) = (u32x4){pk2(xv[8 * k8], xv[8 * k8 + 1]), pk2(xv[8 * k8 + 2], xv[8 * k8 + 3]), pk2(xv[8 * k8 + 4], xv[8 * k8 + 5]), pk2(xv[8 * k8 + 6], xv[8 * k8 + 7])};
                } else { const int d = col, ks = d >> 5, dd = d & 31, qp = (dd & 15) >> 2, jj = (dd & 3) + 4 * (dd >> 4);
                    unsigned char* nw = (unsigned char*)(sb.NW + cid * 8192) + ks * 1024 + qp * 256 + jj * 2;
#pragma unroll
                    for (int i = 0; i < 64; ++i) *(unsigned short*)(nw + (i >> 4) * 4096 + (i & 15) * 16) = (unsigned short)(pk2(-xv[i], 0.f) & 0xffffu);
                }
            }
            LDS_WAIT();
        } else {
            const float il = gr[8 + h] + i_bias[h]; const float fl = -softplus_f(-(gr[12 + h] + f_bias[h]));
            const float bcum = scan_add(fl, lane), t = il - bcum, pm = scan_max(t, lane), pml = __shfl(pm, 63);
            const float esc = __expf(t - pml);
            const bf16* qb = sb.X2 + (size_t)m0 * 2560 + 512 + h * 128; const bf16* kb = qb + 512; const bf16* vb = kb + 512;
            bf16x8 Kf[4][4], Qf[4][4];
#pragma unroll
            for (int tt = 0; tt < 4; ++tt)
#pragma unroll
                for (int ks = 0; ks < 4; ++ks) { Kf[tt][ks] = *(const bf16x8*)(kb + (size_t)(16 * tt + x) * 2560 + 32 * ks + 8 * q); Qf[tt][ks] = *(const bf16x8*)(qb + (size_t)(16 * tt + x) * 2560 + 32 * ks + 8 * q); }
            float tj[4][4];
#pragma unroll
            for (int jt = 0; jt < 4; ++jt)
#pragma unroll
                for (int r = 0; r < 4; ++r) tj[jt][r] = __shfl(t, 16 * jt + 4 * q + r);
            bf16* ptp = sb.PT + cid * 4096;
#pragma unroll
            for (int it = 0; it < 4; ++it) {
                const float pmi = __shfl(pm, 16 * it + x); f32x4 d2s[4];
#pragma unroll
                for (int jt = 0; jt < 4; ++jt) {
                    if (jt <= it) { f32x4 D2 = {0.f, 0.f, 0.f, 0.f};
#pragma unroll
                        for (int ks = 0; ks < 4; ++ks) D2 = MFMA16(Kf[jt][ks], Qf[it][ks], D2);
#pragma unroll
                        for (int r = 0; r < 4; ++r) { const int j = 16 * jt + 4 * q + r, i = 16 * it + x; d2s[jt][r] = (j <= i) ? D2[r] * 0.08838834764831845f * __expf(fminf(tj[jt][r] - pmi, 0.f)) : 0.f; }
                    } else d2s[jt] = (f32x4){0.f, 0.f, 0.f, 0.f};
                }
#pragma unroll
                for (int kp = 0; kp < 2; ++kp) if (it >= 2 || kp == 0) *(bf16x8*)(ptp + ((it * 2 + kp) * 64 + lane) * 8) = pack8(d2s[2 * kp], d2s[2 * kp + 1]);
            }
            { float* tab = (float*)(ptp + 512); tab[lane] = bcum; tab[64 + lane] = bcum + pm; }
            bf16* kwp = sb.KWT + cid * 8192; bf16* vtp = sb.VT + cid * 8192;
#pragma unroll 1
            for (int dt = 0; dt < 8; ++dt)
#pragma unroll
                for (int kp = 0; kp < 2; ++kp) { *(u32x4*)(kwp + ((dt * 2 + kp) * 64 + lane) * 8) = tr_gather<true>(kb + 16 * dt + x, 2560, kp, q, esc);
                    *(u32x4*)(vtp + ((dt * 2 + kp) * 64 + lane) * 8) = tr_gather<false>(vb + 16 * dt + x, 2560, kp, q, 0.f); }
        }
    }
}
__device__ __forceinline__ void recur_phase(const ScanBufs sb, int G, int bid, int wave, int lane) {
    const int x = lane & 15, q = lane >> 4, et = wave;
#pragma unroll 1
    for (int u = bid; u < 2 * BATCH * 4; u += G) {
        const int mixer = u >> 7, b = (u & 127) >> 2, h = u & 3;
        if (mixer == 0) {
            f32x4 S[8];
#pragma unroll
            for (int d = 0; d < 8; ++d) S[d] = (f32x4){0.f, 0.f, 0.f, 0.f};
#pragma unroll 1
            for (int c = 0; c < SEQ / 64; ++c) {
                const int m0 = b * SEQ + c * 64; const size_t cid = (size_t)((b * 4 + h) * 32 + c);
                const bf16* nwp = sb.NW + cid * 8192; const bf16* utp = sb.UT + cid * 8192 + (size_t)(16 * et + x) * 64; const bf16* atp = sb.ATT + cid * 4096; const bf16* ktp = sb.KT + cid * 8192;
                const float* tab = (const float*)(atp + 512);
                bf16x8 Sb[4];
#pragma unroll
                for (int ks = 0; ks < 4; ++ks) Sb[ks] = pack8(S[2 * ks], S[2 * ks + 1]);
                f32x4 vn[4];
#pragma unroll
                for (int mt = 0; mt < 4; ++mt) { const u32x2 uu = *(const u32x2*)(utp + 16 * mt + 4 * q); f32x4 acc = {bf_lo(uu.x), bf_hi(uu.x), bf_lo(uu.y), bf_hi(uu.y)};
#pragma unroll
                    for (int ks = 0; ks < 4; ++ks) acc = MFMA16(*(const bf16x8*)(nwp + ((mt * 4 + ks) * 64 + lane) * 8), Sb[ks], acc);
                    vn[mt] = acc; }
                bf16x8 vb2[2] = {pack8(vn[0], vn[1]), pack8(vn[2], vn[3])};
#pragma unroll
                for (int it = 0; it < 4; ++it) { f32x4 acc = {0.f, 0.f, 0.f, 0.f};
                    const bf16* qrow = sb.QKVA + (size_t)(m0 + 16 * it + x) * 1536 + h * 128 + 4 * q;
#pragma unroll
                    for (int ks = 0; ks < 4; ++ks) { const u32x2 a = *(const u32x2*)(qrow + 32 * ks), bq = *(const u32x2*)(qrow + 32 * ks + 16); const u32x4 w = {a.x, a.y, bq.x, bq.y};
                        acc = MFMA16(Sb[ks], __builtin_bit_cast(bf16x8, w), acc); }
                    acc = acc * tab[16 * it + x];
#pragma unroll
                    for (int kp = 0; kp < 2; ++kp) if (it >= 2 || kp == 0) acc = MFMA16(vb2[kp], *(const bf16x8*)(atp + ((it * 2 + kp) * 64 + lane) * 8), acc);
                    *(u32x2*)(sb.QKVA + (size_t)(m0 + 16 * it + x) * 1536 + 512 + h * 128 + 16 * et + 4 * q) = (u32x2){pk2v(acc.x, acc.y), pk2v(acc.z, acc.w)}; }
                f32x4 vs[4];
#pragma unroll
                for (int mt = 0; mt < 4; ++mt)
#pragma unroll
                    for (int r = 0; r < 4; ++r) vs[mt][r] = vn[mt][r] * tab[64 + 16 * mt + 4 * q + r];
                const bf16x8 vsb[2] = {pack8(vs[0], vs[1]), pack8(vs[2], vs[3])};
                const float gam = tab[63];
#pragma unroll
                for (int dt = 0; dt < 8; ++dt) { f32x4 acc = S[dt] * gam;
#pragma unroll
                    for (int kp = 0; kp < 2; ++kp) acc = MFMA16(*(const bf16x8*)(ktp + ((dt * 2 + kp) * 64 + lane) * 8), vsb[kp], acc);
                    S[dt] = acc; }
            }
        } else {
            f32x4 Cs[8], Ce[8]; float mrun = 0.f;
#pragma unroll
            for (int d = 0; d < 8; ++d) { Cs[d] = (f32x4){0.f, 0.f, 0.f, 0.f}; Ce[d] = Cs[d]; }
            const short one = (x == 0) ? (short)0x3F80 : (short)0; const bf16x8 ones = {one, one, one, one, one, one, one, one};
#pragma unroll 1
            for (int c = 0; c < SEQ / 64; ++c) {
                const int m0 = b * SEQ + c * 64; const size_t cid = (size_t)((b * 4 + h) * 32 + c);
                const bf16* ptp = sb.PT + cid * 4096; const bf16* kwp = sb.KWT + cid * 8192; const bf16* vtp = sb.VT + cid * 8192;
                const float* tab = (const float*)(ptp + 512);
                bf16x8 Cb[4], Eb[4];
#pragma unroll
                for (int ks = 0; ks < 4; ++ks) { Cb[ks] = pack8(Cs[2 * ks], Cs[2 * ks + 1]); Eb[ks] = pack8(Ce[2 * ks], Ce[2 * ks + 1]); }
                const bf16x8 vf[2] = {*(const bf16x8*)(vtp + ((et * 2 + 0) * 64 + lane) * 8), *(const bf16x8*)(vtp + ((et * 2 + 1) * 64 + lane) * 8)};
#pragma unroll
                for (int it = 0; it < 4; ++it) {
                    const float bc = tab[16 * it + x], mi = tab[64 + 16 * it + x];
                    const float a = bc + mrun, mt = fmaxf(a, mi), f1 = __expf(a - mt) * 0.08838834764831845f, f2 = __expf(mi - mt);
                    f32x4 a1 = {0.f, 0.f, 0.f, 0.f}, aP = a1, e1 = a1, eP = a1;
                    const bf16* qrow = sb.X2 + (size_t)(m0 + 16 * it + x) * 2560 + 512 + h * 128 + 4 * q;
#pragma unroll
                    for (int ks = 0; ks < 4; ++ks) { const u32x2 aa = *(const u32x2*)(qrow + 32 * ks), bq = *(const u32x2*)(qrow + 32 * ks + 16); const u32x4 w = {aa.x, aa.y, bq.x, bq.y}; const bf16x8 qf = __builtin_bit_cast(bf16x8, w);
                        a1 = MFMA16(Cb[ks], qf, a1); if (wave == 0) e1 = MFMA16(Eb[ks], qf, e1); }
#pragma unroll
                    for (int kp = 0; kp < 2; ++kp) if (it >= 2 || kp == 0) { const bf16x8 pf = *(const bf16x8*)(ptp + ((it * 2 + kp) * 64 + lane) * 8); aP = MFMA16(vf[kp], pf, aP); if (wave == 0) eP = MFMA16(ones, pf, eP); }
                    const f32x4 nm = a1 * f1 + aP * f2;
                    *(u32x2*)(sb.X2 + (size_t)(m0 + 16 * it + x) * 2560 + 1024 + h * 128 + 16 * et + 4 * q) = (u32x2){pk2(nm.x, nm.y), pk2(nm.z, nm.w)};
                    if (wave == 0 && q == 0) sb.DEN[(size_t)(m0 + 16 * it + x) * 4 + h] = fmaxf(fabsf(e1.x * f1 + eP.x * f2), __expf(-mt));
                }
                const float blast = tab[63], wsmax = tab[127];
                const float mnew = fmaxf(blast + mrun, wsmax), sc = __expf(blast + mrun - mnew), s2 = __expf(wsmax - mnew); mrun = mnew;
#pragma unroll
                for (int dt = 0; dt < 8; ++dt) { f32x4 dC = {0.f, 0.f, 0.f, 0.f}, dE = dC;
#pragma unroll
                    for (int kp = 0; kp < 2; ++kp) { const bf16x8 kf = *(const bf16x8*)(kwp + ((dt * 2 + kp) * 64 + lane) * 8); dC = MFMA16(kf, vf[kp], dC); if (wave == 0) dE = MFMA16(kf, ones, dE); }
                    Cs[dt] = Cs[dt] * sc + dC * s2; if (wave == 0) Ce[dt] = Ce[dt] * sc + dE * s2; }
            }
        }
    }
}
__device__ __forceinline__ void post_phase(const ScanBufs sb, const float* norm_a, const float* norm_b, bf16* MIXED, int gw, int NGW, int lane) {
    const int hh = lane >> 3, sub = (lane & 7) * 16;
    for (int m = gw; m < M; m += NGW) {
        const bool isA = hh < 4; const int h = hh & 3;
        const bf16* src = isA ? sb.QKVA + (size_t)m * 1536 + 512 + h * 128 + sub : sb.X2 + (size_t)m * 2560 + 1024 + h * 128 + sub;
        const bf16* gsrc = sb.X2 + (size_t)m * 2560 + (isA ? 0 : 2048) + h * 128 + sub;
        const float* gn = (isA ? norm_a : norm_b + h * 128) + sub;
        const u32x4 r0 = *(const u32x4*)src, r1 = *(const u32x4*)(src + 8), z0 = *(const u32x4*)gsrc, z1 = *(const u32x4*)(gsrc + 8);
        float v[16] = {bf_lo(r0.x), bf_hi(r0.x), bf_lo(r0.y), bf_hi(r0.y), bf_lo(r0.z), bf_hi(r0.z), bf_lo(r0.w), bf_hi(r0.w), bf_lo(r1.x), bf_hi(r1.x), bf_lo(r1.y), bf_hi(r1.y), bf_lo(r1.z), bf_hi(r1.z), bf_lo(r1.w), bf_hi(r1.w)};
        const float z[16] = {bf_lo(z0.x), bf_hi(z0.x), bf_lo(z0.y), bf_hi(z0.y), bf_lo(z0.z), bf_hi(z0.z), bf_lo(z0.w), bf_hi(z0.w), bf_lo(z1.x), bf_hi(z1.x), bf_lo(z1.y), bf_hi(z1.y), bf_lo(z1.z), bf_hi(z1.z), bf_lo(z1.w), bf_hi(z1.w)};
        const float dinv = isA ? 1.f : 1.f / sb.DEN[(size_t)m * 4 + h];
        float ss = 0.f;
#pragma unroll
        for (int i = 0; i < 16; ++i) { v[i] *= dinv; ss += v[i] * v[i]; }
        ss += __shfl_xor(ss, 1); ss += __shfl_xor(ss, 2); ss += __shfl_xor(ss, 4);
        const float rstd = rsqrtf(ss * (1.f / 128.f) + EPS);
        float y[16];
#pragma unroll
        for (int i = 0; i < 16; ++i) { const float sg = sigmoid_f(z[i]); y[i] = v[i] * rstd * gn[i] * (isA ? z[i] * sg : sg); }
        u32x4* dst = (u32x4*)(MIXED + (size_t)m * 1024 + lane * 16);
        dst[0] = (u32x4){pk2(y[0], y[1]), pk2(y[2], y[3]), pk2(y[4], y[5]), pk2(y[6], y[7])}; dst[1] = (u32x4){pk2(y[8], y[9]), pk2(y[10], y[11]), pk2(y[12], y[13]), pk2(y[14], y[15])};
    }
}
__device__ __forceinline__ void attn_slow_phase(LAS unsigned char* lds, int tid, const bf16* QKV, const float* sinks, bf16* O, int G, int bid) {
    LAS unsigned* KL = (LAS unsigned*)lds; LAS unsigned* VL = KL + 256 * 33;
    const int g = tid >> 7, t = tid & 127;
    for (int u = bid; u < BATCH * 4 * 16; u += G) {
        const int b = u >> 6, kvh = (u >> 4) & 3, jb = u & 15;
#pragma unroll
        for (int i = 0; i < 4; ++i) { const int item = tid + 512 * i, r = item >> 3, ch = item & 7, sk = (jb - 1) * 128 + r;
            u32x4 kv = (u32x4){0u, 0u, 0u, 0u}, vv = kv;
            if (sk >= 0) { const bf16* src = QKV + (size_t)(b * SEQ + sk) * 1536 + 1024 + kvh * 64 + ch * 8; kv = *(const u32x4*)src; vv = *(const u32x4*)(src + 256); }
            LAS unsigned* kd = KL + r * 33 + ch * 4; LAS unsigned* vd = VL + r * 33 + ch * 4;
            kd[0] = kv.x; kd[1] = kv.y; kd[2] = kv.z; kd[3] = kv.w; vd[0] = vv.x; vd[1] = vv.y; vd[2] = vv.z; vd[3] = vv.w; }
        __syncthreads();
        const int hq = kvh * 4 + g; const size_t m = (size_t)b * SEQ + jb * 128 + t;
        float q[64], acc[64];
#pragma unroll
        for (int i = 0; i < 8; ++i) { const u32x4 w = *(const u32x4*)(QKV + m * 1536 + hq * 64 + i * 8);
            q[8 * i] = bf_lo(w.x); q[8 * i + 1] = bf_hi(w.x); q[8 * i + 2] = bf_lo(w.y); q[8 * i + 3] = bf_hi(w.y); q[8 * i + 4] = bf_lo(w.z); q[8 * i + 5] = bf_hi(w.z); q[8 * i + 6] = bf_lo(w.w); q[8 * i + 7] = bf_hi(w.w); }
#pragma unroll
        for (int d = 0; d < 64; ++d) acc[d] = 0.f;
        float mx = sinks[hq], l = 1.f;
#pragma unroll 1
        for (int jj = 0; jj < 128; ++jj) {
            const int r = t + 1 + jj;
            if ((jb - 1) * 128 + r >= 0) {
                const LAS unsigned* kr = KL + r * 33; const LAS unsigned* vr = VL + r * 33; float s = 0.f;
#pragma unroll
                for (int d = 0; d < 32; ++d) { const unsigned w = kr[d]; s += q[2 * d] * bf_lo(w) + q[2 * d + 1] * bf_hi(w); }
                if (s > mx) { const float sc = __expf(mx - s); l *= sc;
#pragma unroll
                    for (int d = 0; d < 64; ++d) acc[d] *= sc;
                    mx = s; }
                const float pp = __expf(s - mx); l += pp;
#pragma unroll
                for (int d = 0; d < 32; ++d) { const unsigned w = vr[d]; acc[2 * d] += pp * bf_lo(w); acc[2 * d + 1] += pp * bf_hi(w); }
            }
        }
        const float inv = 1.f / l;
#pragma unroll
        for (int i = 0; i < 8; ++i) *(u32x4*)(O + m * 1024 + hq * 64 + i * 8) = (u32x4){pk2(acc[8 * i] * inv, acc[8 * i + 1] * inv), pk2(acc[8 * i + 2] * inv, acc[8 * i + 3] * inv), pk2(acc[8 * i + 4] * inv, acc[8 * i + 5] * inv), pk2(acc[8 * i + 6] * inv, acc[8 * i + 7] * inv)};
        __syncthreads();
    }
}
#ifndef N_LAUNCH_MODE
#define N_LAUNCH_MODE 0
#endif
__global__ void __launch_bounds__(NTHR, 2) trunk_fwd(Args a_unused) {
    extern __shared__ __attribute__((aligned(16))) unsigned char lds_raw[];
    LAS unsigned char* lds = (LAS unsigned char*)lds_raw;
    volatile LAS unsigned* MISC = (volatile LAS unsigned*)(lds + MISC_OFF);
    if (threadIdx.x < 64) MISC[threadIdx.x] = 0u;
    __syncthreads();
    int lo, hi; XcdBarrier bar;
    { KArgs a = kargs(); lo = a->ph_lo; hi = a->ph_hi; unsigned* ctl = (unsigned*)(a->ws + WS_CTL);
      bar.bar = ctl + CW_BAR; bar.x = 0; bar.st = MISC + 8;
      if (hi - lo > 1) bar = xcd_barrier_post(ctl + CW_BAR, MISC + 8); }
#define IN(k) (lo <= (k) && (k) < hi)
#define SEAM(k) do { if (IN(k) && IN((k) + 1)) xcd_barrier(bar); } while (0)
#define ENV KArgs a = kargs(); const int tid = fresh_tid(), lane = tid & 63, wave = __builtin_amdgcn_readfirstlane(tid >> 6); const int G = gridDim.x, bid = blockIdx.x, gw = bid * NWAVES + wave, NGW = G * NWAVES, gtid = bid * NTHR + tid, NGT = G * NTHR; \
    unsigned char* ws = a->ws; bf16* RA = (bf16*)(ws + WS_RA); bf16* RB = (bf16*)(ws + WS_RB); bf16* RC = (bf16*)(ws + WS_RC); bf16* RD = (bf16*)(ws + WS_RD); float* Gt = (float*)(ws + WS_GT); \
    (void)lane; (void)wave; (void)gw; (void)NGW; (void)gtid; (void)NGT; (void)RA; (void)RB; (void)RC; (void)RD; (void)Gt; (void)G; (void)bid

    if (IN(0)) { ENV; prologue_phase(a, lds, gw, NGW, wave, lane, gtid, NGT); }
    SEAM(0);
#define SCANBUFS ScanBufs sb; sb.QKVA = (bf16*)(ws + WS_QKVA); sb.X2 = (bf16*)(ws + WS_X2); sb.Gt = Gt; sb.KT = (bf16*)(ws + WS_KT); sb.UT = (bf16*)(ws + WS_UT); sb.NW = (bf16*)(ws + WS_NW); sb.ATT = (bf16*)(ws + WS_ATT); \
    sb.KWT = (bf16*)(ws + WS_KWT); sb.VT = (bf16*)(ws + WS_VT); sb.PT = (bf16*)(ws + WS_PT); sb.DEN = (float*)(ws + WS_DEN)
#pragma unroll 1
    for (int L = 0; L < DEPTH; ++L) {
        const int pb = 1 + L * PH_PER_LAYER; const bool even = (L & 1) == 0; const int e = L >> 1;
        if (IN(pb + 0)) { ENV; const float* hin = (L == 0) ? a->x : a->out;
            norm_phase(lds, hin, a->gains + (size_t)L * 4 * DM, RA, even, (const float*)(ws + WS_WGATES) + (size_t)e * 16 * 1024, Gt, gw, NGW, tid, lane); }
        SEAM(pb + 0);
        if (IN(pb + 1)) { ENV;
            const int N = even ? 4096 : 1536;
            pg8::Gemm g{RA, even ? (const bf16*)(ws + WS_WIN) + (size_t)e * 4096 * 1024 : (const bf16*)(ws + WS_WQKV) + (size_t)e * 1536 * 1024, M, N, DM};
            pg8::StaticOrder S; S.init(M, N, G, bid);
            pg8::EpiBf16<0> E{RC, 1536, even ? nullptr : a->b_qkv + (size_t)e * 1536, (bf16*)(ws + WS_X2), 1536, 2560};
            pg8::gemm_phase<pg8::EpiBf16<0>, pg8::StaticOrder, true, true>(lds, g, S, E);
        }
        SEAM(pb + 1);
        if (IN(pb + 2)) { ENV; if (even) conv_phase((const bf16*)(ws + WS_X1), a->conv + (size_t)e * 4 * 1536, (bf16*)(ws + WS_QKVA), gw, NGW, lane); else rope_phase(RC, (const f32x2*)(ws + WS_ROPE), gw, NGW, lane); }
        SEAM(pb + 2);
        if (even) {
            if (IN(pb + 3)) { ENV; SCANBUFS; local_phase(lds, sb, a->a_log + e * 4, a->dt_bias + e * 4, a->i_bias + e * 4, a->f_bias + e * 4, gw, NGW, wave, lane); }
            SEAM(pb + 3);
        }
        if (IN(pb + 4)) { ENV;
            if (even) { SCANBUFS; recur_phase(sb, G, bid, wave, lane); }
            else attn_slow_phase(lds, tid, RC, a->sinks + e * 16, RD, G, bid);
        }
        SEAM(pb + 4);
        if (even) {
            if (IN(pb + 5)) { ENV; SCANBUFS; post_phase(sb, a->norm_a + e * 128, a->norm_b + e * 512, (bf16*)(ws + WS_MIXED), gw, NGW, lane); }
            SEAM(pb + 5);
        }
        if (IN(pb + 6)) { ENV;
            pg8::Gemm g{even ? (const bf16*)(ws + WS_MIXED) : (const bf16*)RD, even ? (const bf16*)(ws + WS_WOUT) + (size_t)e * DM * DM : (const bf16*)(ws + WS_WO) + (size_t)e * DM * DM, M, DM, DM};
            pg8::StaticOrder S; S.init(M, DM, G, bid);
            pg8::EpiF32 E{(float*)RA, DM, even ? nullptr : a->b_o + (size_t)e * DM};
            pg8::gemm_phase<pg8::EpiF32, pg8::StaticOrder, true, true>(lds, g, S, E);
        }
        SEAM(pb + 6);
        if (IN(pb + 7)) { ENV; const float* hin = (L == 0) ? a->x : a->out; const float* gains = a->gains + (size_t)L * 4 * DM;
            resid_a_phase((const float*)RA, hin, a->out, gains + DM, gains + 2 * DM, RD, gw, NGW, lane); }
        SEAM(pb + 7);
        if (IN(pb + 8)) { ENV;
            pg8::Gemm g{RD, (const bf16*)(ws + WS_WUP) + (size_t)L * FF * DM, M, FF, DM};
            pg8::StaticOrder S; S.init(M, FF, G, bid);
            pg8::EpiBf16<1> E{RC, FF, nullptr, RC, 1 << 30, FF};
            pg8::gemm_phase<pg8::EpiBf16<1>, pg8::StaticOrder, true, true>(lds, g, S, E);
        }
        SEAM(pb + 8);
        if (IN(pb + 9)) { ENV;
            pg8::Gemm g{RC, (const bf16*)(ws + WS_WDN) + (size_t)L * DM * FF, M, DM, FF};
            pg8::StaticOrder S; S.init(M, DM, G, bid);
            pg8::EpiF32 E{(float*)RA, DM, nullptr};
            pg8::gemm_phase<pg8::EpiF32, pg8::StaticOrder, true, true>(lds, g, S, E);
        }
        SEAM(pb + 9);
        if (IN(pb + 10)) { ENV; resid_b_phase((const float*)RA, a->out, a->gains + (size_t)L * 4 * DM + 3 * DM, RD, a->p + (size_t)L * M * PLE, RC, gw, NGW, lane, gtid, NGT); }
        SEAM(pb + 10);
        if (IN(pb + 11)) { ENV;
            pg8::Gemm g{RC, (const bf16*)(ws + WS_WPLE) + (size_t)L * DM * PLE, M, DM, PLE};
            pg8::StaticOrder S; S.init(M, DM, G, bid);
            pg8::EpiBf16<0> E{RB, DM, nullptr, RB, 1 << 30, DM};
            pg8::gemm_phase<pg8::EpiBf16<0>, pg8::StaticOrder, true, true>(lds, g, S, E);
        }
        SEAM(pb + 11);
        if (IN(pb + 12)) { ENV;
            pg8::Gemm g{RD, (const bf16*)(ws + WS_WG) + (size_t)L * DM * DM, M, DM, DM};
            pg8::StaticOrder S; S.init(M, DM, G, bid);
            pg8::EpiGate E{a->out, RB, DM};
            pg8::gemm_phase<pg8::EpiGate, pg8::StaticOrder, true, true>(lds, g, S, E);
        }
        SEAM(pb + 12);
    }
#undef SCANBUFS
#undef IN
#undef SEAM
#undef ENV
}

extern "C" void kernel_launch(void* const* d_in, const int* in_sizes, int n_in, void* d_out, int out_size, void* d_ws, size_t ws_size, hipStream_t stream) {
    static int grid = 0;
    if (grid == 0) {
        if (n_in != 22 || in_sizes[0] != M * DM || out_size != M * DM || ws_size < WS_END) {
            fprintf(stderr, "kernel_launch: unexpected shapes (n_in %d, in0 %d, out %d, ws %zu; need ws >= %zu); nothing launched\n", n_in, n_in > 0 ? in_sizes[0] : -1, out_size, ws_size, (size_t)WS_END); grid = -1; return; }
        int dev = 0, cus = 0, per_cu = 0;
        if (hipGetDevice(&dev) != hipSuccess || hipDeviceGetAttribute(&cus, hipDeviceAttributeMultiprocessorCount, dev) != hipSuccess) { fprintf(stderr, "kernel_launch: device query failed\n"); grid = -1; return; }
        if (hipFuncSetAttribute((const void*)trunk_fwd, hipFuncAttributeMaxDynamicSharedMemorySize, LDS_BYTES) != hipSuccess) { fprintf(stderr, "kernel_launch: hipFuncSetAttribute failed\n"); grid = -1; return; }
        if (hipOccupancyMaxActiveBlocksPerMultiprocessor(&per_cu, (const void*)trunk_fwd, NTHR, LDS_BYTES) != hipSuccess || per_cu < 1) fprintf(stderr, "kernel_launch: note: occupancy query reports %d\n", per_cu);
        (void)hipGetLastError();
        grid = cus;
    }
    if (grid < 0) return;
    Args a{};
    a.x = (const float*)d_in[0]; a.p = (const float*)d_in[1]; a.pos = (const int*)d_in[2]; a.gains = (const float*)d_in[3]; a.w_in = (const float*)d_in[4]; a.conv = (const float*)d_in[5];
    a.a_log = (const float*)d_in[6]; a.dt_bias = (const float*)d_in[7]; a.norm_a = (const float*)d_in[8]; a.i_bias = (const float*)d_in[9]; a.f_bias = (const float*)d_in[10]; a.norm_b = (const float*)d_in[11];
    a.b_qkv = (const float*)d_in[14]; a.sinks = (const float*)d_in[15]; a.b_o = (const float*)d_in[17];
    a.out = (float*)d_out; a.ws = (unsigned char*)d_ws;
    a.w_out = (const float*)d_in[12]; a.w_qkv = (const float*)d_in[13]; a.w_o = (const float*)d_in[16]; a.w_up = (const float*)d_in[18]; a.w_down = (const float*)d_in[19]; a.w_ple = (const float*)d_in[20]; a.w_gate = (const float*)d_in[21];
#if N_LAUNCH_MODE == 0
    if (hipMemsetAsync((char*)d_ws + WS_CTL, 0, CTL_ZERO_BYTES, stream) != hipSuccess) { fprintf(stderr, "kernel_launch: memset failed\n"); return; }
    a.ph_lo = 0; a.ph_hi = NPHASE;
    hipLaunchKernelGGL(trunk_fwd, dim3(grid), dim3(NTHR), LDS_BYTES, stream, a);
#else
    for (int ph = 0; ph < NPHASE; ++ph) { a.ph_lo = ph; a.ph_hi = ph + 1; hipLaunchKernelGGL(trunk_fwd, dim3(grid), dim3(NTHR), LDS_BYTES, stream, a); }
#endif
    const hipError_t le = hipPeekAtLastError();
    if (le != hipSuccess) fprintf(stderr, "kernel_launch: launch failed: %s\n", hipGetErrorName(le));
}
```

```cpp
#include <hip/hip_runtime.h>
#include <cstdio>
#include <cstdint>
#define N_LAUNCH_MODE 0
namespace pg8 {
#define PG8_LAS __attribute__((address_space(3)))
typedef unsigned short bf16_t;
typedef short bf16x8 __attribute__((ext_vector_type(8)));
typedef float f32x4 __attribute__((ext_vector_type(4)));
typedef unsigned u32x4 __attribute__((ext_vector_type(4)));
constexpr int BM = 256, BK = 64, HALF = 128, HTB = HALF * BK * 2  , STAGE_BYTES = 8 * HTB, NXCD = 8, WGM = 8;

__host__ __device__ __forceinline__ int lds_byte(int r, int c) { const int st = (r >> 4) * 2 + (c >> 5), rr = r & 15, cc = c & 31, ob = rr * 64 + cc * 2; return st * 1024 + (ob ^ (((ob >> 9) & 1) << 5)); }
__host__ __device__ __forceinline__ void stage_rc(int b, int& R, int& C) { const int st = b / 1024, sb = b % 1024, swz = sb ^ (((sb >> 9) & 1) << 5); R = (st >> 1) * 16 + swz / 64; C = (st & 1) * 32 + (swz % 64) / 2; }
__host__ __device__ __forceinline__ int perm32(int rho) { const int n = rho >> 4, i = rho & 15; return 8 * (i >> 2) + 4 * n + (i & 3); }

struct Unit { int pm, pn; };
struct Gemm { const bf16_t* A; const bf16_t* Bt; int M, N, K; };

struct StaticOrder {
    int nM, nN, nwg, G, c;
    __host__ __device__ void init(int M, int N, int G_, int c_) { nM = M / BM; nN = N / BM; nwg = nM * nN; G = G_; c = c_; }
    __host__ __device__ bool next(int i, Unit& u) const {
        const long L = (long)i * G + c; if (L >= nwg) return false;
        int wgid = (int)L; { const int q = nwg / NXCD, r = nwg % NXCD, xcd = wgid % NXCD, off = wgid / NXCD; wgid = (xcd < r ? xcd * (q + 1) : r * (q + 1) + (xcd - r) * q) + off; }
        const int nig = WGM * nN, gid = wgid / nig, fm = gid * WGM, gsz = (nM - fm) < WGM ? (nM - fm) : WGM;
        u.pm = fm + ((wgid % nig) % gsz); u.pn = (wgid % nig) / gsz; return true;
    }
    __device__ __forceinline__ void a_ready(const Unit&) const {}
    __device__ __forceinline__ void done(const Unit&) const {}
};

__device__ __forceinline__ unsigned cvt_pk_bf16(float lo, float hi) { unsigned r; asm volatile("v_cvt_pk_bf16_f32 %0, %1, %2" : "=v"(r) : "v"(lo), "v"(hi)); return r; }
typedef float f32x2 __attribute__((ext_vector_type(2)));
typedef unsigned u32x2 __attribute__((ext_vector_type(2)));

template <int ACT  > struct EpiBf16 {
    static constexpr bool PERM = true, AFTER_DRAIN = false;
    bf16_t* O; int ldc; const float* bias; bf16_t* O2; int split_col, ldc2;
    __device__ __forceinline__ void operator()(const f32x4 (&acc)[2][2][4][2], const Unit& u, int wr, int wc, int fr, int fq) const {
        const int row0 = u.pm * BM + wr * 64 + fr; const int col0 = u.pn * BM + wc * 32 + 8 * fq;
        const bool second = u.pn * BM >= split_col; bf16_t* const ob = second ? O2 : O; const int ld = second ? ldc2 : ldc, oc0 = second ? col0 - split_col : col0;
        f32x4 bv[2][2];
#pragma unroll
        for (int bj = 0; bj < 2; ++bj)
#pragma unroll
            for (int n = 0; n < 2; ++n) bv[bj][n] = bias ? *(const f32x4*)(bias + col0 + bj * HALF + 4 * n) : (f32x4){0.f, 0.f, 0.f, 0.f};
#pragma unroll
        for (int ai = 0; ai < 2; ++ai)
#pragma unroll
            for (int m = 0; m < 4; ++m) { bf16_t* rowp = ob + (size_t)(row0 + ai * HALF + m * 16) * ld + oc0;
#pragma unroll
                for (int bj = 0; bj < 2; ++bj) { f32x4 v0 = acc[ai][bj][m][0] + bv[bj][0], v1 = acc[ai][bj][m][1] + bv[bj][1];
                    if (ACT == 1) {
#pragma unroll
                        for (int i = 0; i < 4; ++i) { const float a = fmaxf(v0[i], 0.f), b = fmaxf(v1[i], 0.f); v0[i] = a * a; v1[i] = b * b; } }
                    u32x4 w; w.x = cvt_pk_bf16(v0[0], v0[1]); w.y = cvt_pk_bf16(v0[2], v0[3]); w.z = cvt_pk_bf16(v1[0], v1[1]); w.w = cvt_pk_bf16(v1[2], v1[3]);
                    *(u32x4*)(rowp + bj * HALF) = w; } }
    }
};
struct EpiF32 {
    static constexpr bool PERM = false, AFTER_DRAIN = false;
    float* C; int ldc; const float* bias;
    __device__ __forceinline__ void operator()(const f32x4 (&acc)[2][2][4][2], const Unit& u, int wr, int wc, int fr, int fq) const {
        const int row0 = u.pm * BM + wr * 64 + fr, col0 = u.pn * BM + wc * 32 + 4 * fq;
        f32x4 bv[2][2];
#pragma unroll
        for (int bj = 0; bj < 2; ++bj)
#pragma unroll
            for (int n = 0; n < 2; ++n) bv[bj][n] = bias ? *(const f32x4*)(bias + col0 + bj * HALF + n * 16) : (f32x4){0.f, 0.f, 0.f, 0.f};
#pragma unroll
        for (int ai = 0; ai < 2; ++ai)
#pragma unroll
            for (int m = 0; m < 4; ++m) { float* rowp = C + (size_t)(row0 + ai * HALF + m * 16) * ldc + col0;
#pragma unroll
                for (int bj = 0; bj < 2; ++bj)
#pragma unroll
                    for (int n = 0; n < 2; ++n) *(f32x4*)(rowp + bj * HALF + n * 16) = acc[ai][bj][m][n] + bv[bj][n]; }
    }
};
__device__ __forceinline__ float bf_lo(unsigned w) { return __builtin_bit_cast(float, w << 16); }
__device__ __forceinline__ float bf_hi(unsigned w) { return __builtin_bit_cast(float, w & 0xffff0000u); }
struct EpiGate {
    static constexpr bool PERM = false, AFTER_DRAIN = false;
    float* H; const bf16_t* PP; int ldc;
    __device__ __forceinline__ void operator()(const f32x4 (&acc)[2][2][4][2], const Unit& u, int wr, int wc, int fr, int fq) const {
        const int row0 = u.pm * BM + wr * 64 + fr, col0 = u.pn * BM + wc * 32 + 4 * fq;
#pragma unroll
        for (int ai = 0; ai < 2; ++ai)
#pragma unroll
            for (int m = 0; m < 4; ++m) { const size_t ro = (size_t)(row0 + ai * HALF + m * 16) * ldc + col0;
#pragma unroll
                for (int bj = 0; bj < 2; ++bj)
#pragma unroll
                    for (int n = 0; n < 2; ++n) { const size_t off = ro + bj * HALF + n * 16;
                        f32x4 hv = *(const f32x4*)(H + off); const u32x2 pv = *(const u32x2*)(PP + off); const f32x4 a = acc[ai][bj][m][n];
                        const float p0 = bf_lo(pv.x), p1 = bf_hi(pv.x), p2 = bf_lo(pv.y), p3 = bf_hi(pv.y);
                        hv[0] += p0 / (1.f + __expf(-a[0])); hv[1] += p1 / (1.f + __expf(-a[1])); hv[2] += p2 / (1.f + __expf(-a[2])); hv[3] += p3 / (1.f + __expf(-a[3]));
                        *(f32x4*)(H + off) = hv; } }
    }
};

template <class Epi, class Sched, bool ALIGN_EPI = false, bool SP2 = false>
__device__ __forceinline__ void gemm_phase(PG8_LAS unsigned char* lds, const Gemm g, const Sched& S, const Epi& E) {
    int tid_l = threadIdx.x; asm volatile("" : "+v"(tid_l));
    const int tid = tid_l, wid = __builtin_amdgcn_readfirstlane(tid >> 6), lane = tid & 63, wr = wid >> 2, wc = wid & 3, fr = lane & 15, fq = lane >> 4;
    const int K = g.K, nt = K / BK;
    unsigned voffA[2], voffB[2];
#pragma unroll
    for (int i = 0; i < 2; ++i) { int R, C; stage_rc(tid * 16 + i * 8192, R, C); const int Rb = Epi::PERM ? ((R & ~31) + perm32(R & 31)) : R;
        voffA[i] = (unsigned)(R * K + C) * 2u; voffB[i] = (unsigned)(Rb * K + C) * 2u; }
    const size_t kstep = (size_t)(BK * 2);
    const size_t hstep = (size_t)HALF * K * 2;
    const size_t tstep = 2 * hstep;
    const unsigned ldsw = (unsigned)wid * 1024u;
    const int aoff = lds_byte(wr * 64 + fr, fq * 8), boff = lds_byte(wc * 32 + fr, fq * 8);
#define PG8_SA(b, h) (((b) * 2 + (h)) * HTB)
#define PG8_SB(b, h) ((4 + (b) * 2 + (h)) * HTB)
#define PG8_STAGE(bufoff, gbase, voff) do { _Pragma("unroll") for (int _i = 0; _i < 2; ++_i) \
        __builtin_amdgcn_global_load_lds((const unsigned*)((const char*)(gbase) + (voff)[_i]), (PG8_LAS unsigned*)(lds + (bufoff) + ldsw + _i * 8192), 16, 0, 0); } while (0)
#define PG8_LDA(dst, b, h) do { _Pragma("unroll") for (int m = 0; m < 4; ++m) _Pragma("unroll") for (int k = 0; k < 2; ++k) dst[m][k] = *(const PG8_LAS bf16x8*)(lds + PG8_SA(b, h) + aoff + m * 2048 + k * 1024); } while (0)
#define PG8_LDB(dst, b, h) do { _Pragma("unroll") for (int n = 0; n < 2; ++n) _Pragma("unroll") for (int k = 0; k < 2; ++k) dst[n][k] = *(const PG8_LAS bf16x8*)(lds + PG8_SB(b, h) + boff + n * 2048 + k * 1024); } while (0)
#define PG8_MMA(ai, bj, At, Bt) do { __builtin_amdgcn_s_setprio(1); _Pragma("unroll") for (int m = 0; m < 4; ++m) _Pragma("unroll") for (int n = 0; n < 2; ++n) _Pragma("unroll") for (int k = 0; k < 2; ++k) \
        acc[ai][bj][m][n] = __builtin_amdgcn_mfma_f32_16x16x32_bf16(Bt[n][k], At[m][k], acc[ai][bj][m][n], 0, 0, 0); __builtin_amdgcn_s_setprio(0); } while (0)
#define PG8_WAIT_V(n) asm volatile("s_waitcnt vmcnt(" #n ")" ::: "memory")
#define PG8_WAIT_L(n) asm volatile("s_waitcnt lgkmcnt(" #n ")" ::: "memory")
#define PG8_BAR __builtin_amdgcn_s_barrier()
#define PG8_SCHED __builtin_amdgcn_sched_barrier(0)
    Unit cur, nxt; int ui = 0;
    if (!S.next(0, cur)) return;
    f32x4 acc[2][2][4][2];
#pragma unroll
    for (int a = 0; a < 2; ++a)
#pragma unroll
        for (int b = 0; b < 2; ++b)
#pragma unroll
            for (int m = 0; m < 4; ++m)
#pragma unroll
                for (int n = 0; n < 2; ++n) acc[a][b][m][n] = (f32x4){0.f, 0.f, 0.f, 0.f};
    bf16x8 At[4][2], B0[2][2], B1[2][2];
    const char* cA = (const char*)g.A + (size_t)cur.pm * tstep; const char* cB = (const char*)g.Bt + (size_t)cur.pn * tstep;
    S.a_ready(cur);
    if constexpr (SP2) {
        PG8_STAGE(PG8_SB(0, 0), cB, voffB); PG8_STAGE(PG8_SB(0, 1), cB + hstep, voffB); PG8_STAGE(PG8_SA(0, 0), cA, voffA); PG8_STAGE(PG8_SA(0, 1), cA + hstep, voffA);
        if (wr == 1) PG8_BAR;
        PG8_WAIT_V(2); PG8_BAR;
        PG8_STAGE(PG8_SB(1, 0), cB + kstep, voffB); PG8_STAGE(PG8_SA(1, 0), cA + kstep, voffA); PG8_STAGE(PG8_SB(1, 1), cB + hstep + kstep, voffB);
        PG8_WAIT_V(6); PG8_BAR;
    } else {
        PG8_STAGE(PG8_SB(0, 0), cB, voffB); PG8_STAGE(PG8_SA(0, 0), cA, voffA); PG8_STAGE(PG8_SB(0, 1), cB + hstep, voffB); PG8_STAGE(PG8_SA(0, 1), cA + hstep, voffA);
        if (wr == 1) PG8_BAR;
        PG8_WAIT_V(4); PG8_BAR;
        PG8_STAGE(PG8_SB(1, 0), cB + kstep, voffB); PG8_STAGE(PG8_SA(1, 0), cA + kstep, voffA); PG8_STAGE(PG8_SB(1, 1), cB + hstep + kstep, voffB);
        PG8_WAIT_V(6); PG8_BAR;
    }
    for (;;) {
        const bool has_next = S.next(ui + 1, nxt);
        const char* nA = has_next ? (const char*)g.A + (size_t)nxt.pm * tstep : cA; const char* nB = has_next ? (const char*)g.Bt + (size_t)nxt.pn * tstep : cB;
        for (int t = 0; t < nt; t += 2) {
            const bool last = (t == nt - 2);
            const char* a1 = cA + (size_t)(t + 1) * kstep;
            const char* a2 = last ? nA : cA + (size_t)(t + 2) * kstep; const char* b2 = last ? nB : cB + (size_t)(t + 2) * kstep;
            const char* a3 = a2 + kstep; const char* b3 = b2 + kstep;
            if (last && has_next) S.a_ready(nxt);
            if constexpr (SP2) {
            PG8_LDB(B0, 0, 0); PG8_LDB(B1, 0, 1); PG8_SCHED; PG8_LDA(At, 0, 0); PG8_STAGE(PG8_SA(1, 1), a1 + hstep, voffA);
            PG8_WAIT_V(8); PG8_WAIT_L(0); PG8_BAR; PG8_MMA(0, 0, At, B0); PG8_MMA(0, 1, At, B1); PG8_BAR; PG8_SCHED;
            PG8_LDA(At, 0, 1); PG8_STAGE(PG8_SB(0, 0), b2, voffB); PG8_STAGE(PG8_SB(0, 1), b2 + hstep, voffB); PG8_STAGE(PG8_SA(0, 0), a2, voffA);
            PG8_WAIT_V(8); PG8_WAIT_L(0); PG8_BAR; PG8_MMA(1, 0, At, B0); PG8_MMA(1, 1, At, B1); PG8_BAR; PG8_SCHED;
            PG8_LDB(B0, 1, 0); PG8_LDB(B1, 1, 1); PG8_SCHED; PG8_LDA(At, 1, 0); PG8_STAGE(PG8_SA(0, 1), a2 + hstep, voffA);
            PG8_WAIT_V(8); PG8_WAIT_L(0); PG8_BAR; PG8_MMA(0, 0, At, B0); PG8_MMA(0, 1, At, B1); PG8_BAR; PG8_SCHED;
            PG8_LDA(At, 1, 1); PG8_STAGE(PG8_SB(1, 0), b3, voffB); PG8_STAGE(PG8_SB(1, 1), b3 + hstep, voffB); PG8_STAGE(PG8_SA(1, 0), a3, voffA);
            PG8_WAIT_V(8); PG8_WAIT_L(0); PG8_BAR; PG8_MMA(1, 0, At, B0); PG8_MMA(1, 1, At, B1); PG8_BAR; PG8_SCHED;
            } else {
            PG8_LDB(B0, 0, 0); PG8_SCHED; PG8_LDA(At, 0, 0); PG8_STAGE(PG8_SA(1, 1), a1 + hstep, voffA);
            PG8_WAIT_L(8); PG8_BAR; PG8_WAIT_L(0); PG8_MMA(0, 0, At, B0); PG8_BAR; PG8_SCHED;
            PG8_LDB(B1, 0, 1); PG8_STAGE(PG8_SB(0, 0), b2, voffB);
            PG8_BAR; PG8_WAIT_L(0); PG8_MMA(0, 1, At, B1); PG8_BAR;
            PG8_LDA(At, 0, 1); PG8_STAGE(PG8_SA(0, 0), a2, voffA);
            PG8_BAR; PG8_WAIT_L(0); PG8_MMA(1, 0, At, B0); PG8_BAR; PG8_SCHED;
            PG8_STAGE(PG8_SB(0, 1), b2 + hstep, voffB);
            PG8_WAIT_V(6); PG8_BAR; PG8_MMA(1, 1, At, B1); PG8_BAR;
            PG8_LDB(B0, 1, 0); PG8_SCHED; PG8_LDA(At, 1, 0); PG8_STAGE(PG8_SA(0, 1), a2 + hstep, voffA);
            PG8_WAIT_L(8); PG8_BAR; PG8_WAIT_L(0); PG8_MMA(0, 0, At, B0); PG8_BAR; PG8_SCHED;
            PG8_LDB(B1, 1, 1); PG8_STAGE(PG8_SB(1, 0), b3, voffB);
            PG8_BAR; PG8_WAIT_L(0); PG8_MMA(0, 1, At, B1); PG8_BAR;
            PG8_LDA(At, 1, 1); PG8_STAGE(PG8_SA(1, 0), a3, voffA);
            PG8_BAR; PG8_WAIT_L(0); PG8_MMA(1, 0, At, B0); PG8_BAR; PG8_SCHED;
            PG8_STAGE(PG8_SB(1, 1), b3 + hstep, voffB);
            PG8_WAIT_V(6); PG8_BAR; PG8_MMA(1, 1, At, B1); PG8_BAR;
            }
        }
        if constexpr (ALIGN_EPI) { if (wr == 0) PG8_BAR; }
        if constexpr (!Epi::AFTER_DRAIN) { E(acc, cur, wr, wc, fr, fq); S.done(cur); }
        if (!has_next) break;
#pragma unroll
        for (int a = 0; a < 2; ++a)
#pragma unroll
            for (int b = 0; b < 2; ++b)
#pragma unroll
                for (int m = 0; m < 4; ++m)
#pragma unroll
                    for (int n = 0; n < 2; ++n) acc[a][b][m][n] = (f32x4){0.f, 0.f, 0.f, 0.f};
        cur = nxt; cA = nA; cB = nB; ++ui;
        if constexpr (ALIGN_EPI) { if (wr == 1) PG8_BAR; }
    }
    PG8_WAIT_V(0);
    if constexpr (!ALIGN_EPI) { if (wr == 0) PG8_BAR; }
    PG8_BAR;
    if constexpr (Epi::AFTER_DRAIN) { E.fused(acc, cur, wr, wc, fr, fq, lds, wid, lane); S.done(cur); }
#undef PG8_SA
#undef PG8_SB
#undef PG8_STAGE
#undef PG8_LDA
#undef PG8_LDB
#undef PG8_MMA
#undef PG8_WAIT_V
#undef PG8_WAIT_L
#undef PG8_BAR
#undef PG8_SCHED
}
}
constexpr int BATCH = 32, SEQ = 2048, DM = 1024, DEPTH = 4, M = BATCH * SEQ;
constexpr int FF = 4096, PLE = 256, NIN = 4112;
constexpr float EPS = 1e-6f;
constexpr int NWAVES = 8, NTHR = NWAVES * 64;
constexpr int PH_PER_LAYER = 13, NPHASE = 1 + DEPTH * PH_PER_LAYER;
constexpr size_t MiB = 1u << 20;
constexpr size_t WS_CTL = 0, CTL_ZERO_BYTES = 1 * MiB;
constexpr size_t WS_WIN = 1 * MiB, WS_WOUT = 17 * MiB, WS_WQKV = 21 * MiB, WS_WO = 27 * MiB, WS_WUP = 31 * MiB, WS_WDN = 63 * MiB, WS_WPLE = 95 * MiB, WS_WG = 97 * MiB;
constexpr size_t WS_WGATES = 105 * MiB, WS_GT = 106 * MiB, WS_ROPE = 110 * MiB;
constexpr size_t WS_DEN = 126 * MiB;
constexpr size_t WS_RA = 128 * MiB, WS_RB = 256 * MiB, WS_RC = 384 * MiB, WS_RD = 896 * MiB, WS_END = 1024 * MiB;
constexpr size_t WS_QKVA = 128 * MiB, WS_KWT = 320 * MiB, WS_X1 = 384 * MiB, WS_KT = 384 * MiB, WS_UT = 448 * MiB, WS_NW = 512 * MiB, WS_X2 = 576 * MiB, WS_VT = 896 * MiB, WS_ATT = 960 * MiB, WS_PT = 992 * MiB, WS_MIXED = 384 * MiB;
constexpr int CW_BAR = 4096;
constexpr int RING_BYTES = 131072, MISC_OFF = RING_BYTES, LDS_BYTES = RING_BYTES + 1024;

#define GAS __attribute__((address_space(1)))
#define LAS __attribute__((address_space(3)))
typedef unsigned short bf16;
typedef float f32x4 __attribute__((ext_vector_type(4)));
typedef float f32x2 __attribute__((ext_vector_type(2)));
typedef unsigned u32x4 __attribute__((ext_vector_type(4)));
typedef unsigned u32x2 __attribute__((ext_vector_type(2)));
#define LDS_WAIT() asm volatile("s_waitcnt lgkmcnt(0)" ::: "memory")
#define VM_WAIT() asm volatile("s_waitcnt vmcnt(0)" ::: "memory")
using pg8::bf_lo; using pg8::bf_hi;
typedef __bf16 bf16x2_t __attribute__((ext_vector_type(2)));
__device__ __forceinline__ unsigned pk2(float lo, float hi) { return pg8::cvt_pk_bf16(lo, hi); }
__device__ __forceinline__ unsigned pk2v(float lo, float hi) { const f32x2 v = {lo, hi}; const bf16x2_t b = __builtin_convertvector(v, bf16x2_t); return __builtin_bit_cast(unsigned, b); }
__device__ __forceinline__ float wave_sum(float v) {
#pragma unroll
    for (int o = 1; o < 64; o <<= 1) v += __shfl_xor(v, o);
    return v;
}
__device__ __forceinline__ float dot4(f32x4 a, f32x4 b) { return (a.x * b.x + a.y * b.y) + (a.z * b.z + a.w * b.w); }
__device__ __forceinline__ float sigmoid_f(float x) { return 1.f / (1.f + __expf(-x)); }
__device__ __forceinline__ float softplus_f(float x) { return x > 20.f ? x : log1pf(expf(x)); }

#define XB_TMO      128
#define XB_XCNT(j)  (256  + 64 * (j))
#define XB_XSUB(j)  (1280 + 64 * (j))
#define XB_XGEN(j)  (2304 + 64 * (j))
#define XB_TOP      3328
#define XB_TOPGEN   3392
#define XCD_BAR_WORDS 3456
#define XB_SPIN_CAP (1u << 18)

__device__ __forceinline__ unsigned xb_ld(unsigned* p)              { return __hip_atomic_load(p, __ATOMIC_RELAXED, __HIP_MEMORY_SCOPE_AGENT); }
__device__ __forceinline__ unsigned xb_add(unsigned* p, unsigned v) { return __hip_atomic_fetch_add(p, v, __ATOMIC_RELAXED, __HIP_MEMORY_SCOPE_AGENT); }
__device__ __forceinline__ unsigned xb_xcc_id() { return (unsigned)__builtin_amdgcn_s_getreg((3 << 11) | 20) & 0xFu; }
#define XB_SPIN(cond, bar) do { unsigned _sp = 0; while (cond) { __builtin_amdgcn_s_sleep(1); \
    if ((++_sp & 255u) == 0u) { if (xb_ld(&(bar)[XB_TMO])) break; if (_sp > XB_SPIN_CAP) { atomicAdd(&(bar)[XB_TMO], 1u); break; } } } } while (0)

struct XcdBarrier {
    unsigned* bar; unsigned x;
    volatile LAS unsigned* st;
};

__device__ __forceinline__ XcdBarrier xcd_barrier_post(unsigned* bar, volatile LAS unsigned* st) {
    XcdBarrier b; b.bar = bar; b.x = xb_xcc_id(); b.st = st;
    if (threadIdx.x == 0) (void)xb_add(&bar[XB_XCNT(b.x)], 1u);
    return b;
}
__device__ __forceinline__ void xcd_barrier_complete(unsigned* bar, unsigned x, unsigned& nloc, unsigned& nx) {
    const unsigned G = gridDim.x * gridDim.y * gridDim.z;
    unsigned sum, cnt, mine, sp = 0u;
    for (;;) {
        sum = 0u; cnt = 0u; mine = 0u;
#pragma unroll
        for (unsigned j = 0; j < 16; ++j) { const unsigned c = xb_ld(&bar[XB_XCNT(j)]); sum += c; cnt += (c > 0u) ? 1u : 0u; mine = (j == x) ? c : mine; }
        if (sum == G) break;
        __builtin_amdgcn_s_sleep(1);
        if ((++sp & 255u) == 0u) { if (xb_ld(&bar[XB_TMO])) break; if (sp > XB_SPIN_CAP) { atomicAdd(&bar[XB_TMO], 1u); break; } }
    }
    nloc = mine > 0u ? mine : 1u; nx = cnt > 0u ? cnt : 1u;
}

__device__ __forceinline__ void xcd_barrier(const XcdBarrier& b) {
    asm volatile("s_waitcnt vmcnt(0)" ::: "memory");
    __syncthreads();
    if (threadIdx.x == 0) {
        unsigned* bar = b.bar;
        __builtin_amdgcn_s_waitcnt(0);
        unsigned nloc = b.st[0], nx = b.st[1];
        if (nloc == 0u) { xcd_barrier_complete(bar, b.x, nloc, nx); b.st[0] = nloc; b.st[1] = nx; }
        const unsigned old = xb_add(&bar[XB_XSUB(b.x)], 1u);
        const unsigned gen = old / nloc;
        if (old + 1u == (gen + 1u) * nloc) {
            __builtin_amdgcn_fence(__ATOMIC_RELEASE, "agent");
            asm volatile("s_waitcnt vmcnt(0)" ::: "memory");
            const unsigned og = xb_add(&bar[XB_TOP], 1u);
            const unsigned tg = og / nx;
            if (og + 1u == (tg + 1u) * nx) xb_add(&bar[XB_TOPGEN], 1u);
            else XB_SPIN(xb_ld(&bar[XB_TOPGEN]) == tg, bar);
            __builtin_amdgcn_fence(__ATOMIC_ACQUIRE, "agent");
            xb_add(&bar[XB_XGEN(b.x)], 1u);
            asm volatile("s_waitcnt vmcnt(0)" ::: "memory");
        } else {
            XB_SPIN(xb_ld(&bar[XB_XGEN(b.x)]) == gen, bar);
            __builtin_amdgcn_fence(__ATOMIC_ACQUIRE, "agent");
            asm volatile("s_waitcnt vmcnt(0)" ::: "memory");
        }
    }
    __syncthreads();
}
struct Args {
    const float *x, *p; const int* pos; const float *gains, *w_in, *conv, *a_log, *dt_bias, *norm_a, *i_bias, *f_bias, *norm_b, *w_out, *w_qkv, *b_qkv, *sinks, *w_o, *b_o, *w_up, *w_down, *w_ple, *w_gate;
    float* out; unsigned char* ws;
    int ph_lo, ph_hi, dup_mask, dup_par;
};

__device__ __forceinline__ void transpose_item(const float* src, int ld, int K, bf16* dst, LAS float* scr, int item, int nblk, int lane) {
    const int kb = item / nblk, nb = item % nblk, k0 = 64 * kb, n0 = 32 * nb;
#pragma unroll 8
    for (int i = 0; i < 32; ++i) { const int kk = 2 * i + (lane >> 5); scr[kk * 33 + (lane & 31)] = src[(size_t)(k0 + kk) * ld + n0 + (lane & 31)]; }
    LDS_WAIT(); asm volatile("" ::: "memory");
    const int c = lane & 7;
#pragma unroll
    for (int j = 0; j < 4; ++j) { const int n = (lane >> 3) + 8 * j; const LAS float* s = scr + (8 * c) * 33 + n;
        u32x4 o; o.x = pk2(s[0 * 33], s[1 * 33]); o.y = pk2(s[2 * 33], s[3 * 33]); o.z = pk2(s[4 * 33], s[5 * 33]); o.w = pk2(s[6 * 33], s[7 * 33]);
        *(u32x4*)(dst + (size_t)(n0 + n) * K + k0 + 8 * c) = o; }
    LDS_WAIT(); asm volatile("" ::: "memory");
}
__device__ __forceinline__ int gate_col(int c) { return c < 8 ? 1536 + c : 3592 + (c - 8); }

typedef const __attribute__((address_space(4))) Args* KArgs;
__device__ __forceinline__ KArgs kargs() { KArgs p = (KArgs)__builtin_amdgcn_kernarg_segment_ptr(); asm volatile("" : "+s"(p)); return p; }
__device__ __forceinline__ int fresh_tid() { int t = threadIdx.x; asm volatile("" : "+v"(t)); return t; }
__device__ __forceinline__ void prologue_phase(KArgs a, LAS unsigned char* lds, int gw, int NGW, int wave, int lane, int gtid, int NGT) {
    LAS float* scr = (LAS float*)(lds + wave * 16384);
    constexpr int I_IN = 16 * 16, I_SQ = 16 * 32, I_QKV = 16 * 48, I_UP = 16 * 128, I_DN = 64 * 32, I_PLE = 4 * 32;
    constexpr int NITEMS = 16 * I_IN + 2 * I_SQ + 2 * I_QKV + 2 * I_SQ + 4 * I_UP + 4 * I_DN + 4 * I_PLE + 4 * I_SQ;
    unsigned char* ws = a->ws;
    for (int it = gw; it < NITEMS; it += NGW) {
        int r = it;
        if (r < 16 * I_IN) { const int j = r / I_IN, e = j >> 3, s = j & 7, col0 = 512 * s + (s >= 3 ? 8 : 0) + (s >= 7 ? 8 : 0);
            transpose_item(a->w_in + (size_t)e * DM * NIN + col0, NIN, DM, (bf16*)(ws + WS_WIN) + ((size_t)e * 4096 + s * 512) * DM, scr, r % I_IN, 16, lane); continue; } r -= 16 * I_IN;
        if (r < 2 * I_SQ) { const int e = r / I_SQ; transpose_item(a->w_out + (size_t)e * DM * DM, DM, DM, (bf16*)(ws + WS_WOUT) + (size_t)e * DM * DM, scr, r % I_SQ, 32, lane); continue; } r -= 2 * I_SQ;
        if (r < 2 * I_QKV) { const int e = r / I_QKV; transpose_item(a->w_qkv + (size_t)e * DM * 1536, 1536, DM, (bf16*)(ws + WS_WQKV) + (size_t)e * 1536 * DM, scr, r % I_QKV, 48, lane); continue; } r -= 2 * I_QKV;
        if (r < 2 * I_SQ) { const int e = r / I_SQ; transpose_item(a->w_o + (size_t)e * DM * DM, DM, DM, (bf16*)(ws + WS_WO) + (size_t)e * DM * DM, scr, r % I_SQ, 32, lane); continue; } r -= 2 * I_SQ;
        if (r < 4 * I_UP) { const int l = r / I_UP; transpose_item(a->w_up + (size_t)l * DM * FF, FF, DM, (bf16*)(ws + WS_WUP) + (size_t)l * FF * DM, scr, r % I_UP, 128, lane); continue; } r -= 4 * I_UP;
        if (r < 4 * I_DN) { const int l = r / I_DN; transpose_item(a->w_down + (size_t)l * FF * DM, DM, FF, (bf16*)(ws + WS_WDN) + (size_t)l * DM * FF, scr, r % I_DN, 32, lane); continue; } r -= 4 * I_DN;
        if (r < 4 * I_PLE) { const int l = r / I_PLE; transpose_item(a->w_ple + (size_t)l * PLE * DM, DM, PLE, (bf16*)(ws + WS_WPLE) + (size_t)l * DM * PLE, scr, r % I_PLE, 32, lane); continue; } r -= 4 * I_PLE;
        { const int l = r / I_SQ; transpose_item(a->w_gate + (size_t)l * DM * DM, DM, DM, (bf16*)(ws + WS_WG) + (size_t)l * DM * DM, scr, r % I_SQ, 32, lane); }
    }
    float* Wg = (float*)(a->ws + WS_WGATES);
    for (int i = gtid; i < 2 * 16 * 1024; i += NGT) { const int e = i >> 14, c = (i >> 10) & 15, k = i & 1023; Wg[i] = a->w_in[((size_t)e * 1024 + k) * NIN + gate_col(c)]; }
    f32x2* rope = (f32x2*)(a->ws + WS_ROPE);
    for (int i = gtid; i < M * 32; i += NGT) { const int m = i >> 5, d = i & 31;
        const float inv = (float)pow(10000.0, -(double)d / 32.0); const float ang = (float)a->pos[m] * inv; float sn, cs; sincosf(ang, &sn, &cs); rope[i] = (f32x2){cs, sn}; }
}

__device__ __forceinline__ void norm_phase(LAS unsigned char* lds, const float* hin, const float* g0, bf16* HN, bool even, const float* Wg, float* Gt, int gw, int NGW, int tid, int lane) {
    LAS f32x4* wl = (LAS f32x4*)lds;
    if (even) { for (int i = tid; i < 4096; i += NTHR) wl[i] = ((const f32x4*)Wg)[i]; __syncthreads(); }
    f32x4 gv[4];
#pragma unroll
    for (int j = 0; j < 4; ++j) gv[j] = ((const f32x4*)g0)[lane + 64 * j];
    for (int m = gw; m < M; m += NGW) {
        const f32x4* xr = (const f32x4*)(hin + (size_t)m * DM) + lane;
        f32x4 v[4]; float s = 0.f;
#pragma unroll
        for (int j = 0; j < 4; ++j) { v[j] = xr[64 * j]; s += dot4(v[j], v[j]); }
        const float rstd = rsqrtf(wave_sum(s) * (1.f / DM) + EPS);
        u32x2* o8 = (u32x2*)(HN + (size_t)m * DM) + lane;
#pragma unroll
        for (int j = 0; j < 4; ++j) { v[j] = v[j] * rstd * gv[j]; o8[64 * j] = (u32x2){pk2(v[j].x, v[j].y), pk2(v[j].z, v[j].w)}; }
        if (even) {
            float keep = 0.f;
#pragma unroll
            for (int c = 0; c < 16; ++c) { float d = 0.f;
#pragma unroll
                for (int j = 0; j < 4; ++j) d += dot4(v[j], wl[c * 256 + lane + 64 * j]);
                d = wave_sum(d); if (lane == c) keep = d; }
            if (lane < 16) Gt[(size_t)m * 16 + lane] = keep;
        }
    }
    if (even) __syncthreads();
}
__device__ __forceinline__ void resid_a_phase(const float* mix, const float* hin, float* out, const float* g1, const float* g2, bf16* HN, int gw, int NGW, int lane) {
    f32x4 ga[4], gb[4];
#pragma unroll
    for (int j = 0; j < 4; ++j) { ga[j] = ((const f32x4*)g1)[lane + 64 * j]; gb[j] = ((const f32x4*)g2)[lane + 64 * j]; }
    for (int m = gw; m < M; m += NGW) {
        const f32x4* xr = (const f32x4*)(mix + (size_t)m * DM) + lane; const f32x4* hr = (const f32x4*)(hin + (size_t)m * DM) + lane;
        f32x4 v[4], h[4]; float s = 0.f;
#pragma unroll
        for (int j = 0; j < 4; ++j) { v[j] = xr[64 * j]; h[j] = hr[64 * j]; s += dot4(v[j], v[j]); }
        const float r1 = rsqrtf(wave_sum(s) * (1.f / DM) + EPS); float s2 = 0.f;
        f32x4* orow = (f32x4*)(out + (size_t)m * DM) + lane;
#pragma unroll
        for (int j = 0; j < 4; ++j) { h[j] = h[j] + v[j] * r1 * ga[j]; orow[64 * j] = h[j]; s2 += dot4(h[j], h[j]); }
        const float r2 = rsqrtf(wave_sum(s2) * (1.f / DM) + EPS);
        u32x2* o8 = (u32x2*)(HN + (size_t)m * DM) + lane;
#pragma unroll
        for (int j = 0; j < 4; ++j) { const f32x4 y = h[j] * r2 * gb[j]; o8[64 * j] = (u32x2){pk2(y.x, y.y), pk2(y.z, y.w)}; }
    }
}
__device__ __forceinline__ void resid_b_phase(const float* ff, float* out, const float* g3, bf16* HB, const float* pl, bf16* PB, int gw, int NGW, int lane, int gtid, int NGT) {
    f32x4 ga[4];
#pragma unroll
    for (int j = 0; j < 4; ++j) ga[j] = ((const f32x4*)g3)[lane + 64 * j];
    for (int m = gw; m < M; m += NGW) {
        const f32x4* xr = (const f32x4*)(ff + (size_t)m * DM) + lane; f32x4* hr = (f32x4*)(out + (size_t)m * DM) + lane;
        f32x4 v[4], h[4]; float s = 0.f;
#pragma unroll
        for (int j = 0; j < 4; ++j) { v[j] = xr[64 * j]; h[j] = hr[64 * j]; s += dot4(v[j], v[j]); }
        const float r1 = rsqrtf(wave_sum(s) * (1.f / DM) + EPS);
        u32x2* o8 = (u32x2*)(HB + (size_t)m * DM) + lane;
#pragma unroll
        for (int j = 0; j < 4; ++j) { h[j] = h[j] + v[j] * r1 * ga[j]; hr[64 * j] = h[j]; o8[64 * j] = (u32x2){pk2(h[j].x, h[j].y), pk2(h[j].z, h[j].w)}; }
    }
    for (int i = gtid; i < M * PLE / 8; i += NGT) { const f32x4 a = ((const f32x4*)pl)[2 * i], b = ((const f32x4*)pl)[2 * i + 1];
        ((u32x4*)PB)[i] = (u32x4){pk2(a.x, a.y), pk2(a.z, a.w), pk2(b.x, b.y), pk2(b.z, b.w)}; }
}
__device__ __forceinline__ void conv_phase(const bf16* BIG, const float* convw  , bf16* QKVA, int gw, int NGW, int lane) {
    for (int m = gw; m < M; m += NGW) {
        const int s = m & (SEQ - 1);
#pragma unroll
        for (int j = 0; j < 3; ++j) {
            const int col = j * 512 + lane * 8; float acc[8];
#pragma unroll
            for (int i = 0; i < 8; ++i) acc[i] = 0.f;
#pragma unroll
            for (int kk = 0; kk < 4; ++kk) if (s - 3 + kk >= 0) {
                const u32x4 xv = *(const u32x4*)(BIG + (size_t)(m - 3 + kk) * 1536 + col); const f32x4 w0 = *(const f32x4*)(convw + kk * 1536 + col), w1 = *(const f32x4*)(convw + kk * 1536 + col + 4);
                acc[0] += bf_lo(xv.x) * w0.x; acc[1] += bf_hi(xv.x) * w0.y; acc[2] += bf_lo(xv.y) * w0.z; acc[3] += bf_hi(xv.y) * w0.w;
                acc[4] += bf_lo(xv.z) * w1.x; acc[5] += bf_hi(xv.z) * w1.y; acc[6] += bf_lo(xv.w) * w1.z; acc[7] += bf_hi(xv.w) * w1.w; }
            float ss = 0.f;
#pragma unroll
            for (int i = 0; i < 8; ++i) { acc[i] = acc[i] / (1.f + __expf(-acc[i])); ss += acc[i] * acc[i]; }
            if (j < 2) { ss += __shfl_xor(ss, 1); ss += __shfl_xor(ss, 2); ss += __shfl_xor(ss, 4); ss += __shfl_xor(ss, 8);
                const float sc = rsqrtf(ss + EPS) * (j == 0 ? 0.08838834764831845f : 1.f);
#pragma unroll
                for (int i = 0; i < 8; ++i) acc[i] *= sc; }
            *(u32x4*)(QKVA + (size_t)m * 1536 + col) = (u32x4){pk2(acc[0], acc[1]), pk2(acc[2], acc[3]), pk2(acc[4], acc[5]), pk2(acc[6], acc[7])};
        }
    }
}
__device__ __forceinline__ void rope_phase(bf16* QKV, const f32x2* rope, int gw, int NGW, int lane) {
    for (int m = gw; m < M; m += NGW) {
        const int grp = lane & 7; const f32x4* tb = (const f32x4*)(rope + (size_t)m * 32 + grp * 4); const f32x4 t0 = tb[0], t1 = tb[1];
        const float cs[4] = {t0.x, t0.z, t1.x, t1.z}, sn[4] = {t0.y, t0.w, t1.y, t1.w};
#pragma unroll
        for (int k = 0; k < 3; ++k) {
            if (k == 2 && lane >= 32) break;
            const int hh = (k < 2) ? ((lane + 64 * k) >> 3) : (lane >> 3); const float scale = (k < 2) ? 0.125f : 1.f;
            bf16* base = QKV + (size_t)m * 1536 + (k < 2 ? 0 : 1024) + hh * 64 + grp * 4;
            const u32x2 a = *(const u32x2*)base, b = *(const u32x2*)(base + 32);
            const float x1[4] = {bf_lo(a.x), bf_hi(a.x), bf_lo(a.y), bf_hi(a.y)}, x2[4] = {bf_lo(b.x), bf_hi(b.x), bf_lo(b.y), bf_hi(b.y)};
            float o1[4], o2[4];
#pragma unroll
            for (int i = 0; i < 4; ++i) { o1[i] = (x1[i] * cs[i] - x2[i] * sn[i]) * scale; o2[i] = (x2[i] * cs[i] + x1[i] * sn[i]) * scale; }
            *(u32x2*)base = (u32x2){pk2(o1[0], o1[1]), pk2(o1[2], o1[3])}; *(u32x2*)(base + 32) = (u32x2){pk2(o2[0], o2[1]), pk2(o2[2], o2[3])};
        }
    }
}
typedef short bf16x8 __attribute__((ext_vector_type(8)));
#define MFMA16(a, b, c) __builtin_amdgcn_mfma_f32_16x16x32_bf16(a, b, c, 0, 0, 0)
__device__ __forceinline__ bf16x8 pack8(f32x4 a, f32x4 b) { const u32x4 w = {pk2v(a.x, a.y), pk2v(a.z, a.w), pk2v(b.x, b.y), pk2v(b.z, b.w)}; return __builtin_bit_cast(bf16x8, w); }
__device__ __forceinline__ float bf2f(unsigned short v) { return __builtin_bit_cast(float, (unsigned)v << 16); }
__device__ __forceinline__ float rdlane(float v, int i) { return __builtin_bit_cast(float, __builtin_amdgcn_readlane(__builtin_bit_cast(int, v), i)); }
__device__ __forceinline__ float scan_add(float v, int lane) {
#pragma unroll
    for (int o = 1; o < 64; o <<= 1) { const float t = __shfl_up(v, o); if (lane >= o) v += t; }
    return v; }
__device__ __forceinline__ float scan_max(float v, int lane) {
#pragma unroll
    for (int o = 1; o < 64; o <<= 1) { const float t = __shfl_up(v, o); if (lane >= o) v = fmaxf(v, t); }
    return v; }
__device__ __forceinline__ int kperm(int ks, int q, int jj) { return 32 * ks + (jj < 4 ? 4 * q + jj : 16 + 4 * q + jj - 4); }
template <bool SCALE> __device__ __forceinline__ u32x4 tr_gather(const bf16* src  , int ld, int ks, int q, float esc_lane) {
    unsigned w[4];
#pragma unroll
    for (int j2 = 0; j2 < 4; ++j2) { const int r0 = kperm(ks, q, 2 * j2), r1 = r0 + 1; const unsigned short a = src[(size_t)r0 * ld], b = src[(size_t)r1 * ld];
        if (SCALE) { const float s0 = __shfl(esc_lane, r0), s1 = __shfl(esc_lane, r1); w[j2] = pk2(bf2f(a) * s0, bf2f(b) * s1); } else w[j2] = (unsigned)a | ((unsigned)b << 16); }
    return (u32x4){w[0], w[1], w[2], w[3]};
}
struct ScanBufs {
    bf16* QKVA;
    bf16* X2;
    float* Gt;
    bf16 *KT, *UT, *NW, *ATT;
    bf16 *KWT, *VT, *PT;
    float* DEN;
};
__device__ __forceinline__ void local_phase(LAS unsigned char* lds, const ScanBufs sb, const float* a_log, const float* dt_bias, const float* i_bias, const float* f_bias, int gw, int NGW, int wave, int lane) {
    LAS float* Lw = (LAS float*)(lds + wave * 16384);
    const int njobs = 2 * BATCH * 4 * (SEQ / 64), per = (njobs + NGW - 1) / NGW; const int lane_in = lane;
#pragma unroll 1
    for (int rj = 0; rj < per; ++rj) {
        const int job = gw * per + rj; if (job >= njobs) break;
        int lane = lane_in; asm volatile("" : "+v"(lane));
        const int x = lane & 15, q = lane >> 4;
        const int mixer = job & 1, cidx = job >> 1, c = cidx & 31, h = (cidx >> 5) & 3, b = cidx >> 7;
        const int m0 = b * SEQ + c * 64; const size_t cid = (size_t)cidx;
        float* gr = sb.Gt + (size_t)(m0 + lane) * 16;
        if (mixer == 0) {
            const float beta = 1.f / (1.f + expf(-gr[h])); const float g = -expf(a_log[h]) * softplus_f(gr[4 + h] + dt_bias[h]);
            const float gcum = scan_add(g, lane), eg = expf(gcum), glast = __shfl(gcum, 63);
            const bf16* kb = sb.QKVA + (size_t)m0 * 1536 + 512 + h * 128; const bf16* qb = sb.QKVA + (size_t)m0 * 1536 + h * 128; const bf16* vb = kb + 512;
            bf16x8 Kf[4][4], Qf[4][4];
#pragma unroll
            for (int t = 0; t < 4; ++t)
#pragma unroll
                for (int ks = 0; ks < 4; ++ks) { Kf[t][ks] = *(const bf16x8*)(kb + (size_t)(16 * t + x) * 1536 + 32 * ks + 8 * q); Qf[t][ks] = *(const bf16x8*)(qb + (size_t)(16 * t + x) * 1536 + 32 * ks + 8 * q); }
            float gj[4][4];
#pragma unroll
            for (int jt = 0; jt < 4; ++jt)
#pragma unroll
                for (int r = 0; r < 4; ++r) gj[jt][r] = __shfl(gcum, 16 * jt + 4 * q + r);
            bf16* attp = sb.ATT + cid * 4096;
#pragma unroll
            for (int it = 0; it < 4; ++it) {
                const float gi = __shfl(gcum, 16 * it + x), bi = __shfl(beta, 16 * it + x); f32x4 d2s[4];
#pragma unroll
                for (int jt = 0; jt < 4; ++jt) {
                    if (jt <= it) { f32x4 D1 = {0.f, 0.f, 0.f, 0.f}, D2 = D1;
#pragma unroll
                        for (int ks = 0; ks < 4; ++ks) { D1 = MFMA16(Kf[jt][ks], Kf[it][ks], D1); D2 = MFMA16(Kf[jt][ks], Qf[it][ks], D2); }
                        f32x4 lv;
#pragma unroll
                        for (int r = 0; r < 4; ++r) { const int j = 16 * jt + 4 * q + r, i = 16 * it + x; const float dec = __expf(fminf(gi - gj[jt][r], 0.f));
                            lv[r] = (j < i) ? bi * D1[r] * dec : 0.f; d2s[jt][r] = (j <= i) ? D2[r] * dec : 0.f; }
                        *(LAS f32x4*)(Lw + (16 * it + x) * 64 + 16 * jt + 4 * q) = lv;
                    } else d2s[jt] = (f32x4){0.f, 0.f, 0.f, 0.f};
                }
#pragma unroll
                for (int kp = 0; kp < 2; ++kp) if (it >= 2 || kp == 0) *(bf16x8*)(attp + ((it * 2 + kp) * 64 + lane) * 8) = pack8(d2s[2 * kp], d2s[2 * kp + 1]);
            }
            { float* tab = (float*)(attp + 512); tab[lane] = eg; tab[64 + lane] = expf(glast - gcum); }
            bf16* ktp = sb.KT + cid * 8192;
#pragma unroll 1
            for (int dt = 0; dt < 8; ++dt)
#pragma unroll
                for (int kp = 0; kp < 2; ++kp) *(u32x4*)(ktp + ((dt * 2 + kp) * 64 + lane) * 8) = tr_gather<false>(kb + 16 * dt + x, 1536, kp, q, 0.f);
            LDS_WAIT();
            const float be = beta * eg;
#pragma unroll 1
            for (int p = 0; p < 4; ++p) {
                const int col = 64 * (p & 1) + lane; const bf16* src = (p < 2 ? vb : kb) + col; const float scl = p < 2 ? beta : be;
                float xv[64];
#pragma unroll
                for (int i = 0; i < 64; ++i) {
                    float a0 = 0.f, a1 = 0.f, a2 = 0.f, a3 = 0.f;
#pragma unroll
                    for (int g4 = 0; g4 < (i + 3) / 4; ++g4) { const f32x4 lr = *(const LAS f32x4*)(Lw + i * 64 + 4 * g4);
                        if (4 * g4 + 0 < i) a0 += lr.x * xv[4 * g4 + 0]; if (4 * g4 + 1 < i) a1 += lr.y * xv[4 * g4 + 1]; if (4 * g4 + 2 < i) a2 += lr.z * xv[4 * g4 + 2]; if (4 * g4 + 3 < i) a3 += lr.w * xv[4 * g4 + 3]; }
                    xv[i] = rdlane(scl, i) * bf2f(src[(size_t)i * 1536]) - ((a0 + a1) + (a2 + a3));
                }
                if (p < 2) { bf16* ut = sb.UT + cid * 8192 + (size_t)col * 64;
#pragma unroll
                    for (int k8 = 0; k8 < 8; ++k8) *(u32x4*)(ut + 8 * k8) = (u32x4){pk2(xv[8 * k8], xv[8 * k8 + 1]), pk2(xv[8 * k8 + 2], xv[8 * k8 + 3]), pk2(xv[8 * k8 + 4], xv[8 * k8 + 5]), pk2(xv[8 * k8 + 6], xv[8 * k8 + 7])};
                } else { const int d = col, ks = d >> 5, dd = d & 31, qp = (dd & 15) >> 2, jj = (dd & 3) + 4 * (dd >> 4);
                    unsigned char* nw = (unsigned char*)(sb.NW + cid * 8192) + ks * 1024 + qp * 256 + jj * 2;
#pragma unroll
                    for (int i = 0; i < 64; ++i) *(unsigned short*)(nw + (i >> 4) * 4096 + (i & 15) * 16) = (unsigned short)(pk2(-xv[i], 0.f) & 0xffffu);
                }
            }
            LDS_WAIT();
        } else {
            const float il = gr[8 + h] + i_bias[h]; const float fl = -softplus_f(-(gr[12 + h] + f_bias[h]));
            const float bcum = scan_add(fl, lane), t = il - bcum, pm = scan_max(t, lane), pml = __shfl(pm, 63);
            const float esc = __expf(t - pml);
            const bf16* qb = sb.X2 + (size_t)m0 * 2560 + 512 + h * 128; const bf16* kb = qb + 512; const bf16* vb = kb + 512;
            bf16x8 Kf[4][4], Qf[4][4];
#pragma unroll
            for (int tt = 0; tt < 4; ++tt)
#pragma unroll
                for (int ks = 0; ks < 4; ++ks) { Kf[tt][ks] = *(const bf16x8*)(kb + (size_t)(16 * tt + x) * 2560 + 32 * ks + 8 * q); Qf[tt][ks] = *(const bf16x8*)(qb + (size_t)(16 * tt + x) * 2560 + 32 * ks + 8 * q); }
            float tj[4][4];
#pragma unroll
            for (int jt = 0; jt < 4; ++jt)
#pragma unroll
                for (int r = 0; r < 4; ++r) tj[jt][r] = __shfl(t, 16 * jt + 4 * q + r);
            bf16* ptp = sb.PT + cid * 4096;
#pragma unroll
            for (int it = 0; it < 4; ++it) {
                const float pmi = __shfl(pm, 16 * it + x); f32x4 d2s[4];
#pragma unroll
                for (int jt = 0; jt < 4; ++jt) {
                    if (jt <= it) { f32x4 D2 = {0.f, 0.f, 0.f, 0.f};
#pragma unroll
                        for (int ks = 0; ks < 4; ++ks) D2 = MFMA16(Kf[jt][ks], Qf[it][ks], D2);
#pragma unroll
                        for (int r = 0; r < 4; ++r) { const int j = 16 * jt + 4 * q + r, i = 16 * it + x; d2s[jt][r] = (j <= i) ? D2[r] * 0.08838834764831845f * __expf(fminf(tj[jt][r] - pmi, 0.f)) : 0.f; }
                    } else d2s[jt] = (f32x4){0.f, 0.f, 0.f, 0.f};
                }
#pragma unroll
                for (int kp = 0; kp < 2; ++kp) if (it >= 2 || kp == 0) *(bf16x8*)(ptp + ((it * 2 + kp) * 64 + lane) * 8) = pack8(d2s[2 * kp], d2s[2 * kp + 1]);
            }
            { float* tab = (float*)(ptp + 512); tab[lane] = bcum; tab[64 + lane] = bcum + pm; }
            bf16* kwp = sb.KWT + cid * 8192; bf16* vtp = sb.VT + cid * 8192;
#pragma unroll 1
            for (int dt = 0; dt < 8; ++dt)
#pragma unroll
                for (int kp = 0; kp < 2; ++kp) { *(u32x4*)(kwp + ((dt * 2 + kp) * 64 + lane) * 8) = tr_gather<true>(kb + 16 * dt + x, 2560, kp, q, esc);
                    *(u32x4*)(vtp + ((dt * 2 + kp) * 64 + lane) * 8) = tr_gather<false>(vb + 16 * dt + x, 2560, kp, q, 0.f); }
        }
    }
}
__device__ __forceinline__ void recur_phase(const ScanBufs sb, int G, int bid, int wave, int lane) {
    const int x = lane & 15, q = lane >> 4, et = wave;
#pragma unroll 1
    for (int u = bid; u < 2 * BATCH * 4; u += G) {
        const int mixer = u >> 7, b = (u & 127) >> 2, h = u & 3;
        if (mixer == 0) {
            f32x4 S[8];
#pragma unroll
            for (int d = 0; d < 8; ++d) S[d] = (f32x4){0.f, 0.f, 0.f, 0.f};
#pragma unroll 1
            for (int c = 0; c < SEQ / 64; ++c) {
                const int m0 = b * SEQ + c * 64; const size_t cid = (size_t)((b * 4 + h) * 32 + c);
                const bf16* nwp = sb.NW + cid * 8192; const bf16* utp = sb.UT + cid * 8192 + (size_t)(16 * et + x) * 64; const bf16* atp = sb.ATT + cid * 4096; const bf16* ktp = sb.KT + cid * 8192;
                const float* tab = (const float*)(atp + 512);
                bf16x8 Sb[4];
#pragma unroll
                for (int ks = 0; ks < 4; ++ks) Sb[ks] = pack8(S[2 * ks], S[2 * ks + 1]);
                f32x4 vn[4];
#pragma unroll
                for (int mt = 0; mt < 4; ++mt) { const u32x2 uu = *(const u32x2*)(utp + 16 * mt + 4 * q); f32x4 acc = {bf_lo(uu.x), bf_hi(uu.x), bf_lo(uu.y), bf_hi(uu.y)};
#pragma unroll
                    for (int ks = 0; ks < 4; ++ks) acc = MFMA16(*(const bf16x8*)(nwp + ((mt * 4 + ks) * 64 + lane) * 8), Sb[ks], acc);
                    vn[mt] = acc; }
                bf16x8 vb2[2] = {pack8(vn[0], vn[1]), pack8(vn[2], vn[3])};
#pragma unroll
                for (int it = 0; it < 4; ++it) { f32x4 acc = {0.f, 0.f, 0.f, 0.f};
                    const bf16* qrow = sb.QKVA + (size_t)(m0 + 16 * it + x) * 1536 + h * 128 + 4 * q;
#pragma unroll
                    for (int ks = 0; ks < 4; ++ks) { const u32x2 a = *(const u32x2*)(qrow + 32 * ks), bq = *(const u32x2*)(qrow + 32 * ks + 16); const u32x4 w = {a.x, a.y, bq.x, bq.y};
                        acc = MFMA16(Sb[ks], __builtin_bit_cast(bf16x8, w), acc); }
                    acc = acc * tab[16 * it + x];
#pragma unroll
                    for (int kp = 0; kp < 2; ++kp) if (it >= 2 || kp == 0) acc = MFMA16(vb2[kp], *(const bf16x8*)(atp + ((it * 2 + kp) * 64 + lane) * 8), acc);
                    *(u32x2*)(sb.QKVA + (size_t)(m0 + 16 * it + x) * 1536 + 512 + h * 128 + 16 * et + 4 * q) = (u32x2){pk2v(acc.x, acc.y), pk2v(acc.z, acc.w)}; }
                f32x4 vs[4];
#pragma unroll
                for (int mt = 0; mt < 4; ++mt)
#pragma unroll
                    for (int r = 0; r < 4; ++r) vs[mt][r] = vn[mt][r] * tab[64 + 16 * mt + 4 * q + r];
                const bf16x8 vsb[2] = {pack8(vs[0], vs[1]), pack8(vs[2], vs[3])};
                const float gam = tab[63];
#pragma unroll
                for (int dt = 0; dt < 8; ++dt) { f32x4 acc = S[dt] * gam;
#pragma unroll
                    for (int kp = 0; kp < 2; ++kp) acc = MFMA16(*(const bf16x8*)(ktp + ((dt * 2 + kp) * 64 + lane) * 8), vsb[kp], acc);
                    S[dt] = acc; }
            }
        } else {
            f32x4 Cs[8], Ce[8]; float mrun = 0.f;
#pragma unroll
            for (int d = 0; d < 8; ++d) { Cs[d] = (f32x4){0.f, 0.f, 0.f, 0.f}; Ce[d] = Cs[d]; }
            const short one = (x == 0) ? (short)0x3F80 : (short)0; const bf16x8 ones = {one, one, one, one, one, one, one, one};
#pragma unroll 1
            for (int c = 0; c < SEQ / 64; ++c) {
                const int m0 = b * SEQ + c * 64; const size_t cid = (size_t)((b * 4 + h) * 32 + c);
                const bf16* ptp = sb.PT + cid * 4096; const bf16* kwp = sb.KWT + cid * 8192; const bf16* vtp = sb.VT + cid * 8192;
                const float* tab = (const float*)(ptp + 512);
                bf16x8 Cb[4], Eb[4];
#pragma unroll
                for (int ks = 0; ks < 4; ++ks) { Cb[ks] = pack8(Cs[2 * ks], Cs[2 * ks + 1]); Eb[ks] = pack8(Ce[2 * ks], Ce[2 * ks + 1]); }
                const bf16x8 vf[2] = {*(const bf16x8*)(vtp + ((et * 2 + 0) * 64 + lane) * 8), *(const bf16x8*)(vtp + ((et * 2 + 1) * 64 + lane) * 8)};
#pragma unroll
                for (int it = 0; it < 4; ++it) {
                    const float bc = tab[16 * it + x], mi = tab[64 + 16 * it + x];
                    const float a = bc + mrun, mt = fmaxf(a, mi), f1 = __expf(a - mt) * 0.08838834764831845f, f2 = __expf(mi - mt);
                    f32x4 a1 = {0.f, 0.f, 0.f, 0.f}, aP = a1, e1 = a1, eP = a1;
                    const bf16* qrow = sb.X2 + (size_t)(m0 + 16 * it + x) * 2560 + 512 + h * 128 + 4 * q;
#pragma unroll
                    for (int ks = 0; ks < 4; ++ks) { const u32x2 aa = *(const u32x2*)(qrow + 32 * ks), bq = *(const u32x2*)(qrow + 32 * ks + 16); const u32x4 w = {aa.x, aa.y, bq.x, bq.y}; const bf16x8 qf = __builtin_bit_cast(bf16x8, w);
                        a1 = MFMA16(Cb[ks], qf, a1); if (wave == 0) e1 = MFMA16(Eb[ks], qf, e1); }
#pragma unroll
                    for (int kp = 0; kp < 2; ++kp) if (it >= 2 || kp == 0) { const bf16x8 pf = *(const bf16x8*)(ptp + ((it * 2 + kp) * 64 + lane) * 8); aP = MFMA16(vf[kp], pf, aP); if (wave == 0) eP = MFMA16(ones, pf, eP); }
                    const f32x4 nm = a1 * f1 + aP * f2;
                    *(u32x2*)(sb.X2 + (size_t)(m0 + 16 * it + x) * 2560 + 1024 + h * 128 + 16 * et + 4 * q) = (u32x2){pk2(nm.x, nm.y), pk2(nm.z, nm.w)};
                    if (wave == 0 && q == 0) sb.DEN[(size_t)(m0 + 16 * it + x) * 4 + h] = fmaxf(fabsf(e1.x * f1 + eP.x * f2), __expf(-mt));
                }
                const float blast = tab[63], wsmax = tab[127];
                const float mnew = fmaxf(blast + mrun, wsmax), sc = __expf(blast + mrun - mnew), s2 = __expf(wsmax - mnew); mrun = mnew;
#pragma unroll
                for (int dt = 0; dt < 8; ++dt) { f32x4 dC = {0.f, 0.f, 0.f, 0.f}, dE = dC;
#pragma unroll
                    for (int kp = 0; kp < 2; ++kp) { const bf16x8 kf = *(const bf16x8*)(kwp + ((dt * 2 + kp) * 64 + lane) * 8); dC = MFMA16(kf, vf[kp], dC); if (wave == 0) dE = MFMA16(kf, ones, dE); }
                    Cs[dt] = Cs[dt] * sc + dC * s2; if (wave == 0) Ce[dt] = Ce[dt] * sc + dE * s2; }
            }
        }
    }
}
__device__ __forceinline__ void post_phase(const ScanBufs sb, const float* norm_a, const float* norm_b, bf16* MIXED, int gw, int NGW, int lane) {
    const int hh = lane >> 3, sub = (lane & 7) * 16;
    for (int m = gw; m < M; m += NGW) {
        const bool isA = hh < 4; const int h = hh & 3;
        const bf16* src = isA ? sb.QKVA + (size_t)m * 1536 + 512 + h * 128 + sub : sb.X2 + (size_t)m * 2560 + 1024 + h * 128 + sub;
        const bf16* gsrc = sb.X2 + (size_t)m * 2560 + (isA ? 0 : 2048) + h * 128 + sub;
        const float* gn = (isA ? norm_a : norm_b + h * 128) + sub;
        const u32x4 r0 = *(const u32x4*)src, r1 = *(const u32x4*)(src + 8), z0 = *(const u32x4*)gsrc, z1 = *(const u32x4*)(gsrc + 8);
        float v[16] = {bf_lo(r0.x), bf_hi(r0.x), bf_lo(r0.y), bf_hi(r0.y), bf_lo(r0.z), bf_hi(r0.z), bf_lo(r0.w), bf_hi(r0.w), bf_lo(r1.x), bf_hi(r1.x), bf_lo(r1.y), bf_hi(r1.y), bf_lo(r1.z), bf_hi(r1.z), bf_lo(r1.w), bf_hi(r1.w)};
        const float z[16] = {bf_lo(z0.x), bf_hi(z0.x), bf_lo(z0.y), bf_hi(z0.y), bf_lo(z0.z), bf_hi(z0.z), bf_lo(z0.w), bf_hi(z0.w), bf_lo(z1.x), bf_hi(z1.x), bf_lo(z1.y), bf_hi(z1.y), bf_lo(z1.z), bf_hi(z1.z), bf_lo(z1.w), bf_hi(z1.w)};
        const float dinv = isA ? 1.f : 1.f / sb.DEN[(size_t)m * 4 + h];
        float ss = 0.f;
#pragma unroll
        for (int i = 0; i < 16; ++i) { v[i] *= dinv; ss += v[i] * v[i]; }
        ss += __shfl_xor(ss, 1); ss += __shfl_xor(ss, 2); ss += __shfl_xor(ss, 4);
        const float rstd = rsqrtf(ss * (1.f / 128.f) + EPS);
        float y[16];
#pragma unroll
        for (int i = 0; i < 16; ++i) { const float sg = sigmoid_f(z[i]); y[i] = v[i] * rstd * gn[i] * (isA ? z[i] * sg : sg); }
        u32x4* dst = (u32x4*)(MIXED + (size_t)m * 1024 + lane * 16);
        dst[0] = (u32x4){pk2(y[0], y[1]), pk2(y[2], y[3]), pk2(y[4], y[5]), pk2(y[6], y[7])}; dst[1] = (u32x4){pk2(y[8], y[9]), pk2(y[10], y[11]), pk2(y[12], y[13]), pk2(y[14], y[15])};
    }
}
typedef short v4i16_t __attribute__((ext_vector_type(4)));
constexpr int AT_VROW = 80;
constexpr int AT_K_BYTES = 256 * 128, AT_V_BYTES = 272 * AT_VROW * 2;
__device__ __forceinline__ void attn_phase(LAS unsigned char* lds, int tid, int wave, const bf16* QKV, const float* sinks, bf16* O, int G, int bid) {
    LAS unsigned char* KL = lds; LAS unsigned char* VL = lds + AT_K_BYTES;
    const int lane = tid & 63, x = lane & 15, q = lane >> 4, g = wave >> 1, qh = wave & 1;
#pragma unroll 1
    for (int u = bid; u < BATCH * 4 * 16; u += G) {
        const int b = u >> 6, kvh = (u >> 4) & 3, jb = u & 15;
#pragma unroll
        for (int i = 0; i < 4; ++i) { const int item = tid + 512 * i, r = item >> 3, ch = item & 7, sk = (jb - 1) * 128 + r;
            u32x4 kv = (u32x4){0u, 0u, 0u, 0u}, vv = kv;
            if (sk >= 0) { const bf16* src = QKV + (size_t)(b * SEQ + sk) * 1536 + 1024 + kvh * 64 + ch * 8; kv = *(const u32x4*)src; vv = *(const u32x4*)(src + 256); }
            *(LAS u32x4*)(KL + r * 128 + ((ch ^ (r & 7)) << 4)) = kv; *(LAS u32x4*)(VL + r * (AT_VROW * 2) + ch * 16) = vv; }
        if (tid < 128) { const int r = 256 + (tid >> 3), ch = tid & 7; *(LAS u32x4*)(VL + r * (AT_VROW * 2) + ch * 16) = (u32x4){0u, 0u, 0u, 0u}; }
        __syncthreads();
        const int hq = kvh * 4 + g; const float sink = sinks[hq];
        const size_t mq = (size_t)b * SEQ + jb * 128 + 64 * qh;
#pragma unroll 1
        for (int nt = 0; nt < 4; ++nt) {
            bf16x8 Qf[2];
#pragma unroll
            for (int ks = 0; ks < 2; ++ks) Qf[ks] = *(const bf16x8*)(QKV + (mq + 16 * nt + x) * 1536 + hq * 64 + 32 * ks + 8 * q);
            f32x4 s[9]; float mx = -3.0e38f;
#pragma unroll
            for (int j = 0; j < 9; ++j) { const int kt = nt + j, r = 64 * qh + 16 * kt + x;
                f32x4 acc = {0.f, 0.f, 0.f, 0.f};
#pragma unroll
                for (int ks = 0; ks < 2; ++ks) acc = MFMA16(*(const LAS bf16x8*)(KL + r * 128 + (((4 * ks + q) ^ (r & 7)) << 4)), Qf[ks], acc);
#pragma unroll
                for (int rg = 0; rg < 4; ++rg) { const int diff = 16 * j + 4 * q + rg - x, ra = 64 * qh + 16 * kt + 4 * q + rg;
                    const bool valid = diff >= 1 && diff <= 128 && (jb - 1) * 128 + ra >= 0;
                    acc[rg] = valid ? acc[rg] : -3.0e38f; mx = fmaxf(mx, acc[rg]); }
                s[j] = acc; }
            mx = fmaxf(mx, __shfl_xor(mx, 16)); mx = fmaxf(mx, __shfl_xor(mx, 32)); mx = fmaxf(mx, sink);
            float sum = 0.f;
#pragma unroll
            for (int j = 0; j < 9; ++j)
#pragma unroll
                for (int rg = 0; rg < 4; ++rg) { const float p = (s[j][rg] > -1.0e38f) ? __expf(s[j][rg] - mx) : 0.f; s[j][rg] = p; sum += p; }
            sum += __shfl_xor(sum, 16); sum += __shfl_xor(sum, 32);
            const float inv = 1.f / (sum + __expf(sink - mx));
            bf16x8 Pf[5];
#pragma unroll
            for (int j2 = 0; j2 < 4; ++j2) Pf[j2] = pack8(s[2 * j2], s[2 * j2 + 1]);
            Pf[4] = pack8(s[8], (f32x4){0.f, 0.f, 0.f, 0.f});
#pragma unroll
            for (int dt = 0; dt < 4; ++dt) { f32x4 acc = {0.f, 0.f, 0.f, 0.f};
#pragma unroll
                for (int j2 = 0; j2 < 5; ++j2) { const int kb = 64 * qh + 16 * (nt + 2 * j2) + 4 * q + (x >> 2);
                    const LAS unsigned char* p0 = VL + kb * (AT_VROW * 2) + (16 * dt + 4 * (x & 3)) * 2;
                    const v4i16_t lo = __builtin_amdgcn_ds_read_tr16_b64_v4i16((LAS v4i16_t*)p0), hi = __builtin_amdgcn_ds_read_tr16_b64_v4i16((LAS v4i16_t*)(p0 + 16 * AT_VROW * 2));
                    const bf16x8 vf = {lo[0], lo[1], lo[2], lo[3], hi[0], hi[1], hi[2], hi[3]};
                    acc = MFMA16(vf, Pf[j2], acc); }
                acc = acc * inv;
                *(u32x2*)(O + (mq + 16 * nt + x) * 1024 + hq * 64 + 16 * dt + 4 * q) = (u32x2){pk2v(acc.x, acc.y), pk2v(acc.z, acc.w)}; }
        }
        __syncthreads();
    }
}
#ifndef N_LAUNCH_MODE
#define N_LAUNCH_MODE 0
#endif
__global__ void __launch_bounds__(NTHR, 2) trunk_fwd(Args a_unused) {
    extern __shared__ __attribute__((aligned(16))) unsigned char lds_raw[];
    LAS unsigned char* lds = (LAS unsigned char*)lds_raw;
    volatile LAS unsigned* MISC = (volatile LAS unsigned*)(lds + MISC_OFF);
    if (threadIdx.x < 64) MISC[threadIdx.x] = 0u;
    __syncthreads();
    int lo, hi; XcdBarrier bar;
    int dupm = 0, dupp = 0; (void)dupm; (void)dupp;
    { KArgs a = kargs(); lo = a->ph_lo; hi = a->ph_hi; dupm = a->dup_mask; dupp = a->dup_par; unsigned* ctl = (unsigned*)(a->ws + WS_CTL);
      bar.bar = ctl + CW_BAR; bar.x = 0; bar.st = MISC + 8;
      if (hi - lo > 1) bar = xcd_barrier_post(ctl + CW_BAR, MISC + 8); }
#define IN(k) (lo <= (k) && (k) < hi)
#if defined(PROBE_DUP_MASK)
#define REP(k) _Pragma("unroll 1") for (int rep_ = 0; rep_ <= (((dupm >> (k)) & 1) && (dupp == 0 || dupp == 1 + (L & 1)) ? 1 : 0); ++rep_)
#else
#define REP(k)
#endif
#define SEAM(k) do { if (IN(k) && IN((k) + 1)) xcd_barrier(bar); } while (0)
#define ENV KArgs a = kargs(); const int tid = fresh_tid(), lane = tid & 63, wave = __builtin_amdgcn_readfirstlane(tid >> 6); const int G = gridDim.x, bid = blockIdx.x, gw = bid * NWAVES + wave, NGW = G * NWAVES, gtid = bid * NTHR + tid, NGT = G * NTHR; \
    unsigned char* ws = a->ws; bf16* RA = (bf16*)(ws + WS_RA); bf16* RB = (bf16*)(ws + WS_RB); bf16* RC = (bf16*)(ws + WS_RC); bf16* RD = (bf16*)(ws + WS_RD); float* Gt = (float*)(ws + WS_GT); \
    (void)lane; (void)wave; (void)gw; (void)NGW; (void)gtid; (void)NGT; (void)RA; (void)RB; (void)RC; (void)RD; (void)Gt; (void)G; (void)bid

    if (IN(0)) { ENV; prologue_phase(a, lds, gw, NGW, wave, lane, gtid, NGT); }
    SEAM(0);
#define SCANBUFS ScanBufs sb; sb.QKVA = (bf16*)(ws + WS_QKVA); sb.X2 = (bf16*)(ws + WS_X2); sb.Gt = Gt; sb.KT = (bf16*)(ws + WS_KT); sb.UT = (bf16*)(ws + WS_UT); sb.NW = (bf16*)(ws + WS_NW); sb.ATT = (bf16*)(ws + WS_ATT); \
    sb.KWT = (bf16*)(ws + WS_KWT); sb.VT = (bf16*)(ws + WS_VT); sb.PT = (bf16*)(ws + WS_PT); sb.DEN = (float*)(ws + WS_DEN)
#pragma unroll 1
    for (int L = 0; L < DEPTH; ++L) {
        const int pb = 1 + L * PH_PER_LAYER; const bool even = (L & 1) == 0; const int e = L >> 1;
        if (IN(pb + 0)) REP(0) { ENV; const float* hin = (L == 0) ? a->x : a->out;
            norm_phase(lds, hin, a->gains + (size_t)L * 4 * DM, RA, even, (const float*)(ws + WS_WGATES) + (size_t)e * 16 * 1024, Gt, gw, NGW, tid, lane); }
        SEAM(pb + 0);
        if (IN(pb + 1)) REP(1) { ENV;
            const int N = even ? 4096 : 1536;
            pg8::Gemm g{RA, even ? (const bf16*)(ws + WS_WIN) + (size_t)e * 4096 * 1024 : (const bf16*)(ws + WS_WQKV) + (size_t)e * 1536 * 1024, M, N, DM};
            pg8::StaticOrder S; S.init(M, N, G, bid);
            pg8::EpiBf16<0> E{RC, 1536, even ? nullptr : a->b_qkv + (size_t)e * 1536, (bf16*)(ws + WS_X2), 1536, 2560};
            pg8::gemm_phase<pg8::EpiBf16<0>, pg8::StaticOrder, true, true>(lds, g, S, E);
        }
        SEAM(pb + 1);
        if (IN(pb + 2)) REP(2) { ENV; if (even) conv_phase((const bf16*)(ws + WS_X1), a->conv + (size_t)e * 4 * 1536, (bf16*)(ws + WS_QKVA), gw, NGW, lane); else rope_phase(RC, (const f32x2*)(ws + WS_ROPE), gw, NGW, lane); }
        SEAM(pb + 2);
        if (even) {
            if (IN(pb + 3)) REP(3) { ENV; SCANBUFS; local_phase(lds, sb, a->a_log + e * 4, a->dt_bias + e * 4, a->i_bias + e * 4, a->f_bias + e * 4, gw, NGW, wave, lane); }
            SEAM(pb + 3);
        }
        if (IN(pb + 4)) REP(4) { ENV;
            if (even) { SCANBUFS; recur_phase(sb, G, bid, wave, lane); }
            else attn_phase(lds, tid, wave, RC, a->sinks + e * 16, RD, G, bid);
        }
        SEAM(pb + 4);
        if (even) {
            if (IN(pb + 5)) REP(5) { ENV; SCANBUFS; post_phase(sb, a->norm_a + e * 128, a->norm_b + e * 512, (bf16*)(ws + WS_MIXED), gw, NGW, lane); }
            SEAM(pb + 5);
        }
        if (IN(pb + 6)) REP(6) { ENV;
            pg8::Gemm g{even ? (const bf16*)(ws + WS_MIXED) : (const bf16*)RD, even ? (const bf16*)(ws + WS_WOUT) + (size_t)e * DM * DM : (const bf16*)(ws + WS_WO) + (size_t)e * DM * DM, M, DM, DM};
            pg8::StaticOrder S; S.init(M, DM, G, bid);
            pg8::EpiF32 E{(float*)RA, DM, even ? nullptr : a->b_o + (size_t)e * DM};
            pg8::gemm_phase<pg8::EpiF32, pg8::StaticOrder, true, true>(lds, g, S, E);
        }
        SEAM(pb + 6);
        if (IN(pb + 7)) { ENV; const float* hin = (L == 0) ? a->x : a->out; const float* gains = a->gains + (size_t)L * 4 * DM;
            resid_a_phase((const float*)RA, hin, a->out, gains + DM, gains + 2 * DM, RD, gw, NGW, lane); }
        SEAM(pb + 7);
        if (IN(pb + 8)) REP(8) { ENV;
            pg8::Gemm g{RD, (const bf16*)(ws + WS_WUP) + (size_t)L * FF * DM, M, FF, DM};
            pg8::StaticOrder S; S.init(M, FF, G, bid);
            pg8::EpiBf16<1> E{RC, FF, nullptr, RC, 1 << 30, FF};
            pg8::gemm_phase<pg8::EpiBf16<1>, pg8::StaticOrder, true, true>(lds, g, S, E);
        }
        SEAM(pb + 8);
        if (IN(pb + 9)) REP(9) { ENV;
            pg8::Gemm g{RC, (const bf16*)(ws + WS_WDN) + (size_t)L * DM * FF, M, DM, FF};
            pg8::StaticOrder S; S.init(M, DM, G, bid);
            pg8::EpiF32 E{(float*)RA, DM, nullptr};
            pg8::gemm_phase<pg8::EpiF32, pg8::StaticOrder, true, true>(lds, g, S, E);
        }
        SEAM(pb + 9);
        if (IN(pb + 10)) { ENV; resid_b_phase((const float*)RA, a->out, a->gains + (size_t)L * 4 * DM + 3 * DM, RD, a->p + (size_t)L * M * PLE, RC, gw, NGW, lane, gtid, NGT); }
        SEAM(pb + 10);
        if (IN(pb + 11)) REP(11) { ENV;
            pg8::Gemm g{RC, (const bf16*)(ws + WS_WPLE) + (size_t)L * DM * PLE, M, DM, PLE};
            pg8::StaticOrder S; S.init(M, DM, G, bid);
            pg8::EpiBf16<0> E{RB, DM, nullptr, RB, 1 << 30, DM};
            pg8::gemm_phase<pg8::EpiBf16<0>, pg8::StaticOrder, true, true>(lds, g, S, E);
        }
        SEAM(pb + 11);
        if (IN(pb + 12)) { ENV;
            pg8::Gemm g{RD, (const bf16*)(ws + WS_WG) + (size_t)L * DM * DM, M, DM, DM};
            pg8::StaticOrder S; S.init(M, DM, G, bid);
            pg8::EpiGate E{a->out, RB, DM};
            pg8::gemm_phase<pg8::EpiGate, pg8::StaticOrder, true, true>(lds, g, S, E);
        }
        SEAM(pb + 12);
    }
#undef SCANBUFS
#undef IN
#undef SEAM
#undef ENV
}

extern "C" void kernel_launch(void* const* d_in, const int* in_sizes, int n_in, void* d_out, int out_size, void* d_ws, size_t ws_size, hipStream_t stream) {
    static int grid = 0;
    if (grid == 0) {
        if (n_in != 22 || in_sizes[0] != M * DM || out_size != M * DM || ws_size < WS_END) {
            fprintf(stderr, "kernel_launch: unexpected shapes (n_in %d, in0 %d, out %d, ws %zu; need ws >= %zu); nothing launched\n", n_in, n_in > 0 ? in_sizes[0] : -1, out_size, ws_size, (size_t)WS_END); grid = -1; return; }
        int dev = 0, cus = 0, per_cu = 0;
        if (hipGetDevice(&dev) != hipSuccess || hipDeviceGetAttribute(&cus, hipDeviceAttributeMultiprocessorCount, dev) != hipSuccess) { fprintf(stderr, "kernel_launch: device query failed\n"); grid = -1; return; }
        if (hipFuncSetAttribute((const void*)trunk_fwd, hipFuncAttributeMaxDynamicSharedMemorySize, LDS_BYTES) != hipSuccess) { fprintf(stderr, "kernel_launch: hipFuncSetAttribute failed\n"); grid = -1; return; }
        if (hipOccupancyMaxActiveBlocksPerMultiprocessor(&per_cu, (const void*)trunk_fwd, NTHR, LDS_BYTES) != hipSuccess || per_cu < 1) fprintf(stderr, "kernel_launch: note: occupancy query reports %d\n", per_cu);
        (void)hipGetLastError();
        grid = cus;
    }
    if (grid < 0) return;
    Args a{};
    a.x = (const float*)d_in[0]; a.p = (const float*)d_in[1]; a.pos = (const int*)d_in[2]; a.gains = (const float*)d_in[3]; a.w_in = (const float*)d_in[4]; a.conv = (const float*)d_in[5];
    a.a_log = (const float*)d_in[6]; a.dt_bias = (const float*)d_in[7]; a.norm_a = (const float*)d_in[8]; a.i_bias = (const float*)d_in[9]; a.f_bias = (const float*)d_in[10]; a.norm_b = (const float*)d_in[11];
    a.b_qkv = (const float*)d_in[14]; a.sinks = (const float*)d_in[15]; a.b_o = (const float*)d_in[17];
    a.out = (float*)d_out; a.ws = (unsigned char*)d_ws;
#if defined(PROBE_DUP_MASK)
    a.dup_mask = PROBE_DUP_MASK; a.dup_par = PROBE_DUP_PAR;
#endif
    a.w_out = (const float*)d_in[12]; a.w_qkv = (const float*)d_in[13]; a.w_o = (const float*)d_in[16]; a.w_up = (const float*)d_in[18]; a.w_down = (const float*)d_in[19]; a.w_ple = (const float*)d_in[20]; a.w_gate = (const float*)d_in[21];
#if N_LAUNCH_MODE == 0
    if (hipMemsetAsync((char*)d_ws + WS_CTL, 0, CTL_ZERO_BYTES, stream) != hipSuccess) { fprintf(stderr, "kernel_launch: memset failed\n"); return; }
    a.ph_lo = 0; a.ph_hi = NPHASE;
    hipLaunchKernelGGL(trunk_fwd, dim3(grid), dim3(NTHR), LDS_BYTES, stream, a);
#else
    for (int ph = 0; ph < NPHASE; ++ph) { a.ph_lo = ph; a.ph_hi = ph + 1; hipLaunchKernelGGL(trunk_fwd, dim3(grid), dim3(NTHR), LDS_BYTES, stream, a); }
#endif
    const hipError_t le = hipPeekAtLastError();
    if (le != hipSuccess) fprintf(stderr, "kernel_launch: launch failed: %s\n", hipGetErrorName(le));
}
```

```cpp
#include <hip/hip_runtime.h>
#include <cstdio>
#include <cstdint>
#define N_LAUNCH_MODE 0
namespace pg8 {
#define PG8_LAS __attribute__((address_space(3)))
typedef unsigned short bf16_t;
typedef short bf16x8 __attribute__((ext_vector_type(8)));
typedef float f32x4 __attribute__((ext_vector_type(4)));
typedef unsigned u32x4 __attribute__((ext_vector_type(4)));
constexpr int BM = 256, BK = 64, HALF = 128, HTB = HALF * BK * 2  , STAGE_BYTES = 8 * HTB, NXCD = 8, WGM = 8;

__host__ __device__ __forceinline__ int lds_byte(int r, int c) { const int st = (r >> 4) * 2 + (c >> 5), rr = r & 15, cc = c & 31, ob = rr * 64 + cc * 2; return st * 1024 + (ob ^ (((ob >> 9) & 1) << 5)); }
__host__ __device__ __forceinline__ void stage_rc(int b, int& R, int& C) { const int st = b / 1024, sb = b % 1024, swz = sb ^ (((sb >> 9) & 1) << 5); R = (st >> 1) * 16 + swz / 64; C = (st & 1) * 32 + (swz % 64) / 2; }
__host__ __device__ __forceinline__ int perm32(int rho) { const int n = rho >> 4, i = rho & 15; return 8 * (i >> 2) + 4 * n + (i & 3); }

struct Unit { int pm, pn; };
struct Gemm { const bf16_t* A; const bf16_t* Bt; int M, N, K; };

struct StaticOrder {
    int nM, nN, nwg, G, c;
    __host__ __device__ void init(int M, int N, int G_, int c_) { nM = M / BM; nN = N / BM; nwg = nM * nN; G = G_; c = c_; }
    __host__ __device__ bool next(int i, Unit& u) const {
        const long L = (long)i * G + c; if (L >= nwg) return false;
        int wgid = (int)L; { const int q = nwg / NXCD, r = nwg % NXCD, xcd = wgid % NXCD, off = wgid / NXCD; wgid = (xcd < r ? xcd * (q + 1) : r * (q + 1) + (xcd - r) * q) + off; }
        const int nig = WGM * nN, gid = wgid / nig, fm = gid * WGM, gsz = (nM - fm) < WGM ? (nM - fm) : WGM;
        u.pm = fm + ((wgid % nig) % gsz); u.pn = (wgid % nig) / gsz; return true;
    }
    __device__ __forceinline__ void a_ready(const Unit&) const {}
    __device__ __forceinline__ void done(const Unit&) const {}
};

__device__ __forceinline__ unsigned cvt_pk_bf16(float lo, float hi) { unsigned r; asm volatile("v_cvt_pk_bf16_f32 %0, %1, %2" : "=v"(r) : "v"(lo), "v"(hi)); return r; }
typedef float f32x2 __attribute__((ext_vector_type(2)));
typedef unsigned u32x2 __attribute__((ext_vector_type(2)));

template <int ACT  > struct EpiBf16 {
    static constexpr bool PERM = true, AFTER_DRAIN = false;
    bf16_t* O; int ldc; const float* bias; bf16_t* O2; int split_col, ldc2;
    __device__ __forceinline__ void operator()(const f32x4 (&acc)[2][2][4][2], const Unit& u, int wr, int wc, int fr, int fq) const {
        const int row0 = u.pm * BM + wr * 64 + fr; const int col0 = u.pn * BM + wc * 32 + 8 * fq;
        const bool second = u.pn * BM >= split_col; bf16_t* const ob = second ? O2 : O; const int ld = second ? ldc2 : ldc, oc0 = second ? col0 - split_col : col0;
        f32x4 bv[2][2];
#pragma unroll
        for (int bj = 0; bj < 2; ++bj)
#pragma unroll
            for (int n = 0; n < 2; ++n) bv[bj][n] = bias ? *(const f32x4*)(bias + col0 + bj * HALF + 4 * n) : (f32x4){0.f, 0.f, 0.f, 0.f};
#pragma unroll
        for (int ai = 0; ai < 2; ++ai)
#pragma unroll
            for (int m = 0; m < 4; ++m) { bf16_t* rowp = ob + (size_t)(row0 + ai * HALF + m * 16) * ld + oc0;
#pragma unroll
                for (int bj = 0; bj < 2; ++bj) { f32x4 v0 = acc[ai][bj][m][0] + bv[bj][0], v1 = acc[ai][bj][m][1] + bv[bj][1];
                    if (ACT == 1) {
#pragma unroll
                        for (int i = 0; i < 4; ++i) { const float a = fmaxf(v0[i], 0.f), b = fmaxf(v1[i], 0.f); v0[i] = a * a; v1[i] = b * b; } }
                    u32x4 w; w.x = cvt_pk_bf16(v0[0], v0[1]); w.y = cvt_pk_bf16(v0[2], v0[3]); w.z = cvt_pk_bf16(v1[0], v1[1]); w.w = cvt_pk_bf16(v1[2], v1[3]);
                    *(u32x4*)(rowp + bj * HALF) = w; } }
    }
};
struct EpiF32 {
    static constexpr bool PERM = false, AFTER_DRAIN = false;
    float* C; int ldc; const float* bias;
    __device__ __forceinline__ void operator()(const f32x4 (&acc)[2][2][4][2], const Unit& u, int wr, int wc, int fr, int fq) const {
        const int row0 = u.pm * BM + wr * 64 + fr, col0 = u.pn * BM + wc * 32 + 4 * fq;
        f32x4 bv[2][2];
#pragma unroll
        for (int bj = 0; bj < 2; ++bj)
#pragma unroll
            for (int n = 0; n < 2; ++n) bv[bj][n] = bias ? *(const f32x4*)(bias + col0 + bj * HALF + n * 16) : (f32x4){0.f, 0.f, 0.f, 0.f};
#pragma unroll
        for (int ai = 0; ai < 2; ++ai)
#pragma unroll
            for (int m = 0; m < 4; ++m) { float* rowp = C + (size_t)(row0 + ai * HALF + m * 16) * ldc + col0;
#pragma unroll
                for (int bj = 0; bj < 2; ++bj)
#pragma unroll
                    for (int n = 0; n < 2; ++n) *(f32x4*)(rowp + bj * HALF + n * 16) = acc[ai][bj][m][n] + bv[bj][n]; }
    }
};
__device__ __forceinline__ float bf_lo(unsigned w) { return __builtin_bit_cast(float, w << 16); }
__device__ __forceinline__ float bf_hi(unsigned w) { return __builtin_bit_cast(float, w & 0xffff0000u); }
struct EpiGate {
    static constexpr bool PERM = false, AFTER_DRAIN = false;
    float* H; const bf16_t* PP; int ldc;
    __device__ __forceinline__ void operator()(const f32x4 (&acc)[2][2][4][2], const Unit& u, int wr, int wc, int fr, int fq) const {
        const int row0 = u.pm * BM + wr * 64 + fr, col0 = u.pn * BM + wc * 32 + 4 * fq;
#pragma unroll
        for (int ai = 0; ai < 2; ++ai)
#pragma unroll
            for (int m = 0; m < 4; ++m) { const size_t ro = (size_t)(row0 + ai * HALF + m * 16) * ldc + col0;
#pragma unroll
                for (int bj = 0; bj < 2; ++bj)
#pragma unroll
                    for (int n = 0; n < 2; ++n) { const size_t off = ro + bj * HALF + n * 16;
                        f32x4 hv = *(const f32x4*)(H + off); const u32x2 pv = *(const u32x2*)(PP + off); const f32x4 a = acc[ai][bj][m][n];
                        const float p0 = bf_lo(pv.x), p1 = bf_hi(pv.x), p2 = bf_lo(pv.y), p3 = bf_hi(pv.y);
                        hv[0] += p0 / (1.f + __expf(-a[0])); hv[1] += p1 / (1.f + __expf(-a[1])); hv[2] += p2 / (1.f + __expf(-a[2])); hv[3] += p3 / (1.f + __expf(-a[3]));
                        *(f32x4*)(H + off) = hv; } }
    }
};

template <class Epi, class Sched, bool ALIGN_EPI = false, bool SP2 = false>
__device__ __forceinline__ void gemm_phase(PG8_LAS unsigned char* lds, const Gemm g, const Sched& S, const Epi& E) {
    int tid_l = threadIdx.x; asm volatile("" : "+v"(tid_l));
    const int tid = tid_l, wid = __builtin_amdgcn_readfirstlane(tid >> 6), lane = tid & 63, wr = wid >> 2, wc = wid & 3, fr = lane & 15, fq = lane >> 4;
    const int K = g.K, nt = K / BK;
    unsigned voffA[2], voffB[2];
#pragma unroll
    for (int i = 0; i < 2; ++i) { int R, C; stage_rc(tid * 16 + i * 8192, R, C); const int Rb = Epi::PERM ? ((R & ~31) + perm32(R & 31)) : R;
        voffA[i] = (unsigned)(R * K + C) * 2u; voffB[i] = (unsigned)(Rb * K + C) * 2u; }
    const size_t kstep = (size_t)(BK * 2);
    const size_t hstep = (size_t)HALF * K * 2;
    const size_t tstep = 2 * hstep;
    const unsigned ldsw = (unsigned)wid * 1024u;
    const int aoff = lds_byte(wr * 64 + fr, fq * 8), boff = lds_byte(wc * 32 + fr, fq * 8);
#define PG8_SA(b, h) (((b) * 2 + (h)) * HTB)
#define PG8_SB(b, h) ((4 + (b) * 2 + (h)) * HTB)
#define PG8_STAGE(bufoff, gbase, voff) do { _Pragma("unroll") for (int _i = 0; _i < 2; ++_i) \
        __builtin_amdgcn_global_load_lds((const unsigned*)((const char*)(gbase) + (voff)[_i]), (PG8_LAS unsigned*)(lds + (bufoff) + ldsw + _i * 8192), 16, 0, 0); } while (0)
#define PG8_LDA(dst, b, h) do { _Pragma("unroll") for (int m = 0; m < 4; ++m) _Pragma("unroll") for (int k = 0; k < 2; ++k) dst[m][k] = *(const PG8_LAS bf16x8*)(lds + PG8_SA(b, h) + aoff + m * 2048 + k * 1024); } while (0)
#define PG8_LDB(dst, b, h) do { _Pragma("unroll") for (int n = 0; n < 2; ++n) _Pragma("unroll") for (int k = 0; k < 2; ++k) dst[n][k] = *(const PG8_LAS bf16x8*)(lds + PG8_SB(b, h) + boff + n * 2048 + k * 1024); } while (0)
#define PG8_MMA(ai, bj, At, Bt) do { __builtin_amdgcn_s_setprio(1); _Pragma("unroll") for (int m = 0; m < 4; ++m) _Pragma("unroll") for (int n = 0; n < 2; ++n) _Pragma("unroll") for (int k = 0; k < 2; ++k) \
        acc[ai][bj][m][n] = __builtin_amdgcn_mfma_f32_16x16x32_bf16(Bt[n][k], At[m][k], acc[ai][bj][m][n], 0, 0, 0); __builtin_amdgcn_s_setprio(0); } while (0)
#define PG8_WAIT_V(n) asm volatile("s_waitcnt vmcnt(" #n ")" ::: "memory")
#define PG8_WAIT_L(n) asm volatile("s_waitcnt lgkmcnt(" #n ")" ::: "memory")
#define PG8_BAR __builtin_amdgcn_s_barrier()
#define PG8_SCHED __builtin_amdgcn_sched_barrier(0)
    Unit cur, nxt; int ui = 0;
    if (!S.next(0, cur)) return;
    f32x4 acc[2][2][4][2];
#pragma unroll
    for (int a = 0; a < 2; ++a)
#pragma unroll
        for (int b = 0; b < 2; ++b)
#pragma unroll
            for (int m = 0; m < 4; ++m)
#pragma unroll
                for (int n = 0; n < 2; ++n) acc[a][b][m][n] = (f32x4){0.f, 0.f, 0.f, 0.f};
    bf16x8 At[4][2], B0[2][2], B1[2][2];
    const char* cA = (const char*)g.A + (size_t)cur.pm * tstep; const char* cB = (const char*)g.Bt + (size_t)cur.pn * tstep;
    S.a_ready(cur);
    if constexpr (SP2) {
        PG8_STAGE(PG8_SB(0, 0), cB, voffB); PG8_STAGE(PG8_SB(0, 1), cB + hstep, voffB); PG8_STAGE(PG8_SA(0, 0), cA, voffA); PG8_STAGE(PG8_SA(0, 1), cA + hstep, voffA);
        if (wr == 1) PG8_BAR;
        PG8_WAIT_V(2); PG8_BAR;
        PG8_STAGE(PG8_SB(1, 0), cB + kstep, voffB); PG8_STAGE(PG8_SA(1, 0), cA + kstep, voffA); PG8_STAGE(PG8_SB(1, 1), cB + hstep + kstep, voffB);
        PG8_WAIT_V(6); PG8_BAR;
    } else {
        PG8_STAGE(PG8_SB(0, 0), cB, voffB); PG8_STAGE(PG8_SA(0, 0), cA, voffA); PG8_STAGE(PG8_SB(0, 1), cB + hstep, voffB); PG8_STAGE(PG8_SA(0, 1), cA + hstep, voffA);
        if (wr == 1) PG8_BAR;
        PG8_WAIT_V(4); PG8_BAR;
        PG8_STAGE(PG8_SB(1, 0), cB + kstep, voffB); PG8_STAGE(PG8_SA(1, 0), cA + kstep, voffA); PG8_STAGE(PG8_SB(1, 1), cB + hstep + kstep, voffB);
        PG8_WAIT_V(6); PG8_BAR;
    }
    for (;;) {
        const bool has_next = S.next(ui + 1, nxt);
        const char* nA = has_next ? (const char*)g.A + (size_t)nxt.pm * tstep : cA; const char* nB = has_next ? (const char*)g.Bt + (size_t)nxt.pn * tstep : cB;
        for (int t = 0; t < nt; t += 2) {
            const bool last = (t == nt - 2);
            const char* a1 = cA + (size_t)(t + 1) * kstep;
            const char* a2 = last ? nA : cA + (size_t)(t + 2) * kstep; const char* b2 = last ? nB : cB + (size_t)(t + 2) * kstep;
            const char* a3 = a2 + kstep; const char* b3 = b2 + kstep;
            if (last && has_next) S.a_ready(nxt);
            if constexpr (SP2) {
            PG8_LDB(B0, 0, 0); PG8_LDB(B1, 0, 1); PG8_SCHED; PG8_LDA(At, 0, 0); PG8_STAGE(PG8_SA(1, 1), a1 + hstep, voffA);
            PG8_WAIT_V(8); PG8_WAIT_L(0); PG8_BAR; PG8_MMA(0, 0, At, B0); PG8_MMA(0, 1, At, B1); PG8_BAR; PG8_SCHED;
            PG8_LDA(At, 0, 1); PG8_STAGE(PG8_SB(0, 0), b2, voffB); PG8_STAGE(PG8_SB(0, 1), b2 + hstep, voffB); PG8_STAGE(PG8_SA(0, 0), a2, voffA);
            PG8_WAIT_V(8); PG8_WAIT_L(0); PG8_BAR; PG8_MMA(1, 0, At, B0); PG8_MMA(1, 1, At, B1); PG8_BAR; PG8_SCHED;
            PG8_LDB(B0, 1, 0); PG8_LDB(B1, 1, 1); PG8_SCHED; PG8_LDA(At, 1, 0); PG8_STAGE(PG8_SA(0, 1), a2 + hstep, voffA);
            PG8_WAIT_V(8); PG8_WAIT_L(0); PG8_BAR; PG8_MMA(0, 0, At, B0); PG8_MMA(0, 1, At, B1); PG8_BAR; PG8_SCHED;
            PG8_LDA(At, 1, 1); PG8_STAGE(PG8_SB(1, 0), b3, voffB); PG8_STAGE(PG8_SB(1, 1), b3 + hstep, voffB); PG8_STAGE(PG8_SA(1, 0), a3, voffA);
            PG8_WAIT_V(8); PG8_WAIT_L(0); PG8_BAR; PG8_MMA(1, 0, At, B0); PG8_MMA(1, 1, At, B1); PG8_BAR; PG8_SCHED;
            } else {
            PG8_LDB(B0, 0, 0); PG8_SCHED; PG8_LDA(At, 0, 0); PG8_STAGE(PG8_SA(1, 1), a1 + hstep, voffA);
            PG8_WAIT_L(8); PG8_BAR; PG8_WAIT_L(0); PG8_MMA(0, 0, At, B0); PG8_BAR; PG8_SCHED;
            PG8_LDB(B1, 0, 1); PG8_STAGE(PG8_SB(0, 0), b2, voffB);
            PG8_BAR; PG8_WAIT_L(0); PG8_MMA(0, 1, At, B1); PG8_BAR;
            PG8_LDA(At, 0, 1); PG8_STAGE(PG8_SA(0, 0), a2, voffA);
            PG8_BAR; PG8_WAIT_L(0); PG8_MMA(1, 0, At, B0); PG8_BAR; PG8_SCHED;
            PG8_STAGE(PG8_SB(0, 1), b2 + hstep, voffB);
            PG8_WAIT_V(6); PG8_BAR; PG8_MMA(1, 1, At, B1); PG8_BAR;
            PG8_LDB(B0, 1, 0); PG8_SCHED; PG8_LDA(At, 1, 0); PG8_STAGE(PG8_SA(0, 1), a2 + hstep, voffA);
            PG8_WAIT_L(8); PG8_BAR; PG8_WAIT_L(0); PG8_MMA(0, 0, At, B0); PG8_BAR; PG8_SCHED;
            PG8_LDB(B1, 1, 1); PG8_STAGE(PG8_SB(1, 0), b3, voffB);
            PG8_BAR; PG8_WAIT_L(0); PG8_MMA(0, 1, At, B1); PG8_BAR;
            PG8_LDA(At, 1, 1); PG8_STAGE(PG8_SA(1, 0), a3, voffA);
            PG8_BAR; PG8_WAIT_L(0); PG8_MMA(1, 0, At, B0); PG8_BAR; PG8_SCHED;
            PG8_STAGE(PG8_SB(1, 1), b3 + hstep, voffB);
            PG8_WAIT_V(6); PG8_BAR; PG8_MMA(1, 1, At, B1); PG8_BAR;
            }
        }
        if constexpr (ALIGN_EPI) { if (wr == 0) PG8_BAR; }
        if constexpr (!Epi::AFTER_DRAIN) { E(acc, cur, wr, wc, fr, fq); S.done(cur); }
        if (!has_next) break;
#pragma unroll
        for (int a = 0; a < 2; ++a)
#pragma unroll
            for (int b = 0; b < 2; ++b)
#pragma unroll
                for (int m = 0; m < 4; ++m)
#pragma unroll
                    for (int n = 0; n < 2; ++n) acc[a][b][m][n] = (f32x4){0.f, 0.f, 0.f, 0.f};
        cur = nxt; cA = nA; cB = nB; ++ui;
        if constexpr (ALIGN_EPI) { if (wr == 1) PG8_BAR; }
    }
    PG8_WAIT_V(0);
    if constexpr (!ALIGN_EPI) { if (wr == 0) PG8_BAR; }
    PG8_BAR;
    if constexpr (Epi::AFTER_DRAIN) { E.fused(acc, cur, wr, wc, fr, fq, lds, wid, lane); S.done(cur); }
#undef PG8_SA
#undef PG8_SB
#undef PG8_STAGE
#undef PG8_LDA
#undef PG8_LDB
#undef PG8_MMA
#undef PG8_WAIT_V
#undef PG8_WAIT_L
#undef PG8_BAR
#undef PG8_SCHED
}
}
constexpr int BATCH = 32, SEQ = 2048, DM = 1024, DEPTH = 4, M = BATCH * SEQ;
constexpr int FF = 4096, PLE = 256, NIN = 4112;
constexpr float EPS = 1e-6f;
constexpr int NWAVES = 8, NTHR = NWAVES * 64;
constexpr int PH_PER_LAYER = 13, NPHASE = 1 + DEPTH * PH_PER_LAYER;
constexpr size_t MiB = 1u << 20;
constexpr size_t WS_CTL = 0, CTL_ZERO_BYTES = 1 * MiB;
constexpr size_t WS_WIN = 1 * MiB, WS_WOUT = 17 * MiB, WS_WQKV = 21 * MiB, WS_WO = 27 * MiB, WS_WUP = 31 * MiB, WS_WDN = 63 * MiB, WS_WPLE = 95 * MiB, WS_WG = 97 * MiB;
constexpr size_t WS_WGATES = 105 * MiB, WS_GT = 106 * MiB, WS_ROPE = 110 * MiB;
constexpr size_t WS_DEN = 126 * MiB;
constexpr size_t WS_RA = 128 * MiB, WS_RB = 256 * MiB, WS_RC = 384 * MiB, WS_RD = 896 * MiB, WS_END = 1024 * MiB;
constexpr size_t WS_QKVA = 128 * MiB, WS_KWT = 320 * MiB, WS_X1 = 384 * MiB, WS_KT = 384 * MiB, WS_UT = 448 * MiB, WS_NW = 512 * MiB, WS_X2 = 576 * MiB, WS_VT = 896 * MiB, WS_ATT = 960 * MiB, WS_PT = 992 * MiB, WS_MIXED = 384 * MiB;
constexpr int CW_BAR = 4096;
constexpr int RING_BYTES = 131072, MISC_OFF = RING_BYTES, LDS_BYTES = RING_BYTES + 1024;

#define GAS __attribute__((address_space(1)))
#define LAS __attribute__((address_space(3)))
typedef unsigned short bf16;
typedef float f32x4 __attribute__((ext_vector_type(4)));
typedef float f32x2 __attribute__((ext_vector_type(2)));
typedef unsigned u32x4 __attribute__((ext_vector_type(4)));
typedef unsigned u32x2 __attribute__((ext_vector_type(2)));
#define LDS_WAIT() asm volatile("s_waitcnt lgkmcnt(0)" ::: "memory")
#define VM_WAIT() asm volatile("s_waitcnt vmcnt(0)" ::: "memory")
using pg8::bf_lo; using pg8::bf_hi;
typedef __bf16 bf16x2_t __attribute__((ext_vector_type(2)));
__device__ __forceinline__ unsigned pk2(float lo, float hi) { return pg8::cvt_pk_bf16(lo, hi); }
__device__ __forceinline__ unsigned pk2v(float lo, float hi) { const f32x2 v = {lo, hi}; const bf16x2_t b = __builtin_convertvector(v, bf16x2_t); return __builtin_bit_cast(unsigned, b); }
__device__ __forceinline__ float wave_sum(float v) {
#pragma unroll
    for (int o = 1; o < 64; o <<= 1) v += __shfl_xor(v, o);
    return v;
}
__device__ __forceinline__ float dot4(f32x4 a, f32x4 b) { return (a.x * b.x + a.y * b.y) + (a.z * b.z + a.w * b.w); }
__device__ __forceinline__ float sigmoid_f(float x) { return 1.f / (1.f + __expf(-x)); }
__device__ __forceinline__ float softplus_f(float x) { return x > 20.f ? x : log1pf(expf(x)); }

#define XB_TMO      128
#define XB_XCNT(j)  (256  + 64 * (j))
#define XB_XSUB(j)  (1280 + 64 * (j))
#define XB_XGEN(j)  (2304 + 64 * (j))
#define XB_TOP      3328
#define XB_TOPGEN   3392
#define XCD_BAR_WORDS 3456
#define XB_SPIN_CAP (1u << 18)

__device__ __forceinline__ unsigned xb_ld(unsigned* p)              { return __hip_atomic_load(p, __ATOMIC_RELAXED, __HIP_MEMORY_SCOPE_AGENT); }
__device__ __forceinline__ unsigned xb_add(unsigned* p, unsigned v) { return __hip_atomic_fetch_add(p, v, __ATOMIC_RELAXED, __HIP_MEMORY_SCOPE_AGENT); }
__device__ __forceinline__ unsigned xb_xcc_id() { return (unsigned)__builtin_amdgcn_s_getreg((3 << 11) | 20) & 0xFu; }
#define XB_SPIN(cond, bar) do { unsigned _sp = 0; while (cond) { __builtin_amdgcn_s_sleep(1); \
    if ((++_sp & 255u) == 0u) { if (xb_ld(&(bar)[XB_TMO])) break; if (_sp > XB_SPIN_CAP) { atomicAdd(&(bar)[XB_TMO], 1u); break; } } } } while (0)

struct XcdBarrier {
    unsigned* bar; unsigned x;
    volatile LAS unsigned* st;
};

__device__ __forceinline__ XcdBarrier xcd_barrier_post(unsigned* bar, volatile LAS unsigned* st) {
    XcdBarrier b; b.bar = bar; b.x = xb_xcc_id(); b.st = st;
    if (threadIdx.x == 0) (void)xb_add(&bar[XB_XCNT(b.x)], 1u);
    return b;
}
__device__ __forceinline__ void xcd_barrier_complete(unsigned* bar, unsigned x, unsigned& nloc, unsigned& nx) {
    const unsigned G = gridDim.x * gridDim.y * gridDim.z;
    unsigned sum, cnt, mine, sp = 0u;
    for (;;) {
        sum = 0u; cnt = 0u; mine = 0u;
#pragma unroll
        for (unsigned j = 0; j < 16; ++j) { const unsigned c = xb_ld(&bar[XB_XCNT(j)]); sum += c; cnt += (c > 0u) ? 1u : 0u; mine = (j == x) ? c : mine; }
        if (sum == G) break;
        __builtin_amdgcn_s_sleep(1);
        if ((++sp & 255u) == 0u) { if (xb_ld(&bar[XB_TMO])) break; if (sp > XB_SPIN_CAP) { atomicAdd(&bar[XB_TMO], 1u); break; } }
    }
    nloc = mine > 0u ? mine : 1u; nx = cnt > 0u ? cnt : 1u;
}

__device__ __forceinline__ void xcd_barrier(const XcdBarrier& b) {
    asm volatile("s_waitcnt vmcnt(0)" ::: "memory");
    __syncthreads();
    if (threadIdx.x == 0) {
        unsigned* bar = b.bar;
        __builtin_amdgcn_s_waitcnt(0);
        unsigned nloc = b.st[0], nx = b.st[1];
        if (nloc == 0u) { xcd_barrier_complete(bar, b.x, nloc, nx); b.st[0] = nloc; b.st[1] = nx; }
        const unsigned old = xb_add(&bar[XB_XSUB(b.x)], 1u);
        const unsigned gen = old / nloc;
        if (old + 1u == (gen + 1u) * nloc) {
            __builtin_amdgcn_fence(__ATOMIC_RELEASE, "agent");
            asm volatile("s_waitcnt vmcnt(0)" ::: "memory");
            const unsigned og = xb_add(&bar[XB_TOP], 1u);
            const unsigned tg = og / nx;
            if (og + 1u == (tg + 1u) * nx) xb_add(&bar[XB_TOPGEN], 1u);
            else XB_SPIN(xb_ld(&bar[XB_TOPGEN]) == tg, bar);
            __builtin_amdgcn_fence(__ATOMIC_ACQUIRE, "agent");
            xb_add(&bar[XB_XGEN(b.x)], 1u);
            asm volatile("s_waitcnt vmcnt(0)" ::: "memory");
        } else {
            XB_SPIN(xb_ld(&bar[XB_XGEN(b.x)]) == gen, bar);
            __builtin_amdgcn_fence(__ATOMIC_ACQUIRE, "agent");
            asm volatile("s_waitcnt vmcnt(0)" ::: "memory");
        }
    }
    __syncthreads();
}
struct Args {
    const float *x, *p; const int* pos; const float *gains, *w_in, *conv, *a_log, *dt_bias, *norm_a, *i_bias, *f_bias, *norm_b, *w_out, *w_qkv, *b_qkv, *sinks, *w_o, *b_o, *w_up, *w_down, *w_ple, *w_gate;
    float* out; unsigned char* ws;
    int ph_lo, ph_hi, dup_mask, dup_par;
};

__device__ __forceinline__ void transpose_item(const float* src, int ld, int K, bf16* dst, LAS float* scr, int item, int nblk, int lane) {
    const int kb = item / nblk, nb = item % nblk, k0 = 64 * kb, n0 = 32 * nb;
#pragma unroll 8
    for (int i = 0; i < 32; ++i) { const int kk = 2 * i + (lane >> 5); scr[kk * 33 + (lane & 31)] = src[(size_t)(k0 + kk) * ld + n0 + (lane & 31)]; }
    LDS_WAIT(); asm volatile("" ::: "memory");
    const int c = lane & 7;
#pragma unroll
    for (int j = 0; j < 4; ++j) { const int n = (lane >> 3) + 8 * j; const LAS float* s = scr + (8 * c) * 33 + n;
        u32x4 o; o.x = pk2(s[0 * 33], s[1 * 33]); o.y = pk2(s[2 * 33], s[3 * 33]); o.z = pk2(s[4 * 33], s[5 * 33]); o.w = pk2(s[6 * 33], s[7 * 33]);
        *(u32x4*)(dst + (size_t)(n0 + n) * K + k0 + 8 * c) = o; }
    LDS_WAIT(); asm volatile("" ::: "memory");
}
__device__ __forceinline__ int gate_col(int c) { return c < 8 ? 1536 + c : 3592 + (c - 8); }

typedef const __attribute__((address_space(4))) Args* KArgs;
__device__ __forceinline__ KArgs kargs() { KArgs p = (KArgs)__builtin_amdgcn_kernarg_segment_ptr(); asm volatile("" : "+s"(p)); return p; }
__device__ __forceinline__ int fresh_tid() { int t = threadIdx.x; asm volatile("" : "+v"(t)); return t; }
__device__ __forceinline__ void prologue_phase(KArgs a, LAS unsigned char* lds, int gw, int NGW, int wave, int lane, int gtid, int NGT) {
    LAS float* scr = (LAS float*)(lds + wave * 16384);
    constexpr int I_IN = 16 * 16, I_SQ = 16 * 32, I_QKV = 16 * 48, I_UP = 16 * 128, I_DN = 64 * 32, I_PLE = 4 * 32;
    constexpr int NITEMS = 16 * I_IN + 2 * I_SQ + 2 * I_QKV + 2 * I_SQ + 4 * I_UP + 4 * I_DN + 4 * I_PLE + 4 * I_SQ;
    unsigned char* ws = a->ws;
    for (int it = gw; it < NITEMS; it += NGW) {
        int r = it;
        if (r < 16 * I_IN) { const int j = r / I_IN, e = j >> 3, s = j & 7, col0 = 512 * s + (s >= 3 ? 8 : 0) + (s >= 7 ? 8 : 0);
            transpose_item(a->w_in + (size_t)e * DM * NIN + col0, NIN, DM, (bf16*)(ws + WS_WIN) + ((size_t)e * 4096 + s * 512) * DM, scr, r % I_IN, 16, lane); continue; } r -= 16 * I_IN;
        if (r < 2 * I_SQ) { const int e = r / I_SQ; transpose_item(a->w_out + (size_t)e * DM * DM, DM, DM, (bf16*)(ws + WS_WOUT) + (size_t)e * DM * DM, scr, r % I_SQ, 32, lane); continue; } r -= 2 * I_SQ;
        if (r < 2 * I_QKV) { const int e = r / I_QKV; transpose_item(a->w_qkv + (size_t)e * DM * 1536, 1536, DM, (bf16*)(ws + WS_WQKV) + (size_t)e * 1536 * DM, scr, r % I_QKV, 48, lane); continue; } r -= 2 * I_QKV;
        if (r < 2 * I_SQ) { const int e = r / I_SQ; transpose_item(a->w_o + (size_t)e * DM * DM, DM, DM, (bf16*)(ws + WS_WO) + (size_t)e * DM * DM, scr, r % I_SQ, 32, lane); continue; } r -= 2 * I_SQ;
        if (r < 4 * I_UP) { const int l = r / I_UP; transpose_item(a->w_up + (size_t)l * DM * FF, FF, DM, (bf16*)(ws + WS_WUP) + (size_t)l * FF * DM, scr, r % I_UP, 128, lane); continue; } r -= 4 * I_UP;
        if (r < 4 * I_DN) { const int l = r / I_DN; transpose_item(a->w_down + (size_t)l * FF * DM, DM, FF, (bf16*)(ws + WS_WDN) + (size_t)l * DM * FF, scr, r % I_DN, 32, lane); continue; } r -= 4 * I_DN;
        if (r < 4 * I_PLE) { const int l = r / I_PLE; transpose_item(a->w_ple + (size_t)l * PLE * DM, DM, PLE, (bf16*)(ws + WS_WPLE) + (size_t)l * DM * PLE, scr, r % I_PLE, 32, lane); continue; } r -= 4 * I_PLE;
        { const int l = r / I_SQ; transpose_item(a->w_gate + (size_t)l * DM * DM, DM, DM, (bf16*)(ws + WS_WG) + (size_t)l * DM * DM, scr, r % I_SQ, 32, lane); }
    }
    float* Wg = (float*)(a->ws + WS_WGATES);
    for (int i = gtid; i < 2 * 16 * 1024; i += NGT) { const int e = i >> 14, c = (i >> 10) & 15, k = i & 1023; Wg[i] = a->w_in[((size_t)e * 1024 + k) * NIN + gate_col(c)]; }
    f32x2* rope = (f32x2*)(a->ws + WS_ROPE);
    for (int i = gtid; i < M * 32; i += NGT) { const int m = i >> 5, d = i & 31;
        const float inv = (float)pow(10000.0, -(double)d / 32.0); const float ang = (float)a->pos[m] * inv; float sn, cs; sincosf(ang, &sn, &cs); rope[i] = (f32x2){cs, sn}; }
}

__device__ __forceinline__ void norm_phase(LAS unsigned char* lds, const float* hin, const float* g0, bf16* HN, bool even, const float* Wg, float* Gt, int gw, int NGW, int tid, int lane) {
    LAS f32x4* wl = (LAS f32x4*)lds;
    if (even) { for (int i = tid; i < 4096; i += NTHR) wl[i] = ((const f32x4*)Wg)[i]; __syncthreads(); }
    f32x4 gv[4];
#pragma unroll
    for (int j = 0; j < 4; ++j) gv[j] = ((const f32x4*)g0)[lane + 64 * j];
    for (int m = gw; m < M; m += NGW) {
        const f32x4* xr = (const f32x4*)(hin + (size_t)m * DM) + lane;
        f32x4 v[4]; float s = 0.f;
#pragma unroll
        for (int j = 0; j < 4; ++j) { v[j] = xr[64 * j]; s += dot4(v[j], v[j]); }
        const float rstd = rsqrtf(wave_sum(s) * (1.f / DM) + EPS);
        u32x2* o8 = (u32x2*)(HN + (size_t)m * DM) + lane;
#pragma unroll
        for (int j = 0; j < 4; ++j) { v[j] = v[j] * rstd * gv[j]; o8[64 * j] = (u32x2){pk2(v[j].x, v[j].y), pk2(v[j].z, v[j].w)}; }
        if (even) {
            float keep = 0.f;
#pragma unroll
            for (int c = 0; c < 16; ++c) { float d = 0.f;
#pragma unroll
                for (int j = 0; j < 4; ++j) d += dot4(v[j], wl[c * 256 + lane + 64 * j]);
                d = wave_sum(d); if (lane == c) keep = d; }
            if (lane < 16) Gt[(size_t)m * 16 + lane] = keep;
        }
    }
    if (even) __syncthreads();
}
__device__ __forceinline__ void resid_a_phase(const float* mix, const float* hin, float* out, const float* g1, const float* g2, bf16* HN, int gw, int NGW, int lane) {
    f32x4 ga[4], gb[4];
#pragma unroll
    for (int j = 0; j < 4; ++j) { ga[j] = ((const f32x4*)g1)[lane + 64 * j]; gb[j] = ((const f32x4*)g2)[lane + 64 * j]; }
    for (int m = gw; m < M; m += NGW) {
        const f32x4* xr = (const f32x4*)(mix + (size_t)m * DM) + lane; const f32x4* hr = (const f32x4*)(hin + (size_t)m * DM) + lane;
        f32x4 v[4], h[4]; float s = 0.f;
#pragma unroll
        for (int j = 0; j < 4; ++j) { v[j] = xr[64 * j]; h[j] = hr[64 * j]; s += dot4(v[j], v[j]); }
        const float r1 = rsqrtf(wave_sum(s) * (1.f / DM) + EPS); float s2 = 0.f;
        f32x4* orow = (f32x4*)(out + (size_t)m * DM) + lane;
#pragma unroll
        for (int j = 0; j < 4; ++j) { h[j] = h[j] + v[j] * r1 * ga[j]; orow[64 * j] = h[j]; s2 += dot4(h[j], h[j]); }
        const float r2 = rsqrtf(wave_sum(s2) * (1.f / DM) + EPS);
        u32x2* o8 = (u32x2*)(HN + (size_t)m * DM) + lane;
#pragma unroll
        for (int j = 0; j < 4; ++j) { const f32x4 y = h[j] * r2 * gb[j]; o8[64 * j] = (u32x2){pk2(y.x, y.y), pk2(y.z, y.w)}; }
    }
}
__device__ __forceinline__ void resid_b_phase(const float* ff, float* out, const float* g3, bf16* HB, const float* pl, bf16* PB, int gw, int NGW, int lane, int gtid, int NGT) {
    f32x4 ga[4];
#pragma unroll
    for (int j = 0; j < 4; ++j) ga[j] = ((const f32x4*)g3)[lane + 64 * j];
    for (int m = gw; m < M; m += NGW) {
        const f32x4* xr = (const f32x4*)(ff + (size_t)m * DM) + lane; f32x4* hr = (f32x4*)(out + (size_t)m * DM) + lane;
        f32x4 v[4], h[4]; float s = 0.f;
#pragma unroll
        for (int j = 0; j < 4; ++j) { v[j] = xr[64 * j]; h[j] = hr[64 * j]; s += dot4(v[j], v[j]); }
        const float r1 = rsqrtf(wave_sum(s) * (1.f / DM) + EPS);
        u32x2* o8 = (u32x2*)(HB + (size_t)m * DM) + lane;
#pragma unroll
        for (int j = 0; j < 4; ++j) { h[j] = h[j] + v[j] * r1 * ga[j]; hr[64 * j] = h[j]; o8[64 * j] = (u32x2){pk2(h[j].x, h[j].y), pk2(h[j].z, h[j].w)}; }
    }
    for (int i = gtid; i < M * PLE / 8; i += NGT) { const f32x4 a = ((const f32x4*)pl)[2 * i], b = ((const f32x4*)pl)[2 * i + 1];
        ((u32x4*)PB)[i] = (u32x4){pk2(a.x, a.y), pk2(a.z, a.w), pk2(b.x, b.y), pk2(b.z, b.w)}; }
}
__device__ __forceinline__ void conv_phase(const bf16* BIG, const float* convw  , bf16* QKVA, int gw, int NGW, int lane) {
    for (int m = gw; m < M; m += NGW) {
        const int s = m & (SEQ - 1);
#pragma unroll
        for (int j = 0; j < 3; ++j) {
            const int col = j * 512 + lane * 8; float acc[8];
#pragma unroll
            for (int i = 0; i < 8; ++i) acc[i] = 0.f;
#pragma unroll
            for (int kk = 0; kk < 4; ++kk) if (s - 3 + kk >= 0) {
                const u32x4 xv = *(const u32x4*)(BIG + (size_t)(m - 3 + kk) * 1536 + col); const f32x4 w0 = *(const f32x4*)(convw + kk * 1536 + col), w1 = *(const f32x4*)(convw + kk * 1536 + col + 4);
                acc[0] += bf_lo(xv.x) * w0.x; acc[1] += bf_hi(xv.x) * w0.y; acc[2] += bf_lo(xv.y) * w0.z; acc[3] += bf_hi(xv.y) * w0.w;
                acc[4] += bf_lo(xv.z) * w1.x; acc[5] += bf_hi(xv.z) * w1.y; acc[6] += bf_lo(xv.w) * w1.z; acc[7] += bf_hi(xv.w) * w1.w; }
            float ss = 0.f;
#pragma unroll
            for (int i = 0; i < 8; ++i) { acc[i] = acc[i] / (1.f + __expf(-acc[i])); ss += acc[i] * acc[i]; }
            if (j < 2) { ss += __shfl_xor(ss, 1); ss += __shfl_xor(ss, 2); ss += __shfl_xor(ss, 4); ss += __shfl_xor(ss, 8);
                const float sc = rsqrtf(ss + EPS) * (j == 0 ? 0.08838834764831845f : 1.f);
#pragma unroll
                for (int i = 0; i < 8; ++i) acc[i] *= sc; }
            *(u32x4*)(QKVA + (size_t)m * 1536 + col) = (u32x4){pk2(acc[0], acc[1]), pk2(acc[2], acc[3]), pk2(acc[4], acc[5]), pk2(acc[6], acc[7])};
        }
    }
}
__device__ __forceinline__ void rope_phase(bf16* QKV, const f32x2* rope, int gw, int NGW, int lane) {
    for (int m = gw; m < M; m += NGW) {
        const int grp = lane & 7; const f32x4* tb = (const f32x4*)(rope + (size_t)m * 32 + grp * 4); const f32x4 t0 = tb[0], t1 = tb[1];
        const float cs[4] = {t0.x, t0.z, t1.x, t1.z}, sn[4] = {t0.y, t0.w, t1.y, t1.w};
#pragma unroll
        for (int k = 0; k < 3; ++k) {
            if (k == 2 && lane >= 32) break;
            const int hh = (k < 2) ? ((lane + 64 * k) >> 3) : (lane >> 3); const float scale = (k < 2) ? 0.125f : 1.f;
            bf16* base = QKV + (size_t)m * 1536 + (k < 2 ? 0 : 1024) + hh * 64 + grp * 4;
            const u32x2 a = *(const u32x2*)base, b = *(const u32x2*)(base + 32);
            const float x1[4] = {bf_lo(a.x), bf_hi(a.x), bf_lo(a.y), bf_hi(a.y)}, x2[4] = {bf_lo(b.x), bf_hi(b.x), bf_lo(b.y), bf_hi(b.y)};
            float o1[4], o2[4];
#pragma unroll
            for (int i = 0; i < 4; ++i) { o1[i] = (x1[i] * cs[i] - x2[i] * sn[i]) * scale; o2[i] = (x2[i] * cs[i] + x1[i] * sn[i]) * scale; }
            *(u32x2*)base = (u32x2){pk2(o1[0], o1[1]), pk2(o1[2], o1[3])}; *(u32x2*)(base + 32) = (u32x2){pk2(o2[0], o2[1]), pk2(o2[2], o2[3])};
        }
    }
}
typedef short bf16x8 __attribute__((ext_vector_type(8)));
#define MFMA16(a, b, c) __builtin_amdgcn_mfma_f32_16x16x32_bf16(a, b, c, 0, 0, 0)
__device__ __forceinline__ bf16x8 pack8(f32x4 a, f32x4 b) { const u32x4 w = {pk2v(a.x, a.y), pk2v(a.z, a.w), pk2v(b.x, b.y), pk2v(b.z, b.w)}; return __builtin_bit_cast(bf16x8, w); }
__device__ __forceinline__ float bf2f(unsigned short v) { return __builtin_bit_cast(float, (unsigned)v << 16); }
__device__ __forceinline__ float rdlane(float v, int i) { return __builtin_bit_cast(float, __builtin_amdgcn_readlane(__builtin_bit_cast(int, v), i)); }
__device__ __forceinline__ float scan_add(float v, int lane) {
#pragma unroll
    for (int o = 1; o < 64; o <<= 1) { const float t = __shfl_up(v, o); if (lane >= o) v += t; }
    return v; }
__device__ __forceinline__ float scan_max(float v, int lane) {
#pragma unroll
    for (int o = 1; o < 64; o <<= 1) { const float t = __shfl_up(v, o); if (lane >= o) v = fmaxf(v, t); }
    return v; }
__device__ __forceinline__ int kperm(int ks, int q, int jj) { return 32 * ks + (jj < 4 ? 4 * q + jj : 16 + 4 * q + jj - 4); }
template <bool SCALE> __device__ __forceinline__ u32x4 tr_gather(const bf16* src  , int ld, int ks, int q, float esc_lane) {
    unsigned w[4];
#pragma unroll
    for (int j2 = 0; j2 < 4; ++j2) { const int r0 = kperm(ks, q, 2 * j2), r1 = r0 + 1; const unsigned short a = src[(size_t)r0 * ld], b = src[(size_t)r1 * ld];
        if (SCALE) { const float s0 = __shfl(esc_lane, r0), s1 = __shfl(esc_lane, r1); w[j2] = pk2(bf2f(a) * s0, bf2f(b) * s1); } else w[j2] = (unsigned)a | ((unsigned)b << 16); }
    return (u32x4){w[0], w[1], w[2], w[3]};
}
struct ScanBufs {
    bf16* QKVA;
    bf16* X2;
    float* Gt;
    bf16 *KT, *UT, *NW, *ATT;
    bf16 *KWT, *VT, *PT;
    float* DEN;
};
__device__ __forceinline__ void local_phase(LAS unsigned char* lds, const ScanBufs sb, const float* a_log, const float* dt_bias, const float* i_bias, const float* f_bias, int gw, int NGW, int wave, int lane) {
    LAS float* Lw = (LAS float*)(lds + wave * 16384);
    const int njobs = 2 * BATCH * 4 * (SEQ / 64), per = (njobs + NGW - 1) / NGW; const int lane_in = lane;
#pragma unroll 1
    for (int rj = 0; rj < per; ++rj) {
        const int job = gw * per + rj; if (job >= njobs) break;
        int lane = lane_in; asm volatile("" : "+v"(lane));
        const int x = lane & 15, q = lane >> 4;
        const int mixer = job & 1, cidx = job >> 1, c = cidx & 31, h = (cidx >> 5) & 3, b = cidx >> 7;
        const int m0 = b * SEQ + c * 64; const size_t cid = (size_t)cidx;
        float* gr = sb.Gt + (size_t)(m0 + lane) * 16;
        if (mixer == 0) {
            const float beta = 1.f / (1.f + expf(-gr[h])); const float g = -expf(a_log[h]) * softplus_f(gr[4 + h] + dt_bias[h]);
            const float gcum = scan_add(g, lane), eg = expf(gcum), glast = __shfl(gcum, 63);
            const bf16* kb = sb.QKVA + (size_t)m0 * 1536 + 512 + h * 128; const bf16* qb = sb.QKVA + (size_t)m0 * 1536 + h * 128; const bf16* vb = kb + 512;
            bf16x8 Kf[4][4], Qf[4][4];
#pragma unroll
            for (int t = 0; t < 4; ++t)
#pragma unroll
                for (int ks = 0; ks < 4; ++ks) { Kf[t][ks] = *(const bf16x8*)(kb + (size_t)(16 * t + x) * 1536 + 32 * ks + 8 * q); Qf[t][ks] = *(const bf16x8*)(qb + (size_t)(16 * t + x) * 1536 + 32 * ks + 8 * q); }
            float gj[4][4];
#pragma unroll
            for (int jt = 0; jt < 4; ++jt)
#pragma unroll
                for (int r = 0; r < 4; ++r) gj[jt][r] = __shfl(gcum, 16 * jt + 4 * q + r);
            bf16* attp = sb.ATT + cid * 4096;
#pragma unroll
            for (int it = 0; it < 4; ++it) {
                const float gi = __shfl(gcum, 16 * it + x), bi = __shfl(beta, 16 * it + x); f32x4 d2s[4];
#pragma unroll
                for (int jt = 0; jt < 4; ++jt) {
                    if (jt <= it) { f32x4 D1 = {0.f, 0.f, 0.f, 0.f}, D2 = D1;
#pragma unroll
                        for (int ks = 0; ks < 4; ++ks) { D1 = MFMA16(Kf[jt][ks], Kf[it][ks], D1); D2 = MFMA16(Kf[jt][ks], Qf[it][ks], D2); }
                        f32x4 lv;
#pragma unroll
                        for (int r = 0; r < 4; ++r) { const int j = 16 * jt + 4 * q + r, i = 16 * it + x; const float dec = __expf(fminf(gi - gj[jt][r], 0.f));
                            lv[r] = (j < i) ? bi * D1[r] * dec : 0.f; d2s[jt][r] = (j <= i) ? D2[r] * dec : 0.f; }
                        *(LAS f32x4*)(Lw + (16 * it + x) * 64 + 16 * jt + 4 * q) = lv;
                    } else d2s[jt] = (f32x4){0.f, 0.f, 0.f, 0.f};
                }
#pragma unroll
                for (int kp = 0; kp < 2; ++kp) if (it >= 2 || kp == 0) *(bf16x8*)(attp + ((it * 2 + kp) * 64 + lane) * 8) = pack8(d2s[2 * kp], d2s[2 * kp + 1]);
            }
            { float* tab = (float*)(attp + 512); tab[lane] = eg; tab[64 + lane] = expf(glast - gcum); }
            bf16* ktp = sb.KT + cid * 8192;
#pragma unroll 1
            for (int dt = 0; dt < 8; ++dt)
#pragma unroll
                for (int kp = 0; kp < 2; ++kp) *(u32x4*)(ktp + ((dt * 2 + kp) * 64 + lane) * 8) = tr_gather<false>(kb + 16 * dt + x, 1536, kp, q, 0.f);
            LDS_WAIT();
            const float be = beta * eg;
#pragma unroll 1
            for (int p = 0; p < 4; ++p) {
                const int col = 64 * (p & 1) + lane; const bf16* src = (p < 2 ? vb : kb) + col; const float scl = p < 2 ? beta : be;
                float xv[64];
#pragma unroll
                for (int i = 0; i < 64; ++i) {
                    float a0 = 0.f, a1 = 0.f, a2 = 0.f, a3 = 0.f;
#pragma unroll
                    for (int g4 = 0; g4 < (i + 3) / 4; ++g4) { const f32x4 lr = *(const LAS f32x4*)(Lw + i * 64 + 4 * g4);
                        if (4 * g4 + 0 < i) a0 += lr.x * xv[4 * g4 + 0]; if (4 * g4 + 1 < i) a1 += lr.y * xv[4 * g4 + 1]; if (4 * g4 + 2 < i) a2 += lr.z * xv[4 * g4 + 2]; if (4 * g4 + 3 < i) a3 += lr.w * xv[4 * g4 + 3]; }
                    xv[i] = rdlane(scl, i) * bf2f(src[(size_t)i * 1536]) - ((a0 + a1) + (a2 + a3));
                }
                if (p < 2) { bf16* ut = sb.UT + cid * 8192 + (size_t)col * 64;
#pragma unroll
                    for (int k8 = 0; k8 < 8; ++k8) *(u32x4*)(ut + 8 * k8) = (u32x4){pk2(xv[8 * k8], xv[8 * k8 + 1]), pk2(xv[8 * k8 + 2], xv[8 * k8 + 3]), pk2(xv[8 * k8 + 4], xv[8 * k8 + 5]), pk2(xv[8 * k8 + 6], xv[8 * k8 + 7])};
                } else { const int d = col, ks = d >> 5, dd = d & 31, qp = (dd & 15) >> 2, jj = (dd & 3) + 4 * (dd >> 4);
                    unsigned char* nw = (unsigned char*)(sb.NW + cid * 8192) + ks * 1024 + qp * 256 + jj * 2;
#pragma unroll
                    for (int i = 0; i < 64; ++i) *(unsigned short*)(nw + (i >> 4) * 4096 + (i & 15) * 16) = (unsigned short)(pk2(-xv[i], 0.f) & 0xffffu);
                }
            }
            LDS_WAIT();
        } else {
            const float il = gr[8 + h] + i_bias[h]; const float fl = -softplus_f(-(gr[12 + h] + f_bias[h]));
            const float bcum = scan_add(fl, lane), t = il - bcum, pm = scan_max(t, lane), pml = __shfl(pm, 63);
            const float esc = __expf(t - pml);
            const bf16* qb = sb.X2 + (size_t)m0 * 2560 + 512 + h * 128; const bf16* kb = qb + 512; const bf16* vb = kb + 512;
            bf16x8 Kf[4][4], Qf[4][4];
#pragma unroll
            for (int tt = 0; tt < 4; ++tt)
#pragma unroll
                for (int ks = 0; ks < 4; ++ks) { Kf[tt][ks] = *(const bf16x8*)(kb + (size_t)(16 * tt + x) * 2560 + 32 * ks + 8 * q); Qf[tt][ks] = *(const bf16x8*)(qb + (size_t)(16 * tt + x) * 2560 + 32 * ks + 8 * q); }
            float tj[4][4];
#pragma unroll
            for (int jt = 0; jt < 4; ++jt)
#pragma unroll
                for (int r = 0; r < 4; ++r) tj[jt][r] = __shfl(t, 16 * jt + 4 * q + r);
            bf16* ptp = sb.PT + cid * 4096;
#pragma unroll
            for (int it = 0; it < 4; ++it) {
                const float pmi = __shfl(pm, 16 * it + x); f32x4 d2s[4];
#pragma unroll
                for (int jt = 0; jt < 4; ++jt) {
                    if (jt <= it) { f32x4 D2 = {0.f, 0.f, 0.f, 0.f};
#pragma unroll
                        for (int ks = 0; ks < 4; ++ks) D2 = MFMA16(Kf[jt][ks], Qf[it][ks], D2);
#pragma unroll
                        for (int r = 0; r < 4; ++r) { const int j = 16 * jt + 4 * q + r, i = 16 * it + x; d2s[jt][r] = (j <= i) ? D2[r] * 0.08838834764831845f * __expf(fminf(tj[jt][r] - pmi, 0.f)) : 0.f; }
                    } else d2s[jt] = (f32x4){0.f, 0.f, 0.f, 0.f};
                }
#pragma unroll
                for (int kp = 0; kp < 2; ++kp) if (it >= 2 || kp == 0) *(bf16x8*)(ptp + ((it * 2 + kp) * 64 + lane) * 8) = pack8(d2s[2 * kp], d2s[2 * kp + 1]);
            }
            { float* tab = (float*)(ptp + 512); tab[lane] = bcum; tab[64 + lane] = bcum + pm; }
            bf16* kwp = sb.KWT + cid * 8192; bf16* vtp = sb.VT + cid * 8192;
#pragma unroll 1
            for (int dt = 0; dt < 8; ++dt)
#pragma unroll
                for (int kp = 0; kp < 2; ++kp) { *(u32x4*)(kwp + ((dt * 2 + kp) * 64 + lane) * 8) = tr_gather<true>(kb + 16 * dt + x, 2560, kp, q, esc);
                    *(u32x4*)(vtp + ((dt * 2 + kp) * 64 + lane) * 8) = tr_gather<false>(vb + 16 * dt + x, 2560, kp, q, 0.f); }
        }
    }
}
constexpr int RC_NW = 0, RC_ATT = 16384, RC_KT = 24576, RC_QP = 40960, RC_BUF = 57344;
__device__ __forceinline__ void recur_stage(LAS unsigned char* buf, const bf16* f16a  , const bf16* f8  , const bf16* f16b  , const bf16* qbase  , int qpitch, int wave, int lane) {
#pragma unroll
    for (int k = 0; k < 5; ++k) { const int bl = wave + 8 * k;
        const bf16* src = bl < 16 ? f16a + bl * 512 : (bl < 24 ? f8 + (bl - 16) * 512 : f16b + (bl - 24) * 512);
        __builtin_amdgcn_global_load_lds((const unsigned*)(src + lane * 8), (LAS unsigned*)(buf + bl * 1024), 16, 0, 0); }
#pragma unroll
    for (int k = 0; k < 8; ++k) { const int P = (wave * 8 + k) * 256 + lane * 4, f = P >> 10, lp = (P & 1023) >> 4, jj0 = ((P & 15) >> 2) * 2, it = f >> 2, ks = f & 3, xp = lp & 15, qp = lp >> 4;
        const bf16* src = qbase + (size_t)(16 * it + xp) * qpitch + kperm(ks, qp, jj0);
        __builtin_amdgcn_global_load_lds((const unsigned*)src, (LAS unsigned*)(buf + RC_QP + (wave * 8 + k) * 256), 4, 0, 0); }
}
__device__ __forceinline__ void recur_phase(LAS unsigned char* lds, const ScanBufs sb, int G, int bid, int wave, int lane) {
    const int x = lane & 15, q = lane >> 4, et = wave;
#pragma unroll 1
    for (int u = bid; u < 2 * BATCH * 4; u += G) {
        const int mixer = u >> 7, b = (u & 127) >> 2, h = u & 3;
        const size_t cid0 = (size_t)((b * 4 + h) * 32);
        if (mixer == 0) {
            f32x4 S[8];
#pragma unroll
            for (int d = 0; d < 8; ++d) S[d] = (f32x4){0.f, 0.f, 0.f, 0.f};
            recur_stage(lds, sb.NW + cid0 * 8192, sb.ATT + cid0 * 4096, sb.KT + cid0 * 8192, sb.QKVA + (size_t)(b * SEQ) * 1536 + h * 128, 1536, wave, lane);
            __syncthreads();
#pragma unroll 1
            for (int c = 0; c < SEQ / 64; ++c) {
                const int m0 = b * SEQ + c * 64; const size_t cid = cid0 + c;
                const LAS unsigned char* buf = lds + (c & 1) * RC_BUF;
                { const int cn = c + 1 < SEQ / 64 ? c + 1 : c; const size_t cidn = cid0 + cn;
                  recur_stage(lds + ((c + 1) & 1) * RC_BUF, sb.NW + cidn * 8192, sb.ATT + cidn * 4096, sb.KT + cidn * 8192, sb.QKVA + (size_t)(b * SEQ + cn * 64) * 1536 + h * 128, 1536, wave, lane); }
                const bf16* utp = sb.UT + cid * 8192 + (size_t)(16 * et + x) * 64;
                const LAS float* tab = (const LAS float*)(buf + RC_ATT + 1024);
                bf16x8 Sb[4];
#pragma unroll
                for (int ks = 0; ks < 4; ++ks) Sb[ks] = pack8(S[2 * ks], S[2 * ks + 1]);
                f32x4 vn[4];
#pragma unroll
                for (int mt = 0; mt < 4; ++mt) { const u32x2 uu = *(const u32x2*)(utp + 16 * mt + 4 * q); f32x4 acc = {bf_lo(uu.x), bf_hi(uu.x), bf_lo(uu.y), bf_hi(uu.y)};
#pragma unroll
                    for (int ks = 0; ks < 4; ++ks) acc = MFMA16(*(const LAS bf16x8*)(buf + RC_NW + ((mt * 4 + ks) * 64 + lane) * 16), Sb[ks], acc);
                    vn[mt] = acc; }
                bf16x8 vb2[2] = {pack8(vn[0], vn[1]), pack8(vn[2], vn[3])};
#pragma unroll
                for (int it = 0; it < 4; ++it) { f32x4 acc = {0.f, 0.f, 0.f, 0.f};
#pragma unroll
                    for (int ks = 0; ks < 4; ++ks) acc = MFMA16(Sb[ks], *(const LAS bf16x8*)(buf + RC_QP + ((it * 4 + ks) * 64 + lane) * 16), acc);
                    acc = acc * tab[16 * it + x];
#pragma unroll
                    for (int kp = 0; kp < 2; ++kp) if (it >= 2 || kp == 0) acc = MFMA16(vb2[kp], *(const LAS bf16x8*)(buf + RC_ATT + ((it * 2 + kp) * 64 + lane) * 16), acc);
                    *(u32x2*)(sb.QKVA + (size_t)(m0 + 16 * it + x) * 1536 + 512 + h * 128 + 16 * et + 4 * q) = (u32x2){pk2v(acc.x, acc.y), pk2v(acc.z, acc.w)}; }
                f32x4 vs[4];
#pragma unroll
                for (int mt = 0; mt < 4; ++mt) { const f32x4 kk = *(const LAS f32x4*)(tab + 64 + 16 * mt + 4 * q); vs[mt] = vn[mt] * kk; }
                const bf16x8 vsb[2] = {pack8(vs[0], vs[1]), pack8(vs[2], vs[3])};
                const float gam = tab[63];
#pragma unroll
                for (int dt = 0; dt < 8; ++dt) { f32x4 acc = S[dt] * gam;
#pragma unroll
                    for (int kp = 0; kp < 2; ++kp) acc = MFMA16(*(const LAS bf16x8*)(buf + RC_KT + ((dt * 2 + kp) * 64 + lane) * 16), vsb[kp], acc);
                    S[dt] = acc; }
                __syncthreads();
            }
        } else {
            f32x4 Cs[8], Ce[8]; float mrun = 0.f;
#pragma unroll
            for (int d = 0; d < 8; ++d) { Cs[d] = (f32x4){0.f, 0.f, 0.f, 0.f}; Ce[d] = Cs[d]; }
            const short one = (x == 0) ? (short)0x3F80 : (short)0; const bf16x8 ones = {one, one, one, one, one, one, one, one};
            recur_stage(lds, sb.KWT + cid0 * 8192, sb.PT + cid0 * 4096, sb.KWT + cid0 * 8192, sb.X2 + (size_t)(b * SEQ) * 2560 + 512 + h * 128, 2560, wave, lane);
            __syncthreads();
#pragma unroll 1
            for (int c = 0; c < SEQ / 64; ++c) {
                const int m0 = b * SEQ + c * 64; const size_t cid = cid0 + c;
                const LAS unsigned char* buf = lds + (c & 1) * RC_BUF;
                { const int cn = c + 1 < SEQ / 64 ? c + 1 : c; const size_t cidn = cid0 + cn;
                  recur_stage(lds + ((c + 1) & 1) * RC_BUF, sb.KWT + cidn * 8192, sb.PT + cidn * 4096, sb.KWT + cidn * 8192, sb.X2 + (size_t)(b * SEQ + cn * 64) * 2560 + 512 + h * 128, 2560, wave, lane); }
                const bf16* vtp = sb.VT + cid * 8192;
                const LAS float* tab = (const LAS float*)(buf + RC_ATT + 1024);
                bf16x8 Cb[4], Eb[4];
#pragma unroll
                for (int ks = 0; ks < 4; ++ks) { Cb[ks] = pack8(Cs[2 * ks], Cs[2 * ks + 1]); Eb[ks] = pack8(Ce[2 * ks], Ce[2 * ks + 1]); }
                const bf16x8 vf[2] = {*(const bf16x8*)(vtp + ((et * 2 + 0) * 64 + lane) * 8), *(const bf16x8*)(vtp + ((et * 2 + 1) * 64 + lane) * 8)};
#pragma unroll
                for (int it = 0; it < 4; ++it) {
                    const float bc = tab[16 * it + x], mi = tab[64 + 16 * it + x];
                    const float a = bc + mrun, mt = fmaxf(a, mi), f1 = __expf(a - mt) * 0.08838834764831845f, f2 = __expf(mi - mt);
                    f32x4 a1 = {0.f, 0.f, 0.f, 0.f}, aP = a1, e1 = a1, eP = a1;
#pragma unroll
                    for (int ks = 0; ks < 4; ++ks) { const bf16x8 qf = *(const LAS bf16x8*)(buf + RC_QP + ((it * 4 + ks) * 64 + lane) * 16);
                        a1 = MFMA16(Cb[ks], qf, a1); if (wave == 0) e1 = MFMA16(Eb[ks], qf, e1); }
#pragma unroll
                    for (int kp = 0; kp < 2; ++kp) if (it >= 2 || kp == 0) { const bf16x8 pf = *(const LAS bf16x8*)(buf + RC_ATT + ((it * 2 + kp) * 64 + lane) * 16); aP = MFMA16(vf[kp], pf, aP); if (wave == 0) eP = MFMA16(ones, pf, eP); }
                    const f32x4 nm = a1 * f1 + aP * f2;
                    *(u32x2*)(sb.X2 + (size_t)(m0 + 16 * it + x) * 2560 + 1024 + h * 128 + 16 * et + 4 * q) = (u32x2){pk2(nm.x, nm.y), pk2(nm.z, nm.w)};
                    if (wave == 0 && q == 0) sb.DEN[(size_t)(m0 + 16 * it + x) * 4 + h] = fmaxf(fabsf(e1.x * f1 + eP.x * f2), __expf(-mt));
                }
                const float blast = tab[63], wsmax = tab[127];
                const float mnew = fmaxf(blast + mrun, wsmax), sc = __expf(blast + mrun - mnew), s2 = __expf(wsmax - mnew); mrun = mnew;
#pragma unroll
                for (int dt = 0; dt < 8; ++dt) { f32x4 dC = {0.f, 0.f, 0.f, 0.f}, dE = dC;
#pragma unroll
                    for (int kp = 0; kp < 2; ++kp) { const bf16x8 kf = *(const LAS bf16x8*)(buf + RC_KT + ((dt * 2 + kp) * 64 + lane) * 16); dC = MFMA16(kf, vf[kp], dC); if (wave == 0) dE = MFMA16(kf, ones, dE); }
                    Cs[dt] = Cs[dt] * sc + dC * s2; if (wave == 0) Ce[dt] = Ce[dt] * sc + dE * s2; }
                __syncthreads();
            }
        }
    }
}
__device__ __forceinline__ void post_phase(const ScanBufs sb, const float* norm_a, const float* norm_b, bf16* MIXED, int gw, int NGW, int lane) {
    const int hh = lane >> 3, sub = (lane & 7) * 16;
    for (int m = gw; m < M; m += NGW) {
        const bool isA = hh < 4; const int h = hh & 3;
        const bf16* src = isA ? sb.QKVA + (size_t)m * 1536 + 512 + h * 128 + sub : sb.X2 + (size_t)m * 2560 + 1024 + h * 128 + sub;
        const bf16* gsrc = sb.X2 + (size_t)m * 2560 + (isA ? 0 : 2048) + h * 128 + sub;
        const float* gn = (isA ? norm_a : norm_b + h * 128) + sub;
        const u32x4 r0 = *(const u32x4*)src, r1 = *(const u32x4*)(src + 8), z0 = *(const u32x4*)gsrc, z1 = *(const u32x4*)(gsrc + 8);
        float v[16] = {bf_lo(r0.x), bf_hi(r0.x), bf_lo(r0.y), bf_hi(r0.y), bf_lo(r0.z), bf_hi(r0.z), bf_lo(r0.w), bf_hi(r0.w), bf_lo(r1.x), bf_hi(r1.x), bf_lo(r1.y), bf_hi(r1.y), bf_lo(r1.z), bf_hi(r1.z), bf_lo(r1.w), bf_hi(r1.w)};
        const float z[16] = {bf_lo(z0.x), bf_hi(z0.x), bf_lo(z0.y), bf_hi(z0.y), bf_lo(z0.z), bf_hi(z0.z), bf_lo(z0.w), bf_hi(z0.w), bf_lo(z1.x), bf_hi(z1.x), bf_lo(z1.y), bf_hi(z1.y), bf_lo(z1.z), bf_hi(z1.z), bf_lo(z1.w), bf_hi(z1.w)};
        const float dinv = isA ? 1.f : 1.f / sb.DEN[(size_t)m * 4 + h];
        float ss = 0.f;
#pragma unroll
        for (int i = 0; i < 16; ++i) { v[i] *= dinv; ss += v[i] * v[i]; }
        ss += __shfl_xor(ss, 1); ss += __shfl_xor(ss, 2); ss += __shfl_xor(ss, 4);
        const float rstd = rsqrtf(ss * (1.f / 128.f) + EPS);
        float y[16];
#pragma unroll
        for (int i = 0; i < 16; ++i) { const float sg = sigmoid_f(z[i]); y[i] = v[i] * rstd * gn[i] * (isA ? z[i] * sg : sg); }
        u32x4* dst = (u32x4*)(MIXED + (size_t)m * 1024 + lane * 16);
        dst[0] = (u32x4){pk2(y[0], y[1]), pk2(y[2], y[3]), pk2(y[4], y[5]), pk2(y[6], y[7])}; dst[1] = (u32x4){pk2(y[8], y[9]), pk2(y[10], y[11]), pk2(y[12], y[13]), pk2(y[14], y[15])};
    }
}
typedef short v4i16_t __attribute__((ext_vector_type(4)));
constexpr int AT_VROW = 80;
constexpr int AT_K_BYTES = 256 * 128, AT_V_BYTES = 272 * AT_VROW * 2;
__device__ __forceinline__ void attn_phase(LAS unsigned char* lds, int tid, int wave, const bf16* QKV, const float* sinks, bf16* O, int G, int bid) {
    LAS unsigned char* KL = lds; LAS unsigned char* VL = lds + AT_K_BYTES;
    const int lane = tid & 63, x = lane & 15, q = lane >> 4, g = wave >> 1, qh = wave & 1;
#pragma unroll 1
    for (int u = bid; u < BATCH * 4 * 16; u += G) {
        const int b = u >> 6, kvh = (u >> 4) & 3, jb = u & 15;
#pragma unroll
        for (int i = 0; i < 4; ++i) { const int item = tid + 512 * i, r = item >> 3, ch = item & 7, sk = (jb - 1) * 128 + r;
            u32x4 kv = (u32x4){0u, 0u, 0u, 0u}, vv = kv;
            if (sk >= 0) { const bf16* src = QKV + (size_t)(b * SEQ + sk) * 1536 + 1024 + kvh * 64 + ch * 8; kv = *(const u32x4*)src; vv = *(const u32x4*)(src + 256); }
            *(LAS u32x4*)(KL + r * 128 + ((ch ^ (r & 7)) << 4)) = kv; *(LAS u32x4*)(VL + r * (AT_VROW * 2) + ch * 16) = vv; }
        if (tid < 128) { const int r = 256 + (tid >> 3), ch = tid & 7; *(LAS u32x4*)(VL + r * (AT_VROW * 2) + ch * 16) = (u32x4){0u, 0u, 0u, 0u}; }
        __syncthreads();
        const int hq = kvh * 4 + g; const float sink = sinks[hq];
        const size_t mq = (size_t)b * SEQ + jb * 128 + 64 * qh;
#pragma unroll 1
        for (int nt = 0; nt < 4; ++nt) {
            bf16x8 Qf[2];
#pragma unroll
            for (int ks = 0; ks < 2; ++ks) Qf[ks] = *(const bf16x8*)(QKV + (mq + 16 * nt + x) * 1536 + hq * 64 + 32 * ks + 8 * q);
            f32x4 s[9]; float mx = -3.0e38f;
#pragma unroll
            for (int j = 0; j < 9; ++j) { const int kt = nt + j, r = 64 * qh + 16 * kt + x;
                f32x4 acc = {0.f, 0.f, 0.f, 0.f};
#pragma unroll
                for (int ks = 0; ks < 2; ++ks) acc = MFMA16(*(const LAS bf16x8*)(KL + r * 128 + (((4 * ks + q) ^ (r & 7)) << 4)), Qf[ks], acc);
#pragma unroll
                for (int rg = 0; rg < 4; ++rg) { const int diff = 16 * j + 4 * q + rg - x, ra = 64 * qh + 16 * kt + 4 * q + rg;
                    const bool valid = diff >= 1 && diff <= 128 && (jb - 1) * 128 + ra >= 0;
                    acc[rg] = valid ? acc[rg] : -3.0e38f; mx = fmaxf(mx, acc[rg]); }
                s[j] = acc; }
            mx = fmaxf(mx, __shfl_xor(mx, 16)); mx = fmaxf(mx, __shfl_xor(mx, 32)); mx = fmaxf(mx, sink);
            float sum = 0.f;
#pragma unroll
            for (int j = 0; j < 9; ++j)
#pragma unroll
                for (int rg = 0; rg < 4; ++rg) { const float p = (s[j][rg] > -1.0e38f) ? __expf(s[j][rg] - mx) : 0.f; s[j][rg] = p; sum += p; }
            sum += __shfl_xor(sum, 16); sum += __shfl_xor(sum, 32);
            const float inv = 1.f / (sum + __expf(sink - mx));
            bf16x8 Pf[5];
#pragma unroll
            for (int j2 = 0; j2 < 4; ++j2) Pf[j2] = pack8(s[2 * j2], s[2 * j2 + 1]);
            Pf[4] = pack8(s[8], (f32x4){0.f, 0.f, 0.f, 0.f});
#pragma unroll
            for (int dt = 0; dt < 4; ++dt) { f32x4 acc = {0.f, 0.f, 0.f, 0.f};
#pragma unroll
                for (int j2 = 0; j2 < 5; ++j2) { const int kb = 64 * qh + 16 * (nt + 2 * j2) + 4 * q + (x >> 2);
                    const LAS unsigned char* p0 = VL + kb * (AT_VROW * 2) + (16 * dt + 4 * (x & 3)) * 2;
                    const v4i16_t lo = __builtin_amdgcn_ds_read_tr16_b64_v4i16((LAS v4i16_t*)p0), hi = __builtin_amdgcn_ds_read_tr16_b64_v4i16((LAS v4i16_t*)(p0 + 16 * AT_VROW * 2));
                    const bf16x8 vf = {lo[0], lo[1], lo[2], lo[3], hi[0], hi[1], hi[2], hi[3]};
                    acc = MFMA16(vf, Pf[j2], acc); }
                acc = acc * inv;
                *(u32x2*)(O + (mq + 16 * nt + x) * 1024 + hq * 64 + 16 * dt + 4 * q) = (u32x2){pk2v(acc.x, acc.y), pk2v(acc.z, acc.w)}; }
        }
        __syncthreads();
    }
}
#ifndef N_LAUNCH_MODE
#define N_LAUNCH_MODE 0
#endif
__global__ void __launch_bounds__(NTHR, 2) trunk_fwd(Args a_unused) {
    extern __shared__ __attribute__((aligned(16))) unsigned char lds_raw[];
    LAS unsigned char* lds = (LAS unsigned char*)lds_raw;
    volatile LAS unsigned* MISC = (volatile LAS unsigned*)(lds + MISC_OFF);
    if (threadIdx.x < 64) MISC[threadIdx.x] = 0u;
    __syncthreads();
    int lo, hi; XcdBarrier bar;
    int dupm = 0, dupp = 0; (void)dupm; (void)dupp;
    { KArgs a = kargs(); lo = a->ph_lo; hi = a->ph_hi; dupm = a->dup_mask; dupp = a->dup_par; unsigned* ctl = (unsigned*)(a->ws + WS_CTL);
      bar.bar = ctl + CW_BAR; bar.x = 0; bar.st = MISC + 8;
      if (hi - lo > 1) bar = xcd_barrier_post(ctl + CW_BAR, MISC + 8); }
#define IN(k) (lo <= (k) && (k) < hi)
#if defined(PROBE_DUP_MASK)
#define REP(k) _Pragma("unroll 1") for (int rep_ = 0; rep_ <= (((dupm >> (k)) & 1) && (dupp == 0 || dupp == 1 + (L & 1)) ? 1 : 0); ++rep_)
#else
#define REP(k)
#endif
#define SEAM(k) do { if (IN(k) && IN((k) + 1)) xcd_barrier(bar); } while (0)
#define ENV KArgs a = kargs(); const int tid = fresh_tid(), lane = tid & 63, wave = __builtin_amdgcn_readfirstlane(tid >> 6); const int G = gridDim.x, bid = blockIdx.x, gw = bid * NWAVES + wave, NGW = G * NWAVES, gtid = bid * NTHR + tid, NGT = G * NTHR; \
    unsigned char* ws = a->ws; bf16* RA = (bf16*)(ws + WS_RA); bf16* RB = (bf16*)(ws + WS_RB); bf16* RC = (bf16*)(ws + WS_RC); bf16* RD = (bf16*)(ws + WS_RD); float* Gt = (float*)(ws + WS_GT); \
    (void)lane; (void)wave; (void)gw; (void)NGW; (void)gtid; (void)NGT; (void)RA; (void)RB; (void)RC; (void)RD; (void)Gt; (void)G; (void)bid

    if (IN(0)) { ENV; prologue_phase(a, lds, gw, NGW, wave, lane, gtid, NGT); }
    SEAM(0);
#define SCANBUFS ScanBufs sb; sb.QKVA = (bf16*)(ws + WS_QKVA); sb.X2 = (bf16*)(ws + WS_X2); sb.Gt = Gt; sb.KT = (bf16*)(ws + WS_KT); sb.UT = (bf16*)(ws + WS_UT); sb.NW = (bf16*)(ws + WS_NW); sb.ATT = (bf16*)(ws + WS_ATT); \
    sb.KWT = (bf16*)(ws + WS_KWT); sb.VT = (bf16*)(ws + WS_VT); sb.PT = (bf16*)(ws + WS_PT); sb.DEN = (float*)(ws + WS_DEN)
#pragma unroll 1
    for (int L = 0; L < DEPTH; ++L) {
        const int pb = 1 + L * PH_PER_LAYER; const bool even = (L & 1) == 0; const int e = L >> 1;
        if (IN(pb + 0)) REP(0) { ENV; const float* hin = (L == 0) ? a->x : a->out;
            norm_phase(lds, hin, a->gains + (size_t)L * 4 * DM, RA, even, (const float*)(ws + WS_WGATES) + (size_t)e * 16 * 1024, Gt, gw, NGW, tid, lane); }
        SEAM(pb + 0);
        if (IN(pb + 1)) REP(1) { ENV;
            const int N = even ? 4096 : 1536;
            pg8::Gemm g{RA, even ? (const bf16*)(ws + WS_WIN) + (size_t)e * 4096 * 1024 : (const bf16*)(ws + WS_WQKV) + (size_t)e * 1536 * 1024, M, N, DM};
            pg8::StaticOrder S; S.init(M, N, G, bid);
            pg8::EpiBf16<0> E{RC, 1536, even ? nullptr : a->b_qkv + (size_t)e * 1536, (bf16*)(ws + WS_X2), 1536, 2560};
            pg8::gemm_phase<pg8::EpiBf16<0>, pg8::StaticOrder, true, true>(lds, g, S, E);
        }
        SEAM(pb + 1);
        if (IN(pb + 2)) REP(2) { ENV; if (even) conv_phase((const bf16*)(ws + WS_X1), a->conv + (size_t)e * 4 * 1536, (bf16*)(ws + WS_QKVA), gw, NGW, lane); else rope_phase(RC, (const f32x2*)(ws + WS_ROPE), gw, NGW, lane); }
        SEAM(pb + 2);
        if (even) {
            if (IN(pb + 3)) REP(3) { ENV; SCANBUFS; local_phase(lds, sb, a->a_log + e * 4, a->dt_bias + e * 4, a->i_bias + e * 4, a->f_bias + e * 4, gw, NGW, wave, lane); }
            SEAM(pb + 3);
        }
        if (IN(pb + 4)) REP(4) { ENV;
            if (even) { SCANBUFS; recur_phase(lds, sb, G, bid, wave, lane); }
            else attn_phase(lds, tid, wave, RC, a->sinks + e * 16, RD, G, bid);
        }
        SEAM(pb + 4);
        if (even) {
            if (IN(pb + 5)) REP(5) { ENV; SCANBUFS; post_phase(sb, a->norm_a + e * 128, a->norm_b + e * 512, (bf16*)(ws + WS_MIXED), gw, NGW, lane); }
            SEAM(pb + 5);
        }
        if (IN(pb + 6)) REP(6) { ENV;
            pg8::Gemm g{even ? (const bf16*)(ws + WS_MIXED) : (const bf16*)RD, even ? (const bf16*)(ws + WS_WOUT) + (size_t)e * DM * DM : (const bf16*)(ws + WS_WO) + (size_t)e * DM * DM, M, DM, DM};
            pg8::StaticOrder S; S.init(M, DM, G, bid);
            pg8::EpiF32 E{(float*)RA, DM, even ? nullptr : a->b_o + (size_t)e * DM};
            pg8::gemm_phase<pg8::EpiF32, pg8::StaticOrder, true, true>(lds, g, S, E);
        }
        SEAM(pb + 6);
        if (IN(pb + 7)) { ENV; const float* hin = (L == 0) ? a->x : a->out; const float* gains = a->gains + (size_t)L * 4 * DM;
            resid_a_phase((const float*)RA, hin, a->out, gains + DM, gains + 2 * DM, RD, gw, NGW, lane); }
        SEAM(pb + 7);
        if (IN(pb + 8)) REP(8) { ENV;
            pg8::Gemm g{RD, (const bf16*)(ws + WS_WUP) + (size_t)L * FF * DM, M, FF, DM};
            pg8::StaticOrder S; S.init(M, FF, G, bid);
            pg8::EpiBf16<1> E{RC, FF, nullptr, RC, 1 << 30, FF};
            pg8::gemm_phase<pg8::EpiBf16<1>, pg8::StaticOrder, true, true>(lds, g, S, E);
        }
        SEAM(pb + 8);
        if (IN(pb + 9)) REP(9) { ENV;
            pg8::Gemm g{RC, (const bf16*)(ws + WS_WDN) + (size_t)L * DM * FF, M, DM, FF};
            pg8::StaticOrder S; S.init(M, DM, G, bid);
            pg8::EpiF32 E{(float*)RA, DM, nullptr};
            pg8::gemm_phase<pg8::EpiF32, pg8::StaticOrder, true, true>(lds, g, S, E);
        }
        SEAM(pb + 9);
        if (IN(pb + 10)) { ENV; resid_b_phase((const float*)RA, a->out, a->gains + (size_t)L * 4 * DM + 3 * DM, RD, a->p + (size_t)L * M * PLE, RC, gw, NGW, lane, gtid, NGT); }
        SEAM(pb + 10);
        if (IN(pb + 11)) REP(11) { ENV;
            pg8::Gemm g{RC, (const bf16*)(ws + WS_WPLE) + (size_t)L * DM * PLE, M, DM, PLE};
            pg8::StaticOrder S; S.init(M, DM, G, bid);
            pg8::EpiBf16<0> E{RB, DM, nullptr, RB, 1 << 30, DM};
            pg8::gemm_phase<pg8::EpiBf16<0>, pg8::StaticOrder, true, true>(lds, g, S, E);
        }
        SEAM(pb + 11);
        if (IN(pb + 12)) { ENV;
            pg8::Gemm g{RD, (const bf16*)(ws + WS_WG) + (size_t)L * DM * DM, M, DM, DM};
            pg8::StaticOrder S; S.init(M, DM, G, bid);
            pg8::EpiGate E{a->out, RB, DM};
            pg8::gemm_phase<pg8::EpiGate, pg8::StaticOrder, true, true>(lds, g, S, E);
        }
        SEAM(pb + 12);
    }
#undef SCANBUFS
#undef IN
#undef SEAM
#undef ENV
}

extern "C" void kernel_launch(void* const* d_in, const int* in_sizes, int n_in, void* d_out, int out_size, void* d_ws, size_t ws_size, hipStream_t stream) {
    static int grid = 0;
    if (grid == 0) {
        if (n_in != 22 || in_sizes[0] != M * DM || out_size != M * DM || ws_size < WS_END) {
            fprintf(stderr, "kernel_launch: unexpected shapes (n_in %d, in0 %d, out %d, ws %zu; need ws >= %zu); nothing launched\n", n_in, n_in > 0 ? in_sizes[0] : -1, out_size, ws_size, (size_t)WS_END); grid = -1; return; }
        int dev = 0, cus = 0, per_cu = 0;
        if (hipGetDevice(&dev) != hipSuccess || hipDeviceGetAttribute(&cus, hipDeviceAttributeMultiprocessorCount, dev) != hipSuccess) { fprintf(stderr, "kernel_launch: device query failed\n"); grid = -1; return; }
        if (hipFuncSetAttribute((const void*)trunk_fwd, hipFuncAttributeMaxDynamicSharedMemorySize, LDS_BYTES) != hipSuccess) { fprintf(stderr, "kernel_launch: hipFuncSetAttribute failed\n"); grid = -1; return; }
        if (hipOccupancyMaxActiveBlocksPerMultiprocessor(&per_cu, (const void*)trunk_fwd, NTHR, LDS_BYTES) != hipSuccess || per_cu < 1) fprintf(stderr, "kernel_launch: note: occupancy query reports %d\n", per_cu);
        (void)hipGetLastError();
        grid = cus;
    }
    if (grid < 0) return;
    Args a{};
    a.x = (const float*)d_in[0]; a.p = (const float*)d_in[1]; a.pos = (const int*)d_in[2]; a.gains = (const float*)d_in[3]; a.w_in = (const float*)d_in[4]; a.conv = (const float*)d_in[5];
    a.a_log = (const float*)d_in[6]; a.dt_bias = (const float*)d_in[7]; a.norm_a = (const float*)d_in[8]; a.i_bias = (const float*)d_in[9]; a.f_bias = (const float*)d_in[10]; a.norm_b = (const float*)d_in[11];
    a.b_qkv = (const float*)d_in[14]; a.sinks = (const float*)d_in[15]; a.b_o = (const float*)d_in[17];
    a.out = (float*)d_out; a.ws = (unsigned char*)d_ws;
#if defined(PROBE_DUP_MASK)
    a.dup_mask = PROBE_DUP_MASK; a.dup_par = PROBE_DUP_PAR;
#endif
    a.w_out = (const float*)d_in[12]; a.w_qkv = (const float*)d_in[13]; a.w_o = (const float*)d_in[16]; a.w_up = (const float*)d_in[18]; a.w_down = (const float*)d_in[19]; a.w_ple = (const float*)d_in[20]; a.w_gate = (const float*)d_in[21];
#if N_LAUNCH_MODE == 0
    if (hipMemsetAsync((char*)d_ws + WS_CTL, 0, CTL_ZERO_BYTES, stream) != hipSuccess) { fprintf(stderr, "kernel_launch: memset failed\n"); return; }
    a.ph_lo = 0; a.ph_hi = NPHASE;
    hipLaunchKernelGGL(trunk_fwd, dim3(grid), dim3(NTHR), LDS_BYTES, stream, a);
#else
    for (int ph = 0; ph < NPHASE; ++ph) { a.ph_lo = ph; a.ph_hi = ph + 1; hipLaunchKernelGGL(trunk_fwd, dim3(grid), dim3(NTHR), LDS_BYTES, stream, a); }
#endif
    const hipError_t le = hipPeekAtLastError();
    if (le != hipSuccess) fprintf(stderr, "kernel_launch: launch failed: %s\n", hipGetErrorName(le));
}
```

```cpp
#include <hip/hip_runtime.h>
#include <cstdio>
#include <cstdint>
#define N_LAUNCH_MODE 0
namespace pg8 {
#define PG8_LAS __attribute__((address_space(3)))
typedef unsigned short bf16_t;
typedef short bf16x8 __attribute__((ext_vector_type(8)));
typedef float f32x4 __attribute__((ext_vector_type(4)));
typedef unsigned u32x4 __attribute__((ext_vector_type(4)));
constexpr int BM = 256, BK = 64, HALF = 128, HTB = HALF * BK * 2  , STAGE_BYTES = 8 * HTB, NXCD = 8, WGM = 8;

__host__ __device__ __forceinline__ int lds_byte(int r, int c) { const int st = (r >> 4) * 2 + (c >> 5), rr = r & 15, cc = c & 31, ob = rr * 64 + cc * 2; return st * 1024 + (ob ^ (((ob >> 9) & 1) << 5)); }
__host__ __device__ __forceinline__ void stage_rc(int b, int& R, int& C) { const int st = b / 1024, sb = b % 1024, swz = sb ^ (((sb >> 9) & 1) << 5); R = (st >> 1) * 16 + swz / 64; C = (st & 1) * 32 + (swz % 64) / 2; }
__host__ __device__ __forceinline__ int perm32(int rho) { const int n = rho >> 4, i = rho & 15; return 8 * (i >> 2) + 4 * n + (i & 3); }

struct Unit { int pm, pn; };
struct Gemm { const bf16_t* A; const bf16_t* Bt; int M, N, K; };

struct StaticOrder {
    int nM, nN, nwg, G, c;
    __host__ __device__ void init(int M, int N, int G_, int c_) { nM = M / BM; nN = N / BM; nwg = nM * nN; G = G_; c = c_; }
    __host__ __device__ bool next(int i, Unit& u) const {
        const long L = (long)i * G + c; if (L >= nwg) return false;
        int wgid = (int)L; { const int q = nwg / NXCD, r = nwg % NXCD, xcd = wgid % NXCD, off = wgid / NXCD; wgid = (xcd < r ? xcd * (q + 1) : r * (q + 1) + (xcd - r) * q) + off; }
        const int nig = WGM * nN, gid = wgid / nig, fm = gid * WGM, gsz = (nM - fm) < WGM ? (nM - fm) : WGM;
        u.pm = fm + ((wgid % nig) % gsz); u.pn = (wgid % nig) / gsz; return true;
    }
    __device__ __forceinline__ void a_ready(const Unit&) const {}
    __device__ __forceinline__ void done(const Unit&) const {}
};

__device__ __forceinline__ unsigned cvt_pk_bf16(float lo, float hi) { unsigned r; asm volatile("v_cvt_pk_bf16_f32 %0, %1, %2" : "=v"(r) : "v"(lo), "v"(hi)); return r; }
typedef float f32x2 __attribute__((ext_vector_type(2)));
typedef unsigned u32x2 __attribute__((ext_vector_type(2)));

template <int ACT  > struct EpiBf16 {
    static constexpr bool PERM = true, AFTER_DRAIN = false;
    bf16_t* O; int ldc; const float* bias; bf16_t* O2; int split_col, ldc2;
    __device__ __forceinline__ void operator()(const f32x4 (&acc)[2][2][4][2], const Unit& u, int wr, int wc, int fr, int fq) const {
        const int row0 = u.pm * BM + wr * 64 + fr; const int col0 = u.pn * BM + wc * 32 + 8 * fq;
        const bool second = u.pn * BM >= split_col; bf16_t* const ob = second ? O2 : O; const int ld = second ? ldc2 : ldc, oc0 = second ? col0 - split_col : col0;
        f32x4 bv[2][2];
#pragma unroll
        for (int bj = 0; bj < 2; ++bj)
#pragma unroll
            for (int n = 0; n < 2; ++n) bv[bj][n] = bias ? *(const f32x4*)(bias + col0 + bj * HALF + 4 * n) : (f32x4){0.f, 0.f, 0.f, 0.f};
#pragma unroll
        for (int ai = 0; ai < 2; ++ai)
#pragma unroll
            for (int m = 0; m < 4; ++m) { bf16_t* rowp = ob + (size_t)(row0 + ai * HALF + m * 16) * ld + oc0;
#pragma unroll
                for (int bj = 0; bj < 2; ++bj) { f32x4 v0 = acc[ai][bj][m][0] + bv[bj][0], v1 = acc[ai][bj][m][1] + bv[bj][1];
                    if (ACT == 1) {
#pragma unroll
                        for (int i = 0; i < 4; ++i) { const float a = fmaxf(v0[i], 0.f), b = fmaxf(v1[i], 0.f); v0[i] = a * a; v1[i] = b * b; } }
                    u32x4 w; w.x = cvt_pk_bf16(v0[0], v0[1]); w.y = cvt_pk_bf16(v0[2], v0[3]); w.z = cvt_pk_bf16(v1[0], v1[1]); w.w = cvt_pk_bf16(v1[2], v1[3]);
                    *(u32x4*)(rowp + bj * HALF) = w; } }
    }
};
struct EpiF32 {
    static constexpr bool PERM = false, AFTER_DRAIN = false;
    float* C; int ldc; const float* bias;
    __device__ __forceinline__ void operator()(const f32x4 (&acc)[2][2][4][2], const Unit& u, int wr, int wc, int fr, int fq) const {
        const int row0 = u.pm * BM + wr * 64 + fr, col0 = u.pn * BM + wc * 32 + 4 * fq;
        f32x4 bv[2][2];
#pragma unroll
        for (int bj = 0; bj < 2; ++bj)
#pragma unroll
            for (int n = 0; n < 2; ++n) bv[bj][n] = bias ? *(const f32x4*)(bias + col0 + bj * HALF + n * 16) : (f32x4){0.f, 0.f, 0.f, 0.f};
#pragma unroll
        for (int ai = 0; ai < 2; ++ai)
#pragma unroll
            for (int m = 0; m < 4; ++m) { float* rowp = C + (size_t)(row0 + ai * HALF + m * 16) * ldc + col0;
#pragma unroll
                for (int bj = 0; bj < 2; ++bj)
#pragma unroll
                    for (int n = 0; n < 2; ++n) *(f32x4*)(rowp + bj * HALF + n * 16) = acc[ai][bj][m][n] + bv[bj][n]; }
    }
};
__device__ __forceinline__ float bf_lo(unsigned w) { return __builtin_bit_cast(float, w << 16); }
__device__ __forceinline__ float bf_hi(unsigned w) { return __builtin_bit_cast(float, w & 0xffff0000u); }
struct EpiGate {
    static constexpr bool PERM = false, AFTER_DRAIN = false;
    float* H; const bf16_t* PP; int ldc;
    __device__ __forceinline__ void operator()(const f32x4 (&acc)[2][2][4][2], const Unit& u, int wr, int wc, int fr, int fq) const {
        const int row0 = u.pm * BM + wr * 64 + fr, col0 = u.pn * BM + wc * 32 + 4 * fq;
#pragma unroll
        for (int ai = 0; ai < 2; ++ai)
#pragma unroll
            for (int m = 0; m < 4; ++m) { const size_t ro = (size_t)(row0 + ai * HALF + m * 16) * ldc + col0;
#pragma unroll
                for (int bj = 0; bj < 2; ++bj)
#pragma unroll
                    for (int n = 0; n < 2; ++n) { const size_t off = ro + bj * HALF + n * 16;
                        f32x4 hv = *(const f32x4*)(H + off); const u32x2 pv = *(const u32x2*)(PP + off); const f32x4 a = acc[ai][bj][m][n];
                        const float p0 = bf_lo(pv.x), p1 = bf_hi(pv.x), p2 = bf_lo(pv.y), p3 = bf_hi(pv.y);
                        hv[0] += p0 / (1.f + __expf(-a[0])); hv[1] += p1 / (1.f + __expf(-a[1])); hv[2] += p2 / (1.f + __expf(-a[2])); hv[3] += p3 / (1.f + __expf(-a[3]));
                        *(f32x4*)(H + off) = hv; } }
    }
};

template <class Epi, class Sched, bool ALIGN_EPI = false, bool SP2 = false>
__device__ __forceinline__ void gemm_phase(PG8_LAS unsigned char* lds, const Gemm g, const Sched& S, const Epi& E) {
    int tid_l = threadIdx.x; asm volatile("" : "+v"(tid_l));
    const int tid = tid_l, wid = __builtin_amdgcn_readfirstlane(tid >> 6), lane = tid & 63, wr = wid >> 2, wc = wid & 3, fr = lane & 15, fq = lane >> 4;
    const int K = g.K, nt = K / BK;
    unsigned voffA[2], voffB[2];
#pragma unroll
    for (int i = 0; i < 2; ++i) { int R, C; stage_rc(tid * 16 + i * 8192, R, C); const int Rb = Epi::PERM ? ((R & ~31) + perm32(R & 31)) : R;
        voffA[i] = (unsigned)(R * K + C) * 2u; voffB[i] = (unsigned)(Rb * K + C) * 2u; }
    const size_t kstep = (size_t)(BK * 2);
    const size_t hstep = (size_t)HALF * K * 2;
    const size_t tstep = 2 * hstep;
    const unsigned ldsw = (unsigned)wid * 1024u;
    const int aoff = lds_byte(wr * 64 + fr, fq * 8), boff = lds_byte(wc * 32 + fr, fq * 8);
#define PG8_SA(b, h) (((b) * 2 + (h)) * HTB)
#define PG8_SB(b, h) ((4 + (b) * 2 + (h)) * HTB)
#define PG8_STAGE(bufoff, gbase, voff) do { _Pragma("unroll") for (int _i = 0; _i < 2; ++_i) \
        __builtin_amdgcn_global_load_lds((const unsigned*)((const char*)(gbase) + (voff)[_i]), (PG8_LAS unsigned*)(lds + (bufoff) + ldsw + _i * 8192), 16, 0, 0); } while (0)
#define PG8_LDA(dst, b, h) do { _Pragma("unroll") for (int m = 0; m < 4; ++m) _Pragma("unroll") for (int k = 0; k < 2; ++k) dst[m][k] = *(const PG8_LAS bf16x8*)(lds + PG8_SA(b, h) + aoff + m * 2048 + k * 1024); } while (0)
#define PG8_LDB(dst, b, h) do { _Pragma("unroll") for (int n = 0; n < 2; ++n) _Pragma("unroll") for (int k = 0; k < 2; ++k) dst[n][k] = *(const PG8_LAS bf16x8*)(lds + PG8_SB(b, h) + boff + n * 2048 + k * 1024); } while (0)
#define PG8_MMA(ai, bj, At, Bt) do { __builtin_amdgcn_s_setprio(1); _Pragma("unroll") for (int m = 0; m < 4; ++m) _Pragma("unroll") for (int n = 0; n < 2; ++n) _Pragma("unroll") for (int k = 0; k < 2; ++k) \
        acc[ai][bj][m][n] = __builtin_amdgcn_mfma_f32_16x16x32_bf16(Bt[n][k], At[m][k], acc[ai][bj][m][n], 0, 0, 0); __builtin_amdgcn_s_setprio(0); } while (0)
#define PG8_WAIT_V(n) asm volatile("s_waitcnt vmcnt(" #n ")" ::: "memory")
#define PG8_WAIT_L(n) asm volatile("s_waitcnt lgkmcnt(" #n ")" ::: "memory")
#define PG8_BAR __builtin_amdgcn_s_barrier()
#define PG8_SCHED __builtin_amdgcn_sched_barrier(0)
    Unit cur, nxt; int ui = 0;
    if (!S.next(0, cur)) return;
    f32x4 acc[2][2][4][2];
#pragma unroll
    for (int a = 0; a < 2; ++a)
#pragma unroll
        for (int b = 0; b < 2; ++b)
#pragma unroll
            for (int m = 0; m < 4; ++m)
#pragma unroll
                for (int n = 0; n < 2; ++n) acc[a][b][m][n] = (f32x4){0.f, 0.f, 0.f, 0.f};
    bf16x8 At[4][2], B0[2][2], B1[2][2];
    const char* cA = (const char*)g.A + (size_t)cur.pm * tstep; const char* cB = (const char*)g.Bt + (size_t)cur.pn * tstep;
    S.a_ready(cur);
    if constexpr (SP2) {
        PG8_STAGE(PG8_SB(0, 0), cB, voffB); PG8_STAGE(PG8_SB(0, 1), cB + hstep, voffB); PG8_STAGE(PG8_SA(0, 0), cA, voffA); PG8_STAGE(PG8_SA(0, 1), cA + hstep, voffA);
        if (wr == 1) PG8_BAR;
        PG8_WAIT_V(2); PG8_BAR;
        PG8_STAGE(PG8_SB(1, 0), cB + kstep, voffB); PG8_STAGE(PG8_SA(1, 0), cA + kstep, voffA); PG8_STAGE(PG8_SB(1, 1), cB + hstep + kstep, voffB);
        PG8_WAIT_V(6); PG8_BAR;
    } else {
        PG8_STAGE(PG8_SB(0, 0), cB, voffB); PG8_STAGE(PG8_SA(0, 0), cA, voffA); PG8_STAGE(PG8_SB(0, 1), cB + hstep, voffB); PG8_STAGE(PG8_SA(0, 1), cA + hstep, voffA);
        if (wr == 1) PG8_BAR;
        PG8_WAIT_V(4); PG8_BAR;
        PG8_STAGE(PG8_SB(1, 0), cB + kstep, voffB); PG8_STAGE(PG8_SA(1, 0), cA + kstep, voffA); PG8_STAGE(PG8_SB(1, 1), cB + hstep + kstep, voffB);
        PG8_WAIT_V(6); PG8_BAR;
    }
    for (;;) {
        const bool has_next = S.next(ui + 1, nxt);
        const char* nA = has_next ? (const char*)g.A + (size_t)nxt.pm * tstep : cA; const char* nB = has_next ? (const char*)g.Bt + (size_t)nxt.pn * tstep : cB;
        for (int t = 0; t < nt; t += 2) {
            const bool last = (t == nt - 2);
            const char* a1 = cA + (size_t)(t + 1) * kstep;
            const char* a2 = last ? nA : cA + (size_t)(t + 2) * kstep; const char* b2 = last ? nB : cB + (size_t)(t + 2) * kstep;
            const char* a3 = a2 + kstep; const char* b3 = b2 + kstep;
            if (last && has_next) S.a_ready(nxt);
            if constexpr (SP2) {
            PG8_LDB(B0, 0, 0); PG8_LDB(B1, 0, 1); PG8_SCHED; PG8_LDA(At, 0, 0); PG8_STAGE(PG8_SA(1, 1), a1 + hstep, voffA);
            PG8_WAIT_V(8); PG8_WAIT_L(0); PG8_BAR; PG8_MMA(0, 0, At, B0); PG8_MMA(0, 1, At, B1); PG8_BAR; PG8_SCHED;
            PG8_LDA(At, 0, 1); PG8_STAGE(PG8_SB(0, 0), b2, voffB); PG8_STAGE(PG8_SB(0, 1), b2 + hstep, voffB); PG8_STAGE(PG8_SA(0, 0), a2, voffA);
            PG8_WAIT_V(8); PG8_WAIT_L(0); PG8_BAR; PG8_MMA(1, 0, At, B0); PG8_MMA(1, 1, At, B1); PG8_BAR; PG8_SCHED;
            PG8_LDB(B0, 1, 0); PG8_LDB(B1, 1, 1); PG8_SCHED; PG8_LDA(At, 1, 0); PG8_STAGE(PG8_SA(0, 1), a2 + hstep, voffA);
            PG8_WAIT_V(8); PG8_WAIT_L(0); PG8_BAR; PG8_MMA(0, 0, At, B0); PG8_MMA(0, 1, At, B1); PG8_BAR; PG8_SCHED;
            PG8_LDA(At, 1, 1); PG8_STAGE(PG8_SB(1, 0), b3, voffB); PG8_STAGE(PG8_SB(1, 1), b3 + hstep, voffB); PG8_STAGE(PG8_SA(1, 0), a3, voffA);
            PG8_WAIT_V(8); PG8_WAIT_L(0); PG8_BAR; PG8_MMA(1, 0, At, B0); PG8_MMA(1, 1, At, B1); PG8_BAR; PG8_SCHED;
            } else {
            PG8_LDB(B0, 0, 0); PG8_SCHED; PG8_LDA(At, 0, 0); PG8_STAGE(PG8_SA(1, 1), a1 + hstep, voffA);
            PG8_WAIT_L(8); PG8_BAR; PG8_WAIT_L(0); PG8_MMA(0, 0, At, B0); PG8_BAR; PG8_SCHED;
            PG8_LDB(B1, 0, 1); PG8_STAGE(PG8_SB(0, 0), b2, voffB);
            PG8_BAR; PG8_WAIT_L(0); PG8_MMA(0, 1, At, B1); PG8_BAR;
            PG8_LDA(At, 0, 1); PG8_STAGE(PG8_SA(0, 0), a2, voffA);
            PG8_BAR; PG8_WAIT_L(0); PG8_MMA(1, 0, At, B0); PG8_BAR; PG8_SCHED;
            PG8_STAGE(PG8_SB(0, 1), b2 + hstep, voffB);
            PG8_WAIT_V(6); PG8_BAR; PG8_MMA(1, 1, At, B1); PG8_BAR;
            PG8_LDB(B0, 1, 0); PG8_SCHED; PG8_LDA(At, 1, 0); PG8_STAGE(PG8_SA(0, 1), a2 + hstep, voffA);
            PG8_WAIT_L(8); PG8_BAR; PG8_WAIT_L(0); PG8_MMA(0, 0, At, B0); PG8_BAR; PG8_SCHED;
            PG8_LDB(B1, 1, 1); PG8_STAGE(PG8_SB(1, 0), b3, voffB);
            PG8_BAR; PG8_WAIT_L(0); PG8_MMA(0, 1, At, B1); PG8_BAR;
            PG8_LDA(At, 1, 1); PG8_STAGE(PG8_SA(1, 0), a3, voffA);
            PG8_BAR; PG8_WAIT_L(0); PG8_MMA(1, 0, At, B0); PG8_BAR; PG8_SCHED;
            PG8_STAGE(PG8_SB(1, 1), b3 + hstep, voffB);
            PG8_WAIT_V(6); PG8_BAR; PG8_MMA(1, 1, At, B1); PG8_BAR;
            }
        }
        if constexpr (ALIGN_EPI) { if (wr == 0) PG8_BAR; }
        if constexpr (!Epi::AFTER_DRAIN) { E(acc, cur, wr, wc, fr, fq); S.done(cur); }
        if (!has_next) break;
#pragma unroll
        for (int a = 0; a < 2; ++a)
#pragma unroll
            for (int b = 0; b < 2; ++b)
#pragma unroll
                for (int m = 0; m < 4; ++m)
#pragma unroll
                    for (int n = 0; n < 2; ++n) acc[a][b][m][n] = (f32x4){0.f, 0.f, 0.f, 0.f};
        cur = nxt; cA = nA; cB = nB; ++ui;
        if constexpr (ALIGN_EPI) { if (wr == 1) PG8_BAR; }
    }
    PG8_WAIT_V(0);
    if constexpr (!ALIGN_EPI) { if (wr == 0) PG8_BAR; }
    PG8_BAR;
    if constexpr (Epi::AFTER_DRAIN) { E.fused(acc, cur, wr, wc, fr, fq, lds, wid, lane); S.done(cur); }
#undef PG8_SA
#undef PG8_SB
#undef PG8_STAGE
#undef PG8_LDA
#undef PG8_LDB
#undef PG8_MMA
#undef PG8_WAIT_V
#undef PG8_WAIT_L
#undef PG8_BAR
#undef PG8_SCHED
}
}
constexpr int BATCH = 32, SEQ = 2048, DM = 1024, DEPTH = 4, M = BATCH * SEQ;
constexpr int FF = 4096, PLE = 256, NIN = 4112;
constexpr float EPS = 1e-6f;
constexpr int NWAVES = 8, NTHR = NWAVES * 64;
constexpr int PH_PER_LAYER = 13, NPHASE = 1 + DEPTH * PH_PER_LAYER;
constexpr size_t MiB = 1u << 20;
constexpr size_t WS_CTL = 0, CTL_ZERO_BYTES = 1 * MiB;
constexpr size_t WS_WIN = 1 * MiB, WS_WOUT = 17 * MiB, WS_WQKV = 21 * MiB, WS_WO = 27 * MiB, WS_WUP = 31 * MiB, WS_WDN = 63 * MiB, WS_WPLE = 95 * MiB, WS_WG = 97 * MiB;
constexpr size_t WS_WGATES = 105 * MiB, WS_GT = 106 * MiB, WS_ROPE = 110 * MiB;
constexpr size_t WS_DEN = 126 * MiB;
constexpr size_t WS_RA = 128 * MiB, WS_RB = 256 * MiB, WS_RC = 384 * MiB, WS_RD = 896 * MiB, WS_END = 1024 * MiB;
constexpr size_t WS_QKVA = 128 * MiB, WS_KWT = 320 * MiB, WS_X1 = 384 * MiB, WS_KT = 384 * MiB, WS_UT = 448 * MiB, WS_NW = 512 * MiB, WS_X2 = 576 * MiB, WS_VT = 896 * MiB, WS_ATT = 960 * MiB, WS_PT = 992 * MiB, WS_MIXED = 384 * MiB;
constexpr int CW_BAR = 4096;
constexpr int RING_BYTES = 131072, MISC_OFF = RING_BYTES, LDS_BYTES = RING_BYTES + 1024;

#define GAS __attribute__((address_space(1)))
#define LAS __attribute__((address_space(3)))
typedef unsigned short bf16;
typedef float f32x4 __attribute__((ext_vector_type(4)));
typedef float f32x2 __attribute__((ext_vector_type(2)));
typedef unsigned u32x4 __attribute__((ext_vector_type(4)));
typedef unsigned u32x2 __attribute__((ext_vector_type(2)));
#define LDS_WAIT() asm volatile("s_waitcnt lgkmcnt(0)" ::: "memory")
#define VM_WAIT() asm volatile("s_waitcnt vmcnt(0)" ::: "memory")
using pg8::bf_lo; using pg8::bf_hi;
typedef __bf16 bf16x2_t __attribute__((ext_vector_type(2)));
__device__ __forceinline__ unsigned pk2(float lo, float hi) { return pg8::cvt_pk_bf16(lo, hi); }
__device__ __forceinline__ unsigned pk2v(float lo, float hi) { const f32x2 v = {lo, hi}; const bf16x2_t b = __builtin_convertvector(v, bf16x2_t); return __builtin_bit_cast(unsigned, b); }
__device__ __forceinline__ float wave_sum(float v) {
#pragma unroll
    for (int o = 1; o < 64; o <<= 1) v += __shfl_xor(v, o);
    return v;
}
__device__ __forceinline__ float dot4(f32x4 a, f32x4 b) { return (a.x * b.x + a.y * b.y) + (a.z * b.z + a.w * b.w); }
__device__ __forceinline__ float sigmoid_f(float x) { return 1.f / (1.f + __expf(-x)); }
__device__ __forceinline__ float softplus_f(float x) { return x > 20.f ? x : log1pf(expf(x)); }

#define XB_TMO      128
#define XB_XCNT(j)  (256  + 64 * (j))
#define XB_XSUB(j)  (1280 + 64 * (j))
#define XB_XGEN(j)  (2304 + 64 * (j))
#define XB_TOP      3328
#define XB_TOPGEN   3392
#define XCD_BAR_WORDS 3456
#define XB_SPIN_CAP (1u << 18)

__device__ __forceinline__ unsigned xb_ld(unsigned* p)              { return __hip_atomic_load(p, __ATOMIC_RELAXED, __HIP_MEMORY_SCOPE_AGENT); }
__device__ __forceinline__ unsigned xb_add(unsigned* p, unsigned v) { return __hip_atomic_fetch_add(p, v, __ATOMIC_RELAXED, __HIP_MEMORY_SCOPE_AGENT); }
__device__ __forceinline__ unsigned xb_xcc_id() { return (unsigned)__builtin_amdgcn_s_getreg((3 << 11) | 20) & 0xFu; }
#define XB_SPIN(cond, bar) do { unsigned _sp = 0; while (cond) { __builtin_amdgcn_s_sleep(1); \
    if ((++_sp & 255u) == 0u) { if (xb_ld(&(bar)[XB_TMO])) break; if (_sp > XB_SPIN_CAP) { atomicAdd(&(bar)[XB_TMO], 1u); break; } } } } while (0)

struct XcdBarrier {
    unsigned* bar; unsigned x;
    volatile LAS unsigned* st;
};

__device__ __forceinline__ XcdBarrier xcd_barrier_post(unsigned* bar, volatile LAS unsigned* st) {
    XcdBarrier b; b.bar = bar; b.x = xb_xcc_id(); b.st = st;
    if (threadIdx.x == 0) (void)xb_add(&bar[XB_XCNT(b.x)], 1u);
    return b;
}
__device__ __forceinline__ void xcd_barrier_complete(unsigned* bar, unsigned x, unsigned& nloc, unsigned& nx) {
    const unsigned G = gridDim.x * gridDim.y * gridDim.z;
    unsigned sum, cnt, mine, sp = 0u;
    for (;;) {
        sum = 0u; cnt = 0u; mine = 0u;
#pragma unroll
        for (unsigned j = 0; j < 16; ++j) { const unsigned c = xb_ld(&bar[XB_XCNT(j)]); sum += c; cnt += (c > 0u) ? 1u : 0u; mine = (j == x) ? c : mine; }
        if (sum == G) break;
        __builtin_amdgcn_s_sleep(1);
        if ((++sp & 255u) == 0u) { if (xb_ld(&bar[XB_TMO])) break; if (sp > XB_SPIN_CAP) { atomicAdd(&bar[XB_TMO], 1u); break; } }
    }
    nloc = mine > 0u ? mine : 1u; nx = cnt > 0u ? cnt : 1u;
}

__device__ __forceinline__ void xcd_barrier(const XcdBarrier& b) {
    asm volatile("s_waitcnt vmcnt(0)" ::: "memory");
    __syncthreads();
    if (threadIdx.x == 0) {
        unsigned* bar = b.bar;
        __builtin_amdgcn_s_waitcnt(0);
        unsigned nloc = b.st[0], nx = b.st[1];
        if (nloc == 0u) { xcd_barrier_complete(bar, b.x, nloc, nx); b.st[0] = nloc; b.st[1] = nx; }
        const unsigned old = xb_add(&bar[XB_XSUB(b.x)], 1u);
        const unsigned gen = old / nloc;
        if (old + 1u == (gen + 1u) * nloc) {
            __builtin_amdgcn_fence(__ATOMIC_RELEASE, "agent");
            asm volatile("s_waitcnt vmcnt(0)" ::: "memory");
            const unsigned og = xb_add(&bar[XB_TOP], 1u);
            const unsigned tg = og / nx;
            if (og + 1u == (tg + 1u) * nx) xb_add(&bar[XB_TOPGEN], 1u);
            else XB_SPIN(xb_ld(&bar[XB_TOPGEN]) == tg, bar);
            __builtin_amdgcn_fence(__ATOMIC_ACQUIRE, "agent");
            xb_add(&bar[XB_XGEN(b.x)], 1u);
            asm volatile("s_waitcnt vmcnt(0)" ::: "memory");
        } else {
            XB_SPIN(xb_ld(&bar[XB_XGEN(b.x)]) == gen, bar);
            __builtin_amdgcn_fence(__ATOMIC_ACQUIRE, "agent");
            asm volatile("s_waitcnt vmcnt(0)" ::: "memory");
        }
    }
    __syncthreads();
}
struct Args {
    const float *x, *p; const int* pos; const float *gains, *w_in, *conv, *a_log, *dt_bias, *norm_a, *i_bias, *f_bias, *norm_b, *w_out, *w_qkv, *b_qkv, *sinks, *w_o, *b_o, *w_up, *w_down, *w_ple, *w_gate;
    float* out; unsigned char* ws;
    int ph_lo, ph_hi, dup_mask, dup_par;
};

__device__ __forceinline__ void transpose_item(const float* src, int ld, int K, bf16* dst, LAS float* scr, int item, int nblk, int lane) {
    const int kb = item / nblk, nb = item % nblk, k0 = 64 * kb, n0 = 32 * nb;
#pragma unroll 8
    for (int i = 0; i < 32; ++i) { const int kk = 2 * i + (lane >> 5); scr[kk * 33 + (lane & 31)] = src[(size_t)(k0 + kk) * ld + n0 + (lane & 31)]; }
    LDS_WAIT(); asm volatile("" ::: "memory");
    const int c = lane & 7;
#pragma unroll
    for (int j = 0; j < 4; ++j) { const int n = (lane >> 3) + 8 * j; const LAS float* s = scr + (8 * c) * 33 + n;
        u32x4 o; o.x = pk2(s[0 * 33], s[1 * 33]); o.y = pk2(s[2 * 33], s[3 * 33]); o.z = pk2(s[4 * 33], s[5 * 33]); o.w = pk2(s[6 * 33], s[7 * 33]);
        *(u32x4*)(dst + (size_t)(n0 + n) * K + k0 + 8 * c) = o; }
    LDS_WAIT(); asm volatile("" ::: "memory");
}
__device__ __forceinline__ int gate_col(int c) { return c < 8 ? 1536 + c : 3592 + (c - 8); }

typedef const __attribute__((address_space(4))) Args* KArgs;
__device__ __forceinline__ KArgs kargs() { KArgs p = (KArgs)__builtin_amdgcn_kernarg_segment_ptr(); asm volatile("" : "+s"(p)); return p; }
__device__ __forceinline__ int fresh_tid() { int t = threadIdx.x; asm volatile("" : "+v"(t)); return t; }
__device__ __forceinline__ void prologue_phase(KArgs a, LAS unsigned char* lds, int gw, int NGW, int wave, int lane, int gtid, int NGT) {
    LAS float* scr = (LAS float*)(lds + wave * 16384);
    constexpr int I_IN = 16 * 16, I_SQ = 16 * 32, I_QKV = 16 * 48, I_UP = 16 * 128, I_DN = 64 * 32, I_PLE = 4 * 32;
    constexpr int NITEMS = 16 * I_IN + 2 * I_SQ + 2 * I_QKV + 2 * I_SQ + 4 * I_UP + 4 * I_DN + 4 * I_PLE + 4 * I_SQ;
    unsigned char* ws = a->ws;
    for (int it = gw; it < NITEMS; it += NGW) {
        int r = it;
        if (r < 16 * I_IN) { const int j = r / I_IN, e = j >> 3, s = j & 7, col0 = 512 * s + (s >= 3 ? 8 : 0) + (s >= 7 ? 8 : 0);
            transpose_item(a->w_in + (size_t)e * DM * NIN + col0, NIN, DM, (bf16*)(ws + WS_WIN) + ((size_t)e * 4096 + s * 512) * DM, scr, r % I_IN, 16, lane); continue; } r -= 16 * I_IN;
        if (r < 2 * I_SQ) { const int e = r / I_SQ; transpose_item(a->w_out + (size_t)e * DM * DM, DM, DM, (bf16*)(ws + WS_WOUT) + (size_t)e * DM * DM, scr, r % I_SQ, 32, lane); continue; } r -= 2 * I_SQ;
        if (r < 2 * I_QKV) { const int e = r / I_QKV; transpose_item(a->w_qkv + (size_t)e * DM * 1536, 1536, DM, (bf16*)(ws + WS_WQKV) + (size_t)e * 1536 * DM, scr, r % I_QKV, 48, lane); continue; } r -= 2 * I_QKV;
        if (r < 2 * I_SQ) { const int e = r / I_SQ; transpose_item(a->w_o + (size_t)e * DM * DM, DM, DM, (bf16*)(ws + WS_WO) + (size_t)e * DM * DM, scr, r % I_SQ, 32, lane); continue; } r -= 2 * I_SQ;
        if (r < 4 * I_UP) { const int l = r / I_UP; transpose_item(a->w_up + (size_t)l * DM * FF, FF, DM, (bf16*)(ws + WS_WUP) + (size_t)l * FF * DM, scr, r % I_UP, 128, lane); continue; } r -= 4 * I_UP;
        if (r < 4 * I_DN) { const int l = r / I_DN; transpose_item(a->w_down + (size_t)l * FF * DM, DM, FF, (bf16*)(ws + WS_WDN) + (size_t)l * DM * FF, scr, r % I_DN, 32, lane); continue; } r -= 4 * I_DN;
        if (r < 4 * I_PLE) { const int l = r / I_PLE; transpose_item(a->w_ple + (size_t)l * PLE * DM, DM, PLE, (bf16*)(ws + WS_WPLE) + (size_t)l * DM * PLE, scr, r % I_PLE, 32, lane); continue; } r -= 4 * I_PLE;
        { const int l = r / I_SQ; transpose_item(a->w_gate + (size_t)l * DM * DM, DM, DM, (bf16*)(ws + WS_WG) + (size_t)l * DM * DM, scr, r % I_SQ, 32, lane); }
    }
    float* Wg = (float*)(a->ws + WS_WGATES);
    for (int i = gtid; i < 2 * 16 * 1024; i += NGT) { const int e = i >> 14, c = (i >> 10) & 15, k = i & 1023; Wg[i] = a->w_in[((size_t)e * 1024 + k) * NIN + gate_col(c)]; }
    f32x2* rope = (f32x2*)(a->ws + WS_ROPE);
    for (int i = gtid; i < M * 32; i += NGT) { const int m = i >> 5, d = i & 31;
        const float inv = (float)pow(10000.0, -(double)d / 32.0); const float ang = (float)a->pos[m] * inv; float sn, cs; sincosf(ang, &sn, &cs); rope[i] = (f32x2){cs, sn}; }
}

__device__ __forceinline__ void norm_phase(LAS unsigned char* lds, const float* hin, const float* g0, bf16* HN, bool even, const float* Wg, float* Gt, int gw, int NGW, int tid, int lane) {
    LAS f32x4* wl = (LAS f32x4*)lds;
    if (even) { for (int i = tid; i < 4096; i += NTHR) wl[i] = ((const f32x4*)Wg)[i]; __syncthreads(); }
    f32x4 gv[4];
#pragma unroll
    for (int j = 0; j < 4; ++j) gv[j] = ((const f32x4*)g0)[lane + 64 * j];
    for (int m = gw; m < M; m += NGW) {
        const f32x4* xr = (const f32x4*)(hin + (size_t)m * DM) + lane;
        f32x4 v[4]; float s = 0.f;
#pragma unroll
        for (int j = 0; j < 4; ++j) { v[j] = xr[64 * j]; s += dot4(v[j], v[j]); }
        const float rstd = rsqrtf(wave_sum(s) * (1.f / DM) + EPS);
        u32x2* o8 = (u32x2*)(HN + (size_t)m * DM) + lane;
#pragma unroll
        for (int j = 0; j < 4; ++j) { v[j] = v[j] * rstd * gv[j]; o8[64 * j] = (u32x2){pk2(v[j].x, v[j].y), pk2(v[j].z, v[j].w)}; }
        if (even) {
            float keep = 0.f;
#pragma unroll
            for (int c = 0; c < 16; ++c) { float d = 0.f;
#pragma unroll
                for (int j = 0; j < 4; ++j) d += dot4(v[j], wl[c * 256 + lane + 64 * j]);
                d = wave_sum(d); if (lane == c) keep = d; }
            if (lane < 16) Gt[(size_t)m * 16 + lane] = keep;
        }
    }
    if (even) __syncthreads();
}
__device__ __forceinline__ void resid_a_phase(const bf16* mix, const float* hin, float* out, const float* g1, const float* g2, bf16* HN, int gw, int NGW, int lane) {
    f32x4 ga[4], gb[4];
#pragma unroll
    for (int j = 0; j < 4; ++j) { ga[j] = ((const f32x4*)g1)[lane + 64 * j]; gb[j] = ((const f32x4*)g2)[lane + 64 * j]; }
    for (int m = gw; m < M; m += NGW) {
        const u32x2* xr = (const u32x2*)(mix + (size_t)m * DM) + lane; const f32x4* hr = (const f32x4*)(hin + (size_t)m * DM) + lane;
        f32x4 v[4], h[4]; float s = 0.f;
#pragma unroll
        for (int j = 0; j < 4; ++j) { const u32x2 w = xr[64 * j]; v[j] = (f32x4){bf_lo(w.x), bf_hi(w.x), bf_lo(w.y), bf_hi(w.y)}; h[j] = hr[64 * j]; s += dot4(v[j], v[j]); }
        const float r1 = rsqrtf(wave_sum(s) * (1.f / DM) + EPS); float s2 = 0.f;
        f32x4* orow = (f32x4*)(out + (size_t)m * DM) + lane;
#pragma unroll
        for (int j = 0; j < 4; ++j) { h[j] = h[j] + v[j] * r1 * ga[j]; orow[64 * j] = h[j]; s2 += dot4(h[j], h[j]); }
        const float r2 = rsqrtf(wave_sum(s2) * (1.f / DM) + EPS);
        u32x2* o8 = (u32x2*)(HN + (size_t)m * DM) + lane;
#pragma unroll
        for (int j = 0; j < 4; ++j) { const f32x4 y = h[j] * r2 * gb[j]; o8[64 * j] = (u32x2){pk2(y.x, y.y), pk2(y.z, y.w)}; }
    }
}
__device__ __forceinline__ void resid_b_phase(const bf16* ff, float* out, const float* g3, bf16* HB, const float* pl, bf16* PB, int gw, int NGW, int lane, int gtid, int NGT) {
    f32x4 ga[4];
#pragma unroll
    for (int j = 0; j < 4; ++j) ga[j] = ((const f32x4*)g3)[lane + 64 * j];
    for (int m = gw; m < M; m += NGW) {
        const u32x2* xr = (const u32x2*)(ff + (size_t)m * DM) + lane; f32x4* hr = (f32x4*)(out + (size_t)m * DM) + lane;
        f32x4 v[4], h[4]; float s = 0.f;
#pragma unroll
        for (int j = 0; j < 4; ++j) { const u32x2 w = xr[64 * j]; v[j] = (f32x4){bf_lo(w.x), bf_hi(w.x), bf_lo(w.y), bf_hi(w.y)}; h[j] = hr[64 * j]; s += dot4(v[j], v[j]); }
        const float r1 = rsqrtf(wave_sum(s) * (1.f / DM) + EPS);
        u32x2* o8 = (u32x2*)(HB + (size_t)m * DM) + lane;
#pragma unroll
        for (int j = 0; j < 4; ++j) { h[j] = h[j] + v[j] * r1 * ga[j]; hr[64 * j] = h[j]; o8[64 * j] = (u32x2){pk2(h[j].x, h[j].y), pk2(h[j].z, h[j].w)}; }
    }
    for (int i = gtid; i < M * PLE / 8; i += NGT) { const f32x4 a = ((const f32x4*)pl)[2 * i], b = ((const f32x4*)pl)[2 * i + 1];
        ((u32x4*)PB)[i] = (u32x4){pk2(a.x, a.y), pk2(a.z, a.w), pk2(b.x, b.y), pk2(b.z, b.w)}; }
}
__device__ __forceinline__ void conv_phase(const bf16* X1, const float* convw  , bf16* QKVA, int gw, int NGW, int lane) {
    constexpr int RPW = 32;
    for (int blk = gw; blk < M / RPW; blk += NGW) {
        const int mb = blk * RPW;
#pragma unroll 1
        for (int j = 0; j < 3; ++j) {
            const int col = j * 512 + lane * 8;
            u32x4 h0, h1, h2;
            { const bool first = (mb & (SEQ - 1)) == 0; const u32x4 z = {0u, 0u, 0u, 0u};
              h0 = first ? z : *(const u32x4*)(X1 + (size_t)(mb - 3) * 1536 + col); h1 = first ? z : *(const u32x4*)(X1 + (size_t)(mb - 2) * 1536 + col); h2 = first ? z : *(const u32x4*)(X1 + (size_t)(mb - 1) * 1536 + col); }
            f32x4 w[4][2];
#pragma unroll
            for (int kk = 0; kk < 4; ++kk) { w[kk][0] = *(const f32x4*)(convw + kk * 1536 + col); w[kk][1] = *(const f32x4*)(convw + kk * 1536 + col + 4); }
#pragma unroll 2
            for (int r = 0; r < RPW; ++r) {
                const int m = mb + r;
                const u32x4 cur = *(const u32x4*)(X1 + (size_t)m * 1536 + col);
                const u32x4 xs[4] = {h0, h1, h2, cur};
                float acc[8];
#pragma unroll
                for (int i = 0; i < 8; ++i) acc[i] = 0.f;
#pragma unroll
                for (int kk = 0; kk < 4; ++kk) { const u32x4 xv = xs[kk]; const f32x4 w0 = w[kk][0], w1 = w[kk][1];
                    acc[0] += bf_lo(xv.x) * w0.x; acc[1] += bf_hi(xv.x) * w0.y; acc[2] += bf_lo(xv.y) * w0.z; acc[3] += bf_hi(xv.y) * w0.w;
                    acc[4] += bf_lo(xv.z) * w1.x; acc[5] += bf_hi(xv.z) * w1.y; acc[6] += bf_lo(xv.w) * w1.z; acc[7] += bf_hi(xv.w) * w1.w; }
                h0 = h1; h1 = h2; h2 = cur;
                float ss = 0.f;
#pragma unroll
                for (int i = 0; i < 8; ++i) { acc[i] = acc[i] / (1.f + __expf(-acc[i])); ss += acc[i] * acc[i]; }
                if (j < 2) { ss += __shfl_xor(ss, 1); ss += __shfl_xor(ss, 2); ss += __shfl_xor(ss, 4); ss += __shfl_xor(ss, 8);
                    const float sc = rsqrtf(ss + EPS) * (j == 0 ? 0.08838834764831845f : 1.f);
#pragma unroll
                    for (int i = 0; i < 8; ++i) acc[i] *= sc; }
                *(u32x4*)(QKVA + (size_t)m * 1536 + col) = (u32x4){pk2(acc[0], acc[1]), pk2(acc[2], acc[3]), pk2(acc[4], acc[5]), pk2(acc[6], acc[7])};
            }
        }
    }
}
__device__ __forceinline__ void rope_phase(bf16* QKV, const f32x2* rope, int gw, int NGW, int lane) {
    for (int m = gw; m < M; m += NGW) {
        const int grp = lane & 7; const f32x4* tb = (const f32x4*)(rope + (size_t)m * 32 + grp * 4); const f32x4 t0 = tb[0], t1 = tb[1];
        const float cs[4] = {t0.x, t0.z, t1.x, t1.z}, sn[4] = {t0.y, t0.w, t1.y, t1.w};
#pragma unroll
        for (int k = 0; k < 3; ++k) {
            if (k == 2 && lane >= 32) break;
            const int hh = (k < 2) ? ((lane + 64 * k) >> 3) : (lane >> 3); const float scale = (k < 2) ? 0.125f : 1.f;
            bf16* base = QKV + (size_t)m * 1536 + (k < 2 ? 0 : 1024) + hh * 64 + grp * 4;
            const u32x2 a = *(const u32x2*)base, b = *(const u32x2*)(base + 32);
            const float x1[4] = {bf_lo(a.x), bf_hi(a.x), bf_lo(a.y), bf_hi(a.y)}, x2[4] = {bf_lo(b.x), bf_hi(b.x), bf_lo(b.y), bf_hi(b.y)};
            float o1[4], o2[4];
#pragma unroll
            for (int i = 0; i < 4; ++i) { o1[i] = (x1[i] * cs[i] - x2[i] * sn[i]) * scale; o2[i] = (x2[i] * cs[i] + x1[i] * sn[i]) * scale; }
            *(u32x2*)base = (u32x2){pk2(o1[0], o1[1]), pk2(o1[2], o1[3])}; *(u32x2*)(base + 32) = (u32x2){pk2(o2[0], o2[1]), pk2(o2[2], o2[3])};
        }
    }
}
typedef short bf16x8 __attribute__((ext_vector_type(8)));
#define MFMA16(a, b, c) __builtin_amdgcn_mfma_f32_16x16x32_bf16(a, b, c, 0, 0, 0)
__device__ __forceinline__ bf16x8 pack8(f32x4 a, f32x4 b) { const u32x4 w = {pk2v(a.x, a.y), pk2v(a.z, a.w), pk2v(b.x, b.y), pk2v(b.z, b.w)}; return __builtin_bit_cast(bf16x8, w); }
__device__ __forceinline__ float bf2f(unsigned short v) { return __builtin_bit_cast(float, (unsigned)v << 16); }
__device__ __forceinline__ float rdlane(float v, int i) { return __builtin_bit_cast(float, __builtin_amdgcn_readlane(__builtin_bit_cast(int, v), i)); }
__device__ __forceinline__ float scan_add(float v, int lane) {
#pragma unroll
    for (int o = 1; o < 64; o <<= 1) { const float t = __shfl_up(v, o); if (lane >= o) v += t; }
    return v; }
__device__ __forceinline__ float scan_max(float v, int lane) {
#pragma unroll
    for (int o = 1; o < 64; o <<= 1) { const float t = __shfl_up(v, o); if (lane >= o) v = fmaxf(v, t); }
    return v; }
__device__ __forceinline__ int kperm(int ks, int q, int jj) { return 32 * ks + (jj < 4 ? 4 * q + jj : 16 + 4 * q + jj - 4); }
template <bool SCALE> __device__ __forceinline__ u32x4 tr_gather(const bf16* src  , int ld, int ks, int q, float esc_lane) {
    unsigned w[4];
#pragma unroll
    for (int j2 = 0; j2 < 4; ++j2) { const int r0 = kperm(ks, q, 2 * j2), r1 = r0 + 1; const unsigned short a = src[(size_t)r0 * ld], b = src[(size_t)r1 * ld];
        if (SCALE) { const float s0 = __shfl(esc_lane, r0), s1 = __shfl(esc_lane, r1); w[j2] = pk2(bf2f(a) * s0, bf2f(b) * s1); } else w[j2] = (unsigned)a | ((unsigned)b << 16); }
    return (u32x4){w[0], w[1], w[2], w[3]};
}
struct ScanBufs {
    bf16* QKVA;
    bf16* X2;
    float* Gt;
    bf16 *KT, *UT, *NW, *ATT;
    bf16 *KWT, *VT, *PT;
    float* DEN;
};
__device__ __forceinline__ void local_phase(LAS unsigned char* lds, const ScanBufs sb, const float* a_log, const float* dt_bias, const float* i_bias, const float* f_bias, int gw, int NGW, int wave, int lane) {
    LAS float* Lw = (LAS float*)(lds + wave * 16384);
    const int njobs = 2 * BATCH * 4 * (SEQ / 64), per = (njobs + NGW - 1) / NGW; const int lane_in = lane;
#pragma unroll 1
    for (int rj = 0; rj < per; ++rj) {
        const int job = gw * per + rj; if (job >= njobs) break;
        int lane = lane_in; asm volatile("" : "+v"(lane));
        const int x = lane & 15, q = lane >> 4;
        const int mixer = job & 1, cidx = job >> 1, c = cidx & 31, h = (cidx >> 5) & 3, b = cidx >> 7;
        const int m0 = b * SEQ + c * 64; const size_t cid = (size_t)cidx;
        float* gr = sb.Gt + (size_t)(m0 + lane) * 16;
        if (mixer == 0) {
            const float beta = 1.f / (1.f + expf(-gr[h])); const float g = -expf(a_log[h]) * softplus_f(gr[4 + h] + dt_bias[h]);
            const float gcum = scan_add(g, lane), eg = expf(gcum), glast = __shfl(gcum, 63);
            const bf16* kb = sb.QKVA + (size_t)m0 * 1536 + 512 + h * 128; const bf16* qb = sb.QKVA + (size_t)m0 * 1536 + h * 128; const bf16* vb = kb + 512;
            bf16x8 Kf[4][4], Qf[4][4];
#pragma unroll
            for (int t = 0; t < 4; ++t)
#pragma unroll
                for (int ks = 0; ks < 4; ++ks) { Kf[t][ks] = *(const bf16x8*)(kb + (size_t)(16 * t + x) * 1536 + 32 * ks + 8 * q); Qf[t][ks] = *(const bf16x8*)(qb + (size_t)(16 * t + x) * 1536 + 32 * ks + 8 * q); }
            float gj[4][4];
#pragma unroll
            for (int jt = 0; jt < 4; ++jt)
#pragma unroll
                for (int r = 0; r < 4; ++r) gj[jt][r] = __shfl(gcum, 16 * jt + 4 * q + r);
            bf16* attp = sb.ATT + cid * 4096;
#pragma unroll
            for (int it = 0; it < 4; ++it) {
                const float gi = __shfl(gcum, 16 * it + x), bi = __shfl(beta, 16 * it + x); f32x4 d2s[4];
#pragma unroll
                for (int jt = 0; jt < 4; ++jt) {
                    if (jt <= it) { f32x4 D1 = {0.f, 0.f, 0.f, 0.f}, D2 = D1;
#pragma unroll
                        for (int ks = 0; ks < 4; ++ks) { D1 = MFMA16(Kf[jt][ks], Kf[it][ks], D1); D2 = MFMA16(Kf[jt][ks], Qf[it][ks], D2); }
                        f32x4 lv;
#pragma unroll
                        for (int r = 0; r < 4; ++r) { const int j = 16 * jt + 4 * q + r, i = 16 * it + x; const float dec = __expf(fminf(gi - gj[jt][r], 0.f));
                            lv[r] = (j < i) ? bi * D1[r] * dec : 0.f; d2s[jt][r] = (j <= i) ? D2[r] * dec : 0.f; }
#pragma unroll
                        for (int r = 0; r < 4; ++r) Lw[(16 * jt + 4 * q + r) * 64 + 16 * it + x] = lv[r];
                    } else d2s[jt] = (f32x4){0.f, 0.f, 0.f, 0.f};
                }
#pragma unroll
                for (int kp = 0; kp < 2; ++kp) if (it >= 2 || kp == 0) *(bf16x8*)(attp + ((it * 2 + kp) * 64 + lane) * 8) = pack8(d2s[2 * kp], d2s[2 * kp + 1]);
            }
            { float* tab = (float*)(attp + 512); tab[lane] = eg; tab[64 + lane] = expf(glast - gcum); }
            bf16* ktp = sb.KT + cid * 8192;
#pragma unroll 1
            for (int dt = 0; dt < 8; ++dt)
#pragma unroll
                for (int kp = 0; kp < 2; ++kp) *(u32x4*)(ktp + ((dt * 2 + kp) * 64 + lane) * 8) = tr_gather<false>(kb + 16 * dt + x, 1536, kp, q, 0.f);
            LDS_WAIT();
            const float be = beta * eg;
#pragma unroll 1
            for (int p = 0; p < 4; ++p) {
                const int col = 64 * (p & 1) + lane; const bf16* src = (p < 2 ? vb : kb) + col; const float scl = p < 2 ? beta : be;
                float xv[64];
#pragma unroll
                for (int i = 0; i < 64; ++i) xv[i] = bf2f(src[(size_t)i * 1536]);
                asm volatile("" ::: "memory");
#pragma unroll
                for (int i = 0; i < 64; ++i) xv[i] *= rdlane(scl, i);
#pragma unroll
                for (int j = 0; j < 63; ++j) {
#pragma unroll
                    for (int g4 = (j + 1) / 4; g4 < 16; ++g4) { const f32x4 lc = *(const LAS f32x4*)(Lw + j * 64 + 4 * g4);
                        if (4 * g4 + 0 > j) xv[4 * g4 + 0] -= lc.x * xv[j]; if (4 * g4 + 1 > j) xv[4 * g4 + 1] -= lc.y * xv[j]; if (4 * g4 + 2 > j) xv[4 * g4 + 2] -= lc.z * xv[j]; if (4 * g4 + 3 > j) xv[4 * g4 + 3] -= lc.w * xv[j]; }
                }
                if (p < 2) { bf16* ut = sb.UT + cid * 8192 + (size_t)col * 64;
#pragma unroll
                    for (int k8 = 0; k8 < 8; ++k8) *(u32x4*)(ut + 8 * k8) = (u32x4){pk2(xv[8 * k8], xv[8 * k8 + 1]), pk2(xv[8 * k8 + 2], xv[8 * k8 + 3]), pk2(xv[8 * k8 + 4], xv[8 * k8 + 5]), pk2(xv[8 * k8 + 6], xv[8 * k8 + 7])};
                } else { const int d = col, ks = d >> 5, dd = d & 31, qp = (dd & 15) >> 2, jj = (dd & 3) + 4 * (dd >> 4);
                    unsigned char* nw = (unsigned char*)(sb.NW + cid * 8192) + ks * 1024 + qp * 256 + jj * 2;
#pragma unroll
                    for (int i = 0; i < 64; ++i) *(unsigned short*)(nw + (i >> 4) * 4096 + (i & 15) * 16) = (unsigned short)(pk2(-xv[i], 0.f) & 0xffffu);
                }
            }
            LDS_WAIT();
        } else {
            const float il = gr[8 + h] + i_bias[h]; const float fl = -softplus_f(-(gr[12 + h] + f_bias[h]));
            const float bcum = scan_add(fl, lane), t = il - bcum, pm = scan_max(t, lane), pml = __shfl(pm, 63);
            const float esc = __expf(t - pml);
            const bf16* qb = sb.X2 + (size_t)m0 * 2560 + 512 + h * 128; const bf16* kb = qb + 512; const bf16* vb = kb + 512;
            bf16x8 Kf[4][4], Qf[4][4];
#pragma unroll
            for (int tt = 0; tt < 4; ++tt)
#pragma unroll
                for (int ks = 0; ks < 4; ++ks) { Kf[tt][ks] = *(const bf16x8*)(kb + (size_t)(16 * tt + x) * 2560 + 32 * ks + 8 * q); Qf[tt][ks] = *(const bf16x8*)(qb + (size_t)(16 * tt + x) * 2560 + 32 * ks + 8 * q); }
            float tj[4][4];
#pragma unroll
            for (int jt = 0; jt < 4; ++jt)
#pragma unroll
                for (int r = 0; r < 4; ++r) tj[jt][r] = __shfl(t, 16 * jt + 4 * q + r);
            bf16* ptp = sb.PT + cid * 4096;
#pragma unroll
            for (int it = 0; it < 4; ++it) {
                const float pmi = __shfl(pm, 16 * it + x); f32x4 d2s[4];
#pragma unroll
                for (int jt = 0; jt < 4; ++jt) {
                    if (jt <= it) { f32x4 D2 = {0.f, 0.f, 0.f, 0.f};
#pragma unroll
                        for (int ks = 0; ks < 4; ++ks) D2 = MFMA16(Kf[jt][ks], Qf[it][ks], D2);
#pragma unroll
                        for (int r = 0; r < 4; ++r) { const int j = 16 * jt + 4 * q + r, i = 16 * it + x; d2s[jt][r] = (j <= i) ? D2[r] * 0.08838834764831845f * __expf(fminf(tj[jt][r] - pmi, 0.f)) : 0.f; }
                    } else d2s[jt] = (f32x4){0.f, 0.f, 0.f, 0.f};
                }
#pragma unroll
                for (int kp = 0; kp < 2; ++kp) if (it >= 2 || kp == 0) *(bf16x8*)(ptp + ((it * 2 + kp) * 64 + lane) * 8) = pack8(d2s[2 * kp], d2s[2 * kp + 1]);
            }
            { float* tab = (float*)(ptp + 512); tab[lane] = bcum; tab[64 + lane] = bcum + pm; }
            bf16* kwp = sb.KWT + cid * 8192; bf16* vtp = sb.VT + cid * 8192;
#pragma unroll 1
            for (int dt = 0; dt < 8; ++dt)
#pragma unroll
                for (int kp = 0; kp < 2; ++kp) { *(u32x4*)(kwp + ((dt * 2 + kp) * 64 + lane) * 8) = tr_gather<true>(kb + 16 * dt + x, 2560, kp, q, esc);
                    *(u32x4*)(vtp + ((dt * 2 + kp) * 64 + lane) * 8) = tr_gather<false>(vb + 16 * dt + x, 2560, kp, q, 0.f); }
        }
    }
}
constexpr int RC_NW = 0, RC_ATT = 16384, RC_KT = 24576, RC_QP = 40960, RC_BUF = 57344;
__device__ __forceinline__ void recur_stage(LAS unsigned char* buf, const bf16* f16a  , const bf16* f8  , const bf16* f16b  , const bf16* qbase  , int qpitch, int wave, int lane) {
#pragma unroll
    for (int k = 0; k < 5; ++k) { const int bl = wave + 8 * k;
        const bf16* src = bl < 16 ? f16a + bl * 512 : (bl < 24 ? f8 + (bl - 16) * 512 : f16b + (bl - 24) * 512);
        __builtin_amdgcn_global_load_lds((const unsigned*)(src + lane * 8), (LAS unsigned*)(buf + bl * 1024), 16, 0, 0); }
#pragma unroll
    for (int k = 0; k < 8; ++k) { const int P = (wave * 8 + k) * 256 + lane * 4, f = P >> 10, lp = (P & 1023) >> 4, jj0 = ((P & 15) >> 2) * 2, it = f >> 2, ks = f & 3, xp = lp & 15, qp = lp >> 4;
        const bf16* src = qbase + (size_t)(16 * it + xp) * qpitch + kperm(ks, qp, jj0);
        __builtin_amdgcn_global_load_lds((const unsigned*)src, (LAS unsigned*)(buf + RC_QP + (wave * 8 + k) * 256), 4, 0, 0); }
}
__device__ __forceinline__ void recur_phase(LAS unsigned char* lds, const ScanBufs sb, int G, int bid, int wave, int lane) {
    const int x = lane & 15, q = lane >> 4, et = wave;
#pragma unroll 1
    for (int u = bid; u < 2 * BATCH * 4; u += G) {
        const int mixer = u >> 7, b = (u & 127) >> 2, h = u & 3;
        const size_t cid0 = (size_t)((b * 4 + h) * 32);
        if (mixer == 0) {
            f32x4 S[8];
#pragma unroll
            for (int d = 0; d < 8; ++d) S[d] = (f32x4){0.f, 0.f, 0.f, 0.f};
            recur_stage(lds, sb.NW + cid0 * 8192, sb.ATT + cid0 * 4096, sb.KT + cid0 * 8192, sb.QKVA + (size_t)(b * SEQ) * 1536 + h * 128, 1536, wave, lane);
            __syncthreads();
#pragma unroll 1
            for (int c = 0; c < SEQ / 64; ++c) {
                const int m0 = b * SEQ + c * 64; const size_t cid = cid0 + c;
                const LAS unsigned char* buf = lds + (c & 1) * RC_BUF;
                { const int cn = c + 1 < SEQ / 64 ? c + 1 : c; const size_t cidn = cid0 + cn;
                  recur_stage(lds + ((c + 1) & 1) * RC_BUF, sb.NW + cidn * 8192, sb.ATT + cidn * 4096, sb.KT + cidn * 8192, sb.QKVA + (size_t)(b * SEQ + cn * 64) * 1536 + h * 128, 1536, wave, lane); }
                const bf16* utp = sb.UT + cid * 8192 + (size_t)(16 * et + x) * 64;
                const LAS float* tab = (const LAS float*)(buf + RC_ATT + 1024);
                bf16x8 Sb[4];
#pragma unroll
                for (int ks = 0; ks < 4; ++ks) Sb[ks] = pack8(S[2 * ks], S[2 * ks + 1]);
                f32x4 vn[4];
#pragma unroll
                for (int mt = 0; mt < 4; ++mt) { const u32x2 uu = *(const u32x2*)(utp + 16 * mt + 4 * q); f32x4 acc = {bf_lo(uu.x), bf_hi(uu.x), bf_lo(uu.y), bf_hi(uu.y)};
#pragma unroll
                    for (int ks = 0; ks < 4; ++ks) acc = MFMA16(*(const LAS bf16x8*)(buf + RC_NW + ((mt * 4 + ks) * 64 + lane) * 16), Sb[ks], acc);
                    vn[mt] = acc; }
                bf16x8 vb2[2] = {pack8(vn[0], vn[1]), pack8(vn[2], vn[3])};
#pragma unroll
                for (int it = 0; it < 4; ++it) { f32x4 acc = {0.f, 0.f, 0.f, 0.f};
#pragma unroll
                    for (int ks = 0; ks < 4; ++ks) acc = MFMA16(Sb[ks], *(const LAS bf16x8*)(buf + RC_QP + ((it * 4 + ks) * 64 + lane) * 16), acc);
                    acc = acc * tab[16 * it + x];
#pragma unroll
                    for (int kp = 0; kp < 2; ++kp) if (it >= 2 || kp == 0) acc = MFMA16(vb2[kp], *(const LAS bf16x8*)(buf + RC_ATT + ((it * 2 + kp) * 64 + lane) * 16), acc);
                    *(u32x2*)(sb.QKVA + (size_t)(m0 + 16 * it + x) * 1536 + 512 + h * 128 + 16 * et + 4 * q) = (u32x2){pk2v(acc.x, acc.y), pk2v(acc.z, acc.w)}; }
                f32x4 vs[4];
#pragma unroll
                for (int mt = 0; mt < 4; ++mt) { const f32x4 kk = *(const LAS f32x4*)(tab + 64 + 16 * mt + 4 * q); vs[mt] = vn[mt] * kk; }
                const bf16x8 vsb[2] = {pack8(vs[0], vs[1]), pack8(vs[2], vs[3])};
                const float gam = tab[63];
#pragma unroll
                for (int dt = 0; dt < 8; ++dt) { f32x4 acc = S[dt] * gam;
#pragma unroll
                    for (int kp = 0; kp < 2; ++kp) acc = MFMA16(*(const LAS bf16x8*)(buf + RC_KT + ((dt * 2 + kp) * 64 + lane) * 16), vsb[kp], acc);
                    S[dt] = acc; }
                __syncthreads();
            }
        } else {
            f32x4 Cs[8], Ce[8]; float mrun = 0.f;
#pragma unroll
            for (int d = 0; d < 8; ++d) { Cs[d] = (f32x4){0.f, 0.f, 0.f, 0.f}; Ce[d] = Cs[d]; }
            const short one = (x == 0) ? (short)0x3F80 : (short)0; const bf16x8 ones = {one, one, one, one, one, one, one, one};
            recur_stage(lds, sb.KWT + cid0 * 8192, sb.PT + cid0 * 4096, sb.KWT + cid0 * 8192, sb.X2 + (size_t)(b * SEQ) * 2560 + 512 + h * 128, 2560, wave, lane);
            __syncthreads();
#pragma unroll 1
            for (int c = 0; c < SEQ / 64; ++c) {
                const int m0 = b * SEQ + c * 64; const size_t cid = cid0 + c;
                const LAS unsigned char* buf = lds + (c & 1) * RC_BUF;
                { const int cn = c + 1 < SEQ / 64 ? c + 1 : c; const size_t cidn = cid0 + cn;
                  recur_stage(lds + ((c + 1) & 1) * RC_BUF, sb.KWT + cidn * 8192, sb.PT + cidn * 4096, sb.KWT + cidn * 8192, sb.X2 + (size_t)(b * SEQ + cn * 64) * 2560 + 512 + h * 128, 2560, wave, lane); }
                const bf16* vtp = sb.VT + cid * 8192;
                const LAS float* tab = (const LAS float*)(buf + RC_ATT + 1024);
                bf16x8 Cb[4], Eb[4];
#pragma unroll
                for (int ks = 0; ks < 4; ++ks) { Cb[ks] = pack8(Cs[2 * ks], Cs[2 * ks + 1]); Eb[ks] = pack8(Ce[2 * ks], Ce[2 * ks + 1]); }
                const bf16x8 vf[2] = {*(const bf16x8*)(vtp + ((et * 2 + 0) * 64 + lane) * 8), *(const bf16x8*)(vtp + ((et * 2 + 1) * 64 + lane) * 8)};
#pragma unroll
                for (int it = 0; it < 4; ++it) {
                    const float bc = tab[16 * it + x], mi = tab[64 + 16 * it + x];
                    const float a = bc + mrun, mt = fmaxf(a, mi), f1 = __expf(a - mt) * 0.08838834764831845f, f2 = __expf(mi - mt);
                    f32x4 a1 = {0.f, 0.f, 0.f, 0.f}, aP = a1, e1 = a1, eP = a1;
#pragma unroll
                    for (int ks = 0; ks < 4; ++ks) { const bf16x8 qf = *(const LAS bf16x8*)(buf + RC_QP + ((it * 4 + ks) * 64 + lane) * 16);
                        a1 = MFMA16(Cb[ks], qf, a1); if (wave == 0) e1 = MFMA16(Eb[ks], qf, e1); }
#pragma unroll
                    for (int kp = 0; kp < 2; ++kp) if (it >= 2 || kp == 0) { const bf16x8 pf = *(const LAS bf16x8*)(buf + RC_ATT + ((it * 2 + kp) * 64 + lane) * 16); aP = MFMA16(vf[kp], pf, aP); if (wave == 0) eP = MFMA16(ones, pf, eP); }
                    const f32x4 nm = a1 * f1 + aP * f2;
                    *(u32x2*)(sb.X2 + (size_t)(m0 + 16 * it + x) * 2560 + 1024 + h * 128 + 16 * et + 4 * q) = (u32x2){pk2(nm.x, nm.y), pk2(nm.z, nm.w)};
                    if (wave == 0 && q == 0) sb.DEN[(size_t)(m0 + 16 * it + x) * 4 + h] = fmaxf(fabsf(e1.x * f1 + eP.x * f2), __expf(-mt));
                }
                const float blast = tab[63], wsmax = tab[127];
                const float mnew = fmaxf(blast + mrun, wsmax), sc = __expf(blast + mrun - mnew), s2 = __expf(wsmax - mnew); mrun = mnew;
#pragma unroll
                for (int dt = 0; dt < 8; ++dt) { f32x4 dC = {0.f, 0.f, 0.f, 0.f}, dE = dC;
#pragma unroll
                    for (int kp = 0; kp < 2; ++kp) { const bf16x8 kf = *(const LAS bf16x8*)(buf + RC_KT + ((dt * 2 + kp) * 64 + lane) * 16); dC = MFMA16(kf, vf[kp], dC); if (wave == 0) dE = MFMA16(kf, ones, dE); }
                    Cs[dt] = Cs[dt] * sc + dC * s2; if (wave == 0) Ce[dt] = Ce[dt] * sc + dE * s2; }
                __syncthreads();
            }
        }
    }
}
__device__ __forceinline__ void post_phase(const ScanBufs sb, const float* norm_a, const float* norm_b, bf16* MIXED, int gw, int NGW, int lane) {
    const int hh = lane >> 3, sub = (lane & 7) * 16;
    for (int m = gw; m < M; m += NGW) {
        const bool isA = hh < 4; const int h = hh & 3;
        const bf16* src = isA ? sb.QKVA + (size_t)m * 1536 + 512 + h * 128 + sub : sb.X2 + (size_t)m * 2560 + 1024 + h * 128 + sub;
        const bf16* gsrc = sb.X2 + (size_t)m * 2560 + (isA ? 0 : 2048) + h * 128 + sub;
        const float* gn = (isA ? norm_a : norm_b + h * 128) + sub;
        const u32x4 r0 = *(const u32x4*)src, r1 = *(const u32x4*)(src + 8), z0 = *(const u32x4*)gsrc, z1 = *(const u32x4*)(gsrc + 8);
        float v[16] = {bf_lo(r0.x), bf_hi(r0.x), bf_lo(r0.y), bf_hi(r0.y), bf_lo(r0.z), bf_hi(r0.z), bf_lo(r0.w), bf_hi(r0.w), bf_lo(r1.x), bf_hi(r1.x), bf_lo(r1.y), bf_hi(r1.y), bf_lo(r1.z), bf_hi(r1.z), bf_lo(r1.w), bf_hi(r1.w)};
        const float z[16] = {bf_lo(z0.x), bf_hi(z0.x), bf_lo(z0.y), bf_hi(z0.y), bf_lo(z0.z), bf_hi(z0.z), bf_lo(z0.w), bf_hi(z0.w), bf_lo(z1.x), bf_hi(z1.x), bf_lo(z1.y), bf_hi(z1.y), bf_lo(z1.z), bf_hi(z1.z), bf_lo(z1.w), bf_hi(z1.w)};
        const float dinv = isA ? 1.f : 1.f / sb.DEN[(size_t)m * 4 + h];
        float ss = 0.f;
#pragma unroll
        for (int i = 0; i < 16; ++i) { v[i] *= dinv; ss += v[i] * v[i]; }
        ss += __shfl_xor(ss, 1); ss += __shfl_xor(ss, 2); ss += __shfl_xor(ss, 4);
        const float rstd = rsqrtf(ss * (1.f / 128.f) + EPS);
        float y[16];
#pragma unroll
        for (int i = 0; i < 16; ++i) { const float sg = sigmoid_f(z[i]); y[i] = v[i] * rstd * gn[i] * (isA ? z[i] * sg : sg); }
        u32x4* dst = (u32x4*)(MIXED + (size_t)m * 1024 + lane * 16);
        dst[0] = (u32x4){pk2(y[0], y[1]), pk2(y[2], y[3]), pk2(y[4], y[5]), pk2(y[6], y[7])}; dst[1] = (u32x4){pk2(y[8], y[9]), pk2(y[10], y[11]), pk2(y[12], y[13]), pk2(y[14], y[15])};
    }
}
typedef short v4i16_t __attribute__((ext_vector_type(4)));
constexpr int AT_VROW = 80;
constexpr int AT_K_BYTES = 256 * 128, AT_V_BYTES = 272 * AT_VROW * 2;
__device__ __forceinline__ void attn_phase(LAS unsigned char* lds, int tid, int wave, const bf16* QKV, const float* sinks, bf16* O, int G, int bid) {
    LAS unsigned char* KL = lds; LAS unsigned char* VL = lds + AT_K_BYTES;
    const int lane = tid & 63, x = lane & 15, q = lane >> 4, g = wave >> 1, qh = wave & 1;
#pragma unroll 1
    for (int u = bid; u < BATCH * 4 * 16; u += G) {
        const int b = u >> 6, kvh = (u >> 4) & 3, jb = u & 15;
#pragma unroll
        for (int i = 0; i < 4; ++i) { const int item = tid + 512 * i, r = item >> 3, ch = item & 7, sk = (jb - 1) * 128 + r;
            u32x4 kv = (u32x4){0u, 0u, 0u, 0u}, vv = kv;
            if (sk >= 0) { const bf16* src = QKV + (size_t)(b * SEQ + sk) * 1536 + 1024 + kvh * 64 + ch * 8; kv = *(const u32x4*)src; vv = *(const u32x4*)(src + 256); }
            *(LAS u32x4*)(KL + r * 128 + ((ch ^ (r & 7)) << 4)) = kv; *(LAS u32x4*)(VL + r * (AT_VROW * 2) + ch * 16) = vv; }
        if (tid < 128) { const int r = 256 + (tid >> 3), ch = tid & 7; *(LAS u32x4*)(VL + r * (AT_VROW * 2) + ch * 16) = (u32x4){0u, 0u, 0u, 0u}; }
        __syncthreads();
        const int hq = kvh * 4 + g; const float sink = sinks[hq];
        const size_t mq = (size_t)b * SEQ + jb * 128 + 64 * qh;
#pragma unroll 1
        for (int nt = 0; nt < 4; ++nt) {
            bf16x8 Qf[2];
#pragma unroll
            for (int ks = 0; ks < 2; ++ks) Qf[ks] = *(const bf16x8*)(QKV + (mq + 16 * nt + x) * 1536 + hq * 64 + 32 * ks + 8 * q);
            f32x4 s[9]; float mx = -3.0e38f;
#pragma unroll
            for (int j = 0; j < 9; ++j) { const int kt = nt + j, r = 64 * qh + 16 * kt + x;
                f32x4 acc = {0.f, 0.f, 0.f, 0.f};
#pragma unroll
                for (int ks = 0; ks < 2; ++ks) acc = MFMA16(*(const LAS bf16x8*)(KL + r * 128 + (((4 * ks + q) ^ (r & 7)) << 4)), Qf[ks], acc);
#pragma unroll
                for (int rg = 0; rg < 4; ++rg) { const int diff = 16 * j + 4 * q + rg - x, ra = 64 * qh + 16 * kt + 4 * q + rg;
                    const bool valid = diff >= 1 && diff <= 128 && (jb - 1) * 128 + ra >= 0;
                    acc[rg] = valid ? acc[rg] : -3.0e38f; mx = fmaxf(mx, acc[rg]); }
                s[j] = acc; }
            mx = fmaxf(mx, __shfl_xor(mx, 16)); mx = fmaxf(mx, __shfl_xor(mx, 32)); mx = fmaxf(mx, sink);
            float sum = 0.f;
#pragma unroll
            for (int j = 0; j < 9; ++j)
#pragma unroll
                for (int rg = 0; rg < 4; ++rg) { const float p = (s[j][rg] > -1.0e38f) ? __expf(s[j][rg] - mx) : 0.f; s[j][rg] = p; sum += p; }
            sum += __shfl_xor(sum, 16); sum += __shfl_xor(sum, 32);
            const float inv = 1.f / (sum + __expf(sink - mx));
            bf16x8 Pf[5];
#pragma unroll
            for (int j2 = 0; j2 < 4; ++j2) Pf[j2] = pack8(s[2 * j2], s[2 * j2 + 1]);
            Pf[4] = pack8(s[8], (f32x4){0.f, 0.f, 0.f, 0.f});
#pragma unroll
            for (int dt = 0; dt < 4; ++dt) { f32x4 acc = {0.f, 0.f, 0.f, 0.f};
#pragma unroll
                for (int j2 = 0; j2 < 5; ++j2) { const int kb = 64 * qh + 16 * (nt + 2 * j2) + 4 * q + (x >> 2);
                    const LAS unsigned char* p0 = VL + kb * (AT_VROW * 2) + (16 * dt + 4 * (x & 3)) * 2;
                    const v4i16_t lo = __builtin_amdgcn_ds_read_tr16_b64_v4i16((LAS v4i16_t*)p0), hi = __builtin_amdgcn_ds_read_tr16_b64_v4i16((LAS v4i16_t*)(p0 + 16 * AT_VROW * 2));
                    const bf16x8 vf = {lo[0], lo[1], lo[2], lo[3], hi[0], hi[1], hi[2], hi[3]};
                    acc = MFMA16(vf, Pf[j2], acc); }
                acc = acc * inv;
                *(u32x2*)(O + (mq + 16 * nt + x) * 1024 + hq * 64 + 16 * dt + 4 * q) = (u32x2){pk2v(acc.x, acc.y), pk2v(acc.z, acc.w)}; }
        }
        __syncthreads();
    }
}
#ifndef N_LAUNCH_MODE
#define N_LAUNCH_MODE 0
#endif
__global__ void __launch_bounds__(NTHR, 2) trunk_fwd(Args a_unused) {
    extern __shared__ __attribute__((aligned(16))) unsigned char lds_raw[];
    LAS unsigned char* lds = (LAS unsigned char*)lds_raw;
    volatile LAS unsigned* MISC = (volatile LAS unsigned*)(lds + MISC_OFF);
    if (threadIdx.x < 64) MISC[threadIdx.x] = 0u;
    __syncthreads();
    int lo, hi; XcdBarrier bar;
    int dupm = 0, dupp = 0; (void)dupm; (void)dupp;
    { KArgs a = kargs(); lo = a->ph_lo; hi = a->ph_hi; dupm = a->dup_mask; dupp = a->dup_par; unsigned* ctl = (unsigned*)(a->ws + WS_CTL);
      bar.bar = ctl + CW_BAR; bar.x = 0; bar.st = MISC + 8;
      if (hi - lo > 1) bar = xcd_barrier_post(ctl + CW_BAR, MISC + 8); }
#define IN(k) (lo <= (k) && (k) < hi)
#if defined(PROBE_DUP_MASK)
#define REP(k) _Pragma("unroll 1") for (int rep_ = 0; rep_ <= (((dupm >> (k)) & 1) && (dupp == 0 || dupp == 1 + (L & 1)) ? 1 : 0); ++rep_)
#else
#define REP(k)
#endif
#define SEAM(k) do { if (IN(k) && IN((k) + 1)) xcd_barrier(bar); } while (0)
#define ENV KArgs a = kargs(); const int tid = fresh_tid(), lane = tid & 63, wave = __builtin_amdgcn_readfirstlane(tid >> 6); const int G = gridDim.x, bid = blockIdx.x, gw = bid * NWAVES + wave, NGW = G * NWAVES, gtid = bid * NTHR + tid, NGT = G * NTHR; \
    unsigned char* ws = a->ws; bf16* RA = (bf16*)(ws + WS_RA); bf16* RB = (bf16*)(ws + WS_RB); bf16* RC = (bf16*)(ws + WS_RC); bf16* RD = (bf16*)(ws + WS_RD); float* Gt = (float*)(ws + WS_GT); \
    (void)lane; (void)wave; (void)gw; (void)NGW; (void)gtid; (void)NGT; (void)RA; (void)RB; (void)RC; (void)RD; (void)Gt; (void)G; (void)bid

    if (IN(0)) { ENV; prologue_phase(a, lds, gw, NGW, wave, lane, gtid, NGT); }
    SEAM(0);
#define SCANBUFS ScanBufs sb; sb.QKVA = (bf16*)(ws + WS_QKVA); sb.X2 = (bf16*)(ws + WS_X2); sb.Gt = Gt; sb.KT = (bf16*)(ws + WS_KT); sb.UT = (bf16*)(ws + WS_UT); sb.NW = (bf16*)(ws + WS_NW); sb.ATT = (bf16*)(ws + WS_ATT); \
    sb.KWT = (bf16*)(ws + WS_KWT); sb.VT = (bf16*)(ws + WS_VT); sb.PT = (bf16*)(ws + WS_PT); sb.DEN = (float*)(ws + WS_DEN)
#pragma unroll 1
    for (int L = 0; L < DEPTH; ++L) {
        const int pb = 1 + L * PH_PER_LAYER; const bool even = (L & 1) == 0; const int e = L >> 1;
        if (IN(pb + 0)) REP(0) { ENV; const float* hin = (L == 0) ? a->x : a->out;
            norm_phase(lds, hin, a->gains + (size_t)L * 4 * DM, RA, even, (const float*)(ws + WS_WGATES) + (size_t)e * 16 * 1024, Gt, gw, NGW, tid, lane); }
        SEAM(pb + 0);
        if (IN(pb + 1)) REP(1) { ENV;
            const int N = even ? 4096 : 1536;
            pg8::Gemm g{RA, even ? (const bf16*)(ws + WS_WIN) + (size_t)e * 4096 * 1024 : (const bf16*)(ws + WS_WQKV) + (size_t)e * 1536 * 1024, M, N, DM};
            pg8::StaticOrder S; S.init(M, N, G, bid);
            pg8::EpiBf16<0> E{RC, 1536, even ? nullptr : a->b_qkv + (size_t)e * 1536, (bf16*)(ws + WS_X2), 1536, 2560};
            pg8::gemm_phase<pg8::EpiBf16<0>, pg8::StaticOrder, true, true>(lds, g, S, E);
        }
        SEAM(pb + 1);
        if (IN(pb + 2)) REP(2) { ENV; if (even) conv_phase((const bf16*)(ws + WS_X1), a->conv + (size_t)e * 4 * 1536, (bf16*)(ws + WS_QKVA), gw, NGW, lane); else rope_phase(RC, (const f32x2*)(ws + WS_ROPE), gw, NGW, lane); }
        SEAM(pb + 2);
        if (even) {
            if (IN(pb + 3)) REP(3) { ENV; SCANBUFS; local_phase(lds, sb, a->a_log + e * 4, a->dt_bias + e * 4, a->i_bias + e * 4, a->f_bias + e * 4, gw, NGW, wave, lane); }
            SEAM(pb + 3);
        }
        if (IN(pb + 4)) REP(4) { ENV;
            if (even) { SCANBUFS; recur_phase(lds, sb, G, bid, wave, lane); }
            else attn_phase(lds, tid, wave, RC, a->sinks + e * 16, RD, G, bid);
        }
        SEAM(pb + 4);
        if (even) {
            if (IN(pb + 5)) REP(5) { ENV; SCANBUFS; post_phase(sb, a->norm_a + e * 128, a->norm_b + e * 512, (bf16*)(ws + WS_MIXED), gw, NGW, lane); }
            SEAM(pb + 5);
        }
        if (IN(pb + 6)) REP(6) { ENV;
            pg8::Gemm g{even ? (const bf16*)(ws + WS_MIXED) : (const bf16*)RD, even ? (const bf16*)(ws + WS_WOUT) + (size_t)e * DM * DM : (const bf16*)(ws + WS_WO) + (size_t)e * DM * DM, M, DM, DM};
            pg8::StaticOrder S; S.init(M, DM, G, bid);
            pg8::EpiBf16<0> E{RA, DM, even ? nullptr : a->b_o + (size_t)e * DM, RA, 1 << 30, DM};
            pg8::gemm_phase<pg8::EpiBf16<0>, pg8::StaticOrder, true, true>(lds, g, S, E);
        }
        SEAM(pb + 6);
        if (IN(pb + 7)) { ENV; const float* hin = (L == 0) ? a->x : a->out; const float* gains = a->gains + (size_t)L * 4 * DM;
            resid_a_phase(RA, hin, a->out, gains + DM, gains + 2 * DM, RD, gw, NGW, lane); }
        SEAM(pb + 7);
        if (IN(pb + 8)) REP(8) { ENV;
            pg8::Gemm g{RD, (const bf16*)(ws + WS_WUP) + (size_t)L * FF * DM, M, FF, DM};
            pg8::StaticOrder S; S.init(M, FF, G, bid);
            pg8::EpiBf16<1> E{RC, FF, nullptr, RC, 1 << 30, FF};
            pg8::gemm_phase<pg8::EpiBf16<1>, pg8::StaticOrder, true, true>(lds, g, S, E);
        }
        SEAM(pb + 8);
        if (IN(pb + 9)) REP(9) { ENV;
            pg8::Gemm g{RC, (const bf16*)(ws + WS_WDN) + (size_t)L * DM * FF, M, DM, FF};
            pg8::StaticOrder S; S.init(M, DM, G, bid);
            pg8::EpiBf16<0> E{RA, DM, nullptr, RA, 1 << 30, DM};
            pg8::gemm_phase<pg8::EpiBf16<0>, pg8::StaticOrder, true, true>(lds, g, S, E);
        }
        SEAM(pb + 9);
        if (IN(pb + 10)) { ENV; resid_b_phase(RA, a->out, a->gains + (size_t)L * 4 * DM + 3 * DM, RD, a->p + (size_t)L * M * PLE, RC, gw, NGW, lane, gtid, NGT); }
        SEAM(pb + 10);
        if (IN(pb + 11)) REP(11) { ENV;
            pg8::Gemm g{RC, (const bf16*)(ws + WS_WPLE) + (size_t)L * DM * PLE, M, DM, PLE};
            pg8::StaticOrder S; S.init(M, DM, G, bid);
            pg8::EpiBf16<0> E{RB, DM, nullptr, RB, 1 << 30, DM};
            pg8::gemm_phase<pg8::EpiBf16<0>, pg8::StaticOrder, true, true>(lds, g, S, E);
        }
        SEAM(pb + 11);
        if (IN(pb + 12)) { ENV;
            pg8::Gemm g{RD, (const bf16*)(ws + WS_WG) + (size_t)L * DM * DM, M, DM, DM};
            pg8::StaticOrder S; S.init(M, DM, G, bid);
            pg8::EpiGate E{a->out, RB, DM};
            pg8::gemm_phase<pg8::EpiGate, pg8::StaticOrder, true, true>(lds, g, S, E);
        }
        SEAM(pb + 12);
    }
#undef SCANBUFS
#undef IN
#undef SEAM
#undef ENV
}

extern "C" void kernel_launch(void* const* d_in, const int* in_sizes, int n_in, void* d_out, int out_size, void* d_ws, size_t ws_size, hipStream_t stream) {
    static int grid = 0;
    if (grid == 0) {
        if (n_in != 22 || in_sizes[0] != M * DM || out_size != M * DM || ws_size < WS_END) {
            fprintf(stderr, "kernel_launch: unexpected shapes (n_in %d, in0 %d, out %d, ws %zu; need ws >= %zu); nothing launched\n", n_in, n_in > 0 ? in_sizes[0] : -1, out_size, ws_size, (size_t)WS_END); grid = -1; return; }
        int dev = 0, cus = 0, per_cu = 0;
        if (hipGetDevice(&dev) != hipSuccess || hipDeviceGetAttribute(&cus, hipDeviceAttributeMultiprocessorCount, dev) != hipSuccess) { fprintf(stderr, "kernel_launch: device query failed\n"); grid = -1; return; }
        if (hipFuncSetAttribute((const void*)trunk_fwd, hipFuncAttributeMaxDynamicSharedMemorySize, LDS_BYTES) != hipSuccess) { fprintf(stderr, "kernel_launch: hipFuncSetAttribute failed\n"); grid = -1; return; }
        if (hipOccupancyMaxActiveBlocksPerMultiprocessor(&per_cu, (const void*)trunk_fwd, NTHR, LDS_BYTES) != hipSuccess || per_cu < 1) fprintf(stderr, "kernel_launch: note: occupancy query reports %d\n", per_cu);
        (void)hipGetLastError();
        grid = cus;
    }
    if (grid < 0) return;
    Args a{};
    a.x = (const float*)d_in[0]; a.p = (const float*)d_in[1]; a.pos = (const int*)d_in[2]; a.gains = (const float*)d_in[3]; a.w_in = (const float*)d_in[4]; a.conv = (const float*)d_in[5];
    a.a_log = (const float*)d_in[6]; a.dt_bias = (const float*)d_in[7]; a.norm_a = (const float*)d_in[8]; a.i_bias = (const float*)d_in[9]; a.f_bias = (const float*)d_in[10]; a.norm_b = (const float*)d_in[11];
    a.b_qkv = (const float*)d_in[14]; a.sinks = (const float*)d_in[15]; a.b_o = (const float*)d_in[17];
    a.out = (float*)d_out; a.ws = (unsigned char*)d_ws;
#if defined(PROBE_DUP_MASK)
    a.dup_mask = PROBE_DUP_MASK; a.dup_par = PROBE_DUP_PAR;
#endif
    a.w_out = (const float*)d_in[12]; a.w_qkv = (const float*)d_in[13]; a.w_o = (const float*)d_in[16]; a.w_up = (const float*)d_in[18]; a.w_down = (const float*)d_in[19]; a.w_ple = (const float*)d_in[20]; a.w_gate = (const float*)d_in[21];
#if N_LAUNCH_MODE == 0
    if (hipMemsetAsync((char*)d_ws + WS_CTL, 0, CTL_ZERO_BYTES, stream) != hipSuccess) { fprintf(stderr, "kernel_launch: memset failed\n"); return; }
    a.ph_lo = 0; a.ph_hi = NPHASE;
    hipLaunchKernelGGL(trunk_fwd, dim3(grid), dim3(NTHR), LDS_BYTES, stream, a);
#else
    for (int ph = 0; ph < NPHASE; ++ph) { a.ph_lo = ph; a.ph_hi = ph + 1; hipLaunchKernelGGL(trunk_fwd, dim3(grid), dim3(NTHR), LDS_BYTES, stream, a); }
#endif
    const hipError_t le = hipPeekAtLastError();
    if (le != hipSuccess) fprintf(stderr, "kernel_launch: launch failed: %s\n", hipGetErrorName(le));
}
```

```cpp
#include <hip/hip_runtime.h>
#include <cstdio>
#include <cstdint>
#define N_LAUNCH_MODE 0
namespace pg8 {
#define PG8_LAS __attribute__((address_space(3)))
typedef unsigned short bf16_t;
typedef short bf16x8 __attribute__((ext_vector_type(8)));
typedef float f32x4 __attribute__((ext_vector_type(4)));
typedef unsigned u32x4 __attribute__((ext_vector_type(4)));
constexpr int BM = 256, BK = 64, HALF = 128, HTB = HALF * BK * 2  , STAGE_BYTES = 8 * HTB, NXCD = 8, WGM = 8;

__host__ __device__ __forceinline__ int lds_byte(int r, int c) { const int st = (r >> 4) * 2 + (c >> 5), rr = r & 15, cc = c & 31, ob = rr * 64 + cc * 2; return st * 1024 + (ob ^ (((ob >> 9) & 1) << 5)); }
__host__ __device__ __forceinline__ void stage_rc(int b, int& R, int& C) { const int st = b / 1024, sb = b % 1024, swz = sb ^ (((sb >> 9) & 1) << 5); R = (st >> 1) * 16 + swz / 64; C = (st & 1) * 32 + (swz % 64) / 2; }
__host__ __device__ __forceinline__ int perm32(int rho) { const int n = rho >> 4, i = rho & 15; return 8 * (i >> 2) + 4 * n + (i & 3); }

struct Unit { int pm, pn; };
struct Gemm { const bf16_t* A; const bf16_t* Bt; int M, N, K; };

struct StaticOrder {
    int nM, nN, nwg, G, c;
    __host__ __device__ void init(int M, int N, int G_, int c_) { nM = M / BM; nN = N / BM; nwg = nM * nN; G = G_; c = c_; }
    __host__ __device__ bool next(int i, Unit& u) const {
        const long L = (long)i * G + c; if (L >= nwg) return false;
        int wgid = (int)L; { const int q = nwg / NXCD, r = nwg % NXCD, xcd = wgid % NXCD, off = wgid / NXCD; wgid = (xcd < r ? xcd * (q + 1) : r * (q + 1) + (xcd - r) * q) + off; }
        const int nig = WGM * nN, gid = wgid / nig, fm = gid * WGM, gsz = (nM - fm) < WGM ? (nM - fm) : WGM;
        u.pm = fm + ((wgid % nig) % gsz); u.pn = (wgid % nig) / gsz; return true;
    }
    __device__ __forceinline__ void a_ready(const Unit&) const {}
    __device__ __forceinline__ void done(const Unit&) const {}
};

__device__ __forceinline__ unsigned cvt_pk_bf16(float lo, float hi) { unsigned r; asm volatile("v_cvt_pk_bf16_f32 %0, %1, %2" : "=v"(r) : "v"(lo), "v"(hi)); return r; }
typedef float f32x2 __attribute__((ext_vector_type(2)));
typedef unsigned u32x2 __attribute__((ext_vector_type(2)));

template <int ACT  > struct EpiBf16 {
    static constexpr bool PERM = true, AFTER_DRAIN = false;
    bf16_t* O; int ldc; const float* bias; bf16_t* O2; int split_col, ldc2;
    __device__ __forceinline__ void operator()(const f32x4 (&acc)[2][2][4][2], const Unit& u, int wr, int wc, int fr, int fq) const {
        const int row0 = u.pm * BM + wr * 64 + fr; const int col0 = u.pn * BM + wc * 32 + 8 * fq;
        const bool second = u.pn * BM >= split_col; bf16_t* const ob = second ? O2 : O; const int ld = second ? ldc2 : ldc, oc0 = second ? col0 - split_col : col0;
        f32x4 bv[2][2];
#pragma unroll
        for (int bj = 0; bj < 2; ++bj)
#pragma unroll
            for (int n = 0; n < 2; ++n) bv[bj][n] = bias ? *(const f32x4*)(bias + col0 + bj * HALF + 4 * n) : (f32x4){0.f, 0.f, 0.f, 0.f};
#pragma unroll
        for (int ai = 0; ai < 2; ++ai)
#pragma unroll
            for (int m = 0; m < 4; ++m) { bf16_t* rowp = ob + (size_t)(row0 + ai * HALF + m * 16) * ld + oc0;
#pragma unroll
                for (int bj = 0; bj < 2; ++bj) { f32x4 v0 = acc[ai][bj][m][0] + bv[bj][0], v1 = acc[ai][bj][m][1] + bv[bj][1];
                    if (ACT == 1) {
#pragma unroll
                        for (int i = 0; i < 4; ++i) { const float a = fmaxf(v0[i], 0.f), b = fmaxf(v1[i], 0.f); v0[i] = a * a; v1[i] = b * b; } }
                    u32x4 w; w.x = cvt_pk_bf16(v0[0], v0[1]); w.y = cvt_pk_bf16(v0[2], v0[3]); w.z = cvt_pk_bf16(v1[0], v1[1]); w.w = cvt_pk_bf16(v1[2], v1[3]);
                    *(u32x4*)(rowp + bj * HALF) = w; } }
    }
};
struct EpiF32 {
    static constexpr bool PERM = false, AFTER_DRAIN = false;
    float* C; int ldc; const float* bias;
    __device__ __forceinline__ void operator()(const f32x4 (&acc)[2][2][4][2], const Unit& u, int wr, int wc, int fr, int fq) const {
        const int row0 = u.pm * BM + wr * 64 + fr, col0 = u.pn * BM + wc * 32 + 4 * fq;
        f32x4 bv[2][2];
#pragma unroll
        for (int bj = 0; bj < 2; ++bj)
#pragma unroll
            for (int n = 0; n < 2; ++n) bv[bj][n] = bias ? *(const f32x4*)(bias + col0 + bj * HALF + n * 16) : (f32x4){0.f, 0.f, 0.f, 0.f};
#pragma unroll
        for (int ai = 0; ai < 2; ++ai)
#pragma unroll
            for (int m = 0; m < 4; ++m) { float* rowp = C + (size_t)(row0 + ai * HALF + m * 16) * ldc + col0;
#pragma unroll
                for (int bj = 0; bj < 2; ++bj)
#pragma unroll
                    for (int n = 0; n < 2; ++n) *(f32x4*)(rowp + bj * HALF + n * 16) = acc[ai][bj][m][n] + bv[bj][n]; }
    }
};
__device__ __forceinline__ float bf_lo(unsigned w) { return __builtin_bit_cast(float, w << 16); }
__device__ __forceinline__ float bf_hi(unsigned w) { return __builtin_bit_cast(float, w & 0xffff0000u); }
struct EpiGate {
    static constexpr bool PERM = false, AFTER_DRAIN = false;
    float* H; const bf16_t* PP; int ldc;
    __device__ __forceinline__ void operator()(const f32x4 (&acc)[2][2][4][2], const Unit& u, int wr, int wc, int fr, int fq) const {
        const int row0 = u.pm * BM + wr * 64 + fr, col0 = u.pn * BM + wc * 32 + 4 * fq;
#pragma unroll
        for (int ai = 0; ai < 2; ++ai)
#pragma unroll
            for (int m = 0; m < 4; ++m) { const size_t ro = (size_t)(row0 + ai * HALF + m * 16) * ldc + col0;
#pragma unroll
                for (int bj = 0; bj < 2; ++bj)
#pragma unroll
                    for (int n = 0; n < 2; ++n) { const size_t off = ro + bj * HALF + n * 16;
                        f32x4 hv = *(const f32x4*)(H + off); const u32x2 pv = *(const u32x2*)(PP + off); const f32x4 a = acc[ai][bj][m][n];
                        const float p0 = bf_lo(pv.x), p1 = bf_hi(pv.x), p2 = bf_lo(pv.y), p3 = bf_hi(pv.y);
                        hv[0] += p0 / (1.f + __expf(-a[0])); hv[1] += p1 / (1.f + __expf(-a[1])); hv[2] += p2 / (1.f + __expf(-a[2])); hv[3] += p3 / (1.f + __expf(-a[3]));
                        *(f32x4*)(H + off) = hv; } }
    }
};

template <class Epi, class Sched, bool ALIGN_EPI = false, bool SP2 = false>
__device__ __forceinline__ void gemm_phase(PG8_LAS unsigned char* lds, const Gemm g, const Sched& S, const Epi& E) {
    int tid_l = threadIdx.x; asm volatile("" : "+v"(tid_l));
    const int tid = tid_l, wid = __builtin_amdgcn_readfirstlane(tid >> 6), lane = tid & 63, wr = wid >> 2, wc = wid & 3, fr = lane & 15, fq = lane >> 4;
    const int K = g.K, nt = K / BK;
    unsigned voffA[2], voffB[2];
#pragma unroll
    for (int i = 0; i < 2; ++i) { int R, C; stage_rc(tid * 16 + i * 8192, R, C); const int Rb = Epi::PERM ? ((R & ~31) + perm32(R & 31)) : R;
        voffA[i] = (unsigned)(R * K + C) * 2u; voffB[i] = (unsigned)(Rb * K + C) * 2u; }
    const size_t kstep = (size_t)(BK * 2);
    const size_t hstep = (size_t)HALF * K * 2;
    const size_t tstep = 2 * hstep;
    const unsigned ldsw = (unsigned)wid * 1024u;
    const int aoff = lds_byte(wr * 64 + fr, fq * 8), boff = lds_byte(wc * 32 + fr, fq * 8);
#define PG8_SA(b, h) (((b) * 2 + (h)) * HTB)
#define PG8_SB(b, h) ((4 + (b) * 2 + (h)) * HTB)
#define PG8_STAGE(bufoff, gbase, voff) do { _Pragma("unroll") for (int _i = 0; _i < 2; ++_i) \
        __builtin_amdgcn_global_load_lds((const unsigned*)((const char*)(gbase) + (voff)[_i]), (PG8_LAS unsigned*)(lds + (bufoff) + ldsw + _i * 8192), 16, 0, 0); } while (0)
#define PG8_LDA(dst, b, h) do { _Pragma("unroll") for (int m = 0; m < 4; ++m) _Pragma("unroll") for (int k = 0; k < 2; ++k) dst[m][k] = *(const PG8_LAS bf16x8*)(lds + PG8_SA(b, h) + aoff + m * 2048 + k * 1024); } while (0)
#define PG8_LDB(dst, b, h) do { _Pragma("unroll") for (int n = 0; n < 2; ++n) _Pragma("unroll") for (int k = 0; k < 2; ++k) dst[n][k] = *(const PG8_LAS bf16x8*)(lds + PG8_SB(b, h) + boff + n * 2048 + k * 1024); } while (0)
#define PG8_MMA(ai, bj, At, Bt) do { __builtin_amdgcn_s_setprio(1); _Pragma("unroll") for (int m = 0; m < 4; ++m) _Pragma("unroll") for (int n = 0; n < 2; ++n) _Pragma("unroll") for (int k = 0; k < 2; ++k) \
        acc[ai][bj][m][n] = __builtin_amdgcn_mfma_f32_16x16x32_bf16(Bt[n][k], At[m][k], acc[ai][bj][m][n], 0, 0, 0); __builtin_amdgcn_s_setprio(0); } while (0)
#define PG8_WAIT_V(n) asm volatile("s_waitcnt vmcnt(" #n ")" ::: "memory")
#define PG8_WAIT_L(n) asm volatile("s_waitcnt lgkmcnt(" #n ")" ::: "memory")
#define PG8_BAR __builtin_amdgcn_s_barrier()
#define PG8_SCHED __builtin_amdgcn_sched_barrier(0)
    Unit cur, nxt; int ui = 0;
    if (!S.next(0, cur)) return;
    f32x4 acc[2][2][4][2];
#pragma unroll
    for (int a = 0; a < 2; ++a)
#pragma unroll
        for (int b = 0; b < 2; ++b)
#pragma unroll
            for (int m = 0; m < 4; ++m)
#pragma unroll
                for (int n = 0; n < 2; ++n) acc[a][b][m][n] = (f32x4){0.f, 0.f, 0.f, 0.f};
    bf16x8 At[4][2], B0[2][2], B1[2][2];
    const char* cA = (const char*)g.A + (size_t)cur.pm * tstep; const char* cB = (const char*)g.Bt + (size_t)cur.pn * tstep;
    S.a_ready(cur);
    if constexpr (SP2) {
        PG8_STAGE(PG8_SB(0, 0), cB, voffB); PG8_STAGE(PG8_SB(0, 1), cB + hstep, voffB); PG8_STAGE(PG8_SA(0, 0), cA, voffA); PG8_STAGE(PG8_SA(0, 1), cA + hstep, voffA);
        if (wr == 1) PG8_BAR;
        PG8_WAIT_V(2); PG8_BAR;
        PG8_STAGE(PG8_SB(1, 0), cB + kstep, voffB); PG8_STAGE(PG8_SA(1, 0), cA + kstep, voffA); PG8_STAGE(PG8_SB(1, 1), cB + hstep + kstep, voffB);
        PG8_WAIT_V(6); PG8_BAR;
    } else {
        PG8_STAGE(PG8_SB(0, 0), cB, voffB); PG8_STAGE(PG8_SA(0, 0), cA, voffA); PG8_STAGE(PG8_SB(0, 1), cB + hstep, voffB); PG8_STAGE(PG8_SA(0, 1), cA + hstep, voffA);
        if (wr == 1) PG8_BAR;
        PG8_WAIT_V(4); PG8_BAR;
        PG8_STAGE(PG8_SB(1, 0), cB + kstep, voffB); PG8_STAGE(PG8_SA(1, 0), cA + kstep, voffA); PG8_STAGE(PG8_SB(1, 1), cB + hstep + kstep, voffB);
        PG8_WAIT_V(6); PG8_BAR;
    }
    for (;;) {
        const bool has_next = S.next(ui + 1, nxt);
        const char* nA = has_next ? (const char*)g.A + (size_t)nxt.pm * tstep : cA; const char* nB = has_next ? (const char*)g.Bt + (size_t)nxt.pn * tstep : cB;
        for (int t = 0; t < nt; t += 2) {
            const bool last = (t == nt - 2);
            const char* a1 = cA + (size_t)(t + 1) * kstep;
            const char* a2 = last ? nA : cA + (size_t)(t + 2) * kstep; const char* b2 = last ? nB : cB + (size_t)(t + 2) * kstep;
            const char* a3 = a2 + kstep; const char* b3 = b2 + kstep;
            if (last && has_next) S.a_ready(nxt);
            if constexpr (SP2) {
            PG8_LDB(B0, 0, 0); PG8_LDB(B1, 0, 1); PG8_SCHED; PG8_LDA(At, 0, 0); PG8_STAGE(PG8_SA(1, 1), a1 + hstep, voffA);
            PG8_WAIT_V(8); PG8_WAIT_L(0); PG8_BAR; PG8_MMA(0, 0, At, B0); PG8_MMA(0, 1, At, B1); PG8_BAR; PG8_SCHED;
            PG8_LDA(At, 0, 1); PG8_STAGE(PG8_SB(0, 0), b2, voffB); PG8_STAGE(PG8_SB(0, 1), b2 + hstep, voffB); PG8_STAGE(PG8_SA(0, 0), a2, voffA);
            PG8_WAIT_V(8); PG8_WAIT_L(0); PG8_BAR; PG8_MMA(1, 0, At, B0); PG8_MMA(1, 1, At, B1); PG8_BAR; PG8_SCHED;
            PG8_LDB(B0, 1, 0); PG8_LDB(B1, 1, 1); PG8_SCHED; PG8_LDA(At, 1, 0); PG8_STAGE(PG8_SA(0, 1), a2 + hstep, voffA);
            PG8_WAIT_V(8); PG8_WAIT_L(0); PG8_BAR; PG8_MMA(0, 0, At, B0); PG8_MMA(0, 1, At, B1); PG8_BAR; PG8_SCHED;
            PG8_LDA(At, 1, 1); PG8_STAGE(PG8_SB(1, 0), b3, voffB); PG8_STAGE(PG8_SB(1, 1), b3 + hstep, voffB); PG8_STAGE(PG8_SA(1, 0), a3, voffA);
            PG8_WAIT_V(8); PG8_WAIT_L(0); PG8_BAR; PG8_MMA(1, 0, At, B0); PG8_MMA(1, 1, At, B1); PG8_BAR; PG8_SCHED;
            } else {
            PG8_LDB(B0, 0, 0); PG8_SCHED; PG8_LDA(At, 0, 0); PG8_STAGE(PG8_SA(1, 1), a1 + hstep, voffA);
            PG8_WAIT_L(8); PG8_BAR; PG8_WAIT_L(0); PG8_MMA(0, 0, At, B0); PG8_BAR; PG8_SCHED;
            PG8_LDB(B1, 0, 1); PG8_STAGE(PG8_SB(0, 0), b2, voffB);
            PG8_BAR; PG8_WAIT_L(0); PG8_MMA(0, 1, At, B1); PG8_BAR;
            PG8_LDA(At, 0, 1); PG8_STAGE(PG8_SA(0, 0), a2, voffA);
            PG8_BAR; PG8_WAIT_L(0); PG8_MMA(1, 0, At, B0); PG8_BAR; PG8_SCHED;
            PG8_STAGE(PG8_SB(0, 1), b2 + hstep, voffB);
            PG8_WAIT_V(6); PG8_BAR; PG8_MMA(1, 1, At, B1); PG8_BAR;
            PG8_LDB(B0, 1, 0); PG8_SCHED; PG8_LDA(At, 1, 0); PG8_STAGE(PG8_SA(0, 1), a2 + hstep, voffA);
            PG8_WAIT_L(8); PG8_BAR; PG8_WAIT_L(0); PG8_MMA(0, 0, At, B0); PG8_BAR; PG8_SCHED;
            PG8_LDB(B1, 1, 1); PG8_STAGE(PG8_SB(1, 0), b3, voffB);
            PG8_BAR; PG8_WAIT_L(0); PG8_MMA(0, 1, At, B1); PG8_BAR;
            PG8_LDA(At, 1, 1); PG8_STAGE(PG8_SA(1, 0), a3, voffA);
            PG8_BAR; PG8_WAIT_L(0); PG8_MMA(1, 0, At, B0); PG8_BAR; PG8_SCHED;
            PG8_STAGE(PG8_SB(1, 1), b3 + hstep, voffB);
            PG8_WAIT_V(6); PG8_BAR; PG8_MMA(1, 1, At, B1); PG8_BAR;
            }
        }
        if constexpr (ALIGN_EPI) { if (wr == 0) PG8_BAR; }
        if constexpr (!Epi::AFTER_DRAIN) { E(acc, cur, wr, wc, fr, fq); S.done(cur); }
        if (!has_next) break;
#pragma unroll
        for (int a = 0; a < 2; ++a)
#pragma unroll
            for (int b = 0; b < 2; ++b)
#pragma unroll
                for (int m = 0; m < 4; ++m)
#pragma unroll
                    for (int n = 0; n < 2; ++n) acc[a][b][m][n] = (f32x4){0.f, 0.f, 0.f, 0.f};
        cur = nxt; cA = nA; cB = nB; ++ui;
        if constexpr (ALIGN_EPI) { if (wr == 1) PG8_BAR; }
    }
    PG8_WAIT_V(0);
    if constexpr (!ALIGN_EPI) { if (wr == 0) PG8_BAR; }
    PG8_BAR;
    if constexpr (Epi::AFTER_DRAIN) { E.fused(acc, cur, wr, wc, fr, fq, lds, wid, lane); S.done(cur); }
#undef PG8_SA
#undef PG8_SB
#undef PG8_STAGE
#undef PG8_LDA
#undef PG8_LDB
#undef PG8_MMA
#undef PG8_WAIT_V
#undef PG8_WAIT_L
#undef PG8_BAR
#undef PG8_SCHED
}
}
constexpr int BATCH = 32, SEQ = 2048, DM = 1024, DEPTH = 4, M = BATCH * SEQ;
constexpr int FF = 4096, PLE = 256, NIN = 4112;
constexpr float EPS = 1e-6f;
constexpr int NWAVES = 8, NTHR = NWAVES * 64;
constexpr int PH_PER_LAYER = 14, NPHASE = 1 + DEPTH * PH_PER_LAYER;
constexpr size_t MiB = 1u << 20;
constexpr size_t WS_CTL = 0, CTL_ZERO_BYTES = 1 * MiB;
constexpr size_t WS_WIN = 1 * MiB, WS_WOUT = 17 * MiB, WS_WQKV = 21 * MiB, WS_WO = 27 * MiB, WS_WUP = 31 * MiB, WS_WDN = 63 * MiB, WS_WPLE = 95 * MiB, WS_WG = 97 * MiB;
constexpr size_t WS_WGATES = 105 * MiB, WS_GT = 106 * MiB, WS_ROPE = 110 * MiB;
constexpr size_t WS_DEN = 126 * MiB;
constexpr size_t WS_RA = 128 * MiB, WS_RB = 256 * MiB, WS_RC = 384 * MiB, WS_RD = 896 * MiB, WS_END = 1024 * MiB;
constexpr size_t WS_QKVA = 128 * MiB, WS_KWT = 320 * MiB, WS_X1 = 384 * MiB, WS_KT = 384 * MiB, WS_UT = 448 * MiB, WS_NW = 512 * MiB, WS_X2 = 576 * MiB, WS_VT = 896 * MiB, WS_ATT = 960 * MiB, WS_PT = 992 * MiB, WS_MIXED = 384 * MiB;
constexpr int CW_BAR = 4096;
constexpr int RING_BYTES = 131072, MISC_OFF = RING_BYTES, LDS_BYTES = RING_BYTES + 1024;

#define GAS __attribute__((address_space(1)))
#define LAS __attribute__((address_space(3)))
typedef unsigned short bf16;
typedef float f32x4 __attribute__((ext_vector_type(4)));
typedef float f32x2 __attribute__((ext_vector_type(2)));
typedef unsigned u32x4 __attribute__((ext_vector_type(4)));
typedef unsigned u32x2 __attribute__((ext_vector_type(2)));
#define LDS_WAIT() asm volatile("s_waitcnt lgkmcnt(0)" ::: "memory")
#define VM_WAIT() asm volatile("s_waitcnt vmcnt(0)" ::: "memory")
using pg8::bf_lo; using pg8::bf_hi;
typedef __bf16 bf16x2_t __attribute__((ext_vector_type(2)));
__device__ __forceinline__ unsigned pk2(float lo, float hi) { return pg8::cvt_pk_bf16(lo, hi); }
__device__ __forceinline__ unsigned pk2v(float lo, float hi) { const f32x2 v = {lo, hi}; const bf16x2_t b = __builtin_convertvector(v, bf16x2_t); return __builtin_bit_cast(unsigned, b); }
__device__ __forceinline__ float wave_sum(float v) {
#pragma unroll
    for (int o = 1; o < 64; o <<= 1) v += __shfl_xor(v, o);
    return v;
}
__device__ __forceinline__ float dot4(f32x4 a, f32x4 b) { return (a.x * b.x + a.y * b.y) + (a.z * b.z + a.w * b.w); }
__device__ __forceinline__ float sigmoid_f(float x) { return 1.f / (1.f + __expf(-x)); }
__device__ __forceinline__ float softplus_f(float x) { return x > 20.f ? x : log1pf(expf(x)); }

#define XB_TMO      128
#define XB_XCNT(j)  (256  + 64 * (j))
#define XB_XSUB(j)  (1280 + 64 * (j))
#define XB_XGEN(j)  (2304 + 64 * (j))
#define XB_TOP      3328
#define XB_TOPGEN   3392
#define XCD_BAR_WORDS 3456
#define XB_SPIN_CAP (1u << 18)

__device__ __forceinline__ unsigned xb_ld(unsigned* p)              { return __hip_atomic_load(p, __ATOMIC_RELAXED, __HIP_MEMORY_SCOPE_AGENT); }
__device__ __forceinline__ unsigned xb_add(unsigned* p, unsigned v) { return __hip_atomic_fetch_add(p, v, __ATOMIC_RELAXED, __HIP_MEMORY_SCOPE_AGENT); }
__device__ __forceinline__ unsigned xb_xcc_id() { return (unsigned)__builtin_amdgcn_s_getreg((3 << 11) | 20) & 0xFu; }
#define XB_SPIN(cond, bar) do { unsigned _sp = 0; while (cond) { __builtin_amdgcn_s_sleep(1); \
    if ((++_sp & 255u) == 0u) { if (xb_ld(&(bar)[XB_TMO])) break; if (_sp > XB_SPIN_CAP) { atomicAdd(&(bar)[XB_TMO], 1u); break; } } } } while (0)

struct XcdBarrier {
    unsigned* bar; unsigned x;
    volatile LAS unsigned* st;
};

__device__ __forceinline__ XcdBarrier xcd_barrier_post(unsigned* bar, volatile LAS unsigned* st) {
    XcdBarrier b; b.bar = bar; b.x = xb_xcc_id(); b.st = st;
    if (threadIdx.x == 0) (void)xb_add(&bar[XB_XCNT(b.x)], 1u);
    return b;
}
__device__ __forceinline__ void xcd_barrier_complete(unsigned* bar, unsigned x, unsigned& nloc, unsigned& nx) {
    const unsigned G = gridDim.x * gridDim.y * gridDim.z;
    unsigned sum, cnt, mine, sp = 0u;
    for (;;) {
        sum = 0u; cnt = 0u; mine = 0u;
#pragma unroll
        for (unsigned j = 0; j < 16; ++j) { const unsigned c = xb_ld(&bar[XB_XCNT(j)]); sum += c; cnt += (c > 0u) ? 1u : 0u; mine = (j == x) ? c : mine; }
        if (sum == G) break;
        __builtin_amdgcn_s_sleep(1);
        if ((++sp & 255u) == 0u) { if (xb_ld(&bar[XB_TMO])) break; if (sp > XB_SPIN_CAP) { atomicAdd(&bar[XB_TMO], 1u); break; } }
    }
    nloc = mine > 0u ? mine : 1u; nx = cnt > 0u ? cnt : 1u;
}

__device__ __forceinline__ void xcd_barrier(const XcdBarrier& b) {
    asm volatile("s_waitcnt vmcnt(0)" ::: "memory");
    __syncthreads();
    if (threadIdx.x == 0) {
        unsigned* bar = b.bar;
        __builtin_amdgcn_s_waitcnt(0);
        unsigned nloc = b.st[0], nx = b.st[1];
        if (nloc == 0u) { xcd_barrier_complete(bar, b.x, nloc, nx); b.st[0] = nloc; b.st[1] = nx; }
        const unsigned old = xb_add(&bar[XB_XSUB(b.x)], 1u);
        const unsigned gen = old / nloc;
        if (old + 1u == (gen + 1u) * nloc) {
            __builtin_amdgcn_fence(__ATOMIC_RELEASE, "agent");
            asm volatile("s_waitcnt vmcnt(0)" ::: "memory");
            const unsigned og = xb_add(&bar[XB_TOP], 1u);
            const unsigned tg = og / nx;
            if (og + 1u == (tg + 1u) * nx) xb_add(&bar[XB_TOPGEN], 1u);
            else XB_SPIN(xb_ld(&bar[XB_TOPGEN]) == tg, bar);
            __builtin_amdgcn_fence(__ATOMIC_ACQUIRE, "agent");
            xb_add(&bar[XB_XGEN(b.x)], 1u);
            asm volatile("s_waitcnt vmcnt(0)" ::: "memory");
        } else {
            XB_SPIN(xb_ld(&bar[XB_XGEN(b.x)]) == gen, bar);
            __builtin_amdgcn_fence(__ATOMIC_ACQUIRE, "agent");
            asm volatile("s_waitcnt vmcnt(0)" ::: "memory");
        }
    }
    __syncthreads();
}
struct Args {
    const float *x, *p; const int* pos; const float *gains, *w_in, *conv, *a_log, *dt_bias, *norm_a, *i_bias, *f_bias, *norm_b, *w_out, *w_qkv, *b_qkv, *sinks, *w_o, *b_o, *w_up, *w_down, *w_ple, *w_gate;
    float* out; unsigned char* ws;
    int ph_lo, ph_hi, dup_mask, dup_par;
};

__device__ __forceinline__ void transpose_item(const float* src, int ld, int K, bf16* dst, LAS float* scr, int item, int nblk, int lane) {
    const int kb = item / nblk, nb = item % nblk, k0 = 64 * kb, n0 = 32 * nb;
#pragma unroll 8
    for (int i = 0; i < 32; ++i) { const int kk = 2 * i + (lane >> 5); scr[kk * 33 + (lane & 31)] = src[(size_t)(k0 + kk) * ld + n0 + (lane & 31)]; }
    LDS_WAIT(); asm volatile("" ::: "memory");
    const int c = lane & 7;
#pragma unroll
    for (int j = 0; j < 4; ++j) { const int n = (lane >> 3) + 8 * j; const LAS float* s = scr + (8 * c) * 33 + n;
        u32x4 o; o.x = pk2(s[0 * 33], s[1 * 33]); o.y = pk2(s[2 * 33], s[3 * 33]); o.z = pk2(s[4 * 33], s[5 * 33]); o.w = pk2(s[6 * 33], s[7 * 33]);
        *(u32x4*)(dst + (size_t)(n0 + n) * K + k0 + 8 * c) = o; }
    LDS_WAIT(); asm volatile("" ::: "memory");
}
__device__ __forceinline__ int gate_col(int c) { return c < 8 ? 1536 + c : 3592 + (c - 8); }

typedef const __attribute__((address_space(4))) Args* KArgs;
__device__ __forceinline__ KArgs kargs() { KArgs p = (KArgs)__builtin_amdgcn_kernarg_segment_ptr(); asm volatile("" : "+s"(p)); return p; }
__device__ __forceinline__ int fresh_tid() { int t = threadIdx.x; asm volatile("" : "+v"(t)); return t; }
__device__ __forceinline__ void prologue_phase(KArgs a, LAS unsigned char* lds, int gw, int NGW, int wave, int lane, int gtid, int NGT) {
    LAS float* scr = (LAS float*)(lds + wave * 16384);
    constexpr int I_IN = 16 * 16, I_SQ = 16 * 32, I_QKV = 16 * 48, I_UP = 16 * 128, I_DN = 64 * 32, I_PLE = 4 * 32;
    constexpr int NITEMS = 16 * I_IN + 2 * I_SQ + 2 * I_QKV + 2 * I_SQ + 4 * I_UP + 4 * I_DN + 4 * I_PLE + 4 * I_SQ;
    unsigned char* ws = a->ws;
    for (int it = gw; it < NITEMS; it += NGW) {
        int r = it;
        if (r < 16 * I_IN) { const int j = r / I_IN, e = j >> 3, s = j & 7, col0 = 512 * s + (s >= 3 ? 8 : 0) + (s >= 7 ? 8 : 0);
            transpose_item(a->w_in + (size_t)e * DM * NIN + col0, NIN, DM, (bf16*)(ws + WS_WIN) + ((size_t)e * 4096 + s * 512) * DM, scr, r % I_IN, 16, lane); continue; } r -= 16 * I_IN;
        if (r < 2 * I_SQ) { const int e = r / I_SQ; transpose_item(a->w_out + (size_t)e * DM * DM, DM, DM, (bf16*)(ws + WS_WOUT) + (size_t)e * DM * DM, scr, r % I_SQ, 32, lane); continue; } r -= 2 * I_SQ;
        if (r < 2 * I_QKV) { const int e = r / I_QKV; transpose_item(a->w_qkv + (size_t)e * DM * 1536, 1536, DM, (bf16*)(ws + WS_WQKV) + (size_t)e * 1536 * DM, scr, r % I_QKV, 48, lane); continue; } r -= 2 * I_QKV;
        if (r < 2 * I_SQ) { const int e = r / I_SQ; transpose_item(a->w_o + (size_t)e * DM * DM, DM, DM, (bf16*)(ws + WS_WO) + (size_t)e * DM * DM, scr, r % I_SQ, 32, lane); continue; } r -= 2 * I_SQ;
        if (r < 4 * I_UP) { const int l = r / I_UP; transpose_item(a->w_up + (size_t)l * DM * FF, FF, DM, (bf16*)(ws + WS_WUP) + (size_t)l * FF * DM, scr, r % I_UP, 128, lane); continue; } r -= 4 * I_UP;
        if (r < 4 * I_DN) { const int l = r / I_DN; transpose_item(a->w_down + (size_t)l * FF * DM, DM, FF, (bf16*)(ws + WS_WDN) + (size_t)l * DM * FF, scr, r % I_DN, 32, lane); continue; } r -= 4 * I_DN;
        if (r < 4 * I_PLE) { const int l = r / I_PLE; transpose_item(a->w_ple + (size_t)l * PLE * DM, DM, PLE, (bf16*)(ws + WS_WPLE) + (size_t)l * DM * PLE, scr, r % I_PLE, 32, lane); continue; } r -= 4 * I_PLE;
        { const int l = r / I_SQ; transpose_item(a->w_gate + (size_t)l * DM * DM, DM, DM, (bf16*)(ws + WS_WG) + (size_t)l * DM * DM, scr, r % I_SQ, 32, lane); }
    }
    float* Wg = (float*)(a->ws + WS_WGATES);
    for (int i = gtid; i < 2 * 16 * 1024; i += NGT) { const int e = i >> 14, c = (i >> 10) & 15, k = i & 1023; Wg[i] = a->w_in[((size_t)e * 1024 + k) * NIN + gate_col(c)]; }
    f32x2* rope = (f32x2*)(a->ws + WS_ROPE);
    for (int i = gtid; i < M * 32; i += NGT) { const int m = i >> 5, d = i & 31;
        const float inv = (float)pow(10000.0, -(double)d / 32.0); const float ang = (float)a->pos[m] * inv; float sn, cs; sincosf(ang, &sn, &cs); rope[i] = (f32x2){cs, sn}; }
}

__device__ __forceinline__ void norm_phase(LAS unsigned char* lds, const float* hin, const float* g0, bf16* HN, bool even, const float* Wg, float* Gt, int gw, int NGW, int tid, int lane) {
    LAS f32x4* wl = (LAS f32x4*)lds;
    if (even) { for (int i = tid; i < 4096; i += NTHR) wl[i] = ((const f32x4*)Wg)[i]; __syncthreads(); }
    f32x4 gv[4];
#pragma unroll
    for (int j = 0; j < 4; ++j) gv[j] = ((const f32x4*)g0)[lane + 64 * j];
#pragma unroll 2
    for (int m = gw; m < M; m += NGW) {
        const f32x4* xr = (const f32x4*)(hin + (size_t)m * DM) + lane;
        f32x4 v[4]; float s = 0.f;
#pragma unroll
        for (int j = 0; j < 4; ++j) { v[j] = xr[64 * j]; s += dot4(v[j], v[j]); }
        const float rstd = rsqrtf(wave_sum(s) * (1.f / DM) + EPS);
        u32x2* o8 = (u32x2*)(HN + (size_t)m * DM) + lane;
#pragma unroll
        for (int j = 0; j < 4; ++j) { v[j] = v[j] * rstd * gv[j]; o8[64 * j] = (u32x2){pk2(v[j].x, v[j].y), pk2(v[j].z, v[j].w)}; }
        if (even) {
            float keep = 0.f;
#pragma unroll
            for (int c = 0; c < 16; ++c) { float d = 0.f;
#pragma unroll
                for (int j = 0; j < 4; ++j) d += dot4(v[j], wl[c * 256 + lane + 64 * j]);
                d = wave_sum(d); if (lane == c) keep = d; }
            if (lane < 16) Gt[(size_t)m * 16 + lane] = keep;
        }
    }
    if (even) __syncthreads();
}
struct Row16 { f32x4 v[4]; };
__device__ __forceinline__ Row16 ld_row_bf16(const bf16* row, int lane) { const u32x4 a = ((const u32x4*)row)[lane], b = ((const u32x4*)row)[lane + 64]; Row16 r;
    r.v[0] = (f32x4){bf_lo(a.x), bf_hi(a.x), bf_lo(a.y), bf_hi(a.y)}; r.v[1] = (f32x4){bf_lo(a.z), bf_hi(a.z), bf_lo(a.w), bf_hi(a.w)};
    r.v[2] = (f32x4){bf_lo(b.x), bf_hi(b.x), bf_lo(b.y), bf_hi(b.y)}; r.v[3] = (f32x4){bf_lo(b.z), bf_hi(b.z), bf_lo(b.w), bf_hi(b.w)}; return r; }
__device__ __forceinline__ Row16 ld_row_f32(const float* row, int lane) { const f32x4* p = (const f32x4*)row; Row16 r; r.v[0] = p[2 * lane]; r.v[1] = p[2 * lane + 1]; r.v[2] = p[128 + 2 * lane]; r.v[3] = p[128 + 2 * lane + 1]; return r; }
__device__ __forceinline__ void st_row_bf16(bf16* row, int lane, const Row16& r) {
    ((u32x4*)row)[lane] = (u32x4){pk2(r.v[0].x, r.v[0].y), pk2(r.v[0].z, r.v[0].w), pk2(r.v[1].x, r.v[1].y), pk2(r.v[1].z, r.v[1].w)};
    ((u32x4*)row)[lane + 64] = (u32x4){pk2(r.v[2].x, r.v[2].y), pk2(r.v[2].z, r.v[2].w), pk2(r.v[3].x, r.v[3].y), pk2(r.v[3].z, r.v[3].w)}; }
__device__ __forceinline__ void st_row_f32(float* row, int lane, const Row16& r) { f32x4* p = (f32x4*)row; p[2 * lane] = r.v[0]; p[2 * lane + 1] = r.v[1]; p[128 + 2 * lane] = r.v[2]; p[128 + 2 * lane + 1] = r.v[3]; }
__device__ __forceinline__ float row_sumsq(const Row16& r) { return (dot4(r.v[0], r.v[0]) + dot4(r.v[1], r.v[1])) + (dot4(r.v[2], r.v[2]) + dot4(r.v[3], r.v[3])); }
__device__ __forceinline__ void resid_a_phase(const bf16* mix, const float* hin32, bf16* hs, const float* g1, const float* g2, bf16* HN, int gw, int NGW, int lane) {
    const Row16 ga = ld_row_f32(g1, lane), gb = ld_row_f32(g2, lane);
    for (int m = gw; m < M; m += NGW) {
        const Row16 v = ld_row_bf16(mix + (size_t)m * DM, lane); Row16 h = hin32 ? ld_row_f32(hin32 + (size_t)m * DM, lane) : ld_row_bf16(hs + (size_t)m * DM, lane);
        const float r1 = rsqrtf(wave_sum(row_sumsq(v)) * (1.f / DM) + EPS);
#pragma unroll
        for (int j = 0; j < 4; ++j) h.v[j] = h.v[j] + v.v[j] * r1 * ga.v[j];
        st_row_bf16(hs + (size_t)m * DM, lane, h);
        const float r2 = rsqrtf(wave_sum(row_sumsq(h)) * (1.f / DM) + EPS);
#pragma unroll
        for (int j = 0; j < 4; ++j) h.v[j] = h.v[j] * r2 * gb.v[j];
        st_row_bf16(HN + (size_t)m * DM, lane, h);
    }
}
__device__ __forceinline__ void resid_b_phase(const bf16* ff, const bf16* hs, const float* g3, bf16* HB, const float* pl, bf16* PB, int gw, int NGW, int lane, int gtid, int NGT) {
    const Row16 ga = ld_row_f32(g3, lane);
    for (int m = gw; m < M; m += NGW) {
        const Row16 v = ld_row_bf16(ff + (size_t)m * DM, lane); Row16 h = ld_row_bf16(hs + (size_t)m * DM, lane);
        const float r1 = rsqrtf(wave_sum(row_sumsq(v)) * (1.f / DM) + EPS);
#pragma unroll
        for (int j = 0; j < 4; ++j) h.v[j] = h.v[j] + v.v[j] * r1 * ga.v[j];
        st_row_bf16(HB + (size_t)m * DM, lane, h);
    }
    for (int i = gtid; i < M * PLE / 8; i += NGT) { const f32x4 a = ((const f32x4*)pl)[2 * i], b = ((const f32x4*)pl)[2 * i + 1];
        ((u32x4*)PB)[i] = (u32x4){pk2(a.x, a.y), pk2(a.z, a.w), pk2(b.x, b.y), pk2(b.z, b.w)}; }
}
__device__ __forceinline__ void resid_c_phase(LAS unsigned char* lds, const bf16* gpre, const bf16* pp, const bf16* h2, bf16* hs, float* out32, bool has_next, const float* g0, bf16* HN, bool even_next, const float* Wg, float* Gt, int gw, int NGW, int tid, int lane) {
    LAS f32x4* wl = (LAS f32x4*)lds;
    if (has_next && even_next) { for (int i = tid; i < 4096; i += NTHR) wl[i] = ((const f32x4*)Wg)[i]; __syncthreads(); }
    const Row16 gv = ld_row_f32(g0, lane);
    for (int m = gw; m < M; m += NGW) {
        const Row16 g = ld_row_bf16(gpre + (size_t)m * DM, lane), p = ld_row_bf16(pp + (size_t)m * DM, lane); Row16 h = ld_row_bf16(h2 + (size_t)m * DM, lane);
#pragma unroll
        for (int j = 0; j < 4; ++j)
#pragma unroll
            for (int i = 0; i < 4; ++i) h.v[j][i] += p.v[j][i] * sigmoid_f(g.v[j][i]);
        if (has_next) {
            st_row_bf16(hs + (size_t)m * DM, lane, h);
            const float rstd = rsqrtf(wave_sum(row_sumsq(h)) * (1.f / DM) + EPS);
#pragma unroll
            for (int j = 0; j < 4; ++j) h.v[j] = h.v[j] * rstd * gv.v[j];
            st_row_bf16(HN + (size_t)m * DM, lane, h);
            if (even_next) {
                float keep = 0.f;
#pragma unroll
                for (int c = 0; c < 16; ++c) {
                    float d = (dot4(h.v[0], wl[c * 256 + 2 * lane]) + dot4(h.v[1], wl[c * 256 + 2 * lane + 1])) + (dot4(h.v[2], wl[c * 256 + 128 + 2 * lane]) + dot4(h.v[3], wl[c * 256 + 128 + 2 * lane + 1]));
                    d = wave_sum(d); if (lane == c) keep = d; }
                if (lane < 16) Gt[(size_t)m * 16 + lane] = keep;
            }
        } else st_row_f32(out32 + (size_t)m * DM, lane, h);
    }
    if (has_next && even_next) __syncthreads();
}
__device__ __forceinline__ void conv_phase(const bf16* X1, const float* convw  , bf16* QKVA, int gw, int NGW, int lane) {
    constexpr int RPW = 32;
    for (int blk = gw; blk < M / RPW; blk += NGW) {
        const int mb = blk * RPW;
#pragma unroll 1
        for (int j = 0; j < 3; ++j) {
            const int col = j * 512 + lane * 8;
            u32x4 h0, h1, h2;
            { const bool first = (mb & (SEQ - 1)) == 0; const u32x4 z = {0u, 0u, 0u, 0u};
              h0 = first ? z : *(const u32x4*)(X1 + (size_t)(mb - 3) * 1536 + col); h1 = first ? z : *(const u32x4*)(X1 + (size_t)(mb - 2) * 1536 + col); h2 = first ? z : *(const u32x4*)(X1 + (size_t)(mb - 1) * 1536 + col); }
            f32x4 w[4][2];
#pragma unroll
            for (int kk = 0; kk < 4; ++kk) { w[kk][0] = *(const f32x4*)(convw + kk * 1536 + col); w[kk][1] = *(const f32x4*)(convw + kk * 1536 + col + 4); }
#pragma unroll 2
            for (int r = 0; r < RPW; ++r) {
                const int m = mb + r;
                const u32x4 cur = *(const u32x4*)(X1 + (size_t)m * 1536 + col);
                const u32x4 xs[4] = {h0, h1, h2, cur};
                float acc[8];
#pragma unroll
                for (int i = 0; i < 8; ++i) acc[i] = 0.f;
#pragma unroll
                for (int kk = 0; kk < 4; ++kk) { const u32x4 xv = xs[kk]; const f32x4 w0 = w[kk][0], w1 = w[kk][1];
                    acc[0] += bf_lo(xv.x) * w0.x; acc[1] += bf_hi(xv.x) * w0.y; acc[2] += bf_lo(xv.y) * w0.z; acc[3] += bf_hi(xv.y) * w0.w;
                    acc[4] += bf_lo(xv.z) * w1.x; acc[5] += bf_hi(xv.z) * w1.y; acc[6] += bf_lo(xv.w) * w1.z; acc[7] += bf_hi(xv.w) * w1.w; }
                h0 = h1; h1 = h2; h2 = cur;
                float ss = 0.f;
#pragma unroll
                for (int i = 0; i < 8; ++i) { acc[i] = acc[i] / (1.f + __expf(-acc[i])); ss += acc[i] * acc[i]; }
                if (j < 2) { ss += __shfl_xor(ss, 1); ss += __shfl_xor(ss, 2); ss += __shfl_xor(ss, 4); ss += __shfl_xor(ss, 8);
                    const float sc = rsqrtf(ss + EPS) * (j == 0 ? 0.08838834764831845f : 1.f);
#pragma unroll
                    for (int i = 0; i < 8; ++i) acc[i] *= sc; }
                *(u32x4*)(QKVA + (size_t)m * 1536 + col) = (u32x4){pk2(acc[0], acc[1]), pk2(acc[2], acc[3]), pk2(acc[4], acc[5]), pk2(acc[6], acc[7])};
            }
        }
    }
}
__device__ __forceinline__ void rope_phase(bf16* QKV, const f32x2* rope, int gw, int NGW, int lane) {
#pragma unroll 2
    for (int m = gw; m < M; m += NGW) {
        const int grp = lane & 7; const f32x4* tb = (const f32x4*)(rope + (size_t)m * 32 + grp * 4); const f32x4 t0 = tb[0], t1 = tb[1];
        const float cs[4] = {t0.x, t0.z, t1.x, t1.z}, sn[4] = {t0.y, t0.w, t1.y, t1.w};
#pragma unroll
        for (int k = 0; k < 3; ++k) {
            if (k == 2 && lane >= 32) break;
            const int hh = (k < 2) ? ((lane + 64 * k) >> 3) : (lane >> 3); const float scale = (k < 2) ? 0.125f : 1.f;
            bf16* base = QKV + (size_t)m * 1536 + (k < 2 ? 0 : 1024) + hh * 64 + grp * 4;
            const u32x2 a = *(const u32x2*)base, b = *(const u32x2*)(base + 32);
            const float x1[4] = {bf_lo(a.x), bf_hi(a.x), bf_lo(a.y), bf_hi(a.y)}, x2[4] = {bf_lo(b.x), bf_hi(b.x), bf_lo(b.y), bf_hi(b.y)};
            float o1[4], o2[4];
#pragma unroll
            for (int i = 0; i < 4; ++i) { o1[i] = (x1[i] * cs[i] - x2[i] * sn[i]) * scale; o2[i] = (x2[i] * cs[i] + x1[i] * sn[i]) * scale; }
            *(u32x2*)base = (u32x2){pk2(o1[0], o1[1]), pk2(o1[2], o1[3])}; *(u32x2*)(base + 32) = (u32x2){pk2(o2[0], o2[1]), pk2(o2[2], o2[3])};
        }
    }
}
typedef short bf16x8 __attribute__((ext_vector_type(8)));
#define MFMA16(a, b, c) __builtin_amdgcn_mfma_f32_16x16x32_bf16(a, b, c, 0, 0, 0)
__device__ __forceinline__ bf16x8 pack8(f32x4 a, f32x4 b) { const u32x4 w = {pk2v(a.x, a.y), pk2v(a.z, a.w), pk2v(b.x, b.y), pk2v(b.z, b.w)}; return __builtin_bit_cast(bf16x8, w); }
__device__ __forceinline__ float bf2f(unsigned short v) { return __builtin_bit_cast(float, (unsigned)v << 16); }
__device__ __forceinline__ float rdlane(float v, int i) { return __builtin_bit_cast(float, __builtin_amdgcn_readlane(__builtin_bit_cast(int, v), i)); }
__device__ __forceinline__ float scan_add(float v, int lane) {
#pragma unroll
    for (int o = 1; o < 64; o <<= 1) { const float t = __shfl_up(v, o); if (lane >= o) v += t; }
    return v; }
__device__ __forceinline__ float scan_max(float v, int lane) {
#pragma unroll
    for (int o = 1; o < 64; o <<= 1) { const float t = __shfl_up(v, o); if (lane >= o) v = fmaxf(v, t); }
    return v; }
__device__ __forceinline__ int kperm(int ks, int q, int jj) { return 32 * ks + (jj < 4 ? 4 * q + jj : 16 + 4 * q + jj - 4); }
template <bool SCALE> __device__ __forceinline__ u32x4 tr_gather(const bf16* src  , int ld, int ks, int q, float esc_lane) {
    unsigned w[4];
#pragma unroll
    for (int j2 = 0; j2 < 4; ++j2) { const int r0 = kperm(ks, q, 2 * j2), r1 = r0 + 1; const unsigned short a = src[(size_t)r0 * ld], b = src[(size_t)r1 * ld];
        if (SCALE) { const float s0 = __shfl(esc_lane, r0), s1 = __shfl(esc_lane, r1); w[j2] = pk2(bf2f(a) * s0, bf2f(b) * s1); } else w[j2] = (unsigned)a | ((unsigned)b << 16); }
    return (u32x4){w[0], w[1], w[2], w[3]};
}
struct ScanBufs {
    bf16* QKVA;
    bf16* X2;
    float* Gt;
    bf16 *KT, *UT, *NW, *ATT;
    bf16 *KWT, *VT, *PT;
    float* DEN;
};
__device__ __forceinline__ void local_phase(LAS unsigned char* lds, const ScanBufs sb, const float* a_log, const float* dt_bias, const float* i_bias, const float* f_bias, int gw, int NGW, int wave, int lane) {
    LAS float* Lw = (LAS float*)(lds + wave * 16384);
    const int njobs = 2 * BATCH * 4 * (SEQ / 64), per = (njobs + NGW - 1) / NGW; const int lane_in = lane;
#pragma unroll 1
    for (int rj = 0; rj < per; ++rj) {
        const int job = gw * per + rj; if (job >= njobs) break;
        int lane = lane_in; asm volatile("" : "+v"(lane));
        const int x = lane & 15, q = lane >> 4;
        const int mixer = job & 1, cidx = job >> 1, c = cidx & 31, h = (cidx >> 5) & 3, b = cidx >> 7;
        const int m0 = b * SEQ + c * 64; const size_t cid = (size_t)cidx;
        float* gr = sb.Gt + (size_t)(m0 + lane) * 16;
        if (mixer == 0) {
            const float beta = 1.f / (1.f + expf(-gr[h])); const float g = -expf(a_log[h]) * softplus_f(gr[4 + h] + dt_bias[h]);
            const float gcum = scan_add(g, lane), eg = expf(gcum), glast = __shfl(gcum, 63);
            const bf16* kb = sb.QKVA + (size_t)m0 * 1536 + 512 + h * 128; const bf16* qb = sb.QKVA + (size_t)m0 * 1536 + h * 128; const bf16* vb = kb + 512;
            bf16x8 Kf[4][4], Qf[4][4];
#pragma unroll
            for (int t = 0; t < 4; ++t)
#pragma unroll
                for (int ks = 0; ks < 4; ++ks) { Kf[t][ks] = *(const bf16x8*)(kb + (size_t)(16 * t + x) * 1536 + 32 * ks + 8 * q); Qf[t][ks] = *(const bf16x8*)(qb + (size_t)(16 * t + x) * 1536 + 32 * ks + 8 * q); }
            float gj[4][4];
#pragma unroll
            for (int jt = 0; jt < 4; ++jt)
#pragma unroll
                for (int r = 0; r < 4; ++r) gj[jt][r] = __shfl(gcum, 16 * jt + 4 * q + r);
            bf16* attp = sb.ATT + cid * 4096;
#pragma unroll
            for (int it = 0; it < 4; ++it) {
                const float gi = __shfl(gcum, 16 * it + x), bi = __shfl(beta, 16 * it + x); f32x4 d2s[4];
#pragma unroll
                for (int jt = 0; jt < 4; ++jt) {
                    if (jt <= it) { f32x4 D1 = {0.f, 0.f, 0.f, 0.f}, D2 = D1;
#pragma unroll
                        for (int ks = 0; ks < 4; ++ks) { D1 = MFMA16(Kf[jt][ks], Kf[it][ks], D1); D2 = MFMA16(Kf[jt][ks], Qf[it][ks], D2); }
                        f32x4 lv;
#pragma unroll
                        for (int r = 0; r < 4; ++r) { const int j = 16 * jt + 4 * q + r, i = 16 * it + x; const float dec = __expf(fminf(gi - gj[jt][r], 0.f));
                            lv[r] = (j < i) ? bi * D1[r] * dec : 0.f; d2s[jt][r] = (j <= i) ? D2[r] * dec : 0.f; }
#pragma unroll
                        for (int r = 0; r < 4; ++r) Lw[(16 * jt + 4 * q + r) * 64 + 16 * it + x] = lv[r];
                    } else d2s[jt] = (f32x4){0.f, 0.f, 0.f, 0.f};
                }
#pragma unroll
                for (int kp = 0; kp < 2; ++kp) if (it >= 2 || kp == 0) *(bf16x8*)(attp + ((it * 2 + kp) * 64 + lane) * 8) = pack8(d2s[2 * kp], d2s[2 * kp + 1]);
            }
            { float* tab = (float*)(attp + 512); tab[lane] = eg; tab[64 + lane] = expf(glast - gcum); }
            bf16* ktp = sb.KT + cid * 8192;
#pragma unroll 1
            for (int dt = 0; dt < 8; ++dt)
#pragma unroll
                for (int kp = 0; kp < 2; ++kp) *(u32x4*)(ktp + ((dt * 2 + kp) * 64 + lane) * 8) = tr_gather<false>(kb + 16 * dt + x, 1536, kp, q, 0.f);
            LDS_WAIT();
            const float be = beta * eg;
#pragma unroll 1
            for (int p = 0; p < 4; ++p) {
                const int col = 64 * (p & 1) + lane; const bf16* src = (p < 2 ? vb : kb) + col; const float scl = p < 2 ? beta : be;
                float xv[64];
#pragma unroll
                for (int i = 0; i < 64; ++i) xv[i] = bf2f(src[(size_t)i * 1536]);
                asm volatile("" ::: "memory");
#pragma unroll
                for (int i = 0; i < 64; ++i) xv[i] *= rdlane(scl, i);
#pragma unroll
                for (int j = 0; j < 63; ++j) {
#pragma unroll
                    for (int g4 = (j + 1) / 4; g4 < 16; ++g4) { const f32x4 lc = *(const LAS f32x4*)(Lw + j * 64 + 4 * g4);
                        if (4 * g4 + 0 > j) xv[4 * g4 + 0] -= lc.x * xv[j]; if (4 * g4 + 1 > j) xv[4 * g4 + 1] -= lc.y * xv[j]; if (4 * g4 + 2 > j) xv[4 * g4 + 2] -= lc.z * xv[j]; if (4 * g4 + 3 > j) xv[4 * g4 + 3] -= lc.w * xv[j]; }
                }
                if (p < 2) { bf16* ut = sb.UT + cid * 8192 + (size_t)col * 64;
#pragma unroll
                    for (int k8 = 0; k8 < 8; ++k8) *(u32x4*)(ut + 8 * k8) = (u32x4){pk2(xv[8 * k8], xv[8 * k8 + 1]), pk2(xv[8 * k8 + 2], xv[8 * k8 + 3]), pk2(xv[8 * k8 + 4], xv[8 * k8 + 5]), pk2(xv[8 * k8 + 6], xv[8 * k8 + 7])};
                } else { const int d = col, ks = d >> 5, dd = d & 31, qp = (dd & 15) >> 2, jj = (dd & 3) + 4 * (dd >> 4);
                    unsigned char* nw = (unsigned char*)(sb.NW + cid * 8192) + ks * 1024 + qp * 256 + jj * 2;
#pragma unroll
                    for (int i = 0; i < 64; ++i) *(unsigned short*)(nw + (i >> 4) * 4096 + (i & 15) * 16) = (unsigned short)(pk2(-xv[i], 0.f) & 0xffffu);
                }
            }
            LDS_WAIT();
        } else {
            const float il = gr[8 + h] + i_bias[h]; const float fl = -softplus_f(-(gr[12 + h] + f_bias[h]));
            const float bcum = scan_add(fl, lane), t = il - bcum, pm = scan_max(t, lane), pml = __shfl(pm, 63);
            const float esc = __expf(t - pml);
            const bf16* qb = sb.X2 + (size_t)m0 * 2560 + 512 + h * 128; const bf16* kb = qb + 512; const bf16* vb = kb + 512;
            bf16x8 Kf[4][4], Qf[4][4];
#pragma unroll
            for (int tt = 0; tt < 4; ++tt)
#pragma unroll
                for (int ks = 0; ks < 4; ++ks) { Kf[tt][ks] = *(const bf16x8*)(kb + (size_t)(16 * tt + x) * 2560 + 32 * ks + 8 * q); Qf[tt][ks] = *(const bf16x8*)(qb + (size_t)(16 * tt + x) * 2560 + 32 * ks + 8 * q); }
            float tj[4][4];
#pragma unroll
            for (int jt = 0; jt < 4; ++jt)
#pragma unroll
                for (int r = 0; r < 4; ++r) tj[jt][r] = __shfl(t, 16 * jt + 4 * q + r);
            bf16* ptp = sb.PT + cid * 4096;
#pragma unroll
            for (int it = 0; it < 4; ++it) {
                const float pmi = __shfl(pm, 16 * it + x); f32x4 d2s[4];
#pragma unroll
                for (int jt = 0; jt < 4; ++jt) {
                    if (jt <= it) { f32x4 D2 = {0.f, 0.f, 0.f, 0.f};
#pragma unroll
                        for (int ks = 0; ks < 4; ++ks) D2 = MFMA16(Kf[jt][ks], Qf[it][ks], D2);
#pragma unroll
                        for (int r = 0; r < 4; ++r) { const int j = 16 * jt + 4 * q + r, i = 16 * it + x; d2s[jt][r] = (j <= i) ? D2[r] * 0.08838834764831845f * __expf(fminf(tj[jt][r] - pmi, 0.f)) : 0.f; }
                    } else d2s[jt] = (f32x4){0.f, 0.f, 0.f, 0.f};
                }
#pragma unroll
                for (int kp = 0; kp < 2; ++kp) if (it >= 2 || kp == 0) *(bf16x8*)(ptp + ((it * 2 + kp) * 64 + lane) * 8) = pack8(d2s[2 * kp], d2s[2 * kp + 1]);
            }
            { float* tab = (float*)(ptp + 512); tab[lane] = bcum; tab[64 + lane] = bcum + pm; }
            bf16* kwp = sb.KWT + cid * 8192; bf16* vtp = sb.VT + cid * 8192;
#pragma unroll 1
            for (int dt = 0; dt < 8; ++dt)
#pragma unroll
                for (int kp = 0; kp < 2; ++kp) { *(u32x4*)(kwp + ((dt * 2 + kp) * 64 + lane) * 8) = tr_gather<true>(kb + 16 * dt + x, 2560, kp, q, esc);
                    *(u32x4*)(vtp + ((dt * 2 + kp) * 64 + lane) * 8) = tr_gather<false>(vb + 16 * dt + x, 2560, kp, q, 0.f); }
        }
    }
}
constexpr int RC_NW = 0, RC_ATT = 16384, RC_KT = 24576, RC_QP = 40960, RC_BUF = 57344;
__device__ __forceinline__ void recur_stage(LAS unsigned char* buf, const bf16* f16a  , const bf16* f8  , const bf16* f16b  , const bf16* qbase  , int qpitch, int wave, int lane) {
#pragma unroll
    for (int k = 0; k < 5; ++k) { const int bl = wave + 8 * k;
        const bf16* src = bl < 16 ? f16a + bl * 512 : (bl < 24 ? f8 + (bl - 16) * 512 : f16b + (bl - 24) * 512);
        __builtin_amdgcn_global_load_lds((const unsigned*)(src + lane * 8), (LAS unsigned*)(buf + bl * 1024), 16, 0, 0); }
#pragma unroll
    for (int k = 0; k < 8; ++k) { const int P = (wave * 8 + k) * 256 + lane * 4, f = P >> 10, lp = (P & 1023) >> 4, jj0 = ((P & 15) >> 2) * 2, it = f >> 2, ks = f & 3, xp = lp & 15, qp = lp >> 4;
        const bf16* src = qbase + (size_t)(16 * it + xp) * qpitch + kperm(ks, qp, jj0);
        __builtin_amdgcn_global_load_lds((const unsigned*)src, (LAS unsigned*)(buf + RC_QP + (wave * 8 + k) * 256), 4, 0, 0); }
}
__device__ __forceinline__ void recur_phase(LAS unsigned char* lds, const ScanBufs sb, int G, int bid, int wave, int lane) {
    const int x = lane & 15, q = lane >> 4, et = wave;
#pragma unroll 1
    for (int u = bid; u < 2 * BATCH * 4; u += G) {
        const int mixer = u >> 7, b = (u & 127) >> 2, h = u & 3;
        const size_t cid0 = (size_t)((b * 4 + h) * 32);
        if (mixer == 0) {
            f32x4 S[8];
#pragma unroll
            for (int d = 0; d < 8; ++d) S[d] = (f32x4){0.f, 0.f, 0.f, 0.f};
            recur_stage(lds, sb.NW + cid0 * 8192, sb.ATT + cid0 * 4096, sb.KT + cid0 * 8192, sb.QKVA + (size_t)(b * SEQ) * 1536 + h * 128, 1536, wave, lane);
            __syncthreads();
#pragma unroll 1
            for (int c = 0; c < SEQ / 64; ++c) {
                const int m0 = b * SEQ + c * 64; const size_t cid = cid0 + c;
                const LAS unsigned char* buf = lds + (c & 1) * RC_BUF;
                { const int cn = c + 1 < SEQ / 64 ? c + 1 : c; const size_t cidn = cid0 + cn;
                  recur_stage(lds + ((c + 1) & 1) * RC_BUF, sb.NW + cidn * 8192, sb.ATT + cidn * 4096, sb.KT + cidn * 8192, sb.QKVA + (size_t)(b * SEQ + cn * 64) * 1536 + h * 128, 1536, wave, lane); }
                const bf16* utp = sb.UT + cid * 8192 + (size_t)(16 * et + x) * 64;
                const LAS float* tab = (const LAS float*)(buf + RC_ATT + 1024);
                bf16x8 Sb[4];
#pragma unroll
                for (int ks = 0; ks < 4; ++ks) Sb[ks] = pack8(S[2 * ks], S[2 * ks + 1]);
                f32x4 vn[4];
#pragma unroll
                for (int mt = 0; mt < 4; ++mt) { const u32x2 uu = *(const u32x2*)(utp + 16 * mt + 4 * q); f32x4 acc = {bf_lo(uu.x), bf_hi(uu.x), bf_lo(uu.y), bf_hi(uu.y)};
#pragma unroll
                    for (int ks = 0; ks < 4; ++ks) acc = MFMA16(*(const LAS bf16x8*)(buf + RC_NW + ((mt * 4 + ks) * 64 + lane) * 16), Sb[ks], acc);
                    vn[mt] = acc; }
                bf16x8 vb2[2] = {pack8(vn[0], vn[1]), pack8(vn[2], vn[3])};
#pragma unroll
                for (int it = 0; it < 4; ++it) { f32x4 acc = {0.f, 0.f, 0.f, 0.f};
#pragma unroll
                    for (int ks = 0; ks < 4; ++ks) acc = MFMA16(Sb[ks], *(const LAS bf16x8*)(buf + RC_QP + ((it * 4 + ks) * 64 + lane) * 16), acc);
                    acc = acc * tab[16 * it + x];
#pragma unroll
                    for (int kp = 0; kp < 2; ++kp) if (it >= 2 || kp == 0) acc = MFMA16(vb2[kp], *(const LAS bf16x8*)(buf + RC_ATT + ((it * 2 + kp) * 64 + lane) * 16), acc);
                    *(u32x2*)(sb.QKVA + (size_t)(m0 + 16 * it + x) * 1536 + 512 + h * 128 + 16 * et + 4 * q) = (u32x2){pk2v(acc.x, acc.y), pk2v(acc.z, acc.w)}; }
                f32x4 vs[4];
#pragma unroll
                for (int mt = 0; mt < 4; ++mt) { const f32x4 kk = *(const LAS f32x4*)(tab + 64 + 16 * mt + 4 * q); vs[mt] = vn[mt] * kk; }
                const bf16x8 vsb[2] = {pack8(vs[0], vs[1]), pack8(vs[2], vs[3])};
                const float gam = tab[63];
#pragma unroll
                for (int dt = 0; dt < 8; ++dt) { f32x4 acc = S[dt] * gam;
#pragma unroll
                    for (int kp = 0; kp < 2; ++kp) acc = MFMA16(*(const LAS bf16x8*)(buf + RC_KT + ((dt * 2 + kp) * 64 + lane) * 16), vsb[kp], acc);
                    S[dt] = acc; }
                __syncthreads();
            }
        } else {
            f32x4 Cs[8], Ce[8]; float mrun = 0.f;
#pragma unroll
            for (int d = 0; d < 8; ++d) { Cs[d] = (f32x4){0.f, 0.f, 0.f, 0.f}; Ce[d] = Cs[d]; }
            const short one = (x == 0) ? (short)0x3F80 : (short)0; const bf16x8 ones = {one, one, one, one, one, one, one, one};
            recur_stage(lds, sb.KWT + cid0 * 8192, sb.PT + cid0 * 4096, sb.KWT + cid0 * 8192, sb.X2 + (size_t)(b * SEQ) * 2560 + 512 + h * 128, 2560, wave, lane);
            __syncthreads();
#pragma unroll 1
            for (int c = 0; c < SEQ / 64; ++c) {
                const int m0 = b * SEQ + c * 64; const size_t cid = cid0 + c;
                const LAS unsigned char* buf = lds + (c & 1) * RC_BUF;
                { const int cn = c + 1 < SEQ / 64 ? c + 1 : c; const size_t cidn = cid0 + cn;
                  recur_stage(lds + ((c + 1) & 1) * RC_BUF, sb.KWT + cidn * 8192, sb.PT + cidn * 4096, sb.KWT + cidn * 8192, sb.X2 + (size_t)(b * SEQ + cn * 64) * 2560 + 512 + h * 128, 2560, wave, lane); }
                const bf16* vtp = sb.VT + cid * 8192;
                const LAS float* tab = (const LAS float*)(buf + RC_ATT + 1024);
                bf16x8 Cb[4], Eb[4];
#pragma unroll
                for (int ks = 0; ks < 4; ++ks) { Cb[ks] = pack8(Cs[2 * ks], Cs[2 * ks + 1]); Eb[ks] = pack8(Ce[2 * ks], Ce[2 * ks + 1]); }
                const bf16x8 vf[2] = {*(const bf16x8*)(vtp + ((et * 2 + 0) * 64 + lane) * 8), *(const bf16x8*)(vtp + ((et * 2 + 1) * 64 + lane) * 8)};
#pragma unroll
                for (int it = 0; it < 4; ++it) {
                    const float bc = tab[16 * it + x], mi = tab[64 + 16 * it + x];
                    const float a = bc + mrun, mt = fmaxf(a, mi), f1 = __expf(a - mt) * 0.08838834764831845f, f2 = __expf(mi - mt);
                    f32x4 a1 = {0.f, 0.f, 0.f, 0.f}, aP = a1, e1 = a1, eP = a1;
#pragma unroll
                    for (int ks = 0; ks < 4; ++ks) { const bf16x8 qf = *(const LAS bf16x8*)(buf + RC_QP + ((it * 4 + ks) * 64 + lane) * 16);
                        a1 = MFMA16(Cb[ks], qf, a1); if (wave == 0) e1 = MFMA16(Eb[ks], qf, e1); }
#pragma unroll
                    for (int kp = 0; kp < 2; ++kp) if (it >= 2 || kp == 0) { const bf16x8 pf = *(const LAS bf16x8*)(buf + RC_ATT + ((it * 2 + kp) * 64 + lane) * 16); aP = MFMA16(vf[kp], pf, aP); if (wave == 0) eP = MFMA16(ones, pf, eP); }
                    const f32x4 nm = a1 * f1 + aP * f2;
                    *(u32x2*)(sb.X2 + (size_t)(m0 + 16 * it + x) * 2560 + 1024 + h * 128 + 16 * et + 4 * q) = (u32x2){pk2(nm.x, nm.y), pk2(nm.z, nm.w)};
                    if (wave == 0 && q == 0) sb.DEN[(size_t)(m0 + 16 * it + x) * 4 + h] = fmaxf(fabsf(e1.x * f1 + eP.x * f2), __expf(-mt));
                }
                const float blast = tab[63], wsmax = tab[127];
                const float mnew = fmaxf(blast + mrun, wsmax), sc = __expf(blast + mrun - mnew), s2 = __expf(wsmax - mnew); mrun = mnew;
#pragma unroll
                for (int dt = 0; dt < 8; ++dt) { f32x4 dC = {0.f, 0.f, 0.f, 0.f}, dE = dC;
#pragma unroll
                    for (int kp = 0; kp < 2; ++kp) { const bf16x8 kf = *(const LAS bf16x8*)(buf + RC_KT + ((dt * 2 + kp) * 64 + lane) * 16); dC = MFMA16(kf, vf[kp], dC); if (wave == 0) dE = MFMA16(kf, ones, dE); }
                    Cs[dt] = Cs[dt] * sc + dC * s2; if (wave == 0) Ce[dt] = Ce[dt] * sc + dE * s2; }
                __syncthreads();
            }
        }
    }
}
__device__ __forceinline__ void post_phase(const ScanBufs sb, const float* norm_a, const float* norm_b, bf16* MIXED, int gw, int NGW, int lane) {
    const int hh = lane >> 3, sub = (lane & 7) * 16;
#pragma unroll 2
    for (int m = gw; m < M; m += NGW) {
        const bool isA = hh < 4; const int h = hh & 3;
        const bf16* src = isA ? sb.QKVA + (size_t)m * 1536 + 512 + h * 128 + sub : sb.X2 + (size_t)m * 2560 + 1024 + h * 128 + sub;
        const bf16* gsrc = sb.X2 + (size_t)m * 2560 + (isA ? 0 : 2048) + h * 128 + sub;
        const float* gn = (isA ? norm_a : norm_b + h * 128) + sub;
        const u32x4 r0 = *(const u32x4*)src, r1 = *(const u32x4*)(src + 8), z0 = *(const u32x4*)gsrc, z1 = *(const u32x4*)(gsrc + 8);
        float v[16] = {bf_lo(r0.x), bf_hi(r0.x), bf_lo(r0.y), bf_hi(r0.y), bf_lo(r0.z), bf_hi(r0.z), bf_lo(r0.w), bf_hi(r0.w), bf_lo(r1.x), bf_hi(r1.x), bf_lo(r1.y), bf_hi(r1.y), bf_lo(r1.z), bf_hi(r1.z), bf_lo(r1.w), bf_hi(r1.w)};
        const float z[16] = {bf_lo(z0.x), bf_hi(z0.x), bf_lo(z0.y), bf_hi(z0.y), bf_lo(z0.z), bf_hi(z0.z), bf_lo(z0.w), bf_hi(z0.w), bf_lo(z1.x), bf_hi(z1.x), bf_lo(z1.y), bf_hi(z1.y), bf_lo(z1.z), bf_hi(z1.z), bf_lo(z1.w), bf_hi(z1.w)};
        const float dinv = isA ? 1.f : 1.f / sb.DEN[(size_t)m * 4 + h];
        float ss = 0.f;
#pragma unroll
        for (int i = 0; i < 16; ++i) { v[i] *= dinv; ss += v[i] * v[i]; }
        ss += __shfl_xor(ss, 1); ss += __shfl_xor(ss, 2); ss += __shfl_xor(ss, 4);
        const float rstd = rsqrtf(ss * (1.f / 128.f) + EPS);
        float y[16];
#pragma unroll
        for (int i = 0; i < 16; ++i) { const float sg = sigmoid_f(z[i]); y[i] = v[i] * rstd * gn[i] * (isA ? z[i] * sg : sg); }
        u32x4* dst = (u32x4*)(MIXED + (size_t)m * 1024 + lane * 16);
        dst[0] = (u32x4){pk2(y[0], y[1]), pk2(y[2], y[3]), pk2(y[4], y[5]), pk2(y[6], y[7])}; dst[1] = (u32x4){pk2(y[8], y[9]), pk2(y[10], y[11]), pk2(y[12], y[13]), pk2(y[14], y[15])};
    }
}
typedef short v4i16_t __attribute__((ext_vector_type(4)));
constexpr int AT_VROW = 80;
constexpr int AT_K_BYTES = 256 * 128, AT_V_BYTES = 272 * AT_VROW * 2;
__device__ __forceinline__ void attn_phase(LAS unsigned char* lds, int tid, int wave, const bf16* QKV, const float* sinks, bf16* O, int G, int bid) {
    LAS unsigned char* KL = lds; LAS unsigned char* VL = lds + AT_K_BYTES;
    const int lane = tid & 63, x = lane & 15, q = lane >> 4, g = wave >> 1, qh = wave & 1;
#pragma unroll 1
    for (int u = bid; u < BATCH * 4 * 16; u += G) {
        const int b = u >> 6, kvh = (u >> 4) & 3, jb = u & 15;
#pragma unroll
        for (int i = 0; i < 4; ++i) { const int item = tid + 512 * i, r = item >> 3, ch = item & 7, sk = (jb - 1) * 128 + r;
            u32x4 kv = (u32x4){0u, 0u, 0u, 0u}, vv = kv;
            if (sk >= 0) { const bf16* src = QKV + (size_t)(b * SEQ + sk) * 1536 + 1024 + kvh * 64 + ch * 8; kv = *(const u32x4*)src; vv = *(const u32x4*)(src + 256); }
            *(LAS u32x4*)(KL + r * 128 + ((ch ^ (r & 7)) << 4)) = kv; *(LAS u32x4*)(VL + r * (AT_VROW * 2) + ch * 16) = vv; }
        if (tid < 128) { const int r = 256 + (tid >> 3), ch = tid & 7; *(LAS u32x4*)(VL + r * (AT_VROW * 2) + ch * 16) = (u32x4){0u, 0u, 0u, 0u}; }
        __syncthreads();
        const int hq = kvh * 4 + g; const float sink = sinks[hq];
        const size_t mq = (size_t)b * SEQ + jb * 128 + 64 * qh;
#pragma unroll 1
        for (int nt = 0; nt < 4; ++nt) {
            bf16x8 Qf[2];
#pragma unroll
            for (int ks = 0; ks < 2; ++ks) Qf[ks] = *(const bf16x8*)(QKV + (mq + 16 * nt + x) * 1536 + hq * 64 + 32 * ks + 8 * q);
            f32x4 s[9]; float mx = -3.0e38f;
#pragma unroll
            for (int j = 0; j < 9; ++j) { const int kt = nt + j, r = 64 * qh + 16 * kt + x;
                f32x4 acc = {0.f, 0.f, 0.f, 0.f};
#pragma unroll
                for (int ks = 0; ks < 2; ++ks) acc = MFMA16(*(const LAS bf16x8*)(KL + r * 128 + (((4 * ks + q) ^ (r & 7)) << 4)), Qf[ks], acc);
#pragma unroll
                for (int rg = 0; rg < 4; ++rg) { const int diff = 16 * j + 4 * q + rg - x, ra = 64 * qh + 16 * kt + 4 * q + rg;
                    const bool valid = diff >= 1 && diff <= 128 && (jb - 1) * 128 + ra >= 0;
                    acc[rg] = valid ? acc[rg] : -3.0e38f; mx = fmaxf(mx, acc[rg]); }
                s[j] = acc; }
            mx = fmaxf(mx, __shfl_xor(mx, 16)); mx = fmaxf(mx, __shfl_xor(mx, 32)); mx = fmaxf(mx, sink);
            float sum = 0.f;
#pragma unroll
            for (int j = 0; j < 9; ++j)
#pragma unroll
                for (int rg = 0; rg < 4; ++rg) { const float p = (s[j][rg] > -1.0e38f) ? __expf(s[j][rg] - mx) : 0.f; s[j][rg] = p; sum += p; }
            sum += __shfl_xor(sum, 16); sum += __shfl_xor(sum, 32);
            const float inv = 1.f / (sum + __expf(sink - mx));
            bf16x8 Pf[5];
#pragma unroll
            for (int j2 = 0; j2 < 4; ++j2) Pf[j2] = pack8(s[2 * j2], s[2 * j2 + 1]);
            Pf[4] = pack8(s[8], (f32x4){0.f, 0.f, 0.f, 0.f});
#pragma unroll
            for (int dt = 0; dt < 4; ++dt) { f32x4 acc = {0.f, 0.f, 0.f, 0.f};
#pragma unroll
                for (int j2 = 0; j2 < 5; ++j2) { const int kb = 64 * qh + 16 * (nt + 2 * j2) + 4 * q + (x >> 2);
                    const LAS unsigned char* p0 = VL + kb * (AT_VROW * 2) + (16 * dt + 4 * (x & 3)) * 2;
                    const v4i16_t lo = __builtin_amdgcn_ds_read_tr16_b64_v4i16((LAS v4i16_t*)p0), hi = __builtin_amdgcn_ds_read_tr16_b64_v4i16((LAS v4i16_t*)(p0 + 16 * AT_VROW * 2));
                    const bf16x8 vf = {lo[0], lo[1], lo[2], lo[3], hi[0], hi[1], hi[2], hi[3]};
                    acc = MFMA16(vf, Pf[j2], acc); }
                acc = acc * inv;
                *(u32x2*)(O + (mq + 16 * nt + x) * 1024 + hq * 64 + 16 * dt + 4 * q) = (u32x2){pk2v(acc.x, acc.y), pk2v(acc.z, acc.w)}; }
        }
        __syncthreads();
    }
}
#ifndef N_LAUNCH_MODE
#define N_LAUNCH_MODE 0
#endif
__global__ void __launch_bounds__(NTHR, 2) trunk_fwd(Args a_unused) {
    extern __shared__ __attribute__((aligned(16))) unsigned char lds_raw[];
    LAS unsigned char* lds = (LAS unsigned char*)lds_raw;
    volatile LAS unsigned* MISC = (volatile LAS unsigned*)(lds + MISC_OFF);
    if (threadIdx.x < 64) MISC[threadIdx.x] = 0u;
    __syncthreads();
    int lo, hi; XcdBarrier bar;
    int dupm = 0, dupp = 0; (void)dupm; (void)dupp;
    { KArgs a = kargs(); lo = a->ph_lo; hi = a->ph_hi; dupm = a->dup_mask; dupp = a->dup_par; unsigned* ctl = (unsigned*)(a->ws + WS_CTL);
      bar.bar = ctl + CW_BAR; bar.x = 0; bar.st = MISC + 8;
      if (hi - lo > 1) bar = xcd_barrier_post(ctl + CW_BAR, MISC + 8); }
#define IN(k) (lo <= (k) && (k) < hi)
#if defined(PROBE_DUP_MASK)
#define REP(k) _Pragma("unroll 1") for (int rep_ = 0; rep_ <= (((dupm >> (k)) & 1) && (dupp == 0 || dupp == 1 + (L & 1)) ? 1 : 0); ++rep_)
#else
#define REP(k)
#endif
#if defined(PROBE_BAR2)
#define SEAM(k) do { if (IN(k) && IN((k) + 1)) { xcd_barrier(bar); xcd_barrier(bar); } } while (0)
#else
#define SEAM(k) do { if (IN(k) && IN((k) + 1)) xcd_barrier(bar); } while (0)
#endif
#define ENV KArgs a = kargs(); const int tid = fresh_tid(), lane = tid & 63, wave = __builtin_amdgcn_readfirstlane(tid >> 6); const int G = gridDim.x, bid = blockIdx.x, gw = bid * NWAVES + wave, NGW = G * NWAVES, gtid = bid * NTHR + tid, NGT = G * NTHR; \
    unsigned char* ws = a->ws; bf16* RA = (bf16*)(ws + WS_RA); bf16* RB = (bf16*)(ws + WS_RB); bf16* RC = (bf16*)(ws + WS_RC); bf16* RD = (bf16*)(ws + WS_RD); float* Gt = (float*)(ws + WS_GT); \
    (void)lane; (void)wave; (void)gw; (void)NGW; (void)gtid; (void)NGT; (void)RA; (void)RB; (void)RC; (void)RD; (void)Gt; (void)G; (void)bid

    if (IN(0)) { ENV; prologue_phase(a, lds, gw, NGW, wave, lane, gtid, NGT);
#if defined(PROBE_DUP_MASK)
        if (dupm & (1 << 20)) prologue_phase(a, lds, gw, NGW, wave, lane, gtid, NGT);
#endif
    }
    SEAM(0);
#define SCANBUFS ScanBufs sb; sb.QKVA = (bf16*)(ws + WS_QKVA); sb.X2 = (bf16*)(ws + WS_X2); sb.Gt = Gt; sb.KT = (bf16*)(ws + WS_KT); sb.UT = (bf16*)(ws + WS_UT); sb.NW = (bf16*)(ws + WS_NW); sb.ATT = (bf16*)(ws + WS_ATT); \
    sb.KWT = (bf16*)(ws + WS_KWT); sb.VT = (bf16*)(ws + WS_VT); sb.PT = (bf16*)(ws + WS_PT); sb.DEN = (float*)(ws + WS_DEN)
#pragma unroll 1
    for (int L = 0; L < DEPTH; ++L) {
        const int pb = 1 + L * PH_PER_LAYER; const bool even = (L & 1) == 0; const int e = L >> 1;
        if (L == 0 && IN(pb + 0)) REP(0) { ENV; const float* hin = a->x;
            norm_phase(lds, hin, a->gains + (size_t)L * 4 * DM, RA, even, (const float*)(ws + WS_WGATES) + (size_t)e * 16 * 1024, Gt, gw, NGW, tid, lane); }
        if (L == 0) SEAM(pb + 0);
        if (IN(pb + 1)) REP(1) { ENV;
            const int N = even ? 4096 : 1536;
            pg8::Gemm g{RA, even ? (const bf16*)(ws + WS_WIN) + (size_t)e * 4096 * 1024 : (const bf16*)(ws + WS_WQKV) + (size_t)e * 1536 * 1024, M, N, DM};
            pg8::StaticOrder S; S.init(M, N, G, bid);
            pg8::EpiBf16<0> E{RC, 1536, even ? nullptr : a->b_qkv + (size_t)e * 1536, (bf16*)(ws + WS_X2), 1536, 2560};
            pg8::gemm_phase<pg8::EpiBf16<0>, pg8::StaticOrder, true, true>(lds, g, S, E);
        }
        SEAM(pb + 1);
        if (IN(pb + 2)) REP(2) { ENV; if (even) conv_phase((const bf16*)(ws + WS_X1), a->conv + (size_t)e * 4 * 1536, (bf16*)(ws + WS_QKVA), gw, NGW, lane);
            else {
#if defined(PROBE_DUP_MASK)
                if (dupm & (1 << 21)) { const u32x4* s4 = (const u32x4*)RC; u32x4* d4 = (u32x4*)(ws + WS_RA); for (size_t i = gtid; i < (size_t)M * 1536 / 8; i += NGT) d4[i] = s4[i]; __syncthreads(); rope_phase((bf16*)(ws + WS_RA), (const f32x2*)(ws + WS_ROPE), gw, NGW, lane); }
#endif
                rope_phase(RC, (const f32x2*)(ws + WS_ROPE), gw, NGW, lane); } }
        SEAM(pb + 2);
        if (even) {
            if (IN(pb + 3)) REP(3) { ENV; SCANBUFS; local_phase(lds, sb, a->a_log + e * 4, a->dt_bias + e * 4, a->i_bias + e * 4, a->f_bias + e * 4, gw, NGW, wave, lane); }
            SEAM(pb + 3);
        }
        if (IN(pb + 4)) REP(4) { ENV;
            if (even) { SCANBUFS; recur_phase(lds, sb, G, bid, wave, lane); }
            else attn_phase(lds, tid, wave, RC, a->sinks + e * 16, RD, G, bid);
        }
        SEAM(pb + 4);
        if (even) {
            if (IN(pb + 5)) REP(5) { ENV; SCANBUFS; post_phase(sb, a->norm_a + e * 128, a->norm_b + e * 512, (bf16*)(ws + WS_MIXED), gw, NGW, lane); }
            SEAM(pb + 5);
        }
        if (IN(pb + 6)) REP(6) { ENV;
            pg8::Gemm g{even ? (const bf16*)(ws + WS_MIXED) : (const bf16*)RD, even ? (const bf16*)(ws + WS_WOUT) + (size_t)e * DM * DM : (const bf16*)(ws + WS_WO) + (size_t)e * DM * DM, M, DM, DM};
            pg8::StaticOrder S; S.init(M, DM, G, bid);
            pg8::EpiBf16<0> E{RA, DM, even ? nullptr : a->b_o + (size_t)e * DM, RA, 1 << 30, DM};
            pg8::gemm_phase<pg8::EpiBf16<0>, pg8::StaticOrder, true, true>(lds, g, S, E);
        }
        SEAM(pb + 6);
        if (IN(pb + 7)) { ENV; const float* gains = a->gains + (size_t)L * 4 * DM;
            resid_a_phase(RA, (L == 0) ? a->x : nullptr, (bf16*)a->out, gains + DM, gains + 2 * DM, RD, gw, NGW, lane); }
        SEAM(pb + 7);
        if (IN(pb + 8)) REP(8) { ENV;
            pg8::Gemm g{RD, (const bf16*)(ws + WS_WUP) + (size_t)L * FF * DM, M, FF, DM};
            pg8::StaticOrder S; S.init(M, FF, G, bid);
            pg8::EpiBf16<1> E{RC, FF, nullptr, RC, 1 << 30, FF};
            pg8::gemm_phase<pg8::EpiBf16<1>, pg8::StaticOrder, true, true>(lds, g, S, E);
        }
        SEAM(pb + 8);
        if (IN(pb + 9)) REP(9) { ENV;
            pg8::Gemm g{RC, (const bf16*)(ws + WS_WDN) + (size_t)L * DM * FF, M, DM, FF};
            pg8::StaticOrder S; S.init(M, DM, G, bid);
            pg8::EpiBf16<0> E{RA, DM, nullptr, RA, 1 << 30, DM};
            pg8::gemm_phase<pg8::EpiBf16<0>, pg8::StaticOrder, true, true>(lds, g, S, E);
        }
        SEAM(pb + 9);
        if (IN(pb + 10)) { ENV; resid_b_phase(RA, (const bf16*)a->out, a->gains + (size_t)L * 4 * DM + 3 * DM, RD, a->p + (size_t)L * M * PLE, RC, gw, NGW, lane, gtid, NGT); }
        SEAM(pb + 10);
        if (IN(pb + 11)) REP(11) { ENV;
            pg8::Gemm g{RC, (const bf16*)(ws + WS_WPLE) + (size_t)L * DM * PLE, M, DM, PLE};
            pg8::StaticOrder S; S.init(M, DM, G, bid);
            pg8::EpiBf16<0> E{RB, DM, nullptr, RB, 1 << 30, DM};
            pg8::gemm_phase<pg8::EpiBf16<0>, pg8::StaticOrder, true, true>(lds, g, S, E);
        }
        SEAM(pb + 11);
        if (IN(pb + 12)) { ENV;
            pg8::Gemm g{RD, (const bf16*)(ws + WS_WG) + (size_t)L * DM * DM, M, DM, DM};
            pg8::StaticOrder S; S.init(M, DM, G, bid);
            pg8::EpiBf16<0> E{(bf16*)(ws + WS_RC + 64 * MiB), DM, nullptr, RB, 1 << 30, DM};
            pg8::gemm_phase<pg8::EpiBf16<0>, pg8::StaticOrder, true, true>(lds, g, S, E);
        }
        SEAM(pb + 12);
        if (IN(pb + 13)) { ENV; const bool has_next = L + 1 < DEPTH, even_next = ((L + 1) & 1) == 0; const int en = (L + 1) >> 1;
            resid_c_phase(lds, (const bf16*)(ws + WS_RC + 64 * MiB), RB, RD, (bf16*)a->out, a->out, has_next, a->gains + (size_t)(L + 1 < DEPTH ? L + 1 : L) * 4 * DM, RA, even_next, (const float*)(ws + WS_WGATES) + (size_t)(en & 1) * 16 * 1024, Gt, gw, NGW, tid, lane); }
        SEAM(pb + 13);
    }
#undef SCANBUFS
#undef IN
#undef SEAM
#undef ENV
}

extern "C" void kernel_launch(void* const* d_in, const int* in_sizes, int n_in, void* d_out, int out_size, void* d_ws, size_t ws_size, hipStream_t stream) {
    static int grid = 0;
    if (grid == 0) {
        if (n_in != 22 || in_sizes[0] != M * DM || out_size != M * DM || ws_size < WS_END) {
            fprintf(stderr, "kernel_launch: unexpected shapes (n_in %d, in0 %d, out %d, ws %zu; need ws >= %zu); nothing launched\n", n_in, n_in > 0 ? in_sizes[0] : -1, out_size, ws_size, (size_t)WS_END); grid = -1; return; }
        int dev = 0, cus = 0, per_cu = 0;
        if (hipGetDevice(&dev) != hipSuccess || hipDeviceGetAttribute(&cus, hipDeviceAttributeMultiprocessorCount, dev) != hipSuccess) { fprintf(stderr, "kernel_launch: device query failed\n"); grid = -1; return; }
        if (hipFuncSetAttribute((const void*)trunk_fwd, hipFuncAttributeMaxDynamicSharedMemorySize, LDS_BYTES) != hipSuccess) { fprintf(stderr, "kernel_launch: hipFuncSetAttribute failed\n"); grid = -1; return; }
        if (hipOccupancyMaxActiveBlocksPerMultiprocessor(&per_cu, (const void*)trunk_fwd, NTHR, LDS_BYTES) != hipSuccess || per_cu < 1) fprintf(stderr, "kernel_launch: note: occupancy query reports %d\n", per_cu);
        (void)hipGetLastError();
        grid = cus;
    }
    if (grid < 0) return;
    Args a{};
    a.x = (const float*)d_in[0]; a.p = (const float*)d_in[1]; a.pos = (const int*)d_in[2]; a.gains = (const float*)d_in[3]; a.w_in = (const float*)d_in[4]; a.conv = (const float*)d_in[5];
    a.a_log = (const float*)d_in[6]; a.dt_bias = (const float*)d_in[7]; a.norm_a = (const float*)d_in[8]; a.i_bias = (const float*)d_in[9]; a.f_bias = (const float*)d_in[10]; a.norm_b = (const float*)d_in[11];
    a.b_qkv = (const float*)d_in[14]; a.sinks = (const float*)d_in[15]; a.b_o = (const float*)d_in[17];
    a.out = (float*)d_out; a.ws = (unsigned char*)d_ws;
#if defined(PROBE_DUP_MASK)
    a.dup_mask = PROBE_DUP_MASK; a.dup_par = PROBE_DUP_PAR;
#endif
    a.w_out = (const float*)d_in[12]; a.w_qkv = (const float*)d_in[13]; a.w_o = (const float*)d_in[16]; a.w_up = (const float*)d_in[18]; a.w_down = (const float*)d_in[19]; a.w_ple = (const float*)d_in[20]; a.w_gate = (const float*)d_in[21];
#if N_LAUNCH_MODE == 0
    if (hipMemsetAsync((char*)d_ws + WS_CTL, 0, CTL_ZERO_BYTES, stream) != hipSuccess) { fprintf(stderr, "kernel_launch: memset failed\n"); return; }
    a.ph_lo = 0; a.ph_hi = NPHASE;
    hipLaunchKernelGGL(trunk_fwd, dim3(grid), dim3(NTHR), LDS_BYTES, stream, a);
#else
    for (int ph = 0; ph < NPHASE; ++ph) { a.ph_lo = ph; a.ph_hi = ph + 1; hipLaunchKernelGGL(trunk_fwd, dim3(grid), dim3(NTHR), LDS_BYTES, stream, a); }
#endif
    const hipError_t le = hipPeekAtLastError();
    if (le != hipSuccess) fprintf(stderr, "kernel_launch: launch failed: %s\n", hipGetErrorName(le));
}
```

```cpp
#include <hip/hip_runtime.h>
#include <cstdio>
#include <cstdint>
#define N_LAUNCH_MODE 0
namespace pg8 {
#define PG8_LAS __attribute__((address_space(3)))
typedef unsigned short bf16_t;
typedef short bf16x8 __attribute__((ext_vector_type(8)));
typedef float f32x4 __attribute__((ext_vector_type(4)));
typedef unsigned u32x4 __attribute__((ext_vector_type(4)));
constexpr int BM = 256, BK = 64, HALF = 128, HTB = HALF * BK * 2  , STAGE_BYTES = 8 * HTB, NXCD = 8, WGM = 8;

__host__ __device__ __forceinline__ int lds_byte(int r, int c) { const int st = (r >> 4) * 2 + (c >> 5), rr = r & 15, cc = c & 31, ob = rr * 64 + cc * 2; return st * 1024 + (ob ^ (((ob >> 9) & 1) << 5)); }
__host__ __device__ __forceinline__ void stage_rc(int b, int& R, int& C) { const int st = b / 1024, sb = b % 1024, swz = sb ^ (((sb >> 9) & 1) << 5); R = (st >> 1) * 16 + swz / 64; C = (st & 1) * 32 + (swz % 64) / 2; }
__host__ __device__ __forceinline__ int perm32(int rho) { const int n = rho >> 4, i = rho & 15; return 8 * (i >> 2) + 4 * n + (i & 3); }

struct Unit { int pm, pn; };
struct Gemm { const bf16_t* A; const bf16_t* Bt; int M, N, K; };

struct StaticOrder {
    int nM, nN, nwg, G, c;
    __host__ __device__ void init(int M, int N, int G_, int c_) { nM = M / BM; nN = N / BM; nwg = nM * nN; G = G_; c = c_; }
    __host__ __device__ bool next(int i, Unit& u) const {
        const long L = (long)i * G + c; if (L >= nwg) return false;
        int wgid = (int)L; { const int q = nwg / NXCD, r = nwg % NXCD, xcd = wgid % NXCD, off = wgid / NXCD; wgid = (xcd < r ? xcd * (q + 1) : r * (q + 1) + (xcd - r) * q) + off; }
        const int nig = WGM * nN, gid = wgid / nig, fm = gid * WGM, gsz = (nM - fm) < WGM ? (nM - fm) : WGM;
        u.pm = fm + ((wgid % nig) % gsz); u.pn = (wgid % nig) / gsz; return true;
    }
    __device__ __forceinline__ void a_ready(const Unit&) const {}
    __device__ __forceinline__ void done(const Unit&) const {}
};

__device__ __forceinline__ unsigned cvt_pk_bf16(float lo, float hi) { unsigned r; asm volatile("v_cvt_pk_bf16_f32 %0, %1, %2" : "=v"(r) : "v"(lo), "v"(hi)); return r; }
typedef float f32x2 __attribute__((ext_vector_type(2)));
typedef unsigned u32x2 __attribute__((ext_vector_type(2)));

template <int ACT  > struct EpiBf16 {
    static constexpr bool PERM = true, AFTER_DRAIN = false;
    bf16_t* O; int ldc; const float* bias; bf16_t* O2; int split_col, ldc2;
    __device__ __forceinline__ void operator()(const f32x4 (&acc)[2][2][4][2], const Unit& u, int wr, int wc, int fr, int fq) const {
        const int row0 = u.pm * BM + wr * 64 + fr; const int col0 = u.pn * BM + wc * 32 + 8 * fq;
        const bool second = u.pn * BM >= split_col; bf16_t* const ob = second ? O2 : O; const int ld = second ? ldc2 : ldc, oc0 = second ? col0 - split_col : col0;
        f32x4 bv[2][2];
#pragma unroll
        for (int bj = 0; bj < 2; ++bj)
#pragma unroll
            for (int n = 0; n < 2; ++n) bv[bj][n] = bias ? *(const f32x4*)(bias + col0 + bj * HALF + 4 * n) : (f32x4){0.f, 0.f, 0.f, 0.f};
#pragma unroll
        for (int ai = 0; ai < 2; ++ai)
#pragma unroll
            for (int m = 0; m < 4; ++m) { bf16_t* rowp = ob + (size_t)(row0 + ai * HALF + m * 16) * ld + oc0;
#pragma unroll
                for (int bj = 0; bj < 2; ++bj) { f32x4 v0 = acc[ai][bj][m][0] + bv[bj][0], v1 = acc[ai][bj][m][1] + bv[bj][1];
                    if (ACT == 1) {
#pragma unroll
                        for (int i = 0; i < 4; ++i) { const float a = fmaxf(v0[i], 0.f), b = fmaxf(v1[i], 0.f); v0[i] = a * a; v1[i] = b * b; } }
                    u32x4 w; w.x = cvt_pk_bf16(v0[0], v0[1]); w.y = cvt_pk_bf16(v0[2], v0[3]); w.z = cvt_pk_bf16(v1[0], v1[1]); w.w = cvt_pk_bf16(v1[2], v1[3]);
                    *(u32x4*)(rowp + bj * HALF) = w; } }
    }
};
struct EpiIn {
    static constexpr bool PERM = true, AFTER_DRAIN = false;
    bf16_t* O; bf16_t* O2; const float* bias; const float* rope;
    __device__ __forceinline__ void operator()(const f32x4 (&acc)[2][2][4][2], const Unit& u, int wr, int wc, int fr, int fq) const {
        const int row0 = u.pm * BM + wr * 64 + fr, colt = u.pn * BM + wc * 32 + 8 * fq, g = (colt & 63) >> 3;
        const bool rot = rope != nullptr && u.pn < 5, second = rope == nullptr && u.pn >= 6;
        bf16_t* const ob = second ? O2 : O; const int ld = second ? 2560 : 1536, oc0 = second ? colt - 1536 : colt;
#pragma unroll
        for (int ai = 0; ai < 2; ++ai)
#pragma unroll
            for (int m = 0; m < 4; ++m) { const int row = row0 + ai * HALF + m * 16; bf16_t* rowp = ob + (size_t)row * ld;
                f32x4 t0 = {1.f, 0.f, 1.f, 0.f}, t1 = t0;
                if (rot) { t0 = *(const f32x4*)(rope + (size_t)row * 64 + 8 * g); t1 = *(const f32x4*)(rope + (size_t)row * 64 + 8 * g + 4); }
#pragma unroll
                for (int bj = 0; bj < 2; ++bj) { const int c = colt + bj * HALF, hd = c >> 6; f32x4 v0 = acc[ai][bj][m][0], v1 = acc[ai][bj][m][1];
                    if (rope) { v0 = v0 + (rot ? *(const f32x4*)(bias + hd * 64 + 4 * g) : *(const f32x4*)(bias + c)); v1 = v1 + (rot ? *(const f32x4*)(bias + hd * 64 + 32 + 4 * g) : *(const f32x4*)(bias + c + 4)); }
                    if (rot) { const float sc = c < 1024 ? 0.125f : 1.f; const f32x4 cs = {t0.x, t0.z, t1.x, t1.z}, sn = {t0.y, t0.w, t1.y, t1.w};
                        const f32x4 o1 = (v0 * cs - v1 * sn) * sc, o2 = (v1 * cs + v0 * sn) * sc;
                        u32x2 w1, w2; w1.x = cvt_pk_bf16(o1[0], o1[1]); w1.y = cvt_pk_bf16(o1[2], o1[3]); w2.x = cvt_pk_bf16(o2[0], o2[1]); w2.y = cvt_pk_bf16(o2[2], o2[3]);
                        *(u32x2*)(rowp + hd * 64 + 4 * g) = w1; *(u32x2*)(rowp + hd * 64 + 32 + 4 * g) = w2; }
                    else { v0 = v0 * 1.f; v1 = v1 * 1.f;
                        u32x4 w; w.x = cvt_pk_bf16(v0[0], v0[1]); w.y = cvt_pk_bf16(v0[2], v0[3]); w.z = cvt_pk_bf16(v1[0], v1[1]); w.w = cvt_pk_bf16(v1[2], v1[3]); *(u32x4*)(rowp + oc0 + bj * HALF) = w; } } }
    }
};
struct EpiF32 {
    static constexpr bool PERM = false, AFTER_DRAIN = false;
    float* C; int ldc; const float* bias;
    __device__ __forceinline__ void operator()(const f32x4 (&acc)[2][2][4][2], const Unit& u, int wr, int wc, int fr, int fq) const {
        const int row0 = u.pm * BM + wr * 64 + fr, col0 = u.pn * BM + wc * 32 + 4 * fq;
        f32x4 bv[2][2];
#pragma unroll
        for (int bj = 0; bj < 2; ++bj)
#pragma unroll
            for (int n = 0; n < 2; ++n) bv[bj][n] = bias ? *(const f32x4*)(bias + col0 + bj * HALF + n * 16) : (f32x4){0.f, 0.f, 0.f, 0.f};
#pragma unroll
        for (int ai = 0; ai < 2; ++ai)
#pragma unroll
            for (int m = 0; m < 4; ++m) { float* rowp = C + (size_t)(row0 + ai * HALF + m * 16) * ldc + col0;
#pragma unroll
                for (int bj = 0; bj < 2; ++bj)
#pragma unroll
                    for (int n = 0; n < 2; ++n) *(f32x4*)(rowp + bj * HALF + n * 16) = acc[ai][bj][m][n] + bv[bj][n]; }
    }
};
__device__ __forceinline__ float bf_lo(unsigned w) { return __builtin_bit_cast(float, w << 16); }
__device__ __forceinline__ float bf_hi(unsigned w) { return __builtin_bit_cast(float, w & 0xffff0000u); }
struct EpiGate {
    static constexpr bool PERM = false, AFTER_DRAIN = false;
    float* H; const bf16_t* PP; int ldc;
    __device__ __forceinline__ void operator()(const f32x4 (&acc)[2][2][4][2], const Unit& u, int wr, int wc, int fr, int fq) const {
        const int row0 = u.pm * BM + wr * 64 + fr, col0 = u.pn * BM + wc * 32 + 4 * fq;
#pragma unroll
        for (int ai = 0; ai < 2; ++ai)
#pragma unroll
            for (int m = 0; m < 4; ++m) { const size_t ro = (size_t)(row0 + ai * HALF + m * 16) * ldc + col0;
#pragma unroll
                for (int bj = 0; bj < 2; ++bj)
#pragma unroll
                    for (int n = 0; n < 2; ++n) { const size_t off = ro + bj * HALF + n * 16;
                        f32x4 hv = *(const f32x4*)(H + off); const u32x2 pv = *(const u32x2*)(PP + off); const f32x4 a = acc[ai][bj][m][n];
                        const float p0 = bf_lo(pv.x), p1 = bf_hi(pv.x), p2 = bf_lo(pv.y), p3 = bf_hi(pv.y);
                        hv[0] += p0 / (1.f + __expf(-a[0])); hv[1] += p1 / (1.f + __expf(-a[1])); hv[2] += p2 / (1.f + __expf(-a[2])); hv[3] += p3 / (1.f + __expf(-a[3]));
                        *(f32x4*)(H + off) = hv; } }
    }
};

template <class Epi, class Sched, bool ALIGN_EPI = false, bool SP2 = false>
__device__ __forceinline__ void gemm_phase(PG8_LAS unsigned char* lds, const Gemm g, const Sched& S, const Epi& E) {
    int tid_l = threadIdx.x; asm volatile("" : "+v"(tid_l));
    const int tid = tid_l, wid = __builtin_amdgcn_readfirstlane(tid >> 6), lane = tid & 63, wr = wid >> 2, wc = wid & 3, fr = lane & 15, fq = lane >> 4;
    const int K = g.K, nt = K / BK;
    unsigned voffA[2], voffB[2];
#pragma unroll
    for (int i = 0; i < 2; ++i) { int R, C; stage_rc(tid * 16 + i * 8192, R, C); const int Rb = Epi::PERM ? ((R & ~31) + perm32(R & 31)) : R;
        voffA[i] = (unsigned)(R * K + C) * 2u; voffB[i] = (unsigned)(Rb * K + C) * 2u; }
    const size_t kstep = (size_t)(BK * 2);
    const size_t hstep = (size_t)HALF * K * 2;
    const size_t tstep = 2 * hstep;
    const unsigned ldsw = (unsigned)wid * 1024u;
    const int aoff = lds_byte(wr * 64 + fr, fq * 8), boff = lds_byte(wc * 32 + fr, fq * 8);
#define PG8_SA(b, h) (((b) * 2 + (h)) * HTB)
#define PG8_SB(b, h) ((4 + (b) * 2 + (h)) * HTB)
#define PG8_STAGE(bufoff, gbase, voff) do { _Pragma("unroll") for (int _i = 0; _i < 2; ++_i) \
        __builtin_amdgcn_global_load_lds((const unsigned*)((const char*)(gbase) + (voff)[_i]), (PG8_LAS unsigned*)(lds + (bufoff) + ldsw + _i * 8192), 16, 0, 0); } while (0)
#define PG8_LDA(dst, b, h) do { _Pragma("unroll") for (int m = 0; m < 4; ++m) _Pragma("unroll") for (int k = 0; k < 2; ++k) dst[m][k] = *(const PG8_LAS bf16x8*)(lds + PG8_SA(b, h) + aoff + m * 2048 + k * 1024); } while (0)
#define PG8_LDB(dst, b, h) do { _Pragma("unroll") for (int n = 0; n < 2; ++n) _Pragma("unroll") for (int k = 0; k < 2; ++k) dst[n][k] = *(const PG8_LAS bf16x8*)(lds + PG8_SB(b, h) + boff + n * 2048 + k * 1024); } while (0)
#define PG8_MMA(ai, bj, At, Bt) do { __builtin_amdgcn_s_setprio(1); _Pragma("unroll") for (int m = 0; m < 4; ++m) _Pragma("unroll") for (int n = 0; n < 2; ++n) _Pragma("unroll") for (int k = 0; k < 2; ++k) \
        acc[ai][bj][m][n] = __builtin_amdgcn_mfma_f32_16x16x32_bf16(Bt[n][k], At[m][k], acc[ai][bj][m][n], 0, 0, 0); __builtin_amdgcn_s_setprio(0); } while (0)
#define PG8_WAIT_V(n) asm volatile("s_waitcnt vmcnt(" #n ")" ::: "memory")
#define PG8_WAIT_L(n) asm volatile("s_waitcnt lgkmcnt(" #n ")" ::: "memory")
#define PG8_BAR __builtin_amdgcn_s_barrier()
#define PG8_SCHED __builtin_amdgcn_sched_barrier(0)
    Unit cur, nxt; int ui = 0;
    if (!S.next(0, cur)) return;
    f32x4 acc[2][2][4][2];
#pragma unroll
    for (int a = 0; a < 2; ++a)
#pragma unroll
        for (int b = 0; b < 2; ++b)
#pragma unroll
            for (int m = 0; m < 4; ++m)
#pragma unroll
                for (int n = 0; n < 2; ++n) acc[a][b][m][n] = (f32x4){0.f, 0.f, 0.f, 0.f};
    bf16x8 At[4][2], B0[2][2], B1[2][2];
    const char* cA = (const char*)g.A + (size_t)cur.pm * tstep; const char* cB = (const char*)g.Bt + (size_t)cur.pn * tstep;
    S.a_ready(cur);
    if constexpr (SP2) {
        PG8_STAGE(PG8_SB(0, 0), cB, voffB); PG8_STAGE(PG8_SB(0, 1), cB + hstep, voffB); PG8_STAGE(PG8_SA(0, 0), cA, voffA); PG8_STAGE(PG8_SA(0, 1), cA + hstep, voffA);
        if (wr == 1) PG8_BAR;
        PG8_WAIT_V(2); PG8_BAR;
        PG8_STAGE(PG8_SB(1, 0), cB + kstep, voffB); PG8_STAGE(PG8_SA(1, 0), cA + kstep, voffA); PG8_STAGE(PG8_SB(1, 1), cB + hstep + kstep, voffB);
        PG8_WAIT_V(6); PG8_BAR;
    } else {
        PG8_STAGE(PG8_SB(0, 0), cB, voffB); PG8_STAGE(PG8_SA(0, 0), cA, voffA); PG8_STAGE(PG8_SB(0, 1), cB + hstep, voffB); PG8_STAGE(PG8_SA(0, 1), cA + hstep, voffA);
        if (wr == 1) PG8_BAR;
        PG8_WAIT_V(4); PG8_BAR;
        PG8_STAGE(PG8_SB(1, 0), cB + kstep, voffB); PG8_STAGE(PG8_SA(1, 0), cA + kstep, voffA); PG8_STAGE(PG8_SB(1, 1), cB + hstep + kstep, voffB);
        PG8_WAIT_V(6); PG8_BAR;
    }
    for (;;) {
        const bool has_next = S.next(ui + 1, nxt);
        const char* nA = has_next ? (const char*)g.A + (size_t)nxt.pm * tstep : cA; const char* nB = has_next ? (const char*)g.Bt + (size_t)nxt.pn * tstep : cB;
        for (int t = 0; t < nt; t += 2) {
            const bool last = (t == nt - 2);
            const char* a1 = cA + (size_t)(t + 1) * kstep;
            const char* a2 = last ? nA : cA + (size_t)(t + 2) * kstep; const char* b2 = last ? nB : cB + (size_t)(t + 2) * kstep;
            const char* a3 = a2 + kstep; const char* b3 = b2 + kstep;
            if (last && has_next) S.a_ready(nxt);
            if constexpr (SP2) {
            PG8_LDB(B0, 0, 0); PG8_LDB(B1, 0, 1); PG8_SCHED; PG8_LDA(At, 0, 0); PG8_STAGE(PG8_SA(1, 1), a1 + hstep, voffA);
            PG8_WAIT_V(8); PG8_WAIT_L(0); PG8_BAR; PG8_MMA(0, 0, At, B0); PG8_MMA(0, 1, At, B1); PG8_BAR; PG8_SCHED;
            PG8_LDA(At, 0, 1); PG8_STAGE(PG8_SB(0, 0), b2, voffB); PG8_STAGE(PG8_SB(0, 1), b2 + hstep, voffB); PG8_STAGE(PG8_SA(0, 0), a2, voffA);
            PG8_WAIT_V(8); PG8_WAIT_L(0); PG8_BAR; PG8_MMA(1, 0, At, B0); PG8_MMA(1, 1, At, B1); PG8_BAR; PG8_SCHED;
            PG8_LDB(B0, 1, 0); PG8_LDB(B1, 1, 1); PG8_SCHED; PG8_LDA(At, 1, 0); PG8_STAGE(PG8_SA(0, 1), a2 + hstep, voffA);
            PG8_WAIT_V(8); PG8_WAIT_L(0); PG8_BAR; PG8_MMA(0, 0, At, B0); PG8_MMA(0, 1, At, B1); PG8_BAR; PG8_SCHED;
            PG8_LDA(At, 1, 1); PG8_STAGE(PG8_SB(1, 0), b3, voffB); PG8_STAGE(PG8_SB(1, 1), b3 + hstep, voffB); PG8_STAGE(PG8_SA(1, 0), a3, voffA);
            PG8_WAIT_V(8); PG8_WAIT_L(0); PG8_BAR; PG8_MMA(1, 0, At, B0); PG8_MMA(1, 1, At, B1); PG8_BAR; PG8_SCHED;
            } else {
            PG8_LDB(B0, 0, 0); PG8_SCHED; PG8_LDA(At, 0, 0); PG8_STAGE(PG8_SA(1, 1), a1 + hstep, voffA);
            PG8_WAIT_L(8); PG8_BAR; PG8_WAIT_L(0); PG8_MMA(0, 0, At, B0); PG8_BAR; PG8_SCHED;
            PG8_LDB(B1, 0, 1); PG8_STAGE(PG8_SB(0, 0), b2, voffB);
            PG8_BAR; PG8_WAIT_L(0); PG8_MMA(0, 1, At, B1); PG8_BAR;
            PG8_LDA(At, 0, 1); PG8_STAGE(PG8_SA(0, 0), a2, voffA);
            PG8_BAR; PG8_WAIT_L(0); PG8_MMA(1, 0, At, B0); PG8_BAR; PG8_SCHED;
            PG8_STAGE(PG8_SB(0, 1), b2 + hstep, voffB);
            PG8_WAIT_V(6); PG8_BAR; PG8_MMA(1, 1, At, B1); PG8_BAR;
            PG8_LDB(B0, 1, 0); PG8_SCHED; PG8_LDA(At, 1, 0); PG8_STAGE(PG8_SA(0, 1), a2 + hstep, voffA);
            PG8_WAIT_L(8); PG8_BAR; PG8_WAIT_L(0); PG8_MMA(0, 0, At, B0); PG8_BAR; PG8_SCHED;
            PG8_LDB(B1, 1, 1); PG8_STAGE(PG8_SB(1, 0), b3, voffB);
            PG8_BAR; PG8_WAIT_L(0); PG8_MMA(0, 1, At, B1); PG8_BAR;
            PG8_LDA(At, 1, 1); PG8_STAGE(PG8_SA(1, 0), a3, voffA);
            PG8_BAR; PG8_WAIT_L(0); PG8_MMA(1, 0, At, B0); PG8_BAR; PG8_SCHED;
            PG8_STAGE(PG8_SB(1, 1), b3 + hstep, voffB);
            PG8_WAIT_V(6); PG8_BAR; PG8_MMA(1, 1, At, B1); PG8_BAR;
            }
        }
        if constexpr (ALIGN_EPI) { if (wr == 0) PG8_BAR; }
        if constexpr (!Epi::AFTER_DRAIN) { E(acc, cur, wr, wc, fr, fq); S.done(cur); }
        if (!has_next) break;
#pragma unroll
        for (int a = 0; a < 2; ++a)
#pragma unroll
            for (int b = 0; b < 2; ++b)
#pragma unroll
                for (int m = 0; m < 4; ++m)
#pragma unroll
                    for (int n = 0; n < 2; ++n) acc[a][b][m][n] = (f32x4){0.f, 0.f, 0.f, 0.f};
        cur = nxt; cA = nA; cB = nB; ++ui;
        if constexpr (ALIGN_EPI) { if (wr == 1) PG8_BAR; }
    }
    PG8_WAIT_V(0);
    if constexpr (!ALIGN_EPI) { if (wr == 0) PG8_BAR; }
    PG8_BAR;
    if constexpr (Epi::AFTER_DRAIN) { E.fused(acc, cur, wr, wc, fr, fq, lds, wid, lane); S.done(cur); }
#undef PG8_SA
#undef PG8_SB
#undef PG8_STAGE
#undef PG8_LDA
#undef PG8_LDB
#undef PG8_MMA
#undef PG8_WAIT_V
#undef PG8_WAIT_L
#undef PG8_BAR
#undef PG8_SCHED
}
}
constexpr int BATCH = 32, SEQ = 2048, DM = 1024, DEPTH = 4, M = BATCH * SEQ;
constexpr int FF = 4096, PLE = 256, NIN = 4112;
constexpr float EPS = 1e-6f;
constexpr int NWAVES = 8, NTHR = NWAVES * 64;
constexpr int PH_PER_LAYER = 14, NPHASE = 1 + DEPTH * PH_PER_LAYER;
constexpr size_t MiB = 1u << 20;
constexpr size_t WS_CTL = 0, CTL_ZERO_BYTES = 1 * MiB;
constexpr size_t WS_WIN = 1 * MiB, WS_WOUT = 17 * MiB, WS_WQKV = 21 * MiB, WS_WO = 27 * MiB, WS_WUP = 31 * MiB, WS_WDN = 63 * MiB, WS_WPLE = 95 * MiB, WS_WG = 97 * MiB;
constexpr size_t WS_WGATES = 105 * MiB, WS_GT = 106 * MiB, WS_ROPE = 110 * MiB;
constexpr size_t WS_DEN = 126 * MiB;
constexpr size_t WS_RA = 128 * MiB, WS_RB = 256 * MiB, WS_RC = 384 * MiB, WS_RD = 896 * MiB, WS_END = 1024 * MiB;
constexpr size_t WS_QKVA = 128 * MiB, WS_KWT = 320 * MiB, WS_X1 = 384 * MiB, WS_KT = 384 * MiB, WS_UT = 448 * MiB, WS_NW = 512 * MiB, WS_X2 = 576 * MiB, WS_VT = 896 * MiB, WS_ATT = 960 * MiB, WS_PT = 992 * MiB, WS_MIXED = 384 * MiB;
constexpr int CW_BAR = 4096;
constexpr int RING_BYTES = 131072, MISC_OFF = RING_BYTES, LDS_BYTES = RING_BYTES + 1024;

#define GAS __attribute__((address_space(1)))
#define LAS __attribute__((address_space(3)))
typedef unsigned short bf16;
typedef float f32x4 __attribute__((ext_vector_type(4)));
typedef float f32x2 __attribute__((ext_vector_type(2)));
typedef unsigned u32x4 __attribute__((ext_vector_type(4)));
typedef unsigned u32x2 __attribute__((ext_vector_type(2)));
#define LDS_WAIT() asm volatile("s_waitcnt lgkmcnt(0)" ::: "memory")
#define VM_WAIT() asm volatile("s_waitcnt vmcnt(0)" ::: "memory")
using pg8::bf_lo; using pg8::bf_hi;
typedef __bf16 bf16x2_t __attribute__((ext_vector_type(2)));
__device__ __forceinline__ unsigned pk2(float lo, float hi) { return pg8::cvt_pk_bf16(lo, hi); }
__device__ __forceinline__ unsigned pk2v(float lo, float hi) { const f32x2 v = {lo, hi}; const bf16x2_t b = __builtin_convertvector(v, bf16x2_t); return __builtin_bit_cast(unsigned, b); }
__device__ __forceinline__ float wave_sum(float v) {
#pragma unroll
    for (int o = 1; o < 64; o <<= 1) v += __shfl_xor(v, o);
    return v;
}
__device__ __forceinline__ float dot4(f32x4 a, f32x4 b) { return (a.x * b.x + a.y * b.y) + (a.z * b.z + a.w * b.w); }
__device__ __forceinline__ float sigmoid_f(float x) { return 1.f / (1.f + __expf(-x)); }
__device__ __forceinline__ float softplus_f(float x) { return x > 20.f ? x : log1pf(expf(x)); }

#define XB_TMO      128
#define XB_XCNT(j)  (256  + 64 * (j))
#define XB_XSUB(j)  (1280 + 64 * (j))
#define XB_XGEN(j)  (2304 + 64 * (j))
#define XB_TOP      3328
#define XB_TOPGEN   3392
#define XCD_BAR_WORDS 3456
#define XB_SPIN_CAP (1u << 18)

__device__ __forceinline__ unsigned xb_ld(unsigned* p)              { return __hip_atomic_load(p, __ATOMIC_RELAXED, __HIP_MEMORY_SCOPE_AGENT); }
__device__ __forceinline__ unsigned xb_add(unsigned* p, unsigned v) { return __hip_atomic_fetch_add(p, v, __ATOMIC_RELAXED, __HIP_MEMORY_SCOPE_AGENT); }
__device__ __forceinline__ unsigned xb_xcc_id() { return (unsigned)__builtin_amdgcn_s_getreg((3 << 11) | 20) & 0xFu; }
#define XB_SPIN(cond, bar) do { unsigned _sp = 0; while (cond) { __builtin_amdgcn_s_sleep(1); \
    if ((++_sp & 255u) == 0u) { if (xb_ld(&(bar)[XB_TMO])) break; if (_sp > XB_SPIN_CAP) { atomicAdd(&(bar)[XB_TMO], 1u); break; } } } } while (0)

struct XcdBarrier {
    unsigned* bar; unsigned x;
    volatile LAS unsigned* st;
};

__device__ __forceinline__ XcdBarrier xcd_barrier_post(unsigned* bar, volatile LAS unsigned* st) {
    XcdBarrier b; b.bar = bar; b.x = xb_xcc_id(); b.st = st;
    if (threadIdx.x == 0) (void)xb_add(&bar[XB_XCNT(b.x)], 1u);
    return b;
}
__device__ __forceinline__ void xcd_barrier_complete(unsigned* bar, unsigned x, unsigned& nloc, unsigned& nx) {
    const unsigned G = gridDim.x * gridDim.y * gridDim.z;
    unsigned sum, cnt, mine, sp = 0u;
    for (;;) {
        sum = 0u; cnt = 0u; mine = 0u;
#pragma unroll
        for (unsigned j = 0; j < 16; ++j) { const unsigned c = xb_ld(&bar[XB_XCNT(j)]); sum += c; cnt += (c > 0u) ? 1u : 0u; mine = (j == x) ? c : mine; }
        if (sum == G) break;
        __builtin_amdgcn_s_sleep(1);
        if ((++sp & 255u) == 0u) { if (xb_ld(&bar[XB_TMO])) break; if (sp > XB_SPIN_CAP) { atomicAdd(&bar[XB_TMO], 1u); break; } }
    }
    nloc = mine > 0u ? mine : 1u; nx = cnt > 0u ? cnt : 1u;
}

__device__ __forceinline__ void xcd_barrier(const XcdBarrier& b) {
    asm volatile("s_waitcnt vmcnt(0)" ::: "memory");
    __syncthreads();
    if (threadIdx.x == 0) {
        unsigned* bar = b.bar;
        __builtin_amdgcn_s_waitcnt(0);
        unsigned nloc = b.st[0], nx = b.st[1];
        if (nloc == 0u) { xcd_barrier_complete(bar, b.x, nloc, nx); b.st[0] = nloc; b.st[1] = nx; }
        const unsigned old = xb_add(&bar[XB_XSUB(b.x)], 1u);
        const unsigned gen = old / nloc;
        if (old + 1u == (gen + 1u) * nloc) {
            __builtin_amdgcn_fence(__ATOMIC_RELEASE, "agent");
            asm volatile("s_waitcnt vmcnt(0)" ::: "memory");
            const unsigned og = xb_add(&bar[XB_TOP], 1u);
            const unsigned tg = og / nx;
            if (og + 1u == (tg + 1u) * nx) xb_add(&bar[XB_TOPGEN], 1u);
            else XB_SPIN(xb_ld(&bar[XB_TOPGEN]) == tg, bar);
            __builtin_amdgcn_fence(__ATOMIC_ACQUIRE, "agent");
            xb_add(&bar[XB_XGEN(b.x)], 1u);
            asm volatile("s_waitcnt vmcnt(0)" ::: "memory");
        } else {
            XB_SPIN(xb_ld(&bar[XB_XGEN(b.x)]) == gen, bar);
            __builtin_amdgcn_fence(__ATOMIC_ACQUIRE, "agent");
            asm volatile("s_waitcnt vmcnt(0)" ::: "memory");
        }
    }
    __syncthreads();
}
struct Args {
    const float *x, *p; const int* pos; const float *gains, *w_in, *conv, *a_log, *dt_bias, *norm_a, *i_bias, *f_bias, *norm_b, *w_out, *w_qkv, *b_qkv, *sinks, *w_o, *b_o, *w_up, *w_down, *w_ple, *w_gate;
    float* out; unsigned char* ws;
    int ph_lo, ph_hi, dup_mask, dup_par;
};

template <bool ROPE_PERM = false> __device__ __forceinline__ void transpose_item(const float* src, int ld, int K, bf16* dst, LAS float* scr, int item, int nblk, int lane) {
    const int kb = item / nblk, nb = item % nblk, k0 = 64 * kb, n0 = 32 * nb;
#pragma unroll 8
    for (int i = 0; i < 32; ++i) { const int kk = 2 * i + (lane >> 5); scr[kk * 33 + (lane & 31)] = src[(size_t)(k0 + kk) * ld + n0 + (lane & 31)]; }
    LDS_WAIT(); asm volatile("" ::: "memory");
    const int c = lane & 7;
#pragma unroll
    for (int j = 0; j < 4; ++j) { const int n = (lane >> 3) + 8 * j; const LAS float* s = scr + (8 * c) * 33 + n;
        u32x4 o; o.x = pk2(s[0 * 33], s[1 * 33]); o.y = pk2(s[2 * 33], s[3 * 33]); o.z = pk2(s[4 * 33], s[5 * 33]); o.w = pk2(s[6 * 33], s[7 * 33]);
        int nd = n0 + n;
        if (ROPE_PERM && nd < 1280) { const int i = nd & 63; nd = (nd & ~63) + (i < 32 ? 8 * (i >> 2) + (i & 3) : 8 * ((i - 32) >> 2) + 4 + (i & 3)); }
        *(u32x4*)(dst + (size_t)nd * K + k0 + 8 * c) = o; }
    LDS_WAIT(); asm volatile("" ::: "memory");
}
__device__ __forceinline__ int gate_col(int c) { return c < 8 ? 1536 + c : 3592 + (c - 8); }

typedef const __attribute__((address_space(4))) Args* KArgs;
__device__ __forceinline__ KArgs kargs() { KArgs p = (KArgs)__builtin_amdgcn_kernarg_segment_ptr(); asm volatile("" : "+s"(p)); return p; }
__device__ __forceinline__ int fresh_tid() { int t = threadIdx.x; asm volatile("" : "+v"(t)); return t; }
__device__ __forceinline__ void prologue_phase(KArgs a, LAS unsigned char* lds, int gw, int NGW, int wave, int lane, int gtid, int NGT) {
    LAS float* scr = (LAS float*)(lds + wave * 16384);
    constexpr int I_IN = 16 * 16, I_SQ = 16 * 32, I_QKV = 16 * 48, I_UP = 16 * 128, I_DN = 64 * 32, I_PLE = 4 * 32;
    constexpr int NITEMS = 16 * I_IN + 2 * I_SQ + 2 * I_QKV + 2 * I_SQ + 4 * I_UP + 4 * I_DN + 4 * I_PLE + 4 * I_SQ;
    unsigned char* ws = a->ws;
    for (int it = gw; it < NITEMS; it += NGW) {
        int r = it;
        if (r < 16 * I_IN) { const int j = r / I_IN, e = j >> 3, s = j & 7, col0 = 512 * s + (s >= 3 ? 8 : 0) + (s >= 7 ? 8 : 0);
            transpose_item(a->w_in + (size_t)e * DM * NIN + col0, NIN, DM, (bf16*)(ws + WS_WIN) + ((size_t)e * 4096 + s * 512) * DM, scr, r % I_IN, 16, lane); continue; } r -= 16 * I_IN;
        if (r < 2 * I_SQ) { const int e = r / I_SQ; transpose_item(a->w_out + (size_t)e * DM * DM, DM, DM, (bf16*)(ws + WS_WOUT) + (size_t)e * DM * DM, scr, r % I_SQ, 32, lane); continue; } r -= 2 * I_SQ;
        if (r < 2 * I_QKV) { const int e = r / I_QKV; transpose_item<true>(a->w_qkv + (size_t)e * DM * 1536, 1536, DM, (bf16*)(ws + WS_WQKV) + (size_t)e * 1536 * DM, scr, r % I_QKV, 48, lane); continue; } r -= 2 * I_QKV;
        if (r < 2 * I_SQ) { const int e = r / I_SQ; transpose_item(a->w_o + (size_t)e * DM * DM, DM, DM, (bf16*)(ws + WS_WO) + (size_t)e * DM * DM, scr, r % I_SQ, 32, lane); continue; } r -= 2 * I_SQ;
        if (r < 4 * I_UP) { const int l = r / I_UP; transpose_item(a->w_up + (size_t)l * DM * FF, FF, DM, (bf16*)(ws + WS_WUP) + (size_t)l * FF * DM, scr, r % I_UP, 128, lane); continue; } r -= 4 * I_UP;
        if (r < 4 * I_DN) { const int l = r / I_DN; transpose_item(a->w_down + (size_t)l * FF * DM, DM, FF, (bf16*)(ws + WS_WDN) + (size_t)l * DM * FF, scr, r % I_DN, 32, lane); continue; } r -= 4 * I_DN;
        if (r < 4 * I_PLE) { const int l = r / I_PLE; transpose_item(a->w_ple + (size_t)l * PLE * DM, DM, PLE, (bf16*)(ws + WS_WPLE) + (size_t)l * DM * PLE, scr, r % I_PLE, 32, lane); continue; } r -= 4 * I_PLE;
        { const int l = r / I_SQ; transpose_item(a->w_gate + (size_t)l * DM * DM, DM, DM, (bf16*)(ws + WS_WG) + (size_t)l * DM * DM, scr, r % I_SQ, 32, lane); }
    }
    float* Wg = (float*)(a->ws + WS_WGATES);
    for (int i = gtid; i < 2 * 16 * 1024; i += NGT) { const int e = i >> 14, c = (i >> 10) & 15, k = i & 1023; Wg[i] = a->w_in[((size_t)e * 1024 + k) * NIN + gate_col(c)]; }
    f32x2* rope = (f32x2*)(a->ws + WS_ROPE);
    for (int i = gtid; i < M * 32; i += NGT) { const int m = i >> 5, d = i & 31;
        const float inv = (float)pow(10000.0, -(double)d / 32.0); const float ang = (float)a->pos[m] * inv; float sn, cs; sincosf(ang, &sn, &cs); rope[i] = (f32x2){cs, sn}; }
}

__device__ __forceinline__ void norm_phase(LAS unsigned char* lds, const float* hin, const float* g0, bf16* HN, bool even, const float* Wg, float* Gt, int gw, int NGW, int tid, int lane) {
    LAS f32x4* wl = (LAS f32x4*)lds;
    if (even) { for (int i = tid; i < 4096; i += NTHR) wl[i] = ((const f32x4*)Wg)[i]; __syncthreads(); }
    f32x4 gv[4];
#pragma unroll
    for (int j = 0; j < 4; ++j) gv[j] = ((const f32x4*)g0)[lane + 64 * j];
#pragma unroll 2
    for (int m = gw; m < M; m += NGW) {
        const f32x4* xr = (const f32x4*)(hin + (size_t)m * DM) + lane;
        f32x4 v[4]; float s = 0.f;
#pragma unroll
        for (int j = 0; j < 4; ++j) { v[j] = xr[64 * j]; s += dot4(v[j], v[j]); }
        const float rstd = rsqrtf(wave_sum(s) * (1.f / DM) + EPS);
        u32x2* o8 = (u32x2*)(HN + (size_t)m * DM) + lane;
#pragma unroll
        for (int j = 0; j < 4; ++j) { v[j] = v[j] * rstd * gv[j]; o8[64 * j] = (u32x2){pk2(v[j].x, v[j].y), pk2(v[j].z, v[j].w)}; }
        if (even) {
            float keep = 0.f;
#pragma unroll
            for (int c = 0; c < 16; ++c) { float d = 0.f;
#pragma unroll
                for (int j = 0; j < 4; ++j) d += dot4(v[j], wl[c * 256 + lane + 64 * j]);
                d = wave_sum(d); if (lane == c) keep = d; }
            if (lane < 16) Gt[(size_t)m * 16 + lane] = keep;
        }
    }
    if (even) __syncthreads();
}
struct Row16 { f32x4 v[4]; };
__device__ __forceinline__ Row16 ld_row_bf16(const bf16* row, int lane) { const u32x4 a = ((const u32x4*)row)[lane], b = ((const u32x4*)row)[lane + 64]; Row16 r;
    r.v[0] = (f32x4){bf_lo(a.x), bf_hi(a.x), bf_lo(a.y), bf_hi(a.y)}; r.v[1] = (f32x4){bf_lo(a.z), bf_hi(a.z), bf_lo(a.w), bf_hi(a.w)};
    r.v[2] = (f32x4){bf_lo(b.x), bf_hi(b.x), bf_lo(b.y), bf_hi(b.y)}; r.v[3] = (f32x4){bf_lo(b.z), bf_hi(b.z), bf_lo(b.w), bf_hi(b.w)}; return r; }
__device__ __forceinline__ Row16 ld_row_f32(const float* row, int lane) { const f32x4* p = (const f32x4*)row; Row16 r; r.v[0] = p[2 * lane]; r.v[1] = p[2 * lane + 1]; r.v[2] = p[128 + 2 * lane]; r.v[3] = p[128 + 2 * lane + 1]; return r; }
__device__ __forceinline__ void st_row_bf16(bf16* row, int lane, const Row16& r) {
    ((u32x4*)row)[lane] = (u32x4){pk2(r.v[0].x, r.v[0].y), pk2(r.v[0].z, r.v[0].w), pk2(r.v[1].x, r.v[1].y), pk2(r.v[1].z, r.v[1].w)};
    ((u32x4*)row)[lane + 64] = (u32x4){pk2(r.v[2].x, r.v[2].y), pk2(r.v[2].z, r.v[2].w), pk2(r.v[3].x, r.v[3].y), pk2(r.v[3].z, r.v[3].w)}; }
__device__ __forceinline__ void st_row_f32(float* row, int lane, const Row16& r) { f32x4* p = (f32x4*)row; p[2 * lane] = r.v[0]; p[2 * lane + 1] = r.v[1]; p[128 + 2 * lane] = r.v[2]; p[128 + 2 * lane + 1] = r.v[3]; }
__device__ __forceinline__ float row_sumsq(const Row16& r) { return (dot4(r.v[0], r.v[0]) + dot4(r.v[1], r.v[1])) + (dot4(r.v[2], r.v[2]) + dot4(r.v[3], r.v[3])); }
__device__ __forceinline__ void resid_a_phase(const bf16* mix, const float* hin32, bf16* hs, const float* g1, const float* g2, bf16* HN, int gw, int NGW, int lane) {
    const Row16 ga = ld_row_f32(g1, lane), gb = ld_row_f32(g2, lane);
    for (int m = gw; m < M; m += NGW) {
        const Row16 v = ld_row_bf16(mix + (size_t)m * DM, lane); Row16 h = hin32 ? ld_row_f32(hin32 + (size_t)m * DM, lane) : ld_row_bf16(hs + (size_t)m * DM, lane);
        const float r1 = rsqrtf(wave_sum(row_sumsq(v)) * (1.f / DM) + EPS);
#pragma unroll
        for (int j = 0; j < 4; ++j) h.v[j] = h.v[j] + v.v[j] * r1 * ga.v[j];
        st_row_bf16(hs + (size_t)m * DM, lane, h);
        const float r2 = rsqrtf(wave_sum(row_sumsq(h)) * (1.f / DM) + EPS);
#pragma unroll
        for (int j = 0; j < 4; ++j) h.v[j] = h.v[j] * r2 * gb.v[j];
        st_row_bf16(HN + (size_t)m * DM, lane, h);
    }
}
__device__ __forceinline__ void resid_b_phase(const bf16* ff, const bf16* hs, const float* g3, bf16* HB, const float* pl, bf16* PB, int gw, int NGW, int lane, int gtid, int NGT) {
    const Row16 ga = ld_row_f32(g3, lane);
    for (int m = gw; m < M; m += NGW) {
        const Row16 v = ld_row_bf16(ff + (size_t)m * DM, lane); Row16 h = ld_row_bf16(hs + (size_t)m * DM, lane);
        const float r1 = rsqrtf(wave_sum(row_sumsq(v)) * (1.f / DM) + EPS);
#pragma unroll
        for (int j = 0; j < 4; ++j) h.v[j] = h.v[j] + v.v[j] * r1 * ga.v[j];
        st_row_bf16(HB + (size_t)m * DM, lane, h);
    }
    for (int i = gtid; i < M * PLE / 8; i += NGT) { const f32x4 a = ((const f32x4*)pl)[2 * i], b = ((const f32x4*)pl)[2 * i + 1];
        ((u32x4*)PB)[i] = (u32x4){pk2(a.x, a.y), pk2(a.z, a.w), pk2(b.x, b.y), pk2(b.z, b.w)}; }
}
__device__ __forceinline__ void resid_c_phase(LAS unsigned char* lds, const bf16* gpre, const bf16* pp, const bf16* h2, bf16* hs, float* out32, bool has_next, const float* g0, bf16* HN, bool even_next, const float* Wg, float* Gt, int gw, int NGW, int tid, int lane) {
    LAS f32x4* wl = (LAS f32x4*)lds;
    if (has_next && even_next) { for (int i = tid; i < 4096; i += NTHR) wl[i] = ((const f32x4*)Wg)[i]; __syncthreads(); }
    const Row16 gv = ld_row_f32(g0, lane);
    for (int m = gw; m < M; m += NGW) {
        const Row16 g = ld_row_bf16(gpre + (size_t)m * DM, lane), p = ld_row_bf16(pp + (size_t)m * DM, lane); Row16 h = ld_row_bf16(h2 + (size_t)m * DM, lane);
#pragma unroll
        for (int j = 0; j < 4; ++j)
#pragma unroll
            for (int i = 0; i < 4; ++i) h.v[j][i] += p.v[j][i] * sigmoid_f(g.v[j][i]);
        if (has_next) {
            st_row_bf16(hs + (size_t)m * DM, lane, h);
            const float rstd = rsqrtf(wave_sum(row_sumsq(h)) * (1.f / DM) + EPS);
#pragma unroll
            for (int j = 0; j < 4; ++j) h.v[j] = h.v[j] * rstd * gv.v[j];
            st_row_bf16(HN + (size_t)m * DM, lane, h);
            if (even_next) {
                float keep = 0.f;
#pragma unroll
                for (int c = 0; c < 16; ++c) {
                    float d = (dot4(h.v[0], wl[c * 256 + 2 * lane]) + dot4(h.v[1], wl[c * 256 + 2 * lane + 1])) + (dot4(h.v[2], wl[c * 256 + 128 + 2 * lane]) + dot4(h.v[3], wl[c * 256 + 128 + 2 * lane + 1]));
                    d = wave_sum(d); if (lane == c) keep = d; }
                if (lane < 16) Gt[(size_t)m * 16 + lane] = keep;
            }
        } else st_row_f32(out32 + (size_t)m * DM, lane, h);
    }
    if (has_next && even_next) __syncthreads();
}
__device__ __forceinline__ void conv_phase(const bf16* X1, const float* convw  , bf16* QKVA, int gw, int NGW, int lane) {
    constexpr int RPW = 32;
    for (int blk = gw; blk < M / RPW; blk += NGW) {
        const int mb = blk * RPW;
#pragma unroll 1
        for (int j = 0; j < 3; ++j) {
            const int col = j * 512 + lane * 8;
            u32x4 h0, h1, h2;
            { const bool first = (mb & (SEQ - 1)) == 0; const u32x4 z = {0u, 0u, 0u, 0u};
              h0 = first ? z : *(const u32x4*)(X1 + (size_t)(mb - 3) * 1536 + col); h1 = first ? z : *(const u32x4*)(X1 + (size_t)(mb - 2) * 1536 + col); h2 = first ? z : *(const u32x4*)(X1 + (size_t)(mb - 1) * 1536 + col); }
            f32x4 w[4][2];
#pragma unroll
            for (int kk = 0; kk < 4; ++kk) { w[kk][0] = *(const f32x4*)(convw + kk * 1536 + col); w[kk][1] = *(const f32x4*)(convw + kk * 1536 + col + 4); }
#pragma unroll 2
            for (int r = 0; r < RPW; ++r) {
                const int m = mb + r;
                const u32x4 cur = *(const u32x4*)(X1 + (size_t)m * 1536 + col);
                const u32x4 xs[4] = {h0, h1, h2, cur};
                float acc[8];
#pragma unroll
                for (int i = 0; i < 8; ++i) acc[i] = 0.f;
#pragma unroll
                for (int kk = 0; kk < 4; ++kk) { const u32x4 xv = xs[kk]; const f32x4 w0 = w[kk][0], w1 = w[kk][1];
                    acc[0] += bf_lo(xv.x) * w0.x; acc[1] += bf_hi(xv.x) * w0.y; acc[2] += bf_lo(xv.y) * w0.z; acc[3] += bf_hi(xv.y) * w0.w;
                    acc[4] += bf_lo(xv.z) * w1.x; acc[5] += bf_hi(xv.z) * w1.y; acc[6] += bf_lo(xv.w) * w1.z; acc[7] += bf_hi(xv.w) * w1.w; }
                h0 = h1; h1 = h2; h2 = cur;
                float ss = 0.f;
#pragma unroll
                for (int i = 0; i < 8; ++i) { acc[i] = acc[i] / (1.f + __expf(-acc[i])); ss += acc[i] * acc[i]; }
                if (j < 2) { ss += __shfl_xor(ss, 1); ss += __shfl_xor(ss, 2); ss += __shfl_xor(ss, 4); ss += __shfl_xor(ss, 8);
                    const float sc = rsqrtf(ss + EPS) * (j == 0 ? 0.08838834764831845f : 1.f);
#pragma unroll
                    for (int i = 0; i < 8; ++i) acc[i] *= sc; }
                *(u32x4*)(QKVA + (size_t)m * 1536 + col) = (u32x4){pk2(acc[0], acc[1]), pk2(acc[2], acc[3]), pk2(acc[4], acc[5]), pk2(acc[6], acc[7])};
            }
        }
    }
}
__device__ __forceinline__ void rope_phase(bf16* QKV, const f32x2* rope, int gw, int NGW, int lane) {
#pragma unroll 2
    for (int m = gw; m < M; m += NGW) {
        const int grp = lane & 7; const f32x4* tb = (const f32x4*)(rope + (size_t)m * 32 + grp * 4); const f32x4 t0 = tb[0], t1 = tb[1];
        const float cs[4] = {t0.x, t0.z, t1.x, t1.z}, sn[4] = {t0.y, t0.w, t1.y, t1.w};
#pragma unroll
        for (int k = 0; k < 3; ++k) {
            if (k == 2 && lane >= 32) break;
            const int hh = (k < 2) ? ((lane + 64 * k) >> 3) : (lane >> 3); const float scale = (k < 2) ? 0.125f : 1.f;
            bf16* base = QKV + (size_t)m * 1536 + (k < 2 ? 0 : 1024) + hh * 64 + grp * 4;
            const u32x2 a = *(const u32x2*)base, b = *(const u32x2*)(base + 32);
            const float x1[4] = {bf_lo(a.x), bf_hi(a.x), bf_lo(a.y), bf_hi(a.y)}, x2[4] = {bf_lo(b.x), bf_hi(b.x), bf_lo(b.y), bf_hi(b.y)};
            float o1[4], o2[4];
#pragma unroll
            for (int i = 0; i < 4; ++i) { o1[i] = (x1[i] * cs[i] - x2[i] * sn[i]) * scale; o2[i] = (x2[i] * cs[i] + x1[i] * sn[i]) * scale; }
            *(u32x2*)base = (u32x2){pk2(o1[0], o1[1]), pk2(o1[2], o1[3])}; *(u32x2*)(base + 32) = (u32x2){pk2(o2[0], o2[1]), pk2(o2[2], o2[3])};
        }
    }
}
typedef short bf16x8 __attribute__((ext_vector_type(8)));
#define MFMA16(a, b, c) __builtin_amdgcn_mfma_f32_16x16x32_bf16(a, b, c, 0, 0, 0)
__device__ __forceinline__ bf16x8 pack8(f32x4 a, f32x4 b) { const u32x4 w = {pk2v(a.x, a.y), pk2v(a.z, a.w), pk2v(b.x, b.y), pk2v(b.z, b.w)}; return __builtin_bit_cast(bf16x8, w); }
__device__ __forceinline__ float bf2f(unsigned short v) { return __builtin_bit_cast(float, (unsigned)v << 16); }
__device__ __forceinline__ float rdlane(float v, int i) { return __builtin_bit_cast(float, __builtin_amdgcn_readlane(__builtin_bit_cast(int, v), i)); }
__device__ __forceinline__ float scan_add(float v, int lane) {
#pragma unroll
    for (int o = 1; o < 64; o <<= 1) { const float t = __shfl_up(v, o); if (lane >= o) v += t; }
    return v; }
__device__ __forceinline__ float scan_max(float v, int lane) {
#pragma unroll
    for (int o = 1; o < 64; o <<= 1) { const float t = __shfl_up(v, o); if (lane >= o) v = fmaxf(v, t); }
    return v; }
__device__ __forceinline__ int kperm(int ks, int q, int jj) { return 32 * ks + (jj < 4 ? 4 * q + jj : 16 + 4 * q + jj - 4); }
template <bool SCALE> __device__ __forceinline__ u32x4 tr_gather(const bf16* src  , int ld, int ks, int q, float esc_lane) {
    unsigned w[4];
#pragma unroll
    for (int j2 = 0; j2 < 4; ++j2) { const int r0 = kperm(ks, q, 2 * j2), r1 = r0 + 1; const unsigned short a = src[(size_t)r0 * ld], b = src[(size_t)r1 * ld];
        if (SCALE) { const float s0 = __shfl(esc_lane, r0), s1 = __shfl(esc_lane, r1); w[j2] = pk2(bf2f(a) * s0, bf2f(b) * s1); } else w[j2] = (unsigned)a | ((unsigned)b << 16); }
    return (u32x4){w[0], w[1], w[2], w[3]};
}
struct ScanBufs {
    bf16* QKVA;
    bf16* X2;
    float* Gt;
    bf16 *KT, *UT, *NW, *ATT;
    bf16 *KWT, *VT, *PT;
    float* DEN;
};
__device__ __forceinline__ void local_phase(LAS unsigned char* lds, const ScanBufs sb, const float* a_log, const float* dt_bias, const float* i_bias, const float* f_bias, int gw, int NGW, int wave, int lane) {
    LAS float* Lw = (LAS float*)(lds + wave * 16384);
    const int njobs = 2 * BATCH * 4 * (SEQ / 64), per = (njobs + NGW - 1) / NGW; const int lane_in = lane;
#pragma unroll 1
    for (int rj = 0; rj < per; ++rj) {
        const int job = gw * per + rj; if (job >= njobs) break;
        int lane = lane_in; asm volatile("" : "+v"(lane));
        const int x = lane & 15, q = lane >> 4;
        const int mixer = job & 1, cidx = job >> 1, c = cidx & 31, h = (cidx >> 5) & 3, b = cidx >> 7;
        const int m0 = b * SEQ + c * 64; const size_t cid = (size_t)cidx;
        float* gr = sb.Gt + (size_t)(m0 + lane) * 16;
        if (mixer == 0) {
            const float beta = 1.f / (1.f + expf(-gr[h])); const float g = -expf(a_log[h]) * softplus_f(gr[4 + h] + dt_bias[h]);
            const float gcum = scan_add(g, lane), eg = expf(gcum), glast = __shfl(gcum, 63);
            const bf16* kb = sb.QKVA + (size_t)m0 * 1536 + 512 + h * 128; const bf16* qb = sb.QKVA + (size_t)m0 * 1536 + h * 128; const bf16* vb = kb + 512;
            bf16x8 Kf[4][4], Qf[4][4];
#pragma unroll
            for (int t = 0; t < 4; ++t)
#pragma unroll
                for (int ks = 0; ks < 4; ++ks) { Kf[t][ks] = *(const bf16x8*)(kb + (size_t)(16 * t + x) * 1536 + 32 * ks + 8 * q); Qf[t][ks] = *(const bf16x8*)(qb + (size_t)(16 * t + x) * 1536 + 32 * ks + 8 * q); }
            float gj[4][4];
#pragma unroll
            for (int jt = 0; jt < 4; ++jt)
#pragma unroll
                for (int r = 0; r < 4; ++r) gj[jt][r] = __shfl(gcum, 16 * jt + 4 * q + r);
            bf16* attp = sb.ATT + cid * 4096;
#pragma unroll
            for (int it = 0; it < 4; ++it) {
                const float gi = __shfl(gcum, 16 * it + x), bi = __shfl(beta, 16 * it + x); f32x4 d2s[4];
#pragma unroll
                for (int jt = 0; jt < 4; ++jt) {
                    if (jt <= it) { f32x4 D1 = {0.f, 0.f, 0.f, 0.f}, D2 = D1;
#pragma unroll
                        for (int ks = 0; ks < 4; ++ks) { D1 = MFMA16(Kf[jt][ks], Kf[it][ks], D1); D2 = MFMA16(Kf[jt][ks], Qf[it][ks], D2); }
                        f32x4 lv;
#pragma unroll
                        for (int r = 0; r < 4; ++r) { const int j = 16 * jt + 4 * q + r, i = 16 * it + x; const float dec = __expf(fminf(gi - gj[jt][r], 0.f));
                            lv[r] = (j < i) ? bi * D1[r] * dec : 0.f; d2s[jt][r] = (j <= i) ? D2[r] * dec : 0.f; }
#pragma unroll
                        for (int r = 0; r < 4; ++r) Lw[(16 * jt + 4 * q + r) * 64 + 16 * it + x] = lv[r];
                    } else d2s[jt] = (f32x4){0.f, 0.f, 0.f, 0.f};
                }
#pragma unroll
                for (int kp = 0; kp < 2; ++kp) if (it >= 2 || kp == 0) *(bf16x8*)(attp + ((it * 2 + kp) * 64 + lane) * 8) = pack8(d2s[2 * kp], d2s[2 * kp + 1]);
            }
            { float* tab = (float*)(attp + 512); tab[lane] = eg; tab[64 + lane] = expf(glast - gcum); }
            bf16* ktp = sb.KT + cid * 8192;
#pragma unroll 1
            for (int dt = 0; dt < 8; ++dt)
#pragma unroll
                for (int kp = 0; kp < 2; ++kp) *(u32x4*)(ktp + ((dt * 2 + kp) * 64 + lane) * 8) = tr_gather<false>(kb + 16 * dt + x, 1536, kp, q, 0.f);
            LDS_WAIT();
            const float be = beta * eg;
#pragma unroll 1
            for (int p = 0; p < 4; ++p) {
                const int col = 64 * (p & 1) + lane; const bf16* src = (p < 2 ? vb : kb) + col; const float scl = p < 2 ? beta : be;
                float xv[64];
#pragma unroll
                for (int i = 0; i < 64; ++i) xv[i] = bf2f(src[(size_t)i * 1536]);
                asm volatile("" ::: "memory");
#pragma unroll
                for (int i = 0; i < 64; ++i) xv[i] *= rdlane(scl, i);
#pragma unroll
                for (int j = 0; j < 63; ++j) {
#pragma unroll
                    for (int g4 = (j + 1) / 4; g4 < 16; ++g4) { const f32x4 lc = *(const LAS f32x4*)(Lw + j * 64 + 4 * g4);
                        if (4 * g4 + 0 > j) xv[4 * g4 + 0] -= lc.x * xv[j]; if (4 * g4 + 1 > j) xv[4 * g4 + 1] -= lc.y * xv[j]; if (4 * g4 + 2 > j) xv[4 * g4 + 2] -= lc.z * xv[j]; if (4 * g4 + 3 > j) xv[4 * g4 + 3] -= lc.w * xv[j]; }
                }
                if (p < 2) { bf16* ut = sb.UT + cid * 8192 + (size_t)col * 64;
#pragma unroll
                    for (int k8 = 0; k8 < 8; ++k8) *(u32x4*)(ut + 8 * k8) = (u32x4){pk2(xv[8 * k8], xv[8 * k8 + 1]), pk2(xv[8 * k8 + 2], xv[8 * k8 + 3]), pk2(xv[8 * k8 + 4], xv[8 * k8 + 5]), pk2(xv[8 * k8 + 6], xv[8 * k8 + 7])};
                } else { const int d = col, ks = d >> 5, dd = d & 31, qp = (dd & 15) >> 2, jj = (dd & 3) + 4 * (dd >> 4);
                    unsigned char* nw = (unsigned char*)(sb.NW + cid * 8192) + ks * 1024 + qp * 256 + jj * 2;
#pragma unroll
                    for (int i = 0; i < 64; ++i) *(unsigned short*)(nw + (i >> 4) * 4096 + (i & 15) * 16) = (unsigned short)(pk2(-xv[i], 0.f) & 0xffffu);
                }
            }
            LDS_WAIT();
        } else {
            const float il = gr[8 + h] + i_bias[h]; const float fl = -softplus_f(-(gr[12 + h] + f_bias[h]));
            const float bcum = scan_add(fl, lane), t = il - bcum, pm = scan_max(t, lane), pml = __shfl(pm, 63);
            const float esc = __expf(t - pml);
            const bf16* qb = sb.X2 + (size_t)m0 * 2560 + 512 + h * 128; const bf16* kb = qb + 512; const bf16* vb = kb + 512;
            bf16x8 Kf[4][4], Qf[4][4];
#pragma unroll
            for (int tt = 0; tt < 4; ++tt)
#pragma unroll
                for (int ks = 0; ks < 4; ++ks) { Kf[tt][ks] = *(const bf16x8*)(kb + (size_t)(16 * tt + x) * 2560 + 32 * ks + 8 * q); Qf[tt][ks] = *(const bf16x8*)(qb + (size_t)(16 * tt + x) * 2560 + 32 * ks + 8 * q); }
            float tj[4][4];
#pragma unroll
            for (int jt = 0; jt < 4; ++jt)
#pragma unroll
                for (int r = 0; r < 4; ++r) tj[jt][r] = __shfl(t, 16 * jt + 4 * q + r);
            bf16* ptp = sb.PT + cid * 4096;
#pragma unroll
            for (int it = 0; it < 4; ++it) {
                const float pmi = __shfl(pm, 16 * it + x); f32x4 d2s[4];
#pragma unroll
                for (int jt = 0; jt < 4; ++jt) {
                    if (jt <= it) { f32x4 D2 = {0.f, 0.f, 0.f, 0.f};
#pragma unroll
                        for (int ks = 0; ks < 4; ++ks) D2 = MFMA16(Kf[jt][ks], Qf[it][ks], D2);
#pragma unroll
                        for (int r = 0; r < 4; ++r) { const int j = 16 * jt + 4 * q + r, i = 16 * it + x; d2s[jt][r] = (j <= i) ? D2[r] * 0.08838834764831845f * __expf(fminf(tj[jt][r] - pmi, 0.f)) : 0.f; }
                    } else d2s[jt] = (f32x4){0.f, 0.f, 0.f, 0.f};
                }
#pragma unroll
                for (int kp = 0; kp < 2; ++kp) if (it >= 2 || kp == 0) *(bf16x8*)(ptp + ((it * 2 + kp) * 64 + lane) * 8) = pack8(d2s[2 * kp], d2s[2 * kp + 1]);
            }
            { float* tab = (float*)(ptp + 512); tab[lane] = bcum; tab[64 + lane] = bcum + pm; }
            bf16* kwp = sb.KWT + cid * 8192; bf16* vtp = sb.VT + cid * 8192;
#pragma unroll 1
            for (int dt = 0; dt < 8; ++dt)
#pragma unroll
                for (int kp = 0; kp < 2; ++kp) { *(u32x4*)(kwp + ((dt * 2 + kp) * 64 + lane) * 8) = tr_gather<true>(kb + 16 * dt + x, 2560, kp, q, esc);
                    *(u32x4*)(vtp + ((dt * 2 + kp) * 64 + lane) * 8) = tr_gather<false>(vb + 16 * dt + x, 2560, kp, q, 0.f); }
        }
    }
}
constexpr int RC_NW = 0, RC_ATT = 16384, RC_KT = 24576, RC_QP = 40960, RC_BUF = 57344;
__device__ __forceinline__ void recur_stage(LAS unsigned char* buf, const bf16* f16a  , const bf16* f8  , const bf16* f16b  , const bf16* qbase  , int qpitch, int wave, int lane) {
#pragma unroll
    for (int k = 0; k < 5; ++k) { const int bl = wave + 8 * k;
        const bf16* src = bl < 16 ? f16a + bl * 512 : (bl < 24 ? f8 + (bl - 16) * 512 : f16b + (bl - 24) * 512);
        __builtin_amdgcn_global_load_lds((const unsigned*)(src + lane * 8), (LAS unsigned*)(buf + bl * 1024), 16, 0, 0); }
#pragma unroll
    for (int k = 0; k < 8; ++k) { const int P = (wave * 8 + k) * 256 + lane * 4, f = P >> 10, lp = (P & 1023) >> 4, jj0 = ((P & 15) >> 2) * 2, it = f >> 2, ks = f & 3, xp = lp & 15, qp = lp >> 4;
        const bf16* src = qbase + (size_t)(16 * it + xp) * qpitch + kperm(ks, qp, jj0);
        __builtin_amdgcn_global_load_lds((const unsigned*)src, (LAS unsigned*)(buf + RC_QP + (wave * 8 + k) * 256), 4, 0, 0); }
}
__device__ __forceinline__ void recur_phase(LAS unsigned char* lds, const ScanBufs sb, int G, int bid, int wave, int lane) {
    const int x = lane & 15, q = lane >> 4, et = wave;
#pragma unroll 1
    for (int u = bid; u < 2 * BATCH * 4; u += G) {
        const int mixer = u >> 7, b = (u & 127) >> 2, h = u & 3;
        const size_t cid0 = (size_t)((b * 4 + h) * 32);
        if (mixer == 0) {
            f32x4 S[8];
#pragma unroll
            for (int d = 0; d < 8; ++d) S[d] = (f32x4){0.f, 0.f, 0.f, 0.f};
            recur_stage(lds, sb.NW + cid0 * 8192, sb.ATT + cid0 * 4096, sb.KT + cid0 * 8192, sb.QKVA + (size_t)(b * SEQ) * 1536 + h * 128, 1536, wave, lane);
            __syncthreads();
#pragma unroll 1
            for (int c = 0; c < SEQ / 64; ++c) {
                const int m0 = b * SEQ + c * 64; const size_t cid = cid0 + c;
                const LAS unsigned char* buf = lds + (c & 1) * RC_BUF;
                { const int cn = c + 1 < SEQ / 64 ? c + 1 : c; const size_t cidn = cid0 + cn;
                  recur_stage(lds + ((c + 1) & 1) * RC_BUF, sb.NW + cidn * 8192, sb.ATT + cidn * 4096, sb.KT + cidn * 8192, sb.QKVA + (size_t)(b * SEQ + cn * 64) * 1536 + h * 128, 1536, wave, lane); }
                const bf16* utp = sb.UT + cid * 8192 + (size_t)(16 * et + x) * 64;
                const LAS float* tab = (const LAS float*)(buf + RC_ATT + 1024);
                bf16x8 Sb[4];
#pragma unroll
                for (int ks = 0; ks < 4; ++ks) Sb[ks] = pack8(S[2 * ks], S[2 * ks + 1]);
                f32x4 vn[4];
#pragma unroll
                for (int mt = 0; mt < 4; ++mt) { const u32x2 uu = *(const u32x2*)(utp + 16 * mt + 4 * q); f32x4 acc = {bf_lo(uu.x), bf_hi(uu.x), bf_lo(uu.y), bf_hi(uu.y)};
#pragma unroll
                    for (int ks = 0; ks < 4; ++ks) acc = MFMA16(*(const LAS bf16x8*)(buf + RC_NW + ((mt * 4 + ks) * 64 + lane) * 16), Sb[ks], acc);
                    vn[mt] = acc; }
                bf16x8 vb2[2] = {pack8(vn[0], vn[1]), pack8(vn[2], vn[3])};
#pragma unroll
                for (int it = 0; it < 4; ++it) { f32x4 acc = {0.f, 0.f, 0.f, 0.f};
#pragma unroll
                    for (int ks = 0; ks < 4; ++ks) acc = MFMA16(Sb[ks], *(const LAS bf16x8*)(buf + RC_QP + ((it * 4 + ks) * 64 + lane) * 16), acc);
                    acc = acc * tab[16 * it + x];
#pragma unroll
                    for (int kp = 0; kp < 2; ++kp) if (it >= 2 || kp == 0) acc = MFMA16(vb2[kp], *(const LAS bf16x8*)(buf + RC_ATT + ((it * 2 + kp) * 64 + lane) * 16), acc);
                    *(u32x2*)(sb.QKVA + (size_t)(m0 + 16 * it + x) * 1536 + 512 + h * 128 + 16 * et + 4 * q) = (u32x2){pk2v(acc.x, acc.y), pk2v(acc.z, acc.w)}; }
                f32x4 vs[4];
#pragma unroll
                for (int mt = 0; mt < 4; ++mt) { const f32x4 kk = *(const LAS f32x4*)(tab + 64 + 16 * mt + 4 * q); vs[mt] = vn[mt] * kk; }
                const bf16x8 vsb[2] = {pack8(vs[0], vs[1]), pack8(vs[2], vs[3])};
                const float gam = tab[63];
#pragma unroll
                for (int dt = 0; dt < 8; ++dt) { f32x4 acc = S[dt] * gam;
#pragma unroll
                    for (int kp = 0; kp < 2; ++kp) acc = MFMA16(*(const LAS bf16x8*)(buf + RC_KT + ((dt * 2 + kp) * 64 + lane) * 16), vsb[kp], acc);
                    S[dt] = acc; }
                __syncthreads();
            }
        } else {
            f32x4 Cs[8], Ce[8]; float mrun = 0.f;
#pragma unroll
            for (int d = 0; d < 8; ++d) { Cs[d] = (f32x4){0.f, 0.f, 0.f, 0.f}; Ce[d] = Cs[d]; }
            const short one = (x == 0) ? (short)0x3F80 : (short)0; const bf16x8 ones = {one, one, one, one, one, one, one, one};
            recur_stage(lds, sb.KWT + cid0 * 8192, sb.PT + cid0 * 4096, sb.KWT + cid0 * 8192, sb.X2 + (size_t)(b * SEQ) * 2560 + 512 + h * 128, 2560, wave, lane);
            __syncthreads();
#pragma unroll 1
            for (int c = 0; c < SEQ / 64; ++c) {
                const int m0 = b * SEQ + c * 64; const size_t cid = cid0 + c;
                const LAS unsigned char* buf = lds + (c & 1) * RC_BUF;
                { const int cn = c + 1 < SEQ / 64 ? c + 1 : c; const size_t cidn = cid0 + cn;
                  recur_stage(lds + ((c + 1) & 1) * RC_BUF, sb.KWT + cidn * 8192, sb.PT + cidn * 4096, sb.KWT + cidn * 8192, sb.X2 + (size_t)(b * SEQ + cn * 64) * 2560 + 512 + h * 128, 2560, wave, lane); }
                const bf16* vtp = sb.VT + cid * 8192;
                const LAS float* tab = (const LAS float*)(buf + RC_ATT + 1024);
                bf16x8 Cb[4], Eb[4];
#pragma unroll
                for (int ks = 0; ks < 4; ++ks) { Cb[ks] = pack8(Cs[2 * ks], Cs[2 * ks + 1]); Eb[ks] = pack8(Ce[2 * ks], Ce[2 * ks + 1]); }
                const bf16x8 vf[2] = {*(const bf16x8*)(vtp + ((et * 2 + 0) * 64 + lane) * 8), *(const bf16x8*)(vtp + ((et * 2 + 1) * 64 + lane) * 8)};
#pragma unroll
                for (int it = 0; it < 4; ++it) {
                    const float bc = tab[16 * it + x], mi = tab[64 + 16 * it + x];
                    const float a = bc + mrun, mt = fmaxf(a, mi), f1 = __expf(a - mt) * 0.08838834764831845f, f2 = __expf(mi - mt);
                    f32x4 a1 = {0.f, 0.f, 0.f, 0.f}, aP = a1, e1 = a1, eP = a1;
#pragma unroll
                    for (int ks = 0; ks < 4; ++ks) { const bf16x8 qf = *(const LAS bf16x8*)(buf + RC_QP + ((it * 4 + ks) * 64 + lane) * 16);
                        a1 = MFMA16(Cb[ks], qf, a1); if (wave == 0) e1 = MFMA16(Eb[ks], qf, e1); }
#pragma unroll
                    for (int kp = 0; kp < 2; ++kp) if (it >= 2 || kp == 0) { const bf16x8 pf = *(const LAS bf16x8*)(buf + RC_ATT + ((it * 2 + kp) * 64 + lane) * 16); aP = MFMA16(vf[kp], pf, aP); if (wave == 0) eP = MFMA16(ones, pf, eP); }
                    const f32x4 nm = a1 * f1 + aP * f2;
                    *(u32x2*)(sb.X2 + (size_t)(m0 + 16 * it + x) * 2560 + 1024 + h * 128 + 16 * et + 4 * q) = (u32x2){pk2(nm.x, nm.y), pk2(nm.z, nm.w)};
                    if (wave == 0 && q == 0) sb.DEN[(size_t)(m0 + 16 * it + x) * 4 + h] = fmaxf(fabsf(e1.x * f1 + eP.x * f2), __expf(-mt));
                }
                const float blast = tab[63], wsmax = tab[127];
                const float mnew = fmaxf(blast + mrun, wsmax), sc = __expf(blast + mrun - mnew), s2 = __expf(wsmax - mnew); mrun = mnew;
#pragma unroll
                for (int dt = 0; dt < 8; ++dt) { f32x4 dC = {0.f, 0.f, 0.f, 0.f}, dE = dC;
#pragma unroll
                    for (int kp = 0; kp < 2; ++kp) { const bf16x8 kf = *(const LAS bf16x8*)(buf + RC_KT + ((dt * 2 + kp) * 64 + lane) * 16); dC = MFMA16(kf, vf[kp], dC); if (wave == 0) dE = MFMA16(kf, ones, dE); }
                    Cs[dt] = Cs[dt] * sc + dC * s2; if (wave == 0) Ce[dt] = Ce[dt] * sc + dE * s2; }
                __syncthreads();
            }
        }
    }
}
__device__ __forceinline__ void post_phase(const ScanBufs sb, const float* norm_a, const float* norm_b, bf16* MIXED, int gw, int NGW, int lane) {
    const int hh = lane >> 3, sub = (lane & 7) * 16;
#pragma unroll 2
    for (int m = gw; m < M; m += NGW) {
        const bool isA = hh < 4; const int h = hh & 3;
        const bf16* src = isA ? sb.QKVA + (size_t)m * 1536 + 512 + h * 128 + sub : sb.X2 + (size_t)m * 2560 + 1024 + h * 128 + sub;
        const bf16* gsrc = sb.X2 + (size_t)m * 2560 + (isA ? 0 : 2048) + h * 128 + sub;
        const float* gn = (isA ? norm_a : norm_b + h * 128) + sub;
        const u32x4 r0 = *(const u32x4*)src, r1 = *(const u32x4*)(src + 8), z0 = *(const u32x4*)gsrc, z1 = *(const u32x4*)(gsrc + 8);
        float v[16] = {bf_lo(r0.x), bf_hi(r0.x), bf_lo(r0.y), bf_hi(r0.y), bf_lo(r0.z), bf_hi(r0.z), bf_lo(r0.w), bf_hi(r0.w), bf_lo(r1.x), bf_hi(r1.x), bf_lo(r1.y), bf_hi(r1.y), bf_lo(r1.z), bf_hi(r1.z), bf_lo(r1.w), bf_hi(r1.w)};
        const float z[16] = {bf_lo(z0.x), bf_hi(z0.x), bf_lo(z0.y), bf_hi(z0.y), bf_lo(z0.z), bf_hi(z0.z), bf_lo(z0.w), bf_hi(z0.w), bf_lo(z1.x), bf_hi(z1.x), bf_lo(z1.y), bf_hi(z1.y), bf_lo(z1.z), bf_hi(z1.z), bf_lo(z1.w), bf_hi(z1.w)};
        const float dinv = isA ? 1.f : 1.f / sb.DEN[(size_t)m * 4 + h];
        float ss = 0.f;
#pragma unroll
        for (int i = 0; i < 16; ++i) { v[i] *= dinv; ss += v[i] * v[i]; }
        ss += __shfl_xor(ss, 1); ss += __shfl_xor(ss, 2); ss += __shfl_xor(ss, 4);
        const float rstd = rsqrtf(ss * (1.f / 128.f) + EPS);
        float y[16];
#pragma unroll
        for (int i = 0; i < 16; ++i) { const float sg = sigmoid_f(z[i]); y[i] = v[i] * rstd * gn[i] * (isA ? z[i] * sg : sg); }
        u32x4* dst = (u32x4*)(MIXED + (size_t)m * 1024 + lane * 16);
        dst[0] = (u32x4){pk2(y[0], y[1]), pk2(y[2], y[3]), pk2(y[4], y[5]), pk2(y[6], y[7])}; dst[1] = (u32x4){pk2(y[8], y[9]), pk2(y[10], y[11]), pk2(y[12], y[13]), pk2(y[14], y[15])};
    }
}
typedef short v4i16_t __attribute__((ext_vector_type(4)));
constexpr int AT_VROW = 80;
constexpr int AT_K_BYTES = 256 * 128, AT_V_BYTES = 272 * AT_VROW * 2;
__device__ __forceinline__ void attn_phase(LAS unsigned char* lds, int tid, int wave, const bf16* QKV, const float* sinks, bf16* O, int G, int bid) {
    LAS unsigned char* KL = lds; LAS unsigned char* VL = lds + AT_K_BYTES;
    const int lane = tid & 63, x = lane & 15, q = lane >> 4, g = wave >> 1, qh = wave & 1;
    u32x4 kreg[4], vreg[4];
#define AT_LOAD_KV(uu) do { const int b_ = (uu) >> 6, kvh_ = ((uu) >> 4) & 3, jb_ = (uu) & 15; _Pragma("unroll") for (int i = 0; i < 4; ++i) { const int item = tid + 512 * i, r = item >> 3, ch = item & 7, sk = (jb_ - 1) * 128 + r; \
        kreg[i] = (u32x4){0u, 0u, 0u, 0u}; vreg[i] = kreg[i]; if (sk >= 0) { const bf16* src = QKV + (size_t)(b_ * SEQ + sk) * 1536 + 1024 + kvh_ * 64 + ch * 8; kreg[i] = *(const u32x4*)src; vreg[i] = *(const u32x4*)(src + 256); } } } while (0)
    if (bid < BATCH * 4 * 16) AT_LOAD_KV(bid);
#pragma unroll 1
    for (int u = bid; u < BATCH * 4 * 16; u += G) {
        const int b = u >> 6, kvh = (u >> 4) & 3, jb = u & 15;
#pragma unroll
        for (int i = 0; i < 4; ++i) { const int item = tid + 512 * i, r = item >> 3, ch = item & 7;
            *(LAS u32x4*)(KL + r * 128 + ((ch ^ (r & 7)) << 4)) = kreg[i]; *(LAS u32x4*)(VL + r * (AT_VROW * 2) + ch * 16) = vreg[i]; }
        if (tid < 128) { const int r = 256 + (tid >> 3), ch = tid & 7; unsigned z0 = 0u; asm volatile("" : "+v"(z0));
            *(LAS u32x4*)(VL + r * (AT_VROW * 2) + ch * 16) = (u32x4){z0, z0, z0, z0}; }
        __syncthreads();
        if (u + G < BATCH * 4 * 16) AT_LOAD_KV(u + G);
        const int hq = kvh * 4 + g; const float sink = sinks[hq];
        const size_t mq = (size_t)b * SEQ + jb * 128 + 64 * qh;
        bf16x8 Qn[2];
#pragma unroll
        for (int ks = 0; ks < 2; ++ks) Qn[ks] = *(const bf16x8*)(QKV + (mq + x) * 1536 + hq * 64 + 32 * ks + 8 * q);
#pragma unroll 1
        for (int nt = 0; nt < 4; ++nt) {
            const bf16x8 Qf[2] = {Qn[0], Qn[1]};
            { const int nn = nt < 3 ? nt + 1 : 3;
#pragma unroll
              for (int ks = 0; ks < 2; ++ks) Qn[ks] = *(const bf16x8*)(QKV + (mq + 16 * nn + x) * 1536 + hq * 64 + 32 * ks + 8 * q); }
            f32x4 s[9]; float mx = -3.0e38f;
            bf16x8 kf[9][2];
#pragma unroll
            for (int j = 0; j < 9; ++j) { const int r = 64 * qh + 16 * (nt + j) + x;
#pragma unroll
                for (int ks = 0; ks < 2; ++ks) kf[j][ks] = *(const LAS bf16x8*)(KL + r * 128 + (((4 * ks + q) ^ (r & 7)) << 4)); }
            __builtin_amdgcn_sched_barrier(0);
#pragma unroll
            for (int j = 0; j < 9; ++j) { const int kt = nt + j;
                f32x4 acc = {0.f, 0.f, 0.f, 0.f};
#pragma unroll
                for (int ks = 0; ks < 2; ++ks) acc = MFMA16(kf[j][ks], Qf[ks], acc);
#pragma unroll
                for (int rg = 0; rg < 4; ++rg) { const int diff = 16 * j + 4 * q + rg - x, ra = 64 * qh + 16 * kt + 4 * q + rg;
                    const bool valid = diff >= 1 && diff <= 128 && (jb - 1) * 128 + ra >= 0;
                    acc[rg] = valid ? acc[rg] : -3.0e38f; mx = fmaxf(mx, acc[rg]); }
                s[j] = acc; }
            mx = fmaxf(mx, __shfl_xor(mx, 16)); mx = fmaxf(mx, __shfl_xor(mx, 32)); mx = fmaxf(mx, sink);
            float sum = 0.f;
#pragma unroll
            for (int j = 0; j < 9; ++j)
#pragma unroll
                for (int rg = 0; rg < 4; ++rg) { const float p = (s[j][rg] > -1.0e38f) ? __expf(s[j][rg] - mx) : 0.f; s[j][rg] = p; sum += p; }
            sum += __shfl_xor(sum, 16); sum += __shfl_xor(sum, 32);
            const float inv = 1.f / (sum + __expf(sink - mx));
            bf16x8 Pf[5];
#pragma unroll
            for (int j2 = 0; j2 < 4; ++j2) Pf[j2] = pack8(s[2 * j2], s[2 * j2 + 1]);
            Pf[4] = pack8(s[8], (f32x4){0.f, 0.f, 0.f, 0.f});
            bf16x8 vf[4][5];
#pragma unroll
            for (int dt = 0; dt < 4; ++dt)
#pragma unroll
                for (int j2 = 0; j2 < 5; ++j2) { const int kb = 64 * qh + 16 * (nt + 2 * j2) + 4 * q + (x >> 2);
                    const LAS unsigned char* p0 = VL + kb * (AT_VROW * 2) + (16 * dt + 4 * (x & 3)) * 2;
                    const v4i16_t lo = __builtin_amdgcn_ds_read_tr16_b64_v4i16((LAS v4i16_t*)p0), hi = __builtin_amdgcn_ds_read_tr16_b64_v4i16((LAS v4i16_t*)(p0 + 16 * AT_VROW * 2));
                    vf[dt][j2] = (bf16x8){lo[0], lo[1], lo[2], lo[3], hi[0], hi[1], hi[2], hi[3]}; }
            __builtin_amdgcn_sched_barrier(0);
#pragma unroll
            for (int dt = 0; dt < 4; ++dt) { f32x4 acc = {0.f, 0.f, 0.f, 0.f};
#pragma unroll
                for (int j2 = 0; j2 < 5; ++j2) acc = MFMA16(vf[dt][j2], Pf[j2], acc);
                acc = acc * inv;
                *(u32x2*)(O + (mq + 16 * nt + x) * 1024 + hq * 64 + 16 * dt + 4 * q) = (u32x2){pk2v(acc.x, acc.y), pk2v(acc.z, acc.w)}; }
        }
        __syncthreads();
    }
}
#ifndef N_LAUNCH_MODE
#define N_LAUNCH_MODE 0
#endif
__global__ void __launch_bounds__(NTHR, 2) trunk_fwd(Args a_unused) {
    extern __shared__ __attribute__((aligned(16))) unsigned char lds_raw[];
    LAS unsigned char* lds = (LAS unsigned char*)lds_raw;
    volatile LAS unsigned* MISC = (volatile LAS unsigned*)(lds + MISC_OFF);
    if (threadIdx.x < 64) MISC[threadIdx.x] = 0u;
    __syncthreads();
    int lo, hi; XcdBarrier bar;
    int dupm = 0, dupp = 0; (void)dupm; (void)dupp;
    { KArgs a = kargs(); lo = a->ph_lo; hi = a->ph_hi; dupm = a->dup_mask; dupp = a->dup_par; unsigned* ctl = (unsigned*)(a->ws + WS_CTL);
      bar.bar = ctl + CW_BAR; bar.x = 0; bar.st = MISC + 8;
      if (hi - lo > 1) bar = xcd_barrier_post(ctl + CW_BAR, MISC + 8); }
#define IN(k) (lo <= (k) && (k) < hi)
#if defined(PROBE_DUP_MASK)
#define REP(k) _Pragma("unroll 1") for (int rep_ = 0; rep_ <= (((dupm >> (k)) & 1) && (dupp == 0 || dupp == 1 + (L & 1)) ? 1 : 0); ++rep_)
#else
#define REP(k)
#endif
#if defined(PROBE_BAR2)
#define SEAM(k) do { if (IN(k) && IN((k) + 1)) { xcd_barrier(bar); xcd_barrier(bar); } } while (0)
#else
#define SEAM(k) do { if (IN(k) && IN((k) + 1)) xcd_barrier(bar); } while (0)
#endif
#define ENV KArgs a = kargs(); const int tid = fresh_tid(), lane = tid & 63, wave = __builtin_amdgcn_readfirstlane(tid >> 6); const int G = gridDim.x, bid = blockIdx.x, gw = bid * NWAVES + wave, NGW = G * NWAVES, gtid = bid * NTHR + tid, NGT = G * NTHR; \
    unsigned char* ws = a->ws; bf16* RA = (bf16*)(ws + WS_RA); bf16* RB = (bf16*)(ws + WS_RB); bf16* RC = (bf16*)(ws + WS_RC); bf16* RD = (bf16*)(ws + WS_RD); float* Gt = (float*)(ws + WS_GT); \
    (void)lane; (void)wave; (void)gw; (void)NGW; (void)gtid; (void)NGT; (void)RA; (void)RB; (void)RC; (void)RD; (void)Gt; (void)G; (void)bid

    if (IN(0)) { ENV; prologue_phase(a, lds, gw, NGW, wave, lane, gtid, NGT);
#if defined(PROBE_DUP_MASK)
        if (dupm & (1 << 20)) prologue_phase(a, lds, gw, NGW, wave, lane, gtid, NGT);
#endif
    }
    SEAM(0);
#define SCANBUFS ScanBufs sb; sb.QKVA = (bf16*)(ws + WS_QKVA); sb.X2 = (bf16*)(ws + WS_X2); sb.Gt = Gt; sb.KT = (bf16*)(ws + WS_KT); sb.UT = (bf16*)(ws + WS_UT); sb.NW = (bf16*)(ws + WS_NW); sb.ATT = (bf16*)(ws + WS_ATT); \
    sb.KWT = (bf16*)(ws + WS_KWT); sb.VT = (bf16*)(ws + WS_VT); sb.PT = (bf16*)(ws + WS_PT); sb.DEN = (float*)(ws + WS_DEN)
#pragma unroll 1
    for (int L = 0; L < DEPTH; ++L) {
        const int pb = 1 + L * PH_PER_LAYER; const bool even = (L & 1) == 0; const int e = L >> 1;
        if (L == 0 && IN(pb + 0)) REP(0) { ENV; const float* hin = a->x;
            norm_phase(lds, hin, a->gains + (size_t)L * 4 * DM, RA, even, (const float*)(ws + WS_WGATES) + (size_t)e * 16 * 1024, Gt, gw, NGW, tid, lane); }
        if (L == 0) SEAM(pb + 0);
        if (IN(pb + 1)) REP(1) { ENV;
            const int N = even ? 4096 : 1536;
            pg8::Gemm g{RA, even ? (const bf16*)(ws + WS_WIN) + (size_t)e * 4096 * 1024 : (const bf16*)(ws + WS_WQKV) + (size_t)e * 1536 * 1024, M, N, DM};
            pg8::StaticOrder S; S.init(M, N, G, bid);
            pg8::EpiIn E{RC, (bf16*)(ws + WS_X2), even ? nullptr : a->b_qkv + (size_t)e * 1536, even ? nullptr : (const float*)(ws + WS_ROPE)};
            pg8::gemm_phase<pg8::EpiIn, pg8::StaticOrder, true, true>(lds, g, S, E);
        }
        SEAM(pb + 1);
        if (even) {
            if (IN(pb + 2)) REP(2) { ENV; conv_phase((const bf16*)(ws + WS_X1), a->conv + (size_t)e * 4 * 1536, (bf16*)(ws + WS_QKVA), gw, NGW, lane); }
            SEAM(pb + 2);
        }
        if (even) {
            if (IN(pb + 3)) REP(3) { ENV; SCANBUFS; local_phase(lds, sb, a->a_log + e * 4, a->dt_bias + e * 4, a->i_bias + e * 4, a->f_bias + e * 4, gw, NGW, wave, lane); }
            SEAM(pb + 3);
        }
        if (IN(pb + 4)) REP(4) { ENV;
            if (even) { SCANBUFS; recur_phase(lds, sb, G, bid, wave, lane); }
            else attn_phase(lds, tid, wave, RC, a->sinks + e * 16, RD, G, bid);
        }
        SEAM(pb + 4);
        if (even) {
            if (IN(pb + 5)) REP(5) { ENV; SCANBUFS; post_phase(sb, a->norm_a + e * 128, a->norm_b + e * 512, (bf16*)(ws + WS_MIXED), gw, NGW, lane); }
            SEAM(pb + 5);
        }
        if (IN(pb + 6)) REP(6) { ENV;
            pg8::Gemm g{even ? (const bf16*)(ws + WS_MIXED) : (const bf16*)RD, even ? (const bf16*)(ws + WS_WOUT) + (size_t)e * DM * DM : (const bf16*)(ws + WS_WO) + (size_t)e * DM * DM, M, DM, DM};
            pg8::StaticOrder S; S.init(M, DM, G, bid);
            pg8::EpiBf16<0> E{RA, DM, even ? nullptr : a->b_o + (size_t)e * DM, RA, 1 << 30, DM};
            pg8::gemm_phase<pg8::EpiBf16<0>, pg8::StaticOrder, true, true>(lds, g, S, E);
        }
        SEAM(pb + 6);
        if (IN(pb + 7)) { ENV; const float* gains = a->gains + (size_t)L * 4 * DM;
            resid_a_phase(RA, (L == 0) ? a->x : nullptr, (bf16*)a->out, gains + DM, gains + 2 * DM, RD, gw, NGW, lane); }
        SEAM(pb + 7);
        if (IN(pb + 8)) REP(8) { ENV;
            pg8::Gemm g{RD, (const bf16*)(ws + WS_WUP) + (size_t)L * FF * DM, M, FF, DM};
            pg8::StaticOrder S; S.init(M, FF, G, bid);
            pg8::EpiBf16<1> E{RC, FF, nullptr, RC, 1 << 30, FF};
            pg8::gemm_phase<pg8::EpiBf16<1>, pg8::StaticOrder, true, true>(lds, g, S, E);
        }
        SEAM(pb + 8);
        if (IN(pb + 9)) REP(9) { ENV;
            pg8::Gemm g{RC, (const bf16*)(ws + WS_WDN) + (size_t)L * DM * FF, M, DM, FF};
            pg8::StaticOrder S; S.init(M, DM, G, bid);
            pg8::EpiBf16<0> E{RA, DM, nullptr, RA, 1 << 30, DM};
            pg8::gemm_phase<pg8::EpiBf16<0>, pg8::StaticOrder, true, true>(lds, g, S, E);
        }
        SEAM(pb + 9);
        if (IN(pb + 10)) { ENV; resid_b_phase(RA, (const bf16*)a->out, a->gains + (size_t)L * 4 * DM + 3 * DM, RD, a->p + (size_t)L * M * PLE, RC, gw, NGW, lane, gtid, NGT); }
        SEAM(pb + 10);
        if (IN(pb + 11)) REP(11) { ENV;
            pg8::Gemm g{RC, (const bf16*)(ws + WS_WPLE) + (size_t)L * DM * PLE, M, DM, PLE};
            pg8::StaticOrder S; S.init(M, DM, G, bid);
            pg8::EpiBf16<0> E{RB, DM, nullptr, RB, 1 << 30, DM};
            pg8::gemm_phase<pg8::EpiBf16<0>, pg8::StaticOrder, true, true>(lds, g, S, E);
        }
        SEAM(pb + 11);
        if (IN(pb + 12)) { ENV;
            pg8::Gemm g{RD, (const bf16*)(ws + WS_WG) + (size_t)L * DM * DM, M, DM, DM};
            pg8::StaticOrder S; S.init(M, DM, G, bid);
            pg8::EpiBf16<0> E{(bf16*)(ws + WS_RC + 64 * MiB), DM, nullptr, RB, 1 << 30, DM};
            pg8::gemm_phase<pg8::EpiBf16<0>, pg8::StaticOrder, true, true>(lds, g, S, E);
        }
        SEAM(pb + 12);
        if (IN(pb + 13)) { ENV; const bool has_next = L + 1 < DEPTH, even_next = ((L + 1) & 1) == 0; const int en = (L + 1) >> 1;
            resid_c_phase(lds, (const bf16*)(ws + WS_RC + 64 * MiB), RB, RD, (bf16*)a->out, a->out, has_next, a->gains + (size_t)(L + 1 < DEPTH ? L + 1 : L) * 4 * DM, RA, even_next, (const float*)(ws + WS_WGATES) + (size_t)(en & 1) * 16 * 1024, Gt, gw, NGW, tid, lane); }
        SEAM(pb + 13);
    }
#undef SCANBUFS
#undef IN
#undef SEAM
#undef ENV
}

extern "C" void kernel_launch(void* const* d_in, const int* in_sizes, int n_in, void* d_out, int out_size, void* d_ws, size_t ws_size, hipStream_t stream) {
    static int grid = 0;
    if (grid == 0) {
        if (n_in != 22 || in_sizes[0] != M * DM || out_size != M * DM || ws_size < WS_END) {
            fprintf(stderr, "kernel_launch: unexpected shapes (n_in %d, in0 %d, out %d, ws %zu; need ws >= %zu); nothing launched\n", n_in, n_in > 0 ? in_sizes[0] : -1, out_size, ws_size, (size_t)WS_END); grid = -1; return; }
        int dev = 0, cus = 0, per_cu = 0;
        if (hipGetDevice(&dev) != hipSuccess || hipDeviceGetAttribute(&cus, hipDeviceAttributeMultiprocessorCount, dev) != hipSuccess) { fprintf(stderr, "kernel_launch: device query failed\n"); grid = -1; return; }
        if (hipFuncSetAttribute((const void*)trunk_fwd, hipFuncAttributeMaxDynamicSharedMemorySize, LDS_BYTES) != hipSuccess) { fprintf(stderr, "kernel_launch: hipFuncSetAttribute failed\n"); grid = -1; return; }
        if (hipOccupancyMaxActiveBlocksPerMultiprocessor(&per_cu, (const void*)trunk_fwd, NTHR, LDS_BYTES) != hipSuccess || per_cu < 1) fprintf(stderr, "kernel_launch: note: occupancy query reports %d\n", per_cu);
        (void)hipGetLastError();
        grid = cus;
    }
    if (grid < 0) return;
    Args a{};
    a.x = (const float*)d_in[0]; a.p = (const float*)d_in[1]; a.pos = (const int*)d_in[2]; a.gains = (const float*)d_in[3]; a.w_in = (const float*)d_in[4]; a.conv = (const float*)d_in[5];
    a.a_log = (const float*)d_in[6]; a.dt_bias = (const float*)d_in[7]; a.norm_a = (const float*)d_in[8]; a.i_bias = (const float*)d_in[9]; a.f_bias = (const float*)d_in[10]; a.norm_b = (const float*)d_in[11];
    a.b_qkv = (const float*)d_in[14]; a.sinks = (const float*)d_in[15]; a.b_o = (const float*)d_in[17];
    a.out = (float*)d_out; a.ws = (unsigned char*)d_ws;
#if defined(PROBE_DUP_MASK)
    a.dup_mask = PROBE_DUP_MASK; a.dup_par = PROBE_DUP_PAR;
#endif
    a.w_out = (const float*)d_in[12]; a.w_qkv = (const float*)d_in[13]; a.w_o = (const float*)d_in[16]; a.w_up = (const float*)d_in[18]; a.w_down = (const float*)d_in[19]; a.w_ple = (const float*)d_in[20]; a.w_gate = (const float*)d_in[21];
#if N_LAUNCH_MODE == 0
    if (hipMemsetAsync((char*)d_ws + WS_CTL, 0, CTL_ZERO_BYTES, stream) != hipSuccess) { fprintf(stderr, "kernel_launch: memset failed\n"); return; }
    a.ph_lo = 0; a.ph_hi = NPHASE;
    hipLaunchKernelGGL(trunk_fwd, dim3(grid), dim3(NTHR), LDS_BYTES, stream, a);
#else
    for (int ph = 0; ph < NPHASE; ++ph) { a.ph_lo = ph; a.ph_hi = ph + 1; hipLaunchKernelGGL(trunk_fwd, dim3(grid), dim3(NTHR), LDS_BYTES, stream, a); }
#endif
    const hipError_t le = hipPeekAtLastError();
    if (le != hipSuccess) fprintf(stderr, "kernel_launch: launch failed: %s\n", hipGetErrorName(le));
}
```

```cpp
#include <hip/hip_runtime.h>
#include <cstdio>
#include <cstdint>
#define N_LAUNCH_MODE 0
namespace pg8 {
#define PG8_LAS __attribute__((address_space(3)))
typedef unsigned short bf16_t;
typedef short bf16x8 __attribute__((ext_vector_type(8)));
typedef float f32x4 __attribute__((ext_vector_type(4)));
typedef unsigned u32x4 __attribute__((ext_vector_type(4)));
constexpr int BM = 256, BK = 64, HALF = 128, HTB = HALF * BK * 2  , STAGE_BYTES = 8 * HTB, NXCD = 8, WGM = 8;

__host__ __device__ __forceinline__ int lds_byte(int r, int c) { const int st = (r >> 4) * 2 + (c >> 5), rr = r & 15, cc = c & 31, ob = rr * 64 + cc * 2; return st * 1024 + (ob ^ (((ob >> 9) & 1) << 5)); }
__host__ __device__ __forceinline__ void stage_rc(int b, int& R, int& C) { const int st = b / 1024, sb = b % 1024, swz = sb ^ (((sb >> 9) & 1) << 5); R = (st >> 1) * 16 + swz / 64; C = (st & 1) * 32 + (swz % 64) / 2; }
__host__ __device__ __forceinline__ int perm32(int rho) { const int n = rho >> 4, i = rho & 15; return 8 * (i >> 2) + 4 * n + (i & 3); }

struct Unit { int pm, pn; };
struct Gemm { const bf16_t* A; const bf16_t* Bt; int M, N, K; };

struct StaticOrder {
    int nM, nN, nwg, G, c;
    __host__ __device__ void init(int M, int N, int G_, int c_) { nM = M / BM; nN = N / BM; nwg = nM * nN; G = G_; c = c_; }
    __host__ __device__ bool next(int i, Unit& u) const {
        const long L = (long)i * G + c; if (L >= nwg) return false;
        int wgid = (int)L; { const int q = nwg / NXCD, r = nwg % NXCD, xcd = wgid % NXCD, off = wgid / NXCD; wgid = (xcd < r ? xcd * (q + 1) : r * (q + 1) + (xcd - r) * q) + off; }
        const int nig = WGM * nN, gid = wgid / nig, fm = gid * WGM, gsz = (nM - fm) < WGM ? (nM - fm) : WGM;
        u.pm = fm + ((wgid % nig) % gsz); u.pn = (wgid % nig) / gsz; return true;
    }
    __device__ __forceinline__ void a_ready(const Unit&) const {}
    __device__ __forceinline__ void done(const Unit&) const {}
};

__device__ __forceinline__ unsigned cvt_pk_bf16(float lo, float hi) { unsigned r; asm volatile("v_cvt_pk_bf16_f32 %0, %1, %2" : "=v"(r) : "v"(lo), "v"(hi)); return r; }
typedef float f32x2 __attribute__((ext_vector_type(2)));
typedef unsigned u32x2 __attribute__((ext_vector_type(2)));

template <int ACT  > struct EpiBf16 {
    static constexpr bool PERM = true, AFTER_DRAIN = false;
    bf16_t* O; int ldc; const float* bias; bf16_t* O2; int split_col, ldc2;
    __device__ __forceinline__ void operator()(const f32x4 (&acc)[2][2][4][2], const Unit& u, int wr, int wc, int fr, int fq) const {
        const int row0 = u.pm * BM + wr * 64 + fr; const int col0 = u.pn * BM + wc * 32 + 8 * fq;
        const bool second = u.pn * BM >= split_col; bf16_t* const ob = second ? O2 : O; const int ld = second ? ldc2 : ldc, oc0 = second ? col0 - split_col : col0;
        f32x4 bv[2][2];
#pragma unroll
        for (int bj = 0; bj < 2; ++bj)
#pragma unroll
            for (int n = 0; n < 2; ++n) bv[bj][n] = bias ? *(const f32x4*)(bias + col0 + bj * HALF + 4 * n) : (f32x4){0.f, 0.f, 0.f, 0.f};
#pragma unroll
        for (int ai = 0; ai < 2; ++ai)
#pragma unroll
            for (int m = 0; m < 4; ++m) { bf16_t* rowp = ob + (size_t)(row0 + ai * HALF + m * 16) * ld + oc0;
#pragma unroll
                for (int bj = 0; bj < 2; ++bj) { f32x4 v0 = acc[ai][bj][m][0] + bv[bj][0], v1 = acc[ai][bj][m][1] + bv[bj][1];
                    if (ACT == 1) {
#pragma unroll
                        for (int i = 0; i < 4; ++i) { const float a = fmaxf(v0[i], 0.f), b = fmaxf(v1[i], 0.f); v0[i] = a * a; v1[i] = b * b; } }
                    u32x4 w; w.x = cvt_pk_bf16(v0[0], v0[1]); w.y = cvt_pk_bf16(v0[2], v0[3]); w.z = cvt_pk_bf16(v1[0], v1[1]); w.w = cvt_pk_bf16(v1[2], v1[3]);
                    *(u32x4*)(rowp + bj * HALF) = w; } }
    }
};
struct EpiIn {
    static constexpr bool PERM = true, AFTER_DRAIN = false;
    bf16_t* O; bf16_t* O2; const float* bias; const float* rope;
    __device__ __forceinline__ void operator()(const f32x4 (&acc)[2][2][4][2], const Unit& u, int wr, int wc, int fr, int fq) const {
        const int row0 = u.pm * BM + wr * 64 + fr, colt = u.pn * BM + wc * 32 + 8 * fq, g = (colt & 63) >> 3;
        const bool rot = rope != nullptr && u.pn < 5, second = rope == nullptr && u.pn >= 6;
        bf16_t* const ob = second ? O2 : O; const int ld = second ? 2560 : 1536, oc0 = second ? colt - 1536 : colt;
#pragma unroll
        for (int ai = 0; ai < 2; ++ai)
#pragma unroll
            for (int m = 0; m < 4; ++m) { const int row = row0 + ai * HALF + m * 16; bf16_t* rowp = ob + (size_t)row * ld;
                f32x4 t0 = {1.f, 0.f, 1.f, 0.f}, t1 = t0;
                if (rot) { t0 = *(const f32x4*)(rope + (size_t)row * 64 + 8 * g); t1 = *(const f32x4*)(rope + (size_t)row * 64 + 8 * g + 4); }
#pragma unroll
                for (int bj = 0; bj < 2; ++bj) { const int c = colt + bj * HALF, hd = c >> 6; f32x4 v0 = acc[ai][bj][m][0], v1 = acc[ai][bj][m][1];
                    if (rope) { v0 = v0 + (rot ? *(const f32x4*)(bias + hd * 64 + 4 * g) : *(const f32x4*)(bias + c)); v1 = v1 + (rot ? *(const f32x4*)(bias + hd * 64 + 32 + 4 * g) : *(const f32x4*)(bias + c + 4)); }
                    if (rot) { const float sc = c < 1024 ? 0.125f : 1.f; const f32x4 cs = {t0.x, t0.z, t1.x, t1.z}, sn = {t0.y, t0.w, t1.y, t1.w};
                        const f32x4 o1 = (v0 * cs - v1 * sn) * sc, o2 = (v1 * cs + v0 * sn) * sc;
                        u32x2 w1, w2; w1.x = cvt_pk_bf16(o1[0], o1[1]); w1.y = cvt_pk_bf16(o1[2], o1[3]); w2.x = cvt_pk_bf16(o2[0], o2[1]); w2.y = cvt_pk_bf16(o2[2], o2[3]);
                        *(u32x2*)(rowp + hd * 64 + 4 * g) = w1; *(u32x2*)(rowp + hd * 64 + 32 + 4 * g) = w2; }
                    else { v0 = v0 * 1.f; v1 = v1 * 1.f;
                        u32x4 w; w.x = cvt_pk_bf16(v0[0], v0[1]); w.y = cvt_pk_bf16(v0[2], v0[3]); w.z = cvt_pk_bf16(v1[0], v1[1]); w.w = cvt_pk_bf16(v1[2], v1[3]); *(u32x4*)(rowp + oc0 + bj * HALF) = w; } } }
    }
};
struct EpiF32 {
    static constexpr bool PERM = false, AFTER_DRAIN = false;
    float* C; int ldc; const float* bias;
    __device__ __forceinline__ void operator()(const f32x4 (&acc)[2][2][4][2], const Unit& u, int wr, int wc, int fr, int fq) const {
        const int row0 = u.pm * BM + wr * 64 + fr, col0 = u.pn * BM + wc * 32 + 4 * fq;
        f32x4 bv[2][2];
#pragma unroll
        for (int bj = 0; bj < 2; ++bj)
#pragma unroll
            for (int n = 0; n < 2; ++n) bv[bj][n] = bias ? *(const f32x4*)(bias + col0 + bj * HALF + n * 16) : (f32x4){0.f, 0.f, 0.f, 0.f};
#pragma unroll
        for (int ai = 0; ai < 2; ++ai)
#pragma unroll
            for (int m = 0; m < 4; ++m) { float* rowp = C + (size_t)(row0 + ai * HALF + m * 16) * ldc + col0;
#pragma unroll
                for (int bj = 0; bj < 2; ++bj)
#pragma unroll
                    for (int n = 0; n < 2; ++n) *(f32x4*)(rowp + bj * HALF + n * 16) = acc[ai][bj][m][n] + bv[bj][n]; }
    }
};
__device__ __forceinline__ float bf_lo(unsigned w) { return __builtin_bit_cast(float, w << 16); }
__device__ __forceinline__ float bf_hi(unsigned w) { return __builtin_bit_cast(float, w & 0xffff0000u); }
struct EpiGate {
    static constexpr bool PERM = false, AFTER_DRAIN = false;
    float* H; const bf16_t* PP; int ldc;
    __device__ __forceinline__ void operator()(const f32x4 (&acc)[2][2][4][2], const Unit& u, int wr, int wc, int fr, int fq) const {
        const int row0 = u.pm * BM + wr * 64 + fr, col0 = u.pn * BM + wc * 32 + 4 * fq;
#pragma unroll
        for (int ai = 0; ai < 2; ++ai)
#pragma unroll
            for (int m = 0; m < 4; ++m) { const size_t ro = (size_t)(row0 + ai * HALF + m * 16) * ldc + col0;
#pragma unroll
                for (int bj = 0; bj < 2; ++bj)
#pragma unroll
                    for (int n = 0; n < 2; ++n) { const size_t off = ro + bj * HALF + n * 16;
                        f32x4 hv = *(const f32x4*)(H + off); const u32x2 pv = *(const u32x2*)(PP + off); const f32x4 a = acc[ai][bj][m][n];
                        const float p0 = bf_lo(pv.x), p1 = bf_hi(pv.x), p2 = bf_lo(pv.y), p3 = bf_hi(pv.y);
                        hv[0] += p0 / (1.f + __expf(-a[0])); hv[1] += p1 / (1.f + __expf(-a[1])); hv[2] += p2 / (1.f + __expf(-a[2])); hv[3] += p3 / (1.f + __expf(-a[3]));
                        *(f32x4*)(H + off) = hv; } }
    }
};

template <class Epi, class Sched, bool ALIGN_EPI = false, bool SP2 = false>
__device__ __forceinline__ void gemm_phase(PG8_LAS unsigned char* lds, const Gemm g, const Sched& S, const Epi& E) {
    int tid_l = threadIdx.x; asm volatile("" : "+v"(tid_l));
    const int tid = tid_l, wid = __builtin_amdgcn_readfirstlane(tid >> 6), lane = tid & 63, wr = wid >> 2, wc = wid & 3, fr = lane & 15, fq = lane >> 4;
    const int K = g.K, nt = K / BK;
    unsigned voffA[2], voffB[2];
#pragma unroll
    for (int i = 0; i < 2; ++i) { int R, C; stage_rc(tid * 16 + i * 8192, R, C); const int Rb = Epi::PERM ? ((R & ~31) + perm32(R & 31)) : R;
        voffA[i] = (unsigned)(R * K + C) * 2u; voffB[i] = (unsigned)(Rb * K + C) * 2u; }
    const size_t kstep = (size_t)(BK * 2);
    const size_t hstep = (size_t)HALF * K * 2;
    const size_t tstep = 2 * hstep;
    const unsigned ldsw = (unsigned)wid * 1024u;
    const int aoff = lds_byte(wr * 64 + fr, fq * 8), boff = lds_byte(wc * 32 + fr, fq * 8);
#define PG8_SA(b, h) (((b) * 2 + (h)) * HTB)
#define PG8_SB(b, h) ((4 + (b) * 2 + (h)) * HTB)
#define PG8_STAGE(bufoff, gbase, voff) do { _Pragma("unroll") for (int _i = 0; _i < 2; ++_i) \
        __builtin_amdgcn_global_load_lds((const unsigned*)((const char*)(gbase) + (voff)[_i]), (PG8_LAS unsigned*)(lds + (bufoff) + ldsw + _i * 8192), 16, 0, 0); } while (0)
#define PG8_LDA(dst, b, h) do { _Pragma("unroll") for (int m = 0; m < 4; ++m) _Pragma("unroll") for (int k = 0; k < 2; ++k) dst[m][k] = *(const PG8_LAS bf16x8*)(lds + PG8_SA(b, h) + aoff + m * 2048 + k * 1024); } while (0)
#define PG8_LDB(dst, b, h) do { _Pragma("unroll") for (int n = 0; n < 2; ++n) _Pragma("unroll") for (int k = 0; k < 2; ++k) dst[n][k] = *(const PG8_LAS bf16x8*)(lds + PG8_SB(b, h) + boff + n * 2048 + k * 1024); } while (0)
#define PG8_MMA(ai, bj, At, Bt) do { __builtin_amdgcn_s_setprio(1); _Pragma("unroll") for (int m = 0; m < 4; ++m) _Pragma("unroll") for (int n = 0; n < 2; ++n) _Pragma("unroll") for (int k = 0; k < 2; ++k) \
        acc[ai][bj][m][n] = __builtin_amdgcn_mfma_f32_16x16x32_bf16(Bt[n][k], At[m][k], acc[ai][bj][m][n], 0, 0, 0); __builtin_amdgcn_s_setprio(0); } while (0)
#define PG8_WAIT_V(n) asm volatile("s_waitcnt vmcnt(" #n ")" ::: "memory")
#define PG8_WAIT_L(n) asm volatile("s_waitcnt lgkmcnt(" #n ")" ::: "memory")
#define PG8_BAR __builtin_amdgcn_s_barrier()
#define PG8_SCHED __builtin_amdgcn_sched_barrier(0)
    Unit cur, nxt; int ui = 0;
    if (!S.next(0, cur)) return;
    f32x4 acc[2][2][4][2];
#pragma unroll
    for (int a = 0; a < 2; ++a)
#pragma unroll
        for (int b = 0; b < 2; ++b)
#pragma unroll
            for (int m = 0; m < 4; ++m)
#pragma unroll
                for (int n = 0; n < 2; ++n) acc[a][b][m][n] = (f32x4){0.f, 0.f, 0.f, 0.f};
    bf16x8 At[4][2], B0[2][2], B1[2][2];
    const char* cA = (const char*)g.A + (size_t)cur.pm * tstep; const char* cB = (const char*)g.Bt + (size_t)cur.pn * tstep;
    S.a_ready(cur);
    if constexpr (SP2) {
        PG8_STAGE(PG8_SB(0, 0), cB, voffB); PG8_STAGE(PG8_SB(0, 1), cB + hstep, voffB); PG8_STAGE(PG8_SA(0, 0), cA, voffA); PG8_STAGE(PG8_SA(0, 1), cA + hstep, voffA);
        if (wr == 1) PG8_BAR;
        PG8_WAIT_V(2); PG8_BAR;
        PG8_STAGE(PG8_SB(1, 0), cB + kstep, voffB); PG8_STAGE(PG8_SA(1, 0), cA + kstep, voffA); PG8_STAGE(PG8_SB(1, 1), cB + hstep + kstep, voffB);
        PG8_WAIT_V(6); PG8_BAR;
    } else {
        PG8_STAGE(PG8_SB(0, 0), cB, voffB); PG8_STAGE(PG8_SA(0, 0), cA, voffA); PG8_STAGE(PG8_SB(0, 1), cB + hstep, voffB); PG8_STAGE(PG8_SA(0, 1), cA + hstep, voffA);
        if (wr == 1) PG8_BAR;
        PG8_WAIT_V(4); PG8_BAR;
        PG8_STAGE(PG8_SB(1, 0), cB + kstep, voffB); PG8_STAGE(PG8_SA(1, 0), cA + kstep, voffA); PG8_STAGE(PG8_SB(1, 1), cB + hstep + kstep, voffB);
        PG8_WAIT_V(6); PG8_BAR;
    }
    for (;;) {
        const bool has_next = S.next(ui + 1, nxt);
        const char* nA = has_next ? (const char*)g.A + (size_t)nxt.pm * tstep : cA; const char* nB = has_next ? (const char*)g.Bt + (size_t)nxt.pn * tstep : cB;
        for (int t = 0; t < nt; t += 2) {
            const bool last = (t == nt - 2);
            const char* a1 = cA + (size_t)(t + 1) * kstep;
            const char* a2 = last ? nA : cA + (size_t)(t + 2) * kstep; const char* b2 = last ? nB : cB + (size_t)(t + 2) * kstep;
            const char* a3 = a2 + kstep; const char* b3 = b2 + kstep;
            if (last && has_next) S.a_ready(nxt);
            if constexpr (SP2) {
            PG8_LDB(B0, 0, 0); PG8_LDB(B1, 0, 1); PG8_SCHED; PG8_LDA(At, 0, 0); PG8_STAGE(PG8_SA(1, 1), a1 + hstep, voffA);
            PG8_WAIT_V(8); PG8_WAIT_L(0); PG8_BAR; PG8_MMA(0, 0, At, B0); PG8_MMA(0, 1, At, B1); PG8_BAR; PG8_SCHED;
            PG8_LDA(At, 0, 1); PG8_STAGE(PG8_SB(0, 0), b2, voffB); PG8_STAGE(PG8_SB(0, 1), b2 + hstep, voffB); PG8_STAGE(PG8_SA(0, 0), a2, voffA);
            PG8_WAIT_V(8); PG8_WAIT_L(0); PG8_BAR; PG8_MMA(1, 0, At, B0); PG8_MMA(1, 1, At, B1); PG8_BAR; PG8_SCHED;
            PG8_LDB(B0, 1, 0); PG8_LDB(B1, 1, 1); PG8_SCHED; PG8_LDA(At, 1, 0); PG8_STAGE(PG8_SA(0, 1), a2 + hstep, voffA);
            PG8_WAIT_V(8); PG8_WAIT_L(0); PG8_BAR; PG8_MMA(0, 0, At, B0); PG8_MMA(0, 1, At, B1); PG8_BAR; PG8_SCHED;
            PG8_LDA(At, 1, 1); PG8_STAGE(PG8_SB(1, 0), b3, voffB); PG8_STAGE(PG8_SB(1, 1), b3 + hstep, voffB); PG8_STAGE(PG8_SA(1, 0), a3, voffA);
            PG8_WAIT_V(8); PG8_WAIT_L(0); PG8_BAR; PG8_MMA(1, 0, At, B0); PG8_MMA(1, 1, At, B1); PG8_BAR; PG8_SCHED;
            } else {
            PG8_LDB(B0, 0, 0); PG8_SCHED; PG8_LDA(At, 0, 0); PG8_STAGE(PG8_SA(1, 1), a1 + hstep, voffA);
            PG8_WAIT_L(8); PG8_BAR; PG8_WAIT_L(0); PG8_MMA(0, 0, At, B0); PG8_BAR; PG8_SCHED;
            PG8_LDB(B1, 0, 1); PG8_STAGE(PG8_SB(0, 0), b2, voffB);
            PG8_BAR; PG8_WAIT_L(0); PG8_MMA(0, 1, At, B1); PG8_BAR;
            PG8_LDA(At, 0, 1); PG8_STAGE(PG8_SA(0, 0), a2, voffA);
            PG8_BAR; PG8_WAIT_L(0); PG8_MMA(1, 0, At, B0); PG8_BAR; PG8_SCHED;
            PG8_STAGE(PG8_SB(0, 1), b2 + hstep, voffB);
            PG8_WAIT_V(6); PG8_BAR; PG8_MMA(1, 1, At, B1); PG8_BAR;
            PG8_LDB(B0, 1, 0); PG8_SCHED; PG8_LDA(At, 1, 0); PG8_STAGE(PG8_SA(0, 1), a2 + hstep, voffA);
            PG8_WAIT_L(8); PG8_BAR; PG8_WAIT_L(0); PG8_MMA(0, 0, At, B0); PG8_BAR; PG8_SCHED;
            PG8_LDB(B1, 1, 1); PG8_STAGE(PG8_SB(1, 0), b3, voffB);
            PG8_BAR; PG8_WAIT_L(0); PG8_MMA(0, 1, At, B1); PG8_BAR;
            PG8_LDA(At, 1, 1); PG8_STAGE(PG8_SA(1, 0), a3, voffA);
            PG8_BAR; PG8_WAIT_L(0); PG8_MMA(1, 0, At, B0); PG8_BAR; PG8_SCHED;
            PG8_STAGE(PG8_SB(1, 1), b3 + hstep, voffB);
            PG8_WAIT_V(6); PG8_BAR; PG8_MMA(1, 1, At, B1); PG8_BAR;
            }
        }
        if constexpr (ALIGN_EPI) { if (wr == 0) PG8_BAR; }
        if constexpr (!Epi::AFTER_DRAIN) { E(acc, cur, wr, wc, fr, fq); S.done(cur); }
        if (!has_next) break;
#pragma unroll
        for (int a = 0; a < 2; ++a)
#pragma unroll
            for (int b = 0; b < 2; ++b)
#pragma unroll
                for (int m = 0; m < 4; ++m)
#pragma unroll
                    for (int n = 0; n < 2; ++n) acc[a][b][m][n] = (f32x4){0.f, 0.f, 0.f, 0.f};
        cur = nxt; cA = nA; cB = nB; ++ui;
        if constexpr (ALIGN_EPI) { if (wr == 1) PG8_BAR; }
    }
    PG8_WAIT_V(0);
    if constexpr (!ALIGN_EPI) { if (wr == 0) PG8_BAR; }
    PG8_BAR;
    if constexpr (Epi::AFTER_DRAIN) { E.fused(acc, cur, wr, wc, fr, fq, lds, wid, lane); S.done(cur); }
#undef PG8_SA
#undef PG8_SB
#undef PG8_STAGE
#undef PG8_LDA
#undef PG8_LDB
#undef PG8_MMA
#undef PG8_WAIT_V
#undef PG8_WAIT_L
#undef PG8_BAR
#undef PG8_SCHED
}
}
constexpr int BATCH = 32, SEQ = 2048, DM = 1024, DEPTH = 4, M = BATCH * SEQ;
constexpr int FF = 4096, PLE = 256, NIN = 4112;
constexpr float EPS = 1e-6f;
constexpr int NWAVES = 8, NTHR = NWAVES * 64;
constexpr int PH_PER_LAYER = 14, NPHASE = 1 + DEPTH * PH_PER_LAYER;
constexpr size_t MiB = 1u << 20;
constexpr size_t WS_CTL = 0, CTL_ZERO_BYTES = 1 * MiB;
constexpr size_t WS_WIN = 1 * MiB, WS_WOUT = 17 * MiB, WS_WQKV = 21 * MiB, WS_WO = 27 * MiB, WS_WUP = 31 * MiB, WS_WDN = 63 * MiB, WS_WPLE = 95 * MiB, WS_WG = 97 * MiB;
constexpr size_t WS_WGATES = 105 * MiB, WS_GT = 106 * MiB, WS_ROPE = 110 * MiB;
constexpr size_t WS_DEN = 126 * MiB;
constexpr size_t WS_RA = 128 * MiB, WS_RB = 256 * MiB, WS_RC = 384 * MiB, WS_RD = 896 * MiB, WS_END = 1024 * MiB;
constexpr size_t WS_QKVA = 128 * MiB, WS_KWT = 320 * MiB, WS_X1 = 384 * MiB, WS_KT = 384 * MiB, WS_UT = 448 * MiB, WS_NW = 512 * MiB, WS_X2 = 576 * MiB, WS_VT = 896 * MiB, WS_ATT = 960 * MiB, WS_PT = 992 * MiB, WS_MIXED = 384 * MiB;
constexpr int CW_BAR = 4096;
constexpr int RING_BYTES = 131072, MISC_OFF = RING_BYTES, LDS_BYTES = RING_BYTES + 1024;

#define GAS __attribute__((address_space(1)))
#define LAS __attribute__((address_space(3)))
typedef unsigned short bf16;
typedef float f32x4 __attribute__((ext_vector_type(4)));
typedef float f32x2 __attribute__((ext_vector_type(2)));
typedef unsigned u32x4 __attribute__((ext_vector_type(4)));
typedef unsigned u32x2 __attribute__((ext_vector_type(2)));
#define LDS_WAIT() asm volatile("s_waitcnt lgkmcnt(0)" ::: "memory")
#define VM_WAIT() asm volatile("s_waitcnt vmcnt(0)" ::: "memory")
using pg8::bf_lo; using pg8::bf_hi;
typedef __bf16 bf16x2_t __attribute__((ext_vector_type(2)));
__device__ __forceinline__ unsigned pk2(float lo, float hi) { return pg8::cvt_pk_bf16(lo, hi); }
__device__ __forceinline__ unsigned pk2v(float lo, float hi) { const f32x2 v = {lo, hi}; const bf16x2_t b = __builtin_convertvector(v, bf16x2_t); return __builtin_bit_cast(unsigned, b); }
__device__ __forceinline__ float wave_sum(float v) {
#pragma unroll
    for (int o = 1; o < 64; o <<= 1) v += __shfl_xor(v, o);
    return v;
}
__device__ __forceinline__ float dot4(f32x4 a, f32x4 b) { return (a.x * b.x + a.y * b.y) + (a.z * b.z + a.w * b.w); }
__device__ __forceinline__ float sigmoid_f(float x) { return 1.f / (1.f + __expf(-x)); }
__device__ __forceinline__ float softplus_f(float x) { return x > 20.f ? x : log1pf(expf(x)); }

#define XB_TMO      128
#define XB_XCNT(j)  (256  + 64 * (j))
#define XB_XSUB(j)  (1280 + 64 * (j))
#define XB_XGEN(j)  (2304 + 64 * (j))
#define XB_TOP      3328
#define XB_TOPGEN   3392
#define XCD_BAR_WORDS 3456
#define XB_SPIN_CAP (1u << 18)

__device__ __forceinline__ unsigned xb_ld(unsigned* p)              { return __hip_atomic_load(p, __ATOMIC_RELAXED, __HIP_MEMORY_SCOPE_AGENT); }
__device__ __forceinline__ unsigned xb_add(unsigned* p, unsigned v) { return __hip_atomic_fetch_add(p, v, __ATOMIC_RELAXED, __HIP_MEMORY_SCOPE_AGENT); }
__device__ __forceinline__ unsigned xb_xcc_id() { return (unsigned)__builtin_amdgcn_s_getreg((3 << 11) | 20) & 0xFu; }
#define XB_SPIN(cond, bar) do { unsigned _sp = 0; while (cond) { __builtin_amdgcn_s_sleep(1); \
    if ((++_sp & 255u) == 0u) { if (xb_ld(&(bar)[XB_TMO])) break; if (_sp > XB_SPIN_CAP) { atomicAdd(&(bar)[XB_TMO], 1u); break; } } } } while (0)

struct XcdBarrier {
    unsigned* bar; unsigned x;
    volatile LAS unsigned* st;
};

__device__ __forceinline__ XcdBarrier xcd_barrier_post(unsigned* bar, volatile LAS unsigned* st) {
    XcdBarrier b; b.bar = bar; b.x = xb_xcc_id(); b.st = st;
    if (threadIdx.x == 0) (void)xb_add(&bar[XB_XCNT(b.x)], 1u);
    return b;
}
__device__ __forceinline__ void xcd_barrier_complete(unsigned* bar, unsigned x, unsigned& nloc, unsigned& nx) {
    const unsigned G = gridDim.x * gridDim.y * gridDim.z;
    unsigned sum, cnt, mine, sp = 0u;
    for (;;) {
        sum = 0u; cnt = 0u; mine = 0u;
#pragma unroll
        for (unsigned j = 0; j < 16; ++j) { const unsigned c = xb_ld(&bar[XB_XCNT(j)]); sum += c; cnt += (c > 0u) ? 1u : 0u; mine = (j == x) ? c : mine; }
        if (sum == G) break;
        __builtin_amdgcn_s_sleep(1);
        if ((++sp & 255u) == 0u) { if (xb_ld(&bar[XB_TMO])) break; if (sp > XB_SPIN_CAP) { atomicAdd(&bar[XB_TMO], 1u); break; } }
    }
    nloc = mine > 0u ? mine : 1u; nx = cnt > 0u ? cnt : 1u;
}

__device__ __forceinline__ void xcd_barrier(const XcdBarrier& b) {
    asm volatile("s_waitcnt vmcnt(0)" ::: "memory");
    __syncthreads();
    if (threadIdx.x == 0) {
        unsigned* bar = b.bar;
        __builtin_amdgcn_s_waitcnt(0);
        unsigned nloc = b.st[0], nx = b.st[1];
        if (nloc == 0u) { xcd_barrier_complete(bar, b.x, nloc, nx); b.st[0] = nloc; b.st[1] = nx; }
        const unsigned old = xb_add(&bar[XB_XSUB(b.x)], 1u);
        const unsigned gen = old / nloc;
        if (old + 1u == (gen + 1u) * nloc) {
            __builtin_amdgcn_fence(__ATOMIC_RELEASE, "agent");
            asm volatile("s_waitcnt vmcnt(0)" ::: "memory");
            const unsigned og = xb_add(&bar[XB_TOP], 1u);
            const unsigned tg = og / nx;
            if (og + 1u == (tg + 1u) * nx) xb_add(&bar[XB_TOPGEN], 1u);
            else XB_SPIN(xb_ld(&bar[XB_TOPGEN]) == tg, bar);
            __builtin_amdgcn_fence(__ATOMIC_ACQUIRE, "agent");
            xb_add(&bar[XB_XGEN(b.x)], 1u);
            asm volatile("s_waitcnt vmcnt(0)" ::: "memory");
        } else {
            XB_SPIN(xb_ld(&bar[XB_XGEN(b.x)]) == gen, bar);
            __builtin_amdgcn_fence(__ATOMIC_ACQUIRE, "agent");
            asm volatile("s_waitcnt vmcnt(0)" ::: "memory");
        }
    }
    __syncthreads();
}
struct Args {
    const float *x, *p; const int* pos; const float *gains, *w_in, *conv, *a_log, *dt_bias, *norm_a, *i_bias, *f_bias, *norm_b, *w_out, *w_qkv, *b_qkv, *sinks, *w_o, *b_o, *w_up, *w_down, *w_ple, *w_gate;
    float* out; unsigned char* ws;
    int ph_lo, ph_hi, dup_mask, dup_par;
};

template <bool ROPE_PERM = false> __device__ __forceinline__ void transpose_item(const float* src, int ld, int K, bf16* dst, LAS float* scr, int item, int nblk, int lane) {
    const int kb = item / nblk, nb = item % nblk, k0 = 64 * kb, n0 = 32 * nb;
#pragma unroll 8
    for (int i = 0; i < 32; ++i) { const int kk = 2 * i + (lane >> 5); scr[kk * 33 + (lane & 31)] = src[(size_t)(k0 + kk) * ld + n0 + (lane & 31)]; }
    LDS_WAIT(); asm volatile("" ::: "memory");
    const int c = lane & 7;
#pragma unroll
    for (int j = 0; j < 4; ++j) { const int n = (lane >> 3) + 8 * j; const LAS float* s = scr + (8 * c) * 33 + n;
        u32x4 o; o.x = pk2(s[0 * 33], s[1 * 33]); o.y = pk2(s[2 * 33], s[3 * 33]); o.z = pk2(s[4 * 33], s[5 * 33]); o.w = pk2(s[6 * 33], s[7 * 33]);
        int nd = n0 + n;
        if (ROPE_PERM && nd < 1280) { const int i = nd & 63; nd = (nd & ~63) + (i < 32 ? 8 * (i >> 2) + (i & 3) : 8 * ((i - 32) >> 2) + 4 + (i & 3)); }
        *(u32x4*)(dst + (size_t)nd * K + k0 + 8 * c) = o; }
    LDS_WAIT(); asm volatile("" ::: "memory");
}
__device__ __forceinline__ int gate_col(int c) { return c < 8 ? 1536 + c : 3592 + (c - 8); }

typedef const __attribute__((address_space(4))) Args* KArgs;
__device__ __forceinline__ KArgs kargs() { KArgs p = (KArgs)__builtin_amdgcn_kernarg_segment_ptr(); asm volatile("" : "+s"(p)); return p; }
__device__ __forceinline__ int fresh_tid() { int t = threadIdx.x; asm volatile("" : "+v"(t)); return t; }
__device__ __forceinline__ void prologue_phase(KArgs a, LAS unsigned char* lds, int gw, int NGW, int wave, int lane, int gtid, int NGT) {
    LAS float* scr = (LAS float*)(lds + wave * 16384);
    constexpr int I_IN = 16 * 16, I_SQ = 16 * 32, I_QKV = 16 * 48, I_UP = 16 * 128, I_DN = 64 * 32, I_PLE = 4 * 32;
    constexpr int NITEMS = 16 * I_IN + 2 * I_SQ + 2 * I_QKV + 2 * I_SQ + 4 * I_UP + 4 * I_DN + 4 * I_PLE + 4 * I_SQ;
    unsigned char* ws = a->ws;
    for (int it = gw; it < NITEMS; it += NGW) {
        int r = it;
        if (r < 16 * I_IN) { const int j = r / I_IN, e = j >> 3, s = j & 7, col0 = 512 * s + (s >= 3 ? 8 : 0) + (s >= 7 ? 8 : 0);
            transpose_item(a->w_in + (size_t)e * DM * NIN + col0, NIN, DM, (bf16*)(ws + WS_WIN) + ((size_t)e * 4096 + s * 512) * DM, scr, r % I_IN, 16, lane); continue; } r -= 16 * I_IN;
        if (r < 2 * I_SQ) { const int e = r / I_SQ; transpose_item(a->w_out + (size_t)e * DM * DM, DM, DM, (bf16*)(ws + WS_WOUT) + (size_t)e * DM * DM, scr, r % I_SQ, 32, lane); continue; } r -= 2 * I_SQ;
        if (r < 2 * I_QKV) { const int e = r / I_QKV; transpose_item<true>(a->w_qkv + (size_t)e * DM * 1536, 1536, DM, (bf16*)(ws + WS_WQKV) + (size_t)e * 1536 * DM, scr, r % I_QKV, 48, lane); continue; } r -= 2 * I_QKV;
        if (r < 2 * I_SQ) { const int e = r / I_SQ; transpose_item(a->w_o + (size_t)e * DM * DM, DM, DM, (bf16*)(ws + WS_WO) + (size_t)e * DM * DM, scr, r % I_SQ, 32, lane); continue; } r -= 2 * I_SQ;
        if (r < 4 * I_UP) { const int l = r / I_UP; transpose_item(a->w_up + (size_t)l * DM * FF, FF, DM, (bf16*)(ws + WS_WUP) + (size_t)l * FF * DM, scr, r % I_UP, 128, lane); continue; } r -= 4 * I_UP;
        if (r < 4 * I_DN) { const int l = r / I_DN; transpose_item(a->w_down + (size_t)l * FF * DM, DM, FF, (bf16*)(ws + WS_WDN) + (size_t)l * DM * FF, scr, r % I_DN, 32, lane); continue; } r -= 4 * I_DN;
        if (r < 4 * I_PLE) { const int l = r / I_PLE; transpose_item(a->w_ple + (size_t)l * PLE * DM, DM, PLE, (bf16*)(ws + WS_WPLE) + (size_t)l * DM * PLE, scr, r % I_PLE, 32, lane); continue; } r -= 4 * I_PLE;
        { const int l = r / I_SQ; transpose_item(a->w_gate + (size_t)l * DM * DM, DM, DM, (bf16*)(ws + WS_WG) + (size_t)l * DM * DM, scr, r % I_SQ, 32, lane); }
    }
    float* Wg = (float*)(a->ws + WS_WGATES);
    for (int i = gtid; i < 2 * 16 * 1024; i += NGT) { const int e = i >> 14, c = (i >> 10) & 15, k = i & 1023; Wg[i] = a->w_in[((size_t)e * 1024 + k) * NIN + gate_col(c)]; }
    f32x2* rope = (f32x2*)(a->ws + WS_ROPE);
    for (int i = gtid; i < M * 32; i += NGT) { const int m = i >> 5, d = i & 31;
        const float inv = (float)pow(10000.0, -(double)d / 32.0); const float ang = (float)a->pos[m] * inv; float sn, cs; sincosf(ang, &sn, &cs); rope[i] = (f32x2){cs, sn}; }
}

__device__ __forceinline__ void norm_phase(LAS unsigned char* lds, const float* hin, const float* g0, bf16* HN, bool even, const float* Wg, float* Gt, int gw, int NGW, int tid, int lane) {
    LAS f32x4* wl = (LAS f32x4*)lds;
    if (even) { for (int i = tid; i < 4096; i += NTHR) wl[i] = ((const f32x4*)Wg)[i]; __syncthreads(); }
    f32x4 gv[4];
#pragma unroll
    for (int j = 0; j < 4; ++j) gv[j] = ((const f32x4*)g0)[lane + 64 * j];
#pragma unroll 2
    for (int m = gw; m < M; m += NGW) {
        const f32x4* xr = (const f32x4*)(hin + (size_t)m * DM) + lane;
        f32x4 v[4]; float s = 0.f;
#pragma unroll
        for (int j = 0; j < 4; ++j) { v[j] = xr[64 * j]; s += dot4(v[j], v[j]); }
        const float rstd = rsqrtf(wave_sum(s) * (1.f / DM) + EPS);
        u32x2* o8 = (u32x2*)(HN + (size_t)m * DM) + lane;
#pragma unroll
        for (int j = 0; j < 4; ++j) { v[j] = v[j] * rstd * gv[j]; o8[64 * j] = (u32x2){pk2(v[j].x, v[j].y), pk2(v[j].z, v[j].w)}; }
        if (even) {
            float keep = 0.f;
#pragma unroll
            for (int c = 0; c < 16; ++c) { float d = 0.f;
#pragma unroll
                for (int j = 0; j < 4; ++j) d += dot4(v[j], wl[c * 256 + lane + 64 * j]);
                d = wave_sum(d); if (lane == c) keep = d; }
            if (lane < 16) Gt[(size_t)m * 16 + lane] = keep;
        }
    }
    if (even) __syncthreads();
}
struct Row16 { f32x4 v[4]; };
__device__ __forceinline__ Row16 ld_row_bf16(const bf16* row, int lane) { const u32x4 a = ((const u32x4*)row)[lane], b = ((const u32x4*)row)[lane + 64]; Row16 r;
    r.v[0] = (f32x4){bf_lo(a.x), bf_hi(a.x), bf_lo(a.y), bf_hi(a.y)}; r.v[1] = (f32x4){bf_lo(a.z), bf_hi(a.z), bf_lo(a.w), bf_hi(a.w)};
    r.v[2] = (f32x4){bf_lo(b.x), bf_hi(b.x), bf_lo(b.y), bf_hi(b.y)}; r.v[3] = (f32x4){bf_lo(b.z), bf_hi(b.z), bf_lo(b.w), bf_hi(b.w)}; return r; }
__device__ __forceinline__ Row16 ld_row_f32(const float* row, int lane) { const f32x4* p = (const f32x4*)row; Row16 r; r.v[0] = p[2 * lane]; r.v[1] = p[2 * lane + 1]; r.v[2] = p[128 + 2 * lane]; r.v[3] = p[128 + 2 * lane + 1]; return r; }
__device__ __forceinline__ void st_row_bf16(bf16* row, int lane, const Row16& r) {
    ((u32x4*)row)[lane] = (u32x4){pk2(r.v[0].x, r.v[0].y), pk2(r.v[0].z, r.v[0].w), pk2(r.v[1].x, r.v[1].y), pk2(r.v[1].z, r.v[1].w)};
    ((u32x4*)row)[lane + 64] = (u32x4){pk2(r.v[2].x, r.v[2].y), pk2(r.v[2].z, r.v[2].w), pk2(r.v[3].x, r.v[3].y), pk2(r.v[3].z, r.v[3].w)}; }
__device__ __forceinline__ void st_row_f32(float* row, int lane, const Row16& r) { f32x4* p = (f32x4*)row; p[2 * lane] = r.v[0]; p[2 * lane + 1] = r.v[1]; p[128 + 2 * lane] = r.v[2]; p[128 + 2 * lane + 1] = r.v[3]; }
__device__ __forceinline__ float row_sumsq(const Row16& r) { return (dot4(r.v[0], r.v[0]) + dot4(r.v[1], r.v[1])) + (dot4(r.v[2], r.v[2]) + dot4(r.v[3], r.v[3])); }
__device__ __forceinline__ void resid_a_phase(const bf16* mix, const float* hin32, bf16* hs, const float* g1, const float* g2, bf16* HN, int gw, int NGW, int lane) {
    const Row16 ga = ld_row_f32(g1, lane), gb = ld_row_f32(g2, lane);
    for (int m = gw; m < M; m += NGW) {
        const Row16 v = ld_row_bf16(mix + (size_t)m * DM, lane); Row16 h = hin32 ? ld_row_f32(hin32 + (size_t)m * DM, lane) : ld_row_bf16(hs + (size_t)m * DM, lane);
        const float r1 = rsqrtf(wave_sum(row_sumsq(v)) * (1.f / DM) + EPS);
#pragma unroll
        for (int j = 0; j < 4; ++j) h.v[j] = h.v[j] + v.v[j] * r1 * ga.v[j];
        st_row_bf16(hs + (size_t)m * DM, lane, h);
        const float r2 = rsqrtf(wave_sum(row_sumsq(h)) * (1.f / DM) + EPS);
#pragma unroll
        for (int j = 0; j < 4; ++j) h.v[j] = h.v[j] * r2 * gb.v[j];
        st_row_bf16(HN + (size_t)m * DM, lane, h);
    }
}
__device__ __forceinline__ void resid_b_phase(const bf16* ff, const bf16* hs, const float* g3, bf16* HB, const float* pl, bf16* PB, int gw, int NGW, int lane, int gtid, int NGT) {
    const Row16 ga = ld_row_f32(g3, lane);
    for (int m = gw; m < M; m += NGW) {
        const Row16 v = ld_row_bf16(ff + (size_t)m * DM, lane); Row16 h = ld_row_bf16(hs + (size_t)m * DM, lane);
        const float r1 = rsqrtf(wave_sum(row_sumsq(v)) * (1.f / DM) + EPS);
#pragma unroll
        for (int j = 0; j < 4; ++j) h.v[j] = h.v[j] + v.v[j] * r1 * ga.v[j];
        st_row_bf16(HB + (size_t)m * DM, lane, h);
    }
    for (int i = gtid; i < M * PLE / 8; i += NGT) { const f32x4 a = ((const f32x4*)pl)[2 * i], b = ((const f32x4*)pl)[2 * i + 1];
        ((u32x4*)PB)[i] = (u32x4){pk2(a.x, a.y), pk2(a.z, a.w), pk2(b.x, b.y), pk2(b.z, b.w)}; }
}
__device__ __forceinline__ void resid_c_phase(LAS unsigned char* lds, const bf16* gpre, const bf16* pp, const bf16* h2, bf16* hs, float* out32, bool has_next, const float* g0, bf16* HN, bool even_next, const float* Wg, float* Gt, int gw, int NGW, int tid, int lane) {
    LAS f32x4* wl = (LAS f32x4*)lds;
    if (has_next && even_next) { for (int i = tid; i < 4096; i += NTHR) wl[i] = ((const f32x4*)Wg)[i]; __syncthreads(); }
    const Row16 gv = ld_row_f32(g0, lane);
    for (int m = gw; m < M; m += NGW) {
        const Row16 g = ld_row_bf16(gpre + (size_t)m * DM, lane), p = ld_row_bf16(pp + (size_t)m * DM, lane); Row16 h = ld_row_bf16(h2 + (size_t)m * DM, lane);
#pragma unroll
        for (int j = 0; j < 4; ++j)
#pragma unroll
            for (int i = 0; i < 4; ++i) h.v[j][i] += p.v[j][i] * sigmoid_f(g.v[j][i]);
        if (has_next) {
            st_row_bf16(hs + (size_t)m * DM, lane, h);
            const float rstd = rsqrtf(wave_sum(row_sumsq(h)) * (1.f / DM) + EPS);
#pragma unroll
            for (int j = 0; j < 4; ++j) h.v[j] = h.v[j] * rstd * gv.v[j];
            st_row_bf16(HN + (size_t)m * DM, lane, h);
            if (even_next) {
                float keep = 0.f;
#pragma unroll
                for (int c = 0; c < 16; ++c) {
                    float d = (dot4(h.v[0], wl[c * 256 + 2 * lane]) + dot4(h.v[1], wl[c * 256 + 2 * lane + 1])) + (dot4(h.v[2], wl[c * 256 + 128 + 2 * lane]) + dot4(h.v[3], wl[c * 256 + 128 + 2 * lane + 1]));
                    d = wave_sum(d); if (lane == c) keep = d; }
                if (lane < 16) Gt[(size_t)m * 16 + lane] = keep;
            }
        } else st_row_f32(out32 + (size_t)m * DM, lane, h);
    }
    if (has_next && even_next) __syncthreads();
}
__device__ __forceinline__ void conv_phase(const bf16* X1, const float* convw  , bf16* QKVA, int gw, int NGW, int lane) {
    constexpr int RPW = 32;
    for (int blk = gw; blk < M / RPW; blk += NGW) {
        const int mb = blk * RPW;
#pragma unroll 1
        for (int j = 0; j < 3; ++j) {
            const int col = j * 512 + lane * 8;
            u32x4 h0, h1, h2;
            { const bool first = (mb & (SEQ - 1)) == 0; const u32x4 z = {0u, 0u, 0u, 0u};
              h0 = first ? z : *(const u32x4*)(X1 + (size_t)(mb - 3) * 1536 + col); h1 = first ? z : *(const u32x4*)(X1 + (size_t)(mb - 2) * 1536 + col); h2 = first ? z : *(const u32x4*)(X1 + (size_t)(mb - 1) * 1536 + col); }
            f32x4 w[4][2];
#pragma unroll
            for (int kk = 0; kk < 4; ++kk) { w[kk][0] = *(const f32x4*)(convw + kk * 1536 + col); w[kk][1] = *(const f32x4*)(convw + kk * 1536 + col + 4); }
#pragma unroll 1
            for (int r4 = 0; r4 < RPW; r4 += 4) {
                u32x4 cur[4];
#pragma unroll
                for (int rr = 0; rr < 4; ++rr) cur[rr] = *(const u32x4*)(X1 + (size_t)(mb + r4 + rr) * 1536 + col);
#pragma unroll
                for (int rr = 0; rr < 4; ++rr) {
                    const int m = mb + r4 + rr;
                    const u32x4 xs[4] = {rr == 0 ? h0 : (rr == 1 ? h1 : (rr == 2 ? h2 : cur[0])), rr == 0 ? h1 : (rr == 1 ? h2 : cur[rr - 2 < 0 ? 0 : rr - 2]), rr == 0 ? h2 : cur[rr - 1 < 0 ? 0 : rr - 1], cur[rr]};
                    float acc[8];
#pragma unroll
                    for (int i = 0; i < 8; ++i) acc[i] = 0.f;
#pragma unroll
                    for (int kk = 0; kk < 4; ++kk) { const u32x4 xv = xs[kk]; const f32x4 w0 = w[kk][0], w1 = w[kk][1];
                        acc[0] += bf_lo(xv.x) * w0.x; acc[1] += bf_hi(xv.x) * w0.y; acc[2] += bf_lo(xv.y) * w0.z; acc[3] += bf_hi(xv.y) * w0.w;
                        acc[4] += bf_lo(xv.z) * w1.x; acc[5] += bf_hi(xv.z) * w1.y; acc[6] += bf_lo(xv.w) * w1.z; acc[7] += bf_hi(xv.w) * w1.w; }
                    float ss = 0.f;
#pragma unroll
                    for (int i = 0; i < 8; ++i) { acc[i] = acc[i] / (1.f + __expf(-acc[i])); ss += acc[i] * acc[i]; }
                    if (j < 2) { ss += __shfl_xor(ss, 1); ss += __shfl_xor(ss, 2); ss += __shfl_xor(ss, 4); ss += __shfl_xor(ss, 8);
                        const float sc = rsqrtf(ss + EPS) * (j == 0 ? 0.08838834764831845f : 1.f);
#pragma unroll
                        for (int i = 0; i < 8; ++i) acc[i] *= sc; }
                    *(u32x4*)(QKVA + (size_t)m * 1536 + col) = (u32x4){pk2(acc[0], acc[1]), pk2(acc[2], acc[3]), pk2(acc[4], acc[5]), pk2(acc[6], acc[7])};
                }
                h0 = cur[1]; h1 = cur[2]; h2 = cur[3];
            }
        }
    }
}
__device__ __forceinline__ void rope_phase(bf16* QKV, const f32x2* rope, int gw, int NGW, int lane) {
#pragma unroll 2
    for (int m = gw; m < M; m += NGW) {
        const int grp = lane & 7; const f32x4* tb = (const f32x4*)(rope + (size_t)m * 32 + grp * 4); const f32x4 t0 = tb[0], t1 = tb[1];
        const float cs[4] = {t0.x, t0.z, t1.x, t1.z}, sn[4] = {t0.y, t0.w, t1.y, t1.w};
#pragma unroll
        for (int k = 0; k < 3; ++k) {
            if (k == 2 && lane >= 32) break;
            const int hh = (k < 2) ? ((lane + 64 * k) >> 3) : (lane >> 3); const float scale = (k < 2) ? 0.125f : 1.f;
            bf16* base = QKV + (size_t)m * 1536 + (k < 2 ? 0 : 1024) + hh * 64 + grp * 4;
            const u32x2 a = *(const u32x2*)base, b = *(const u32x2*)(base + 32);
            const float x1[4] = {bf_lo(a.x), bf_hi(a.x), bf_lo(a.y), bf_hi(a.y)}, x2[4] = {bf_lo(b.x), bf_hi(b.x), bf_lo(b.y), bf_hi(b.y)};
            float o1[4], o2[4];
#pragma unroll
            for (int i = 0; i < 4; ++i) { o1[i] = (x1[i] * cs[i] - x2[i] * sn[i]) * scale; o2[i] = (x2[i] * cs[i] + x1[i] * sn[i]) * scale; }
            *(u32x2*)base = (u32x2){pk2(o1[0], o1[1]), pk2(o1[2], o1[3])}; *(u32x2*)(base + 32) = (u32x2){pk2(o2[0], o2[1]), pk2(o2[2], o2[3])};
        }
    }
}
typedef short bf16x8 __attribute__((ext_vector_type(8)));
#define MFMA16(a, b, c) __builtin_amdgcn_mfma_f32_16x16x32_bf16(a, b, c, 0, 0, 0)
__device__ __forceinline__ bf16x8 pack8(f32x4 a, f32x4 b) { const u32x4 w = {pk2v(a.x, a.y), pk2v(a.z, a.w), pk2v(b.x, b.y), pk2v(b.z, b.w)}; return __builtin_bit_cast(bf16x8, w); }
__device__ __forceinline__ float bf2f(unsigned short v) { return __builtin_bit_cast(float, (unsigned)v << 16); }
__device__ __forceinline__ float rdlane(float v, int i) { return __builtin_bit_cast(float, __builtin_amdgcn_readlane(__builtin_bit_cast(int, v), i)); }
__device__ __forceinline__ float scan_add(float v, int lane) {
#pragma unroll
    for (int o = 1; o < 64; o <<= 1) { const float t = __shfl_up(v, o); if (lane >= o) v += t; }
    return v; }
__device__ __forceinline__ float scan_max(float v, int lane) {
#pragma unroll
    for (int o = 1; o < 64; o <<= 1) { const float t = __shfl_up(v, o); if (lane >= o) v = fmaxf(v, t); }
    return v; }
__device__ __forceinline__ int kperm(int ks, int q, int jj) { return 32 * ks + (jj < 4 ? 4 * q + jj : 16 + 4 * q + jj - 4); }
template <bool SCALE> __device__ __forceinline__ u32x4 tr_gather(const bf16* src  , int ld, int ks, int q, float esc_lane) {
    unsigned w[4];
#pragma unroll
    for (int j2 = 0; j2 < 4; ++j2) { const int r0 = kperm(ks, q, 2 * j2), r1 = r0 + 1; const unsigned short a = src[(size_t)r0 * ld], b = src[(size_t)r1 * ld];
        if (SCALE) { const float s0 = __shfl(esc_lane, r0), s1 = __shfl(esc_lane, r1); w[j2] = pk2(bf2f(a) * s0, bf2f(b) * s1); } else w[j2] = (unsigned)a | ((unsigned)b << 16); }
    return (u32x4){w[0], w[1], w[2], w[3]};
}
__device__ __forceinline__ u32x4 scale_frag(u32x4 raw, int ks, int q, float esc_lane) {
    unsigned w[4] = {raw.x, raw.y, raw.z, raw.w};
#pragma unroll
    for (int j2 = 0; j2 < 4; ++j2) { const int r0 = kperm(ks, q, 2 * j2); const float s0 = __shfl(esc_lane, r0), s1 = __shfl(esc_lane, r0 + 1); w[j2] = pk2(bf_lo(w[j2]) * s0, bf_hi(w[j2]) * s1); }
    return (u32x4){w[0], w[1], w[2], w[3]};
}
struct ScanBufs {
    bf16* QKVA;
    bf16* X2;
    float* Gt;
    bf16 *KT, *UT, *NW, *ATT;
    bf16 *KWT, *VT, *PT;
    float* DEN;
};
__device__ __forceinline__ void local_phase(LAS unsigned char* lds, const ScanBufs sb, const float* a_log, const float* dt_bias, const float* i_bias, const float* f_bias, int gw, int NGW, int wave, int lane) {
    LAS float* Lw = (LAS float*)(lds + wave * 16384);
    const int njobs = 2 * BATCH * 4 * (SEQ / 64), per = (njobs + NGW - 1) / NGW; const int lane_in = lane;
#pragma unroll 1
    for (int rj = 0; rj < per; ++rj) {
        const int job = gw * per + rj; if (job >= njobs) break;
        int lane = lane_in; asm volatile("" : "+v"(lane));
        const int x = lane & 15, q = lane >> 4;
        const int mixer = job & 1, cidx = job >> 1, c = cidx & 31, h = (cidx >> 5) & 3, b = cidx >> 7;
        const int m0 = b * SEQ + c * 64; const size_t cid = (size_t)cidx;
        float* gr = sb.Gt + (size_t)(m0 + lane) * 16;
        if (mixer == 0) {
            const float beta = 1.f / (1.f + expf(-gr[h])); const float g = -expf(a_log[h]) * softplus_f(gr[4 + h] + dt_bias[h]);
            const float gcum = scan_add(g, lane), eg = expf(gcum), glast = __shfl(gcum, 63);
            const bf16* kb = sb.QKVA + (size_t)m0 * 1536 + 512 + h * 128; const bf16* qb = sb.QKVA + (size_t)m0 * 1536 + h * 128; const bf16* vb = kb + 512;
            bf16x8 Kf[4][4], Qf[4][4];
#pragma unroll
            for (int t = 0; t < 4; ++t)
#pragma unroll
                for (int ks = 0; ks < 4; ++ks) { Kf[t][ks] = *(const bf16x8*)(kb + (size_t)(16 * t + x) * 1536 + 32 * ks + 8 * q); Qf[t][ks] = *(const bf16x8*)(qb + (size_t)(16 * t + x) * 1536 + 32 * ks + 8 * q); }
            float gj[4][4];
#pragma unroll
            for (int jt = 0; jt < 4; ++jt)
#pragma unroll
                for (int r = 0; r < 4; ++r) gj[jt][r] = __shfl(gcum, 16 * jt + 4 * q + r);
            bf16* attp = sb.ATT + cid * 4096;
#pragma unroll
            for (int it = 0; it < 4; ++it) {
                const float gi = __shfl(gcum, 16 * it + x), bi = __shfl(beta, 16 * it + x); f32x4 d2s[4];
#pragma unroll
                for (int jt = 0; jt < 4; ++jt) {
                    if (jt <= it) { f32x4 D1 = {0.f, 0.f, 0.f, 0.f}, D2 = D1;
#pragma unroll
                        for (int ks = 0; ks < 4; ++ks) { D1 = MFMA16(Kf[jt][ks], Kf[it][ks], D1); D2 = MFMA16(Kf[jt][ks], Qf[it][ks], D2); }
                        f32x4 lv;
#pragma unroll
                        for (int r = 0; r < 4; ++r) { const int j = 16 * jt + 4 * q + r, i = 16 * it + x; const float dec = __expf(fminf(gi - gj[jt][r], 0.f));
                            lv[r] = (j < i) ? bi * D1[r] * dec : 0.f; d2s[jt][r] = (j <= i) ? D2[r] * dec : 0.f; }
#pragma unroll
                        for (int r = 0; r < 4; ++r) Lw[(16 * jt + 4 * q + r) * 64 + 16 * it + x] = lv[r];
                    } else d2s[jt] = (f32x4){0.f, 0.f, 0.f, 0.f};
                }
#pragma unroll
                for (int kp = 0; kp < 2; ++kp) if (it >= 2 || kp == 0) *(bf16x8*)(attp + ((it * 2 + kp) * 64 + lane) * 8) = pack8(d2s[2 * kp], d2s[2 * kp + 1]);
            }
            { float* tab = (float*)(attp + 512); tab[lane] = eg; tab[64 + lane] = expf(glast - gcum); }
            bf16* ktp = sb.KT + cid * 8192;
            LDS_WAIT();
            float xv[64];
#pragma unroll
            for (int i = 0; i < 64; ++i) xv[i] = (i == lane) ? 1.f : 0.f;
#pragma unroll
            for (int j = 0; j < 63; ++j) {
#pragma unroll
                for (int g4 = (j + 1) / 4; g4 < 16; ++g4) { const f32x4 lc = *(const LAS f32x4*)(Lw + j * 64 + 4 * g4);
                    if (4 * g4 + 0 > j) xv[4 * g4 + 0] -= lc.x * xv[j]; if (4 * g4 + 1 > j) xv[4 * g4 + 1] -= lc.y * xv[j]; if (4 * g4 + 2 > j) xv[4 * g4 + 2] -= lc.z * xv[j]; if (4 * g4 + 3 > j) xv[4 * g4 + 3] -= lc.w * xv[j]; }
            }
            LDS_WAIT();
            { LAS unsigned short* TL = (LAS unsigned short*)Lw;
#pragma unroll
              for (int i = 0; i < 64; ++i) TL[i * 64 + ((((lane >> 3) ^ (i & 7)) << 3) | (lane & 7))] = (unsigned short)(pk2(xv[i], 0.f) & 0xffffu); }
            LDS_WAIT();
            bf16x8 Tf[4][2];
#pragma unroll
            for (int it = 0; it < 4; ++it)
#pragma unroll
                for (int ks = 0; ks < 2; ++ks) { const int row = 16 * it + x; const LAS unsigned char* tb = (const LAS unsigned char*)Lw + row * 128;
                    const int c0 = 32 * ks + 4 * q, c1 = c0 + 16;
                    const u32x2 lo = *(const LAS u32x2*)(tb + ((((c0 >> 3) ^ (row & 7)) << 4) | ((c0 & 7) << 1))), hi = *(const LAS u32x2*)(tb + ((((c1 >> 3) ^ (row & 7)) << 4) | ((c1 & 7) << 1)));
                    const u32x4 w = {lo.x, lo.y, hi.x, hi.y}; Tf[it][ks] = __builtin_bit_cast(bf16x8, w); }
            const float be = beta * eg;
            bf16* utp = sb.UT + cid * 8192;
#pragma unroll 4
            for (int et = 0; et < 8; ++et) {
                bf16x8 vfr[2];
#pragma unroll
                for (int ks = 0; ks < 2; ++ks) { const u32x4 gth = tr_gather<true>(vb + 16 * et + x, 1536, ks, q, beta); vfr[ks] = __builtin_bit_cast(bf16x8, gth); }
#pragma unroll
                for (int mt = 0; mt < 4; ++mt) { f32x4 acc = {0.f, 0.f, 0.f, 0.f};
#pragma unroll
                    for (int ks = 0; ks < 2; ++ks) acc = MFMA16(Tf[mt][ks], vfr[ks], acc);
                    *(u32x2*)(utp + (size_t)(16 * et + x) * 64 + 16 * mt + 4 * q) = (u32x2){pk2v(acc.x, acc.y), pk2v(acc.z, acc.w)}; }
            }
            bf16* nwp = sb.NW + cid * 8192;
#pragma unroll 2
            for (int kp2 = 0; kp2 < 4; ++kp2) {
                bf16x8 kfr[2][2];
#pragma unroll
                for (int dd = 0; dd < 2; ++dd)
#pragma unroll
                    for (int ks = 0; ks < 2; ++ks) { const int dt = 2 * kp2 + dd; const u32x4 raw = tr_gather<false>(kb + 16 * dt + x, 1536, ks, q, 0.f);
                        *(u32x4*)(ktp + ((dt * 2 + ks) * 64 + lane) * 8) = raw;
                        kfr[dd][ks] = __builtin_bit_cast(bf16x8, scale_frag(raw, ks, q, be)); }
#pragma unroll
                for (int it = 0; it < 4; ++it) { f32x4 a0 = {0.f, 0.f, 0.f, 0.f}, a1 = a0;
#pragma unroll
                    for (int ks = 0; ks < 2; ++ks) { a0 = MFMA16(kfr[0][ks], Tf[it][ks], a0); a1 = MFMA16(kfr[1][ks], Tf[it][ks], a1); }
                    a0 = a0 * -1.f; a1 = a1 * -1.f;
                    *(u32x4*)(nwp + ((it * 4 + kp2) * 64 + lane) * 8) = (u32x4){pk2v(a0.x, a0.y), pk2v(a0.z, a0.w), pk2v(a1.x, a1.y), pk2v(a1.z, a1.w)}; }
            }
            LDS_WAIT();
        } else {
            const float il = gr[8 + h] + i_bias[h]; const float fl = -softplus_f(-(gr[12 + h] + f_bias[h]));
            const float bcum = scan_add(fl, lane), t = il - bcum, pm = scan_max(t, lane), pml = __shfl(pm, 63);
            const float esc = __expf(t - pml);
            const bf16* qb = sb.X2 + (size_t)m0 * 2560 + 512 + h * 128; const bf16* kb = qb + 512; const bf16* vb = kb + 512;
            bf16x8 Kf[4][4], Qf[4][4];
#pragma unroll
            for (int tt = 0; tt < 4; ++tt)
#pragma unroll
                for (int ks = 0; ks < 4; ++ks) { Kf[tt][ks] = *(const bf16x8*)(kb + (size_t)(16 * tt + x) * 2560 + 32 * ks + 8 * q); Qf[tt][ks] = *(const bf16x8*)(qb + (size_t)(16 * tt + x) * 2560 + 32 * ks + 8 * q); }
            float tj[4][4];
#pragma unroll
            for (int jt = 0; jt < 4; ++jt)
#pragma unroll
                for (int r = 0; r < 4; ++r) tj[jt][r] = __shfl(t, 16 * jt + 4 * q + r);
            bf16* ptp = sb.PT + cid * 4096;
#pragma unroll
            for (int it = 0; it < 4; ++it) {
                const float pmi = __shfl(pm, 16 * it + x); f32x4 d2s[4];
#pragma unroll
                for (int jt = 0; jt < 4; ++jt) {
                    if (jt <= it) { f32x4 D2 = {0.f, 0.f, 0.f, 0.f};
#pragma unroll
                        for (int ks = 0; ks < 4; ++ks) D2 = MFMA16(Kf[jt][ks], Qf[it][ks], D2);
#pragma unroll
                        for (int r = 0; r < 4; ++r) { const int j = 16 * jt + 4 * q + r, i = 16 * it + x; d2s[jt][r] = (j <= i) ? D2[r] * 0.08838834764831845f * __expf(fminf(tj[jt][r] - pmi, 0.f)) : 0.f; }
                    } else d2s[jt] = (f32x4){0.f, 0.f, 0.f, 0.f};
                }
#pragma unroll
                for (int kp = 0; kp < 2; ++kp) if (it >= 2 || kp == 0) *(bf16x8*)(ptp + ((it * 2 + kp) * 64 + lane) * 8) = pack8(d2s[2 * kp], d2s[2 * kp + 1]);
            }
            { float* tab = (float*)(ptp + 512); tab[lane] = bcum; tab[64 + lane] = bcum + pm; }
            bf16* kwp = sb.KWT + cid * 8192; bf16* vtp = sb.VT + cid * 8192;
#pragma unroll 2
            for (int dt = 0; dt < 8; ++dt)
#pragma unroll
                for (int kp = 0; kp < 2; ++kp) { *(u32x4*)(kwp + ((dt * 2 + kp) * 64 + lane) * 8) = tr_gather<true>(kb + 16 * dt + x, 2560, kp, q, esc);
                    *(u32x4*)(vtp + ((dt * 2 + kp) * 64 + lane) * 8) = tr_gather<false>(vb + 16 * dt + x, 2560, kp, q, 0.f); }
        }
    }
}
constexpr int RC_NW = 0, RC_ATT = 16384, RC_KT = 24576, RC_QP = 40960, RC_BUF = 57344;
__device__ __forceinline__ void recur_stage(LAS unsigned char* buf, const bf16* f16a  , const bf16* f8  , const bf16* f16b  , const bf16* qbase  , int qpitch, int wave, int lane) {
#pragma unroll
    for (int k = 0; k < 5; ++k) { const int bl = wave + 8 * k;
        const bf16* src = bl < 16 ? f16a + bl * 512 : (bl < 24 ? f8 + (bl - 16) * 512 : f16b + (bl - 24) * 512);
        __builtin_amdgcn_global_load_lds((const unsigned*)(src + lane * 8), (LAS unsigned*)(buf + bl * 1024), 16, 0, 0); }
#pragma unroll
    for (int k = 0; k < 8; ++k) { const int P = (wave * 8 + k) * 256 + lane * 4, f = P >> 10, lp = (P & 1023) >> 4, jj0 = ((P & 15) >> 2) * 2, it = f >> 2, ks = f & 3, xp = lp & 15, qp = lp >> 4;
        const bf16* src = qbase + (size_t)(16 * it + xp) * qpitch + kperm(ks, qp, jj0);
        __builtin_amdgcn_global_load_lds((const unsigned*)src, (LAS unsigned*)(buf + RC_QP + (wave * 8 + k) * 256), 4, 0, 0); }
}
__device__ __forceinline__ void recur_phase(LAS unsigned char* lds, const ScanBufs sb, int G, int bid, int wave, int lane) {
    const int x = lane & 15, q = lane >> 4, et = wave;
#pragma unroll 1
    for (int u = bid; u < 2 * BATCH * 4; u += G) {
        const int mixer = u >> 7, b = (u & 127) >> 2, h = u & 3;
        const size_t cid0 = (size_t)((b * 4 + h) * 32);
        if (mixer == 0) {
            f32x4 S[8];
#pragma unroll
            for (int d = 0; d < 8; ++d) S[d] = (f32x4){0.f, 0.f, 0.f, 0.f};
            recur_stage(lds, sb.NW + cid0 * 8192, sb.ATT + cid0 * 4096, sb.KT + cid0 * 8192, sb.QKVA + (size_t)(b * SEQ) * 1536 + h * 128, 1536, wave, lane);
            __syncthreads();
#pragma unroll 1
            for (int c = 0; c < SEQ / 64; ++c) {
                const int m0 = b * SEQ + c * 64; const size_t cid = cid0 + c;
                const LAS unsigned char* buf = lds + (c & 1) * RC_BUF;
                { const int cn = c + 1 < SEQ / 64 ? c + 1 : c; const size_t cidn = cid0 + cn;
                  recur_stage(lds + ((c + 1) & 1) * RC_BUF, sb.NW + cidn * 8192, sb.ATT + cidn * 4096, sb.KT + cidn * 8192, sb.QKVA + (size_t)(b * SEQ + cn * 64) * 1536 + h * 128, 1536, wave, lane); }
                const bf16* utp = sb.UT + cid * 8192 + (size_t)(16 * et + x) * 64;
                const LAS float* tab = (const LAS float*)(buf + RC_ATT + 1024);
                bf16x8 Sb[4];
#pragma unroll
                for (int ks = 0; ks < 4; ++ks) Sb[ks] = pack8(S[2 * ks], S[2 * ks + 1]);
                f32x4 vn[4];
                { bf16x8 fr[16]; u32x2 uu[4];
#pragma unroll
                  for (int i = 0; i < 16; ++i) fr[i] = *(const LAS bf16x8*)(buf + RC_NW + (i * 64 + lane) * 16);
#pragma unroll
                  for (int mt = 0; mt < 4; ++mt) uu[mt] = *(const u32x2*)(utp + 16 * mt + 4 * q);
                  __builtin_amdgcn_sched_barrier(0);
#pragma unroll
                  for (int mt = 0; mt < 4; ++mt) { f32x4 acc = {bf_lo(uu[mt].x), bf_hi(uu[mt].x), bf_lo(uu[mt].y), bf_hi(uu[mt].y)};
#pragma unroll
                    for (int ks = 0; ks < 4; ++ks) acc = MFMA16(fr[mt * 4 + ks], Sb[ks], acc);
                    vn[mt] = acc; } }
                bf16x8 vb2[2] = {pack8(vn[0], vn[1]), pack8(vn[2], vn[3])};
                bf16x8 fq[16], fa[8]; float egl[4];
#pragma unroll
                for (int i = 0; i < 16; ++i) fq[i] = *(const LAS bf16x8*)(buf + RC_QP + (i * 64 + lane) * 16);
#pragma unroll
                for (int i = 0; i < 8; ++i) if (i >= 4 || (i & 1) == 0) fa[i] = *(const LAS bf16x8*)(buf + RC_ATT + (i * 64 + lane) * 16);
#pragma unroll
                for (int it = 0; it < 4; ++it) egl[it] = tab[16 * it + x];
                __builtin_amdgcn_sched_barrier(0);
#pragma unroll
                for (int it = 0; it < 4; ++it) { f32x4 acc = {0.f, 0.f, 0.f, 0.f};
#pragma unroll
                    for (int ks = 0; ks < 4; ++ks) acc = MFMA16(Sb[ks], fq[it * 4 + ks], acc);
                    acc = acc * egl[it];
#pragma unroll
                    for (int kp = 0; kp < 2; ++kp) if (it >= 2 || kp == 0) acc = MFMA16(vb2[kp], fa[it * 2 + kp], acc);
                    *(u32x2*)(sb.QKVA + (size_t)(m0 + 16 * it + x) * 1536 + 512 + h * 128 + 16 * et + 4 * q) = (u32x2){pk2v(acc.x, acc.y), pk2v(acc.z, acc.w)}; }
                f32x4 vs[4];
#pragma unroll
                for (int mt = 0; mt < 4; ++mt) { const f32x4 kk = *(const LAS f32x4*)(tab + 64 + 16 * mt + 4 * q); vs[mt] = vn[mt] * kk; }
                const bf16x8 vsb[2] = {pack8(vs[0], vs[1]), pack8(vs[2], vs[3])};
                const float gam = tab[63];
                { bf16x8 fk[16];
#pragma unroll
                  for (int i = 0; i < 16; ++i) fk[i] = *(const LAS bf16x8*)(buf + RC_KT + (i * 64 + lane) * 16);
                  __builtin_amdgcn_sched_barrier(0);
#pragma unroll
                  for (int dt = 0; dt < 8; ++dt) { f32x4 acc = S[dt] * gam;
#pragma unroll
                    for (int kp = 0; kp < 2; ++kp) acc = MFMA16(fk[dt * 2 + kp], vsb[kp], acc);
                    S[dt] = acc; } }
                __syncthreads();
            }
        } else {
            f32x4 Cs[8], Ce[8]; float mrun = 0.f;
#pragma unroll
            for (int d = 0; d < 8; ++d) { Cs[d] = (f32x4){0.f, 0.f, 0.f, 0.f}; Ce[d] = Cs[d]; }
            const short one = (x == 0) ? (short)0x3F80 : (short)0; const bf16x8 ones = {one, one, one, one, one, one, one, one};
            recur_stage(lds, sb.KWT + cid0 * 8192, sb.PT + cid0 * 4096, sb.KWT + cid0 * 8192, sb.X2 + (size_t)(b * SEQ) * 2560 + 512 + h * 128, 2560, wave, lane);
            __syncthreads();
#pragma unroll 1
            for (int c = 0; c < SEQ / 64; ++c) {
                const int m0 = b * SEQ + c * 64; const size_t cid = cid0 + c;
                const LAS unsigned char* buf = lds + (c & 1) * RC_BUF;
                { const int cn = c + 1 < SEQ / 64 ? c + 1 : c; const size_t cidn = cid0 + cn;
                  recur_stage(lds + ((c + 1) & 1) * RC_BUF, sb.KWT + cidn * 8192, sb.PT + cidn * 4096, sb.KWT + cidn * 8192, sb.X2 + (size_t)(b * SEQ + cn * 64) * 2560 + 512 + h * 128, 2560, wave, lane); }
                const bf16* vtp = sb.VT + cid * 8192;
                const LAS float* tab = (const LAS float*)(buf + RC_ATT + 1024);
                bf16x8 Cb[4], Eb[4];
#pragma unroll
                for (int ks = 0; ks < 4; ++ks) { Cb[ks] = pack8(Cs[2 * ks], Cs[2 * ks + 1]); Eb[ks] = pack8(Ce[2 * ks], Ce[2 * ks + 1]); }
                const bf16x8 vf[2] = {*(const bf16x8*)(vtp + ((et * 2 + 0) * 64 + lane) * 8), *(const bf16x8*)(vtp + ((et * 2 + 1) * 64 + lane) * 8)};
#pragma unroll
                for (int it = 0; it < 4; ++it) {
                    bf16x8 fq[16], fp[8];
#pragma unroll
                    for (int ks = 0; ks < 4; ++ks) fq[it * 4 + ks] = *(const LAS bf16x8*)(buf + RC_QP + ((it * 4 + ks) * 64 + lane) * 16);
#pragma unroll
                    for (int kp = 0; kp < 2; ++kp) if (it >= 2 || kp == 0) fp[it * 2 + kp] = *(const LAS bf16x8*)(buf + RC_ATT + ((it * 2 + kp) * 64 + lane) * 16);
                    const float bc = tab[16 * it + x], mi = tab[64 + 16 * it + x];
                    __builtin_amdgcn_sched_barrier(0);
                    const float a = bc + mrun, mt = fmaxf(a, mi), f1 = __expf(a - mt) * 0.08838834764831845f, f2 = __expf(mi - mt);
                    f32x4 a1 = {0.f, 0.f, 0.f, 0.f}, aP = a1, e1 = a1, eP = a1;
#pragma unroll
                    for (int ks = 0; ks < 4; ++ks) { const bf16x8 qf = fq[it * 4 + ks];
                        a1 = MFMA16(Cb[ks], qf, a1); if (wave == 0) e1 = MFMA16(Eb[ks], qf, e1); }
#pragma unroll
                    for (int kp = 0; kp < 2; ++kp) if (it >= 2 || kp == 0) { const bf16x8 pf = fp[it * 2 + kp]; aP = MFMA16(vf[kp], pf, aP); if (wave == 0) eP = MFMA16(ones, pf, eP); }
                    const f32x4 nm = a1 * f1 + aP * f2;
                    *(u32x2*)(sb.X2 + (size_t)(m0 + 16 * it + x) * 2560 + 1024 + h * 128 + 16 * et + 4 * q) = (u32x2){pk2(nm.x, nm.y), pk2(nm.z, nm.w)};
                    if (wave == 0 && q == 0) sb.DEN[(size_t)(m0 + 16 * it + x) * 4 + h] = fmaxf(fabsf(e1.x * f1 + eP.x * f2), __expf(-mt));
                }
                const float blast = tab[63], wsmax = tab[127];
                const float mnew = fmaxf(blast + mrun, wsmax), sc = __expf(blast + mrun - mnew), s2 = __expf(wsmax - mnew); mrun = mnew;
                bf16x8 fk[16];
#pragma unroll
                for (int i = 0; i < 16; ++i) fk[i] = *(const LAS bf16x8*)(buf + RC_KT + (i * 64 + lane) * 16);
                __builtin_amdgcn_sched_barrier(0);
#pragma unroll
                for (int dt = 0; dt < 8; ++dt) { f32x4 dC = {0.f, 0.f, 0.f, 0.f}, dE = dC;
#pragma unroll
                    for (int kp = 0; kp < 2; ++kp) { const bf16x8 kf = fk[dt * 2 + kp]; dC = MFMA16(kf, vf[kp], dC); if (wave == 0) dE = MFMA16(kf, ones, dE); }
                    Cs[dt] = Cs[dt] * sc + dC * s2; if (wave == 0) Ce[dt] = Ce[dt] * sc + dE * s2; }
                __syncthreads();
            }
        }
    }
}
__device__ __forceinline__ void post_phase(const ScanBufs sb, const float* norm_a, const float* norm_b, bf16* MIXED, int gw, int NGW, int lane) {
    const int hh = lane >> 3, sub = (lane & 7) * 16;
#pragma unroll 2
    for (int m = gw; m < M; m += NGW) {
        const bool isA = hh < 4; const int h = hh & 3;
        const bf16* src = isA ? sb.QKVA + (size_t)m * 1536 + 512 + h * 128 + sub : sb.X2 + (size_t)m * 2560 + 1024 + h * 128 + sub;
        const bf16* gsrc = sb.X2 + (size_t)m * 2560 + (isA ? 0 : 2048) + h * 128 + sub;
        const float* gn = (isA ? norm_a : norm_b + h * 128) + sub;
        const u32x4 r0 = *(const u32x4*)src, r1 = *(const u32x4*)(src + 8), z0 = *(const u32x4*)gsrc, z1 = *(const u32x4*)(gsrc + 8);
        float v[16] = {bf_lo(r0.x), bf_hi(r0.x), bf_lo(r0.y), bf_hi(r0.y), bf_lo(r0.z), bf_hi(r0.z), bf_lo(r0.w), bf_hi(r0.w), bf_lo(r1.x), bf_hi(r1.x), bf_lo(r1.y), bf_hi(r1.y), bf_lo(r1.z), bf_hi(r1.z), bf_lo(r1.w), bf_hi(r1.w)};
        const float z[16] = {bf_lo(z0.x), bf_hi(z0.x), bf_lo(z0.y), bf_hi(z0.y), bf_lo(z0.z), bf_hi(z0.z), bf_lo(z0.w), bf_hi(z0.w), bf_lo(z1.x), bf_hi(z1.x), bf_lo(z1.y), bf_hi(z1.y), bf_lo(z1.z), bf_hi(z1.z), bf_lo(z1.w), bf_hi(z1.w)};
        const float dinv = isA ? 1.f : 1.f / sb.DEN[(size_t)m * 4 + h];
        float ss = 0.f;
#pragma unroll
        for (int i = 0; i < 16; ++i) { v[i] *= dinv; ss += v[i] * v[i]; }
        ss += __shfl_xor(ss, 1); ss += __shfl_xor(ss, 2); ss += __shfl_xor(ss, 4);
        const float rstd = rsqrtf(ss * (1.f / 128.f) + EPS);
        float y[16];
#pragma unroll
        for (int i = 0; i < 16; ++i) { const float sg = sigmoid_f(z[i]); y[i] = v[i] * rstd * gn[i] * (isA ? z[i] * sg : sg); }
        u32x4* dst = (u32x4*)(MIXED + (size_t)m * 1024 + lane * 16);
        dst[0] = (u32x4){pk2(y[0], y[1]), pk2(y[2], y[3]), pk2(y[4], y[5]), pk2(y[6], y[7])}; dst[1] = (u32x4){pk2(y[8], y[9]), pk2(y[10], y[11]), pk2(y[12], y[13]), pk2(y[14], y[15])};
    }
}
typedef short v4i16_t __attribute__((ext_vector_type(4)));
constexpr int AT_VROW = 80;
constexpr int AT_K_BYTES = 256 * 128, AT_V_BYTES = 272 * AT_VROW * 2;
__device__ __forceinline__ void attn_phase(LAS unsigned char* lds, int tid, int wave, const bf16* QKV, const float* sinks, bf16* O, int G, int bid) {
    LAS unsigned char* KL = lds; LAS unsigned char* VL = lds + AT_K_BYTES;
    const int lane = tid & 63, x = lane & 15, q = lane >> 4, g = wave >> 1, qh = wave & 1;
    u32x4 kreg[4], vreg[4];
#define AT_LOAD_KV(uu) do { const int b_ = (uu) >> 6, kvh_ = ((uu) >> 4) & 3, jb_ = (uu) & 15; _Pragma("unroll") for (int i = 0; i < 4; ++i) { const int item = tid + 512 * i, r = item >> 3, ch = item & 7, sk = (jb_ - 1) * 128 + r; \
        kreg[i] = (u32x4){0u, 0u, 0u, 0u}; vreg[i] = kreg[i]; if (sk >= 0) { const bf16* src = QKV + (size_t)(b_ * SEQ + sk) * 1536 + 1024 + kvh_ * 64 + ch * 8; kreg[i] = *(const u32x4*)src; vreg[i] = *(const u32x4*)(src + 256); } } } while (0)
    if (bid < BATCH * 4 * 16) AT_LOAD_KV(bid);
#pragma unroll 1
    for (int u = bid; u < BATCH * 4 * 16; u += G) {
        const int b = u >> 6, kvh = (u >> 4) & 3, jb = u & 15;
#pragma unroll
        for (int i = 0; i < 4; ++i) { const int item = tid + 512 * i, r = item >> 3, ch = item & 7;
            *(LAS u32x4*)(KL + r * 128 + ((ch ^ (r & 7)) << 4)) = kreg[i]; *(LAS u32x4*)(VL + r * (AT_VROW * 2) + ch * 16) = vreg[i]; }
        if (tid < 128) { const int r = 256 + (tid >> 3), ch = tid & 7; unsigned z0 = 0u; asm volatile("" : "+v"(z0));
            *(LAS u32x4*)(VL + r * (AT_VROW * 2) + ch * 16) = (u32x4){z0, z0, z0, z0}; }
        __syncthreads();
        if (u + G < BATCH * 4 * 16) AT_LOAD_KV(u + G);
        const int hq = kvh * 4 + g; const float sink = sinks[hq];
        const size_t mq = (size_t)b * SEQ + jb * 128 + 64 * qh;
        bf16x8 Qn[2];
#pragma unroll
        for (int ks = 0; ks < 2; ++ks) Qn[ks] = *(const bf16x8*)(QKV + (mq + x) * 1536 + hq * 64 + 32 * ks + 8 * q);
#pragma unroll 1
        for (int nt = 0; nt < 4; ++nt) {
            const bf16x8 Qf[2] = {Qn[0], Qn[1]};
            { const int nn = nt < 3 ? nt + 1 : 3;
#pragma unroll
              for (int ks = 0; ks < 2; ++ks) Qn[ks] = *(const bf16x8*)(QKV + (mq + 16 * nn + x) * 1536 + hq * 64 + 32 * ks + 8 * q); }
            f32x4 s[9]; float mx = -3.0e38f;
            bf16x8 kf[9][2];
#pragma unroll
            for (int j = 0; j < 9; ++j) { const int r = 64 * qh + 16 * (nt + j) + x;
#pragma unroll
                for (int ks = 0; ks < 2; ++ks) kf[j][ks] = *(const LAS bf16x8*)(KL + r * 128 + (((4 * ks + q) ^ (r & 7)) << 4)); }
            __builtin_amdgcn_sched_barrier(0);
#pragma unroll
            for (int j = 0; j < 9; ++j) { const int kt = nt + j;
                f32x4 acc = {0.f, 0.f, 0.f, 0.f};
#pragma unroll
                for (int ks = 0; ks < 2; ++ks) acc = MFMA16(kf[j][ks], Qf[ks], acc);
#pragma unroll
                for (int rg = 0; rg < 4; ++rg) { const int diff = 16 * j + 4 * q + rg - x, ra = 64 * qh + 16 * kt + 4 * q + rg;
                    const bool valid = diff >= 1 && diff <= 128 && (jb - 1) * 128 + ra >= 0;
                    acc[rg] = valid ? acc[rg] : -3.0e38f; mx = fmaxf(mx, acc[rg]); }
                s[j] = acc; }
            mx = fmaxf(mx, __shfl_xor(mx, 16)); mx = fmaxf(mx, __shfl_xor(mx, 32)); mx = fmaxf(mx, sink);
            float sum = 0.f;
#pragma unroll
            for (int j = 0; j < 9; ++j)
#pragma unroll
                for (int rg = 0; rg < 4; ++rg) { const float p = (s[j][rg] > -1.0e38f) ? __expf(s[j][rg] - mx) : 0.f; s[j][rg] = p; sum += p; }
            sum += __shfl_xor(sum, 16); sum += __shfl_xor(sum, 32);
            const float inv = 1.f / (sum + __expf(sink - mx));
            bf16x8 Pf[5];
#pragma unroll
            for (int j2 = 0; j2 < 4; ++j2) Pf[j2] = pack8(s[2 * j2], s[2 * j2 + 1]);
            Pf[4] = pack8(s[8], (f32x4){0.f, 0.f, 0.f, 0.f});
            bf16x8 vf[4][5];
#pragma unroll
            for (int dt = 0; dt < 4; ++dt)
#pragma unroll
                for (int j2 = 0; j2 < 5; ++j2) { const int kb = 64 * qh + 16 * (nt + 2 * j2) + 4 * q + (x >> 2);
                    const LAS unsigned char* p0 = VL + kb * (AT_VROW * 2) + (16 * dt + 4 * (x & 3)) * 2;
                    const v4i16_t lo = __builtin_amdgcn_ds_read_tr16_b64_v4i16((LAS v4i16_t*)p0), hi = __builtin_amdgcn_ds_read_tr16_b64_v4i16((LAS v4i16_t*)(p0 + 16 * AT_VROW * 2));
                    vf[dt][j2] = (bf16x8){lo[0], lo[1], lo[2], lo[3], hi[0], hi[1], hi[2], hi[3]}; }
            __builtin_amdgcn_sched_barrier(0);
#pragma unroll
            for (int dt = 0; dt < 4; ++dt) { f32x4 acc = {0.f, 0.f, 0.f, 0.f};
#pragma unroll
                for (int j2 = 0; j2 < 5; ++j2) acc = MFMA16(vf[dt][j2], Pf[j2], acc);
                acc = acc * inv;
                *(u32x2*)(O + (mq + 16 * nt + x) * 1024 + hq * 64 + 16 * dt + 4 * q) = (u32x2){pk2v(acc.x, acc.y), pk2v(acc.z, acc.w)}; }
        }
        __syncthreads();
    }
}
#ifndef N_LAUNCH_MODE
#define N_LAUNCH_MODE 0
#endif
__global__ void __launch_bounds__(NTHR, 2) trunk_fwd(Args a_unused) {
    extern __shared__ __attribute__((aligned(16))) unsigned char lds_raw[];
    LAS unsigned char* lds = (LAS unsigned char*)lds_raw;
    volatile LAS unsigned* MISC = (volatile LAS unsigned*)(lds + MISC_OFF);
    if (threadIdx.x < 64) MISC[threadIdx.x] = 0u;
    __syncthreads();
    int lo, hi; XcdBarrier bar;
    int dupm = 0, dupp = 0; (void)dupm; (void)dupp;
    { KArgs a = kargs(); lo = a->ph_lo; hi = a->ph_hi; dupm = a->dup_mask; dupp = a->dup_par; unsigned* ctl = (unsigned*)(a->ws + WS_CTL);
      bar.bar = ctl + CW_BAR; bar.x = 0; bar.st = MISC + 8;
      if (hi - lo > 1) bar = xcd_barrier_post(ctl + CW_BAR, MISC + 8); }
#define IN(k) (lo <= (k) && (k) < hi)
#if defined(PROBE_DUP_MASK)
#define REP(k) _Pragma("unroll 1") for (int rep_ = 0; rep_ <= (((dupm >> (k)) & 1) && (dupp == 0 || dupp == 1 + (L & 1)) ? 1 : 0); ++rep_)
#else
#define REP(k)
#endif
#if defined(PROBE_BAR2)
#define SEAM(k) do { if (IN(k) && IN((k) + 1)) { xcd_barrier(bar); xcd_barrier(bar); } } while (0)
#else
#define SEAM(k) do { if (IN(k) && IN((k) + 1)) xcd_barrier(bar); } while (0)
#endif
#define ENV KArgs a = kargs(); const int tid = fresh_tid(), lane = tid & 63, wave = __builtin_amdgcn_readfirstlane(tid >> 6); const int G = gridDim.x, bid = blockIdx.x, gw = bid * NWAVES + wave, NGW = G * NWAVES, gtid = bid * NTHR + tid, NGT = G * NTHR; \
    unsigned char* ws = a->ws; bf16* RA = (bf16*)(ws + WS_RA); bf16* RB = (bf16*)(ws + WS_RB); bf16* RC = (bf16*)(ws + WS_RC); bf16* RD = (bf16*)(ws + WS_RD); float* Gt = (float*)(ws + WS_GT); \
    (void)lane; (void)wave; (void)gw; (void)NGW; (void)gtid; (void)NGT; (void)RA; (void)RB; (void)RC; (void)RD; (void)Gt; (void)G; (void)bid

    if (IN(0)) { ENV; prologue_phase(a, lds, gw, NGW, wave, lane, gtid, NGT);
#if defined(PROBE_DUP_MASK)
        if (dupm & (1 << 20)) prologue_phase(a, lds, gw, NGW, wave, lane, gtid, NGT);
#endif
    }
    SEAM(0);
#define SCANBUFS ScanBufs sb; sb.QKVA = (bf16*)(ws + WS_QKVA); sb.X2 = (bf16*)(ws + WS_X2); sb.Gt = Gt; sb.KT = (bf16*)(ws + WS_KT); sb.UT = (bf16*)(ws + WS_UT); sb.NW = (bf16*)(ws + WS_NW); sb.ATT = (bf16*)(ws + WS_ATT); \
    sb.KWT = (bf16*)(ws + WS_KWT); sb.VT = (bf16*)(ws + WS_VT); sb.PT = (bf16*)(ws + WS_PT); sb.DEN = (float*)(ws + WS_DEN)
#pragma unroll 1
    for (int L = 0; L < DEPTH; ++L) {
        const int pb = 1 + L * PH_PER_LAYER; const bool even = (L & 1) == 0; const int e = L >> 1;
        if (L == 0 && IN(pb + 0)) REP(0) { ENV; const float* hin = a->x;
            norm_phase(lds, hin, a->gains + (size_t)L * 4 * DM, RA, even, (const float*)(ws + WS_WGATES) + (size_t)e * 16 * 1024, Gt, gw, NGW, tid, lane); }
        if (L == 0) SEAM(pb + 0);
        if (IN(pb + 1)) REP(1) { ENV;
            const int N = even ? 4096 : 1536;
            pg8::Gemm g{RA, even ? (const bf16*)(ws + WS_WIN) + (size_t)e * 4096 * 1024 : (const bf16*)(ws + WS_WQKV) + (size_t)e * 1536 * 1024, M, N, DM};
            pg8::StaticOrder S; S.init(M, N, G, bid);
            pg8::EpiIn E{RC, (bf16*)(ws + WS_X2), even ? nullptr : a->b_qkv + (size_t)e * 1536, even ? nullptr : (const float*)(ws + WS_ROPE)};
            pg8::gemm_phase<pg8::EpiIn, pg8::StaticOrder, true, true>(lds, g, S, E);
        }
        SEAM(pb + 1);
        if (even) {
            if (IN(pb + 2)) REP(2) { ENV; conv_phase((const bf16*)(ws + WS_X1), a->conv + (size_t)e * 4 * 1536, (bf16*)(ws + WS_QKVA), gw, NGW, lane); }
            SEAM(pb + 2);
        }
        if (even) {
            if (IN(pb + 3)) REP(3) { ENV; SCANBUFS; local_phase(lds, sb, a->a_log + e * 4, a->dt_bias + e * 4, a->i_bias + e * 4, a->f_bias + e * 4, gw, NGW, wave, lane); }
            SEAM(pb + 3);
        }
        if (IN(pb + 4)) REP(4) { ENV;
            if (even) { SCANBUFS; recur_phase(lds, sb, G, bid, wave, lane); }
            else attn_phase(lds, tid, wave, RC, a->sinks + e * 16, RD, G, bid);
        }
        SEAM(pb + 4);
        if (even) {
            if (IN(pb + 5)) REP(5) { ENV; SCANBUFS; post_phase(sb, a->norm_a + e * 128, a->norm_b + e * 512, (bf16*)(ws + WS_MIXED), gw, NGW, lane); }
            SEAM(pb + 5);
        }
        if (IN(pb + 6)) REP(6) { ENV;
            pg8::Gemm g{even ? (const bf16*)(ws + WS_MIXED) : (const bf16*)RD, even ? (const bf16*)(ws + WS_WOUT) + (size_t)e * DM * DM : (const bf16*)(ws + WS_WO) + (size_t)e * DM * DM, M, DM, DM};
            pg8::StaticOrder S; S.init(M, DM, G, bid);
            pg8::EpiBf16<0> E{RA, DM, even ? nullptr : a->b_o + (size_t)e * DM, RA, 1 << 30, DM};
            pg8::gemm_phase<pg8::EpiBf16<0>, pg8::StaticOrder, true, true>(lds, g, S, E);
        }
        SEAM(pb + 6);
        if (IN(pb + 7)) { ENV; const float* gains = a->gains + (size_t)L * 4 * DM;
            resid_a_phase(RA, (L == 0) ? a->x : nullptr, (bf16*)a->out, gains + DM, gains + 2 * DM, RD, gw, NGW, lane); }
        SEAM(pb + 7);
        if (IN(pb + 8)) REP(8) { ENV;
            pg8::Gemm g{RD, (const bf16*)(ws + WS_WUP) + (size_t)L * FF * DM, M, FF, DM};
            pg8::StaticOrder S; S.init(M, FF, G, bid);
            pg8::EpiBf16<1> E{RC, FF, nullptr, RC, 1 << 30, FF};
            pg8::gemm_phase<pg8::EpiBf16<1>, pg8::StaticOrder, true, true>(lds, g, S, E);
        }
        SEAM(pb + 8);
        if (IN(pb + 9)) REP(9) { ENV;
            pg8::Gemm g{RC, (const bf16*)(ws + WS_WDN) + (size_t)L * DM * FF, M, DM, FF};
            pg8::StaticOrder S; S.init(M, DM, G, bid);
            pg8::EpiBf16<0> E{RA, DM, nullptr, RA, 1 << 30, DM};
            pg8::gemm_phase<pg8::EpiBf16<0>, pg8::StaticOrder, true, true>(lds, g, S, E);
        }
        SEAM(pb + 9);
        if (IN(pb + 10)) { ENV; resid_b_phase(RA, (const bf16*)a->out, a->gains + (size_t)L * 4 * DM + 3 * DM, RD, a->p + (size_t)L * M * PLE, RC, gw, NGW, lane, gtid, NGT); }
        SEAM(pb + 10);
        if (IN(pb + 11)) REP(11) { ENV;
            pg8::Gemm g{RC, (const bf16*)(ws + WS_WPLE) + (size_t)L * DM * PLE, M, DM, PLE};
            pg8::StaticOrder S; S.init(M, DM, G, bid);
            pg8::EpiBf16<0> E{RB, DM, nullptr, RB, 1 << 30, DM};
            pg8::gemm_phase<pg8::EpiBf16<0>, pg8::StaticOrder, true, true>(lds, g, S, E);
        }
        SEAM(pb + 11);
        if (IN(pb + 12)) { ENV;
            pg8::Gemm g{RD, (const bf16*)(ws + WS_WG) + (size_t)L * DM * DM, M, DM, DM};
            pg8::StaticOrder S; S.init(M, DM, G, bid);
            pg8::EpiBf16<0> E{(bf16*)(ws + WS_RC + 64 * MiB), DM, nullptr, RB, 1 << 30, DM};
            pg8::gemm_phase<pg8::EpiBf16<0>, pg8::StaticOrder, true, true>(lds, g, S, E);
        }
        SEAM(pb + 12);
        if (IN(pb + 13)) { ENV; const bool has_next = L + 1 < DEPTH, even_next = ((L + 1) & 1) == 0; const int en = (L + 1) >> 1;
            resid_c_phase(lds, (const bf16*)(ws + WS_RC + 64 * MiB), RB, RD, (bf16*)a->out, a->out, has_next, a->gains + (size_t)(L + 1 < DEPTH ? L + 1 : L) * 4 * DM, RA, even_next, (const float*)(ws + WS_WGATES) + (size_t)(en & 1) * 16 * 1024, Gt, gw, NGW, tid, lane); }
        SEAM(pb + 13);
    }
#undef SCANBUFS
#undef IN
#undef SEAM
#undef ENV
}

extern "C" void kernel_launch(void* const* d_in, const int* in_sizes, int n_in, void* d_out, int out_size, void* d_ws, size_t ws_size, hipStream_t stream) {
    static int grid = 0;
    if (grid == 0) {
        if (n_in != 22 || in_sizes[0] != M * DM || out_size != M * DM || ws_size < WS_END) {
            fprintf(stderr, "kernel_launch: unexpected shapes (n_in %d, in0 %d, out %d, ws %zu; need ws >= %zu); nothing launched\n", n_in, n_in > 0 ? in_sizes[0] : -1, out_size, ws_size, (size_t)WS_END); grid = -1; return; }
        int dev = 0, cus = 0, per_cu = 0;
        if (hipGetDevice(&dev) != hipSuccess || hipDeviceGetAttribute(&cus, hipDeviceAttributeMultiprocessorCount, dev) != hipSuccess) { fprintf(stderr, "kernel_launch: device query failed\n"); grid = -1; return; }
        if (hipFuncSetAttribute((const void*)trunk_fwd, hipFuncAttributeMaxDynamicSharedMemorySize, LDS_BYTES) != hipSuccess) { fprintf(stderr, "kernel_launch: hipFuncSetAttribute failed\n"); grid = -1; return; }
        if (hipOccupancyMaxActiveBlocksPerMultiprocessor(&per_cu, (const void*)trunk_fwd, NTHR, LDS_BYTES) != hipSuccess || per_cu < 1) fprintf(stderr, "kernel_launch: note: occupancy query reports %d\n", per_cu);
        (void)hipGetLastError();
        grid = cus;
    }
    if (grid < 0) return;
    Args a{};
    a.x = (const float*)d_in[0]; a.p = (const float*)d_in[1]; a.pos = (const int*)d_in[2]; a.gains = (const float*)d_in[3]; a.w_in = (const float*)d_in[4]; a.conv = (const float*)d_in[5];
    a.a_log = (const float*)d_in[6]; a.dt_bias = (const float*)d_in[7]; a.norm_a = (const float*)d_in[8]; a.i_bias = (const float*)d_in[9]; a.f_bias = (const float*)d_in[10]; a.norm_b = (const float*)d_in[11];
    a.b_qkv = (const float*)d_in[14]; a.sinks = (const float*)d_in[15]; a.b_o = (const float*)d_in[17];
    a.out = (float*)d_out; a.ws = (unsigned char*)d_ws;
#if defined(PROBE_DUP_MASK)
    a.dup_mask = PROBE_DUP_MASK; a.dup_par = PROBE_DUP_PAR;
#endif
    a.w_out = (const float*)d_in[12]; a.w_qkv = (const float*)d_in[13]; a.w_o = (const float*)d_in[16]; a.w_up = (const float*)d_in[18]; a.w_down = (const float*)d_in[19]; a.w_ple = (const float*)d_in[20]; a.w_gate = (const float*)d_in[21];
#if N_LAUNCH_MODE == 0
    if (hipMemsetAsync((char*)d_ws + WS_CTL, 0, CTL_ZERO_BYTES, stream) != hipSuccess) { fprintf(stderr, "kernel_launch: memset failed\n"); return; }
    a.ph_lo = 0; a.ph_hi = NPHASE;
    hipLaunchKernelGGL(trunk_fwd, dim3(grid), dim3(NTHR), LDS_BYTES, stream, a);
#else
    for (int ph = 0; ph < NPHASE; ++ph) { a.ph_lo = ph; a.ph_hi = ph + 1; hipLaunchKernelGGL(trunk_fwd, dim3(grid), dim3(NTHR), LDS_BYTES, stream, a); }
#endif
    const hipError_t le = hipPeekAtLastError();
    if (le != hipSuccess) fprintf(stderr, "kernel_launch: launch failed: %s\n", hipGetErrorName(le));
}
```

```cpp
#include <hip/hip_runtime.h>
#include <cstdio>
#include <cstdint>
#define N_LAUNCH_MODE 0
namespace pg8 {
#define PG8_LAS __attribute__((address_space(3)))
typedef unsigned short bf16_t;
typedef short bf16x8 __attribute__((ext_vector_type(8)));
typedef float f32x4 __attribute__((ext_vector_type(4)));
typedef unsigned u32x4 __attribute__((ext_vector_type(4)));
constexpr int BM = 256, BK = 64, HALF = 128, HTB = HALF * BK * 2  , STAGE_BYTES = 8 * HTB, NXCD = 8, WGM = 8;

__host__ __device__ __forceinline__ int lds_byte(int r, int c) { const int st = (r >> 4) * 2 + (c >> 5), rr = r & 15, cc = c & 31, ob = rr * 64 + cc * 2; return st * 1024 + (ob ^ (((ob >> 9) & 1) << 5)); }
__host__ __device__ __forceinline__ void stage_rc(int b, int& R, int& C) { const int st = b / 1024, sb = b % 1024, swz = sb ^ (((sb >> 9) & 1) << 5); R = (st >> 1) * 16 + swz / 64; C = (st & 1) * 32 + (swz % 64) / 2; }
__host__ __device__ __forceinline__ int perm32(int rho) { const int n = rho >> 4, i = rho & 15; return 8 * (i >> 2) + 4 * n + (i & 3); }

struct Unit { int pm, pn; };
struct Gemm { const bf16_t* A; const bf16_t* Bt; int M, N, K; };

struct StaticOrder {
    int nM, nN, nwg, G, c;
    __host__ __device__ void init(int M, int N, int G_, int c_) { nM = M / BM; nN = N / BM; nwg = nM * nN; G = G_; c = c_; }
    __host__ __device__ bool next(int i, Unit& u) const {
        const long L = (long)i * G + c; if (L >= nwg) return false;
        int wgid = (int)L; { const int q = nwg / NXCD, r = nwg % NXCD, xcd = wgid % NXCD, off = wgid / NXCD; wgid = (xcd < r ? xcd * (q + 1) : r * (q + 1) + (xcd - r) * q) + off; }
        const int nig = WGM * nN, gid = wgid / nig, fm = gid * WGM, gsz = (nM - fm) < WGM ? (nM - fm) : WGM;
        u.pm = fm + ((wgid % nig) % gsz); u.pn = (wgid % nig) / gsz; return true;
    }
    __device__ __forceinline__ void a_ready(const Unit&) const {}
    __device__ __forceinline__ void done(const Unit&) const {}
};

__device__ __forceinline__ unsigned cvt_pk_bf16(float lo, float hi) { unsigned r; asm volatile("v_cvt_pk_bf16_f32 %0, %1, %2" : "=v"(r) : "v"(lo), "v"(hi)); return r; }
typedef float f32x2 __attribute__((ext_vector_type(2)));
typedef unsigned u32x2 __attribute__((ext_vector_type(2)));

template <int ACT  > struct EpiBf16 {
    static constexpr bool PERM = true, AFTER_DRAIN = false;
    bf16_t* O; int ldc; const float* bias; bf16_t* O2; int split_col, ldc2; const float* rowscale;
    __device__ __forceinline__ void operator()(const f32x4 (&acc)[2][2][4][2], const Unit& u, int wr, int wc, int fr, int fq) const {
        const int row0 = u.pm * BM + wr * 64 + fr; const int col0 = u.pn * BM + wc * 32 + 8 * fq;
        const bool second = u.pn * BM >= split_col; bf16_t* const ob = second ? O2 : O; const int ld = second ? ldc2 : ldc, oc0 = second ? col0 - split_col : col0;
        f32x4 bv[2][2];
#pragma unroll
        for (int bj = 0; bj < 2; ++bj)
#pragma unroll
            for (int n = 0; n < 2; ++n) bv[bj][n] = bias ? *(const f32x4*)(bias + col0 + bj * HALF + 4 * n) : (f32x4){0.f, 0.f, 0.f, 0.f};
#pragma unroll
        for (int ai = 0; ai < 2; ++ai)
#pragma unroll
            for (int m = 0; m < 4; ++m) { bf16_t* rowp = ob + (size_t)(row0 + ai * HALF + m * 16) * ld + oc0; const float rs = rowscale ? rowscale[row0 + ai * HALF + m * 16] : 1.f;
#pragma unroll
                for (int bj = 0; bj < 2; ++bj) { f32x4 v0 = acc[ai][bj][m][0] * rs + bv[bj][0], v1 = acc[ai][bj][m][1] * rs + bv[bj][1];
                    if (ACT == 1) {
#pragma unroll
                        for (int i = 0; i < 4; ++i) { const float a = fmaxf(v0[i], 0.f), b = fmaxf(v1[i], 0.f); v0[i] = a * a; v1[i] = b * b; } }
                    u32x4 w; w.x = cvt_pk_bf16(v0[0], v0[1]); w.y = cvt_pk_bf16(v0[2], v0[3]); w.z = cvt_pk_bf16(v1[0], v1[1]); w.w = cvt_pk_bf16(v1[2], v1[3]);
                    *(u32x4*)(rowp + bj * HALF) = w; } }
    }
};
struct EpiIn {
    static constexpr bool PERM = true, AFTER_DRAIN = false;
    bf16_t* O; bf16_t* O2; const float* bias; const float* rope; const float* rowscale;
    __device__ __forceinline__ void operator()(const f32x4 (&acc)[2][2][4][2], const Unit& u, int wr, int wc, int fr, int fq) const {
        const int row0 = u.pm * BM + wr * 64 + fr, colt = u.pn * BM + wc * 32 + 8 * fq, g = (colt & 63) >> 3;
        const bool rot = rope != nullptr && u.pn < 5, second = rope == nullptr && u.pn >= 6;
        bf16_t* const ob = second ? O2 : O; const int ld = second ? 2560 : 1536, oc0 = second ? colt - 1536 : colt;
#pragma unroll
        for (int ai = 0; ai < 2; ++ai)
#pragma unroll
            for (int m = 0; m < 4; ++m) { const int row = row0 + ai * HALF + m * 16; bf16_t* rowp = ob + (size_t)row * ld;
                const float rs = rowscale[row]; f32x4 t0 = {1.f, 0.f, 1.f, 0.f}, t1 = t0;
                if (rot) { t0 = *(const f32x4*)(rope + (size_t)row * 64 + 8 * g); t1 = *(const f32x4*)(rope + (size_t)row * 64 + 8 * g + 4); }
#pragma unroll
                for (int bj = 0; bj < 2; ++bj) { const int c = colt + bj * HALF, hd = c >> 6; f32x4 v0 = acc[ai][bj][m][0] * rs, v1 = acc[ai][bj][m][1] * rs;
                    if (rope) { v0 = v0 + (rot ? *(const f32x4*)(bias + hd * 64 + 4 * g) : *(const f32x4*)(bias + c)); v1 = v1 + (rot ? *(const f32x4*)(bias + hd * 64 + 32 + 4 * g) : *(const f32x4*)(bias + c + 4)); }
                    if (rot) { const float sc = c < 1024 ? 0.125f : 1.f; const f32x4 cs = {t0.x, t0.z, t1.x, t1.z}, sn = {t0.y, t0.w, t1.y, t1.w};
                        const f32x4 o1 = (v0 * cs - v1 * sn) * sc, o2 = (v1 * cs + v0 * sn) * sc;
                        u32x2 w1, w2; w1.x = cvt_pk_bf16(o1[0], o1[1]); w1.y = cvt_pk_bf16(o1[2], o1[3]); w2.x = cvt_pk_bf16(o2[0], o2[1]); w2.y = cvt_pk_bf16(o2[2], o2[3]);
                        *(u32x2*)(rowp + hd * 64 + 4 * g) = w1; *(u32x2*)(rowp + hd * 64 + 32 + 4 * g) = w2; }
                    else {
                        u32x4 w; w.x = cvt_pk_bf16(v0[0], v0[1]); w.y = cvt_pk_bf16(v0[2], v0[3]); w.z = cvt_pk_bf16(v1[0], v1[1]); w.w = cvt_pk_bf16(v1[2], v1[3]); *(u32x4*)(rowp + oc0 + bj * HALF) = w; } } }
    }
};
struct EpiF32 {
    static constexpr bool PERM = false, AFTER_DRAIN = false;
    float* C; int ldc; const float* bias;
    __device__ __forceinline__ void operator()(const f32x4 (&acc)[2][2][4][2], const Unit& u, int wr, int wc, int fr, int fq) const {
        const int row0 = u.pm * BM + wr * 64 + fr, col0 = u.pn * BM + wc * 32 + 4 * fq;
        f32x4 bv[2][2];
#pragma unroll
        for (int bj = 0; bj < 2; ++bj)
#pragma unroll
            for (int n = 0; n < 2; ++n) bv[bj][n] = bias ? *(const f32x4*)(bias + col0 + bj * HALF + n * 16) : (f32x4){0.f, 0.f, 0.f, 0.f};
#pragma unroll
        for (int ai = 0; ai < 2; ++ai)
#pragma unroll
            for (int m = 0; m < 4; ++m) { float* rowp = C + (size_t)(row0 + ai * HALF + m * 16) * ldc + col0;
#pragma unroll
                for (int bj = 0; bj < 2; ++bj)
#pragma unroll
                    for (int n = 0; n < 2; ++n) *(f32x4*)(rowp + bj * HALF + n * 16) = acc[ai][bj][m][n] + bv[bj][n]; }
    }
};
__device__ __forceinline__ float bf_lo(unsigned w) { return __builtin_bit_cast(float, w << 16); }
__device__ __forceinline__ float bf_hi(unsigned w) { return __builtin_bit_cast(float, w & 0xffff0000u); }
struct EpiGate {
    static constexpr bool PERM = false, AFTER_DRAIN = false;
    float* H; const bf16_t* PP; int ldc;
    __device__ __forceinline__ void operator()(const f32x4 (&acc)[2][2][4][2], const Unit& u, int wr, int wc, int fr, int fq) const {
        const int row0 = u.pm * BM + wr * 64 + fr, col0 = u.pn * BM + wc * 32 + 4 * fq;
#pragma unroll
        for (int ai = 0; ai < 2; ++ai)
#pragma unroll
            for (int m = 0; m < 4; ++m) { const size_t ro = (size_t)(row0 + ai * HALF + m * 16) * ldc + col0;
#pragma unroll
                for (int bj = 0; bj < 2; ++bj)
#pragma unroll
                    for (int n = 0; n < 2; ++n) { const size_t off = ro + bj * HALF + n * 16;
                        f32x4 hv = *(const f32x4*)(H + off); const u32x2 pv = *(const u32x2*)(PP + off); const f32x4 a = acc[ai][bj][m][n];
                        const float p0 = bf_lo(pv.x), p1 = bf_hi(pv.x), p2 = bf_lo(pv.y), p3 = bf_hi(pv.y);
                        hv[0] += p0 / (1.f + __expf(-a[0])); hv[1] += p1 / (1.f + __expf(-a[1])); hv[2] += p2 / (1.f + __expf(-a[2])); hv[3] += p3 / (1.f + __expf(-a[3]));
                        *(f32x4*)(H + off) = hv; } }
    }
};

template <class Epi, class Sched, bool ALIGN_EPI = false, bool SP2 = false>
__device__ __forceinline__ void gemm_phase(PG8_LAS unsigned char* lds, const Gemm g, const Sched& S, const Epi& E) {
    int tid_l = threadIdx.x; asm volatile("" : "+v"(tid_l));
    const int tid = tid_l, wid = __builtin_amdgcn_readfirstlane(tid >> 6), lane = tid & 63, wr = wid >> 2, wc = wid & 3, fr = lane & 15, fq = lane >> 4;
    const int K = g.K, nt = K / BK;
    unsigned voffA[2], voffB[2];
#pragma unroll
    for (int i = 0; i < 2; ++i) { int R, C; stage_rc(tid * 16 + i * 8192, R, C); const int Rb = Epi::PERM ? ((R & ~31) + perm32(R & 31)) : R;
        voffA[i] = (unsigned)(R * K + C) * 2u; voffB[i] = (unsigned)(Rb * K + C) * 2u; }
    const size_t kstep = (size_t)(BK * 2);
    const size_t hstep = (size_t)HALF * K * 2;
    const size_t tstep = 2 * hstep;
    const unsigned ldsw = (unsigned)wid * 1024u;
    const int aoff = lds_byte(wr * 64 + fr, fq * 8), boff = lds_byte(wc * 32 + fr, fq * 8);
#define PG8_SA(b, h) (((b) * 2 + (h)) * HTB)
#define PG8_SB(b, h) ((4 + (b) * 2 + (h)) * HTB)
#define PG8_STAGE(bufoff, gbase, voff) do { _Pragma("unroll") for (int _i = 0; _i < 2; ++_i) \
        __builtin_amdgcn_global_load_lds((const unsigned*)((const char*)(gbase) + (voff)[_i]), (PG8_LAS unsigned*)(lds + (bufoff) + ldsw + _i * 8192), 16, 0, 0); } while (0)
#define PG8_LDA(dst, b, h) do { _Pragma("unroll") for (int m = 0; m < 4; ++m) _Pragma("unroll") for (int k = 0; k < 2; ++k) dst[m][k] = *(const PG8_LAS bf16x8*)(lds + PG8_SA(b, h) + aoff + m * 2048 + k * 1024); } while (0)
#define PG8_LDB(dst, b, h) do { _Pragma("unroll") for (int n = 0; n < 2; ++n) _Pragma("unroll") for (int k = 0; k < 2; ++k) dst[n][k] = *(const PG8_LAS bf16x8*)(lds + PG8_SB(b, h) + boff + n * 2048 + k * 1024); } while (0)
#define PG8_MMA(ai, bj, At, Bt) do { __builtin_amdgcn_s_setprio(1); _Pragma("unroll") for (int m = 0; m < 4; ++m) _Pragma("unroll") for (int n = 0; n < 2; ++n) _Pragma("unroll") for (int k = 0; k < 2; ++k) \
        acc[ai][bj][m][n] = __builtin_amdgcn_mfma_f32_16x16x32_bf16(Bt[n][k], At[m][k], acc[ai][bj][m][n], 0, 0, 0); __builtin_amdgcn_s_setprio(0); } while (0)
#define PG8_WAIT_V(n) asm volatile("s_waitcnt vmcnt(" #n ")" ::: "memory")
#define PG8_WAIT_L(n) asm volatile("s_waitcnt lgkmcnt(" #n ")" ::: "memory")
#define PG8_BAR __builtin_amdgcn_s_barrier()
#define PG8_SCHED __builtin_amdgcn_sched_barrier(0)
    Unit cur, nxt; int ui = 0;
    if (!S.next(0, cur)) return;
    f32x4 acc[2][2][4][2];
#pragma unroll
    for (int a = 0; a < 2; ++a)
#pragma unroll
        for (int b = 0; b < 2; ++b)
#pragma unroll
            for (int m = 0; m < 4; ++m)
#pragma unroll
                for (int n = 0; n < 2; ++n) acc[a][b][m][n] = (f32x4){0.f, 0.f, 0.f, 0.f};
    bf16x8 At[4][2], B0[2][2], B1[2][2];
    const char* cA = (const char*)g.A + (size_t)cur.pm * tstep; const char* cB = (const char*)g.Bt + (size_t)cur.pn * tstep;
    S.a_ready(cur);
    if constexpr (SP2) {
        PG8_STAGE(PG8_SB(0, 0), cB, voffB); PG8_STAGE(PG8_SB(0, 1), cB + hstep, voffB); PG8_STAGE(PG8_SA(0, 0), cA, voffA); PG8_STAGE(PG8_SA(0, 1), cA + hstep, voffA);
        if (wr == 1) PG8_BAR;
        PG8_WAIT_V(2); PG8_BAR;
        PG8_STAGE(PG8_SB(1, 0), cB + kstep, voffB); PG8_STAGE(PG8_SA(1, 0), cA + kstep, voffA); PG8_STAGE(PG8_SB(1, 1), cB + hstep + kstep, voffB);
        PG8_WAIT_V(6); PG8_BAR;
    } else {
        PG8_STAGE(PG8_SB(0, 0), cB, voffB); PG8_STAGE(PG8_SA(0, 0), cA, voffA); PG8_STAGE(PG8_SB(0, 1), cB + hstep, voffB); PG8_STAGE(PG8_SA(0, 1), cA + hstep, voffA);
        if (wr == 1) PG8_BAR;
        PG8_WAIT_V(4); PG8_BAR;
        PG8_STAGE(PG8_SB(1, 0), cB + kstep, voffB); PG8_STAGE(PG8_SA(1, 0), cA + kstep, voffA); PG8_STAGE(PG8_SB(1, 1), cB + hstep + kstep, voffB);
        PG8_WAIT_V(6); PG8_BAR;
    }
    for (;;) {
        const bool has_next = S.next(ui + 1, nxt);
        const char* nA = has_next ? (const char*)g.A + (size_t)nxt.pm * tstep : cA; const char* nB = has_next ? (const char*)g.Bt + (size_t)nxt.pn * tstep : cB;
        for (int t = 0; t < nt; t += 2) {
            const bool last = (t == nt - 2);
            const char* a1 = cA + (size_t)(t + 1) * kstep;
            const char* a2 = last ? nA : cA + (size_t)(t + 2) * kstep; const char* b2 = last ? nB : cB + (size_t)(t + 2) * kstep;
            const char* a3 = a2 + kstep; const char* b3 = b2 + kstep;
            if (last && has_next) S.a_ready(nxt);
            if constexpr (SP2) {
            PG8_LDB(B0, 0, 0); PG8_LDB(B1, 0, 1); PG8_SCHED; PG8_LDA(At, 0, 0); PG8_STAGE(PG8_SA(1, 1), a1 + hstep, voffA);
            PG8_WAIT_V(8); PG8_WAIT_L(0); PG8_BAR; PG8_MMA(0, 0, At, B0); PG8_MMA(0, 1, At, B1); PG8_BAR; PG8_SCHED;
            PG8_LDA(At, 0, 1); PG8_STAGE(PG8_SB(0, 0), b2, voffB); PG8_STAGE(PG8_SB(0, 1), b2 + hstep, voffB); PG8_STAGE(PG8_SA(0, 0), a2, voffA);
            PG8_WAIT_V(8); PG8_WAIT_L(0); PG8_BAR; PG8_MMA(1, 0, At, B0); PG8_MMA(1, 1, At, B1); PG8_BAR; PG8_SCHED;
            PG8_LDB(B0, 1, 0); PG8_LDB(B1, 1, 1); PG8_SCHED; PG8_LDA(At, 1, 0); PG8_STAGE(PG8_SA(0, 1), a2 + hstep, voffA);
            PG8_WAIT_V(8); PG8_WAIT_L(0); PG8_BAR; PG8_MMA(0, 0, At, B0); PG8_MMA(0, 1, At, B1); PG8_BAR; PG8_SCHED;
            PG8_LDA(At, 1, 1); PG8_STAGE(PG8_SB(1, 0), b3, voffB); PG8_STAGE(PG8_SB(1, 1), b3 + hstep, voffB); PG8_STAGE(PG8_SA(1, 0), a3, voffA);
            PG8_WAIT_V(8); PG8_WAIT_L(0); PG8_BAR; PG8_MMA(1, 0, At, B0); PG8_MMA(1, 1, At, B1); PG8_BAR; PG8_SCHED;
            } else {
            PG8_LDB(B0, 0, 0); PG8_SCHED; PG8_LDA(At, 0, 0); PG8_STAGE(PG8_SA(1, 1), a1 + hstep, voffA);
            PG8_WAIT_L(8); PG8_BAR; PG8_WAIT_L(0); PG8_MMA(0, 0, At, B0); PG8_BAR; PG8_SCHED;
            PG8_LDB(B1, 0, 1); PG8_STAGE(PG8_SB(0, 0), b2, voffB);
            PG8_BAR; PG8_WAIT_L(0); PG8_MMA(0, 1, At, B1); PG8_BAR;
            PG8_LDA(At, 0, 1); PG8_STAGE(PG8_SA(0, 0), a2, voffA);
            PG8_BAR; PG8_WAIT_L(0); PG8_MMA(1, 0, At, B0); PG8_BAR; PG8_SCHED;
            PG8_STAGE(PG8_SB(0, 1), b2 + hstep, voffB);
            PG8_WAIT_V(6); PG8_BAR; PG8_MMA(1, 1, At, B1); PG8_BAR;
            PG8_LDB(B0, 1, 0); PG8_SCHED; PG8_LDA(At, 1, 0); PG8_STAGE(PG8_SA(0, 1), a2 + hstep, voffA);
            PG8_WAIT_L(8); PG8_BAR; PG8_WAIT_L(0); PG8_MMA(0, 0, At, B0); PG8_BAR; PG8_SCHED;
            PG8_LDB(B1, 1, 1); PG8_STAGE(PG8_SB(1, 0), b3, voffB);
            PG8_BAR; PG8_WAIT_L(0); PG8_MMA(0, 1, At, B1); PG8_BAR;
            PG8_LDA(At, 1, 1); PG8_STAGE(PG8_SA(1, 0), a3, voffA);
            PG8_BAR; PG8_WAIT_L(0); PG8_MMA(1, 0, At, B0); PG8_BAR; PG8_SCHED;
            PG8_STAGE(PG8_SB(1, 1), b3 + hstep, voffB);
            PG8_WAIT_V(6); PG8_BAR; PG8_MMA(1, 1, At, B1); PG8_BAR;
            }
        }
        if constexpr (ALIGN_EPI) { if (wr == 0) PG8_BAR; }
        if constexpr (!Epi::AFTER_DRAIN) { E(acc, cur, wr, wc, fr, fq); S.done(cur); }
        if (!has_next) break;
#pragma unroll
        for (int a = 0; a < 2; ++a)
#pragma unroll
            for (int b = 0; b < 2; ++b)
#pragma unroll
                for (int m = 0; m < 4; ++m)
#pragma unroll
                    for (int n = 0; n < 2; ++n) acc[a][b][m][n] = (f32x4){0.f, 0.f, 0.f, 0.f};
        cur = nxt; cA = nA; cB = nB; ++ui;
        if constexpr (ALIGN_EPI) { if (wr == 1) PG8_BAR; }
    }
    PG8_WAIT_V(0);
    if constexpr (!ALIGN_EPI) { if (wr == 0) PG8_BAR; }
    PG8_BAR;
    if constexpr (Epi::AFTER_DRAIN) { E.fused(acc, cur, wr, wc, fr, fq, lds, wid, lane); S.done(cur); }
#undef PG8_SA
#undef PG8_SB
#undef PG8_STAGE
#undef PG8_LDA
#undef PG8_LDB
#undef PG8_MMA
#undef PG8_WAIT_V
#undef PG8_WAIT_L
#undef PG8_BAR
#undef PG8_SCHED
}
}
constexpr int BATCH = 32, SEQ = 2048, DM = 1024, DEPTH = 4, M = BATCH * SEQ;
constexpr int FF = 4096, PLE = 256, NIN = 4112;
constexpr float EPS = 1e-6f;
constexpr int NWAVES = 8, NTHR = NWAVES * 64;
constexpr int PH_PER_LAYER = 14, NPHASE = 1 + DEPTH * PH_PER_LAYER;
constexpr size_t MiB = 1u << 20;
constexpr size_t WS_CTL = 0, CTL_ZERO_BYTES = 1 * MiB;
constexpr size_t WS_WIN = 1 * MiB, WS_WOUT = 17 * MiB, WS_WQKV = 21 * MiB, WS_WO = 27 * MiB, WS_WUP = 31 * MiB, WS_WDN = 63 * MiB, WS_WPLE = 95 * MiB, WS_WG = 97 * MiB;
constexpr size_t WS_WGATES = 105 * MiB, WS_GT = 106 * MiB, WS_ROPE = 110 * MiB;
constexpr size_t WS_DEN = 126 * MiB, WS_RS0 = 127 * MiB, WS_RS2 = 127 * MiB + 512 * 1024;
constexpr size_t WS_RA = 128 * MiB, WS_RB = 256 * MiB, WS_RC = 384 * MiB, WS_RD = 896 * MiB, WS_END = 1024 * MiB;
constexpr size_t WS_QKVA = 128 * MiB, WS_KWT = 320 * MiB, WS_X1 = 384 * MiB, WS_KT = 384 * MiB, WS_UT = 448 * MiB, WS_NW = 512 * MiB, WS_X2 = 576 * MiB, WS_VT = 896 * MiB, WS_ATT = 960 * MiB, WS_PT = 992 * MiB, WS_MIXED = 384 * MiB;
constexpr int CW_BAR = 4096;
constexpr int RING_BYTES = 131072, MISC_OFF = RING_BYTES, LDS_BYTES = RING_BYTES + 1024;

#define GAS __attribute__((address_space(1)))
#define LAS __attribute__((address_space(3)))
typedef unsigned short bf16;
typedef float f32x4 __attribute__((ext_vector_type(4)));
typedef float f32x2 __attribute__((ext_vector_type(2)));
typedef unsigned u32x4 __attribute__((ext_vector_type(4)));
typedef unsigned u32x2 __attribute__((ext_vector_type(2)));
#define LDS_WAIT() asm volatile("s_waitcnt lgkmcnt(0)" ::: "memory")
#define VM_WAIT() asm volatile("s_waitcnt vmcnt(0)" ::: "memory")
using pg8::bf_lo; using pg8::bf_hi;
typedef __bf16 bf16x2_t __attribute__((ext_vector_type(2)));
__device__ __forceinline__ unsigned pk2(float lo, float hi) { return pg8::cvt_pk_bf16(lo, hi); }
__device__ __forceinline__ unsigned pk2v(float lo, float hi) { const f32x2 v = {lo, hi}; const bf16x2_t b = __builtin_convertvector(v, bf16x2_t); return __builtin_bit_cast(unsigned, b); }
__device__ __forceinline__ float wave_sum(float v) {
#pragma unroll
    for (int o = 1; o < 64; o <<= 1) v += __shfl_xor(v, o);
    return v;
}
__device__ __forceinline__ float dot4(f32x4 a, f32x4 b) { return (a.x * b.x + a.y * b.y) + (a.z * b.z + a.w * b.w); }
__device__ __forceinline__ float sigmoid_f(float x) { return 1.f / (1.f + __expf(-x)); }
__device__ __forceinline__ float softplus_f(float x) { return x > 20.f ? x : log1pf(expf(x)); }

#define XB_TMO      128
#define XB_XCNT(j)  (256  + 64 * (j))
#define XB_XSUB(j)  (1280 + 64 * (j))
#define XB_XGEN(j)  (2304 + 64 * (j))
#define XB_TOP      3328
#define XB_TOPGEN   3392
#define XCD_BAR_WORDS 3456
#define XB_SPIN_CAP (1u << 18)

__device__ __forceinline__ unsigned xb_ld(unsigned* p)              { return __hip_atomic_load(p, __ATOMIC_RELAXED, __HIP_MEMORY_SCOPE_AGENT); }
__device__ __forceinline__ unsigned xb_add(unsigned* p, unsigned v) { return __hip_atomic_fetch_add(p, v, __ATOMIC_RELAXED, __HIP_MEMORY_SCOPE_AGENT); }
__device__ __forceinline__ unsigned xb_xcc_id() { return (unsigned)__builtin_amdgcn_s_getreg((3 << 11) | 20) & 0xFu; }
#define XB_SPIN(cond, bar) do { unsigned _sp = 0; while (cond) { __builtin_amdgcn_s_sleep(1); \
    if ((++_sp & 255u) == 0u) { if (xb_ld(&(bar)[XB_TMO])) break; if (_sp > XB_SPIN_CAP) { atomicAdd(&(bar)[XB_TMO], 1u); break; } } } } while (0)

struct XcdBarrier {
    unsigned* bar; unsigned x;
    volatile LAS unsigned* st;
};

__device__ __forceinline__ XcdBarrier xcd_barrier_post(unsigned* bar, volatile LAS unsigned* st) {
    XcdBarrier b; b.bar = bar; b.x = xb_xcc_id(); b.st = st;
    if (threadIdx.x == 0) (void)xb_add(&bar[XB_XCNT(b.x)], 1u);
    return b;
}
__device__ __forceinline__ void xcd_barrier_complete(unsigned* bar, unsigned x, unsigned& nloc, unsigned& nx) {
    const unsigned G = gridDim.x * gridDim.y * gridDim.z;
    unsigned sum, cnt, mine, sp = 0u;
    for (;;) {
        sum = 0u; cnt = 0u; mine = 0u;
#pragma unroll
        for (unsigned j = 0; j < 16; ++j) { const unsigned c = xb_ld(&bar[XB_XCNT(j)]); sum += c; cnt += (c > 0u) ? 1u : 0u; mine = (j == x) ? c : mine; }
        if (sum == G) break;
        __builtin_amdgcn_s_sleep(1);
        if ((++sp & 255u) == 0u) { if (xb_ld(&bar[XB_TMO])) break; if (sp > XB_SPIN_CAP) { atomicAdd(&bar[XB_TMO], 1u); break; } }
    }
    nloc = mine > 0u ? mine : 1u; nx = cnt > 0u ? cnt : 1u;
}

__device__ __forceinline__ void xcd_barrier(const XcdBarrier& b) {
    asm volatile("s_waitcnt vmcnt(0)" ::: "memory");
    __syncthreads();
    if (threadIdx.x == 0) {
        unsigned* bar = b.bar;
        __builtin_amdgcn_s_waitcnt(0);
        unsigned nloc = b.st[0], nx = b.st[1];
        if (nloc == 0u) { xcd_barrier_complete(bar, b.x, nloc, nx); b.st[0] = nloc; b.st[1] = nx; }
        const unsigned old = xb_add(&bar[XB_XSUB(b.x)], 1u);
        const unsigned gen = old / nloc;
        if (old + 1u == (gen + 1u) * nloc) {
            __builtin_amdgcn_fence(__ATOMIC_RELEASE, "agent");
            asm volatile("s_waitcnt vmcnt(0)" ::: "memory");
            const unsigned og = xb_add(&bar[XB_TOP], 1u);
            const unsigned tg = og / nx;
            if (og + 1u == (tg + 1u) * nx) xb_add(&bar[XB_TOPGEN], 1u);
            else XB_SPIN(xb_ld(&bar[XB_TOPGEN]) == tg, bar);
            __builtin_amdgcn_fence(__ATOMIC_ACQUIRE, "agent");
            xb_add(&bar[XB_XGEN(b.x)], 1u);
            asm volatile("s_waitcnt vmcnt(0)" ::: "memory");
        } else {
            XB_SPIN(xb_ld(&bar[XB_XGEN(b.x)]) == gen, bar);
            __builtin_amdgcn_fence(__ATOMIC_ACQUIRE, "agent");
            asm volatile("s_waitcnt vmcnt(0)" ::: "memory");
        }
    }
    __syncthreads();
}
struct Args {
    const float *x, *p; const int* pos; const float *gains, *w_in, *conv, *a_log, *dt_bias, *norm_a, *i_bias, *f_bias, *norm_b, *w_out, *w_qkv, *b_qkv, *sinks, *w_o, *b_o, *w_up, *w_down, *w_ple, *w_gate;
    float* out; unsigned char* ws;
    int ph_lo, ph_hi, dup_mask, dup_par;
};

template <bool ROPE_PERM = false> __device__ __forceinline__ void transpose_item(const float* src, int ld, int K, bf16* dst, LAS float* scr, int item, int nblk, int lane, const float* kscale = nullptr) {
    const int kb = item / nblk, nb = item % nblk, k0 = 64 * kb, n0 = 32 * nb;
#pragma unroll 8
    for (int i = 0; i < 32; ++i) { const int kk = 2 * i + (lane >> 5); scr[kk * 33 + (lane & 31)] = src[(size_t)(k0 + kk) * ld + n0 + (lane & 31)] * (kscale ? kscale[k0 + kk] : 1.f); }
    LDS_WAIT(); asm volatile("" ::: "memory");
    const int c = lane & 7;
#pragma unroll
    for (int j = 0; j < 4; ++j) { const int n = (lane >> 3) + 8 * j; const LAS float* s = scr + (8 * c) * 33 + n;
        u32x4 o; o.x = pk2(s[0 * 33], s[1 * 33]); o.y = pk2(s[2 * 33], s[3 * 33]); o.z = pk2(s[4 * 33], s[5 * 33]); o.w = pk2(s[6 * 33], s[7 * 33]);
        int nd = n0 + n;
        if (ROPE_PERM && nd < 1280) { const int i = nd & 63; nd = (nd & ~63) + (i < 32 ? 8 * (i >> 2) + (i & 3) : 8 * ((i - 32) >> 2) + 4 + (i & 3)); }
        *(u32x4*)(dst + (size_t)nd * K + k0 + 8 * c) = o; }
    LDS_WAIT(); asm volatile("" ::: "memory");
}
__device__ __forceinline__ int gate_col(int c) { return c < 8 ? 1536 + c : 3592 + (c - 8); }

typedef const __attribute__((address_space(4))) Args* KArgs;
__device__ __forceinline__ KArgs kargs() { KArgs p = (KArgs)__builtin_amdgcn_kernarg_segment_ptr(); asm volatile("" : "+s"(p)); return p; }
__device__ __forceinline__ int fresh_tid() { int t = threadIdx.x; asm volatile("" : "+v"(t)); return t; }
__device__ __forceinline__ void prologue_phase(KArgs a, LAS unsigned char* lds, int gw, int NGW, int wave, int lane, int gtid, int NGT) {
    LAS float* scr = (LAS float*)(lds + wave * 16384);
    constexpr int I_IN = 16 * 16, I_SQ = 16 * 32, I_QKV = 16 * 48, I_UP = 16 * 128, I_DN = 64 * 32, I_PLE = 4 * 32;
    constexpr int NITEMS = 16 * I_IN + 2 * I_SQ + 2 * I_QKV + 2 * I_SQ + 4 * I_UP + 4 * I_DN + 4 * I_PLE + 4 * I_SQ;
    unsigned char* ws = a->ws;
    for (int it = gw; it < NITEMS; it += NGW) {
        int r = it;
        if (r < 16 * I_IN) { const int j = r / I_IN, e = j >> 3, s = j & 7, col0 = 512 * s + (s >= 3 ? 8 : 0) + (s >= 7 ? 8 : 0);
            transpose_item(a->w_in + (size_t)e * DM * NIN + col0, NIN, DM, (bf16*)(ws + WS_WIN) + ((size_t)e * 4096 + s * 512) * DM, scr, r % I_IN, 16, lane, a->gains + (size_t)(2 * e) * 4 * DM); continue; } r -= 16 * I_IN;
        if (r < 2 * I_SQ) { const int e = r / I_SQ; transpose_item(a->w_out + (size_t)e * DM * DM, DM, DM, (bf16*)(ws + WS_WOUT) + (size_t)e * DM * DM, scr, r % I_SQ, 32, lane); continue; } r -= 2 * I_SQ;
        if (r < 2 * I_QKV) { const int e = r / I_QKV; transpose_item<true>(a->w_qkv + (size_t)e * DM * 1536, 1536, DM, (bf16*)(ws + WS_WQKV) + (size_t)e * 1536 * DM, scr, r % I_QKV, 48, lane, a->gains + (size_t)(2 * e + 1) * 4 * DM); continue; } r -= 2 * I_QKV;
        if (r < 2 * I_SQ) { const int e = r / I_SQ; transpose_item(a->w_o + (size_t)e * DM * DM, DM, DM, (bf16*)(ws + WS_WO) + (size_t)e * DM * DM, scr, r % I_SQ, 32, lane); continue; } r -= 2 * I_SQ;
        if (r < 4 * I_UP) { const int l = r / I_UP; transpose_item(a->w_up + (size_t)l * DM * FF, FF, DM, (bf16*)(ws + WS_WUP) + (size_t)l * FF * DM, scr, r % I_UP, 128, lane, a->gains + ((size_t)l * 4 + 2) * DM); continue; } r -= 4 * I_UP;
        if (r < 4 * I_DN) { const int l = r / I_DN; transpose_item(a->w_down + (size_t)l * FF * DM, DM, FF, (bf16*)(ws + WS_WDN) + (size_t)l * DM * FF, scr, r % I_DN, 32, lane); continue; } r -= 4 * I_DN;
        if (r < 4 * I_PLE) { const int l = r / I_PLE; transpose_item(a->w_ple + (size_t)l * PLE * DM, DM, PLE, (bf16*)(ws + WS_WPLE) + (size_t)l * DM * PLE, scr, r % I_PLE, 32, lane); continue; } r -= 4 * I_PLE;
        { const int l = r / I_SQ; transpose_item(a->w_gate + (size_t)l * DM * DM, DM, DM, (bf16*)(ws + WS_WG) + (size_t)l * DM * DM, scr, r % I_SQ, 32, lane); }
    }
    float* Wg = (float*)(a->ws + WS_WGATES);
    for (int i = gtid; i < 2 * 16 * 1024; i += NGT) { const int e = i >> 14, c = (i >> 10) & 15, k = i & 1023; Wg[i] = a->w_in[((size_t)e * 1024 + k) * NIN + gate_col(c)]; }
    f32x2* rope = (f32x2*)(a->ws + WS_ROPE);
    for (int i = gtid; i < M * 32; i += NGT) { const int m = i >> 5, d = i & 31;
        const float inv = (float)pow(10000.0, -(double)d / 32.0); const float ang = (float)a->pos[m] * inv; float sn, cs; sincosf(ang, &sn, &cs); rope[i] = (f32x2){cs, sn}; }
}

__device__ __forceinline__ void norm_phase(LAS unsigned char* lds, const float* hin, const float* g0, bf16* HN, float* RS, bool even, const float* Wg, float* Gt, int gw, int NGW, int tid, int lane) {
    LAS f32x4* wl = (LAS f32x4*)lds;
    if (even) { for (int i = tid; i < 4096; i += NTHR) wl[i] = ((const f32x4*)Wg)[i]; __syncthreads(); }
    f32x4 gv[4];
#pragma unroll
    for (int j = 0; j < 4; ++j) gv[j] = ((const f32x4*)g0)[lane + 64 * j];
#pragma unroll 2
    for (int m = gw; m < M; m += NGW) {
        const f32x4* xr = (const f32x4*)(hin + (size_t)m * DM) + lane;
        f32x4 v[4]; float s = 0.f;
#pragma unroll
        for (int j = 0; j < 4; ++j) { v[j] = xr[64 * j]; s += dot4(v[j], v[j]); }
        const float rstd = rsqrtf(wave_sum(s) * (1.f / DM) + EPS);
        u32x2* o8 = (u32x2*)(HN + (size_t)m * DM) + lane;
#pragma unroll
        for (int j = 0; j < 4; ++j) { o8[64 * j] = (u32x2){pk2(v[j].x, v[j].y), pk2(v[j].z, v[j].w)}; v[j] = v[j] * rstd * gv[j]; }
        if (lane == 0) RS[m] = rstd;
        if (even) {
            float keep = 0.f;
#pragma unroll
            for (int c = 0; c < 16; ++c) { float d = 0.f;
#pragma unroll
                for (int j = 0; j < 4; ++j) d += dot4(v[j], wl[c * 256 + lane + 64 * j]);
                d = wave_sum(d); if (lane == c) keep = d; }
            if (lane < 16) Gt[(size_t)m * 16 + lane] = keep;
        }
    }
    if (even) __syncthreads();
}
struct Row16 { f32x4 v[4]; };
__device__ __forceinline__ Row16 ld_row_bf16(const bf16* row, int lane) { const u32x4 a = ((const u32x4*)row)[lane], b = ((const u32x4*)row)[lane + 64]; Row16 r;
    r.v[0] = (f32x4){bf_lo(a.x), bf_hi(a.x), bf_lo(a.y), bf_hi(a.y)}; r.v[1] = (f32x4){bf_lo(a.z), bf_hi(a.z), bf_lo(a.w), bf_hi(a.w)};
    r.v[2] = (f32x4){bf_lo(b.x), bf_hi(b.x), bf_lo(b.y), bf_hi(b.y)}; r.v[3] = (f32x4){bf_lo(b.z), bf_hi(b.z), bf_lo(b.w), bf_hi(b.w)}; return r; }
__device__ __forceinline__ Row16 ld_row_f32(const float* row, int lane) { const f32x4* p = (const f32x4*)row; Row16 r; r.v[0] = p[2 * lane]; r.v[1] = p[2 * lane + 1]; r.v[2] = p[128 + 2 * lane]; r.v[3] = p[128 + 2 * lane + 1]; return r; }
__device__ __forceinline__ void st_row_bf16(bf16* row, int lane, const Row16& r) {
    ((u32x4*)row)[lane] = (u32x4){pk2(r.v[0].x, r.v[0].y), pk2(r.v[0].z, r.v[0].w), pk2(r.v[1].x, r.v[1].y), pk2(r.v[1].z, r.v[1].w)};
    ((u32x4*)row)[lane + 64] = (u32x4){pk2(r.v[2].x, r.v[2].y), pk2(r.v[2].z, r.v[2].w), pk2(r.v[3].x, r.v[3].y), pk2(r.v[3].z, r.v[3].w)}; }
__device__ __forceinline__ void st_row_f32(float* row, int lane, const Row16& r) { f32x4* p = (f32x4*)row; p[2 * lane] = r.v[0]; p[2 * lane + 1] = r.v[1]; p[128 + 2 * lane] = r.v[2]; p[128 + 2 * lane + 1] = r.v[3]; }
__device__ __forceinline__ float row_sumsq(const Row16& r) { return (dot4(r.v[0], r.v[0]) + dot4(r.v[1], r.v[1])) + (dot4(r.v[2], r.v[2]) + dot4(r.v[3], r.v[3])); }
__device__ __forceinline__ void resid_a_phase(const bf16* mix, const float* hin32, bf16* hs, const float* g1, float* RS, int gw, int NGW, int lane) {
    const Row16 ga = ld_row_f32(g1, lane);
    for (int m = gw; m < M; m += NGW) {
        const Row16 v = ld_row_bf16(mix + (size_t)m * DM, lane); Row16 h = hin32 ? ld_row_f32(hin32 + (size_t)m * DM, lane) : ld_row_bf16(hs + (size_t)m * DM, lane);
        const float r1 = rsqrtf(wave_sum(row_sumsq(v)) * (1.f / DM) + EPS);
#pragma unroll
        for (int j = 0; j < 4; ++j) h.v[j] = h.v[j] + v.v[j] * r1 * ga.v[j];
        st_row_bf16(hs + (size_t)m * DM, lane, h);
        const float r2 = rsqrtf(wave_sum(row_sumsq(h)) * (1.f / DM) + EPS);
        if (lane == 0) RS[m] = r2;
    }
}
__device__ __forceinline__ void resid_b_phase(const bf16* ff, const bf16* hs, const float* g3, bf16* HB, const float* pl, bf16* PB, int gw, int NGW, int lane, int gtid, int NGT) {
    const Row16 ga = ld_row_f32(g3, lane);
    for (int m = gw; m < M; m += NGW) {
        const Row16 v = ld_row_bf16(ff + (size_t)m * DM, lane); Row16 h = ld_row_bf16(hs + (size_t)m * DM, lane);
        const float r1 = rsqrtf(wave_sum(row_sumsq(v)) * (1.f / DM) + EPS);
#pragma unroll
        for (int j = 0; j < 4; ++j) h.v[j] = h.v[j] + v.v[j] * r1 * ga.v[j];
        st_row_bf16(HB + (size_t)m * DM, lane, h);
    }
    for (int i = gtid; i < M * PLE / 8; i += NGT) { const f32x4 a = ((const f32x4*)pl)[2 * i], b = ((const f32x4*)pl)[2 * i + 1];
        ((u32x4*)PB)[i] = (u32x4){pk2(a.x, a.y), pk2(a.z, a.w), pk2(b.x, b.y), pk2(b.z, b.w)}; }
}
__device__ __forceinline__ void resid_c_phase(LAS unsigned char* lds, const bf16* gpre, const bf16* pp, const bf16* h2, bf16* hs, float* out32, bool has_next, const float* g0, float* RS, bool even_next, const float* Wg, float* Gt, int gw, int NGW, int tid, int lane) {
    LAS f32x4* wl = (LAS f32x4*)lds;
    if (has_next && even_next) { for (int i = tid; i < 4096; i += NTHR) wl[i] = ((const f32x4*)Wg)[i]; __syncthreads(); }
    const Row16 gv = ld_row_f32(g0, lane);
    for (int m = gw; m < M; m += NGW) {
        const Row16 g = ld_row_bf16(gpre + (size_t)m * DM, lane), p = ld_row_bf16(pp + (size_t)m * DM, lane); Row16 h = ld_row_bf16(h2 + (size_t)m * DM, lane);
#pragma unroll
        for (int j = 0; j < 4; ++j)
#pragma unroll
            for (int i = 0; i < 4; ++i) h.v[j][i] += p.v[j][i] * sigmoid_f(g.v[j][i]);
        if (has_next) {
            st_row_bf16(hs + (size_t)m * DM, lane, h);
            const float rstd = rsqrtf(wave_sum(row_sumsq(h)) * (1.f / DM) + EPS);
            if (lane == 0) RS[m] = rstd;
            if (even_next) {
#pragma unroll
                for (int j = 0; j < 4; ++j) h.v[j] = h.v[j] * rstd * gv.v[j];
                float keep = 0.f;
#pragma unroll
                for (int c = 0; c < 16; ++c) {
                    float d = (dot4(h.v[0], wl[c * 256 + 2 * lane]) + dot4(h.v[1], wl[c * 256 + 2 * lane + 1])) + (dot4(h.v[2], wl[c * 256 + 128 + 2 * lane]) + dot4(h.v[3], wl[c * 256 + 128 + 2 * lane + 1]));
                    d = wave_sum(d); if (lane == c) keep = d; }
                if (lane < 16) Gt[(size_t)m * 16 + lane] = keep;
            }
        } else st_row_f32(out32 + (size_t)m * DM, lane, h);
    }
    if (has_next && even_next) __syncthreads();
}
__device__ __forceinline__ void conv_phase(const bf16* X1, const float* convw  , bf16* QKVA, int gw, int NGW, int lane) {
    constexpr int RPW = 32;
    for (int blk = gw; blk < M / RPW; blk += NGW) {
        const int mb = blk * RPW;
#pragma unroll 1
        for (int j = 0; j < 3; ++j) {
            const int col = j * 512 + lane * 8;
            u32x4 h0, h1, h2;
            { const bool first = (mb & (SEQ - 1)) == 0; const u32x4 z = {0u, 0u, 0u, 0u};
              h0 = first ? z : *(const u32x4*)(X1 + (size_t)(mb - 3) * 1536 + col); h1 = first ? z : *(const u32x4*)(X1 + (size_t)(mb - 2) * 1536 + col); h2 = first ? z : *(const u32x4*)(X1 + (size_t)(mb - 1) * 1536 + col); }
            f32x4 w[4][2];
#pragma unroll
            for (int kk = 0; kk < 4; ++kk) { w[kk][0] = *(const f32x4*)(convw + kk * 1536 + col); w[kk][1] = *(const f32x4*)(convw + kk * 1536 + col + 4); }
#pragma unroll 1
            for (int r4 = 0; r4 < RPW; r4 += 4) {
                u32x4 cur[4];
#pragma unroll
                for (int rr = 0; rr < 4; ++rr) cur[rr] = *(const u32x4*)(X1 + (size_t)(mb + r4 + rr) * 1536 + col);
#pragma unroll
                for (int rr = 0; rr < 4; ++rr) {
                    const int m = mb + r4 + rr;
                    const u32x4 xs[4] = {rr == 0 ? h0 : (rr == 1 ? h1 : (rr == 2 ? h2 : cur[0])), rr == 0 ? h1 : (rr == 1 ? h2 : cur[rr - 2 < 0 ? 0 : rr - 2]), rr == 0 ? h2 : cur[rr - 1 < 0 ? 0 : rr - 1], cur[rr]};
                    float acc[8];
#pragma unroll
                    for (int i = 0; i < 8; ++i) acc[i] = 0.f;
#pragma unroll
                    for (int kk = 0; kk < 4; ++kk) { const u32x4 xv = xs[kk]; const f32x4 w0 = w[kk][0], w1 = w[kk][1];
                        acc[0] += bf_lo(xv.x) * w0.x; acc[1] += bf_hi(xv.x) * w0.y; acc[2] += bf_lo(xv.y) * w0.z; acc[3] += bf_hi(xv.y) * w0.w;
                        acc[4] += bf_lo(xv.z) * w1.x; acc[5] += bf_hi(xv.z) * w1.y; acc[6] += bf_lo(xv.w) * w1.z; acc[7] += bf_hi(xv.w) * w1.w; }
                    float ss = 0.f;
#pragma unroll
                    for (int i = 0; i < 8; ++i) { acc[i] = acc[i] / (1.f + __expf(-acc[i])); ss += acc[i] * acc[i]; }
                    if (j < 2) { ss += __shfl_xor(ss, 1); ss += __shfl_xor(ss, 2); ss += __shfl_xor(ss, 4); ss += __shfl_xor(ss, 8);
                        const float sc = rsqrtf(ss + EPS) * (j == 0 ? 0.08838834764831845f : 1.f);
#pragma unroll
                        for (int i = 0; i < 8; ++i) acc[i] *= sc; }
                    *(u32x4*)(QKVA + (size_t)m * 1536 + col) = (u32x4){pk2(acc[0], acc[1]), pk2(acc[2], acc[3]), pk2(acc[4], acc[5]), pk2(acc[6], acc[7])};
                }
                h0 = cur[1]; h1 = cur[2]; h2 = cur[3];
            }
        }
    }
}
__device__ __forceinline__ void rope_phase(bf16* QKV, const f32x2* rope, int gw, int NGW, int lane) {
#pragma unroll 2
    for (int m = gw; m < M; m += NGW) {
        const int grp = lane & 7; const f32x4* tb = (const f32x4*)(rope + (size_t)m * 32 + grp * 4); const f32x4 t0 = tb[0], t1 = tb[1];
        const float cs[4] = {t0.x, t0.z, t1.x, t1.z}, sn[4] = {t0.y, t0.w, t1.y, t1.w};
#pragma unroll
        for (int k = 0; k < 3; ++k) {
            if (k == 2 && lane >= 32) break;
            const int hh = (k < 2) ? ((lane + 64 * k) >> 3) : (lane >> 3); const float scale = (k < 2) ? 0.125f : 1.f;
            bf16* base = QKV + (size_t)m * 1536 + (k < 2 ? 0 : 1024) + hh * 64 + grp * 4;
            const u32x2 a = *(const u32x2*)base, b = *(const u32x2*)(base + 32);
            const float x1[4] = {bf_lo(a.x), bf_hi(a.x), bf_lo(a.y), bf_hi(a.y)}, x2[4] = {bf_lo(b.x), bf_hi(b.x), bf_lo(b.y), bf_hi(b.y)};
            float o1[4], o2[4];
#pragma unroll
            for (int i = 0; i < 4; ++i) { o1[i] = (x1[i] * cs[i] - x2[i] * sn[i]) * scale; o2[i] = (x2[i] * cs[i] + x1[i] * sn[i]) * scale; }
            *(u32x2*)base = (u32x2){pk2(o1[0], o1[1]), pk2(o1[2], o1[3])}; *(u32x2*)(base + 32) = (u32x2){pk2(o2[0], o2[1]), pk2(o2[2], o2[3])};
        }
    }
}
typedef short bf16x8 __attribute__((ext_vector_type(8)));
#define MFMA16(a, b, c) __builtin_amdgcn_mfma_f32_16x16x32_bf16(a, b, c, 0, 0, 0)
__device__ __forceinline__ bf16x8 pack8(f32x4 a, f32x4 b) { const u32x4 w = {pk2v(a.x, a.y), pk2v(a.z, a.w), pk2v(b.x, b.y), pk2v(b.z, b.w)}; return __builtin_bit_cast(bf16x8, w); }
__device__ __forceinline__ float bf2f(unsigned short v) { return __builtin_bit_cast(float, (unsigned)v << 16); }
__device__ __forceinline__ float rdlane(float v, int i) { return __builtin_bit_cast(float, __builtin_amdgcn_readlane(__builtin_bit_cast(int, v), i)); }
__device__ __forceinline__ float scan_add(float v, int lane) {
#pragma unroll
    for (int o = 1; o < 64; o <<= 1) { const float t = __shfl_up(v, o); if (lane >= o) v += t; }
    return v; }
__device__ __forceinline__ float scan_max(float v, int lane) {
#pragma unroll
    for (int o = 1; o < 64; o <<= 1) { const float t = __shfl_up(v, o); if (lane >= o) v = fmaxf(v, t); }
    return v; }
__device__ __forceinline__ int kperm(int ks, int q, int jj) { return 32 * ks + (jj < 4 ? 4 * q + jj : 16 + 4 * q + jj - 4); }
template <bool SCALE> __device__ __forceinline__ u32x4 tr_gather(const bf16* src  , int ld, int ks, int q, float esc_lane) {
    unsigned w[4];
#pragma unroll
    for (int j2 = 0; j2 < 4; ++j2) { const int r0 = kperm(ks, q, 2 * j2), r1 = r0 + 1; const unsigned short a = src[(size_t)r0 * ld], b = src[(size_t)r1 * ld];
        if (SCALE) { const float s0 = __shfl(esc_lane, r0), s1 = __shfl(esc_lane, r1); w[j2] = pk2(bf2f(a) * s0, bf2f(b) * s1); } else w[j2] = (unsigned)a | ((unsigned)b << 16); }
    return (u32x4){w[0], w[1], w[2], w[3]};
}
__device__ __forceinline__ u32x4 scale_frag(u32x4 raw, int ks, int q, float esc_lane) {
    unsigned w[4] = {raw.x, raw.y, raw.z, raw.w};
#pragma unroll
    for (int j2 = 0; j2 < 4; ++j2) { const int r0 = kperm(ks, q, 2 * j2); const float s0 = __shfl(esc_lane, r0), s1 = __shfl(esc_lane, r0 + 1); w[j2] = pk2(bf_lo(w[j2]) * s0, bf_hi(w[j2]) * s1); }
    return (u32x4){w[0], w[1], w[2], w[3]};
}
struct ScanBufs {
    bf16* QKVA;
    bf16* X2;
    float* Gt;
    bf16 *KT, *UT, *NW, *ATT;
    bf16 *KWT, *VT, *PT;
    float* DEN;
};
__device__ __forceinline__ void local_phase(LAS unsigned char* lds, const ScanBufs sb, const float* a_log, const float* dt_bias, const float* i_bias, const float* f_bias, int gw, int NGW, int wave, int lane) {
    LAS float* Lw = (LAS float*)(lds + wave * 16384);
    const int njobs = 2 * BATCH * 4 * (SEQ / 64), per = (njobs + NGW - 1) / NGW; const int lane_in = lane;
#pragma unroll 1
    for (int rj = 0; rj < per; ++rj) {
        const int job = gw * per + rj; if (job >= njobs) break;
        int lane = lane_in; asm volatile("" : "+v"(lane));
        const int x = lane & 15, q = lane >> 4;
        const int mixer = job & 1, cidx = job >> 1, c = cidx & 31, h = (cidx >> 5) & 3, b = cidx >> 7;
        const int m0 = b * SEQ + c * 64; const size_t cid = (size_t)cidx;
        float* gr = sb.Gt + (size_t)(m0 + lane) * 16;
        if (mixer == 0) {
            const float beta = 1.f / (1.f + expf(-gr[h])); const float g = -expf(a_log[h]) * softplus_f(gr[4 + h] + dt_bias[h]);
            const float gcum = scan_add(g, lane), eg = expf(gcum), glast = __shfl(gcum, 63);
            const bf16* kb = sb.QKVA + (size_t)m0 * 1536 + 512 + h * 128; const bf16* qb = sb.QKVA + (size_t)m0 * 1536 + h * 128; const bf16* vb = kb + 512;
            bf16x8 Kf[4][4], Qf[4][4];
#pragma unroll
            for (int t = 0; t < 4; ++t)
#pragma unroll
                for (int ks = 0; ks < 4; ++ks) { Kf[t][ks] = *(const bf16x8*)(kb + (size_t)(16 * t + x) * 1536 + 32 * ks + 8 * q); Qf[t][ks] = *(const bf16x8*)(qb + (size_t)(16 * t + x) * 1536 + 32 * ks + 8 * q); }
            float gj[4][4];
#pragma unroll
            for (int jt = 0; jt < 4; ++jt)
#pragma unroll
                for (int r = 0; r < 4; ++r) gj[jt][r] = __shfl(gcum, 16 * jt + 4 * q + r);
            bf16* attp = sb.ATT + cid * 4096;
#pragma unroll
            for (int it = 0; it < 4; ++it) {
                const float gi = __shfl(gcum, 16 * it + x), bi = __shfl(beta, 16 * it + x); f32x4 d2s[4];
#pragma unroll
                for (int jt = 0; jt < 4; ++jt) {
                    if (jt <= it) { f32x4 D1 = {0.f, 0.f, 0.f, 0.f}, D2 = D1;
#pragma unroll
                        for (int ks = 0; ks < 4; ++ks) { D1 = MFMA16(Kf[jt][ks], Kf[it][ks], D1); D2 = MFMA16(Kf[jt][ks], Qf[it][ks], D2); }
                        f32x4 lv;
#pragma unroll
                        for (int r = 0; r < 4; ++r) { const int j = 16 * jt + 4 * q + r, i = 16 * it + x; const float dec = __expf(fminf(gi - gj[jt][r], 0.f));
                            lv[r] = (j < i) ? bi * D1[r] * dec : 0.f; d2s[jt][r] = (j <= i) ? D2[r] * dec : 0.f; }
#pragma unroll
                        for (int r = 0; r < 4; ++r) Lw[(16 * jt + 4 * q + r) * 64 + 16 * it + x] = lv[r];
                    } else d2s[jt] = (f32x4){0.f, 0.f, 0.f, 0.f};
                }
#pragma unroll
                for (int kp = 0; kp < 2; ++kp) if (it >= 2 || kp == 0) *(bf16x8*)(attp + ((it * 2 + kp) * 64 + lane) * 8) = pack8(d2s[2 * kp], d2s[2 * kp + 1]);
            }
            { float* tab = (float*)(attp + 512); tab[lane] = eg; tab[64 + lane] = expf(glast - gcum); }
            bf16* ktp = sb.KT + cid * 8192;
            LDS_WAIT();
            float xv[64];
#pragma unroll
            for (int i = 0; i < 64; ++i) xv[i] = (i == lane) ? 1.f : 0.f;
#pragma unroll
            for (int j = 0; j < 63; ++j) {
#pragma unroll
                for (int g4 = (j + 1) / 4; g4 < 16; ++g4) { const f32x4 lc = *(const LAS f32x4*)(Lw + j * 64 + 4 * g4);
                    if (4 * g4 + 0 > j) xv[4 * g4 + 0] -= lc.x * xv[j]; if (4 * g4 + 1 > j) xv[4 * g4 + 1] -= lc.y * xv[j]; if (4 * g4 + 2 > j) xv[4 * g4 + 2] -= lc.z * xv[j]; if (4 * g4 + 3 > j) xv[4 * g4 + 3] -= lc.w * xv[j]; }
            }
            LDS_WAIT();
            { LAS unsigned short* TL = (LAS unsigned short*)Lw;
#pragma unroll
              for (int i = 0; i < 64; ++i) TL[i * 64 + ((((lane >> 3) ^ (i & 7)) << 3) | (lane & 7))] = (unsigned short)(pk2(xv[i], 0.f) & 0xffffu); }
            LDS_WAIT();
            bf16x8 Tf[4][2];
#pragma unroll
            for (int it = 0; it < 4; ++it)
#pragma unroll
                for (int ks = 0; ks < 2; ++ks) { const int row = 16 * it + x; const LAS unsigned char* tb = (const LAS unsigned char*)Lw + row * 128;
                    const int c0 = 32 * ks + 4 * q, c1 = c0 + 16;
                    const u32x2 lo = *(const LAS u32x2*)(tb + ((((c0 >> 3) ^ (row & 7)) << 4) | ((c0 & 7) << 1))), hi = *(const LAS u32x2*)(tb + ((((c1 >> 3) ^ (row & 7)) << 4) | ((c1 & 7) << 1)));
                    const u32x4 w = {lo.x, lo.y, hi.x, hi.y}; Tf[it][ks] = __builtin_bit_cast(bf16x8, w); }
            const float be = beta * eg;
            bf16* utp = sb.UT + cid * 8192;
#pragma unroll 4
            for (int et = 0; et < 8; ++et) {
                bf16x8 vfr[2];
#pragma unroll
                for (int ks = 0; ks < 2; ++ks) { const u32x4 gth = tr_gather<true>(vb + 16 * et + x, 1536, ks, q, beta); vfr[ks] = __builtin_bit_cast(bf16x8, gth); }
#pragma unroll
                for (int mt = 0; mt < 4; ++mt) { f32x4 acc = {0.f, 0.f, 0.f, 0.f};
#pragma unroll
                    for (int ks = 0; ks < 2; ++ks) acc = MFMA16(Tf[mt][ks], vfr[ks], acc);
                    *(u32x2*)(utp + (size_t)(16 * et + x) * 64 + 16 * mt + 4 * q) = (u32x2){pk2v(acc.x, acc.y), pk2v(acc.z, acc.w)}; }
            }
            bf16* nwp = sb.NW + cid * 8192;
#pragma unroll 2
            for (int kp2 = 0; kp2 < 4; ++kp2) {
                bf16x8 kfr[2][2];
#pragma unroll
                for (int dd = 0; dd < 2; ++dd)
#pragma unroll
                    for (int ks = 0; ks < 2; ++ks) { const int dt = 2 * kp2 + dd; const u32x4 raw = tr_gather<false>(kb + 16 * dt + x, 1536, ks, q, 0.f);
                        *(u32x4*)(ktp + ((dt * 2 + ks) * 64 + lane) * 8) = raw;
                        kfr[dd][ks] = __builtin_bit_cast(bf16x8, scale_frag(raw, ks, q, be)); }
#pragma unroll
                for (int it = 0; it < 4; ++it) { f32x4 a0 = {0.f, 0.f, 0.f, 0.f}, a1 = a0;
#pragma unroll
                    for (int ks = 0; ks < 2; ++ks) { a0 = MFMA16(kfr[0][ks], Tf[it][ks], a0); a1 = MFMA16(kfr[1][ks], Tf[it][ks], a1); }
                    a0 = a0 * -1.f; a1 = a1 * -1.f;
                    *(u32x4*)(nwp + ((it * 4 + kp2) * 64 + lane) * 8) = (u32x4){pk2v(a0.x, a0.y), pk2v(a0.z, a0.w), pk2v(a1.x, a1.y), pk2v(a1.z, a1.w)}; }
            }
            LDS_WAIT();
        } else {
            const float il = gr[8 + h] + i_bias[h]; const float fl = -softplus_f(-(gr[12 + h] + f_bias[h]));
            const float bcum = scan_add(fl, lane), t = il - bcum, pm = scan_max(t, lane), pml = __shfl(pm, 63);
            const float esc = __expf(t - pml);
            const bf16* qb = sb.X2 + (size_t)m0 * 2560 + 512 + h * 128; const bf16* kb = qb + 512; const bf16* vb = kb + 512;
            bf16x8 Kf[4][4], Qf[4][4];
#pragma unroll
            for (int tt = 0; tt < 4; ++tt)
#pragma unroll
                for (int ks = 0; ks < 4; ++ks) { Kf[tt][ks] = *(const bf16x8*)(kb + (size_t)(16 * tt + x) * 2560 + 32 * ks + 8 * q); Qf[tt][ks] = *(const bf16x8*)(qb + (size_t)(16 * tt + x) * 2560 + 32 * ks + 8 * q); }
            float tj[4][4];
#pragma unroll
            for (int jt = 0; jt < 4; ++jt)
#pragma unroll
                for (int r = 0; r < 4; ++r) tj[jt][r] = __shfl(t, 16 * jt + 4 * q + r);
            bf16* ptp = sb.PT + cid * 4096;
#pragma unroll
            for (int it = 0; it < 4; ++it) {
                const float pmi = __shfl(pm, 16 * it + x); f32x4 d2s[4];
#pragma unroll
                for (int jt = 0; jt < 4; ++jt) {
                    if (jt <= it) { f32x4 D2 = {0.f, 0.f, 0.f, 0.f};
#pragma unroll
                        for (int ks = 0; ks < 4; ++ks) D2 = MFMA16(Kf[jt][ks], Qf[it][ks], D2);
#pragma unroll
                        for (int r = 0; r < 4; ++r) { const int j = 16 * jt + 4 * q + r, i = 16 * it + x; d2s[jt][r] = (j <= i) ? D2[r] * 0.08838834764831845f * __expf(fminf(tj[jt][r] - pmi, 0.f)) : 0.f; }
                    } else d2s[jt] = (f32x4){0.f, 0.f, 0.f, 0.f};
                }
#pragma unroll
                for (int kp = 0; kp < 2; ++kp) if (it >= 2 || kp == 0) *(bf16x8*)(ptp + ((it * 2 + kp) * 64 + lane) * 8) = pack8(d2s[2 * kp], d2s[2 * kp + 1]);
            }
            { float* tab = (float*)(ptp + 512); tab[lane] = bcum; tab[64 + lane] = bcum + pm; }
            bf16* kwp = sb.KWT + cid * 8192; bf16* vtp = sb.VT + cid * 8192;
#pragma unroll 2
            for (int dt = 0; dt < 8; ++dt)
#pragma unroll
                for (int kp = 0; kp < 2; ++kp) { *(u32x4*)(kwp + ((dt * 2 + kp) * 64 + lane) * 8) = tr_gather<true>(kb + 16 * dt + x, 2560, kp, q, esc);
                    *(u32x4*)(vtp + ((dt * 2 + kp) * 64 + lane) * 8) = tr_gather<false>(vb + 16 * dt + x, 2560, kp, q, 0.f); }
        }
    }
}
constexpr int RC_NW = 0, RC_ATT = 16384, RC_KT = 24576, RC_QP = 40960, RC_BUF = 57344;
__device__ __forceinline__ void recur_stage(LAS unsigned char* buf, const bf16* f16a  , const bf16* f8  , const bf16* f16b  , const bf16* qbase  , int qpitch, int wave, int lane) {
#pragma unroll
    for (int k = 0; k < 5; ++k) { const int bl = wave + 8 * k;
        const bf16* src = bl < 16 ? f16a + bl * 512 : (bl < 24 ? f8 + (bl - 16) * 512 : f16b + (bl - 24) * 512);
        __builtin_amdgcn_global_load_lds((const unsigned*)(src + lane * 8), (LAS unsigned*)(buf + bl * 1024), 16, 0, 0); }
#pragma unroll
    for (int k = 0; k < 8; ++k) { const int P = (wave * 8 + k) * 256 + lane * 4, f = P >> 10, lp = (P & 1023) >> 4, jj0 = ((P & 15) >> 2) * 2, it = f >> 2, ks = f & 3, xp = lp & 15, qp = lp >> 4;
        const bf16* src = qbase + (size_t)(16 * it + xp) * qpitch + kperm(ks, qp, jj0);
        __builtin_amdgcn_global_load_lds((const unsigned*)src, (LAS unsigned*)(buf + RC_QP + (wave * 8 + k) * 256), 4, 0, 0); }
}
__device__ __forceinline__ void recur_phase(LAS unsigned char* lds, const ScanBufs sb, int G, int bid, int wave, int lane) {
    const int x = lane & 15, q = lane >> 4, et = wave;
#pragma unroll 1
    for (int u = bid; u < 2 * BATCH * 4; u += G) {
        const int mixer = u >> 7, b = (u & 127) >> 2, h = u & 3;
        const size_t cid0 = (size_t)((b * 4 + h) * 32);
        if (mixer == 0) {
            f32x4 S[8];
#pragma unroll
            for (int d = 0; d < 8; ++d) S[d] = (f32x4){0.f, 0.f, 0.f, 0.f};
            recur_stage(lds, sb.NW + cid0 * 8192, sb.ATT + cid0 * 4096, sb.KT + cid0 * 8192, sb.QKVA + (size_t)(b * SEQ) * 1536 + h * 128, 1536, wave, lane);
            __syncthreads();
#pragma unroll 1
            for (int c = 0; c < SEQ / 64; ++c) {
                const int m0 = b * SEQ + c * 64; const size_t cid = cid0 + c;
                const LAS unsigned char* buf = lds + (c & 1) * RC_BUF;
                { const int cn = c + 1 < SEQ / 64 ? c + 1 : c; const size_t cidn = cid0 + cn;
                  recur_stage(lds + ((c + 1) & 1) * RC_BUF, sb.NW + cidn * 8192, sb.ATT + cidn * 4096, sb.KT + cidn * 8192, sb.QKVA + (size_t)(b * SEQ + cn * 64) * 1536 + h * 128, 1536, wave, lane); }
                const bf16* utp = sb.UT + cid * 8192 + (size_t)(16 * et + x) * 64;
                const LAS float* tab = (const LAS float*)(buf + RC_ATT + 1024);
                bf16x8 Sb[4];
#pragma unroll
                for (int ks = 0; ks < 4; ++ks) Sb[ks] = pack8(S[2 * ks], S[2 * ks + 1]);
                f32x4 vn[4];
                { bf16x8 fr[16]; u32x2 uu[4];
#pragma unroll
                  for (int i = 0; i < 16; ++i) fr[i] = *(const LAS bf16x8*)(buf + RC_NW + (i * 64 + lane) * 16);
#pragma unroll
                  for (int mt = 0; mt < 4; ++mt) uu[mt] = *(const u32x2*)(utp + 16 * mt + 4 * q);
                  __builtin_amdgcn_sched_barrier(0);
#pragma unroll
                  for (int mt = 0; mt < 4; ++mt) { f32x4 acc = {bf_lo(uu[mt].x), bf_hi(uu[mt].x), bf_lo(uu[mt].y), bf_hi(uu[mt].y)};
#pragma unroll
                    for (int ks = 0; ks < 4; ++ks) acc = MFMA16(fr[mt * 4 + ks], Sb[ks], acc);
                    vn[mt] = acc; } }
                bf16x8 vb2[2] = {pack8(vn[0], vn[1]), pack8(vn[2], vn[3])};
                bf16x8 fq[16], fa[8]; float egl[4];
#pragma unroll
                for (int i = 0; i < 16; ++i) fq[i] = *(const LAS bf16x8*)(buf + RC_QP + (i * 64 + lane) * 16);
#pragma unroll
                for (int i = 0; i < 8; ++i) if (i >= 4 || (i & 1) == 0) fa[i] = *(const LAS bf16x8*)(buf + RC_ATT + (i * 64 + lane) * 16);
#pragma unroll
                for (int it = 0; it < 4; ++it) egl[it] = tab[16 * it + x];
                __builtin_amdgcn_sched_barrier(0);
#pragma unroll
                for (int it = 0; it < 4; ++it) { f32x4 acc = {0.f, 0.f, 0.f, 0.f};
#pragma unroll
                    for (int ks = 0; ks < 4; ++ks) acc = MFMA16(Sb[ks], fq[it * 4 + ks], acc);
                    acc = acc * egl[it];
#pragma unroll
                    for (int kp = 0; kp < 2; ++kp) if (it >= 2 || kp == 0) acc = MFMA16(vb2[kp], fa[it * 2 + kp], acc);
                    *(u32x2*)(sb.QKVA + (size_t)(m0 + 16 * it + x) * 1536 + 512 + h * 128 + 16 * et + 4 * q) = (u32x2){pk2v(acc.x, acc.y), pk2v(acc.z, acc.w)}; }
                f32x4 vs[4];
#pragma unroll
                for (int mt = 0; mt < 4; ++mt) { const f32x4 kk = *(const LAS f32x4*)(tab + 64 + 16 * mt + 4 * q); vs[mt] = vn[mt] * kk; }
                const bf16x8 vsb[2] = {pack8(vs[0], vs[1]), pack8(vs[2], vs[3])};
                const float gam = tab[63];
                { bf16x8 fk[16];
#pragma unroll
                  for (int i = 0; i < 16; ++i) fk[i] = *(const LAS bf16x8*)(buf + RC_KT + (i * 64 + lane) * 16);
                  __builtin_amdgcn_sched_barrier(0);
#pragma unroll
                  for (int dt = 0; dt < 8; ++dt) { f32x4 acc = S[dt] * gam;
#pragma unroll
                    for (int kp = 0; kp < 2; ++kp) acc = MFMA16(fk[dt * 2 + kp], vsb[kp], acc);
                    S[dt] = acc; } }
                __syncthreads();
            }
        } else {
            f32x4 Cs[8], Ce[8]; float mrun = 0.f;
#pragma unroll
            for (int d = 0; d < 8; ++d) { Cs[d] = (f32x4){0.f, 0.f, 0.f, 0.f}; Ce[d] = Cs[d]; }
            const short one = (x == 0) ? (short)0x3F80 : (short)0; const bf16x8 ones = {one, one, one, one, one, one, one, one};
            recur_stage(lds, sb.KWT + cid0 * 8192, sb.PT + cid0 * 4096, sb.KWT + cid0 * 8192, sb.X2 + (size_t)(b * SEQ) * 2560 + 512 + h * 128, 2560, wave, lane);
            __syncthreads();
#pragma unroll 1
            for (int c = 0; c < SEQ / 64; ++c) {
                const int m0 = b * SEQ + c * 64; const size_t cid = cid0 + c;
                const LAS unsigned char* buf = lds + (c & 1) * RC_BUF;
                { const int cn = c + 1 < SEQ / 64 ? c + 1 : c; const size_t cidn = cid0 + cn;
                  recur_stage(lds + ((c + 1) & 1) * RC_BUF, sb.KWT + cidn * 8192, sb.PT + cidn * 4096, sb.KWT + cidn * 8192, sb.X2 + (size_t)(b * SEQ + cn * 64) * 2560 + 512 + h * 128, 2560, wave, lane); }
                const bf16* vtp = sb.VT + cid * 8192;
                const LAS float* tab = (const LAS float*)(buf + RC_ATT + 1024);
                bf16x8 Cb[4], Eb[4];
#pragma unroll
                for (int ks = 0; ks < 4; ++ks) { Cb[ks] = pack8(Cs[2 * ks], Cs[2 * ks + 1]); Eb[ks] = pack8(Ce[2 * ks], Ce[2 * ks + 1]); }
                const bf16x8 vf[2] = {*(const bf16x8*)(vtp + ((et * 2 + 0) * 64 + lane) * 8), *(const bf16x8*)(vtp + ((et * 2 + 1) * 64 + lane) * 8)};
#pragma unroll
                for (int it = 0; it < 4; ++it) {
                    bf16x8 fq[16], fp[8];
#pragma unroll
                    for (int ks = 0; ks < 4; ++ks) fq[it * 4 + ks] = *(const LAS bf16x8*)(buf + RC_QP + ((it * 4 + ks) * 64 + lane) * 16);
#pragma unroll
                    for (int kp = 0; kp < 2; ++kp) if (it >= 2 || kp == 0) fp[it * 2 + kp] = *(const LAS bf16x8*)(buf + RC_ATT + ((it * 2 + kp) * 64 + lane) * 16);
                    const float bc = tab[16 * it + x], mi = tab[64 + 16 * it + x];
                    __builtin_amdgcn_sched_barrier(0);
                    const float a = bc + mrun, mt = fmaxf(a, mi), f1 = __expf(a - mt) * 0.08838834764831845f, f2 = __expf(mi - mt);
                    f32x4 a1 = {0.f, 0.f, 0.f, 0.f}, aP = a1, e1 = a1, eP = a1;
#pragma unroll
                    for (int ks = 0; ks < 4; ++ks) { const bf16x8 qf = fq[it * 4 + ks];
                        a1 = MFMA16(Cb[ks], qf, a1); if (wave == 0) e1 = MFMA16(Eb[ks], qf, e1); }
#pragma unroll
                    for (int kp = 0; kp < 2; ++kp) if (it >= 2 || kp == 0) { const bf16x8 pf = fp[it * 2 + kp]; aP = MFMA16(vf[kp], pf, aP); if (wave == 0) eP = MFMA16(ones, pf, eP); }
                    const f32x4 nm = a1 * f1 + aP * f2;
                    *(u32x2*)(sb.X2 + (size_t)(m0 + 16 * it + x) * 2560 + 1024 + h * 128 + 16 * et + 4 * q) = (u32x2){pk2(nm.x, nm.y), pk2(nm.z, nm.w)};
                    if (wave == 0 && q == 0) sb.DEN[(size_t)(m0 + 16 * it + x) * 4 + h] = fmaxf(fabsf(e1.x * f1 + eP.x * f2), __expf(-mt));
                }
                const float blast = tab[63], wsmax = tab[127];
                const float mnew = fmaxf(blast + mrun, wsmax), sc = __expf(blast + mrun - mnew), s2 = __expf(wsmax - mnew); mrun = mnew;
                bf16x8 fk[16];
#pragma unroll
                for (int i = 0; i < 16; ++i) fk[i] = *(const LAS bf16x8*)(buf + RC_KT + (i * 64 + lane) * 16);
                __builtin_amdgcn_sched_barrier(0);
#pragma unroll
                for (int dt = 0; dt < 8; ++dt) { f32x4 dC = {0.f, 0.f, 0.f, 0.f}, dE = dC;
#pragma unroll
                    for (int kp = 0; kp < 2; ++kp) { const bf16x8 kf = fk[dt * 2 + kp]; dC = MFMA16(kf, vf[kp], dC); if (wave == 0) dE = MFMA16(kf, ones, dE); }
                    Cs[dt] = Cs[dt] * sc + dC * s2; if (wave == 0) Ce[dt] = Ce[dt] * sc + dE * s2; }
                __syncthreads();
            }
        }
    }
}
__device__ __forceinline__ void post_phase(const ScanBufs sb, const float* norm_a, const float* norm_b, bf16* MIXED, int gw, int NGW, int lane) {
    const int hh = lane >> 3, sub = (lane & 7) * 16;
#pragma unroll 2
    for (int m = gw; m < M; m += NGW) {
        const bool isA = hh < 4; const int h = hh & 3;
        const bf16* src = isA ? sb.QKVA + (size_t)m * 1536 + 512 + h * 128 + sub : sb.X2 + (size_t)m * 2560 + 1024 + h * 128 + sub;
        const bf16* gsrc = sb.X2 + (size_t)m * 2560 + (isA ? 0 : 2048) + h * 128 + sub;
        const float* gn = (isA ? norm_a : norm_b + h * 128) + sub;
        const u32x4 r0 = *(const u32x4*)src, r1 = *(const u32x4*)(src + 8), z0 = *(const u32x4*)gsrc, z1 = *(const u32x4*)(gsrc + 8);
        float v[16] = {bf_lo(r0.x), bf_hi(r0.x), bf_lo(r0.y), bf_hi(r0.y), bf_lo(r0.z), bf_hi(r0.z), bf_lo(r0.w), bf_hi(r0.w), bf_lo(r1.x), bf_hi(r1.x), bf_lo(r1.y), bf_hi(r1.y), bf_lo(r1.z), bf_hi(r1.z), bf_lo(r1.w), bf_hi(r1.w)};
        const float z[16] = {bf_lo(z0.x), bf_hi(z0.x), bf_lo(z0.y), bf_hi(z0.y), bf_lo(z0.z), bf_hi(z0.z), bf_lo(z0.w), bf_hi(z0.w), bf_lo(z1.x), bf_hi(z1.x), bf_lo(z1.y), bf_hi(z1.y), bf_lo(z1.z), bf_hi(z1.z), bf_lo(z1.w), bf_hi(z1.w)};
        const float dinv = isA ? 1.f : 1.f / sb.DEN[(size_t)m * 4 + h];
        float ss = 0.f;
#pragma unroll
        for (int i = 0; i < 16; ++i) { v[i] *= dinv; ss += v[i] * v[i]; }
        ss += __shfl_xor(ss, 1); ss += __shfl_xor(ss, 2); ss += __shfl_xor(ss, 4);
        const float rstd = rsqrtf(ss * (1.f / 128.f) + EPS);
        float y[16];
#pragma unroll
        for (int i = 0; i < 16; ++i) { const float sg = sigmoid_f(z[i]); y[i] = v[i] * rstd * gn[i] * (isA ? z[i] * sg : sg); }
        u32x4* dst = (u32x4*)(MIXED + (size_t)m * 1024 + lane * 16);
        dst[0] = (u32x4){pk2(y[0], y[1]), pk2(y[2], y[3]), pk2(y[4], y[5]), pk2(y[6], y[7])}; dst[1] = (u32x4){pk2(y[8], y[9]), pk2(y[10], y[11]), pk2(y[12], y[13]), pk2(y[14], y[15])};
    }
}
typedef short v4i16_t __attribute__((ext_vector_type(4)));
constexpr int AT_VROW = 80;
constexpr int AT_K_BYTES = 256 * 128, AT_V_BYTES = 272 * AT_VROW * 2;
__device__ __forceinline__ void attn_phase(LAS unsigned char* lds, int tid, int wave, const bf16* QKV, const float* sinks, bf16* O, int G, int bid) {
    LAS unsigned char* KL = lds; LAS unsigned char* VL = lds + AT_K_BYTES;
    const int lane = tid & 63, x = lane & 15, q = lane >> 4, g = wave >> 1, qh = wave & 1;
    u32x4 kreg[4], vreg[4];
#define AT_LOAD_KV(uu) do { const int b_ = (uu) >> 6, kvh_ = ((uu) >> 4) & 3, jb_ = (uu) & 15; _Pragma("unroll") for (int i = 0; i < 4; ++i) { const int item = tid + 512 * i, r = item >> 3, ch = item & 7, sk = (jb_ - 1) * 128 + r; \
        kreg[i] = (u32x4){0u, 0u, 0u, 0u}; vreg[i] = kreg[i]; if (sk >= 0) { const bf16* src = QKV + (size_t)(b_ * SEQ + sk) * 1536 + 1024 + kvh_ * 64 + ch * 8; kreg[i] = *(const u32x4*)src; vreg[i] = *(const u32x4*)(src + 256); } } } while (0)
    if (bid < BATCH * 4 * 16) AT_LOAD_KV(bid);
#pragma unroll 1
    for (int u = bid; u < BATCH * 4 * 16; u += G) {
        const int b = u >> 6, kvh = (u >> 4) & 3, jb = u & 15;
#pragma unroll
        for (int i = 0; i < 4; ++i) { const int item = tid + 512 * i, r = item >> 3, ch = item & 7;
            *(LAS u32x4*)(KL + r * 128 + ((ch ^ (r & 7)) << 4)) = kreg[i]; *(LAS u32x4*)(VL + r * (AT_VROW * 2) + ch * 16) = vreg[i]; }
        if (tid < 128) { const int r = 256 + (tid >> 3), ch = tid & 7; unsigned z0 = 0u; asm volatile("" : "+v"(z0));
            *(LAS u32x4*)(VL + r * (AT_VROW * 2) + ch * 16) = (u32x4){z0, z0, z0, z0}; }
        __syncthreads();
        if (u + G < BATCH * 4 * 16) AT_LOAD_KV(u + G);
        const int hq = kvh * 4 + g; const float sink = sinks[hq];
        const size_t mq = (size_t)b * SEQ + jb * 128 + 64 * qh;
        bf16x8 Qn[2];
#pragma unroll
        for (int ks = 0; ks < 2; ++ks) Qn[ks] = *(const bf16x8*)(QKV + (mq + x) * 1536 + hq * 64 + 32 * ks + 8 * q);
#pragma unroll 1
        for (int nt = 0; nt < 4; ++nt) {
            const bf16x8 Qf[2] = {Qn[0], Qn[1]};
            { const int nn = nt < 3 ? nt + 1 : 3;
#pragma unroll
              for (int ks = 0; ks < 2; ++ks) Qn[ks] = *(const bf16x8*)(QKV + (mq + 16 * nn + x) * 1536 + hq * 64 + 32 * ks + 8 * q); }
            f32x4 s[9]; float mx = -3.0e38f;
            bf16x8 kf[9][2];
#pragma unroll
            for (int j = 0; j < 9; ++j) { const int r = 64 * qh + 16 * (nt + j) + x;
#pragma unroll
                for (int ks = 0; ks < 2; ++ks) kf[j][ks] = *(const LAS bf16x8*)(KL + r * 128 + (((4 * ks + q) ^ (r & 7)) << 4)); }
            __builtin_amdgcn_sched_barrier(0);
#pragma unroll
            for (int j = 0; j < 9; ++j) { const int kt = nt + j;
                f32x4 acc = {0.f, 0.f, 0.f, 0.f};
#pragma unroll
                for (int ks = 0; ks < 2; ++ks) acc = MFMA16(kf[j][ks], Qf[ks], acc);
#pragma unroll
                for (int rg = 0; rg < 4; ++rg) { const int diff = 16 * j + 4 * q + rg - x, ra = 64 * qh + 16 * kt + 4 * q + rg;
                    const bool valid = diff >= 1 && diff <= 128 && (jb - 1) * 128 + ra >= 0;
                    acc[rg] = valid ? acc[rg] : -3.0e38f; mx = fmaxf(mx, acc[rg]); }
                s[j] = acc; }
            mx = fmaxf(mx, __shfl_xor(mx, 16)); mx = fmaxf(mx, __shfl_xor(mx, 32)); mx = fmaxf(mx, sink);
            float sum = 0.f;
#pragma unroll
            for (int j = 0; j < 9; ++j)
#pragma unroll
                for (int rg = 0; rg < 4; ++rg) { const float p = (s[j][rg] > -1.0e38f) ? __expf(s[j][rg] - mx) : 0.f; s[j][rg] = p; sum += p; }
            sum += __shfl_xor(sum, 16); sum += __shfl_xor(sum, 32);
            const float inv = 1.f / (sum + __expf(sink - mx));
            bf16x8 Pf[5];
#pragma unroll
            for (int j2 = 0; j2 < 4; ++j2) Pf[j2] = pack8(s[2 * j2], s[2 * j2 + 1]);
            Pf[4] = pack8(s[8], (f32x4){0.f, 0.f, 0.f, 0.f});
            bf16x8 vf[4][5];
#pragma unroll
            for (int dt = 0; dt < 4; ++dt)
#pragma unroll
                for (int j2 = 0; j2 < 5; ++j2) { const int kb = 64 * qh + 16 * (nt + 2 * j2) + 4 * q + (x >> 2);
                    const LAS unsigned char* p0 = VL + kb * (AT_VROW * 2) + (16 * dt + 4 * (x & 3)) * 2;
                    const v4i16_t lo = __builtin_amdgcn_ds_read_tr16_b64_v4i16((LAS v4i16_t*)p0), hi = __builtin_amdgcn_ds_read_tr16_b64_v4i16((LAS v4i16_t*)(p0 + 16 * AT_VROW * 2));
                    vf[dt][j2] = (bf16x8){lo[0], lo[1], lo[2], lo[3], hi[0], hi[1], hi[2], hi[3]}; }
            __builtin_amdgcn_sched_barrier(0);
#pragma unroll
            for (int dt = 0; dt < 4; ++dt) { f32x4 acc = {0.f, 0.f, 0.f, 0.f};
#pragma unroll
                for (int j2 = 0; j2 < 5; ++j2) acc = MFMA16(vf[dt][j2], Pf[j2], acc);
                acc = acc * inv;
                *(u32x2*)(O + (mq + 16 * nt + x) * 1024 + hq * 64 + 16 * dt + 4 * q) = (u32x2){pk2v(acc.x, acc.y), pk2v(acc.z, acc.w)}; }
        }
        __syncthreads();
    }
}
#ifndef N_LAUNCH_MODE
#define N_LAUNCH_MODE 0
#endif
__global__ void __launch_bounds__(NTHR, 2) trunk_fwd(Args a_unused) {
    extern __shared__ __attribute__((aligned(16))) unsigned char lds_raw[];
    LAS unsigned char* lds = (LAS unsigned char*)lds_raw;
    volatile LAS unsigned* MISC = (volatile LAS unsigned*)(lds + MISC_OFF);
    if (threadIdx.x < 64) MISC[threadIdx.x] = 0u;
    __syncthreads();
    int lo, hi; XcdBarrier bar;
    int dupm = 0, dupp = 0; (void)dupm; (void)dupp;
    { KArgs a = kargs(); lo = a->ph_lo; hi = a->ph_hi; dupm = a->dup_mask; dupp = a->dup_par; unsigned* ctl = (unsigned*)(a->ws + WS_CTL);
      bar.bar = ctl + CW_BAR; bar.x = 0; bar.st = MISC + 8;
      if (hi - lo > 1) bar = xcd_barrier_post(ctl + CW_BAR, MISC + 8); }
#define IN(k) (lo <= (k) && (k) < hi)
#if defined(PROBE_DUP_MASK)
#define REP(k) _Pragma("unroll 1") for (int rep_ = 0; rep_ <= (((dupm >> (k)) & 1) && (dupp == 0 || dupp == 1 + (L & 1)) ? 1 : 0); ++rep_)
#else
#define REP(k)
#endif
#if defined(PROBE_BAR2)
#define SEAM(k) do { if (IN(k) && IN((k) + 1)) { xcd_barrier(bar); xcd_barrier(bar); } } while (0)
#else
#define SEAM(k) do { if (IN(k) && IN((k) + 1)) xcd_barrier(bar); } while (0)
#endif
#define ENV KArgs a = kargs(); const int tid = fresh_tid(), lane = tid & 63, wave = __builtin_amdgcn_readfirstlane(tid >> 6); const int G = gridDim.x, bid = blockIdx.x, gw = bid * NWAVES + wave, NGW = G * NWAVES, gtid = bid * NTHR + tid, NGT = G * NTHR; \
    unsigned char* ws = a->ws; bf16* RA = (bf16*)(ws + WS_RA); bf16* RB = (bf16*)(ws + WS_RB); bf16* RC = (bf16*)(ws + WS_RC); bf16* RD = (bf16*)(ws + WS_RD); float* Gt = (float*)(ws + WS_GT); \
    (void)lane; (void)wave; (void)gw; (void)NGW; (void)gtid; (void)NGT; (void)RA; (void)RB; (void)RC; (void)RD; (void)Gt; (void)G; (void)bid

    if (IN(0)) { ENV; prologue_phase(a, lds, gw, NGW, wave, lane, gtid, NGT);
#if defined(PROBE_DUP_MASK)
        if (dupm & (1 << 20)) prologue_phase(a, lds, gw, NGW, wave, lane, gtid, NGT);
#endif
    }
    SEAM(0);
#define SCANBUFS ScanBufs sb; sb.QKVA = (bf16*)(ws + WS_QKVA); sb.X2 = (bf16*)(ws + WS_X2); sb.Gt = Gt; sb.KT = (bf16*)(ws + WS_KT); sb.UT = (bf16*)(ws + WS_UT); sb.NW = (bf16*)(ws + WS_NW); sb.ATT = (bf16*)(ws + WS_ATT); \
    sb.KWT = (bf16*)(ws + WS_KWT); sb.VT = (bf16*)(ws + WS_VT); sb.PT = (bf16*)(ws + WS_PT); sb.DEN = (float*)(ws + WS_DEN)
#pragma unroll 1
    for (int L = 0; L < DEPTH; ++L) {
        const int pb = 1 + L * PH_PER_LAYER; const bool even = (L & 1) == 0; const int e = L >> 1;
        if (L == 0 && IN(pb + 0)) REP(0) { ENV; const float* hin = a->x;
            norm_phase(lds, hin, a->gains + (size_t)L * 4 * DM, (bf16*)a->out, (float*)(ws + WS_RS0), even, (const float*)(ws + WS_WGATES) + (size_t)e * 16 * 1024, Gt, gw, NGW, tid, lane); }
        if (L == 0) SEAM(pb + 0);
        if (IN(pb + 1)) REP(1) { ENV;
            const int N = even ? 4096 : 1536;
            pg8::Gemm g{(const bf16*)a->out, even ? (const bf16*)(ws + WS_WIN) + (size_t)e * 4096 * 1024 : (const bf16*)(ws + WS_WQKV) + (size_t)e * 1536 * 1024, M, N, DM};
            pg8::StaticOrder S; S.init(M, N, G, bid);
            pg8::EpiIn E{RC, (bf16*)(ws + WS_X2), even ? nullptr : a->b_qkv + (size_t)e * 1536, even ? nullptr : (const float*)(ws + WS_ROPE), (const float*)(ws + WS_RS0)};
            pg8::gemm_phase<pg8::EpiIn, pg8::StaticOrder, true, true>(lds, g, S, E);
        }
        SEAM(pb + 1);
        if (even) {
            if (IN(pb + 2)) REP(2) { ENV; conv_phase((const bf16*)(ws + WS_X1), a->conv + (size_t)e * 4 * 1536, (bf16*)(ws + WS_QKVA), gw, NGW, lane); }
            SEAM(pb + 2);
        }
        if (even) {
            if (IN(pb + 3)) REP(3) { ENV; SCANBUFS; local_phase(lds, sb, a->a_log + e * 4, a->dt_bias + e * 4, a->i_bias + e * 4, a->f_bias + e * 4, gw, NGW, wave, lane); }
            SEAM(pb + 3);
        }
        if (IN(pb + 4)) REP(4) { ENV;
            if (even) { SCANBUFS; recur_phase(lds, sb, G, bid, wave, lane); }
            else attn_phase(lds, tid, wave, RC, a->sinks + e * 16, RD, G, bid);
        }
        SEAM(pb + 4);
        if (even) {
            if (IN(pb + 5)) REP(5) { ENV; SCANBUFS; post_phase(sb, a->norm_a + e * 128, a->norm_b + e * 512, (bf16*)(ws + WS_MIXED), gw, NGW, lane); }
            SEAM(pb + 5);
        }
        if (IN(pb + 6)) REP(6) { ENV;
            pg8::Gemm g{even ? (const bf16*)(ws + WS_MIXED) : (const bf16*)RD, even ? (const bf16*)(ws + WS_WOUT) + (size_t)e * DM * DM : (const bf16*)(ws + WS_WO) + (size_t)e * DM * DM, M, DM, DM};
            pg8::StaticOrder S; S.init(M, DM, G, bid);
            pg8::EpiBf16<0> E{RA, DM, even ? nullptr : a->b_o + (size_t)e * DM, RA, 1 << 30, DM, nullptr};
            pg8::gemm_phase<pg8::EpiBf16<0>, pg8::StaticOrder, true, true>(lds, g, S, E);
        }
        SEAM(pb + 6);
        if (IN(pb + 7)) { ENV; const float* gains = a->gains + (size_t)L * 4 * DM;
            resid_a_phase(RA, (L == 0) ? a->x : nullptr, (bf16*)a->out, gains + DM, (float*)(ws + WS_RS2), gw, NGW, lane); }
        SEAM(pb + 7);
        if (IN(pb + 8)) REP(8) { ENV;
            pg8::Gemm g{(const bf16*)a->out, (const bf16*)(ws + WS_WUP) + (size_t)L * FF * DM, M, FF, DM};
            pg8::StaticOrder S; S.init(M, FF, G, bid);
            pg8::EpiBf16<1> E{RC, FF, nullptr, RC, 1 << 30, FF, (const float*)(ws + WS_RS2)};
            pg8::gemm_phase<pg8::EpiBf16<1>, pg8::StaticOrder, true, true>(lds, g, S, E);
        }
        SEAM(pb + 8);
        if (IN(pb + 9)) REP(9) { ENV;
            pg8::Gemm g{RC, (const bf16*)(ws + WS_WDN) + (size_t)L * DM * FF, M, DM, FF};
            pg8::StaticOrder S; S.init(M, DM, G, bid);
            pg8::EpiBf16<0> E{RA, DM, nullptr, RA, 1 << 30, DM, nullptr};
            pg8::gemm_phase<pg8::EpiBf16<0>, pg8::StaticOrder, true, true>(lds, g, S, E);
        }
        SEAM(pb + 9);
        if (IN(pb + 10)) { ENV; resid_b_phase(RA, (const bf16*)a->out, a->gains + (size_t)L * 4 * DM + 3 * DM, RD, a->p + (size_t)L * M * PLE, RC, gw, NGW, lane, gtid, NGT); }
        SEAM(pb + 10);
        if (IN(pb + 11)) REP(11) { ENV;
            pg8::Gemm g{RC, (const bf16*)(ws + WS_WPLE) + (size_t)L * DM * PLE, M, DM, PLE};
            pg8::StaticOrder S; S.init(M, DM, G, bid);
            pg8::EpiBf16<0> E{RB, DM, nullptr, RB, 1 << 30, DM, nullptr};
            pg8::gemm_phase<pg8::EpiBf16<0>, pg8::StaticOrder, true, true>(lds, g, S, E);
        }
        SEAM(pb + 11);
        if (IN(pb + 12)) { ENV;
            pg8::Gemm g{RD, (const bf16*)(ws + WS_WG) + (size_t)L * DM * DM, M, DM, DM};
            pg8::StaticOrder S; S.init(M, DM, G, bid);
            pg8::EpiBf16<0> E{(bf16*)(ws + WS_RC + 64 * MiB), DM, nullptr, RB, 1 << 30, DM, nullptr};
            pg8::gemm_phase<pg8::EpiBf16<0>, pg8::StaticOrder, true, true>(lds, g, S, E);
        }
        SEAM(pb + 12);
        if (IN(pb + 13)) { ENV; const bool has_next = L + 1 < DEPTH, even_next = ((L + 1) & 1) == 0; const int en = (L + 1) >> 1;
            resid_c_phase(lds, (const bf16*)(ws + WS_RC + 64 * MiB), RB, RD, (bf16*)a->out, a->out, has_next, a->gains + (size_t)(L + 1 < DEPTH ? L + 1 : L) * 4 * DM, (float*)(ws + WS_RS0), even_next, (const float*)(ws + WS_WGATES) + (size_t)(en & 1) * 16 * 1024, Gt, gw, NGW, tid, lane); }
        SEAM(pb + 13);
    }
#undef SCANBUFS
#undef IN
#undef SEAM
#undef ENV
}

extern "C" void kernel_launch(void* const* d_in, const int* in_sizes, int n_in, void* d_out, int out_size, void* d_ws, size_t ws_size, hipStream_t stream) {
    static int grid = 0;
    if (grid == 0) {
        if (n_in != 22 || in_sizes[0] != M * DM || out_size != M * DM || ws_size < WS_END) {
            fprintf(stderr, "kernel_launch: unexpected shapes (n_in %d, in0 %d, out %d, ws %zu; need ws >= %zu); nothing launched\n", n_in, n_in > 0 ? in_sizes[0] : -1, out_size, ws_size, (size_t)WS_END); grid = -1; return; }
        int dev = 0, cus = 0, per_cu = 0;
        if (hipGetDevice(&dev) != hipSuccess || hipDeviceGetAttribute(&cus, hipDeviceAttributeMultiprocessorCount, dev) != hipSuccess) { fprintf(stderr, "kernel_launch: device query failed\n"); grid = -1; return; }
        if (hipFuncSetAttribute((const void*)trunk_fwd, hipFuncAttributeMaxDynamicSharedMemorySize, LDS_BYTES) != hipSuccess) { fprintf(stderr, "kernel_launch: hipFuncSetAttribute failed\n"); grid = -1; return; }
        if (hipOccupancyMaxActiveBlocksPerMultiprocessor(&per_cu, (const void*)trunk_fwd, NTHR, LDS_BYTES) != hipSuccess || per_cu < 1) fprintf(stderr, "kernel_launch: note: occupancy query reports %d\n", per_cu);
        (void)hipGetLastError();
        grid = cus;
    }
    if (grid < 0) return;
    Args a{};
    a.x = (const float*)d_in[0]; a.p = (const float*)d_in[1]; a.pos = (const int*)d_in[2]; a.gains = (const float*)d_in[3]; a.w_in = (const float*)d_in[4]; a.conv = (const float*)d_in[5];
    a.a_log = (const float*)d_in[6]; a.dt_bias = (const float*)d_in[7]; a.norm_a = (const float*)d_in[8]; a.i_bias = (const float*)d_in[9]; a.f_bias = (const float*)d_in[10]; a.norm_b = (const float*)d_in[11];
    a.b_qkv = (const float*)d_in[14]; a.sinks = (const float*)d_in[15]; a.b_o = (const float*)d_in[17];
    a.out = (float*)d_out; a.ws = (unsigned char*)d_ws;
#if defined(PROBE_DUP_MASK)
    a.dup_mask = PROBE_DUP_MASK; a.dup_par = PROBE_DUP_PAR;
#endif
    a.w_out = (const float*)d_in[12]; a.w_qkv = (const float*)d_in[13]; a.w_o = (const float*)d_in[16]; a.w_up = (const float*)d_in[18]; a.w_down = (const float*)d_in[19]; a.w_ple = (const float*)d_in[20]; a.w_gate = (const float*)d_in[21];
#if N_LAUNCH_MODE == 0
    if (hipMemsetAsync((char*)d_ws + WS_CTL, 0, CTL_ZERO_BYTES, stream) != hipSuccess) { fprintf(stderr, "kernel_launch: memset failed\n"); return; }
    a.ph_lo = 0; a.ph_hi = NPHASE;
    hipLaunchKernelGGL(trunk_fwd, dim3(grid), dim3(NTHR), LDS_BYTES, stream, a);
#else
    for (int ph = 0; ph < NPHASE; ++ph) { a.ph_lo = ph; a.ph_hi = ph + 1; hipLaunchKernelGGL(trunk_fwd, dim3(grid), dim3(NTHR), LDS_BYTES, stream, a); }
#endif
    const hipError_t le = hipPeekAtLastError();
    if (le != hipSuccess) fprintf(stderr, "kernel_launch: launch failed: %s\n", hipGetErrorName(le));
}
```

```cpp
#include <hip/hip_runtime.h>
#include <cstdio>
#include <cstdint>
#define N_LAUNCH_MODE 0
namespace pg8 {
#define PG8_LAS __attribute__((address_space(3)))
typedef unsigned short bf16_t;
typedef short bf16x8 __attribute__((ext_vector_type(8)));
typedef float f32x4 __attribute__((ext_vector_type(4)));
typedef unsigned u32x4 __attribute__((ext_vector_type(4)));
constexpr int BM = 256, BK = 64, HALF = 128, HTB = HALF * BK * 2  , STAGE_BYTES = 8 * HTB, NXCD = 8, WGM = 8;

__host__ __device__ __forceinline__ int lds_byte(int r, int c) { const int st = (r >> 4) * 2 + (c >> 5), rr = r & 15, cc = c & 31, ob = rr * 64 + cc * 2; return st * 1024 + (ob ^ (((ob >> 9) & 1) << 5)); }
__host__ __device__ __forceinline__ void stage_rc(int b, int& R, int& C) { const int st = b / 1024, sb = b % 1024, swz = sb ^ (((sb >> 9) & 1) << 5); R = (st >> 1) * 16 + swz / 64; C = (st & 1) * 32 + (swz % 64) / 2; }
__host__ __device__ __forceinline__ int perm32(int rho) { const int n = rho >> 4, i = rho & 15; return 8 * (i >> 2) + 4 * n + (i & 3); }

struct Unit { int pm, pn; };
struct Gemm { const bf16_t* A; const bf16_t* Bt; int M, N, K; };

struct StaticOrder {
    int nM, nN, nwg, G, c;
    __host__ __device__ void init(int M, int N, int G_, int c_) { nM = M / BM; nN = N / BM; nwg = nM * nN; G = G_; c = c_; }
    __host__ __device__ bool next(int i, Unit& u) const {
        const long L = (long)i * G + c; if (L >= nwg) return false;
        int wgid = (int)L; { const int q = nwg / NXCD, r = nwg % NXCD, xcd = wgid % NXCD, off = wgid / NXCD; wgid = (xcd < r ? xcd * (q + 1) : r * (q + 1) + (xcd - r) * q) + off; }
        const int nig = WGM * nN, gid = wgid / nig, fm = gid * WGM, gsz = (nM - fm) < WGM ? (nM - fm) : WGM;
        u.pm = fm + ((wgid % nig) % gsz); u.pn = (wgid % nig) / gsz; return true;
    }
    __device__ __forceinline__ void a_ready(const Unit&) const {}
    __device__ __forceinline__ void done(const Unit&) const {}
};

__device__ __forceinline__ unsigned cvt_pk_bf16(float lo, float hi) { unsigned r; asm volatile("v_cvt_pk_bf16_f32 %0, %1, %2" : "=v"(r) : "v"(lo), "v"(hi)); return r; }
typedef float f32x2 __attribute__((ext_vector_type(2)));
typedef unsigned u32x2 __attribute__((ext_vector_type(2)));

template <int ACT  > struct EpiBf16 {
    static constexpr bool PERM = true, AFTER_DRAIN = false;
    bf16_t* O; int ldc; const float* bias; bf16_t* O2; int split_col, ldc2; const float* rowscale;
    __device__ __forceinline__ void operator()(const f32x4 (&acc)[2][2][4][2], const Unit& u, int wr, int wc, int fr, int fq) const {
        const int row0 = u.pm * BM + wr * 64 + fr; const int col0 = u.pn * BM + wc * 32 + 8 * fq;
        const bool second = u.pn * BM >= split_col; bf16_t* const ob = second ? O2 : O; const int ld = second ? ldc2 : ldc, oc0 = second ? col0 - split_col : col0;
        f32x4 bv[2][2];
#pragma unroll
        for (int bj = 0; bj < 2; ++bj)
#pragma unroll
            for (int n = 0; n < 2; ++n) bv[bj][n] = bias ? *(const f32x4*)(bias + col0 + bj * HALF + 4 * n) : (f32x4){0.f, 0.f, 0.f, 0.f};
#pragma unroll
        for (int ai = 0; ai < 2; ++ai)
#pragma unroll
            for (int m = 0; m < 4; ++m) { bf16_t* rowp = ob + (size_t)(row0 + ai * HALF + m * 16) * ld + oc0; const float rs = rowscale ? rowscale[row0 + ai * HALF + m * 16] : 1.f;
#pragma unroll
                for (int bj = 0; bj < 2; ++bj) { f32x4 v0 = acc[ai][bj][m][0] * rs + bv[bj][0], v1 = acc[ai][bj][m][1] * rs + bv[bj][1];
                    if (ACT == 1) {
#pragma unroll
                        for (int i = 0; i < 4; ++i) { const float a = fmaxf(v0[i], 0.f), b = fmaxf(v1[i], 0.f); v0[i] = a * a; v1[i] = b * b; } }
                    u32x4 w; w.x = cvt_pk_bf16(v0[0], v0[1]); w.y = cvt_pk_bf16(v0[2], v0[3]); w.z = cvt_pk_bf16(v1[0], v1[1]); w.w = cvt_pk_bf16(v1[2], v1[3]);
                    *(u32x4*)(rowp + bj * HALF) = w; } }
    }
};
struct EpiIn {
    static constexpr bool PERM = true, AFTER_DRAIN = false;
    bf16_t* O; bf16_t* O2; const float* bias; const float* rope; const float* rowscale;
    __device__ __forceinline__ void operator()(const f32x4 (&acc)[2][2][4][2], const Unit& u, int wr, int wc, int fr, int fq) const {
        const int row0 = u.pm * BM + wr * 64 + fr, colt = u.pn * BM + wc * 32 + 8 * fq, g = (colt & 63) >> 3;
        const bool rot = rope != nullptr && u.pn < 5, second = rope == nullptr && u.pn >= 6;
        bf16_t* const ob = second ? O2 : O; const int ld = second ? 2560 : 1536, oc0 = second ? colt - 1536 : colt;
#pragma unroll
        for (int ai = 0; ai < 2; ++ai)
#pragma unroll
            for (int m = 0; m < 4; ++m) { const int row = row0 + ai * HALF + m * 16; bf16_t* rowp = ob + (size_t)row * ld;
                const float rs = rowscale[row]; f32x4 t0 = {1.f, 0.f, 1.f, 0.f}, t1 = t0;
                if (rot) { t0 = *(const f32x4*)(rope + (size_t)row * 64 + 8 * g); t1 = *(const f32x4*)(rope + (size_t)row * 64 + 8 * g + 4); }
#pragma unroll
                for (int bj = 0; bj < 2; ++bj) { const int c = colt + bj * HALF, hd = c >> 6; f32x4 v0 = acc[ai][bj][m][0] * rs, v1 = acc[ai][bj][m][1] * rs;
                    if (rope) { v0 = v0 + (rot ? *(const f32x4*)(bias + hd * 64 + 4 * g) : *(const f32x4*)(bias + c)); v1 = v1 + (rot ? *(const f32x4*)(bias + hd * 64 + 32 + 4 * g) : *(const f32x4*)(bias + c + 4)); }
                    if (rot) { const float sc = c < 1024 ? 0.125f : 1.f; const f32x4 cs = {t0.x, t0.z, t1.x, t1.z}, sn = {t0.y, t0.w, t1.y, t1.w};
                        const f32x4 o1 = (v0 * cs - v1 * sn) * sc, o2 = (v1 * cs + v0 * sn) * sc;
                        u32x2 w1, w2; w1.x = cvt_pk_bf16(o1[0], o1[1]); w1.y = cvt_pk_bf16(o1[2], o1[3]); w2.x = cvt_pk_bf16(o2[0], o2[1]); w2.y = cvt_pk_bf16(o2[2], o2[3]);
                        *(u32x2*)(rowp + hd * 64 + 4 * g) = w1; *(u32x2*)(rowp + hd * 64 + 32 + 4 * g) = w2; }
                    else {
                        u32x4 w; w.x = cvt_pk_bf16(v0[0], v0[1]); w.y = cvt_pk_bf16(v0[2], v0[3]); w.z = cvt_pk_bf16(v1[0], v1[1]); w.w = cvt_pk_bf16(v1[2], v1[3]); *(u32x4*)(rowp + oc0 + bj * HALF) = w; } } }
    }
};
struct EpiF32 {
    static constexpr bool PERM = false, AFTER_DRAIN = false;
    float* C; int ldc; const float* bias;
    __device__ __forceinline__ void operator()(const f32x4 (&acc)[2][2][4][2], const Unit& u, int wr, int wc, int fr, int fq) const {
        const int row0 = u.pm * BM + wr * 64 + fr, col0 = u.pn * BM + wc * 32 + 4 * fq;
        f32x4 bv[2][2];
#pragma unroll
        for (int bj = 0; bj < 2; ++bj)
#pragma unroll
            for (int n = 0; n < 2; ++n) bv[bj][n] = bias ? *(const f32x4*)(bias + col0 + bj * HALF + n * 16) : (f32x4){0.f, 0.f, 0.f, 0.f};
#pragma unroll
        for (int ai = 0; ai < 2; ++ai)
#pragma unroll
            for (int m = 0; m < 4; ++m) { float* rowp = C + (size_t)(row0 + ai * HALF + m * 16) * ldc + col0;
#pragma unroll
                for (int bj = 0; bj < 2; ++bj)
#pragma unroll
                    for (int n = 0; n < 2; ++n) *(f32x4*)(rowp + bj * HALF + n * 16) = acc[ai][bj][m][n] + bv[bj][n]; }
    }
};
__device__ __forceinline__ float bf_lo(unsigned w) { return __builtin_bit_cast(float, w << 16); }
__device__ __forceinline__ float bf_hi(unsigned w) { return __builtin_bit_cast(float, w & 0xffff0000u); }
struct EpiGate {
    static constexpr bool PERM = false, AFTER_DRAIN = false;
    float* H; const bf16_t* PP; int ldc;
    __device__ __forceinline__ void operator()(const f32x4 (&acc)[2][2][4][2], const Unit& u, int wr, int wc, int fr, int fq) const {
        const int row0 = u.pm * BM + wr * 64 + fr, col0 = u.pn * BM + wc * 32 + 4 * fq;
#pragma unroll
        for (int ai = 0; ai < 2; ++ai)
#pragma unroll
            for (int m = 0; m < 4; ++m) { const size_t ro = (size_t)(row0 + ai * HALF + m * 16) * ldc + col0;
#pragma unroll
                for (int bj = 0; bj < 2; ++bj)
#pragma unroll
                    for (int n = 0; n < 2; ++n) { const size_t off = ro + bj * HALF + n * 16;
                        f32x4 hv = *(const f32x4*)(H + off); const u32x2 pv = *(const u32x2*)(PP + off); const f32x4 a = acc[ai][bj][m][n];
                        const float p0 = bf_lo(pv.x), p1 = bf_hi(pv.x), p2 = bf_lo(pv.y), p3 = bf_hi(pv.y);
                        hv[0] += p0 / (1.f + __expf(-a[0])); hv[1] += p1 / (1.f + __expf(-a[1])); hv[2] += p2 / (1.f + __expf(-a[2])); hv[3] += p3 / (1.f + __expf(-a[3]));
                        *(f32x4*)(H + off) = hv; } }
    }
};

template <class Epi, class Sched, bool ALIGN_EPI = false, bool SP2 = false>
__device__ __forceinline__ void gemm_phase(PG8_LAS unsigned char* lds, const Gemm g, const Sched& S, const Epi& E) {
    int tid_l = threadIdx.x; asm volatile("" : "+v"(tid_l));
    const int tid = tid_l, wid = __builtin_amdgcn_readfirstlane(tid >> 6), lane = tid & 63, wr = wid >> 2, wc = wid & 3, fr = lane & 15, fq = lane >> 4;
    const int K = g.K, nt = K / BK;
    unsigned voffA[2], voffB[2];
#pragma unroll
    for (int i = 0; i < 2; ++i) { int R, C; stage_rc(tid * 16 + i * 8192, R, C); const int Rb = Epi::PERM ? ((R & ~31) + perm32(R & 31)) : R;
        voffA[i] = (unsigned)(R * K + C) * 2u; voffB[i] = (unsigned)(Rb * K + C) * 2u; }
    const size_t kstep = (size_t)(BK * 2);
    const size_t hstep = (size_t)HALF * K * 2;
    const size_t tstep = 2 * hstep;
    const unsigned ldsw = (unsigned)wid * 1024u;
    const int aoff = lds_byte(wr * 64 + fr, fq * 8), boff = lds_byte(wc * 32 + fr, fq * 8);
#define PG8_SA(b, h) (((b) * 2 + (h)) * HTB)
#define PG8_SB(b, h) ((4 + (b) * 2 + (h)) * HTB)
#define PG8_STAGE(bufoff, gbase, voff) do { _Pragma("unroll") for (int _i = 0; _i < 2; ++_i) \
        __builtin_amdgcn_global_load_lds((const unsigned*)((const char*)(gbase) + (voff)[_i]), (PG8_LAS unsigned*)(lds + (bufoff) + ldsw + _i * 8192), 16, 0, 0); } while (0)
#define PG8_LDA(dst, b, h) do { _Pragma("unroll") for (int m = 0; m < 4; ++m) _Pragma("unroll") for (int k = 0; k < 2; ++k) dst[m][k] = *(const PG8_LAS bf16x8*)(lds + PG8_SA(b, h) + aoff + m * 2048 + k * 1024); } while (0)
#define PG8_LDB(dst, b, h) do { _Pragma("unroll") for (int n = 0; n < 2; ++n) _Pragma("unroll") for (int k = 0; k < 2; ++k) dst[n][k] = *(const PG8_LAS bf16x8*)(lds + PG8_SB(b, h) + boff + n * 2048 + k * 1024); } while (0)
#define PG8_MMA(ai, bj, At, Bt) do { __builtin_amdgcn_s_setprio(1); _Pragma("unroll") for (int m = 0; m < 4; ++m) _Pragma("unroll") for (int n = 0; n < 2; ++n) _Pragma("unroll") for (int k = 0; k < 2; ++k) \
        acc[ai][bj][m][n] = __builtin_amdgcn_mfma_f32_16x16x32_bf16(Bt[n][k], At[m][k], acc[ai][bj][m][n], 0, 0, 0); __builtin_amdgcn_s_setprio(0); } while (0)
#define PG8_WAIT_V(n) asm volatile("s_waitcnt vmcnt(" #n ")" ::: "memory")
#define PG8_WAIT_L(n) asm volatile("s_waitcnt lgkmcnt(" #n ")" ::: "memory")
#define PG8_BAR __builtin_amdgcn_s_barrier()
#define PG8_SCHED __builtin_amdgcn_sched_barrier(0)
    Unit cur, nxt; int ui = 0;
    if (!S.next(0, cur)) return;
    f32x4 acc[2][2][4][2];
#pragma unroll
    for (int a = 0; a < 2; ++a)
#pragma unroll
        for (int b = 0; b < 2; ++b)
#pragma unroll
            for (int m = 0; m < 4; ++m)
#pragma unroll
                for (int n = 0; n < 2; ++n) acc[a][b][m][n] = (f32x4){0.f, 0.f, 0.f, 0.f};
    bf16x8 At[4][2], B0[2][2], B1[2][2];
    const char* cA = (const char*)g.A + (size_t)cur.pm * tstep; const char* cB = (const char*)g.Bt + (size_t)cur.pn * tstep;
    S.a_ready(cur);
    if constexpr (SP2) {
        PG8_STAGE(PG8_SB(0, 0), cB, voffB); PG8_STAGE(PG8_SB(0, 1), cB + hstep, voffB); PG8_STAGE(PG8_SA(0, 0), cA, voffA); PG8_STAGE(PG8_SA(0, 1), cA + hstep, voffA);
        if (wr == 1) PG8_BAR;
        PG8_WAIT_V(2); PG8_BAR;
        PG8_STAGE(PG8_SB(1, 0), cB + kstep, voffB); PG8_STAGE(PG8_SA(1, 0), cA + kstep, voffA); PG8_STAGE(PG8_SB(1, 1), cB + hstep + kstep, voffB);
        PG8_WAIT_V(6); PG8_BAR;
    } else {
        PG8_STAGE(PG8_SB(0, 0), cB, voffB); PG8_STAGE(PG8_SA(0, 0), cA, voffA); PG8_STAGE(PG8_SB(0, 1), cB + hstep, voffB); PG8_STAGE(PG8_SA(0, 1), cA + hstep, voffA);
        if (wr == 1) PG8_BAR;
        PG8_WAIT_V(4); PG8_BAR;
        PG8_STAGE(PG8_SB(1, 0), cB + kstep, voffB); PG8_STAGE(PG8_SA(1, 0), cA + kstep, voffA); PG8_STAGE(PG8_SB(1, 1), cB + hstep + kstep, voffB);
        PG8_WAIT_V(6); PG8_BAR;
    }
    for (;;) {
        const bool has_next = S.next(ui + 1, nxt);
        const char* nA = has_next ? (const char*)g.A + (size_t)nxt.pm * tstep : cA; const char* nB = has_next ? (const char*)g.Bt + (size_t)nxt.pn * tstep : cB;
        for (int t = 0; t < nt; t += 2) {
            const bool last = (t == nt - 2);
            const char* a1 = cA + (size_t)(t + 1) * kstep;
            const char* a2 = last ? nA : cA + (size_t)(t + 2) * kstep; const char* b2 = last ? nB : cB + (size_t)(t + 2) * kstep;
            const char* a3 = a2 + kstep; const char* b3 = b2 + kstep;
            if (last && has_next) S.a_ready(nxt);
            if constexpr (SP2) {
            PG8_LDB(B0, 0, 0); PG8_LDB(B1, 0, 1); PG8_SCHED; PG8_LDA(At, 0, 0); PG8_STAGE(PG8_SA(1, 1), a1 + hstep, voffA);
            PG8_WAIT_V(8); PG8_WAIT_L(0); PG8_BAR; PG8_MMA(0, 0, At, B0); PG8_MMA(0, 1, At, B1); PG8_BAR; PG8_SCHED;
            PG8_LDA(At, 0, 1); PG8_STAGE(PG8_SB(0, 0), b2, voffB); PG8_STAGE(PG8_SB(0, 1), b2 + hstep, voffB); PG8_STAGE(PG8_SA(0, 0), a2, voffA);
            PG8_WAIT_V(8); PG8_WAIT_L(0); PG8_BAR; PG8_MMA(1, 0, At, B0); PG8_MMA(1, 1, At, B1); PG8_BAR; PG8_SCHED;
            PG8_LDB(B0, 1, 0); PG8_LDB(B1, 1, 1); PG8_SCHED; PG8_LDA(At, 1, 0); PG8_STAGE(PG8_SA(0, 1), a2 + hstep, voffA);
            PG8_WAIT_V(8); PG8_WAIT_L(0); PG8_BAR; PG8_MMA(0, 0, At, B0); PG8_MMA(0, 1, At, B1); PG8_BAR; PG8_SCHED;
            PG8_LDA(At, 1, 1); PG8_STAGE(PG8_SB(1, 0), b3, voffB); PG8_STAGE(PG8_SB(1, 1), b3 + hstep, voffB); PG8_STAGE(PG8_SA(1, 0), a3, voffA);
            PG8_WAIT_V(8); PG8_WAIT_L(0); PG8_BAR; PG8_MMA(1, 0, At, B0); PG8_MMA(1, 1, At, B1); PG8_BAR; PG8_SCHED;
            } else {
            PG8_LDB(B0, 0, 0); PG8_SCHED; PG8_LDA(At, 0, 0); PG8_STAGE(PG8_SA(1, 1), a1 + hstep, voffA);
            PG8_WAIT_L(8); PG8_BAR; PG8_WAIT_L(0); PG8_MMA(0, 0, At, B0); PG8_BAR; PG8_SCHED;
            PG8_LDB(B1, 0, 1); PG8_STAGE(PG8_SB(0, 0), b2, voffB);
            PG8_BAR; PG8_WAIT_L(0); PG8_MMA(0, 1, At, B1); PG8_BAR;
            PG8_LDA(At, 0, 1); PG8_STAGE(PG8_SA(0, 0), a2, voffA);
            PG8_BAR; PG8_WAIT_L(0); PG8_MMA(1, 0, At, B0); PG8_BAR; PG8_SCHED;
            PG8_STAGE(PG8_SB(0, 1), b2 + hstep, voffB);
            PG8_WAIT_V(6); PG8_BAR; PG8_MMA(1, 1, At, B1); PG8_BAR;
            PG8_LDB(B0, 1, 0); PG8_SCHED; PG8_LDA(At, 1, 0); PG8_STAGE(PG8_SA(0, 1), a2 + hstep, voffA);
            PG8_WAIT_L(8); PG8_BAR; PG8_WAIT_L(0); PG8_MMA(0, 0, At, B0); PG8_BAR; PG8_SCHED;
            PG8_LDB(B1, 1, 1); PG8_STAGE(PG8_SB(1, 0), b3, voffB);
            PG8_BAR; PG8_WAIT_L(0); PG8_MMA(0, 1, At, B1); PG8_BAR;
            PG8_LDA(At, 1, 1); PG8_STAGE(PG8_SA(1, 0), a3, voffA);
            PG8_BAR; PG8_WAIT_L(0); PG8_MMA(1, 0, At, B0); PG8_BAR; PG8_SCHED;
            PG8_STAGE(PG8_SB(1, 1), b3 + hstep, voffB);
            PG8_WAIT_V(6); PG8_BAR; PG8_MMA(1, 1, At, B1); PG8_BAR;
            }
        }
        if constexpr (ALIGN_EPI) { if (wr == 0) PG8_BAR; }
        if constexpr (!Epi::AFTER_DRAIN) { E(acc, cur, wr, wc, fr, fq); S.done(cur); }
        if (!has_next) break;
#pragma unroll
        for (int a = 0; a < 2; ++a)
#pragma unroll
            for (int b = 0; b < 2; ++b)
#pragma unroll
                for (int m = 0; m < 4; ++m)
#pragma unroll
                    for (int n = 0; n < 2; ++n) acc[a][b][m][n] = (f32x4){0.f, 0.f, 0.f, 0.f};
        cur = nxt; cA = nA; cB = nB; ++ui;
        if constexpr (ALIGN_EPI) { if (wr == 1) PG8_BAR; }
    }
    PG8_WAIT_V(0);
    if constexpr (!ALIGN_EPI) { if (wr == 0) PG8_BAR; }
    PG8_BAR;
    if constexpr (Epi::AFTER_DRAIN) { E.fused(acc, cur, wr, wc, fr, fq, lds, wid, lane); S.done(cur); }
#undef PG8_SA
#undef PG8_SB
#undef PG8_STAGE
#undef PG8_LDA
#undef PG8_LDB
#undef PG8_MMA
#undef PG8_WAIT_V
#undef PG8_WAIT_L
#undef PG8_BAR
#undef PG8_SCHED
}
}
constexpr int BATCH = 32, SEQ = 2048, DM = 1024, DEPTH = 4, M = BATCH * SEQ;
constexpr int FF = 4096, PLE = 256, NIN = 4112;
constexpr float EPS = 1e-6f;
constexpr int NWAVES = 8, NTHR = NWAVES * 64;
constexpr int PH_PER_LAYER = 13, NPHASE = 1 + DEPTH * PH_PER_LAYER;
constexpr size_t MiB = 1u << 20;
constexpr size_t WS_CTL = 0, CTL_ZERO_BYTES = 32768;
constexpr size_t WS_WIN = 1 * MiB, WS_WOUT = 17 * MiB, WS_WQKV = 21 * MiB, WS_WO = 27 * MiB, WS_WUP = 31 * MiB, WS_WDN = 63 * MiB, WS_WPLE = 95 * MiB, WS_WG = 97 * MiB;
constexpr size_t WS_WGATES = 105 * MiB, WS_GT = 106 * MiB, WS_ROPE = 110 * MiB;
constexpr size_t WS_DEN = 126 * MiB, WS_RS0 = 127 * MiB, WS_RS2 = 127 * MiB + 512 * 1024;
constexpr size_t WS_RA = 128 * MiB, WS_RB = 256 * MiB, WS_RC = 384 * MiB, WS_RD = 896 * MiB, WS_END = 1024 * MiB;
constexpr size_t WS_QKVA = 128 * MiB, WS_KWT = 320 * MiB, WS_X1 = 384 * MiB, WS_KT = 384 * MiB, WS_UT = 448 * MiB, WS_NW = 512 * MiB, WS_X2 = 576 * MiB, WS_VT = 896 * MiB, WS_ATT = 960 * MiB, WS_PT = 992 * MiB, WS_MIXED = 384 * MiB;
constexpr int CW_BAR = 4096;
constexpr int RING_BYTES = 131072, MISC_OFF = RING_BYTES, LDS_BYTES = RING_BYTES + 1024;

#define GAS __attribute__((address_space(1)))
#define LAS __attribute__((address_space(3)))
typedef unsigned short bf16;
typedef float f32x4 __attribute__((ext_vector_type(4)));
typedef float f32x2 __attribute__((ext_vector_type(2)));
typedef unsigned u32x4 __attribute__((ext_vector_type(4)));
typedef unsigned u32x2 __attribute__((ext_vector_type(2)));
#define LDS_WAIT() asm volatile("s_waitcnt lgkmcnt(0)" ::: "memory")
#define VM_WAIT() asm volatile("s_waitcnt vmcnt(0)" ::: "memory")
using pg8::bf_lo; using pg8::bf_hi;
typedef __bf16 bf16x2_t __attribute__((ext_vector_type(2)));
__device__ __forceinline__ unsigned pk2(float lo, float hi) { return pg8::cvt_pk_bf16(lo, hi); }
__device__ __forceinline__ unsigned pk2v(float lo, float hi) { const f32x2 v = {lo, hi}; const bf16x2_t b = __builtin_convertvector(v, bf16x2_t); return __builtin_bit_cast(unsigned, b); }
__device__ __forceinline__ float wave_sum(float v) {
#pragma unroll
    for (int o = 1; o < 64; o <<= 1) v += __shfl_xor(v, o);
    return v;
}
__device__ __forceinline__ float dot4(f32x4 a, f32x4 b) { return (a.x * b.x + a.y * b.y) + (a.z * b.z + a.w * b.w); }
__device__ __forceinline__ float sigmoid_f(float x) { return 1.f / (1.f + __expf(-x)); }
__device__ __forceinline__ float softplus_f(float x) { return x > 20.f ? x : log1pf(expf(x)); }

#define XB_TMO      128
#define XB_XCNT(j)  (256  + 64 * (j))
#define XB_XSUB(j)  (1280 + 64 * (j))
#define XB_XGEN(j)  (2304 + 64 * (j))
#define XB_TOP      3328
#define XB_TOPGEN   3392
#define XCD_BAR_WORDS 3456
#define XB_SPIN_CAP (1u << 18)

__device__ __forceinline__ unsigned xb_ld(unsigned* p)              { return __hip_atomic_load(p, __ATOMIC_RELAXED, __HIP_MEMORY_SCOPE_AGENT); }
__device__ __forceinline__ unsigned xb_add(unsigned* p, unsigned v) { return __hip_atomic_fetch_add(p, v, __ATOMIC_RELAXED, __HIP_MEMORY_SCOPE_AGENT); }
__device__ __forceinline__ unsigned xb_xcc_id() { return (unsigned)__builtin_amdgcn_s_getreg((3 << 11) | 20) & 0xFu; }
#define XB_SPIN(cond, bar) do { unsigned _sp = 0; while (cond) { __builtin_amdgcn_s_sleep(1); \
    if ((++_sp & 255u) == 0u) { if (xb_ld(&(bar)[XB_TMO])) break; if (_sp > XB_SPIN_CAP) { atomicAdd(&(bar)[XB_TMO], 1u); break; } } } } while (0)

struct XcdBarrier {
    unsigned* bar; unsigned x;
    volatile LAS unsigned* st;
};

__device__ __forceinline__ XcdBarrier xcd_barrier_post(unsigned* bar, volatile LAS unsigned* st) {
    XcdBarrier b; b.bar = bar; b.x = xb_xcc_id(); b.st = st;
    if (threadIdx.x == 0) (void)xb_add(&bar[XB_XCNT(b.x)], 1u);
    return b;
}
__device__ __forceinline__ void xcd_barrier_complete(unsigned* bar, unsigned x, unsigned& nloc, unsigned& nx) {
    const unsigned G = gridDim.x * gridDim.y * gridDim.z;
    unsigned sum, cnt, mine, sp = 0u;
    for (;;) {
        sum = 0u; cnt = 0u; mine = 0u;
#pragma unroll
        for (unsigned j = 0; j < 16; ++j) { const unsigned c = xb_ld(&bar[XB_XCNT(j)]); sum += c; cnt += (c > 0u) ? 1u : 0u; mine = (j == x) ? c : mine; }
        if (sum == G) break;
        __builtin_amdgcn_s_sleep(1);
        if ((++sp & 255u) == 0u) { if (xb_ld(&bar[XB_TMO])) break; if (sp > XB_SPIN_CAP) { atomicAdd(&bar[XB_TMO], 1u); break; } }
    }
    nloc = mine > 0u ? mine : 1u; nx = cnt > 0u ? cnt : 1u;
}

__device__ __forceinline__ void xcd_barrier(const XcdBarrier& b) {
    asm volatile("s_waitcnt vmcnt(0)" ::: "memory");
    __syncthreads();
    if (threadIdx.x == 0) {
        unsigned* bar = b.bar;
        __builtin_amdgcn_s_waitcnt(0);
        unsigned nloc = b.st[0], nx = b.st[1];
        if (nloc == 0u) { xcd_barrier_complete(bar, b.x, nloc, nx); b.st[0] = nloc; b.st[1] = nx; }
        const unsigned old = xb_add(&bar[XB_XSUB(b.x)], 1u);
        const unsigned gen = old / nloc;
        if (old + 1u == (gen + 1u) * nloc) {
            __builtin_amdgcn_fence(__ATOMIC_RELEASE, "agent");
            asm volatile("s_waitcnt vmcnt(0)" ::: "memory");
            const unsigned og = xb_add(&bar[XB_TOP], 1u);
            const unsigned tg = og / nx;
            if (og + 1u == (tg + 1u) * nx) xb_add(&bar[XB_TOPGEN], 1u);
            else XB_SPIN(xb_ld(&bar[XB_TOPGEN]) == tg, bar);
            __builtin_amdgcn_fence(__ATOMIC_ACQUIRE, "agent");
            xb_add(&bar[XB_XGEN(b.x)], 1u);
            asm volatile("s_waitcnt vmcnt(0)" ::: "memory");
        } else {
            XB_SPIN(xb_ld(&bar[XB_XGEN(b.x)]) == gen, bar);
            __builtin_amdgcn_fence(__ATOMIC_ACQUIRE, "agent");
            asm volatile("s_waitcnt vmcnt(0)" ::: "memory");
        }
    }
    __syncthreads();
}
struct Args {
    const float *x, *p; const int* pos; const float *gains, *w_in, *conv, *a_log, *dt_bias, *norm_a, *i_bias, *f_bias, *norm_b, *w_out, *w_qkv, *b_qkv, *sinks, *w_o, *b_o, *w_up, *w_down, *w_ple, *w_gate;
    float* out; unsigned char* ws;
    int ph_lo, ph_hi, dup_mask, dup_par;
};

template <bool ROPE_PERM = false> __device__ __forceinline__ void transpose_item(const float* src, int ld, int K, bf16* dst, LAS float* scr, int item, int nblk, int lane, const float* kscale = nullptr) {
    const int kb = item / nblk, nb = item % nblk, k0 = 64 * kb, n0 = 32 * nb;
#pragma unroll 8
    for (int i = 0; i < 32; ++i) { const int kk = 2 * i + (lane >> 5); scr[kk * 33 + (lane & 31)] = src[(size_t)(k0 + kk) * ld + n0 + (lane & 31)] * (kscale ? kscale[k0 + kk] : 1.f); }
    LDS_WAIT(); asm volatile("" ::: "memory");
    const int c = lane & 7;
#pragma unroll
    for (int j = 0; j < 4; ++j) { const int n = (lane >> 3) + 8 * j; const LAS float* s = scr + (8 * c) * 33 + n;
        u32x4 o; o.x = pk2(s[0 * 33], s[1 * 33]); o.y = pk2(s[2 * 33], s[3 * 33]); o.z = pk2(s[4 * 33], s[5 * 33]); o.w = pk2(s[6 * 33], s[7 * 33]);
        int nd = n0 + n;
        if (ROPE_PERM && nd < 1280) { const int i = nd & 63; nd = (nd & ~63) + (i < 32 ? 8 * (i >> 2) + (i & 3) : 8 * ((i - 32) >> 2) + 4 + (i & 3)); }
        *(u32x4*)(dst + (size_t)nd * K + k0 + 8 * c) = o; }
    LDS_WAIT(); asm volatile("" ::: "memory");
}
__device__ __forceinline__ int gate_col(int c) { return c < 8 ? 1536 + c : 3592 + (c - 8); }

typedef const __attribute__((address_space(4))) Args* KArgs;
__device__ __forceinline__ KArgs kargs() { KArgs p = (KArgs)__builtin_amdgcn_kernarg_segment_ptr(); asm volatile("" : "+s"(p)); return p; }
__device__ __forceinline__ int fresh_tid() { int t = threadIdx.x; asm volatile("" : "+v"(t)); return t; }
__device__ __forceinline__ void prologue_phase(KArgs a, LAS unsigned char* lds, int gw, int NGW, int wave, int lane, int gtid, int NGT) {
    LAS float* scr = (LAS float*)(lds + wave * 16384);
    constexpr int I_IN = 16 * 16, I_SQ = 16 * 32, I_QKV = 16 * 48, I_UP = 16 * 128, I_DN = 64 * 32, I_PLE = 4 * 32;
    constexpr int NITEMS = 16 * I_IN + 2 * I_SQ + 2 * I_QKV + 2 * I_SQ + 4 * I_UP + 4 * I_DN + 4 * I_PLE + 4 * I_SQ;
    unsigned char* ws = a->ws;
    for (int it = gw; it < NITEMS; it += NGW) {
        int r = it;
        if (r < 16 * I_IN) { const int j = r / I_IN, e = j >> 3, s = j & 7, col0 = 512 * s + (s >= 3 ? 8 : 0) + (s >= 7 ? 8 : 0);
            transpose_item(a->w_in + (size_t)e * DM * NIN + col0, NIN, DM, (bf16*)(ws + WS_WIN) + ((size_t)e * 4096 + s * 512) * DM, scr, r % I_IN, 16, lane, a->gains + (size_t)(2 * e) * 4 * DM); continue; } r -= 16 * I_IN;
        if (r < 2 * I_SQ) { const int e = r / I_SQ; transpose_item(a->w_out + (size_t)e * DM * DM, DM, DM, (bf16*)(ws + WS_WOUT) + (size_t)e * DM * DM, scr, r % I_SQ, 32, lane); continue; } r -= 2 * I_SQ;
        if (r < 2 * I_QKV) { const int e = r / I_QKV; transpose_item<true>(a->w_qkv + (size_t)e * DM * 1536, 1536, DM, (bf16*)(ws + WS_WQKV) + (size_t)e * 1536 * DM, scr, r % I_QKV, 48, lane, a->gains + (size_t)(2 * e + 1) * 4 * DM); continue; } r -= 2 * I_QKV;
        if (r < 2 * I_SQ) { const int e = r / I_SQ; transpose_item(a->w_o + (size_t)e * DM * DM, DM, DM, (bf16*)(ws + WS_WO) + (size_t)e * DM * DM, scr, r % I_SQ, 32, lane); continue; } r -= 2 * I_SQ;
        if (r < 4 * I_UP) { const int l = r / I_UP; transpose_item(a->w_up + (size_t)l * DM * FF, FF, DM, (bf16*)(ws + WS_WUP) + (size_t)l * FF * DM, scr, r % I_UP, 128, lane, a->gains + ((size_t)l * 4 + 2) * DM); continue; } r -= 4 * I_UP;
        if (r < 4 * I_DN) { const int l = r / I_DN; transpose_item(a->w_down + (size_t)l * FF * DM, DM, FF, (bf16*)(ws + WS_WDN) + (size_t)l * DM * FF, scr, r % I_DN, 32, lane); continue; } r -= 4 * I_DN;
        if (r < 4 * I_PLE) { const int l = r / I_PLE; transpose_item(a->w_ple + (size_t)l * PLE * DM, DM, PLE, (bf16*)(ws + WS_WPLE) + (size_t)l * DM * PLE, scr, r % I_PLE, 32, lane); continue; } r -= 4 * I_PLE;
        { const int l = r / I_SQ; transpose_item(a->w_gate + (size_t)l * DM * DM, DM, DM, (bf16*)(ws + WS_WG) + (size_t)l * DM * DM, scr, r % I_SQ, 32, lane); }
    }
    float* Wg = (float*)(a->ws + WS_WGATES);
    for (int i = gtid; i < 2 * 16 * 1024; i += NGT) { const int e = i >> 14, c = (i >> 10) & 15, k = i & 1023; Wg[i] = a->w_in[((size_t)e * 1024 + k) * NIN + gate_col(c)]; }
    f32x2* rope = (f32x2*)(a->ws + WS_ROPE);
    for (int i = gtid; i < M * 32; i += NGT) { const int m = i >> 5, d = i & 31;
        const float inv = (float)pow(10000.0, -(double)d / 32.0); const float ang = (float)a->pos[m] * inv; float sn, cs; sincosf(ang, &sn, &cs); rope[i] = (f32x2){cs, sn}; }
}

__device__ __forceinline__ void norm_phase(LAS unsigned char* lds, const float* hin, const float* g0, bf16* HN, float* RS, bool even, const float* Wg, float* Gt, int gw, int NGW, int tid, int lane) {
    LAS f32x4* wl = (LAS f32x4*)lds;
    if (even) { for (int i = tid; i < 4096; i += NTHR) wl[i] = ((const f32x4*)Wg)[i]; __syncthreads(); }
    f32x4 gv[4];
#pragma unroll
    for (int j = 0; j < 4; ++j) gv[j] = ((const f32x4*)g0)[lane + 64 * j];
#pragma unroll 2
    for (int m = gw; m < M; m += NGW) {
        const f32x4* xr = (const f32x4*)(hin + (size_t)m * DM) + lane;
        f32x4 v[4]; float s = 0.f;
#pragma unroll
        for (int j = 0; j < 4; ++j) { v[j] = xr[64 * j]; s += dot4(v[j], v[j]); }
        const float rstd = rsqrtf(wave_sum(s) * (1.f / DM) + EPS);
        u32x2* o8 = (u32x2*)(HN + (size_t)m * DM) + lane;
#pragma unroll
        for (int j = 0; j < 4; ++j) { o8[64 * j] = (u32x2){pk2(v[j].x, v[j].y), pk2(v[j].z, v[j].w)}; v[j] = v[j] * rstd * gv[j]; }
        if (lane == 0) RS[m] = rstd;
        if (even) {
            float keep = 0.f;
#pragma unroll
            for (int c = 0; c < 16; ++c) { float d = 0.f;
#pragma unroll
                for (int j = 0; j < 4; ++j) d += dot4(v[j], wl[c * 256 + lane + 64 * j]);
                d = wave_sum(d); if (lane == c) keep = d; }
            if (lane < 16) Gt[(size_t)m * 16 + lane] = keep;
        }
    }
    if (even) __syncthreads();
}
struct Row16 { f32x4 v[4]; };
__device__ __forceinline__ Row16 ld_row_bf16(const bf16* row, int lane) { const u32x4 a = ((const u32x4*)row)[lane], b = ((const u32x4*)row)[lane + 64]; Row16 r;
    r.v[0] = (f32x4){bf_lo(a.x), bf_hi(a.x), bf_lo(a.y), bf_hi(a.y)}; r.v[1] = (f32x4){bf_lo(a.z), bf_hi(a.z), bf_lo(a.w), bf_hi(a.w)};
    r.v[2] = (f32x4){bf_lo(b.x), bf_hi(b.x), bf_lo(b.y), bf_hi(b.y)}; r.v[3] = (f32x4){bf_lo(b.z), bf_hi(b.z), bf_lo(b.w), bf_hi(b.w)}; return r; }
__device__ __forceinline__ Row16 ld_row_f32(const float* row, int lane) { const f32x4* p = (const f32x4*)row; Row16 r; r.v[0] = p[2 * lane]; r.v[1] = p[2 * lane + 1]; r.v[2] = p[128 + 2 * lane]; r.v[3] = p[128 + 2 * lane + 1]; return r; }
__device__ __forceinline__ void st_row_bf16(bf16* row, int lane, const Row16& r) {
    ((u32x4*)row)[lane] = (u32x4){pk2(r.v[0].x, r.v[0].y), pk2(r.v[0].z, r.v[0].w), pk2(r.v[1].x, r.v[1].y), pk2(r.v[1].z, r.v[1].w)};
    ((u32x4*)row)[lane + 64] = (u32x4){pk2(r.v[2].x, r.v[2].y), pk2(r.v[2].z, r.v[2].w), pk2(r.v[3].x, r.v[3].y), pk2(r.v[3].z, r.v[3].w)}; }
__device__ __forceinline__ void st_row_f32(float* row, int lane, const Row16& r) { f32x4* p = (f32x4*)row; p[2 * lane] = r.v[0]; p[2 * lane + 1] = r.v[1]; p[128 + 2 * lane] = r.v[2]; p[128 + 2 * lane + 1] = r.v[3]; }
__device__ __forceinline__ float row_sumsq(const Row16& r) { return (dot4(r.v[0], r.v[0]) + dot4(r.v[1], r.v[1])) + (dot4(r.v[2], r.v[2]) + dot4(r.v[3], r.v[3])); }
__device__ __forceinline__ void resid_a_phase(const bf16* mix, const float* hin32, bf16* hs, const float* g1, float* RS, int gw, int NGW, int lane) {
    const Row16 ga = ld_row_f32(g1, lane);
    for (int m = gw; m < M; m += NGW) {
        const Row16 v = ld_row_bf16(mix + (size_t)m * DM, lane); Row16 h = hin32 ? ld_row_f32(hin32 + (size_t)m * DM, lane) : ld_row_bf16(hs + (size_t)m * DM, lane);
        const float r1 = rsqrtf(wave_sum(row_sumsq(v)) * (1.f / DM) + EPS);
#pragma unroll
        for (int j = 0; j < 4; ++j) h.v[j] = h.v[j] + v.v[j] * r1 * ga.v[j];
        st_row_bf16(hs + (size_t)m * DM, lane, h);
        const float r2 = rsqrtf(wave_sum(row_sumsq(h)) * (1.f / DM) + EPS);
        if (lane == 0) RS[m] = r2;
    }
}
__device__ __forceinline__ void resid_b_phase(const bf16* ff, const bf16* hs, const float* g3, bf16* HB, const float* pl, bf16* PB, int gw, int NGW, int lane, int gtid, int NGT) {
    const Row16 ga = ld_row_f32(g3, lane);
    for (int m = gw; m < M; m += NGW) {
        const Row16 v = ld_row_bf16(ff + (size_t)m * DM, lane); Row16 h = ld_row_bf16(hs + (size_t)m * DM, lane);
        const float r1 = rsqrtf(wave_sum(row_sumsq(v)) * (1.f / DM) + EPS);
#pragma unroll
        for (int j = 0; j < 4; ++j) h.v[j] = h.v[j] + v.v[j] * r1 * ga.v[j];
        st_row_bf16(HB + (size_t)m * DM, lane, h);
    }
    for (int i = gtid; i < M * PLE / 8; i += NGT) { const f32x4 a = ((const f32x4*)pl)[2 * i], b = ((const f32x4*)pl)[2 * i + 1];
        ((u32x4*)PB)[i] = (u32x4){pk2(a.x, a.y), pk2(a.z, a.w), pk2(b.x, b.y), pk2(b.z, b.w)}; }
}
__device__ __forceinline__ void resid_c_phase(LAS unsigned char* lds, const bf16* gpre, const bf16* pp, const bf16* h2, bf16* hs, float* out32, bool has_next, const float* g0, float* RS, bool even_next, const float* Wg, float* Gt, int gw, int NGW, int tid, int lane) {
    LAS f32x4* wl = (LAS f32x4*)lds;
    if (has_next && even_next) { for (int i = tid; i < 4096; i += NTHR) wl[i] = ((const f32x4*)Wg)[i]; __syncthreads(); }
    const Row16 gv = ld_row_f32(g0, lane);
    for (int m = gw; m < M; m += NGW) {
        const Row16 g = ld_row_bf16(gpre + (size_t)m * DM, lane), p = ld_row_bf16(pp + (size_t)m * DM, lane); Row16 h = ld_row_bf16(h2 + (size_t)m * DM, lane);
#pragma unroll
        for (int j = 0; j < 4; ++j)
#pragma unroll
            for (int i = 0; i < 4; ++i) h.v[j][i] += p.v[j][i] * sigmoid_f(g.v[j][i]);
        if (has_next) {
            st_row_bf16(hs + (size_t)m * DM, lane, h);
            const float rstd = rsqrtf(wave_sum(row_sumsq(h)) * (1.f / DM) + EPS);
            if (lane == 0) RS[m] = rstd;
            if (even_next) {
#pragma unroll
                for (int j = 0; j < 4; ++j) h.v[j] = h.v[j] * rstd * gv.v[j];
                float keep = 0.f;
#pragma unroll
                for (int c = 0; c < 16; ++c) {
                    float d = (dot4(h.v[0], wl[c * 256 + 2 * lane]) + dot4(h.v[1], wl[c * 256 + 2 * lane + 1])) + (dot4(h.v[2], wl[c * 256 + 128 + 2 * lane]) + dot4(h.v[3], wl[c * 256 + 128 + 2 * lane + 1]));
                    d = wave_sum(d); if (lane == c) keep = d; }
                if (lane < 16) Gt[(size_t)m * 16 + lane] = keep;
            }
        } else st_row_f32(out32 + (size_t)m * DM, lane, h);
    }
    if (has_next && even_next) __syncthreads();
}
__device__ __forceinline__ void conv_phase(const bf16* X1, const float* convw  , bf16* QKVA, int gw, int NGW, int lane) {
    constexpr int RPW = 32;
    for (int blk = gw; blk < M / RPW; blk += NGW) {
        const int mb = blk * RPW;
#pragma unroll 1
        for (int j = 0; j < 3; ++j) {
            const int col = j * 512 + lane * 8;
            u32x4 h0, h1, h2;
            { const bool first = (mb & (SEQ - 1)) == 0; const u32x4 z = {0u, 0u, 0u, 0u};
              h0 = first ? z : *(const u32x4*)(X1 + (size_t)(mb - 3) * 1536 + col); h1 = first ? z : *(const u32x4*)(X1 + (size_t)(mb - 2) * 1536 + col); h2 = first ? z : *(const u32x4*)(X1 + (size_t)(mb - 1) * 1536 + col); }
            f32x4 w[4][2];
#pragma unroll
            for (int kk = 0; kk < 4; ++kk) { w[kk][0] = *(const f32x4*)(convw + kk * 1536 + col); w[kk][1] = *(const f32x4*)(convw + kk * 1536 + col + 4); }
#pragma unroll 1
            for (int r4 = 0; r4 < RPW; r4 += 4) {
                u32x4 cur[4];
#pragma unroll
                for (int rr = 0; rr < 4; ++rr) cur[rr] = *(const u32x4*)(X1 + (size_t)(mb + r4 + rr) * 1536 + col);
#pragma unroll
                for (int rr = 0; rr < 4; ++rr) {
                    const int m = mb + r4 + rr;
                    const u32x4 xs[4] = {rr == 0 ? h0 : (rr == 1 ? h1 : (rr == 2 ? h2 : cur[0])), rr == 0 ? h1 : (rr == 1 ? h2 : cur[rr - 2 < 0 ? 0 : rr - 2]), rr == 0 ? h2 : cur[rr - 1 < 0 ? 0 : rr - 1], cur[rr]};
                    float acc[8];
#pragma unroll
                    for (int i = 0; i < 8; ++i) acc[i] = 0.f;
#pragma unroll
                    for (int kk = 0; kk < 4; ++kk) { const u32x4 xv = xs[kk]; const f32x4 w0 = w[kk][0], w1 = w[kk][1];
                        acc[0] += bf_lo(xv.x) * w0.x; acc[1] += bf_hi(xv.x) * w0.y; acc[2] += bf_lo(xv.y) * w0.z; acc[3] += bf_hi(xv.y) * w0.w;
                        acc[4] += bf_lo(xv.z) * w1.x; acc[5] += bf_hi(xv.z) * w1.y; acc[6] += bf_lo(xv.w) * w1.z; acc[7] += bf_hi(xv.w) * w1.w; }
                    float ss = 0.f;
#pragma unroll
                    for (int i = 0; i < 8; ++i) { acc[i] = acc[i] / (1.f + __expf(-acc[i])); ss += acc[i] * acc[i]; }
                    if (j < 2) { ss += __shfl_xor(ss, 1); ss += __shfl_xor(ss, 2); ss += __shfl_xor(ss, 4); ss += __shfl_xor(ss, 8);
                        const float sc = rsqrtf(ss + EPS) * (j == 0 ? 0.08838834764831845f : 1.f);
#pragma unroll
                        for (int i = 0; i < 8; ++i) acc[i] *= sc; }
                    *(u32x4*)(QKVA + (size_t)m * 1536 + col) = (u32x4){pk2(acc[0], acc[1]), pk2(acc[2], acc[3]), pk2(acc[4], acc[5]), pk2(acc[6], acc[7])};
                }
                h0 = cur[1]; h1 = cur[2]; h2 = cur[3];
            }
        }
    }
}
__device__ __forceinline__ void rope_phase(bf16* QKV, const f32x2* rope, int gw, int NGW, int lane) {
#pragma unroll 2
    for (int m = gw; m < M; m += NGW) {
        const int grp = lane & 7; const f32x4* tb = (const f32x4*)(rope + (size_t)m * 32 + grp * 4); const f32x4 t0 = tb[0], t1 = tb[1];
        const float cs[4] = {t0.x, t0.z, t1.x, t1.z}, sn[4] = {t0.y, t0.w, t1.y, t1.w};
#pragma unroll
        for (int k = 0; k < 3; ++k) {
            if (k == 2 && lane >= 32) break;
            const int hh = (k < 2) ? ((lane + 64 * k) >> 3) : (lane >> 3); const float scale = (k < 2) ? 0.125f : 1.f;
            bf16* base = QKV + (size_t)m * 1536 + (k < 2 ? 0 : 1024) + hh * 64 + grp * 4;
            const u32x2 a = *(const u32x2*)base, b = *(const u32x2*)(base + 32);
            const float x1[4] = {bf_lo(a.x), bf_hi(a.x), bf_lo(a.y), bf_hi(a.y)}, x2[4] = {bf_lo(b.x), bf_hi(b.x), bf_lo(b.y), bf_hi(b.y)};
            float o1[4], o2[4];
#pragma unroll
            for (int i = 0; i < 4; ++i) { o1[i] = (x1[i] * cs[i] - x2[i] * sn[i]) * scale; o2[i] = (x2[i] * cs[i] + x1[i] * sn[i]) * scale; }
            *(u32x2*)base = (u32x2){pk2(o1[0], o1[1]), pk2(o1[2], o1[3])}; *(u32x2*)(base + 32) = (u32x2){pk2(o2[0], o2[1]), pk2(o2[2], o2[3])};
        }
    }
}
typedef short bf16x8 __attribute__((ext_vector_type(8)));
#define MFMA16(a, b, c) __builtin_amdgcn_mfma_f32_16x16x32_bf16(a, b, c, 0, 0, 0)
__device__ __forceinline__ bf16x8 pack8(f32x4 a, f32x4 b) { const u32x4 w = {pk2v(a.x, a.y), pk2v(a.z, a.w), pk2v(b.x, b.y), pk2v(b.z, b.w)}; return __builtin_bit_cast(bf16x8, w); }
__device__ __forceinline__ float bf2f(unsigned short v) { return __builtin_bit_cast(float, (unsigned)v << 16); }
__device__ __forceinline__ float rdlane(float v, int i) { return __builtin_bit_cast(float, __builtin_amdgcn_readlane(__builtin_bit_cast(int, v), i)); }
__device__ __forceinline__ float scan_add(float v, int lane) {
#pragma unroll
    for (int o = 1; o < 64; o <<= 1) { const float t = __shfl_up(v, o); if (lane >= o) v += t; }
    return v; }
__device__ __forceinline__ float scan_max(float v, int lane) {
#pragma unroll
    for (int o = 1; o < 64; o <<= 1) { const float t = __shfl_up(v, o); if (lane >= o) v = fmaxf(v, t); }
    return v; }
__device__ __forceinline__ int kperm(int ks, int q, int jj) { return 32 * ks + (jj < 4 ? 4 * q + jj : 16 + 4 * q + jj - 4); }
template <bool SCALE> __device__ __forceinline__ u32x4 tr_gather(const bf16* src  , int ld, int ks, int q, float esc_lane) {
    unsigned w[4];
#pragma unroll
    for (int j2 = 0; j2 < 4; ++j2) { const int r0 = kperm(ks, q, 2 * j2), r1 = r0 + 1; const unsigned short a = src[(size_t)r0 * ld], b = src[(size_t)r1 * ld];
        if (SCALE) { const float s0 = __shfl(esc_lane, r0), s1 = __shfl(esc_lane, r1); w[j2] = pk2(bf2f(a) * s0, bf2f(b) * s1); } else w[j2] = (unsigned)a | ((unsigned)b << 16); }
    return (u32x4){w[0], w[1], w[2], w[3]};
}
__device__ __forceinline__ u32x4 scale_frag(u32x4 raw, int ks, int q, float esc_lane) {
    unsigned w[4] = {raw.x, raw.y, raw.z, raw.w};
#pragma unroll
    for (int j2 = 0; j2 < 4; ++j2) { const int r0 = kperm(ks, q, 2 * j2); const float s0 = __shfl(esc_lane, r0), s1 = __shfl(esc_lane, r0 + 1); w[j2] = pk2(bf_lo(w[j2]) * s0, bf_hi(w[j2]) * s1); }
    return (u32x4){w[0], w[1], w[2], w[3]};
}
struct ScanBufs {
    bf16* QKVA;
    bf16* X2;
    float* Gt;
    bf16 *KT, *UT, *NW, *ATT;
    bf16 *KWT, *VT, *PT;
    float* DEN;
};
__device__ __forceinline__ void local_phase(LAS unsigned char* lds, const ScanBufs sb, const float* a_log, const float* dt_bias, const float* i_bias, const float* f_bias, int gw, int NGW, int wave, int lane) {
    LAS float* Lw = (LAS float*)(lds + wave * 16384);
    const int njobs = 2 * BATCH * 4 * (SEQ / 64), per = (njobs + NGW - 1) / NGW; const int lane_in = lane;
#pragma unroll 1
    for (int rj = 0; rj < per; ++rj) {
        const int job = gw * per + rj; if (job >= njobs) break;
        int lane = lane_in; asm volatile("" : "+v"(lane));
        const int x = lane & 15, q = lane >> 4;
        const int mixer = job & 1, cidx = job >> 1, c = cidx & 31, h = (cidx >> 5) & 3, b = cidx >> 7;
        const int m0 = b * SEQ + c * 64; const size_t cid = (size_t)cidx;
        float* gr = sb.Gt + (size_t)(m0 + lane) * 16;
        if (mixer == 0) {
            const float beta = 1.f / (1.f + expf(-gr[h])); const float g = -expf(a_log[h]) * softplus_f(gr[4 + h] + dt_bias[h]);
            const float gcum = scan_add(g, lane), eg = expf(gcum), glast = __shfl(gcum, 63);
            const bf16* kb = sb.QKVA + (size_t)m0 * 1536 + 512 + h * 128; const bf16* qb = sb.QKVA + (size_t)m0 * 1536 + h * 128; const bf16* vb = kb + 512;
            bf16x8 Kf[4][4], Qf[4][4];
#pragma unroll
            for (int t = 0; t < 4; ++t)
#pragma unroll
                for (int ks = 0; ks < 4; ++ks) { Kf[t][ks] = *(const bf16x8*)(kb + (size_t)(16 * t + x) * 1536 + 32 * ks + 8 * q); Qf[t][ks] = *(const bf16x8*)(qb + (size_t)(16 * t + x) * 1536 + 32 * ks + 8 * q); }
            float gj[4][4];
#pragma unroll
            for (int jt = 0; jt < 4; ++jt)
#pragma unroll
                for (int r = 0; r < 4; ++r) gj[jt][r] = __shfl(gcum, 16 * jt + 4 * q + r);
            bf16* attp = sb.ATT + cid * 4096;
#pragma unroll
            for (int it = 0; it < 4; ++it) {
                const float gi = __shfl(gcum, 16 * it + x), bi = __shfl(beta, 16 * it + x); f32x4 d2s[4];
#pragma unroll
                for (int jt = 0; jt < 4; ++jt) {
                    if (jt <= it) { f32x4 D1 = {0.f, 0.f, 0.f, 0.f}, D2 = D1;
#pragma unroll
                        for (int ks = 0; ks < 4; ++ks) { D1 = MFMA16(Kf[jt][ks], Kf[it][ks], D1); D2 = MFMA16(Kf[jt][ks], Qf[it][ks], D2); }
                        f32x4 lv;
#pragma unroll
                        for (int r = 0; r < 4; ++r) { const int j = 16 * jt + 4 * q + r, i = 16 * it + x; const float dec = __expf(fminf(gi - gj[jt][r], 0.f));
                            lv[r] = (j < i) ? bi * D1[r] * dec : 0.f; d2s[jt][r] = (j <= i) ? D2[r] * dec : 0.f; }
#pragma unroll
                        for (int r = 0; r < 4; ++r) Lw[(16 * jt + 4 * q + r) * 64 + 16 * it + x] = lv[r];
                    } else d2s[jt] = (f32x4){0.f, 0.f, 0.f, 0.f};
                }
#pragma unroll
                for (int kp = 0; kp < 2; ++kp) if (it >= 2 || kp == 0) *(bf16x8*)(attp + ((it * 2 + kp) * 64 + lane) * 8) = pack8(d2s[2 * kp], d2s[2 * kp + 1]);
            }
            { float* tab = (float*)(attp + 512); tab[lane] = eg; tab[64 + lane] = expf(glast - gcum); }
            bf16* ktp = sb.KT + cid * 8192;
            LDS_WAIT();
            float xv[64];
#pragma unroll
            for (int i = 0; i < 64; ++i) xv[i] = (i == lane) ? 1.f : 0.f;
#pragma unroll
            for (int j = 0; j < 63; ++j) {
#pragma unroll
                for (int g4 = (j + 1) / 4; g4 < 16; ++g4) { const f32x4 lc = *(const LAS f32x4*)(Lw + j * 64 + 4 * g4);
                    if (4 * g4 + 0 > j) xv[4 * g4 + 0] -= lc.x * xv[j]; if (4 * g4 + 1 > j) xv[4 * g4 + 1] -= lc.y * xv[j]; if (4 * g4 + 2 > j) xv[4 * g4 + 2] -= lc.z * xv[j]; if (4 * g4 + 3 > j) xv[4 * g4 + 3] -= lc.w * xv[j]; }
            }
            LDS_WAIT();
            { LAS unsigned short* TL = (LAS unsigned short*)Lw;
#pragma unroll
              for (int i = 0; i < 64; ++i) TL[i * 64 + ((((lane >> 3) ^ (i & 7)) << 3) | (lane & 7))] = (unsigned short)(pk2(xv[i], 0.f) & 0xffffu); }
            LDS_WAIT();
            bf16x8 Tf[4][2];
#pragma unroll
            for (int it = 0; it < 4; ++it)
#pragma unroll
                for (int ks = 0; ks < 2; ++ks) { const int row = 16 * it + x; const LAS unsigned char* tb = (const LAS unsigned char*)Lw + row * 128;
                    const int c0 = 32 * ks + 4 * q, c1 = c0 + 16;
                    const u32x2 lo = *(const LAS u32x2*)(tb + ((((c0 >> 3) ^ (row & 7)) << 4) | ((c0 & 7) << 1))), hi = *(const LAS u32x2*)(tb + ((((c1 >> 3) ^ (row & 7)) << 4) | ((c1 & 7) << 1)));
                    const u32x4 w = {lo.x, lo.y, hi.x, hi.y}; Tf[it][ks] = __builtin_bit_cast(bf16x8, w); }
            const float be = beta * eg;
            bf16* utp = sb.UT + cid * 8192;
#pragma unroll 4
            for (int et = 0; et < 8; ++et) {
                bf16x8 vfr[2];
#pragma unroll
                for (int ks = 0; ks < 2; ++ks) { const u32x4 gth = tr_gather<true>(vb + 16 * et + x, 1536, ks, q, beta); vfr[ks] = __builtin_bit_cast(bf16x8, gth); }
#pragma unroll
                for (int mt = 0; mt < 4; ++mt) { f32x4 acc = {0.f, 0.f, 0.f, 0.f};
#pragma unroll
                    for (int ks = 0; ks < 2; ++ks) acc = MFMA16(Tf[mt][ks], vfr[ks], acc);
                    *(u32x2*)(utp + (size_t)(16 * et + x) * 64 + 16 * mt + 4 * q) = (u32x2){pk2v(acc.x, acc.y), pk2v(acc.z, acc.w)}; }
            }
            bf16* nwp = sb.NW + cid * 8192;
#pragma unroll 2
            for (int kp2 = 0; kp2 < 4; ++kp2) {
                bf16x8 kfr[2][2];
#pragma unroll
                for (int dd = 0; dd < 2; ++dd)
#pragma unroll
                    for (int ks = 0; ks < 2; ++ks) { const int dt = 2 * kp2 + dd; const u32x4 raw = tr_gather<false>(kb + 16 * dt + x, 1536, ks, q, 0.f);
                        *(u32x4*)(ktp + ((dt * 2 + ks) * 64 + lane) * 8) = raw;
                        kfr[dd][ks] = __builtin_bit_cast(bf16x8, scale_frag(raw, ks, q, be)); }
#pragma unroll
                for (int it = 0; it < 4; ++it) { f32x4 a0 = {0.f, 0.f, 0.f, 0.f}, a1 = a0;
#pragma unroll
                    for (int ks = 0; ks < 2; ++ks) { a0 = MFMA16(kfr[0][ks], Tf[it][ks], a0); a1 = MFMA16(kfr[1][ks], Tf[it][ks], a1); }
                    a0 = a0 * -1.f; a1 = a1 * -1.f;
                    *(u32x4*)(nwp + ((it * 4 + kp2) * 64 + lane) * 8) = (u32x4){pk2v(a0.x, a0.y), pk2v(a0.z, a0.w), pk2v(a1.x, a1.y), pk2v(a1.z, a1.w)}; }
            }
            LDS_WAIT();
        } else {
            const float il = gr[8 + h] + i_bias[h]; const float fl = -softplus_f(-(gr[12 + h] + f_bias[h]));
            const float bcum = scan_add(fl, lane), t = il - bcum, pm = scan_max(t, lane), pml = __shfl(pm, 63);
            const float esc = __expf(t - pml);
            const bf16* qb = sb.X2 + (size_t)m0 * 2560 + 512 + h * 128; const bf16* kb = qb + 512; const bf16* vb = kb + 512;
            bf16x8 Kf[4][4], Qf[4][4];
#pragma unroll
            for (int tt = 0; tt < 4; ++tt)
#pragma unroll
                for (int ks = 0; ks < 4; ++ks) { Kf[tt][ks] = *(const bf16x8*)(kb + (size_t)(16 * tt + x) * 2560 + 32 * ks + 8 * q); Qf[tt][ks] = *(const bf16x8*)(qb + (size_t)(16 * tt + x) * 2560 + 32 * ks + 8 * q); }
            float tj[4][4];
#pragma unroll
            for (int jt = 0; jt < 4; ++jt)
#pragma unroll
                for (int r = 0; r < 4; ++r) tj[jt][r] = __shfl(t, 16 * jt + 4 * q + r);
            bf16* ptp = sb.PT + cid * 4096;
#pragma unroll
            for (int it = 0; it < 4; ++it) {
                const float pmi = __shfl(pm, 16 * it + x); f32x4 d2s[4];
#pragma unroll
                for (int jt = 0; jt < 4; ++jt) {
                    if (jt <= it) { f32x4 D2 = {0.f, 0.f, 0.f, 0.f};
#pragma unroll
                        for (int ks = 0; ks < 4; ++ks) D2 = MFMA16(Kf[jt][ks], Qf[it][ks], D2);
#pragma unroll
                        for (int r = 0; r < 4; ++r) { const int j = 16 * jt + 4 * q + r, i = 16 * it + x; d2s[jt][r] = (j <= i) ? D2[r] * 0.08838834764831845f * __expf(fminf(tj[jt][r] - pmi, 0.f)) : 0.f; }
                    } else d2s[jt] = (f32x4){0.f, 0.f, 0.f, 0.f};
                }
#pragma unroll
                for (int kp = 0; kp < 2; ++kp) if (it >= 2 || kp == 0) *(bf16x8*)(ptp + ((it * 2 + kp) * 64 + lane) * 8) = pack8(d2s[2 * kp], d2s[2 * kp + 1]);
            }
            { float* tab = (float*)(ptp + 512); tab[lane] = bcum; tab[64 + lane] = bcum + pm; }
            bf16* kwp = sb.KWT + cid * 8192; bf16* vtp = sb.VT + cid * 8192;
#pragma unroll 2
            for (int dt = 0; dt < 8; ++dt)
#pragma unroll
                for (int kp = 0; kp < 2; ++kp) { *(u32x4*)(kwp + ((dt * 2 + kp) * 64 + lane) * 8) = tr_gather<true>(kb + 16 * dt + x, 2560, kp, q, esc);
                    *(u32x4*)(vtp + ((dt * 2 + kp) * 64 + lane) * 8) = tr_gather<false>(vb + 16 * dt + x, 2560, kp, q, 0.f); }
        }
    }
}
constexpr int RC_NW = 0, RC_ATT = 16384, RC_KT = 24576, RC_QP = 40960, RC_BUF = 57344;
__device__ __forceinline__ void recur_stage(LAS unsigned char* buf, const bf16* f16a  , const bf16* f8  , const bf16* f16b  , const bf16* qbase  , int qpitch, int wave, int lane) {
#pragma unroll
    for (int k = 0; k < 5; ++k) { const int bl = wave + 8 * k;
        const bf16* src = bl < 16 ? f16a + bl * 512 : (bl < 24 ? f8 + (bl - 16) * 512 : f16b + (bl - 24) * 512);
        __builtin_amdgcn_global_load_lds((const unsigned*)(src + lane * 8), (LAS unsigned*)(buf + bl * 1024), 16, 0, 0); }
#pragma unroll
    for (int k = 0; k < 8; ++k) { const int P = (wave * 8 + k) * 256 + lane * 4, f = P >> 10, lp = (P & 1023) >> 4, jj0 = ((P & 15) >> 2) * 2, it = f >> 2, ks = f & 3, xp = lp & 15, qp = lp >> 4;
        const bf16* src = qbase + (size_t)(16 * it + xp) * qpitch + kperm(ks, qp, jj0);
        __builtin_amdgcn_global_load_lds((const unsigned*)src, (LAS unsigned*)(buf + RC_QP + (wave * 8 + k) * 256), 4, 0, 0); }
}
__device__ __forceinline__ void recur_phase(LAS unsigned char* lds, const ScanBufs sb, int G, int bid, int wave, int lane) {
    const int x = lane & 15, q = lane >> 4, et = wave;
#pragma unroll 1
    for (int u = bid; u < 2 * BATCH * 4; u += G) {
        const int mixer = u >> 7, b = (u & 127) >> 2, h = u & 3;
        const size_t cid0 = (size_t)((b * 4 + h) * 32);
        if (mixer == 0) {
            f32x4 S[8];
#pragma unroll
            for (int d = 0; d < 8; ++d) S[d] = (f32x4){0.f, 0.f, 0.f, 0.f};
            recur_stage(lds, sb.NW + cid0 * 8192, sb.ATT + cid0 * 4096, sb.KT + cid0 * 8192, sb.QKVA + (size_t)(b * SEQ) * 1536 + h * 128, 1536, wave, lane);
            __syncthreads();
#pragma unroll 1
            for (int c = 0; c < SEQ / 64; ++c) {
                const int m0 = b * SEQ + c * 64; const size_t cid = cid0 + c;
                const LAS unsigned char* buf = lds + (c & 1) * RC_BUF;
                { const int cn = c + 1 < SEQ / 64 ? c + 1 : c; const size_t cidn = cid0 + cn;
                  recur_stage(lds + ((c + 1) & 1) * RC_BUF, sb.NW + cidn * 8192, sb.ATT + cidn * 4096, sb.KT + cidn * 8192, sb.QKVA + (size_t)(b * SEQ + cn * 64) * 1536 + h * 128, 1536, wave, lane); }
                const bf16* utp = sb.UT + cid * 8192 + (size_t)(16 * et + x) * 64;
                const LAS float* tab = (const LAS float*)(buf + RC_ATT + 1024);
                bf16x8 Sb[4];
#pragma unroll
                for (int ks = 0; ks < 4; ++ks) Sb[ks] = pack8(S[2 * ks], S[2 * ks + 1]);
                f32x4 vn[4];
                { bf16x8 fr[16]; u32x2 uu[4];
#pragma unroll
                  for (int i = 0; i < 16; ++i) fr[i] = *(const LAS bf16x8*)(buf + RC_NW + (i * 64 + lane) * 16);
#pragma unroll
                  for (int mt = 0; mt < 4; ++mt) uu[mt] = *(const u32x2*)(utp + 16 * mt + 4 * q);
                  __builtin_amdgcn_sched_barrier(0);
#pragma unroll
                  for (int mt = 0; mt < 4; ++mt) { f32x4 acc = {bf_lo(uu[mt].x), bf_hi(uu[mt].x), bf_lo(uu[mt].y), bf_hi(uu[mt].y)};
#pragma unroll
                    for (int ks = 0; ks < 4; ++ks) acc = MFMA16(fr[mt * 4 + ks], Sb[ks], acc);
                    vn[mt] = acc; } }
                bf16x8 vb2[2] = {pack8(vn[0], vn[1]), pack8(vn[2], vn[3])};
                bf16x8 fq[16], fa[8]; float egl[4];
#pragma unroll
                for (int i = 0; i < 16; ++i) fq[i] = *(const LAS bf16x8*)(buf + RC_QP + (i * 64 + lane) * 16);
#pragma unroll
                for (int i = 0; i < 8; ++i) if (i >= 4 || (i & 1) == 0) fa[i] = *(const LAS bf16x8*)(buf + RC_ATT + (i * 64 + lane) * 16);
#pragma unroll
                for (int it = 0; it < 4; ++it) egl[it] = tab[16 * it + x];
                __builtin_amdgcn_sched_barrier(0);
#pragma unroll
                for (int it = 0; it < 4; ++it) { f32x4 acc = {0.f, 0.f, 0.f, 0.f};
#pragma unroll
                    for (int ks = 0; ks < 4; ++ks) acc = MFMA16(Sb[ks], fq[it * 4 + ks], acc);
                    acc = acc * egl[it];
#pragma unroll
                    for (int kp = 0; kp < 2; ++kp) if (it >= 2 || kp == 0) acc = MFMA16(vb2[kp], fa[it * 2 + kp], acc);
                    *(u32x2*)(sb.QKVA + (size_t)(m0 + 16 * it + x) * 1536 + 512 + h * 128 + 16 * et + 4 * q) = (u32x2){pk2v(acc.x, acc.y), pk2v(acc.z, acc.w)}; }
                f32x4 vs[4];
#pragma unroll
                for (int mt = 0; mt < 4; ++mt) { const f32x4 kk = *(const LAS f32x4*)(tab + 64 + 16 * mt + 4 * q); vs[mt] = vn[mt] * kk; }
                const bf16x8 vsb[2] = {pack8(vs[0], vs[1]), pack8(vs[2], vs[3])};
                const float gam = tab[63];
                { bf16x8 fk[16];
#pragma unroll
                  for (int i = 0; i < 16; ++i) fk[i] = *(const LAS bf16x8*)(buf + RC_KT + (i * 64 + lane) * 16);
                  __builtin_amdgcn_sched_barrier(0);
#pragma unroll
                  for (int dt = 0; dt < 8; ++dt) { f32x4 acc = S[dt] * gam;
#pragma unroll
                    for (int kp = 0; kp < 2; ++kp) acc = MFMA16(fk[dt * 2 + kp], vsb[kp], acc);
                    S[dt] = acc; } }
                __syncthreads();
            }
        } else {
            f32x4 Cs[8], Ce[8]; float mrun = 0.f;
#pragma unroll
            for (int d = 0; d < 8; ++d) { Cs[d] = (f32x4){0.f, 0.f, 0.f, 0.f}; Ce[d] = Cs[d]; }
            const short one = (x == 0) ? (short)0x3F80 : (short)0; const bf16x8 ones = {one, one, one, one, one, one, one, one};
            recur_stage(lds, sb.KWT + cid0 * 8192, sb.PT + cid0 * 4096, sb.KWT + cid0 * 8192, sb.X2 + (size_t)(b * SEQ) * 2560 + 512 + h * 128, 2560, wave, lane);
            __syncthreads();
#pragma unroll 1
            for (int c = 0; c < SEQ / 64; ++c) {
                const int m0 = b * SEQ + c * 64; const size_t cid = cid0 + c;
                const LAS unsigned char* buf = lds + (c & 1) * RC_BUF;
                { const int cn = c + 1 < SEQ / 64 ? c + 1 : c; const size_t cidn = cid0 + cn;
                  recur_stage(lds + ((c + 1) & 1) * RC_BUF, sb.KWT + cidn * 8192, sb.PT + cidn * 4096, sb.KWT + cidn * 8192, sb.X2 + (size_t)(b * SEQ + cn * 64) * 2560 + 512 + h * 128, 2560, wave, lane); }
                const bf16* vtp = sb.VT + cid * 8192;
                const LAS float* tab = (const LAS float*)(buf + RC_ATT + 1024);
                bf16x8 Cb[4], Eb[4];
#pragma unroll
                for (int ks = 0; ks < 4; ++ks) { Cb[ks] = pack8(Cs[2 * ks], Cs[2 * ks + 1]); Eb[ks] = pack8(Ce[2 * ks], Ce[2 * ks + 1]); }
                const bf16x8 vf[2] = {*(const bf16x8*)(vtp + ((et * 2 + 0) * 64 + lane) * 8), *(const bf16x8*)(vtp + ((et * 2 + 1) * 64 + lane) * 8)};
#pragma unroll
                for (int it = 0; it < 4; ++it) {
                    bf16x8 fq[16], fp[8];
#pragma unroll
                    for (int ks = 0; ks < 4; ++ks) fq[it * 4 + ks] = *(const LAS bf16x8*)(buf + RC_QP + ((it * 4 + ks) * 64 + lane) * 16);
#pragma unroll
                    for (int kp = 0; kp < 2; ++kp) if (it >= 2 || kp == 0) fp[it * 2 + kp] = *(const LAS bf16x8*)(buf + RC_ATT + ((it * 2 + kp) * 64 + lane) * 16);
                    const float bc = tab[16 * it + x], mi = tab[64 + 16 * it + x];
                    __builtin_amdgcn_sched_barrier(0);
                    const float a = bc + mrun, mt = fmaxf(a, mi), f1 = __expf(a - mt) * 0.08838834764831845f, f2 = __expf(mi - mt);
                    f32x4 a1 = {0.f, 0.f, 0.f, 0.f}, aP = a1, e1 = a1, eP = a1;
#pragma unroll
                    for (int ks = 0; ks < 4; ++ks) { const bf16x8 qf = fq[it * 4 + ks];
                        a1 = MFMA16(Cb[ks], qf, a1); if (wave == 0) e1 = MFMA16(Eb[ks], qf, e1); }
#pragma unroll
                    for (int kp = 0; kp < 2; ++kp) if (it >= 2 || kp == 0) { const bf16x8 pf = fp[it * 2 + kp]; aP = MFMA16(vf[kp], pf, aP); if (wave == 0) eP = MFMA16(ones, pf, eP); }
                    const f32x4 nm = a1 * f1 + aP * f2;
                    *(u32x2*)(sb.X2 + (size_t)(m0 + 16 * it + x) * 2560 + 1024 + h * 128 + 16 * et + 4 * q) = (u32x2){pk2(nm.x, nm.y), pk2(nm.z, nm.w)};
                    if (wave == 0 && q == 0) sb.DEN[(size_t)(m0 + 16 * it + x) * 4 + h] = fmaxf(fabsf(e1.x * f1 + eP.x * f2), __expf(-mt));
                }
                const float blast = tab[63], wsmax = tab[127];
                const float mnew = fmaxf(blast + mrun, wsmax), sc = __expf(blast + mrun - mnew), s2 = __expf(wsmax - mnew); mrun = mnew;
                bf16x8 fk[16];
#pragma unroll
                for (int i = 0; i < 16; ++i) fk[i] = *(const LAS bf16x8*)(buf + RC_KT + (i * 64 + lane) * 16);
                __builtin_amdgcn_sched_barrier(0);
#pragma unroll
                for (int dt = 0; dt < 8; ++dt) { f32x4 dC = {0.f, 0.f, 0.f, 0.f}, dE = dC;
#pragma unroll
                    for (int kp = 0; kp < 2; ++kp) { const bf16x8 kf = fk[dt * 2 + kp]; dC = MFMA16(kf, vf[kp], dC); if (wave == 0) dE = MFMA16(kf, ones, dE); }
                    Cs[dt] = Cs[dt] * sc + dC * s2; if (wave == 0) Ce[dt] = Ce[dt] * sc + dE * s2; }
                __syncthreads();
            }
        }
    }
}
__device__ __forceinline__ void post_phase(const ScanBufs sb, const float* norm_a, const float* norm_b, bf16* MIXED, int gw, int NGW, int lane) {
    const int hh = lane >> 3, sub = (lane & 7) * 16;
#pragma unroll 2
    for (int m = gw; m < M; m += NGW) {
        const bool isA = hh < 4; const int h = hh & 3;
        const bf16* src = isA ? sb.QKVA + (size_t)m * 1536 + 512 + h * 128 + sub : sb.X2 + (size_t)m * 2560 + 1024 + h * 128 + sub;
        const bf16* gsrc = sb.X2 + (size_t)m * 2560 + (isA ? 0 : 2048) + h * 128 + sub;
        const float* gn = (isA ? norm_a : norm_b + h * 128) + sub;
        const u32x4 r0 = *(const u32x4*)src, r1 = *(const u32x4*)(src + 8), z0 = *(const u32x4*)gsrc, z1 = *(const u32x4*)(gsrc + 8);
        float v[16] = {bf_lo(r0.x), bf_hi(r0.x), bf_lo(r0.y), bf_hi(r0.y), bf_lo(r0.z), bf_hi(r0.z), bf_lo(r0.w), bf_hi(r0.w), bf_lo(r1.x), bf_hi(r1.x), bf_lo(r1.y), bf_hi(r1.y), bf_lo(r1.z), bf_hi(r1.z), bf_lo(r1.w), bf_hi(r1.w)};
        const float z[16] = {bf_lo(z0.x), bf_hi(z0.x), bf_lo(z0.y), bf_hi(z0.y), bf_lo(z0.z), bf_hi(z0.z), bf_lo(z0.w), bf_hi(z0.w), bf_lo(z1.x), bf_hi(z1.x), bf_lo(z1.y), bf_hi(z1.y), bf_lo(z1.z), bf_hi(z1.z), bf_lo(z1.w), bf_hi(z1.w)};
        const float dinv = isA ? 1.f : 1.f / sb.DEN[(size_t)m * 4 + h];
        float ss = 0.f;
#pragma unroll
        for (int i = 0; i < 16; ++i) { v[i] *= dinv; ss += v[i] * v[i]; }
        ss += __shfl_xor(ss, 1); ss += __shfl_xor(ss, 2); ss += __shfl_xor(ss, 4);
        const float rstd = rsqrtf(ss * (1.f / 128.f) + EPS);
        float y[16];
#pragma unroll
        for (int i = 0; i < 16; ++i) { const float sg = sigmoid_f(z[i]); y[i] = v[i] * rstd * gn[i] * (isA ? z[i] * sg : sg); }
        u32x4* dst = (u32x4*)(MIXED + (size_t)m * 1024 + lane * 16);
        dst[0] = (u32x4){pk2(y[0], y[1]), pk2(y[2], y[3]), pk2(y[4], y[5]), pk2(y[6], y[7])}; dst[1] = (u32x4){pk2(y[8], y[9]), pk2(y[10], y[11]), pk2(y[12], y[13]), pk2(y[14], y[15])};
    }
}
typedef short v4i16_t __attribute__((ext_vector_type(4)));
constexpr int AT_VROW = 80;
constexpr int AT_K_BYTES = 256 * 128, AT_V_BYTES = 272 * AT_VROW * 2;
__device__ __forceinline__ void attn_phase(LAS unsigned char* lds, int tid, int wave, const bf16* QKV, const float* sinks, bf16* O, int G, int bid) {
    LAS unsigned char* KL = lds; LAS unsigned char* VL = lds + AT_K_BYTES;
    const int lane = tid & 63, x = lane & 15, q = lane >> 4, g = wave >> 1, qh = wave & 1;
    u32x4 kreg[4], vreg[4];
#define AT_LOAD_KV(uu) do { const int b_ = (uu) >> 6, kvh_ = ((uu) >> 4) & 3, jb_ = (uu) & 15; _Pragma("unroll") for (int i = 0; i < 4; ++i) { const int item = tid + 512 * i, r = item >> 3, ch = item & 7, sk = (jb_ - 1) * 128 + r; \
        kreg[i] = (u32x4){0u, 0u, 0u, 0u}; vreg[i] = kreg[i]; if (sk >= 0) { const bf16* src = QKV + (size_t)(b_ * SEQ + sk) * 1536 + 1024 + kvh_ * 64 + ch * 8; kreg[i] = *(const u32x4*)src; vreg[i] = *(const u32x4*)(src + 256); } } } while (0)
    if (bid < BATCH * 4 * 16) AT_LOAD_KV(bid);
#pragma unroll 1
    for (int u = bid; u < BATCH * 4 * 16; u += G) {
        const int b = u >> 6, kvh = (u >> 4) & 3, jb = u & 15;
#pragma unroll
        for (int i = 0; i < 4; ++i) { const int item = tid + 512 * i, r = item >> 3, ch = item & 7;
            *(LAS u32x4*)(KL + r * 128 + ((ch ^ (r & 7)) << 4)) = kreg[i]; *(LAS u32x4*)(VL + r * (AT_VROW * 2) + ch * 16) = vreg[i]; }
        if (tid < 128) { const int r = 256 + (tid >> 3), ch = tid & 7; unsigned z0 = 0u; asm volatile("" : "+v"(z0));
            *(LAS u32x4*)(VL + r * (AT_VROW * 2) + ch * 16) = (u32x4){z0, z0, z0, z0}; }
        __syncthreads();
        if (u + G < BATCH * 4 * 16) AT_LOAD_KV(u + G);
        const int hq = kvh * 4 + g; const float sink = sinks[hq];
        const size_t mq = (size_t)b * SEQ + jb * 128 + 64 * qh;
        bf16x8 Qn[2];
#pragma unroll
        for (int ks = 0; ks < 2; ++ks) Qn[ks] = *(const bf16x8*)(QKV + (mq + x) * 1536 + hq * 64 + 32 * ks + 8 * q);
#pragma unroll 1
        for (int nt = 0; nt < 4; ++nt) {
            const bf16x8 Qf[2] = {Qn[0], Qn[1]};
            { const int nn = nt < 3 ? nt + 1 : 3;
#pragma unroll
              for (int ks = 0; ks < 2; ++ks) Qn[ks] = *(const bf16x8*)(QKV + (mq + 16 * nn + x) * 1536 + hq * 64 + 32 * ks + 8 * q); }
            f32x4 s[9]; float mx = -3.0e38f;
            bf16x8 kf[9][2];
#pragma unroll
            for (int j = 0; j < 9; ++j) { const int r = 64 * qh + 16 * (nt + j) + x;
#pragma unroll
                for (int ks = 0; ks < 2; ++ks) kf[j][ks] = *(const LAS bf16x8*)(KL + r * 128 + (((4 * ks + q) ^ (r & 7)) << 4)); }
            __builtin_amdgcn_sched_barrier(0);
#pragma unroll
            for (int j = 0; j < 9; ++j) { const int kt = nt + j;
                f32x4 acc = {0.f, 0.f, 0.f, 0.f};
#pragma unroll
                for (int ks = 0; ks < 2; ++ks) acc = MFMA16(kf[j][ks], Qf[ks], acc);
#pragma unroll
                for (int rg = 0; rg < 4; ++rg) { const int diff = 16 * j + 4 * q + rg - x, ra = 64 * qh + 16 * kt + 4 * q + rg;
                    const bool valid = diff >= 1 && diff <= 128 && (jb - 1) * 128 + ra >= 0;
                    acc[rg] = valid ? acc[rg] : -3.0e38f; mx = fmaxf(mx, acc[rg]); }
                s[j] = acc; }
            mx = fmaxf(mx, __shfl_xor(mx, 16)); mx = fmaxf(mx, __shfl_xor(mx, 32)); mx = fmaxf(mx, sink);
            float sum = 0.f;
#pragma unroll
            for (int j = 0; j < 9; ++j)
#pragma unroll
                for (int rg = 0; rg < 4; ++rg) { const float p = (s[j][rg] > -1.0e38f) ? __expf(s[j][rg] - mx) : 0.f; s[j][rg] = p; sum += p; }
            sum += __shfl_xor(sum, 16); sum += __shfl_xor(sum, 32);
            const float inv = 1.f / (sum + __expf(sink - mx));
            bf16x8 Pf[5];
#pragma unroll
            for (int j2 = 0; j2 < 4; ++j2) Pf[j2] = pack8(s[2 * j2], s[2 * j2 + 1]);
            Pf[4] = pack8(s[8], (f32x4){0.f, 0.f, 0.f, 0.f});
            bf16x8 vf[4][5];
#pragma unroll
            for (int dt = 0; dt < 4; ++dt)
#pragma unroll
                for (int j2 = 0; j2 < 5; ++j2) { const int kb = 64 * qh + 16 * (nt + 2 * j2) + 4 * q + (x >> 2);
                    const LAS unsigned char* p0 = VL + kb * (AT_VROW * 2) + (16 * dt + 4 * (x & 3)) * 2;
                    const v4i16_t lo = __builtin_amdgcn_ds_read_tr16_b64_v4i16((LAS v4i16_t*)p0), hi = __builtin_amdgcn_ds_read_tr16_b64_v4i16((LAS v4i16_t*)(p0 + 16 * AT_VROW * 2));
                    vf[dt][j2] = (bf16x8){lo[0], lo[1], lo[2], lo[3], hi[0], hi[1], hi[2], hi[3]}; }
            __builtin_amdgcn_sched_barrier(0);
#pragma unroll
            for (int dt = 0; dt < 4; ++dt) { f32x4 acc = {0.f, 0.f, 0.f, 0.f};
#pragma unroll
                for (int j2 = 0; j2 < 5; ++j2) acc = MFMA16(vf[dt][j2], Pf[j2], acc);
                acc = acc * inv;
                *(u32x2*)(O + (mq + 16 * nt + x) * 1024 + hq * 64 + 16 * dt + 4 * q) = (u32x2){pk2v(acc.x, acc.y), pk2v(acc.z, acc.w)}; }
        }
        __syncthreads();
    }
}
#ifndef N_LAUNCH_MODE
#define N_LAUNCH_MODE 0
#endif
__global__ void __launch_bounds__(NTHR, 2) trunk_fwd(Args a_unused) {
    extern __shared__ __attribute__((aligned(16))) unsigned char lds_raw[];
    LAS unsigned char* lds = (LAS unsigned char*)lds_raw;
    volatile LAS unsigned* MISC = (volatile LAS unsigned*)(lds + MISC_OFF);
    if (threadIdx.x < 64) MISC[threadIdx.x] = 0u;
    __syncthreads();
    int lo, hi; XcdBarrier bar;
    int dupm = 0, dupp = 0; (void)dupm; (void)dupp;
    { KArgs a = kargs(); lo = a->ph_lo; hi = a->ph_hi; dupm = a->dup_mask; dupp = a->dup_par; unsigned* ctl = (unsigned*)(a->ws + WS_CTL);
      bar.bar = ctl + CW_BAR; bar.x = 0; bar.st = MISC + 8;
      if (hi - lo > 1) bar = xcd_barrier_post(ctl + CW_BAR, MISC + 8); }
#define IN(k) (lo <= (k) && (k) < hi)
#if defined(PROBE_DUP_MASK)
#define REP(k) _Pragma("unroll 1") for (int rep_ = 0; rep_ <= (((dupm >> (k)) & 1) && (dupp == 0 || dupp == 1 + (L & 1)) ? 1 : 0); ++rep_)
#else
#define REP(k)
#endif
#if defined(PROBE_BAR2)
#define SEAM(k) do { if (IN(k) && IN((k) + 1)) { xcd_barrier(bar); xcd_barrier(bar); } } while (0)
#else
#define SEAM(k) do { if (IN(k) && IN((k) + 1)) xcd_barrier(bar); } while (0)
#endif
#define ENV KArgs a = kargs(); const int tid = fresh_tid(), lane = tid & 63, wave = __builtin_amdgcn_readfirstlane(tid >> 6); const int G = gridDim.x, bid = blockIdx.x, gw = bid * NWAVES + wave, NGW = G * NWAVES, gtid = bid * NTHR + tid, NGT = G * NTHR; \
    unsigned char* ws = a->ws; bf16* RA = (bf16*)(ws + WS_RA); bf16* RB = (bf16*)(ws + WS_RB); bf16* RC = (bf16*)(ws + WS_RC); bf16* RD = (bf16*)(ws + WS_RD); float* Gt = (float*)(ws + WS_GT); \
    (void)lane; (void)wave; (void)gw; (void)NGW; (void)gtid; (void)NGT; (void)RA; (void)RB; (void)RC; (void)RD; (void)Gt; (void)G; (void)bid

    if (IN(0)) { ENV; prologue_phase(a, lds, gw, NGW, wave, lane, gtid, NGT);
#if defined(PROBE_DUP_MASK)
        if (dupm & (1 << 20)) prologue_phase(a, lds, gw, NGW, wave, lane, gtid, NGT);
#endif
    }
    SEAM(0);
#define SCANBUFS ScanBufs sb; sb.QKVA = (bf16*)(ws + WS_QKVA); sb.X2 = (bf16*)(ws + WS_X2); sb.Gt = Gt; sb.KT = (bf16*)(ws + WS_KT); sb.UT = (bf16*)(ws + WS_UT); sb.NW = (bf16*)(ws + WS_NW); sb.ATT = (bf16*)(ws + WS_ATT); \
    sb.KWT = (bf16*)(ws + WS_KWT); sb.VT = (bf16*)(ws + WS_VT); sb.PT = (bf16*)(ws + WS_PT); sb.DEN = (float*)(ws + WS_DEN)
#pragma unroll 1
    for (int L = 0; L < DEPTH; ++L) {
        const int pb = 1 + L * PH_PER_LAYER; const bool even = (L & 1) == 0; const int e = L >> 1;
        if (L == 0 && IN(pb + 0)) REP(0) { ENV; const float* hin = a->x;
            norm_phase(lds, hin, a->gains + (size_t)L * 4 * DM, (bf16*)a->out, (float*)(ws + WS_RS0), even, (const float*)(ws + WS_WGATES) + (size_t)e * 16 * 1024, Gt, gw, NGW, tid, lane); }
        if (L == 0) SEAM(pb + 0);
        if (IN(pb + 1)) REP(1) { ENV;
            const int N = even ? 4096 : 1536;
            pg8::Gemm g{(const bf16*)a->out, even ? (const bf16*)(ws + WS_WIN) + (size_t)e * 4096 * 1024 : (const bf16*)(ws + WS_WQKV) + (size_t)e * 1536 * 1024, M, N, DM};
            pg8::StaticOrder S; S.init(M, N, G, bid);
            pg8::EpiIn E{RC, (bf16*)(ws + WS_X2), even ? nullptr : a->b_qkv + (size_t)e * 1536, even ? nullptr : (const float*)(ws + WS_ROPE), (const float*)(ws + WS_RS0)};
            pg8::gemm_phase<pg8::EpiIn, pg8::StaticOrder, true, true>(lds, g, S, E);
        }
        SEAM(pb + 1);
        if (even) {
            if (IN(pb + 2)) REP(2) { ENV; conv_phase((const bf16*)(ws + WS_X1), a->conv + (size_t)e * 4 * 1536, (bf16*)(ws + WS_QKVA), gw, NGW, lane); }
            SEAM(pb + 2);
        }
        if (even) {
            if (IN(pb + 3)) REP(3) { ENV; SCANBUFS; local_phase(lds, sb, a->a_log + e * 4, a->dt_bias + e * 4, a->i_bias + e * 4, a->f_bias + e * 4, gw, NGW, wave, lane); }
            SEAM(pb + 3);
        }
        if (IN(pb + 4)) REP(4) { ENV;
            if (even) { SCANBUFS; recur_phase(lds, sb, G, bid, wave, lane); }
            else attn_phase(lds, tid, wave, RC, a->sinks + e * 16, RD, G, bid);
        }
        SEAM(pb + 4);
        if (even) {
            if (IN(pb + 5)) REP(5) { ENV; SCANBUFS; post_phase(sb, a->norm_a + e * 128, a->norm_b + e * 512, (bf16*)(ws + WS_MIXED), gw, NGW, lane); }
            SEAM(pb + 5);
        }
        if (IN(pb + 6)) REP(6) { ENV;
            pg8::Gemm g{even ? (const bf16*)(ws + WS_MIXED) : (const bf16*)RD, even ? (const bf16*)(ws + WS_WOUT) + (size_t)e * DM * DM : (const bf16*)(ws + WS_WO) + (size_t)e * DM * DM, M, DM, DM};
            pg8::StaticOrder S; S.init(M, DM, G, bid);
            pg8::EpiBf16<0> E{RA, DM, even ? nullptr : a->b_o + (size_t)e * DM, RA, 1 << 30, DM, nullptr};
            pg8::gemm_phase<pg8::EpiBf16<0>, pg8::StaticOrder, true, true>(lds, g, S, E);
        }
        SEAM(pb + 6);
        if (IN(pb + 7)) { ENV; const float* gains = a->gains + (size_t)L * 4 * DM;
            resid_a_phase(RA, (L == 0) ? a->x : nullptr, (bf16*)a->out, gains + DM, (float*)(ws + WS_RS2), gw, NGW, lane); }
        SEAM(pb + 7);
        if (IN(pb + 8)) REP(8) { ENV;
            pg8::Gemm g{(const bf16*)a->out, (const bf16*)(ws + WS_WUP) + (size_t)L * FF * DM, M, FF, DM};
            pg8::StaticOrder S; S.init(M, FF, G, bid);
            pg8::EpiBf16<1> E{RC, FF, nullptr, RC, 1 << 30, FF, (const float*)(ws + WS_RS2)};
            pg8::gemm_phase<pg8::EpiBf16<1>, pg8::StaticOrder, true, true>(lds, g, S, E);
        }
        SEAM(pb + 8);
        if (IN(pb + 9)) REP(9) { ENV;
            pg8::Gemm g{RC, (const bf16*)(ws + WS_WDN) + (size_t)L * DM * FF, M, DM, FF};
            pg8::StaticOrder S; S.init(M, DM, G, bid);
            pg8::EpiBf16<0> E{RA, DM, nullptr, RA, 1 << 30, DM, nullptr};
            pg8::gemm_phase<pg8::EpiBf16<0>, pg8::StaticOrder, true, true>(lds, g, S, E);
        }
        SEAM(pb + 9);
        if (IN(pb + 10)) { ENV; resid_b_phase(RA, (const bf16*)a->out, a->gains + (size_t)L * 4 * DM + 3 * DM, RD, a->p + (size_t)L * M * PLE, RC, gw, NGW, lane, gtid, NGT); }
        SEAM(pb + 10);
        if (IN(pb + 11)) REP(11) { ENV;
            pg8::Gemm g{RC, (const bf16*)(ws + WS_WPLE) + (size_t)L * DM * PLE, M, DM, PLE};
            pg8::StaticOrder S; S.init(M, DM, G, bid);
            pg8::EpiBf16<0> E{RB, DM, nullptr, RB, 1 << 30, DM, nullptr};
            pg8::gemm_phase<pg8::EpiBf16<0>, pg8::StaticOrder, true, true>(lds, g, S, E);
        }
        if (IN(pb + 11)) { ENV;
            pg8::Gemm g{RD, (const bf16*)(ws + WS_WG) + (size_t)L * DM * DM, M, DM, DM};
            pg8::StaticOrder S; S.init(M, DM, G, bid);
            pg8::EpiBf16<0> E{(bf16*)(ws + WS_RC + 64 * MiB), DM, nullptr, RB, 1 << 30, DM, nullptr};
            pg8::gemm_phase<pg8::EpiBf16<0>, pg8::StaticOrder, true, true>(lds, g, S, E);
        }
        SEAM(pb + 11);
        if (IN(pb + 12)) { ENV; const bool has_next = L + 1 < DEPTH, even_next = ((L + 1) & 1) == 0; const int en = (L + 1) >> 1;
            resid_c_phase(lds, (const bf16*)(ws + WS_RC + 64 * MiB), RB, RD, (bf16*)a->out, a->out, has_next, a->gains + (size_t)(L + 1 < DEPTH ? L + 1 : L) * 4 * DM, (float*)(ws + WS_RS0), even_next, (const float*)(ws + WS_WGATES) + (size_t)(en & 1) * 16 * 1024, Gt, gw, NGW, tid, lane); }
        SEAM(pb + 12);
    }
#undef SCANBUFS
#undef IN
#undef SEAM
#undef ENV
}

extern "C" void kernel_launch(void* const* d_in, const int* in_sizes, int n_in, void* d_out, int out_size, void* d_ws, size_t ws_size, hipStream_t stream) {
    static int grid = 0;
    if (grid == 0) {
        if (n_in != 22 || in_sizes[0] != M * DM || out_size != M * DM || ws_size < WS_END) {
            fprintf(stderr, "kernel_launch: unexpected shapes (n_in %d, in0 %d, out %d, ws %zu; need ws >= %zu); nothing launched\n", n_in, n_in > 0 ? in_sizes[0] : -1, out_size, ws_size, (size_t)WS_END); grid = -1; return; }
        int dev = 0, cus = 0, per_cu = 0;
        if (hipGetDevice(&dev) != hipSuccess || hipDeviceGetAttribute(&cus, hipDeviceAttributeMultiprocessorCount, dev) != hipSuccess) { fprintf(stderr, "kernel_launch: device query failed\n"); grid = -1; return; }
        if (hipFuncSetAttribute((const void*)trunk_fwd, hipFuncAttributeMaxDynamicSharedMemorySize, LDS_BYTES) != hipSuccess) { fprintf(stderr, "kernel_launch: hipFuncSetAttribute failed\n"); grid = -1; return; }
        if (hipOccupancyMaxActiveBlocksPerMultiprocessor(&per_cu, (const void*)trunk_fwd, NTHR, LDS_BYTES) != hipSuccess || per_cu < 1) fprintf(stderr, "kernel_launch: note: occupancy query reports %d\n", per_cu);
        (void)hipGetLastError();
        grid = cus;
    }
    if (grid < 0) return;
    Args a{};
    a.x = (const float*)d_in[0]; a.p = (const float*)d_in[1]; a.pos = (const int*)d_in[2]; a.gains = (const float*)d_in[3]; a.w_in = (const float*)d_in[4]; a.conv = (const float*)d_in[5];
    a.a_log = (const float*)d_in[6]; a.dt_bias = (const float*)d_in[7]; a.norm_a = (const float*)d_in[8]; a.i_bias = (const float*)d_in[9]; a.f_bias = (const float*)d_in[10]; a.norm_b = (const float*)d_in[11];
    a.b_qkv = (const float*)d_in[14]; a.sinks = (const float*)d_in[15]; a.b_o = (const float*)d_in[17];
    a.out = (float*)d_out; a.ws = (unsigned char*)d_ws;
#if defined(PROBE_DUP_MASK)
    a.dup_mask = PROBE_DUP_MASK; a.dup_par = PROBE_DUP_PAR;
#endif
    a.w_out = (const float*)d_in[12]; a.w_qkv = (const float*)d_in[13]; a.w_o = (const float*)d_in[16]; a.w_up = (const float*)d_in[18]; a.w_down = (const float*)d_in[19]; a.w_ple = (const float*)d_in[20]; a.w_gate = (const float*)d_in[21];
#if N_LAUNCH_MODE == 0
    if (hipMemsetAsync((char*)d_ws + WS_CTL, 0, CTL_ZERO_BYTES, stream) != hipSuccess) { fprintf(stderr, "kernel_launch: memset failed\n"); return; }
    a.ph_lo = 0; a.ph_hi = NPHASE;
    hipLaunchKernelGGL(trunk_fwd, dim3(grid), dim3(NTHR), LDS_BYTES, stream, a);
#else
    for (int ph = 0; ph < NPHASE; ++ph) { a.ph_lo = ph; a.ph_hi = ph + 1; hipLaunchKernelGGL(trunk_fwd, dim3(grid), dim3(NTHR), LDS_BYTES, stream, a); }
#endif
    const hipError_t le = hipPeekAtLastError();
    if (le != hipSuccess) fprintf(stderr, "kernel_launch: launch failed: %s\n", hipGetErrorName(le));
}
```

```cpp
#include <hip/hip_runtime.h>
#include <cstdio>
#include <cstdint>
#define N_LAUNCH_MODE 0
namespace pg8 {
#define PG8_LAS __attribute__((address_space(3)))
typedef unsigned short bf16_t;
typedef short bf16x8 __attribute__((ext_vector_type(8)));
typedef float f32x4 __attribute__((ext_vector_type(4)));
typedef unsigned u32x4 __attribute__((ext_vector_type(4)));
constexpr int BM = 256, BK = 64, HALF = 128, HTB = HALF * BK * 2  , STAGE_BYTES = 8 * HTB, NXCD = 8, WGM = 8;

__host__ __device__ __forceinline__ int lds_byte(int r, int c) { const int st = (r >> 4) * 2 + (c >> 5), rr = r & 15, cc = c & 31, ob = rr * 64 + cc * 2; return st * 1024 + (ob ^ (((ob >> 9) & 1) << 5)); }
__host__ __device__ __forceinline__ void stage_rc(int b, int& R, int& C) { const int st = b / 1024, sb = b % 1024, swz = sb ^ (((sb >> 9) & 1) << 5); R = (st >> 1) * 16 + swz / 64; C = (st & 1) * 32 + (swz % 64) / 2; }
__host__ __device__ __forceinline__ int perm32(int rho) { const int n = rho >> 4, i = rho & 15; return 8 * (i >> 2) + 4 * n + (i & 3); }

struct Unit { int pm, pn; };
struct Gemm { const bf16_t* A; const bf16_t* Bt; int M, N, K; };

struct StaticOrder {
    int nM, nN, nwg, G, c;
    __host__ __device__ void init(int M, int N, int G_, int c_) { nM = M / BM; nN = N / BM; nwg = nM * nN; G = G_; c = c_; }
    __host__ __device__ bool next(int i, Unit& u) const {
        const long L = (long)i * G + c; if (L >= nwg) return false;
        int wgid = (int)L; { const int q = nwg / NXCD, r = nwg % NXCD, xcd = wgid % NXCD, off = wgid / NXCD; wgid = (xcd < r ? xcd * (q + 1) : r * (q + 1) + (xcd - r) * q) + off; }
        const int nig = WGM * nN, gid = wgid / nig, fm = gid * WGM, gsz = (nM - fm) < WGM ? (nM - fm) : WGM;
        u.pm = fm + ((wgid % nig) % gsz); u.pn = (wgid % nig) / gsz; return true;
    }
    __device__ __forceinline__ void a_ready(const Unit&) const {}
    __device__ __forceinline__ void done(const Unit&) const {}
};

__device__ __forceinline__ unsigned cvt_pk_bf16(float lo, float hi) { unsigned r; asm volatile("v_cvt_pk_bf16_f32 %0, %1, %2" : "=v"(r) : "v"(lo), "v"(hi)); return r; }
typedef float f32x2 __attribute__((ext_vector_type(2)));
typedef unsigned u32x2 __attribute__((ext_vector_type(2)));

template <int ACT  > struct EpiBf16 {
    static constexpr bool PERM = true, AFTER_DRAIN = false;
    bf16_t* O; int ldc; const float* bias; bf16_t* O2; int split_col, ldc2; const float* rowscale;
    __device__ __forceinline__ void operator()(const f32x4 (&acc)[2][2][4][2], const Unit& u, int wr, int wc, int fr, int fq) const {
        const int row0 = u.pm * BM + wr * 64 + fr; const int col0 = u.pn * BM + wc * 32 + 8 * fq;
        const bool second = u.pn * BM >= split_col; bf16_t* const ob = second ? O2 : O; const int ld = second ? ldc2 : ldc, oc0 = second ? col0 - split_col : col0;
        f32x4 bv[2][2];
#pragma unroll
        for (int bj = 0; bj < 2; ++bj)
#pragma unroll
            for (int n = 0; n < 2; ++n) bv[bj][n] = bias ? *(const f32x4*)(bias + col0 + bj * HALF + 4 * n) : (f32x4){0.f, 0.f, 0.f, 0.f};
#pragma unroll
        for (int ai = 0; ai < 2; ++ai)
#pragma unroll
            for (int m = 0; m < 4; ++m) { bf16_t* rowp = ob + (size_t)(row0 + ai * HALF + m * 16) * ld + oc0; const float rs = rowscale ? rowscale[row0 + ai * HALF + m * 16] : 1.f;
#pragma unroll
                for (int bj = 0; bj < 2; ++bj) { f32x4 v0 = acc[ai][bj][m][0] * rs + bv[bj][0], v1 = acc[ai][bj][m][1] * rs + bv[bj][1];
                    if (ACT == 1) {
#pragma unroll
                        for (int i = 0; i < 4; ++i) { const float a = fmaxf(v0[i], 0.f), b = fmaxf(v1[i], 0.f); v0[i] = a * a; v1[i] = b * b; } }
                    u32x4 w; w.x = cvt_pk_bf16(v0[0], v0[1]); w.y = cvt_pk_bf16(v0[2], v0[3]); w.z = cvt_pk_bf16(v1[0], v1[1]); w.w = cvt_pk_bf16(v1[2], v1[3]);
                    *(u32x4*)(rowp + bj * HALF) = w; } }
    }
};
__device__ __forceinline__ float row_rstd16(const float* ps, int row) { const f32x4* p = (const f32x4*)(ps + (size_t)row * 16); const f32x4 a = p[0], b = p[1], c = p[2], d = p[3];
    return rsqrtf((((a.x + a.y) + (a.z + a.w)) + ((b.x + b.y) + (b.z + b.w)) + (((c.x + c.y) + (c.z + c.w)) + ((d.x + d.y) + (d.z + d.w)))) * (1.f / 1024.f) + 1e-6f); }
struct EpiIn {
    static constexpr bool PERM = true, AFTER_DRAIN = false;
    bf16_t* O; bf16_t* O2; const float* bias; const float* rope; const float* ps; float* gates;
    __device__ __forceinline__ void operator()(const f32x4 (&acc)[2][2][4][2], const Unit& u, int wr, int wc, int fr, int fq) const {
        const int row0 = u.pm * BM + wr * 64 + fr, colt = u.pn * BM + wc * 32 + 8 * fq, g = (colt & 63) >> 3;
        if (rope == nullptr && u.pn == 16) {
            if (wc == 0 && fq < 2) {
#pragma unroll
                for (int ai = 0; ai < 2; ++ai)
#pragma unroll
                    for (int m = 0; m < 4; ++m) { const int row = row0 + ai * HALF + m * 16; const float rs = row_rstd16(ps, row);
#pragma unroll
                        for (int n = 0; n < 2; ++n) *(f32x4*)(gates + (size_t)row * 16 + 8 * fq + 4 * n) = acc[ai][0][m][n] * rs; } }
            return; }
        const bool rot = rope != nullptr && u.pn < 5, second = rope == nullptr && u.pn >= 6;
        bf16_t* const ob = second ? O2 : O; const int ld = second ? 2560 : 1536, oc0 = second ? colt - 1536 : colt;
#pragma unroll
        for (int ai = 0; ai < 2; ++ai)
#pragma unroll
            for (int m = 0; m < 4; ++m) { const int row = row0 + ai * HALF + m * 16; bf16_t* rowp = ob + (size_t)row * ld;
                const float rs = row_rstd16(ps, row); f32x4 t0 = {1.f, 0.f, 1.f, 0.f}, t1 = t0;
                if (rot) { t0 = *(const f32x4*)(rope + (size_t)row * 64 + 8 * g); t1 = *(const f32x4*)(rope + (size_t)row * 64 + 8 * g + 4); }
#pragma unroll
                for (int bj = 0; bj < 2; ++bj) { const int c = colt + bj * HALF, hd = c >> 6; f32x4 v0 = acc[ai][bj][m][0] * rs, v1 = acc[ai][bj][m][1] * rs;
                    if (rope) { v0 = v0 + (rot ? *(const f32x4*)(bias + hd * 64 + 4 * g) : *(const f32x4*)(bias + c)); v1 = v1 + (rot ? *(const f32x4*)(bias + hd * 64 + 32 + 4 * g) : *(const f32x4*)(bias + c + 4)); }
                    if (rot) { const float sc = c < 1024 ? 0.125f : 1.f; const f32x4 cs = {t0.x, t0.z, t1.x, t1.z}, sn = {t0.y, t0.w, t1.y, t1.w};
                        const f32x4 o1 = (v0 * cs - v1 * sn) * sc, o2 = (v1 * cs + v0 * sn) * sc;
                        u32x2 w1, w2; w1.x = cvt_pk_bf16(o1[0], o1[1]); w1.y = cvt_pk_bf16(o1[2], o1[3]); w2.x = cvt_pk_bf16(o2[0], o2[1]); w2.y = cvt_pk_bf16(o2[2], o2[3]);
                        *(u32x2*)(rowp + hd * 64 + 4 * g) = w1; *(u32x2*)(rowp + hd * 64 + 32 + 4 * g) = w2; }
                    else {
                        u32x4 w; w.x = cvt_pk_bf16(v0[0], v0[1]); w.y = cvt_pk_bf16(v0[2], v0[3]); w.z = cvt_pk_bf16(v1[0], v1[1]); w.w = cvt_pk_bf16(v1[2], v1[3]); *(u32x4*)(rowp + oc0 + bj * HALF) = w; } } }
    }
};
struct EpiF32 {
    static constexpr bool PERM = false, AFTER_DRAIN = false;
    float* C; int ldc; const float* bias;
    __device__ __forceinline__ void operator()(const f32x4 (&acc)[2][2][4][2], const Unit& u, int wr, int wc, int fr, int fq) const {
        const int row0 = u.pm * BM + wr * 64 + fr, col0 = u.pn * BM + wc * 32 + 4 * fq;
        f32x4 bv[2][2];
#pragma unroll
        for (int bj = 0; bj < 2; ++bj)
#pragma unroll
            for (int n = 0; n < 2; ++n) bv[bj][n] = bias ? *(const f32x4*)(bias + col0 + bj * HALF + n * 16) : (f32x4){0.f, 0.f, 0.f, 0.f};
#pragma unroll
        for (int ai = 0; ai < 2; ++ai)
#pragma unroll
            for (int m = 0; m < 4; ++m) { float* rowp = C + (size_t)(row0 + ai * HALF + m * 16) * ldc + col0;
#pragma unroll
                for (int bj = 0; bj < 2; ++bj)
#pragma unroll
                    for (int n = 0; n < 2; ++n) *(f32x4*)(rowp + bj * HALF + n * 16) = acc[ai][bj][m][n] + bv[bj][n]; }
    }
};
__device__ __forceinline__ float bf_lo(unsigned w) { return __builtin_bit_cast(float, w << 16); }
__device__ __forceinline__ float bf_hi(unsigned w) { return __builtin_bit_cast(float, w & 0xffff0000u); }
struct EpiGate2 {
    static constexpr bool PERM = true, AFTER_DRAIN = false;
    const bf16_t* H2; const bf16_t* PP; bf16_t* HS; float* out32; float* ps;
    __device__ __forceinline__ void operator()(const f32x4 (&acc)[2][2][4][2], const Unit& u, int wr, int wc, int fr, int fq) const {
        const int row0 = u.pm * BM + wr * 64 + fr, col0 = u.pn * BM + wc * 32 + 8 * fq;
#pragma unroll
        for (int ai = 0; ai < 2; ++ai) {
            u32x4 hw[4][2], pw[4][2];
#pragma unroll
            for (int m = 0; m < 4; ++m)
#pragma unroll
                for (int bj = 0; bj < 2; ++bj) { const size_t off = (size_t)(row0 + ai * HALF + m * 16) * 1024 + col0 + bj * HALF; hw[m][bj] = *(const u32x4*)(H2 + off); pw[m][bj] = *(const u32x4*)(PP + off); }
#pragma unroll
            for (int m = 0; m < 4; ++m) { const int row = row0 + ai * HALF + m * 16; float ss = 0.f;
#pragma unroll
                for (int bj = 0; bj < 2; ++bj) { const size_t off = (size_t)row * 1024 + col0 + bj * HALF;
                    const u32x4 h_ = hw[m][bj], p_ = pw[m][bj]; const f32x4 a0 = acc[ai][bj][m][0], a1 = acc[ai][bj][m][1];
                    f32x4 h0 = {bf_lo(h_.x), bf_hi(h_.x), bf_lo(h_.y), bf_hi(h_.y)}, h1 = {bf_lo(h_.z), bf_hi(h_.z), bf_lo(h_.w), bf_hi(h_.w)};
                    const f32x4 p0 = {bf_lo(p_.x), bf_hi(p_.x), bf_lo(p_.y), bf_hi(p_.y)}, p1 = {bf_lo(p_.z), bf_hi(p_.z), bf_lo(p_.w), bf_hi(p_.w)};
#pragma unroll
                    for (int i = 0; i < 4; ++i) { h0[i] += p0[i] * __builtin_amdgcn_rcpf(1.f + __expf(-a0[i])); h1[i] += p1[i] * __builtin_amdgcn_rcpf(1.f + __expf(-a1[i])); }
                    ss += ((h0.x * h0.x + h0.y * h0.y) + (h0.z * h0.z + h0.w * h0.w)) + ((h1.x * h1.x + h1.y * h1.y) + (h1.z * h1.z + h1.w * h1.w));
                    if (out32) { *(f32x4*)(out32 + off) = h0; *(f32x4*)(out32 + off + 4) = h1; }
                    else { u32x4 w; w.x = cvt_pk_bf16(h0[0], h0[1]); w.y = cvt_pk_bf16(h0[2], h0[3]); w.z = cvt_pk_bf16(h1[0], h1[1]); w.w = cvt_pk_bf16(h1[2], h1[3]); *(u32x4*)(HS + off) = w; } }
                ss += __shfl_xor(ss, 16); ss += __shfl_xor(ss, 32);
                if (fq == 0) ps[(size_t)row * 16 + u.pn * 4 + wc] = ss; } }
    }
};
struct EpiGate {
    static constexpr bool PERM = false, AFTER_DRAIN = false;
    float* H; const bf16_t* PP; int ldc;
    __device__ __forceinline__ void operator()(const f32x4 (&acc)[2][2][4][2], const Unit& u, int wr, int wc, int fr, int fq) const {
        const int row0 = u.pm * BM + wr * 64 + fr, col0 = u.pn * BM + wc * 32 + 4 * fq;
#pragma unroll
        for (int ai = 0; ai < 2; ++ai)
#pragma unroll
            for (int m = 0; m < 4; ++m) { const size_t ro = (size_t)(row0 + ai * HALF + m * 16) * ldc + col0;
#pragma unroll
                for (int bj = 0; bj < 2; ++bj)
#pragma unroll
                    for (int n = 0; n < 2; ++n) { const size_t off = ro + bj * HALF + n * 16;
                        f32x4 hv = *(const f32x4*)(H + off); const u32x2 pv = *(const u32x2*)(PP + off); const f32x4 a = acc[ai][bj][m][n];
                        const float p0 = bf_lo(pv.x), p1 = bf_hi(pv.x), p2 = bf_lo(pv.y), p3 = bf_hi(pv.y);
                        hv[0] += p0 / (1.f + __expf(-a[0])); hv[1] += p1 / (1.f + __expf(-a[1])); hv[2] += p2 / (1.f + __expf(-a[2])); hv[3] += p3 / (1.f + __expf(-a[3]));
                        *(f32x4*)(H + off) = hv; } }
    }
};

template <class Epi, class Sched, bool ALIGN_EPI = false, bool SP2 = false>
__device__ __forceinline__ void gemm_phase(PG8_LAS unsigned char* lds, const Gemm g, const Sched& S, const Epi& E) {
    int tid_l = threadIdx.x; asm volatile("" : "+v"(tid_l));
    const int tid = tid_l, wid = __builtin_amdgcn_readfirstlane(tid >> 6), lane = tid & 63, wr = wid >> 2, wc = wid & 3, fr = lane & 15, fq = lane >> 4;
    const int K = g.K, nt = K / BK;
    unsigned voffA[2], voffB[2];
#pragma unroll
    for (int i = 0; i < 2; ++i) { int R, C; stage_rc(tid * 16 + i * 8192, R, C); const int Rb = Epi::PERM ? ((R & ~31) + perm32(R & 31)) : R;
        voffA[i] = (unsigned)(R * K + C) * 2u; voffB[i] = (unsigned)(Rb * K + C) * 2u; }
    const size_t kstep = (size_t)(BK * 2);
    const size_t hstep = (size_t)HALF * K * 2;
    const size_t tstep = 2 * hstep;
    const unsigned ldsw = (unsigned)wid * 1024u;
    const int aoff = lds_byte(wr * 64 + fr, fq * 8), boff = lds_byte(wc * 32 + fr, fq * 8);
#define PG8_SA(b, h) (((b) * 2 + (h)) * HTB)
#define PG8_SB(b, h) ((4 + (b) * 2 + (h)) * HTB)
#define PG8_STAGE(bufoff, gbase, voff) do { _Pragma("unroll") for (int _i = 0; _i < 2; ++_i) \
        __builtin_amdgcn_global_load_lds((const unsigned*)((const char*)(gbase) + (voff)[_i]), (PG8_LAS unsigned*)(lds + (bufoff) + ldsw + _i * 8192), 16, 0, 0); } while (0)
#define PG8_LDA(dst, b, h) do { _Pragma("unroll") for (int m = 0; m < 4; ++m) _Pragma("unroll") for (int k = 0; k < 2; ++k) dst[m][k] = *(const PG8_LAS bf16x8*)(lds + PG8_SA(b, h) + aoff + m * 2048 + k * 1024); } while (0)
#define PG8_LDB(dst, b, h) do { _Pragma("unroll") for (int n = 0; n < 2; ++n) _Pragma("unroll") for (int k = 0; k < 2; ++k) dst[n][k] = *(const PG8_LAS bf16x8*)(lds + PG8_SB(b, h) + boff + n * 2048 + k * 1024); } while (0)
#define PG8_MMA(ai, bj, At, Bt) do { __builtin_amdgcn_s_setprio(1); _Pragma("unroll") for (int m = 0; m < 4; ++m) _Pragma("unroll") for (int n = 0; n < 2; ++n) _Pragma("unroll") for (int k = 0; k < 2; ++k) \
        acc[ai][bj][m][n] = __builtin_amdgcn_mfma_f32_16x16x32_bf16(Bt[n][k], At[m][k], acc[ai][bj][m][n], 0, 0, 0); __builtin_amdgcn_s_setprio(0); } while (0)
#define PG8_WAIT_V(n) asm volatile("s_waitcnt vmcnt(" #n ")" ::: "memory")
#define PG8_WAIT_L(n) asm volatile("s_waitcnt lgkmcnt(" #n ")" ::: "memory")
#define PG8_BAR __builtin_amdgcn_s_barrier()
#define PG8_SCHED __builtin_amdgcn_sched_barrier(0)
    Unit cur, nxt; int ui = 0;
    if (!S.next(0, cur)) return;
    f32x4 acc[2][2][4][2];
#pragma unroll
    for (int a = 0; a < 2; ++a)
#pragma unroll
        for (int b = 0; b < 2; ++b)
#pragma unroll
            for (int m = 0; m < 4; ++m)
#pragma unroll
                for (int n = 0; n < 2; ++n) acc[a][b][m][n] = (f32x4){0.f, 0.f, 0.f, 0.f};
    bf16x8 At[4][2], B0[2][2], B1[2][2];
    const char* cA = (const char*)g.A + (size_t)cur.pm * tstep; const char* cB = (const char*)g.Bt + (size_t)cur.pn * tstep;
    S.a_ready(cur);
    if constexpr (SP2) {
        PG8_STAGE(PG8_SB(0, 0), cB, voffB); PG8_STAGE(PG8_SB(0, 1), cB + hstep, voffB); PG8_STAGE(PG8_SA(0, 0), cA, voffA); PG8_STAGE(PG8_SA(0, 1), cA + hstep, voffA);
        if (wr == 1) PG8_BAR;
        PG8_WAIT_V(2); PG8_BAR;
        PG8_STAGE(PG8_SB(1, 0), cB + kstep, voffB); PG8_STAGE(PG8_SA(1, 0), cA + kstep, voffA); PG8_STAGE(PG8_SB(1, 1), cB + hstep + kstep, voffB);
        PG8_WAIT_V(6); PG8_BAR;
    } else {
        PG8_STAGE(PG8_SB(0, 0), cB, voffB); PG8_STAGE(PG8_SA(0, 0), cA, voffA); PG8_STAGE(PG8_SB(0, 1), cB + hstep, voffB); PG8_STAGE(PG8_SA(0, 1), cA + hstep, voffA);
        if (wr == 1) PG8_BAR;
        PG8_WAIT_V(4); PG8_BAR;
        PG8_STAGE(PG8_SB(1, 0), cB + kstep, voffB); PG8_STAGE(PG8_SA(1, 0), cA + kstep, voffA); PG8_STAGE(PG8_SB(1, 1), cB + hstep + kstep, voffB);
        PG8_WAIT_V(6); PG8_BAR;
    }
    for (;;) {
        const bool has_next = S.next(ui + 1, nxt);
        const char* nA = has_next ? (const char*)g.A + (size_t)nxt.pm * tstep : cA; const char* nB = has_next ? (const char*)g.Bt + (size_t)nxt.pn * tstep : cB;
        for (int t = 0; t < nt; t += 2) {
            const bool last = (t == nt - 2);
            const char* a1 = cA + (size_t)(t + 1) * kstep;
            const char* a2 = last ? nA : cA + (size_t)(t + 2) * kstep; const char* b2 = last ? nB : cB + (size_t)(t + 2) * kstep;
            const char* a3 = a2 + kstep; const char* b3 = b2 + kstep;
            if (last && has_next) S.a_ready(nxt);
            if constexpr (SP2) {
            PG8_LDB(B0, 0, 0); PG8_LDB(B1, 0, 1); PG8_SCHED; PG8_LDA(At, 0, 0); PG8_STAGE(PG8_SA(1, 1), a1 + hstep, voffA);
            PG8_WAIT_V(8); PG8_WAIT_L(0); PG8_BAR; PG8_MMA(0, 0, At, B0); PG8_MMA(0, 1, At, B1); PG8_BAR; PG8_SCHED;
            PG8_LDA(At, 0, 1); PG8_STAGE(PG8_SB(0, 0), b2, voffB); PG8_STAGE(PG8_SB(0, 1), b2 + hstep, voffB); PG8_STAGE(PG8_SA(0, 0), a2, voffA);
            PG8_WAIT_V(8); PG8_WAIT_L(0); PG8_BAR; PG8_MMA(1, 0, At, B0); PG8_MMA(1, 1, At, B1); PG8_BAR; PG8_SCHED;
            PG8_LDB(B0, 1, 0); PG8_LDB(B1, 1, 1); PG8_SCHED; PG8_LDA(At, 1, 0); PG8_STAGE(PG8_SA(0, 1), a2 + hstep, voffA);
            PG8_WAIT_V(8); PG8_WAIT_L(0); PG8_BAR; PG8_MMA(0, 0, At, B0); PG8_MMA(0, 1, At, B1); PG8_BAR; PG8_SCHED;
            PG8_LDA(At, 1, 1); PG8_STAGE(PG8_SB(1, 0), b3, voffB); PG8_STAGE(PG8_SB(1, 1), b3 + hstep, voffB); PG8_STAGE(PG8_SA(1, 0), a3, voffA);
            PG8_WAIT_V(8); PG8_WAIT_L(0); PG8_BAR; PG8_MMA(1, 0, At, B0); PG8_MMA(1, 1, At, B1); PG8_BAR; PG8_SCHED;
            } else {
            PG8_LDB(B0, 0, 0); PG8_SCHED; PG8_LDA(At, 0, 0); PG8_STAGE(PG8_SA(1, 1), a1 + hstep, voffA);
            PG8_WAIT_L(8); PG8_BAR; PG8_WAIT_L(0); PG8_MMA(0, 0, At, B0); PG8_BAR; PG8_SCHED;
            PG8_LDB(B1, 0, 1); PG8_STAGE(PG8_SB(0, 0), b2, voffB);
            PG8_BAR; PG8_WAIT_L(0); PG8_MMA(0, 1, At, B1); PG8_BAR;
            PG8_LDA(At, 0, 1); PG8_STAGE(PG8_SA(0, 0), a2, voffA);
            PG8_BAR; PG8_WAIT_L(0); PG8_MMA(1, 0, At, B0); PG8_BAR; PG8_SCHED;
            PG8_STAGE(PG8_SB(0, 1), b2 + hstep, voffB);
            PG8_WAIT_V(6); PG8_BAR; PG8_MMA(1, 1, At, B1); PG8_BAR;
            PG8_LDB(B0, 1, 0); PG8_SCHED; PG8_LDA(At, 1, 0); PG8_STAGE(PG8_SA(0, 1), a2 + hstep, voffA);
            PG8_WAIT_L(8); PG8_BAR; PG8_WAIT_L(0); PG8_MMA(0, 0, At, B0); PG8_BAR; PG8_SCHED;
            PG8_LDB(B1, 1, 1); PG8_STAGE(PG8_SB(1, 0), b3, voffB);
            PG8_BAR; PG8_WAIT_L(0); PG8_MMA(0, 1, At, B1); PG8_BAR;
            PG8_LDA(At, 1, 1); PG8_STAGE(PG8_SA(1, 0), a3, voffA);
            PG8_BAR; PG8_WAIT_L(0); PG8_MMA(1, 0, At, B0); PG8_BAR; PG8_SCHED;
            PG8_STAGE(PG8_SB(1, 1), b3 + hstep, voffB);
            PG8_WAIT_V(6); PG8_BAR; PG8_MMA(1, 1, At, B1); PG8_BAR;
            }
        }
        if constexpr (ALIGN_EPI) { if (wr == 0) PG8_BAR; }
        if constexpr (!Epi::AFTER_DRAIN) { E(acc, cur, wr, wc, fr, fq); S.done(cur); }
        if (!has_next) break;
#pragma unroll
        for (int a = 0; a < 2; ++a)
#pragma unroll
            for (int b = 0; b < 2; ++b)
#pragma unroll
                for (int m = 0; m < 4; ++m)
#pragma unroll
                    for (int n = 0; n < 2; ++n) acc[a][b][m][n] = (f32x4){0.f, 0.f, 0.f, 0.f};
        cur = nxt; cA = nA; cB = nB; ++ui;
        if constexpr (ALIGN_EPI) { if (wr == 1) PG8_BAR; }
    }
    PG8_WAIT_V(0);
    if constexpr (!ALIGN_EPI) { if (wr == 0) PG8_BAR; }
    PG8_BAR;
    if constexpr (Epi::AFTER_DRAIN) { E.fused(acc, cur, wr, wc, fr, fq, lds, wid, lane); S.done(cur); }
#undef PG8_SA
#undef PG8_SB
#undef PG8_STAGE
#undef PG8_LDA
#undef PG8_LDB
#undef PG8_MMA
#undef PG8_WAIT_V
#undef PG8_WAIT_L
#undef PG8_BAR
#undef PG8_SCHED
}
}
constexpr int BATCH = 32, SEQ = 2048, DM = 1024, DEPTH = 4, M = BATCH * SEQ;
constexpr int FF = 4096, PLE = 256, NIN = 4112;
constexpr float EPS = 1e-6f;
constexpr int NWAVES = 8, NTHR = NWAVES * 64;
constexpr int PH_PER_LAYER = 13, NPHASE = 1 + DEPTH * PH_PER_LAYER;
constexpr size_t MiB = 1u << 20;
constexpr size_t WS_CTL = 0, CTL_ZERO_BYTES = 32768;
constexpr int NINP = 4352;
constexpr size_t WS_WIN = 1 * MiB, WS_WOUT = 18 * MiB, WS_WQKV = 22 * MiB, WS_WO = 28 * MiB, WS_WUP = 32 * MiB, WS_WDN = 64 * MiB, WS_WPLE = 96 * MiB, WS_WG = 98 * MiB;
constexpr size_t WS_WGATES = 105 * MiB, WS_GT = 106 * MiB, WS_ROPE = 110 * MiB;
constexpr size_t WS_PS0 = 128 * MiB;
constexpr size_t WS_DEN = 126 * MiB, WS_RS0 = 127 * MiB, WS_RS2 = 127 * MiB + 512 * 1024;
constexpr size_t WS_RA = 128 * MiB, WS_RB = 256 * MiB, WS_RC = 384 * MiB, WS_RD = 896 * MiB, WS_END = 1024 * MiB;
constexpr size_t WS_QKVA = 128 * MiB, WS_KWT = 320 * MiB, WS_X1 = 384 * MiB, WS_KT = 384 * MiB, WS_UT = 448 * MiB, WS_NW = 512 * MiB, WS_X2 = 576 * MiB, WS_VT = 896 * MiB, WS_ATT = 960 * MiB, WS_PT = 992 * MiB, WS_MIXED = 384 * MiB;
constexpr int CW_BAR = 4096;
constexpr int RING_BYTES = 131072, MISC_OFF = RING_BYTES, LDS_BYTES = RING_BYTES + 1024;

#define GAS __attribute__((address_space(1)))
#define LAS __attribute__((address_space(3)))
typedef unsigned short bf16;
typedef float f32x4 __attribute__((ext_vector_type(4)));
typedef float f32x2 __attribute__((ext_vector_type(2)));
typedef unsigned u32x4 __attribute__((ext_vector_type(4)));
typedef unsigned u32x2 __attribute__((ext_vector_type(2)));
#define LDS_WAIT() asm volatile("s_waitcnt lgkmcnt(0)" ::: "memory")
#define VM_WAIT() asm volatile("s_waitcnt vmcnt(0)" ::: "memory")
using pg8::bf_lo; using pg8::bf_hi;
typedef __bf16 bf16x2_t __attribute__((ext_vector_type(2)));
__device__ __forceinline__ unsigned pk2(float lo, float hi) { return pg8::cvt_pk_bf16(lo, hi); }
__device__ __forceinline__ unsigned pk2v(float lo, float hi) { const f32x2 v = {lo, hi}; const bf16x2_t b = __builtin_convertvector(v, bf16x2_t); return __builtin_bit_cast(unsigned, b); }
__device__ __forceinline__ float wave_sum(float v) {
#pragma unroll
    for (int o = 1; o < 64; o <<= 1) v += __shfl_xor(v, o);
    return v;
}
__device__ __forceinline__ float dot4(f32x4 a, f32x4 b) { return (a.x * b.x + a.y * b.y) + (a.z * b.z + a.w * b.w); }
__device__ __forceinline__ float sigmoid_f(float x) { return 1.f / (1.f + __expf(-x)); }
__device__ __forceinline__ float softplus_f(float x) { return x > 20.f ? x : log1pf(expf(x)); }

#define XB_TMO      128
#define XB_XCNT(j)  (256  + 64 * (j))
#define XB_XSUB(j)  (1280 + 64 * (j))
#define XB_XGEN(j)  (2304 + 64 * (j))
#define XB_TOP      3328
#define XB_TOPGEN   3392
#define XCD_BAR_WORDS 3456
#define XB_SPIN_CAP (1u << 18)

__device__ __forceinline__ unsigned xb_ld(unsigned* p)              { return __hip_atomic_load(p, __ATOMIC_RELAXED, __HIP_MEMORY_SCOPE_AGENT); }
__device__ __forceinline__ unsigned xb_add(unsigned* p, unsigned v) { return __hip_atomic_fetch_add(p, v, __ATOMIC_RELAXED, __HIP_MEMORY_SCOPE_AGENT); }
__device__ __forceinline__ unsigned xb_xcc_id() { return (unsigned)__builtin_amdgcn_s_getreg((3 << 11) | 20) & 0xFu; }
#define XB_SPIN(cond, bar) do { unsigned _sp = 0; while (cond) { __builtin_amdgcn_s_sleep(1); \
    if ((++_sp & 255u) == 0u) { if (xb_ld(&(bar)[XB_TMO])) break; if (_sp > XB_SPIN_CAP) { atomicAdd(&(bar)[XB_TMO], 1u); break; } } } } while (0)

struct XcdBarrier {
    unsigned* bar; unsigned x;
    volatile LAS unsigned* st;
};

__device__ __forceinline__ XcdBarrier xcd_barrier_post(unsigned* bar, volatile LAS unsigned* st) {
    XcdBarrier b; b.bar = bar; b.x = xb_xcc_id(); b.st = st;
    if (threadIdx.x == 0) (void)xb_add(&bar[XB_XCNT(b.x)], 1u);
    return b;
}
__device__ __forceinline__ void xcd_barrier_complete(unsigned* bar, unsigned x, unsigned& nloc, unsigned& nx) {
    const unsigned G = gridDim.x * gridDim.y * gridDim.z;
    unsigned sum, cnt, mine, sp = 0u;
    for (;;) {
        sum = 0u; cnt = 0u; mine = 0u;
#pragma unroll
        for (unsigned j = 0; j < 16; ++j) { const unsigned c = xb_ld(&bar[XB_XCNT(j)]); sum += c; cnt += (c > 0u) ? 1u : 0u; mine = (j == x) ? c : mine; }
        if (sum == G) break;
        __builtin_amdgcn_s_sleep(1);
        if ((++sp & 255u) == 0u) { if (xb_ld(&bar[XB_TMO])) break; if (sp > XB_SPIN_CAP) { atomicAdd(&bar[XB_TMO], 1u); break; } }
    }
    nloc = mine > 0u ? mine : 1u; nx = cnt > 0u ? cnt : 1u;
}

__device__ __forceinline__ void xcd_barrier(const XcdBarrier& b) {
    asm volatile("s_waitcnt vmcnt(0)" ::: "memory");
    __syncthreads();
    if (threadIdx.x == 0) {
        unsigned* bar = b.bar;
        __builtin_amdgcn_s_waitcnt(0);
        unsigned nloc = b.st[0], nx = b.st[1];
        if (nloc == 0u) { xcd_barrier_complete(bar, b.x, nloc, nx); b.st[0] = nloc; b.st[1] = nx; }
        const unsigned old = xb_add(&bar[XB_XSUB(b.x)], 1u);
        const unsigned gen = old / nloc;
        if (old + 1u == (gen + 1u) * nloc) {
            __builtin_amdgcn_fence(__ATOMIC_RELEASE, "agent");
            asm volatile("s_waitcnt vmcnt(0)" ::: "memory");
            const unsigned og = xb_add(&bar[XB_TOP], 1u);
            const unsigned tg = og / nx;
            if (og + 1u == (tg + 1u) * nx) xb_add(&bar[XB_TOPGEN], 1u);
            else XB_SPIN(xb_ld(&bar[XB_TOPGEN]) == tg, bar);
            __builtin_amdgcn_fence(__ATOMIC_ACQUIRE, "agent");
            xb_add(&bar[XB_XGEN(b.x)], 1u);
            asm volatile("s_waitcnt vmcnt(0)" ::: "memory");
        } else {
            XB_SPIN(xb_ld(&bar[XB_XGEN(b.x)]) == gen, bar);
            __builtin_amdgcn_fence(__ATOMIC_ACQUIRE, "agent");
            asm volatile("s_waitcnt vmcnt(0)" ::: "memory");
        }
    }
    __syncthreads();
}
struct Args {
    const float *x, *p; const int* pos; const float *gains, *w_in, *conv, *a_log, *dt_bias, *norm_a, *i_bias, *f_bias, *norm_b, *w_out, *w_qkv, *b_qkv, *sinks, *w_o, *b_o, *w_up, *w_down, *w_ple, *w_gate;
    float* out; unsigned char* ws;
    int ph_lo, ph_hi, dup_mask, dup_par;
};

template <bool ROPE_PERM = false> __device__ __forceinline__ void transpose_item(const float* src, int ld, int K, bf16* dst, LAS float* scr, int item, int nblk, int lane, const float* kscale = nullptr) {
    const int kb = item / nblk, nb = item % nblk, k0 = 64 * kb, n0 = 32 * nb;
#pragma unroll 8
    for (int i = 0; i < 32; ++i) { const int kk = 2 * i + (lane >> 5); scr[kk * 33 + (lane & 31)] = src[(size_t)(k0 + kk) * ld + n0 + (lane & 31)] * (kscale ? kscale[k0 + kk] : 1.f); }
    LDS_WAIT(); asm volatile("" ::: "memory");
    const int c = lane & 7;
#pragma unroll
    for (int j = 0; j < 4; ++j) { const int n = (lane >> 3) + 8 * j; const LAS float* s = scr + (8 * c) * 33 + n;
        u32x4 o; o.x = pk2(s[0 * 33], s[1 * 33]); o.y = pk2(s[2 * 33], s[3 * 33]); o.z = pk2(s[4 * 33], s[5 * 33]); o.w = pk2(s[6 * 33], s[7 * 33]);
        int nd = n0 + n;
        if (ROPE_PERM && nd < 1280) { const int i = nd & 63; nd = (nd & ~63) + (i < 32 ? 8 * (i >> 2) + (i & 3) : 8 * ((i - 32) >> 2) + 4 + (i & 3)); }
        *(u32x4*)(dst + (size_t)nd * K + k0 + 8 * c) = o; }
    LDS_WAIT(); asm volatile("" ::: "memory");
}
__device__ __forceinline__ int gate_col(int c) { return c < 8 ? 1536 + c : 3592 + (c - 8); }

typedef const __attribute__((address_space(4))) Args* KArgs;
__device__ __forceinline__ KArgs kargs() { KArgs p = (KArgs)__builtin_amdgcn_kernarg_segment_ptr(); asm volatile("" : "+s"(p)); return p; }
__device__ __forceinline__ int fresh_tid() { int t = threadIdx.x; asm volatile("" : "+v"(t)); return t; }
__device__ __forceinline__ void prologue_phase(KArgs a, LAS unsigned char* lds, int gw, int NGW, int wave, int lane, int gtid, int NGT) {
    LAS float* scr = (LAS float*)(lds + wave * 16384);
    constexpr int I_IN = 16 * 16, I_SQ = 16 * 32, I_QKV = 16 * 48, I_UP = 16 * 128, I_DN = 64 * 32, I_PLE = 4 * 32;
    constexpr int NITEMS = 16 * I_IN + 2 * I_SQ + 2 * I_QKV + 2 * I_SQ + 4 * I_UP + 4 * I_DN + 4 * I_PLE + 4 * I_SQ;
    unsigned char* ws = a->ws;
    for (int it = gw; it < NITEMS; it += NGW) {
        int r = it;
        if (r < 16 * I_IN) { const int j = r / I_IN, e = j >> 3, s = j & 7, col0 = 512 * s + (s >= 3 ? 8 : 0) + (s >= 7 ? 8 : 0);
            transpose_item(a->w_in + (size_t)e * DM * NIN + col0, NIN, DM, (bf16*)(ws + WS_WIN) + ((size_t)e * NINP + s * 512) * DM, scr, r % I_IN, 16, lane, a->gains + (size_t)(2 * e) * 4 * DM); continue; } r -= 16 * I_IN;
        if (r < 2 * I_SQ) { const int e = r / I_SQ; transpose_item(a->w_out + (size_t)e * DM * DM, DM, DM, (bf16*)(ws + WS_WOUT) + (size_t)e * DM * DM, scr, r % I_SQ, 32, lane); continue; } r -= 2 * I_SQ;
        if (r < 2 * I_QKV) { const int e = r / I_QKV; transpose_item<true>(a->w_qkv + (size_t)e * DM * 1536, 1536, DM, (bf16*)(ws + WS_WQKV) + (size_t)e * 1536 * DM, scr, r % I_QKV, 48, lane, a->gains + (size_t)(2 * e + 1) * 4 * DM); continue; } r -= 2 * I_QKV;
        if (r < 2 * I_SQ) { const int e = r / I_SQ; transpose_item(a->w_o + (size_t)e * DM * DM, DM, DM, (bf16*)(ws + WS_WO) + (size_t)e * DM * DM, scr, r % I_SQ, 32, lane); continue; } r -= 2 * I_SQ;
        if (r < 4 * I_UP) { const int l = r / I_UP; transpose_item(a->w_up + (size_t)l * DM * FF, FF, DM, (bf16*)(ws + WS_WUP) + (size_t)l * FF * DM, scr, r % I_UP, 128, lane, a->gains + ((size_t)l * 4 + 2) * DM); continue; } r -= 4 * I_UP;
        if (r < 4 * I_DN) { const int l = r / I_DN; transpose_item(a->w_down + (size_t)l * FF * DM, DM, FF, (bf16*)(ws + WS_WDN) + (size_t)l * DM * FF, scr, r % I_DN, 32, lane); continue; } r -= 4 * I_DN;
        if (r < 4 * I_PLE) { const int l = r / I_PLE; transpose_item(a->w_ple + (size_t)l * PLE * DM, DM, PLE, (bf16*)(ws + WS_WPLE) + (size_t)l * DM * PLE, scr, r % I_PLE, 32, lane); continue; } r -= 4 * I_PLE;
        { const int l = r / I_SQ; transpose_item(a->w_gate + (size_t)l * DM * DM, DM, DM, (bf16*)(ws + WS_WG) + (size_t)l * DM * DM, scr, r % I_SQ, 32, lane); }
    }
    for (int i = gtid; i < 2 * 256 * 1024; i += NGT) { const int e = i >> 18, c = (i >> 10) & 255, k = i & 1023;
        const float v = c < 16 ? a->w_in[((size_t)e * 1024 + k) * NIN + gate_col(c)] * a->gains[(size_t)(2 * e) * 4 * DM + k] : 0.f;
        ((bf16*)(ws + WS_WIN))[((size_t)e * NINP + 4096 + c) * DM + k] = (bf16)(pk2(v, 0.f) & 0xffffu); }
    f32x2* rope = (f32x2*)(a->ws + WS_ROPE);
    for (int i = gtid; i < M * 32; i += NGT) { const int m = i >> 5, d = i & 31;
        const float inv = (float)pow(10000.0, -(double)d / 32.0); const float ang = (float)a->pos[m] * inv; float sn, cs; sincosf(ang, &sn, &cs); rope[i] = (f32x2){cs, sn}; }
}

__device__ __forceinline__ void norm_phase(const float* hin, bf16* HN, float* RS, int gw, int NGW, int lane) {
    for (int m = gw; m < M; m += NGW) {
        const f32x4* xr = (const f32x4*)(hin + (size_t)m * DM) + lane;
        f32x4 v[4]; float s = 0.f;
#pragma unroll
        for (int j = 0; j < 4; ++j) { v[j] = xr[64 * j]; s += dot4(v[j], v[j]); }
        u32x2* o8 = (u32x2*)(HN + (size_t)m * DM) + lane;
#pragma unroll
        for (int j = 0; j < 4; ++j) o8[64 * j] = (u32x2){pk2(v[j].x, v[j].y), pk2(v[j].z, v[j].w)};
        const float tot = wave_sum(s);
        if (lane < 16) RS[(size_t)m * 16 + lane] = lane == 0 ? tot : 0.f;
    }
}
struct Row16 { f32x4 v[4]; };
__device__ __forceinline__ Row16 ld_row_bf16(const bf16* row, int lane) { const u32x4 a = ((const u32x4*)row)[lane], b = ((const u32x4*)row)[lane + 64]; Row16 r;
    r.v[0] = (f32x4){bf_lo(a.x), bf_hi(a.x), bf_lo(a.y), bf_hi(a.y)}; r.v[1] = (f32x4){bf_lo(a.z), bf_hi(a.z), bf_lo(a.w), bf_hi(a.w)};
    r.v[2] = (f32x4){bf_lo(b.x), bf_hi(b.x), bf_lo(b.y), bf_hi(b.y)}; r.v[3] = (f32x4){bf_lo(b.z), bf_hi(b.z), bf_lo(b.w), bf_hi(b.w)}; return r; }
__device__ __forceinline__ Row16 ld_row_f32(const float* row, int lane) { const f32x4* p = (const f32x4*)row; Row16 r; r.v[0] = p[2 * lane]; r.v[1] = p[2 * lane + 1]; r.v[2] = p[128 + 2 * lane]; r.v[3] = p[128 + 2 * lane + 1]; return r; }
__device__ __forceinline__ void st_row_bf16(bf16* row, int lane, const Row16& r) {
    ((u32x4*)row)[lane] = (u32x4){pk2(r.v[0].x, r.v[0].y), pk2(r.v[0].z, r.v[0].w), pk2(r.v[1].x, r.v[1].y), pk2(r.v[1].z, r.v[1].w)};
    ((u32x4*)row)[lane + 64] = (u32x4){pk2(r.v[2].x, r.v[2].y), pk2(r.v[2].z, r.v[2].w), pk2(r.v[3].x, r.v[3].y), pk2(r.v[3].z, r.v[3].w)}; }
__device__ __forceinline__ void st_row_f32(float* row, int lane, const Row16& r) { f32x4* p = (f32x4*)row; p[2 * lane] = r.v[0]; p[2 * lane + 1] = r.v[1]; p[128 + 2 * lane] = r.v[2]; p[128 + 2 * lane + 1] = r.v[3]; }
__device__ __forceinline__ float row_sumsq(const Row16& r) { return (dot4(r.v[0], r.v[0]) + dot4(r.v[1], r.v[1])) + (dot4(r.v[2], r.v[2]) + dot4(r.v[3], r.v[3])); }
__device__ __forceinline__ void resid_a_phase(const bf16* mix, const float* hin32, bf16* hs, const float* g1, float* RS, int gw, int NGW, int lane) {
    const Row16 ga = ld_row_f32(g1, lane);
    for (int m = gw; m < M; m += NGW) {
        const Row16 v = ld_row_bf16(mix + (size_t)m * DM, lane); Row16 h = hin32 ? ld_row_f32(hin32 + (size_t)m * DM, lane) : ld_row_bf16(hs + (size_t)m * DM, lane);
        const float r1 = rsqrtf(wave_sum(row_sumsq(v)) * (1.f / DM) + EPS);
#pragma unroll
        for (int j = 0; j < 4; ++j) h.v[j] = h.v[j] + v.v[j] * r1 * ga.v[j];
        st_row_bf16(hs + (size_t)m * DM, lane, h);
        const float r2 = rsqrtf(wave_sum(row_sumsq(h)) * (1.f / DM) + EPS);
        if (lane == 0) RS[m] = r2;
    }
}
__device__ __forceinline__ void resid_b_phase(const bf16* ff, const bf16* hs, const float* g3, bf16* HB, const float* pl, bf16* PB, int gw, int NGW, int lane, int gtid, int NGT) {
    const Row16 ga = ld_row_f32(g3, lane);
    for (int m = gw; m < M; m += NGW) {
        const Row16 v = ld_row_bf16(ff + (size_t)m * DM, lane); Row16 h = ld_row_bf16(hs + (size_t)m * DM, lane);
        const float r1 = rsqrtf(wave_sum(row_sumsq(v)) * (1.f / DM) + EPS);
#pragma unroll
        for (int j = 0; j < 4; ++j) h.v[j] = h.v[j] + v.v[j] * r1 * ga.v[j];
        st_row_bf16(HB + (size_t)m * DM, lane, h);
    }
    for (int i = gtid; i < M * PLE / 8; i += NGT) { const f32x4 a = ((const f32x4*)pl)[2 * i], b = ((const f32x4*)pl)[2 * i + 1];
        ((u32x4*)PB)[i] = (u32x4){pk2(a.x, a.y), pk2(a.z, a.w), pk2(b.x, b.y), pk2(b.z, b.w)}; }
}
__device__ __forceinline__ void resid_c_phase(const bf16* gpre, const bf16* pp, const bf16* h2, bf16* hs, float* out32, bool has_next, float* RS, int gw, int NGW, int lane) {
    for (int m = gw; m < M; m += NGW) {
        const Row16 g = ld_row_bf16(gpre + (size_t)m * DM, lane), p = ld_row_bf16(pp + (size_t)m * DM, lane); Row16 h = ld_row_bf16(h2 + (size_t)m * DM, lane);
#pragma unroll
        for (int j = 0; j < 4; ++j)
#pragma unroll
            for (int i = 0; i < 4; ++i) h.v[j][i] += p.v[j][i] * sigmoid_f(g.v[j][i]);
        if (has_next) {
            st_row_bf16(hs + (size_t)m * DM, lane, h);
            const float rstd = rsqrtf(wave_sum(row_sumsq(h)) * (1.f / DM) + EPS);
            if (lane == 0) RS[m] = rstd;
        } else st_row_f32(out32 + (size_t)m * DM, lane, h);
    }
}
__device__ __forceinline__ void conv_phase(const bf16* X1, const float* convw  , bf16* QKVA, int gw, int NGW, int lane) {
    constexpr int RPW = 32;
    for (int blk = gw; blk < M / RPW; blk += NGW) {
        const int mb = blk * RPW;
#pragma unroll 1
        for (int j = 0; j < 3; ++j) {
            const int col = j * 512 + lane * 8;
            u32x4 h0, h1, h2;
            { const bool first = (mb & (SEQ - 1)) == 0; const u32x4 z = {0u, 0u, 0u, 0u};
              h0 = first ? z : *(const u32x4*)(X1 + (size_t)(mb - 3) * 1536 + col); h1 = first ? z : *(const u32x4*)(X1 + (size_t)(mb - 2) * 1536 + col); h2 = first ? z : *(const u32x4*)(X1 + (size_t)(mb - 1) * 1536 + col); }
            f32x4 w[4][2];
#pragma unroll
            for (int kk = 0; kk < 4; ++kk) { w[kk][0] = *(const f32x4*)(convw + kk * 1536 + col); w[kk][1] = *(const f32x4*)(convw + kk * 1536 + col + 4); }
#pragma unroll 1
            for (int r4 = 0; r4 < RPW; r4 += 4) {
                u32x4 cur[4];
#pragma unroll
                for (int rr = 0; rr < 4; ++rr) cur[rr] = *(const u32x4*)(X1 + (size_t)(mb + r4 + rr) * 1536 + col);
#pragma unroll
                for (int rr = 0; rr < 4; ++rr) {
                    const int m = mb + r4 + rr;
                    const u32x4 xs[4] = {rr == 0 ? h0 : (rr == 1 ? h1 : (rr == 2 ? h2 : cur[0])), rr == 0 ? h1 : (rr == 1 ? h2 : cur[rr - 2 < 0 ? 0 : rr - 2]), rr == 0 ? h2 : cur[rr - 1 < 0 ? 0 : rr - 1], cur[rr]};
                    float acc[8];
#pragma unroll
                    for (int i = 0; i < 8; ++i) acc[i] = 0.f;
#pragma unroll
                    for (int kk = 0; kk < 4; ++kk) { const u32x4 xv = xs[kk]; const f32x4 w0 = w[kk][0], w1 = w[kk][1];
                        acc[0] += bf_lo(xv.x) * w0.x; acc[1] += bf_hi(xv.x) * w0.y; acc[2] += bf_lo(xv.y) * w0.z; acc[3] += bf_hi(xv.y) * w0.w;
                        acc[4] += bf_lo(xv.z) * w1.x; acc[5] += bf_hi(xv.z) * w1.y; acc[6] += bf_lo(xv.w) * w1.z; acc[7] += bf_hi(xv.w) * w1.w; }
                    float ss = 0.f;
#pragma unroll
                    for (int i = 0; i < 8; ++i) { acc[i] = acc[i] / (1.f + __expf(-acc[i])); ss += acc[i] * acc[i]; }
                    if (j < 2) { ss += __shfl_xor(ss, 1); ss += __shfl_xor(ss, 2); ss += __shfl_xor(ss, 4); ss += __shfl_xor(ss, 8);
                        const float sc = rsqrtf(ss + EPS) * (j == 0 ? 0.08838834764831845f : 1.f);
#pragma unroll
                        for (int i = 0; i < 8; ++i) acc[i] *= sc; }
                    *(u32x4*)(QKVA + (size_t)m * 1536 + col) = (u32x4){pk2(acc[0], acc[1]), pk2(acc[2], acc[3]), pk2(acc[4], acc[5]), pk2(acc[6], acc[7])};
                }
                h0 = cur[1]; h1 = cur[2]; h2 = cur[3];
            }
        }
    }
}
__device__ __forceinline__ void rope_phase(bf16* QKV, const f32x2* rope, int gw, int NGW, int lane) {
#pragma unroll 2
    for (int m = gw; m < M; m += NGW) {
        const int grp = lane & 7; const f32x4* tb = (const f32x4*)(rope + (size_t)m * 32 + grp * 4); const f32x4 t0 = tb[0], t1 = tb[1];
        const float cs[4] = {t0.x, t0.z, t1.x, t1.z}, sn[4] = {t0.y, t0.w, t1.y, t1.w};
#pragma unroll
        for (int k = 0; k < 3; ++k) {
            if (k == 2 && lane >= 32) break;
            const int hh = (k < 2) ? ((lane + 64 * k) >> 3) : (lane >> 3); const float scale = (k < 2) ? 0.125f : 1.f;
            bf16* base = QKV + (size_t)m * 1536 + (k < 2 ? 0 : 1024) + hh * 64 + grp * 4;
            const u32x2 a = *(const u32x2*)base, b = *(const u32x2*)(base + 32);
            const float x1[4] = {bf_lo(a.x), bf_hi(a.x), bf_lo(a.y), bf_hi(a.y)}, x2[4] = {bf_lo(b.x), bf_hi(b.x), bf_lo(b.y), bf_hi(b.y)};
            float o1[4], o2[4];
#pragma unroll
            for (int i = 0; i < 4; ++i) { o1[i] = (x1[i] * cs[i] - x2[i] * sn[i]) * scale; o2[i] = (x2[i] * cs[i] + x1[i] * sn[i]) * scale; }
            *(u32x2*)base = (u32x2){pk2(o1[0], o1[1]), pk2(o1[2], o1[3])}; *(u32x2*)(base + 32) = (u32x2){pk2(o2[0], o2[1]), pk2(o2[2], o2[3])};
        }
    }
}
typedef short bf16x8 __attribute__((ext_vector_type(8)));
#define MFMA16(a, b, c) __builtin_amdgcn_mfma_f32_16x16x32_bf16(a, b, c, 0, 0, 0)
__device__ __forceinline__ bf16x8 pack8(f32x4 a, f32x4 b) { const u32x4 w = {pk2v(a.x, a.y), pk2v(a.z, a.w), pk2v(b.x, b.y), pk2v(b.z, b.w)}; return __builtin_bit_cast(bf16x8, w); }
__device__ __forceinline__ float bf2f(unsigned short v) { return __builtin_bit_cast(float, (unsigned)v << 16); }
__device__ __forceinline__ float rdlane(float v, int i) { return __builtin_bit_cast(float, __builtin_amdgcn_readlane(__builtin_bit_cast(int, v), i)); }
__device__ __forceinline__ float scan_add(float v, int lane) {
#pragma unroll
    for (int o = 1; o < 64; o <<= 1) { const float t = __shfl_up(v, o); if (lane >= o) v += t; }
    return v; }
__device__ __forceinline__ float scan_max(float v, int lane) {
#pragma unroll
    for (int o = 1; o < 64; o <<= 1) { const float t = __shfl_up(v, o); if (lane >= o) v = fmaxf(v, t); }
    return v; }
__device__ __forceinline__ int kperm(int ks, int q, int jj) { return 32 * ks + (jj < 4 ? 4 * q + jj : 16 + 4 * q + jj - 4); }
template <bool SCALE> __device__ __forceinline__ u32x4 tr_gather(const bf16* src  , int ld, int ks, int q, float esc_lane) {
    unsigned w[4];
#pragma unroll
    for (int j2 = 0; j2 < 4; ++j2) { const int r0 = kperm(ks, q, 2 * j2), r1 = r0 + 1; const unsigned short a = src[(size_t)r0 * ld], b = src[(size_t)r1 * ld];
        if (SCALE) { const float s0 = __shfl(esc_lane, r0), s1 = __shfl(esc_lane, r1); w[j2] = pk2(bf2f(a) * s0, bf2f(b) * s1); } else w[j2] = (unsigned)a | ((unsigned)b << 16); }
    return (u32x4){w[0], w[1], w[2], w[3]};
}
__device__ __forceinline__ u32x4 scale_frag(u32x4 raw, int ks, int q, float esc_lane) {
    unsigned w[4] = {raw.x, raw.y, raw.z, raw.w};
#pragma unroll
    for (int j2 = 0; j2 < 4; ++j2) { const int r0 = kperm(ks, q, 2 * j2); const float s0 = __shfl(esc_lane, r0), s1 = __shfl(esc_lane, r0 + 1); w[j2] = pk2(bf_lo(w[j2]) * s0, bf_hi(w[j2]) * s1); }
    return (u32x4){w[0], w[1], w[2], w[3]};
}
struct ScanBufs {
    bf16* QKVA;
    bf16* X2;
    float* Gt;
    bf16 *KT, *UT, *NW, *ATT;
    bf16 *KWT, *VT, *PT;
    float* DEN;
};
__device__ __forceinline__ void local_phase(LAS unsigned char* lds, const ScanBufs sb, const float* a_log, const float* dt_bias, const float* i_bias, const float* f_bias, int gw, int NGW, int wave, int lane) {
    LAS float* Lw = (LAS float*)(lds + wave * 16384);
    const int njobs = 2 * BATCH * 4 * (SEQ / 64), per = (njobs + NGW - 1) / NGW; const int lane_in = lane;
#pragma unroll 1
    for (int rj = 0; rj < per; ++rj) {
        const int job = gw * per + rj; if (job >= njobs) break;
        int lane = lane_in; asm volatile("" : "+v"(lane));
        const int x = lane & 15, q = lane >> 4;
        const int mixer = job & 1, cidx = job >> 1, c = cidx & 31, h = (cidx >> 5) & 3, b = cidx >> 7;
        const int m0 = b * SEQ + c * 64; const size_t cid = (size_t)cidx;
        float* gr = sb.Gt + (size_t)(m0 + lane) * 16;
        if (mixer == 0) {
            const float beta = 1.f / (1.f + expf(-gr[h])); const float g = -expf(a_log[h]) * softplus_f(gr[4 + h] + dt_bias[h]);
            const float gcum = scan_add(g, lane), eg = expf(gcum), glast = __shfl(gcum, 63);
            const bf16* kb = sb.QKVA + (size_t)m0 * 1536 + 512 + h * 128; const bf16* qb = sb.QKVA + (size_t)m0 * 1536 + h * 128; const bf16* vb = kb + 512;
            bf16x8 Kf[4][4], Qf[4][4];
#pragma unroll
            for (int t = 0; t < 4; ++t)
#pragma unroll
                for (int ks = 0; ks < 4; ++ks) { Kf[t][ks] = *(const bf16x8*)(kb + (size_t)(16 * t + x) * 1536 + 32 * ks + 8 * q); Qf[t][ks] = *(const bf16x8*)(qb + (size_t)(16 * t + x) * 1536 + 32 * ks + 8 * q); }
            float gj[4][4];
#pragma unroll
            for (int jt = 0; jt < 4; ++jt)
#pragma unroll
                for (int r = 0; r < 4; ++r) gj[jt][r] = __shfl(gcum, 16 * jt + 4 * q + r);
            bf16* attp = sb.ATT + cid * 4096;
#pragma unroll
            for (int it = 0; it < 4; ++it) {
                const float gi = __shfl(gcum, 16 * it + x), bi = __shfl(beta, 16 * it + x); f32x4 d2s[4];
#pragma unroll
                for (int jt = 0; jt < 4; ++jt) {
                    if (jt <= it) { f32x4 D1 = {0.f, 0.f, 0.f, 0.f}, D2 = D1;
#pragma unroll
                        for (int ks = 0; ks < 4; ++ks) { D1 = MFMA16(Kf[jt][ks], Kf[it][ks], D1); D2 = MFMA16(Kf[jt][ks], Qf[it][ks], D2); }
                        f32x4 lv;
#pragma unroll
                        for (int r = 0; r < 4; ++r) { const int j = 16 * jt + 4 * q + r, i = 16 * it + x; const float dec = __expf(fminf(gi - gj[jt][r], 0.f));
                            lv[r] = (j < i) ? bi * D1[r] * dec : 0.f; d2s[jt][r] = (j <= i) ? D2[r] * dec : 0.f; }
#pragma unroll
                        for (int r = 0; r < 4; ++r) Lw[(16 * jt + 4 * q + r) * 64 + 16 * it + x] = lv[r];
                    } else d2s[jt] = (f32x4){0.f, 0.f, 0.f, 0.f};
                }
#pragma unroll
                for (int kp = 0; kp < 2; ++kp) if (it >= 2 || kp == 0) *(bf16x8*)(attp + ((it * 2 + kp) * 64 + lane) * 8) = pack8(d2s[2 * kp], d2s[2 * kp + 1]);
            }
            { float* tab = (float*)(attp + 512); tab[lane] = eg; tab[64 + lane] = expf(glast - gcum); }
            bf16* ktp = sb.KT + cid * 8192;
            LDS_WAIT();
            float xv[64];
#pragma unroll
            for (int i = 0; i < 64; ++i) xv[i] = (i == lane) ? 1.f : 0.f;
#pragma unroll
            for (int j = 0; j < 63; ++j) {
#pragma unroll
                for (int g4 = (j + 1) / 4; g4 < 16; ++g4) { const f32x4 lc = *(const LAS f32x4*)(Lw + j * 64 + 4 * g4);
                    if (4 * g4 + 0 > j) xv[4 * g4 + 0] -= lc.x * xv[j]; if (4 * g4 + 1 > j) xv[4 * g4 + 1] -= lc.y * xv[j]; if (4 * g4 + 2 > j) xv[4 * g4 + 2] -= lc.z * xv[j]; if (4 * g4 + 3 > j) xv[4 * g4 + 3] -= lc.w * xv[j]; }
            }
            LDS_WAIT();
            { LAS unsigned short* TL = (LAS unsigned short*)Lw;
#pragma unroll
              for (int i = 0; i < 64; ++i) TL[i * 64 + ((((lane >> 3) ^ (i & 7)) << 3) | (lane & 7))] = (unsigned short)(pk2(xv[i], 0.f) & 0xffffu); }
            LDS_WAIT();
            bf16x8 Tf[4][2];
#pragma unroll
            for (int it = 0; it < 4; ++it)
#pragma unroll
                for (int ks = 0; ks < 2; ++ks) { const int row = 16 * it + x; const LAS unsigned char* tb = (const LAS unsigned char*)Lw + row * 128;
                    const int c0 = 32 * ks + 4 * q, c1 = c0 + 16;
                    const u32x2 lo = *(const LAS u32x2*)(tb + ((((c0 >> 3) ^ (row & 7)) << 4) | ((c0 & 7) << 1))), hi = *(const LAS u32x2*)(tb + ((((c1 >> 3) ^ (row & 7)) << 4) | ((c1 & 7) << 1)));
                    const u32x4 w = {lo.x, lo.y, hi.x, hi.y}; Tf[it][ks] = __builtin_bit_cast(bf16x8, w); }
            const float be = beta * eg;
            bf16* utp = sb.UT + cid * 8192;
#pragma unroll 4
            for (int et = 0; et < 8; ++et) {
                bf16x8 vfr[2];
#pragma unroll
                for (int ks = 0; ks < 2; ++ks) { const u32x4 gth = tr_gather<true>(vb + 16 * et + x, 1536, ks, q, beta); vfr[ks] = __builtin_bit_cast(bf16x8, gth); }
#pragma unroll
                for (int mt = 0; mt < 4; ++mt) { f32x4 acc = {0.f, 0.f, 0.f, 0.f};
#pragma unroll
                    for (int ks = 0; ks < 2; ++ks) acc = MFMA16(Tf[mt][ks], vfr[ks], acc);
                    *(u32x2*)(utp + (size_t)(16 * et + x) * 64 + 16 * mt + 4 * q) = (u32x2){pk2v(acc.x, acc.y), pk2v(acc.z, acc.w)}; }
            }
            bf16* nwp = sb.NW + cid * 8192;
#pragma unroll 2
            for (int kp2 = 0; kp2 < 4; ++kp2) {
                bf16x8 kfr[2][2];
#pragma unroll
                for (int dd = 0; dd < 2; ++dd)
#pragma unroll
                    for (int ks = 0; ks < 2; ++ks) { const int dt = 2 * kp2 + dd; const u32x4 raw = tr_gather<false>(kb + 16 * dt + x, 1536, ks, q, 0.f);
                        *(u32x4*)(ktp + ((dt * 2 + ks) * 64 + lane) * 8) = raw;
                        kfr[dd][ks] = __builtin_bit_cast(bf16x8, scale_frag(raw, ks, q, be)); }
#pragma unroll
                for (int it = 0; it < 4; ++it) { f32x4 a0 = {0.f, 0.f, 0.f, 0.f}, a1 = a0;
#pragma unroll
                    for (int ks = 0; ks < 2; ++ks) { a0 = MFMA16(kfr[0][ks], Tf[it][ks], a0); a1 = MFMA16(kfr[1][ks], Tf[it][ks], a1); }
                    a0 = a0 * -1.f; a1 = a1 * -1.f;
                    *(u32x4*)(nwp + ((it * 4 + kp2) * 64 + lane) * 8) = (u32x4){pk2v(a0.x, a0.y), pk2v(a0.z, a0.w), pk2v(a1.x, a1.y), pk2v(a1.z, a1.w)}; }
            }
            LDS_WAIT();
        } else {
            const float il = gr[8 + h] + i_bias[h]; const float fl = -softplus_f(-(gr[12 + h] + f_bias[h]));
            const float bcum = scan_add(fl, lane), t = il - bcum, pm = scan_max(t, lane), pml = __shfl(pm, 63);
            const float esc = __expf(t - pml);
            const bf16* qb = sb.X2 + (size_t)m0 * 2560 + 512 + h * 128; const bf16* kb = qb + 512; const bf16* vb = kb + 512;
            bf16x8 Kf[4][4], Qf[4][4];
#pragma unroll
            for (int tt = 0; tt < 4; ++tt)
#pragma unroll
                for (int ks = 0; ks < 4; ++ks) { Kf[tt][ks] = *(const bf16x8*)(kb + (size_t)(16 * tt + x) * 2560 + 32 * ks + 8 * q); Qf[tt][ks] = *(const bf16x8*)(qb + (size_t)(16 * tt + x) * 2560 + 32 * ks + 8 * q); }
            float tj[4][4];
#pragma unroll
            for (int jt = 0; jt < 4; ++jt)
#pragma unroll
                for (int r = 0; r < 4; ++r) tj[jt][r] = __shfl(t, 16 * jt + 4 * q + r);
            bf16* ptp = sb.PT + cid * 4096;
#pragma unroll
            for (int it = 0; it < 4; ++it) {
                const float pmi = __shfl(pm, 16 * it + x); f32x4 d2s[4];
#pragma unroll
                for (int jt = 0; jt < 4; ++jt) {
                    if (jt <= it) { f32x4 D2 = {0.f, 0.f, 0.f, 0.f};
#pragma unroll
                        for (int ks = 0; ks < 4; ++ks) D2 = MFMA16(Kf[jt][ks], Qf[it][ks], D2);
#pragma unroll
                        for (int r = 0; r < 4; ++r) { const int j = 16 * jt + 4 * q + r, i = 16 * it + x; d2s[jt][r] = (j <= i) ? D2[r] * 0.08838834764831845f * __expf(fminf(tj[jt][r] - pmi, 0.f)) : 0.f; }
                    } else d2s[jt] = (f32x4){0.f, 0.f, 0.f, 0.f};
                }
#pragma unroll
                for (int kp = 0; kp < 2; ++kp) if (it >= 2 || kp == 0) *(bf16x8*)(ptp + ((it * 2 + kp) * 64 + lane) * 8) = pack8(d2s[2 * kp], d2s[2 * kp + 1]);
            }
            { float* tab = (float*)(ptp + 512); tab[lane] = bcum; tab[64 + lane] = bcum + pm; }
            bf16* kwp = sb.KWT + cid * 8192; bf16* vtp = sb.VT + cid * 8192;
#pragma unroll 2
            for (int dt = 0; dt < 8; ++dt)
#pragma unroll
                for (int kp = 0; kp < 2; ++kp) { *(u32x4*)(kwp + ((dt * 2 + kp) * 64 + lane) * 8) = tr_gather<true>(kb + 16 * dt + x, 2560, kp, q, esc);
                    *(u32x4*)(vtp + ((dt * 2 + kp) * 64 + lane) * 8) = tr_gather<false>(vb + 16 * dt + x, 2560, kp, q, 0.f); }
        }
    }
}
constexpr int RC_NW = 0, RC_ATT = 16384, RC_KT = 24576, RC_QP = 40960, RC_BUF = 57344;
__device__ __forceinline__ void recur_stage(LAS unsigned char* buf, const bf16* f16a  , const bf16* f8  , const bf16* f16b  , const bf16* qbase  , int qpitch, int wave, int lane) {
#pragma unroll
    for (int k = 0; k < 5; ++k) { const int bl = wave + 8 * k;
        const bf16* src = bl < 16 ? f16a + bl * 512 : (bl < 24 ? f8 + (bl - 16) * 512 : f16b + (bl - 24) * 512);
        __builtin_amdgcn_global_load_lds((const unsigned*)(src + lane * 8), (LAS unsigned*)(buf + bl * 1024), 16, 0, 0); }
#pragma unroll
    for (int k = 0; k < 8; ++k) { const int P = (wave * 8 + k) * 256 + lane * 4, f = P >> 10, lp = (P & 1023) >> 4, jj0 = ((P & 15) >> 2) * 2, it = f >> 2, ks = f & 3, xp = lp & 15, qp = lp >> 4;
        const bf16* src = qbase + (size_t)(16 * it + xp) * qpitch + kperm(ks, qp, jj0);
        __builtin_amdgcn_global_load_lds((const unsigned*)src, (LAS unsigned*)(buf + RC_QP + (wave * 8 + k) * 256), 4, 0, 0); }
}
__device__ __forceinline__ void recur_phase(LAS unsigned char* lds, const ScanBufs sb, int G, int bid, int wave, int lane) {
    const int x = lane & 15, q = lane >> 4, et = wave;
#pragma unroll 1
    for (int u = bid; u < 2 * BATCH * 4; u += G) {
        const int mixer = u >> 7, b = (u & 127) >> 2, h = u & 3;
        const size_t cid0 = (size_t)((b * 4 + h) * 32);
        if (mixer == 0) {
            f32x4 S[8];
#pragma unroll
            for (int d = 0; d < 8; ++d) S[d] = (f32x4){0.f, 0.f, 0.f, 0.f};
            recur_stage(lds, sb.NW + cid0 * 8192, sb.ATT + cid0 * 4096, sb.KT + cid0 * 8192, sb.QKVA + (size_t)(b * SEQ) * 1536 + h * 128, 1536, wave, lane);
            __syncthreads();
#pragma unroll 1
            for (int c = 0; c < SEQ / 64; ++c) {
                const int m0 = b * SEQ + c * 64; const size_t cid = cid0 + c;
                const LAS unsigned char* buf = lds + (c & 1) * RC_BUF;
                { const int cn = c + 1 < SEQ / 64 ? c + 1 : c; const size_t cidn = cid0 + cn;
                  recur_stage(lds + ((c + 1) & 1) * RC_BUF, sb.NW + cidn * 8192, sb.ATT + cidn * 4096, sb.KT + cidn * 8192, sb.QKVA + (size_t)(b * SEQ + cn * 64) * 1536 + h * 128, 1536, wave, lane); }
                const bf16* utp = sb.UT + cid * 8192 + (size_t)(16 * et + x) * 64;
                const LAS float* tab = (const LAS float*)(buf + RC_ATT + 1024);
                bf16x8 Sb[4];
#pragma unroll
                for (int ks = 0; ks < 4; ++ks) Sb[ks] = pack8(S[2 * ks], S[2 * ks + 1]);
                f32x4 vn[4];
                { bf16x8 fr[16]; u32x2 uu[4];
#pragma unroll
                  for (int i = 0; i < 16; ++i) fr[i] = *(const LAS bf16x8*)(buf + RC_NW + (i * 64 + lane) * 16);
#pragma unroll
                  for (int mt = 0; mt < 4; ++mt) uu[mt] = *(const u32x2*)(utp + 16 * mt + 4 * q);
                  __builtin_amdgcn_sched_barrier(0);
#pragma unroll
                  for (int mt = 0; mt < 4; ++mt) { f32x4 acc = {bf_lo(uu[mt].x), bf_hi(uu[mt].x), bf_lo(uu[mt].y), bf_hi(uu[mt].y)};
#pragma unroll
                    for (int ks = 0; ks < 4; ++ks) acc = MFMA16(fr[mt * 4 + ks], Sb[ks], acc);
                    vn[mt] = acc; } }
                bf16x8 vb2[2] = {pack8(vn[0], vn[1]), pack8(vn[2], vn[3])};
                bf16x8 fq[16], fa[8]; float egl[4];
#pragma unroll
                for (int i = 0; i < 16; ++i) fq[i] = *(const LAS bf16x8*)(buf + RC_QP + (i * 64 + lane) * 16);
#pragma unroll
                for (int i = 0; i < 8; ++i) if (i >= 4 || (i & 1) == 0) fa[i] = *(const LAS bf16x8*)(buf + RC_ATT + (i * 64 + lane) * 16);
#pragma unroll
                for (int it = 0; it < 4; ++it) egl[it] = tab[16 * it + x];
                __builtin_amdgcn_sched_barrier(0);
#pragma unroll
                for (int it = 0; it < 4; ++it) { f32x4 acc = {0.f, 0.f, 0.f, 0.f};
#pragma unroll
                    for (int ks = 0; ks < 4; ++ks) acc = MFMA16(Sb[ks], fq[it * 4 + ks], acc);
                    acc = acc * egl[it];
#pragma unroll
                    for (int kp = 0; kp < 2; ++kp) if (it >= 2 || kp == 0) acc = MFMA16(vb2[kp], fa[it * 2 + kp], acc);
                    *(u32x2*)(sb.QKVA + (size_t)(m0 + 16 * it + x) * 1536 + 512 + h * 128 + 16 * et + 4 * q) = (u32x2){pk2v(acc.x, acc.y), pk2v(acc.z, acc.w)}; }
                f32x4 vs[4];
#pragma unroll
                for (int mt = 0; mt < 4; ++mt) { const f32x4 kk = *(const LAS f32x4*)(tab + 64 + 16 * mt + 4 * q); vs[mt] = vn[mt] * kk; }
                const bf16x8 vsb[2] = {pack8(vs[0], vs[1]), pack8(vs[2], vs[3])};
                const float gam = tab[63];
                { bf16x8 fk[16];
#pragma unroll
                  for (int i = 0; i < 16; ++i) fk[i] = *(const LAS bf16x8*)(buf + RC_KT + (i * 64 + lane) * 16);
                  __builtin_amdgcn_sched_barrier(0);
#pragma unroll
                  for (int dt = 0; dt < 8; ++dt) { f32x4 acc = S[dt] * gam;
#pragma unroll
                    for (int kp = 0; kp < 2; ++kp) acc = MFMA16(fk[dt * 2 + kp], vsb[kp], acc);
                    S[dt] = acc; } }
                __syncthreads();
            }
        } else {
            f32x4 Cs[8], Ce[8]; float mrun = 0.f;
#pragma unroll
            for (int d = 0; d < 8; ++d) { Cs[d] = (f32x4){0.f, 0.f, 0.f, 0.f}; Ce[d] = Cs[d]; }
            const short one = (x == 0) ? (short)0x3F80 : (short)0; const bf16x8 ones = {one, one, one, one, one, one, one, one};
            recur_stage(lds, sb.KWT + cid0 * 8192, sb.PT + cid0 * 4096, sb.KWT + cid0 * 8192, sb.X2 + (size_t)(b * SEQ) * 2560 + 512 + h * 128, 2560, wave, lane);
            __syncthreads();
#pragma unroll 1
            for (int c = 0; c < SEQ / 64; ++c) {
                const int m0 = b * SEQ + c * 64; const size_t cid = cid0 + c;
                const LAS unsigned char* buf = lds + (c & 1) * RC_BUF;
                { const int cn = c + 1 < SEQ / 64 ? c + 1 : c; const size_t cidn = cid0 + cn;
                  recur_stage(lds + ((c + 1) & 1) * RC_BUF, sb.KWT + cidn * 8192, sb.PT + cidn * 4096, sb.KWT + cidn * 8192, sb.X2 + (size_t)(b * SEQ + cn * 64) * 2560 + 512 + h * 128, 2560, wave, lane); }
                const bf16* vtp = sb.VT + cid * 8192;
                const LAS float* tab = (const LAS float*)(buf + RC_ATT + 1024);
                bf16x8 Cb[4], Eb[4];
#pragma unroll
                for (int ks = 0; ks < 4; ++ks) { Cb[ks] = pack8(Cs[2 * ks], Cs[2 * ks + 1]); Eb[ks] = pack8(Ce[2 * ks], Ce[2 * ks + 1]); }
                const bf16x8 vf[2] = {*(const bf16x8*)(vtp + ((et * 2 + 0) * 64 + lane) * 8), *(const bf16x8*)(vtp + ((et * 2 + 1) * 64 + lane) * 8)};
#pragma unroll
                for (int it = 0; it < 4; ++it) {
                    bf16x8 fq[16], fp[8];
#pragma unroll
                    for (int ks = 0; ks < 4; ++ks) fq[it * 4 + ks] = *(const LAS bf16x8*)(buf + RC_QP + ((it * 4 + ks) * 64 + lane) * 16);
#pragma unroll
                    for (int kp = 0; kp < 2; ++kp) if (it >= 2 || kp == 0) fp[it * 2 + kp] = *(const LAS bf16x8*)(buf + RC_ATT + ((it * 2 + kp) * 64 + lane) * 16);
                    const float bc = tab[16 * it + x], mi = tab[64 + 16 * it + x];
                    __builtin_amdgcn_sched_barrier(0);
                    const float a = bc + mrun, mt = fmaxf(a, mi), f1 = __expf(a - mt) * 0.08838834764831845f, f2 = __expf(mi - mt);
                    f32x4 a1 = {0.f, 0.f, 0.f, 0.f}, aP = a1, e1 = a1, eP = a1;
#pragma unroll
                    for (int ks = 0; ks < 4; ++ks) { const bf16x8 qf = fq[it * 4 + ks];
                        a1 = MFMA16(Cb[ks], qf, a1); if (wave == 0) e1 = MFMA16(Eb[ks], qf, e1); }
#pragma unroll
                    for (int kp = 0; kp < 2; ++kp) if (it >= 2 || kp == 0) { const bf16x8 pf = fp[it * 2 + kp]; aP = MFMA16(vf[kp], pf, aP); if (wave == 0) eP = MFMA16(ones, pf, eP); }
                    const f32x4 nm = a1 * f1 + aP * f2;
                    *(u32x2*)(sb.X2 + (size_t)(m0 + 16 * it + x) * 2560 + 1024 + h * 128 + 16 * et + 4 * q) = (u32x2){pk2(nm.x, nm.y), pk2(nm.z, nm.w)};
                    if (wave == 0 && q == 0) sb.DEN[(size_t)(m0 + 16 * it + x) * 4 + h] = fmaxf(fabsf(e1.x * f1 + eP.x * f2), __expf(-mt));
                }
                const float blast = tab[63], wsmax = tab[127];
                const float mnew = fmaxf(blast + mrun, wsmax), sc = __expf(blast + mrun - mnew), s2 = __expf(wsmax - mnew); mrun = mnew;
                bf16x8 fk[16];
#pragma unroll
                for (int i = 0; i < 16; ++i) fk[i] = *(const LAS bf16x8*)(buf + RC_KT + (i * 64 + lane) * 16);
                __builtin_amdgcn_sched_barrier(0);
#pragma unroll
                for (int dt = 0; dt < 8; ++dt) { f32x4 dC = {0.f, 0.f, 0.f, 0.f}, dE = dC;
#pragma unroll
                    for (int kp = 0; kp < 2; ++kp) { const bf16x8 kf = fk[dt * 2 + kp]; dC = MFMA16(kf, vf[kp], dC); if (wave == 0) dE = MFMA16(kf, ones, dE); }
                    Cs[dt] = Cs[dt] * sc + dC * s2; if (wave == 0) Ce[dt] = Ce[dt] * sc + dE * s2; }
                __syncthreads();
            }
        }
    }
}
__device__ __forceinline__ void post_phase(const ScanBufs sb, const float* norm_a, const float* norm_b, bf16* MIXED, int gw, int NGW, int lane) {
    const int hh = lane >> 3, sub = (lane & 7) * 16;
#pragma unroll 2
    for (int m = gw; m < M; m += NGW) {
        const bool isA = hh < 4; const int h = hh & 3;
        const bf16* src = isA ? sb.QKVA + (size_t)m * 1536 + 512 + h * 128 + sub : sb.X2 + (size_t)m * 2560 + 1024 + h * 128 + sub;
        const bf16* gsrc = sb.X2 + (size_t)m * 2560 + (isA ? 0 : 2048) + h * 128 + sub;
        const float* gn = (isA ? norm_a : norm_b + h * 128) + sub;
        const u32x4 r0 = *(const u32x4*)src, r1 = *(const u32x4*)(src + 8), z0 = *(const u32x4*)gsrc, z1 = *(const u32x4*)(gsrc + 8);
        float v[16] = {bf_lo(r0.x), bf_hi(r0.x), bf_lo(r0.y), bf_hi(r0.y), bf_lo(r0.z), bf_hi(r0.z), bf_lo(r0.w), bf_hi(r0.w), bf_lo(r1.x), bf_hi(r1.x), bf_lo(r1.y), bf_hi(r1.y), bf_lo(r1.z), bf_hi(r1.z), bf_lo(r1.w), bf_hi(r1.w)};
        const float z[16] = {bf_lo(z0.x), bf_hi(z0.x), bf_lo(z0.y), bf_hi(z0.y), bf_lo(z0.z), bf_hi(z0.z), bf_lo(z0.w), bf_hi(z0.w), bf_lo(z1.x), bf_hi(z1.x), bf_lo(z1.y), bf_hi(z1.y), bf_lo(z1.z), bf_hi(z1.z), bf_lo(z1.w), bf_hi(z1.w)};
        const float dinv = isA ? 1.f : 1.f / sb.DEN[(size_t)m * 4 + h];
        float ss = 0.f;
#pragma unroll
        for (int i = 0; i < 16; ++i) { v[i] *= dinv; ss += v[i] * v[i]; }
        ss += __shfl_xor(ss, 1); ss += __shfl_xor(ss, 2); ss += __shfl_xor(ss, 4);
        const float rstd = rsqrtf(ss * (1.f / 128.f) + EPS);
        float y[16];
#pragma unroll
        for (int i = 0; i < 16; ++i) { const float sg = sigmoid_f(z[i]); y[i] = v[i] * rstd * gn[i] * (isA ? z[i] * sg : sg); }
        u32x4* dst = (u32x4*)(MIXED + (size_t)m * 1024 + lane * 16);
        dst[0] = (u32x4){pk2(y[0], y[1]), pk2(y[2], y[3]), pk2(y[4], y[5]), pk2(y[6], y[7])}; dst[1] = (u32x4){pk2(y[8], y[9]), pk2(y[10], y[11]), pk2(y[12], y[13]), pk2(y[14], y[15])};
    }
}
typedef short v4i16_t __attribute__((ext_vector_type(4)));
constexpr int AT_VROW = 80;
constexpr int AT_K_BYTES = 256 * 128, AT_V_BYTES = 272 * AT_VROW * 2;
__device__ __forceinline__ void attn_phase(LAS unsigned char* lds, int tid, int wave, const bf16* QKV, const float* sinks, bf16* O, int G, int bid) {
    LAS unsigned char* KL = lds; LAS unsigned char* VL = lds + AT_K_BYTES;
    const int lane = tid & 63, x = lane & 15, q = lane >> 4, g = wave >> 1, qh = wave & 1;
    u32x4 kreg[4], vreg[4];
#define AT_LOAD_KV(uu) do { const int b_ = (uu) >> 6, kvh_ = ((uu) >> 4) & 3, jb_ = (uu) & 15; _Pragma("unroll") for (int i = 0; i < 4; ++i) { const int item = tid + 512 * i, r = item >> 3, ch = item & 7, sk = (jb_ - 1) * 128 + r; \
        kreg[i] = (u32x4){0u, 0u, 0u, 0u}; vreg[i] = kreg[i]; if (sk >= 0) { const bf16* src = QKV + (size_t)(b_ * SEQ + sk) * 1536 + 1024 + kvh_ * 64 + ch * 8; kreg[i] = *(const u32x4*)src; vreg[i] = *(const u32x4*)(src + 256); } } } while (0)
    if (bid < BATCH * 4 * 16) AT_LOAD_KV(bid);
#pragma unroll 1
    for (int u = bid; u < BATCH * 4 * 16; u += G) {
        const int b = u >> 6, kvh = (u >> 4) & 3, jb = u & 15;
#pragma unroll
        for (int i = 0; i < 4; ++i) { const int item = tid + 512 * i, r = item >> 3, ch = item & 7;
            *(LAS u32x4*)(KL + r * 128 + ((ch ^ (r & 7)) << 4)) = kreg[i]; *(LAS u32x4*)(VL + r * (AT_VROW * 2) + ch * 16) = vreg[i]; }
        if (tid < 128) { const int r = 256 + (tid >> 3), ch = tid & 7; unsigned z0 = 0u; asm volatile("" : "+v"(z0));
            *(LAS u32x4*)(VL + r * (AT_VROW * 2) + ch * 16) = (u32x4){z0, z0, z0, z0}; }
        __syncthreads();
        if (u + G < BATCH * 4 * 16) AT_LOAD_KV(u + G);
        const int hq = kvh * 4 + g; const float sink = sinks[hq];
        const size_t mq = (size_t)b * SEQ + jb * 128 + 64 * qh;
        bf16x8 Qn[2];
#pragma unroll
        for (int ks = 0; ks < 2; ++ks) Qn[ks] = *(const bf16x8*)(QKV + (mq + x) * 1536 + hq * 64 + 32 * ks + 8 * q);
#pragma unroll 1
        for (int nt = 0; nt < 4; ++nt) {
            const bf16x8 Qf[2] = {Qn[0], Qn[1]};
            { const int nn = nt < 3 ? nt + 1 : 3;
#pragma unroll
              for (int ks = 0; ks < 2; ++ks) Qn[ks] = *(const bf16x8*)(QKV + (mq + 16 * nn + x) * 1536 + hq * 64 + 32 * ks + 8 * q); }
            f32x4 s[9]; float mx = -3.0e38f;
            bf16x8 kf[9][2];
#pragma unroll
            for (int j = 0; j < 9; ++j) { const int r = 64 * qh + 16 * (nt + j) + x;
#pragma unroll
                for (int ks = 0; ks < 2; ++ks) kf[j][ks] = *(const LAS bf16x8*)(KL + r * 128 + (((4 * ks + q) ^ (r & 7)) << 4)); }
            __builtin_amdgcn_sched_barrier(0);
#pragma unroll
            for (int j = 0; j < 9; ++j) { const int kt = nt + j;
                f32x4 acc = {0.f, 0.f, 0.f, 0.f};
#pragma unroll
                for (int ks = 0; ks < 2; ++ks) acc = MFMA16(kf[j][ks], Qf[ks], acc);
#pragma unroll
                for (int rg = 0; rg < 4; ++rg) { const int diff = 16 * j + 4 * q + rg - x, ra = 64 * qh + 16 * kt + 4 * q + rg;
                    const bool valid = diff >= 1 && diff <= 128 && (jb - 1) * 128 + ra >= 0;
                    acc[rg] = valid ? acc[rg] : -3.0e38f; mx = fmaxf(mx, acc[rg]); }
                s[j] = acc; }
            mx = fmaxf(mx, __shfl_xor(mx, 16)); mx = fmaxf(mx, __shfl_xor(mx, 32)); mx = fmaxf(mx, sink);
            float sum = 0.f;
#pragma unroll
            for (int j = 0; j < 9; ++j)
#pragma unroll
                for (int rg = 0; rg < 4; ++rg) { const float p = (s[j][rg] > -1.0e38f) ? __expf(s[j][rg] - mx) : 0.f; s[j][rg] = p; sum += p; }
            sum += __shfl_xor(sum, 16); sum += __shfl_xor(sum, 32);
            const float inv = 1.f / (sum + __expf(sink - mx));
            bf16x8 Pf[5];
#pragma unroll
            for (int j2 = 0; j2 < 4; ++j2) Pf[j2] = pack8(s[2 * j2], s[2 * j2 + 1]);
            Pf[4] = pack8(s[8], (f32x4){0.f, 0.f, 0.f, 0.f});
            bf16x8 vf[4][5];
#pragma unroll
            for (int dt = 0; dt < 4; ++dt)
#pragma unroll
                for (int j2 = 0; j2 < 5; ++j2) { const int kb = 64 * qh + 16 * (nt + 2 * j2) + 4 * q + (x >> 2);
                    const LAS unsigned char* p0 = VL + kb * (AT_VROW * 2) + (16 * dt + 4 * (x & 3)) * 2;
                    const v4i16_t lo = __builtin_amdgcn_ds_read_tr16_b64_v4i16((LAS v4i16_t*)p0), hi = __builtin_amdgcn_ds_read_tr16_b64_v4i16((LAS v4i16_t*)(p0 + 16 * AT_VROW * 2));
                    vf[dt][j2] = (bf16x8){lo[0], lo[1], lo[2], lo[3], hi[0], hi[1], hi[2], hi[3]}; }
            __builtin_amdgcn_sched_barrier(0);
#pragma unroll
            for (int dt = 0; dt < 4; ++dt) { f32x4 acc = {0.f, 0.f, 0.f, 0.f};
#pragma unroll
                for (int j2 = 0; j2 < 5; ++j2) acc = MFMA16(vf[dt][j2], Pf[j2], acc);
                acc = acc * inv;
                *(u32x2*)(O + (mq + 16 * nt + x) * 1024 + hq * 64 + 16 * dt + 4 * q) = (u32x2){pk2v(acc.x, acc.y), pk2v(acc.z, acc.w)}; }
        }
        __syncthreads();
    }
}
#ifndef N_LAUNCH_MODE
#define N_LAUNCH_MODE 0
#endif
__global__ void __launch_bounds__(NTHR, 2) trunk_fwd(Args a_unused) {
    extern __shared__ __attribute__((aligned(16))) unsigned char lds_raw[];
    LAS unsigned char* lds = (LAS unsigned char*)lds_raw;
    volatile LAS unsigned* MISC = (volatile LAS unsigned*)(lds + MISC_OFF);
    if (threadIdx.x < 64) MISC[threadIdx.x] = 0u;
    __syncthreads();
    int lo, hi; XcdBarrier bar;
    int dupm = 0, dupp = 0; (void)dupm; (void)dupp;
    { KArgs a = kargs(); lo = a->ph_lo; hi = a->ph_hi; dupm = a->dup_mask; dupp = a->dup_par; unsigned* ctl = (unsigned*)(a->ws + WS_CTL);
      bar.bar = ctl + CW_BAR; bar.x = 0; bar.st = MISC + 8;
      if (hi - lo > 1) bar = xcd_barrier_post(ctl + CW_BAR, MISC + 8); }
#define IN(k) (lo <= (k) && (k) < hi)
#if defined(PROBE_DUP_MASK)
#define REP(k) _Pragma("unroll 1") for (int rep_ = 0; rep_ <= (((dupm >> (k)) & 1) && (dupp == 0 || dupp == 1 + (L & 1)) ? 1 : 0); ++rep_)
#else
#define REP(k)
#endif
#if defined(PROBE_BAR2)
#define SEAM(k) do { if (IN(k) && IN((k) + 1)) { xcd_barrier(bar); xcd_barrier(bar); } } while (0)
#else
#define SEAM(k) do { if (IN(k) && IN((k) + 1)) xcd_barrier(bar); } while (0)
#endif
#define ENV KArgs a = kargs(); const int tid = fresh_tid(), lane = tid & 63, wave = __builtin_amdgcn_readfirstlane(tid >> 6); const int G = gridDim.x, bid = blockIdx.x, gw = bid * NWAVES + wave, NGW = G * NWAVES, gtid = bid * NTHR + tid, NGT = G * NTHR; \
    unsigned char* ws = a->ws; bf16* RA = (bf16*)(ws + WS_RA); bf16* RB = (bf16*)(ws + WS_RB); bf16* RC = (bf16*)(ws + WS_RC); bf16* RD = (bf16*)(ws + WS_RD); float* Gt = (float*)(ws + WS_GT); \
    (void)lane; (void)wave; (void)gw; (void)NGW; (void)gtid; (void)NGT; (void)RA; (void)RB; (void)RC; (void)RD; (void)Gt; (void)G; (void)bid

    if (IN(0)) { ENV; prologue_phase(a, lds, gw, NGW, wave, lane, gtid, NGT);
#if defined(PROBE_DUP_MASK)
        if (dupm & (1 << 20)) prologue_phase(a, lds, gw, NGW, wave, lane, gtid, NGT);
#endif
    }
    SEAM(0);
#define SCANBUFS ScanBufs sb; sb.QKVA = (bf16*)(ws + WS_QKVA); sb.X2 = (bf16*)(ws + WS_X2); sb.Gt = Gt; sb.KT = (bf16*)(ws + WS_KT); sb.UT = (bf16*)(ws + WS_UT); sb.NW = (bf16*)(ws + WS_NW); sb.ATT = (bf16*)(ws + WS_ATT); \
    sb.KWT = (bf16*)(ws + WS_KWT); sb.VT = (bf16*)(ws + WS_VT); sb.PT = (bf16*)(ws + WS_PT); sb.DEN = (float*)(ws + WS_DEN)
#pragma unroll 1
    for (int L = 0; L < DEPTH; ++L) {
        const int pb = 1 + L * PH_PER_LAYER; const bool even = (L & 1) == 0; const int e = L >> 1;
        if (L == 0 && IN(pb + 0)) REP(0) { ENV; const float* hin = a->x;
            norm_phase(hin, (bf16*)a->out, (float*)(ws + WS_PS0), gw, NGW, lane); }
        if (L == 0) SEAM(pb + 0);
        if (IN(pb + 1)) REP(1) { ENV;
            const int N = even ? NINP : 1536;
            pg8::Gemm g{(const bf16*)a->out, even ? (const bf16*)(ws + WS_WIN) + (size_t)e * NINP * 1024 : (const bf16*)(ws + WS_WQKV) + (size_t)e * 1536 * 1024, M, N, DM};
            pg8::StaticOrder S; S.init(M, N, G, bid);
            pg8::EpiIn E{RC, (bf16*)(ws + WS_X2), even ? nullptr : a->b_qkv + (size_t)e * 1536, even ? nullptr : (const float*)(ws + WS_ROPE), (const float*)(ws + WS_PS0), Gt};
            pg8::gemm_phase<pg8::EpiIn, pg8::StaticOrder, true, true>(lds, g, S, E);
        }
        SEAM(pb + 1);
        if (even) {
            if (IN(pb + 2)) REP(2) { ENV; conv_phase((const bf16*)(ws + WS_X1), a->conv + (size_t)e * 4 * 1536, (bf16*)(ws + WS_QKVA), gw, NGW, lane); }
            SEAM(pb + 2);
        }
        if (even) {
            if (IN(pb + 3)) REP(3) { ENV; SCANBUFS; local_phase(lds, sb, a->a_log + e * 4, a->dt_bias + e * 4, a->i_bias + e * 4, a->f_bias + e * 4, gw, NGW, wave, lane); }
            SEAM(pb + 3);
        }
        if (IN(pb + 4)) REP(4) { ENV;
            if (even) { SCANBUFS; recur_phase(lds, sb, G, bid, wave, lane); }
            else attn_phase(lds, tid, wave, RC, a->sinks + e * 16, RD, G, bid);
        }
        SEAM(pb + 4);
        if (even) {
            if (IN(pb + 5)) REP(5) { ENV; SCANBUFS; post_phase(sb, a->norm_a + e * 128, a->norm_b + e * 512, (bf16*)(ws + WS_MIXED), gw, NGW, lane); }
            SEAM(pb + 5);
        }
        if (IN(pb + 6)) REP(6) { ENV;
            pg8::Gemm g{even ? (const bf16*)(ws + WS_MIXED) : (const bf16*)RD, even ? (const bf16*)(ws + WS_WOUT) + (size_t)e * DM * DM : (const bf16*)(ws + WS_WO) + (size_t)e * DM * DM, M, DM, DM};
            pg8::StaticOrder S; S.init(M, DM, G, bid);
            pg8::EpiBf16<0> E{RA, DM, even ? nullptr : a->b_o + (size_t)e * DM, RA, 1 << 30, DM, nullptr};
            pg8::gemm_phase<pg8::EpiBf16<0>, pg8::StaticOrder, true, true>(lds, g, S, E);
        }
        SEAM(pb + 6);
        if (IN(pb + 7)) { ENV; const float* gains = a->gains + (size_t)L * 4 * DM;
            resid_a_phase(RA, (L == 0) ? a->x : nullptr, (bf16*)a->out, gains + DM, (float*)(ws + WS_RS2), gw, NGW, lane); }
        SEAM(pb + 7);
        if (IN(pb + 8)) REP(8) { ENV;
            pg8::Gemm g{(const bf16*)a->out, (const bf16*)(ws + WS_WUP) + (size_t)L * FF * DM, M, FF, DM};
            pg8::StaticOrder S; S.init(M, FF, G, bid);
            pg8::EpiBf16<1> E{RC, FF, nullptr, RC, 1 << 30, FF, (const float*)(ws + WS_RS2)};
            pg8::gemm_phase<pg8::EpiBf16<1>, pg8::StaticOrder, true, true>(lds, g, S, E);
        }
        SEAM(pb + 8);
        if (IN(pb + 9)) REP(9) { ENV;
            pg8::Gemm g{RC, (const bf16*)(ws + WS_WDN) + (size_t)L * DM * FF, M, DM, FF};
            pg8::StaticOrder S; S.init(M, DM, G, bid);
            pg8::EpiBf16<0> E{RA, DM, nullptr, RA, 1 << 30, DM, nullptr};
            pg8::gemm_phase<pg8::EpiBf16<0>, pg8::StaticOrder, true, true>(lds, g, S, E);
        }
        SEAM(pb + 9);
        if (IN(pb + 10)) { ENV; resid_b_phase(RA, (const bf16*)a->out, a->gains + (size_t)L * 4 * DM + 3 * DM, RD, a->p + (size_t)L * M * PLE, RC, gw, NGW, lane, gtid, NGT); }
        SEAM(pb + 10);
        if (IN(pb + 11)) REP(11) { ENV;
            pg8::Gemm g{RC, (const bf16*)(ws + WS_WPLE) + (size_t)L * DM * PLE, M, DM, PLE};
            pg8::StaticOrder S; S.init(M, DM, G, bid);
            pg8::EpiBf16<0> E{RB, DM, nullptr, RB, 1 << 30, DM, nullptr};
            pg8::gemm_phase<pg8::EpiBf16<0>, pg8::StaticOrder, true, true>(lds, g, S, E);
        }
        SEAM(pb + 11);
        if (IN(pb + 12)) { ENV; const bool has_next = L + 1 < DEPTH;
            pg8::Gemm g{RD, (const bf16*)(ws + WS_WG) + (size_t)L * DM * DM, M, DM, DM};
            pg8::StaticOrder S; S.init(M, DM, G, bid);
            pg8::EpiGate2 E{RD, RB, (bf16*)a->out, has_next ? nullptr : a->out, (float*)(ws + WS_PS0)};
            pg8::gemm_phase<pg8::EpiGate2, pg8::StaticOrder, true, true>(lds, g, S, E);
        }
        SEAM(pb + 12);
    }
#undef SCANBUFS
#undef IN
#undef SEAM
#undef ENV
}

extern "C" void kernel_launch(void* const* d_in, const int* in_sizes, int n_in, void* d_out, int out_size, void* d_ws, size_t ws_size, hipStream_t stream) {
    static int grid = 0;
    if (grid == 0) {
        if (n_in != 22 || in_sizes[0] != M * DM || out_size != M * DM || ws_size < WS_END) {
            fprintf(stderr, "kernel_launch: unexpected shapes (n_in %d, in0 %d, out %d, ws %zu; need ws >= %zu); nothing launched\n", n_in, n_in > 0 ? in_sizes[0] : -1, out_size, ws_size, (size_t)WS_END); grid = -1; return; }
        int dev = 0, cus = 0, per_cu = 0;
        if (hipGetDevice(&dev) != hipSuccess || hipDeviceGetAttribute(&cus, hipDeviceAttributeMultiprocessorCount, dev) != hipSuccess) { fprintf(stderr, "kernel_launch: device query failed\n"); grid = -1; return; }
        if (hipFuncSetAttribute((const void*)trunk_fwd, hipFuncAttributeMaxDynamicSharedMemorySize, LDS_BYTES) != hipSuccess) { fprintf(stderr, "kernel_launch: hipFuncSetAttribute failed\n"); grid = -1; return; }
        if (hipOccupancyMaxActiveBlocksPerMultiprocessor(&per_cu, (const void*)trunk_fwd, NTHR, LDS_BYTES) != hipSuccess || per_cu < 1) fprintf(stderr, "kernel_launch: note: occupancy query reports %d\n", per_cu);
        (void)hipGetLastError();
        grid = cus;
    }
    if (grid < 0) return;
    Args a{};
    a.x = (const float*)d_in[0]; a.p = (const float*)d_in[1]; a.pos = (const int*)d_in[2]; a.gains = (const float*)d_in[3]; a.w_in = (const float*)d_in[4]; a.conv = (const float*)d_in[5];
    a.a_log = (const float*)d_in[6]; a.dt_bias = (const float*)d_in[7]; a.norm_a = (const float*)d_in[8]; a.i_bias = (const float*)d_in[9]; a.f_bias = (const float*)d_in[10]; a.norm_b = (const float*)d_in[11];
    a.b_qkv = (const float*)d_in[14]; a.sinks = (const float*)d_in[15]; a.b_o = (const float*)d_in[17];
    a.out = (float*)d_out; a.ws = (unsigned char*)d_ws;
#if defined(PROBE_DUP_MASK)
    a.dup_mask = PROBE_DUP_MASK; a.dup_par = PROBE_DUP_PAR;
#endif
    a.w_out = (const float*)d_in[12]; a.w_qkv = (const float*)d_in[13]; a.w_o = (const float*)d_in[16]; a.w_up = (const float*)d_in[18]; a.w_down = (const float*)d_in[19]; a.w_ple = (const float*)d_in[20]; a.w_gate = (const float*)d_in[21];
#if N_LAUNCH_MODE == 0
    if (hipMemsetAsync((char*)d_ws + WS_CTL, 0, CTL_ZERO_BYTES, stream) != hipSuccess) { fprintf(stderr, "kernel_launch: memset failed\n"); return; }
    a.ph_lo = 0; a.ph_hi = NPHASE;
    hipLaunchKernelGGL(trunk_fwd, dim3(grid), dim3(NTHR), LDS_BYTES, stream, a);
#else
    for (int ph = 0; ph < NPHASE; ++ph) { a.ph_lo = ph; a.ph_hi = ph + 1; hipLaunchKernelGGL(trunk_fwd, dim3(grid), dim3(NTHR), LDS_BYTES, stream, a); }
#endif
    const hipError_t le = hipPeekAtLastError();
    if (le != hipSuccess) fprintf(stderr, "kernel_launch: launch failed: %s\n", hipGetErrorName(le));
}
```

```cpp
#include <hip/hip_runtime.h>
#include <cstdio>
#include <cstdint>
#define N_LAUNCH_MODE 0
namespace pg8 {
#define PG8_LAS __attribute__((address_space(3)))
typedef unsigned short bf16_t;
typedef short bf16x8 __attribute__((ext_vector_type(8)));
typedef float f32x4 __attribute__((ext_vector_type(4)));
typedef unsigned u32x4 __attribute__((ext_vector_type(4)));
constexpr int BM = 256, BK = 64, HALF = 128, HTB = HALF * BK * 2  , STAGE_BYTES = 8 * HTB, NXCD = 8, WGM = 8;

__host__ __device__ __forceinline__ int lds_byte(int r, int c) { const int st = (r >> 4) * 2 + (c >> 5), rr = r & 15, cc = c & 31, ob = rr * 64 + cc * 2; return st * 1024 + (ob ^ (((ob >> 9) & 1) << 5)); }
__host__ __device__ __forceinline__ void stage_rc(int b, int& R, int& C) { const int st = b / 1024, sb = b % 1024, swz = sb ^ (((sb >> 9) & 1) << 5); R = (st >> 1) * 16 + swz / 64; C = (st & 1) * 32 + (swz % 64) / 2; }
__host__ __device__ __forceinline__ int perm32(int rho) { const int n = rho >> 4, i = rho & 15; return 8 * (i >> 2) + 4 * n + (i & 3); }

struct Unit { int pm, pn; };
struct Gemm { const bf16_t* A; const bf16_t* Bt; int M, N, K; int stamp = 0; };

struct StaticOrder {
    int nM, nN, nwg, G, c;
    __host__ __device__ void init(int M, int N, int G_, int c_) { nM = M / BM; nN = N / BM; nwg = nM * nN; G = G_; c = c_; }
    __host__ __device__ bool next(int i, Unit& u) const {
        const long L = (long)i * G + c; if (L >= nwg) return false;
        int wgid = (int)L; { const int q = nwg / NXCD, r = nwg % NXCD, xcd = wgid % NXCD, off = wgid / NXCD; wgid = (xcd < r ? xcd * (q + 1) : r * (q + 1) + (xcd - r) * q) + off; }
        const int nig = WGM * nN, gid = wgid / nig, fm = gid * WGM, gsz = (nM - fm) < WGM ? (nM - fm) : WGM;
        u.pm = fm + ((wgid % nig) % gsz); u.pn = (wgid % nig) / gsz; return true;
    }
    __device__ __forceinline__ void a_ready(const Unit&) const {}
    __device__ __forceinline__ void done(const Unit&) const {}
};

__device__ __forceinline__ unsigned cvt_pk_bf16(float lo, float hi) { unsigned r; asm volatile("v_cvt_pk_bf16_f32 %0, %1, %2" : "=v"(r) : "v"(lo), "v"(hi)); return r; }
typedef float f32x2 __attribute__((ext_vector_type(2)));
typedef unsigned u32x2 __attribute__((ext_vector_type(2)));

template <int ACT  > struct EpiBf16 {
    static constexpr bool PERM = true, AFTER_DRAIN = false;
    bf16_t* O; int ldc; const float* bias; bf16_t* O2; int split_col, ldc2; const float* rowscale;
    __device__ __forceinline__ void operator()(const f32x4 (&acc)[2][2][4][2], const Unit& u, int wr, int wc, int fr, int fq) const {
        const int row0 = u.pm * BM + wr * 64 + fr; const int col0 = u.pn * BM + wc * 32 + 8 * fq;
        const bool second = u.pn * BM >= split_col; bf16_t* const ob = second ? O2 : O; const int ld = second ? ldc2 : ldc, oc0 = second ? col0 - split_col : col0;
        f32x4 bv[2][2];
#pragma unroll
        for (int bj = 0; bj < 2; ++bj)
#pragma unroll
            for (int n = 0; n < 2; ++n) bv[bj][n] = bias ? *(const f32x4*)(bias + col0 + bj * HALF + 4 * n) : (f32x4){0.f, 0.f, 0.f, 0.f};
        float rs8[2][4];
#pragma unroll
        for (int ai = 0; ai < 2; ++ai)
#pragma unroll
            for (int m = 0; m < 4; ++m) rs8[ai][m] = rowscale ? rowscale[row0 + ai * HALF + m * 16] : 1.f;
#pragma unroll
        for (int ai = 0; ai < 2; ++ai)
#pragma unroll
            for (int m = 0; m < 4; ++m) { bf16_t* rowp = ob + (size_t)(row0 + ai * HALF + m * 16) * ld + oc0; const float rs = rs8[ai][m];
#pragma unroll
                for (int bj = 0; bj < 2; ++bj) { f32x4 v0 = acc[ai][bj][m][0] * rs + bv[bj][0], v1 = acc[ai][bj][m][1] * rs + bv[bj][1];
                    if (ACT == 1) {
#pragma unroll
                        for (int i = 0; i < 4; ++i) { const float a = fmaxf(v0[i], 0.f), b = fmaxf(v1[i], 0.f); v0[i] = a * a; v1[i] = b * b; } }
                    u32x4 w; w.x = cvt_pk_bf16(v0[0], v0[1]); w.y = cvt_pk_bf16(v0[2], v0[3]); w.z = cvt_pk_bf16(v1[0], v1[1]); w.w = cvt_pk_bf16(v1[2], v1[3]);
                    *(u32x4*)(rowp + bj * HALF) = w; } }
    }
};
__device__ __forceinline__ float row_rstd16(const float* ps, int row) { const f32x4* p = (const f32x4*)(ps + (size_t)row * 16); const f32x4 a = p[0], b = p[1], c = p[2], d = p[3];
    return rsqrtf((((a.x + a.y) + (a.z + a.w)) + ((b.x + b.y) + (b.z + b.w)) + (((c.x + c.y) + (c.z + c.w)) + ((d.x + d.y) + (d.z + d.w)))) * (1.f / 1024.f) + 1e-6f); }
#define EPIIN_R8                                                                                                                                          \
        float r8[2][4];                                                                                                                                   \
        { float s8[2][4];                                                                                                                                 \
          _Pragma("unroll") for (int ai = 0; ai < 2; ++ai)                                                                                                \
              _Pragma("unroll") for (int m = 0; m < 4; ++m) { const f32x4 pq_ = *(const f32x4*)(ps + (size_t)(row0 + ai * HALF + m * 16) * 16 + 4 * fq); s8[ai][m] = (pq_.x + pq_.y) + (pq_.z + pq_.w); } \
          _Pragma("unroll") for (int ai = 0; ai < 2; ++ai)                                                                                                \
              _Pragma("unroll") for (int m = 0; m < 4; ++m) { float s_ = s8[ai][m]; s_ += __shfl_xor(s_, 16); s_ += __shfl_xor(s_, 32); r8[ai][m] = rsqrtf(s_ * (1.f / 1024.f) + 1e-6f); } }
struct EpiInEven {
    static constexpr bool PERM = true, AFTER_DRAIN = false;
    bf16_t* O; bf16_t* O2; const float* ps; float* gates;
    __device__ __forceinline__ void operator()(const f32x4 (&acc)[2][2][4][2], const Unit& u, int wr, int wc, int fr, int fq) const {
        const int row0 = u.pm * BM + wr * 64 + fr, colt = u.pn * BM + wc * 32 + 8 * fq;
        EPIIN_R8
        if (u.pn == 16) {
            if (wc == 0 && fq < 2) {
#pragma unroll
                for (int ai = 0; ai < 2; ++ai)
#pragma unroll
                    for (int m = 0; m < 4; ++m) { const int row = row0 + ai * HALF + m * 16;
#pragma unroll
                        for (int n = 0; n < 2; ++n) *(f32x4*)(gates + (size_t)row * 16 + 8 * fq + 4 * n) = acc[ai][0][m][n] * r8[ai][m]; } }
            return; }
        const bool second = u.pn >= 6;
        bf16_t* const ob = second ? O2 : O; const int ld = second ? 2560 : 1536, oc0 = second ? colt - 1536 : colt;
#pragma unroll
        for (int ai = 0; ai < 2; ++ai)
#pragma unroll
            for (int m = 0; m < 4; ++m) { bf16_t* rowp = ob + (size_t)(row0 + ai * HALF + m * 16) * ld + oc0; const float r = r8[ai][m];
#pragma unroll
                for (int bj = 0; bj < 2; ++bj) { const f32x4 v0 = acc[ai][bj][m][0] * r, v1 = acc[ai][bj][m][1] * r;
                    u32x4 w; w.x = cvt_pk_bf16(v0[0], v0[1]); w.y = cvt_pk_bf16(v0[2], v0[3]); w.z = cvt_pk_bf16(v1[0], v1[1]); w.w = cvt_pk_bf16(v1[2], v1[3]); *(u32x4*)(rowp + bj * HALF) = w; } }
    }
};
struct EpiInOdd {
    static constexpr bool PERM = true, AFTER_DRAIN = false;
    bf16_t* O; const float* bias; const float* rope; const float* ps;
    __device__ __forceinline__ void operator()(const f32x4 (&acc)[2][2][4][2], const Unit& u, int wr, int wc, int fr, int fq) const {
        const int row0 = u.pm * BM + wr * 64 + fr, colt = u.pn * BM + wc * 32 + 8 * fq, g = (colt & 63) >> 3;
        EPIIN_R8
        const bool rot = u.pn < 5;
        f32x4 b1[2], b2[2];
#pragma unroll
        for (int bj = 0; bj < 2; ++bj) { const int c = colt + bj * HALF, hd = c >> 6;
            b1[bj] = rot ? *(const f32x4*)(bias + hd * 64 + 4 * g) : *(const f32x4*)(bias + c); b2[bj] = rot ? *(const f32x4*)(bias + hd * 64 + 32 + 4 * g) : *(const f32x4*)(bias + c + 4); }
#pragma unroll
        for (int ai = 0; ai < 2; ++ai) {
#pragma unroll
            for (int m = 0; m < 4; ++m) { const int row = row0 + ai * HALF + m * 16; bf16_t* rowp = O + (size_t)row * 1536; const float r = r8[ai][m];
                f32x4 t0 = {1.f, 0.f, 1.f, 0.f}, t1 = t0;
                if (rot) { const float* tp = rope + (size_t)row * 64 + 8 * g; t0 = *(const f32x4*)tp; t1 = *(const f32x4*)(tp + 4); }
#pragma unroll
                for (int bj = 0; bj < 2; ++bj) { const int c = colt + bj * HALF, hd = c >> 6; const f32x4 v0 = acc[ai][bj][m][0] * r + b1[bj], v1 = acc[ai][bj][m][1] * r + b2[bj];
                    if (rot) { const float sc = c < 1024 ? 0.125f : 1.f; const f32x4 cs = {t0.x, t0.z, t1.x, t1.z}, sn = {t0.y, t0.w, t1.y, t1.w};
                        const f32x4 o1 = (v0 * cs - v1 * sn) * sc, o2 = (v1 * cs + v0 * sn) * sc;
                        u32x2 w1, w2; w1.x = cvt_pk_bf16(o1[0], o1[1]); w1.y = cvt_pk_bf16(o1[2], o1[3]); w2.x = cvt_pk_bf16(o2[0], o2[1]); w2.y = cvt_pk_bf16(o2[2], o2[3]);
                        *(u32x2*)(rowp + hd * 64 + 4 * g) = w1; *(u32x2*)(rowp + hd * 64 + 32 + 4 * g) = w2; }
                    else { u32x4 w; w.x = cvt_pk_bf16(v0[0], v0[1]); w.y = cvt_pk_bf16(v0[2], v0[3]); w.z = cvt_pk_bf16(v1[0], v1[1]); w.w = cvt_pk_bf16(v1[2], v1[3]); *(u32x4*)(rowp + colt + bj * HALF) = w; } } } }
    }
};
struct EpiF32 {
    static constexpr bool PERM = false, AFTER_DRAIN = false;
    float* C; int ldc; const float* bias;
    __device__ __forceinline__ void operator()(const f32x4 (&acc)[2][2][4][2], const Unit& u, int wr, int wc, int fr, int fq) const {
        const int row0 = u.pm * BM + wr * 64 + fr, col0 = u.pn * BM + wc * 32 + 4 * fq;
        f32x4 bv[2][2];
#pragma unroll
        for (int bj = 0; bj < 2; ++bj)
#pragma unroll
            for (int n = 0; n < 2; ++n) bv[bj][n] = bias ? *(const f32x4*)(bias + col0 + bj * HALF + n * 16) : (f32x4){0.f, 0.f, 0.f, 0.f};
#pragma unroll
        for (int ai = 0; ai < 2; ++ai)
#pragma unroll
            for (int m = 0; m < 4; ++m) { float* rowp = C + (size_t)(row0 + ai * HALF + m * 16) * ldc + col0;
#pragma unroll
                for (int bj = 0; bj < 2; ++bj)
#pragma unroll
                    for (int n = 0; n < 2; ++n) *(f32x4*)(rowp + bj * HALF + n * 16) = acc[ai][bj][m][n] + bv[bj][n]; }
    }
};
__device__ __forceinline__ float bf_lo(unsigned w) { return __builtin_bit_cast(float, w << 16); }
__device__ __forceinline__ float bf_hi(unsigned w) { return __builtin_bit_cast(float, w & 0xffff0000u); }
struct EpiGate2 {
    static constexpr bool PERM = true, AFTER_DRAIN = false;
    const bf16_t* H2; const bf16_t* PP; bf16_t* HS; float* out32; float* ps;
    __device__ __forceinline__ void operator()(const f32x4 (&acc)[2][2][4][2], const Unit& u, int wr, int wc, int fr, int fq) const {
        const int row0 = u.pm * BM + wr * 64 + fr, col0 = u.pn * BM + wc * 32 + 8 * fq;
#pragma unroll
        for (int ai = 0; ai < 2; ++ai) {
            u32x4 hw[4][2], pw[4][2];
#pragma unroll
            for (int m = 0; m < 4; ++m)
#pragma unroll
                for (int bj = 0; bj < 2; ++bj) { const size_t off = (size_t)(row0 + ai * HALF + m * 16) * 1024 + col0 + bj * HALF; hw[m][bj] = *(const u32x4*)(H2 + off); pw[m][bj] = *(const u32x4*)(PP + off); }
#pragma unroll
            for (int m = 0; m < 4; ++m) { const int row = row0 + ai * HALF + m * 16; float ss = 0.f;
#pragma unroll
                for (int bj = 0; bj < 2; ++bj) { const size_t off = (size_t)row * 1024 + col0 + bj * HALF;
                    const u32x4 h_ = hw[m][bj], p_ = pw[m][bj]; const f32x4 a0 = acc[ai][bj][m][0], a1 = acc[ai][bj][m][1];
                    f32x4 h0 = {bf_lo(h_.x), bf_hi(h_.x), bf_lo(h_.y), bf_hi(h_.y)}, h1 = {bf_lo(h_.z), bf_hi(h_.z), bf_lo(h_.w), bf_hi(h_.w)};
                    const f32x4 p0 = {bf_lo(p_.x), bf_hi(p_.x), bf_lo(p_.y), bf_hi(p_.y)}, p1 = {bf_lo(p_.z), bf_hi(p_.z), bf_lo(p_.w), bf_hi(p_.w)};
#pragma unroll
                    for (int i = 0; i < 4; ++i) { h0[i] += p0[i] * __builtin_amdgcn_rcpf(1.f + __expf(-a0[i])); h1[i] += p1[i] * __builtin_amdgcn_rcpf(1.f + __expf(-a1[i])); }
                    ss += ((h0.x * h0.x + h0.y * h0.y) + (h0.z * h0.z + h0.w * h0.w)) + ((h1.x * h1.x + h1.y * h1.y) + (h1.z * h1.z + h1.w * h1.w));
                    if (out32) { *(f32x4*)(out32 + off) = h0; *(f32x4*)(out32 + off + 4) = h1; }
                    else { u32x4 w; w.x = cvt_pk_bf16(h0[0], h0[1]); w.y = cvt_pk_bf16(h0[2], h0[3]); w.z = cvt_pk_bf16(h1[0], h1[1]); w.w = cvt_pk_bf16(h1[2], h1[3]); *(u32x4*)(HS + off) = w; } }
                ss += __shfl_xor(ss, 16); ss += __shfl_xor(ss, 32);
                if (fq == 0) ps[(size_t)row * 16 + u.pn * 4 + wc] = ss; } }
    }
};
struct EpiGate {
    static constexpr bool PERM = false, AFTER_DRAIN = false;
    float* H; const bf16_t* PP; int ldc;
    __device__ __forceinline__ void operator()(const f32x4 (&acc)[2][2][4][2], const Unit& u, int wr, int wc, int fr, int fq) const {
        const int row0 = u.pm * BM + wr * 64 + fr, col0 = u.pn * BM + wc * 32 + 4 * fq;
#pragma unroll
        for (int ai = 0; ai < 2; ++ai)
#pragma unroll
            for (int m = 0; m < 4; ++m) { const size_t ro = (size_t)(row0 + ai * HALF + m * 16) * ldc + col0;
#pragma unroll
                for (int bj = 0; bj < 2; ++bj)
#pragma unroll
                    for (int n = 0; n < 2; ++n) { const size_t off = ro + bj * HALF + n * 16;
                        f32x4 hv = *(const f32x4*)(H + off); const u32x2 pv = *(const u32x2*)(PP + off); const f32x4 a = acc[ai][bj][m][n];
                        const float p0 = bf_lo(pv.x), p1 = bf_hi(pv.x), p2 = bf_lo(pv.y), p3 = bf_hi(pv.y);
                        hv[0] += p0 / (1.f + __expf(-a[0])); hv[1] += p1 / (1.f + __expf(-a[1])); hv[2] += p2 / (1.f + __expf(-a[2])); hv[3] += p3 / (1.f + __expf(-a[3]));
                        *(f32x4*)(H + off) = hv; } }
    }
};

template <class Epi, class Sched, bool ALIGN_EPI = false, bool SP2 = false>
__device__ __forceinline__ void gemm_phase(PG8_LAS unsigned char* lds, const Gemm g, const Sched& S, const Epi& E) {
    int tid_l = threadIdx.x; asm volatile("" : "+v"(tid_l));
    const int tid = tid_l, wid = __builtin_amdgcn_readfirstlane(tid >> 6), lane = tid & 63, wr = wid >> 2, wc = wid & 3, fr = lane & 15, fq = lane >> 4;
    const int K = g.K, nt = K / BK;
    unsigned voffA[2], voffB[2];
#pragma unroll
    for (int i = 0; i < 2; ++i) { int R, C; stage_rc(tid * 16 + i * 8192, R, C); const int Rb = Epi::PERM ? ((R & ~31) + perm32(R & 31)) : R;
        voffA[i] = (unsigned)(R * K + C) * 2u; voffB[i] = (unsigned)(Rb * K + C) * 2u; }
    const size_t kstep = (size_t)(BK * 2);
    const size_t hstep = (size_t)HALF * K * 2;
    const size_t tstep = 2 * hstep;
    const unsigned ldsw = (unsigned)wid * 1024u;
    const int aoff = lds_byte(wr * 64 + fr, fq * 8), boff = lds_byte(wc * 32 + fr, fq * 8);
#define PG8_SA(b, h) (((b) * 2 + (h)) * HTB)
#define PG8_SB(b, h) ((4 + (b) * 2 + (h)) * HTB)
#define PG8_STAGE(bufoff, gbase, voff) do { _Pragma("unroll") for (int _i = 0; _i < 2; ++_i) \
        __builtin_amdgcn_global_load_lds((const unsigned*)((const char*)(gbase) + (voff)[_i]), (PG8_LAS unsigned*)(lds + (bufoff) + ldsw + _i * 8192), 16, 0, 0); } while (0)
#define PG8_LDA(dst, b, h) do { _Pragma("unroll") for (int m = 0; m < 4; ++m) _Pragma("unroll") for (int k = 0; k < 2; ++k) dst[m][k] = *(const PG8_LAS bf16x8*)(lds + PG8_SA(b, h) + aoff + m * 2048 + k * 1024); } while (0)
#define PG8_LDB(dst, b, h) do { _Pragma("unroll") for (int n = 0; n < 2; ++n) _Pragma("unroll") for (int k = 0; k < 2; ++k) dst[n][k] = *(const PG8_LAS bf16x8*)(lds + PG8_SB(b, h) + boff + n * 2048 + k * 1024); } while (0)
#define PG8_MMA(ai, bj, At, Bt) do { __builtin_amdgcn_s_setprio(1); _Pragma("unroll") for (int m = 0; m < 4; ++m) _Pragma("unroll") for (int n = 0; n < 2; ++n) _Pragma("unroll") for (int k = 0; k < 2; ++k) \
        acc[ai][bj][m][n] = __builtin_amdgcn_mfma_f32_16x16x32_bf16(Bt[n][k], At[m][k], acc[ai][bj][m][n], 0, 0, 0); __builtin_amdgcn_s_setprio(0); } while (0)
#define PG8_WAIT_V(n) asm volatile("s_waitcnt vmcnt(" #n ")" ::: "memory")
#define PG8_WAIT_L(n) asm volatile("s_waitcnt lgkmcnt(" #n ")" ::: "memory")
#define PG8_BAR __builtin_amdgcn_s_barrier()
#define PG8_SCHED __builtin_amdgcn_sched_barrier(0)
    Unit cur, nxt; int ui = 0;
    if (!S.next(0, cur)) return;
    f32x4 acc[2][2][4][2];
#pragma unroll
    for (int a = 0; a < 2; ++a)
#pragma unroll
        for (int b = 0; b < 2; ++b)
#pragma unroll
            for (int m = 0; m < 4; ++m)
#pragma unroll
                for (int n = 0; n < 2; ++n) acc[a][b][m][n] = (f32x4){0.f, 0.f, 0.f, 0.f};
    bf16x8 At[4][2], B0[2][2], B1[2][2];
    const char* cA = (const char*)g.A + (size_t)cur.pm * tstep; const char* cB = (const char*)g.Bt + (size_t)cur.pn * tstep;
    S.a_ready(cur);
    if constexpr (SP2) {
        PG8_STAGE(PG8_SB(0, 0), cB, voffB); PG8_STAGE(PG8_SB(0, 1), cB + hstep, voffB); PG8_STAGE(PG8_SA(0, 0), cA, voffA); PG8_STAGE(PG8_SA(0, 1), cA + hstep, voffA);
        if (wr == 1) PG8_BAR;
        PG8_WAIT_V(2); PG8_BAR;
        PG8_STAGE(PG8_SB(1, 0), cB + kstep, voffB); PG8_STAGE(PG8_SA(1, 0), cA + kstep, voffA); PG8_STAGE(PG8_SB(1, 1), cB + hstep + kstep, voffB);
        PG8_WAIT_V(6); PG8_BAR;
    } else {
        PG8_STAGE(PG8_SB(0, 0), cB, voffB); PG8_STAGE(PG8_SA(0, 0), cA, voffA); PG8_STAGE(PG8_SB(0, 1), cB + hstep, voffB); PG8_STAGE(PG8_SA(0, 1), cA + hstep, voffA);
        if (wr == 1) PG8_BAR;
        PG8_WAIT_V(4); PG8_BAR;
        PG8_STAGE(PG8_SB(1, 0), cB + kstep, voffB); PG8_STAGE(PG8_SA(1, 0), cA + kstep, voffA); PG8_STAGE(PG8_SB(1, 1), cB + hstep + kstep, voffB);
        PG8_WAIT_V(6); PG8_BAR;
    }
    for (;;) {
        const bool has_next = S.next(ui + 1, nxt);
        const char* nA = has_next ? (const char*)g.A + (size_t)nxt.pm * tstep : cA; const char* nB = has_next ? (const char*)g.Bt + (size_t)nxt.pn * tstep : cB;
        for (int t = 0; t < nt; t += 2) {
            const bool last = (t == nt - 2);
            const char* a1 = cA + (size_t)(t + 1) * kstep;
            const char* a2 = last ? nA : cA + (size_t)(t + 2) * kstep; const char* b2 = last ? nB : cB + (size_t)(t + 2) * kstep;
            const char* a3 = a2 + kstep; const char* b3 = b2 + kstep;
            if (last && has_next) S.a_ready(nxt);
            if constexpr (SP2) {
            PG8_LDB(B0, 0, 0); PG8_LDB(B1, 0, 1); PG8_SCHED; PG8_LDA(At, 0, 0); PG8_STAGE(PG8_SA(1, 1), a1 + hstep, voffA);
            PG8_WAIT_V(8); PG8_WAIT_L(0); PG8_BAR; PG8_MMA(0, 0, At, B0); PG8_MMA(0, 1, At, B1); PG8_BAR; PG8_SCHED;
            PG8_LDA(At, 0, 1); PG8_STAGE(PG8_SB(0, 0), b2, voffB); PG8_STAGE(PG8_SB(0, 1), b2 + hstep, voffB); PG8_STAGE(PG8_SA(0, 0), a2, voffA);
            PG8_WAIT_V(8); PG8_WAIT_L(0); PG8_BAR; PG8_MMA(1, 0, At, B0); PG8_MMA(1, 1, At, B1); PG8_BAR; PG8_SCHED;
            PG8_LDB(B0, 1, 0); PG8_LDB(B1, 1, 1); PG8_SCHED; PG8_LDA(At, 1, 0); PG8_STAGE(PG8_SA(0, 1), a2 + hstep, voffA);
            PG8_WAIT_V(8); PG8_WAIT_L(0); PG8_BAR; PG8_MMA(0, 0, At, B0); PG8_MMA(0, 1, At, B1); PG8_BAR; PG8_SCHED;
            PG8_LDA(At, 1, 1); PG8_STAGE(PG8_SB(1, 0), b3, voffB); PG8_STAGE(PG8_SB(1, 1), b3 + hstep, voffB); PG8_STAGE(PG8_SA(1, 0), a3, voffA);
            PG8_WAIT_V(8); PG8_WAIT_L(0); PG8_BAR; PG8_MMA(1, 0, At, B0); PG8_MMA(1, 1, At, B1); PG8_BAR; PG8_SCHED;
            } else {
            PG8_LDB(B0, 0, 0); PG8_SCHED; PG8_LDA(At, 0, 0); PG8_STAGE(PG8_SA(1, 1), a1 + hstep, voffA);
            PG8_WAIT_L(8); PG8_BAR; PG8_WAIT_L(0); PG8_MMA(0, 0, At, B0); PG8_BAR; PG8_SCHED;
            PG8_LDB(B1, 0, 1); PG8_STAGE(PG8_SB(0, 0), b2, voffB);
            PG8_BAR; PG8_WAIT_L(0); PG8_MMA(0, 1, At, B1); PG8_BAR;
            PG8_LDA(At, 0, 1); PG8_STAGE(PG8_SA(0, 0), a2, voffA);
            PG8_BAR; PG8_WAIT_L(0); PG8_MMA(1, 0, At, B0); PG8_BAR; PG8_SCHED;
            PG8_STAGE(PG8_SB(0, 1), b2 + hstep, voffB);
            PG8_WAIT_V(6); PG8_BAR; PG8_MMA(1, 1, At, B1); PG8_BAR;
            PG8_LDB(B0, 1, 0); PG8_SCHED; PG8_LDA(At, 1, 0); PG8_STAGE(PG8_SA(0, 1), a2 + hstep, voffA);
            PG8_WAIT_L(8); PG8_BAR; PG8_WAIT_L(0); PG8_MMA(0, 0, At, B0); PG8_BAR; PG8_SCHED;
            PG8_LDB(B1, 1, 1); PG8_STAGE(PG8_SB(1, 0), b3, voffB);
            PG8_BAR; PG8_WAIT_L(0); PG8_MMA(0, 1, At, B1); PG8_BAR;
            PG8_LDA(At, 1, 1); PG8_STAGE(PG8_SA(1, 0), a3, voffA);
            PG8_BAR; PG8_WAIT_L(0); PG8_MMA(1, 0, At, B0); PG8_BAR; PG8_SCHED;
            PG8_STAGE(PG8_SB(1, 1), b3 + hstep, voffB);
            PG8_WAIT_V(6); PG8_BAR; PG8_MMA(1, 1, At, B1); PG8_BAR;
            }
        }
        if constexpr (ALIGN_EPI) { if (wr == 0) PG8_BAR; }
#if defined(PROBE_GSEC)
        { const bool son = g.stamp && blockIdx.x == 0 && wid == 0; unsigned long long t0_ = 0;
          if (son && PROBE_GSEC == 1) { asm volatile("s_waitcnt lgkmcnt(0)" ::: "memory"); t0_ = __builtin_amdgcn_s_memrealtime(); }
          if constexpr (!Epi::AFTER_DRAIN) { E(acc, cur, wr, wc, fr, fq); S.done(cur); }
          if (son && PROBE_GSEC == 1) { asm volatile("s_waitcnt lgkmcnt(0)" ::: "memory"); const unsigned d_ = (unsigned)(__builtin_amdgcn_s_memrealtime() - t0_); if (lane == 0) ((volatile PG8_LAS unsigned*)(lds + 131072))[22] += d_; } }
#else
        if constexpr (!Epi::AFTER_DRAIN) { E(acc, cur, wr, wc, fr, fq); S.done(cur); }
#endif
        if (!has_next) break;
#pragma unroll
        for (int a = 0; a < 2; ++a)
#pragma unroll
            for (int b = 0; b < 2; ++b)
#pragma unroll
                for (int m = 0; m < 4; ++m)
#pragma unroll
                    for (int n = 0; n < 2; ++n) acc[a][b][m][n] = (f32x4){0.f, 0.f, 0.f, 0.f};
        cur = nxt; cA = nA; cB = nB; ++ui;
        if constexpr (ALIGN_EPI) { if (wr == 1) PG8_BAR; }
    }
    PG8_WAIT_V(0);
    if constexpr (!ALIGN_EPI) { if (wr == 0) PG8_BAR; }
    PG8_BAR;
    if constexpr (Epi::AFTER_DRAIN) { E.fused(acc, cur, wr, wc, fr, fq, lds, wid, lane); S.done(cur); }
#undef PG8_SA
#undef PG8_SB
#undef PG8_STAGE
#undef PG8_LDA
#undef PG8_LDB
#undef PG8_MMA
#undef PG8_WAIT_V
#undef PG8_WAIT_L
#undef PG8_BAR
#undef PG8_SCHED
}
}
constexpr int BATCH = 32, SEQ = 2048, DM = 1024, DEPTH = 4, M = BATCH * SEQ;
constexpr int FF = 4096, PLE = 256, NIN = 4112;
constexpr float EPS = 1e-6f;
constexpr int NWAVES = 8, NTHR = NWAVES * 64;
constexpr int PH_PER_LAYER = 13, NPHASE = 1 + DEPTH * PH_PER_LAYER;
constexpr size_t MiB = 1u << 20;
constexpr size_t WS_CTL = 0, CTL_ZERO_BYTES = 32768;
constexpr int NINP = 4352;
constexpr size_t WS_WIN = 1 * MiB, WS_WOUT = 18 * MiB, WS_WQKV = 22 * MiB, WS_WO = 28 * MiB, WS_WUP = 32 * MiB, WS_WDN = 64 * MiB, WS_WPLE = 96 * MiB, WS_WG = 98 * MiB;
constexpr size_t WS_WGATES = 105 * MiB, WS_GT = 106 * MiB, WS_ROPE = 110 * MiB;
constexpr size_t WS_PS0 = 128 * MiB;
constexpr size_t WS_DEN = 126 * MiB, WS_RS0 = 127 * MiB, WS_RS2 = 127 * MiB + 512 * 1024;
constexpr size_t WS_RA = 128 * MiB, WS_RB = 256 * MiB, WS_RC = 384 * MiB, WS_RD = 896 * MiB, WS_END = 1024 * MiB;
constexpr size_t WS_QKVA = 128 * MiB, WS_KWT = 320 * MiB, WS_X1 = 384 * MiB, WS_KT = 384 * MiB, WS_UT = 448 * MiB, WS_NW = 512 * MiB, WS_X2 = 576 * MiB, WS_VT = 896 * MiB, WS_ATT = 960 * MiB, WS_PT = 992 * MiB, WS_MIXED = 384 * MiB;
constexpr int CW_BAR = 4096;
constexpr int RING_BYTES = 131072, MISC_OFF = RING_BYTES, LDS_BYTES = RING_BYTES + 1024;

#define GAS __attribute__((address_space(1)))
#define LAS __attribute__((address_space(3)))
typedef unsigned short bf16;
typedef float f32x4 __attribute__((ext_vector_type(4)));
typedef float f32x2 __attribute__((ext_vector_type(2)));
typedef unsigned u32x4 __attribute__((ext_vector_type(4)));
typedef unsigned u32x2 __attribute__((ext_vector_type(2)));
#define LDS_WAIT() asm volatile("s_waitcnt lgkmcnt(0)" ::: "memory")
#define VM_WAIT() asm volatile("s_waitcnt vmcnt(0)" ::: "memory")
using pg8::bf_lo; using pg8::bf_hi;
typedef __bf16 bf16x2_t __attribute__((ext_vector_type(2)));
__device__ __forceinline__ unsigned pk2(float lo, float hi) { return pg8::cvt_pk_bf16(lo, hi); }
__device__ __forceinline__ unsigned pk2v(float lo, float hi) { const f32x2 v = {lo, hi}; const bf16x2_t b = __builtin_convertvector(v, bf16x2_t); return __builtin_bit_cast(unsigned, b); }
__device__ __forceinline__ float wave_sum(float v) {
#pragma unroll
    for (int o = 1; o < 64; o <<= 1) v += __shfl_xor(v, o);
    return v;
}
__device__ __forceinline__ float dot4(f32x4 a, f32x4 b) { return (a.x * b.x + a.y * b.y) + (a.z * b.z + a.w * b.w); }
__device__ __forceinline__ float sigmoid_f(float x) { return 1.f / (1.f + __expf(-x)); }
__device__ __forceinline__ float softplus_f(float x) { const float y = __expf(-fabsf(x)); const float l = y < 0.03125f ? y * (1.f - y * (0.5f - y * (0.33333334f - 0.25f * y))) : __logf(1.f + y); return fmaxf(x, 0.f) + l; }

#define XB_TMO      128
#define XB_XCNT(j)  (256  + 64 * (j))
#define XB_XSUB(j)  (1280 + 64 * (j))
#define XB_XGEN(j)  (2304 + 64 * (j))
#define XB_TOP      3328
#define XB_TOPGEN   3392
#define XCD_BAR_WORDS 3456
#define XB_SPIN_CAP (1u << 18)

__device__ __forceinline__ unsigned xb_ld(unsigned* p)              { return __hip_atomic_load(p, __ATOMIC_RELAXED, __HIP_MEMORY_SCOPE_AGENT); }
__device__ __forceinline__ unsigned xb_add(unsigned* p, unsigned v) { return __hip_atomic_fetch_add(p, v, __ATOMIC_RELAXED, __HIP_MEMORY_SCOPE_AGENT); }
__device__ __forceinline__ unsigned xb_xcc_id() { return (unsigned)__builtin_amdgcn_s_getreg((3 << 11) | 20) & 0xFu; }
#define XB_SPIN(cond, bar) do { unsigned _sp = 0; while (cond) { __builtin_amdgcn_s_sleep(1); \
    if ((++_sp & 255u) == 0u) { if (xb_ld(&(bar)[XB_TMO])) break; if (_sp > XB_SPIN_CAP) { atomicAdd(&(bar)[XB_TMO], 1u); break; } } } } while (0)

struct XcdBarrier {
    unsigned* bar; unsigned x;
    volatile LAS unsigned* st;
};

__device__ __forceinline__ XcdBarrier xcd_barrier_post(unsigned* bar, volatile LAS unsigned* st) {
    XcdBarrier b; b.bar = bar; b.x = xb_xcc_id(); b.st = st;
    if (threadIdx.x == 0) (void)xb_add(&bar[XB_XCNT(b.x)], 1u);
    return b;
}
__device__ __forceinline__ void xcd_barrier_complete(unsigned* bar, unsigned x, unsigned& nloc, unsigned& nx) {
    const unsigned G = gridDim.x * gridDim.y * gridDim.z;
    unsigned sum, cnt, mine, sp = 0u;
    for (;;) {
        sum = 0u; cnt = 0u; mine = 0u;
#pragma unroll
        for (unsigned j = 0; j < 16; ++j) { const unsigned c = xb_ld(&bar[XB_XCNT(j)]); sum += c; cnt += (c > 0u) ? 1u : 0u; mine = (j == x) ? c : mine; }
        if (sum == G) break;
        __builtin_amdgcn_s_sleep(1);
        if ((++sp & 255u) == 0u) { if (xb_ld(&bar[XB_TMO])) break; if (sp > XB_SPIN_CAP) { atomicAdd(&bar[XB_TMO], 1u); break; } }
    }
    nloc = mine > 0u ? mine : 1u; nx = cnt > 0u ? cnt : 1u;
}

__device__ __forceinline__ void xcd_barrier(const XcdBarrier& b) {
    asm volatile("s_waitcnt vmcnt(0)" ::: "memory");
    __syncthreads();
    if (threadIdx.x == 0) {
        unsigned* bar = b.bar;
        __builtin_amdgcn_s_waitcnt(0);
        unsigned nloc = b.st[0], nx = b.st[1];
        if (nloc == 0u) { xcd_barrier_complete(bar, b.x, nloc, nx); b.st[0] = nloc; b.st[1] = nx; }
        const unsigned old = xb_add(&bar[XB_XSUB(b.x)], 1u);
        const unsigned gen = old / nloc;
        if (old + 1u == (gen + 1u) * nloc) {
            __builtin_amdgcn_fence(__ATOMIC_RELEASE, "agent");
            asm volatile("s_waitcnt vmcnt(0)" ::: "memory");
            const unsigned og = xb_add(&bar[XB_TOP], 1u);
            const unsigned tg = og / nx;
            if (og + 1u == (tg + 1u) * nx) xb_add(&bar[XB_TOPGEN], 1u);
            else XB_SPIN(xb_ld(&bar[XB_TOPGEN]) == tg, bar);
            __builtin_amdgcn_fence(__ATOMIC_ACQUIRE, "agent");
            xb_add(&bar[XB_XGEN(b.x)], 1u);
            asm volatile("s_waitcnt vmcnt(0)" ::: "memory");
        } else {
            XB_SPIN(xb_ld(&bar[XB_XGEN(b.x)]) == gen, bar);
            __builtin_amdgcn_fence(__ATOMIC_ACQUIRE, "agent");
            asm volatile("s_waitcnt vmcnt(0)" ::: "memory");
        }
    }
    __syncthreads();
}
#ifndef ROPE_FUSED
#define ROPE_FUSED 1
#endif
struct Args {
    const float *x, *p; const int* pos; const float *gains, *w_in, *conv, *a_log, *dt_bias, *norm_a, *i_bias, *f_bias, *norm_b, *w_out, *w_qkv, *b_qkv, *sinks, *w_o, *b_o, *w_up, *w_down, *w_ple, *w_gate;
    float* out; unsigned char* ws;
    int ph_lo, ph_hi, dup_mask, dup_par;
};

template <bool ROPE_PERM = false> __device__ __forceinline__ void transpose_item(const float* src, int ld, int K, bf16* dst, LAS float* scr, int item, int nblk, int lane, const float* kscale = nullptr) {
    const int kb = item / nblk, nb = item % nblk, k0 = 64 * kb, n0 = 32 * nb;
#pragma unroll 8
    for (int i = 0; i < 32; ++i) { const int kk = 2 * i + (lane >> 5); scr[kk * 33 + (lane & 31)] = src[(size_t)(k0 + kk) * ld + n0 + (lane & 31)] * (kscale ? kscale[k0 + kk] : 1.f); }
    LDS_WAIT(); asm volatile("" ::: "memory");
    const int c = lane & 7;
#pragma unroll
    for (int j = 0; j < 4; ++j) { const int n = (lane >> 3) + 8 * j; const LAS float* s = scr + (8 * c) * 33 + n;
        u32x4 o; o.x = pk2(s[0 * 33], s[1 * 33]); o.y = pk2(s[2 * 33], s[3 * 33]); o.z = pk2(s[4 * 33], s[5 * 33]); o.w = pk2(s[6 * 33], s[7 * 33]);
        int nd = n0 + n;
        if (ROPE_PERM && nd < 1280) { const int i = nd & 63; nd = (nd & ~63) + (i < 32 ? 8 * (i >> 2) + (i & 3) : 8 * ((i - 32) >> 2) + 4 + (i & 3)); }
        *(u32x4*)(dst + (size_t)nd * K + k0 + 8 * c) = o; }
    LDS_WAIT(); asm volatile("" ::: "memory");
}
__device__ __forceinline__ int gate_col(int c) { return c < 8 ? 1536 + c : 3592 + (c - 8); }

typedef const __attribute__((address_space(4))) Args* KArgs;
__device__ __forceinline__ KArgs kargs() { KArgs p = (KArgs)__builtin_amdgcn_kernarg_segment_ptr(); asm volatile("" : "+s"(p)); return p; }
__device__ __forceinline__ int fresh_tid() { int t = threadIdx.x; asm volatile("" : "+v"(t)); return t; }
__device__ __forceinline__ void prologue_phase(KArgs a, LAS unsigned char* lds, int gw, int NGW, int wave, int lane, int gtid, int NGT) {
    LAS float* scr = (LAS float*)(lds + wave * 16384);
    constexpr int I_IN = 16 * 16, I_SQ = 16 * 32, I_QKV = 16 * 48, I_UP = 16 * 128, I_DN = 64 * 32, I_PLE = 4 * 32;
    constexpr int NITEMS = 16 * I_IN + 2 * I_SQ + 2 * I_QKV + 2 * I_SQ + 4 * I_UP + 4 * I_DN + 4 * I_PLE + 4 * I_SQ;
    unsigned char* ws = a->ws;
    for (int it = gw; it < NITEMS; it += NGW) {
        int r = it;
        if (r < 16 * I_IN) { const int j = r / I_IN, e = j >> 3, s = j & 7, col0 = 512 * s + (s >= 3 ? 8 : 0) + (s >= 7 ? 8 : 0);
            transpose_item(a->w_in + (size_t)e * DM * NIN + col0, NIN, DM, (bf16*)(ws + WS_WIN) + ((size_t)e * NINP + s * 512) * DM, scr, r % I_IN, 16, lane, a->gains + (size_t)(2 * e) * 4 * DM); continue; } r -= 16 * I_IN;
        if (r < 2 * I_SQ) { const int e = r / I_SQ; transpose_item(a->w_out + (size_t)e * DM * DM, DM, DM, (bf16*)(ws + WS_WOUT) + (size_t)e * DM * DM, scr, r % I_SQ, 32, lane); continue; } r -= 2 * I_SQ;
        if (r < 2 * I_QKV) { const int e = r / I_QKV; transpose_item<ROPE_FUSED != 0>(a->w_qkv + (size_t)e * DM * 1536, 1536, DM, (bf16*)(ws + WS_WQKV) + (size_t)e * 1536 * DM, scr, r % I_QKV, 48, lane, a->gains + (size_t)(2 * e + 1) * 4 * DM); continue; } r -= 2 * I_QKV;
        if (r < 2 * I_SQ) { const int e = r / I_SQ; transpose_item(a->w_o + (size_t)e * DM * DM, DM, DM, (bf16*)(ws + WS_WO) + (size_t)e * DM * DM, scr, r % I_SQ, 32, lane); continue; } r -= 2 * I_SQ;
        if (r < 4 * I_UP) { const int l = r / I_UP; transpose_item(a->w_up + (size_t)l * DM * FF, FF, DM, (bf16*)(ws + WS_WUP) + (size_t)l * FF * DM, scr, r % I_UP, 128, lane, a->gains + ((size_t)l * 4 + 2) * DM); continue; } r -= 4 * I_UP;
        if (r < 4 * I_DN) { const int l = r / I_DN; transpose_item(a->w_down + (size_t)l * FF * DM, DM, FF, (bf16*)(ws + WS_WDN) + (size_t)l * DM * FF, scr, r % I_DN, 32, lane); continue; } r -= 4 * I_DN;
        if (r < 4 * I_PLE) { const int l = r / I_PLE; transpose_item(a->w_ple + (size_t)l * PLE * DM, DM, PLE, (bf16*)(ws + WS_WPLE) + (size_t)l * DM * PLE, scr, r % I_PLE, 32, lane); continue; } r -= 4 * I_PLE;
        { const int l = r / I_SQ; transpose_item(a->w_gate + (size_t)l * DM * DM, DM, DM, (bf16*)(ws + WS_WG) + (size_t)l * DM * DM, scr, r % I_SQ, 32, lane); }
    }
    for (int i = gtid; i < 2 * 256 * 1024; i += NGT) { const int e = i >> 18, c = (i >> 10) & 255, k = i & 1023;
        const float v = c < 16 ? a->w_in[((size_t)e * 1024 + k) * NIN + gate_col(c)] * a->gains[(size_t)(2 * e) * 4 * DM + k] : 0.f;
        ((bf16*)(ws + WS_WIN))[((size_t)e * NINP + 4096 + c) * DM + k] = (bf16)(pk2(v, 0.f) & 0xffffu); }
    f32x2* rope = (f32x2*)(a->ws + WS_ROPE);
    for (int i = gtid; i < M * 32; i += NGT) { const int m = i >> 5, d = i & 31;
        const float inv = (float)pow(10000.0, -(double)d / 32.0); const float ang = (float)a->pos[m] * inv; float sn, cs; sincosf(ang, &sn, &cs); rope[i] = (f32x2){cs, sn}; }
}

__device__ __forceinline__ void norm_phase(const float* hin, bf16* HN, float* RS, int gw, int NGW, int lane) {
    for (int m = gw; m < M; m += NGW) {
        const f32x4* xr = (const f32x4*)(hin + (size_t)m * DM) + lane;
        f32x4 v[4]; float s = 0.f;
#pragma unroll
        for (int j = 0; j < 4; ++j) { v[j] = xr[64 * j]; s += dot4(v[j], v[j]); }
        u32x2* o8 = (u32x2*)(HN + (size_t)m * DM) + lane;
#pragma unroll
        for (int j = 0; j < 4; ++j) o8[64 * j] = (u32x2){pk2(v[j].x, v[j].y), pk2(v[j].z, v[j].w)};
        const float tot = wave_sum(s);
        if (lane < 16) RS[(size_t)m * 16 + lane] = lane == 0 ? tot : 0.f;
    }
}
struct Row16 { f32x4 v[4]; };
__device__ __forceinline__ Row16 ld_row_bf16(const bf16* row, int lane) { const u32x4 a = ((const u32x4*)row)[lane], b = ((const u32x4*)row)[lane + 64]; Row16 r;
    r.v[0] = (f32x4){bf_lo(a.x), bf_hi(a.x), bf_lo(a.y), bf_hi(a.y)}; r.v[1] = (f32x4){bf_lo(a.z), bf_hi(a.z), bf_lo(a.w), bf_hi(a.w)};
    r.v[2] = (f32x4){bf_lo(b.x), bf_hi(b.x), bf_lo(b.y), bf_hi(b.y)}; r.v[3] = (f32x4){bf_lo(b.z), bf_hi(b.z), bf_lo(b.w), bf_hi(b.w)}; return r; }
__device__ __forceinline__ Row16 ld_row_f32(const float* row, int lane) { const f32x4* p = (const f32x4*)row; Row16 r; r.v[0] = p[2 * lane]; r.v[1] = p[2 * lane + 1]; r.v[2] = p[128 + 2 * lane]; r.v[3] = p[128 + 2 * lane + 1]; return r; }
__device__ __forceinline__ void st_row_bf16(bf16* row, int lane, const Row16& r) {
    ((u32x4*)row)[lane] = (u32x4){pk2(r.v[0].x, r.v[0].y), pk2(r.v[0].z, r.v[0].w), pk2(r.v[1].x, r.v[1].y), pk2(r.v[1].z, r.v[1].w)};
    ((u32x4*)row)[lane + 64] = (u32x4){pk2(r.v[2].x, r.v[2].y), pk2(r.v[2].z, r.v[2].w), pk2(r.v[3].x, r.v[3].y), pk2(r.v[3].z, r.v[3].w)}; }
__device__ __forceinline__ void st_row_f32(float* row, int lane, const Row16& r) { f32x4* p = (f32x4*)row; p[2 * lane] = r.v[0]; p[2 * lane + 1] = r.v[1]; p[128 + 2 * lane] = r.v[2]; p[128 + 2 * lane + 1] = r.v[3]; }
__device__ __forceinline__ float row_sumsq(const Row16& r) { return (dot4(r.v[0], r.v[0]) + dot4(r.v[1], r.v[1])) + (dot4(r.v[2], r.v[2]) + dot4(r.v[3], r.v[3])); }
__device__ __forceinline__ void resid_a_phase(const bf16* mix, const float* hin32, bf16* hs, const float* g1, float* RS, int gw, int NGW, int lane) {
    const Row16 ga = ld_row_f32(g1, lane);
    for (int m = gw; m < M; m += NGW) {
        const Row16 v = ld_row_bf16(mix + (size_t)m * DM, lane); Row16 h = hin32 ? ld_row_f32(hin32 + (size_t)m * DM, lane) : ld_row_bf16(hs + (size_t)m * DM, lane);
        const float r1 = rsqrtf(wave_sum(row_sumsq(v)) * (1.f / DM) + EPS);
#pragma unroll
        for (int j = 0; j < 4; ++j) h.v[j] = h.v[j] + v.v[j] * r1 * ga.v[j];
        st_row_bf16(hs + (size_t)m * DM, lane, h);
        const float r2 = rsqrtf(wave_sum(row_sumsq(h)) * (1.f / DM) + EPS);
        if (lane == 0) RS[m] = r2;
    }
}
__device__ __forceinline__ void resid_b_phase(const bf16* ff, const bf16* hs, const float* g3, bf16* HB, const float* pl, bf16* PB, int gw, int NGW, int lane, int gtid, int NGT) {
    const Row16 ga = ld_row_f32(g3, lane);
    for (int m = gw; m < M; m += NGW) {
        const Row16 v = ld_row_bf16(ff + (size_t)m * DM, lane); Row16 h = ld_row_bf16(hs + (size_t)m * DM, lane);
        const float r1 = rsqrtf(wave_sum(row_sumsq(v)) * (1.f / DM) + EPS);
#pragma unroll
        for (int j = 0; j < 4; ++j) h.v[j] = h.v[j] + v.v[j] * r1 * ga.v[j];
        st_row_bf16(HB + (size_t)m * DM, lane, h);
    }
    for (int i = gtid; i < M * PLE / 8; i += NGT) { const f32x4 a = ((const f32x4*)pl)[2 * i], b = ((const f32x4*)pl)[2 * i + 1];
        ((u32x4*)PB)[i] = (u32x4){pk2(a.x, a.y), pk2(a.z, a.w), pk2(b.x, b.y), pk2(b.z, b.w)}; }
}
__device__ __forceinline__ void resid_c_phase(const bf16* gpre, const bf16* pp, const bf16* h2, bf16* hs, float* out32, bool has_next, float* RS, int gw, int NGW, int lane) {
    for (int m = gw; m < M; m += NGW) {
        const Row16 g = ld_row_bf16(gpre + (size_t)m * DM, lane), p = ld_row_bf16(pp + (size_t)m * DM, lane); Row16 h = ld_row_bf16(h2 + (size_t)m * DM, lane);
#pragma unroll
        for (int j = 0; j < 4; ++j)
#pragma unroll
            for (int i = 0; i < 4; ++i) h.v[j][i] += p.v[j][i] * sigmoid_f(g.v[j][i]);
        if (has_next) {
            st_row_bf16(hs + (size_t)m * DM, lane, h);
            const float rstd = rsqrtf(wave_sum(row_sumsq(h)) * (1.f / DM) + EPS);
            if (lane == 0) RS[m] = rstd;
        } else st_row_f32(out32 + (size_t)m * DM, lane, h);
    }
}
__device__ __forceinline__ void conv_phase(const bf16* X1, const float* convw  , bf16* QKVA, int gw, int NGW, int lane) {
    constexpr int RPW = 32;
    for (int blk = gw; blk < M / RPW; blk += NGW) {
        const int mb = blk * RPW;
#pragma unroll 1
        for (int j = 0; j < 3; ++j) {
            const int col = j * 512 + lane * 8;
            u32x4 h0, h1, h2;
            { const bool first = (mb & (SEQ - 1)) == 0; const u32x4 z = {0u, 0u, 0u, 0u};
              h0 = first ? z : *(const u32x4*)(X1 + (size_t)(mb - 3) * 1536 + col); h1 = first ? z : *(const u32x4*)(X1 + (size_t)(mb - 2) * 1536 + col); h2 = first ? z : *(const u32x4*)(X1 + (size_t)(mb - 1) * 1536 + col); }
            f32x4 w[4][2];
#pragma unroll
            for (int kk = 0; kk < 4; ++kk) { w[kk][0] = *(const f32x4*)(convw + kk * 1536 + col); w[kk][1] = *(const f32x4*)(convw + kk * 1536 + col + 4); }
#pragma unroll 1
            for (int r4 = 0; r4 < RPW; r4 += 4) {
                u32x4 cur[4];
#pragma unroll
                for (int rr = 0; rr < 4; ++rr) cur[rr] = *(const u32x4*)(X1 + (size_t)(mb + r4 + rr) * 1536 + col);
#pragma unroll
                for (int rr = 0; rr < 4; ++rr) {
                    const int m = mb + r4 + rr;
                    const u32x4 xs[4] = {rr == 0 ? h0 : (rr == 1 ? h1 : (rr == 2 ? h2 : cur[0])), rr == 0 ? h1 : (rr == 1 ? h2 : cur[rr - 2 < 0 ? 0 : rr - 2]), rr == 0 ? h2 : cur[rr - 1 < 0 ? 0 : rr - 1], cur[rr]};
                    float acc[8];
#pragma unroll
                    for (int i = 0; i < 8; ++i) acc[i] = 0.f;
#pragma unroll
                    for (int kk = 0; kk < 4; ++kk) { const u32x4 xv = xs[kk]; const f32x4 w0 = w[kk][0], w1 = w[kk][1];
                        acc[0] += bf_lo(xv.x) * w0.x; acc[1] += bf_hi(xv.x) * w0.y; acc[2] += bf_lo(xv.y) * w0.z; acc[3] += bf_hi(xv.y) * w0.w;
                        acc[4] += bf_lo(xv.z) * w1.x; acc[5] += bf_hi(xv.z) * w1.y; acc[6] += bf_lo(xv.w) * w1.z; acc[7] += bf_hi(xv.w) * w1.w; }
                    float ss = 0.f;
#pragma unroll
                    for (int i = 0; i < 8; ++i) { acc[i] = acc[i] / (1.f + __expf(-acc[i])); ss += acc[i] * acc[i]; }
                    if (j < 2) { ss += __shfl_xor(ss, 1); ss += __shfl_xor(ss, 2); ss += __shfl_xor(ss, 4); ss += __shfl_xor(ss, 8);
                        const float sc = rsqrtf(ss + EPS) * (j == 0 ? 0.08838834764831845f : 1.f);
#pragma unroll
                        for (int i = 0; i < 8; ++i) acc[i] *= sc; }
                    *(u32x4*)(QKVA + (size_t)m * 1536 + col) = (u32x4){pk2(acc[0], acc[1]), pk2(acc[2], acc[3]), pk2(acc[4], acc[5]), pk2(acc[6], acc[7])};
                }
                h0 = cur[1]; h1 = cur[2]; h2 = cur[3];
            }
        }
    }
}
__device__ __forceinline__ void rope_phase(bf16* QKV, const f32x2* rope, int gw, int NGW, int lane) {
#pragma unroll 2
    for (int m = gw; m < M; m += NGW) {
        const int grp = lane & 7; const f32x4* tb = (const f32x4*)(rope + (size_t)m * 32 + grp * 4); const f32x4 t0 = tb[0], t1 = tb[1];
        const float cs[4] = {t0.x, t0.z, t1.x, t1.z}, sn[4] = {t0.y, t0.w, t1.y, t1.w};
#pragma unroll
        for (int k = 0; k < 3; ++k) {
            if (k == 2 && lane >= 32) break;
            const int hh = (k < 2) ? ((lane + 64 * k) >> 3) : (lane >> 3); const float scale = (k < 2) ? 0.125f : 1.f;
            bf16* base = QKV + (size_t)m * 1536 + (k < 2 ? 0 : 1024) + hh * 64 + grp * 4;
            const u32x2 a = *(const u32x2*)base, b = *(const u32x2*)(base + 32);
            const float x1[4] = {bf_lo(a.x), bf_hi(a.x), bf_lo(a.y), bf_hi(a.y)}, x2[4] = {bf_lo(b.x), bf_hi(b.x), bf_lo(b.y), bf_hi(b.y)};
            float o1[4], o2[4];
#pragma unroll
            for (int i = 0; i < 4; ++i) { o1[i] = (x1[i] * cs[i] - x2[i] * sn[i]) * scale; o2[i] = (x2[i] * cs[i] + x1[i] * sn[i]) * scale; }
            *(u32x2*)base = (u32x2){pk2(o1[0], o1[1]), pk2(o1[2], o1[3])}; *(u32x2*)(base + 32) = (u32x2){pk2(o2[0], o2[1]), pk2(o2[2], o2[3])};
        }
    }
}
typedef short bf16x8 __attribute__((ext_vector_type(8)));
typedef short v4i16_t __attribute__((ext_vector_type(4)));
#define MFMA16(a, b, c) __builtin_amdgcn_mfma_f32_16x16x32_bf16(a, b, c, 0, 0, 0)
__device__ __forceinline__ bf16x8 pack8(f32x4 a, f32x4 b) { const u32x4 w = {pk2v(a.x, a.y), pk2v(a.z, a.w), pk2v(b.x, b.y), pk2v(b.z, b.w)}; return __builtin_bit_cast(bf16x8, w); }
__device__ __forceinline__ float bf2f(unsigned short v) { return __builtin_bit_cast(float, (unsigned)v << 16); }
__device__ __forceinline__ float rdlane(float v, int i) { return __builtin_bit_cast(float, __builtin_amdgcn_readlane(__builtin_bit_cast(int, v), i)); }
__device__ __forceinline__ float scan_add(float v, int lane) {
#pragma unroll
    for (int o = 1; o < 64; o <<= 1) { const float t = __shfl_up(v, o); if (lane >= o) v += t; }
    return v; }
__device__ __forceinline__ float scan_max(float v, int lane) {
#pragma unroll
    for (int o = 1; o < 64; o <<= 1) { const float t = __shfl_up(v, o); if (lane >= o) v = fmaxf(v, t); }
    return v; }
__device__ __forceinline__ int kperm(int ks, int q, int jj) { return 32 * ks + (jj < 4 ? 4 * q + jj : 16 + 4 * q + jj - 4); }
template <bool SCALE> __device__ __forceinline__ u32x4 tr_gather(const bf16* src  , int ld, int ks, int q, float esc_lane) {
    unsigned w[4];
#pragma unroll
    for (int j2 = 0; j2 < 4; ++j2) { const int r0 = kperm(ks, q, 2 * j2), r1 = r0 + 1; const unsigned short a = src[(size_t)r0 * ld], b = src[(size_t)r1 * ld];
        if (SCALE) { const float s0 = __shfl(esc_lane, r0), s1 = __shfl(esc_lane, r1); w[j2] = pk2(bf2f(a) * s0, bf2f(b) * s1); } else w[j2] = (unsigned)a | ((unsigned)b << 16); }
    return (u32x4){w[0], w[1], w[2], w[3]};
}
__device__ __forceinline__ u32x4 scale_frag(u32x4 raw, int ks, int q, float esc_lane) {
    unsigned w[4] = {raw.x, raw.y, raw.z, raw.w};
#pragma unroll
    for (int j2 = 0; j2 < 4; ++j2) { const int r0 = kperm(ks, q, 2 * j2); const float s0 = __shfl(esc_lane, r0), s1 = __shfl(esc_lane, r0 + 1); w[j2] = pk2(bf_lo(w[j2]) * s0, bf_hi(w[j2]) * s1); }
    return (u32x4){w[0], w[1], w[2], w[3]};
}
__device__ __forceinline__ void load_scales(float esc_lane, int q, float (&sc)[2][8]) {
#pragma unroll
    for (int ks = 0; ks < 2; ++ks)
#pragma unroll
        for (int jj = 0; jj < 8; ++jj) sc[ks][jj] = __shfl(esc_lane, kperm(ks, q, jj));
}
__device__ __forceinline__ u32x4 scale_frag_pre(u32x4 raw, const float (&f)[8]) {
    return (u32x4){pk2(bf_lo(raw.x) * f[0], bf_hi(raw.x) * f[1]), pk2(bf_lo(raw.y) * f[2], bf_hi(raw.y) * f[3]), pk2(bf_lo(raw.z) * f[4], bf_hi(raw.z) * f[5]), pk2(bf_lo(raw.w) * f[6], bf_hi(raw.w) * f[7])};
}
__device__ __forceinline__ void stage_tile64(LAS unsigned char* Lb, const bf16* tb, int pitch, int x, int q) {
    u32x4 tl[16];
#pragma unroll
    for (int i = 0; i < 16; ++i) tl[i] = *(const u32x4*)(tb + (size_t)(4 * i + q) * pitch + x * 8);
#pragma unroll
    for (int i = 0; i < 16; ++i) *(LAS u32x4*)(Lb + (4 * i + q) * 256 + x * 16) = tl[i];
    LDS_WAIT();
}
__device__ __forceinline__ u32x4 tr_frag(const LAS unsigned char* Lb, int t, int ks, int x, int q) {
    const LAS unsigned char* p0 = Lb + (32 * ks + 4 * q + (x >> 2)) * 256 + (16 * t + 4 * (x & 3)) * 2;
    const v4i16_t lo = __builtin_amdgcn_ds_read_tr16_b64_v4i16((LAS v4i16_t*)p0), hi = __builtin_amdgcn_ds_read_tr16_b64_v4i16((LAS v4i16_t*)(p0 + 16 * 256));
    const bf16x8 fr = {lo[0], lo[1], lo[2], lo[3], hi[0], hi[1], hi[2], hi[3]}; return __builtin_bit_cast(u32x4, fr);
}
struct ScanBufs {
    bf16* QKVA;
    bf16* X2;
    float* Gt;
    bf16 *KT, *UT, *NW, *ATT;
    bf16 *KWT, *VT, *PT;
    float* DEN;
};
#if defined(PROBE_LSEC)
#define LSEC_BEGIN(k) do { if ((k) == PROBE_LSEC && lsec_on) { asm volatile("s_waitcnt vmcnt(0) lgkmcnt(0)" ::: "memory"); lsec_t0 = __builtin_amdgcn_s_memrealtime(); } } while (0)
#define LSEC_END(k) do { if ((k) == PROBE_LSEC && lsec_on) { asm volatile("s_waitcnt vmcnt(0) lgkmcnt(0)" ::: "memory"); lsec_acc += (unsigned)(__builtin_amdgcn_s_memrealtime() - lsec_t0); } } while (0)
#else
#define LSEC_BEGIN(k)
#define LSEC_END(k)
#endif
__device__ __forceinline__ void local_phase(LAS unsigned char* lds, const ScanBufs sb, const float* a_log, const float* dt_bias, const float* i_bias, const float* f_bias, unsigned* qctr, int gw, int NGW, int wave, int lane) {
    LAS float* Lw = (LAS float*)(lds + wave * 16384);
#if defined(PROBE_LSEC)
    const bool lsec_on = (gw == 0); unsigned long long lsec_t0 = 0; unsigned lsec_acc = 0;
#endif
    const int njobs = 2 * BATCH * 4 * (SEQ / 64); const int lane_in = lane;
#pragma unroll 1
    for (;;) {
        int job = 0; if (lane_in == 0) job = (int)__hip_atomic_fetch_add(qctr, 1u, __ATOMIC_RELAXED, __HIP_MEMORY_SCOPE_AGENT);
        job = __builtin_amdgcn_readfirstlane(job); if (job >= njobs) break;
        int lane = lane_in; asm volatile("" : "+v"(lane));
        const int x = lane & 15, q = lane >> 4;
        const int mixer = job >= njobs / 2 ? 1 : 0, cidx = mixer ? job - njobs / 2 : job, c = cidx & 31, h = (cidx >> 5) & 3, b = cidx >> 7;
        const int m0 = b * SEQ + c * 64; const size_t cid = (size_t)cidx;
        float* gr = sb.Gt + (size_t)(m0 + lane) * 16;
        if (mixer == 0) {
            LSEC_BEGIN(1);
            const float beta = 1.f / (1.f + __expf(-gr[h])); const float g = -__expf(a_log[h]) * softplus_f(gr[4 + h] + dt_bias[h]);
            const float gcum = scan_add(g, lane), eg = __expf(gcum), glast = __shfl(gcum, 63);
            LSEC_END(1); LSEC_BEGIN(2);
            const bf16* kb = sb.QKVA + (size_t)m0 * 1536 + 512 + h * 128; const bf16* qb = sb.QKVA + (size_t)m0 * 1536 + h * 128; const bf16* vb = kb + 512;
            bf16x8 Kf[4][4], Qf[4][4];
#pragma unroll
            for (int t = 0; t < 4; ++t)
#pragma unroll
                for (int ks = 0; ks < 4; ++ks) { Kf[t][ks] = *(const bf16x8*)(kb + (size_t)(16 * t + x) * 1536 + 32 * ks + 8 * q); Qf[t][ks] = *(const bf16x8*)(qb + (size_t)(16 * t + x) * 1536 + 32 * ks + 8 * q); }
            float gj[4][4];
#pragma unroll
            for (int jt = 0; jt < 4; ++jt)
#pragma unroll
                for (int r = 0; r < 4; ++r) gj[jt][r] = __shfl(gcum, 16 * jt + 4 * q + r);
            bf16* attp = sb.ATT + cid * 4096;
#pragma unroll
            for (int it = 0; it < 4; ++it) {
                const float gi = __shfl(gcum, 16 * it + x), bi = __shfl(beta, 16 * it + x); f32x4 d2s[4];
#pragma unroll
                for (int jt = 0; jt < 4; ++jt) {
                    if (jt <= it) { f32x4 D1 = {0.f, 0.f, 0.f, 0.f}, D2 = D1;
#pragma unroll
                        for (int ks = 0; ks < 4; ++ks) { D1 = MFMA16(Kf[jt][ks], Kf[it][ks], D1); D2 = MFMA16(Kf[jt][ks], Qf[it][ks], D2); }
                        f32x4 lv;
#pragma unroll
                        for (int r = 0; r < 4; ++r) { const int j = 16 * jt + 4 * q + r, i = 16 * it + x; const float dec = __expf(fminf(gi - gj[jt][r], 0.f));
                            lv[r] = (j < i) ? bi * D1[r] * dec : 0.f; d2s[jt][r] = (j <= i) ? D2[r] * dec : 0.f; }
#pragma unroll
                        for (int r = 0; r < 4; ++r) Lw[(16 * jt + 4 * q + r) * 64 + 16 * it + x] = lv[r];
                    } else d2s[jt] = (f32x4){0.f, 0.f, 0.f, 0.f};
                }
#pragma unroll
                for (int kp = 0; kp < 2; ++kp) if (it >= 2 || kp == 0) *(bf16x8*)(attp + ((it * 2 + kp) * 64 + lane) * 8) = pack8(d2s[2 * kp], d2s[2 * kp + 1]);
            }
            { float* tab = (float*)(attp + 512); tab[lane] = eg; tab[64 + lane] = __expf(glast - gcum); }
            bf16* ktp = sb.KT + cid * 8192;
            LDS_WAIT();
            LSEC_END(2); LSEC_BEGIN(3);
            float xv[64];
#pragma unroll
            for (int i = 0; i < 64; ++i) xv[i] = (i == lane) ? 1.f : 0.f;
#pragma unroll
            for (int j = 0; j < 63; ++j) {
#pragma unroll
                for (int g4 = (j + 1) / 4; g4 < 16; ++g4) { const f32x4 lc = *(const LAS f32x4*)(Lw + j * 64 + 4 * g4);
                    if (4 * g4 + 0 > j) xv[4 * g4 + 0] -= lc.x * xv[j]; if (4 * g4 + 1 > j) xv[4 * g4 + 1] -= lc.y * xv[j]; if (4 * g4 + 2 > j) xv[4 * g4 + 2] -= lc.z * xv[j]; if (4 * g4 + 3 > j) xv[4 * g4 + 3] -= lc.w * xv[j]; }
            }
            LDS_WAIT();
            LSEC_END(3); LSEC_BEGIN(4);
            { LAS unsigned short* TL = (LAS unsigned short*)Lw;
#pragma unroll
              for (int i = 0; i < 64; ++i) TL[i * 64 + ((((lane >> 3) ^ (i & 7)) << 3) | (lane & 7))] = (unsigned short)(pk2(xv[i], 0.f) & 0xffffu); }
            LDS_WAIT();
            bf16x8 Tf[4][2];
#pragma unroll
            for (int it = 0; it < 4; ++it)
#pragma unroll
                for (int ks = 0; ks < 2; ++ks) { const int row = 16 * it + x; const LAS unsigned char* tb = (const LAS unsigned char*)Lw + row * 128;
                    const int c0 = 32 * ks + 4 * q, c1 = c0 + 16;
                    const u32x2 lo = *(const LAS u32x2*)(tb + ((((c0 >> 3) ^ (row & 7)) << 4) | ((c0 & 7) << 1))), hi = *(const LAS u32x2*)(tb + ((((c1 >> 3) ^ (row & 7)) << 4) | ((c1 & 7) << 1)));
                    const u32x4 w = {lo.x, lo.y, hi.x, hi.y}; Tf[it][ks] = __builtin_bit_cast(bf16x8, w); }
            const float be = beta * eg;
            LSEC_END(4); LSEC_BEGIN(5);
            bf16* utp = sb.UT + cid * 8192;
            float scb[2][8], scbe[2][8]; load_scales(beta, q, scb); load_scales(be, q, scbe);
            LDS_WAIT(); stage_tile64((LAS unsigned char*)Lw, vb, 1536, x, q);
#pragma unroll 4
            for (int et = 0; et < 8; ++et) {
                bf16x8 vfr[2];
#pragma unroll
                for (int ks = 0; ks < 2; ++ks) { const u32x4 gth = scale_frag_pre(tr_frag((const LAS unsigned char*)Lw, et, ks, x, q), scb[ks]); vfr[ks] = __builtin_bit_cast(bf16x8, gth); }
#pragma unroll
                for (int mt = 0; mt < 4; ++mt) { f32x4 acc = {0.f, 0.f, 0.f, 0.f};
#pragma unroll
                    for (int ks = 0; ks < 2; ++ks) acc = MFMA16(Tf[mt][ks], vfr[ks], acc);
                    *(u32x2*)(utp + (size_t)(16 * et + x) * 64 + 16 * mt + 4 * q) = (u32x2){pk2v(acc.x, acc.y), pk2v(acc.z, acc.w)}; }
            }
            LSEC_END(5); LSEC_BEGIN(6);
            bf16* nwp = sb.NW + cid * 8192;
            LDS_WAIT(); stage_tile64((LAS unsigned char*)Lw, kb, 1536, x, q);
#pragma unroll 2
            for (int kp2 = 0; kp2 < 4; ++kp2) {
                bf16x8 kfr[2][2];
#pragma unroll
                for (int dd = 0; dd < 2; ++dd)
#pragma unroll
                    for (int ks = 0; ks < 2; ++ks) { const int dt = 2 * kp2 + dd; const u32x4 raw = tr_frag((const LAS unsigned char*)Lw, dt, ks, x, q);
                        *(u32x4*)(ktp + ((dt * 2 + ks) * 64 + lane) * 8) = raw;
                        kfr[dd][ks] = __builtin_bit_cast(bf16x8, scale_frag_pre(raw, scbe[ks])); }
#pragma unroll
                for (int it = 0; it < 4; ++it) { f32x4 a0 = {0.f, 0.f, 0.f, 0.f}, a1 = a0;
#pragma unroll
                    for (int ks = 0; ks < 2; ++ks) { a0 = MFMA16(kfr[0][ks], Tf[it][ks], a0); a1 = MFMA16(kfr[1][ks], Tf[it][ks], a1); }
                    a0 = a0 * -1.f; a1 = a1 * -1.f;
                    *(u32x4*)(nwp + ((it * 4 + kp2) * 64 + lane) * 8) = (u32x4){pk2v(a0.x, a0.y), pk2v(a0.z, a0.w), pk2v(a1.x, a1.y), pk2v(a1.z, a1.w)}; }
            }
            LDS_WAIT();
            LSEC_END(6);
        } else {
            LSEC_BEGIN(7);
            LSEC_BEGIN(8);
            const float il = gr[8 + h] + i_bias[h]; const float fl = -softplus_f(-(gr[12 + h] + f_bias[h]));
            const float bcum = scan_add(fl, lane), t = il - bcum, pm = scan_max(t, lane), pml = __shfl(pm, 63);
            const float esc = __expf(t - pml);
            LSEC_END(8);
            LSEC_BEGIN(9);
            const bf16* qb = sb.X2 + (size_t)m0 * 2560 + 512 + h * 128; const bf16* kb = qb + 512; const bf16* vb = kb + 512;
            bf16x8 Kf[4][4], Qf[4][4];
#pragma unroll
            for (int tt = 0; tt < 4; ++tt)
#pragma unroll
                for (int ks = 0; ks < 4; ++ks) { Kf[tt][ks] = *(const bf16x8*)(kb + (size_t)(16 * tt + x) * 2560 + 32 * ks + 8 * q); Qf[tt][ks] = *(const bf16x8*)(qb + (size_t)(16 * tt + x) * 2560 + 32 * ks + 8 * q); }
            float tj[4][4];
#pragma unroll
            for (int jt = 0; jt < 4; ++jt)
#pragma unroll
                for (int r = 0; r < 4; ++r) tj[jt][r] = __shfl(t, 16 * jt + 4 * q + r);
            bf16* ptp = sb.PT + cid * 4096;
#pragma unroll
            for (int it = 0; it < 4; ++it) {
                const float pmi = __shfl(pm, 16 * it + x); f32x4 d2s[4];
#pragma unroll
                for (int jt = 0; jt < 4; ++jt) {
                    if (jt <= it) { f32x4 D2 = {0.f, 0.f, 0.f, 0.f};
#pragma unroll
                        for (int ks = 0; ks < 4; ++ks) D2 = MFMA16(Kf[jt][ks], Qf[it][ks], D2);
#pragma unroll
                        for (int r = 0; r < 4; ++r) { const int j = 16 * jt + 4 * q + r, i = 16 * it + x; d2s[jt][r] = (j <= i) ? D2[r] * 0.08838834764831845f * __expf(fminf(tj[jt][r] - pmi, 0.f)) : 0.f; }
                    } else d2s[jt] = (f32x4){0.f, 0.f, 0.f, 0.f};
                }
#pragma unroll
                for (int kp = 0; kp < 2; ++kp) if (it >= 2 || kp == 0) *(bf16x8*)(ptp + ((it * 2 + kp) * 64 + lane) * 8) = pack8(d2s[2 * kp], d2s[2 * kp + 1]);
            }
            { float* tab = (float*)(ptp + 512); tab[lane] = bcum; tab[64 + lane] = bcum + pm; }
            LSEC_END(9); LSEC_BEGIN(10);
            bf16* kwp = sb.KWT + cid * 8192; bf16* vtp = sb.VT + cid * 8192;
            float sce[2][8]; load_scales(esc, q, sce);
#pragma unroll 1
            for (int tv = 0; tv < 2; ++tv) {
                const bf16* tb = tv == 0 ? kb : vb; bf16* dstp = tv == 0 ? kwp : vtp;
                stage_tile64((LAS unsigned char*)Lw, tb, 2560, x, q);
#pragma unroll
                for (int dt = 0; dt < 8; ++dt)
#pragma unroll
                    for (int kp = 0; kp < 2; ++kp) { const u32x4 raw = tr_frag((const LAS unsigned char*)Lw, dt, kp, x, q);
                        *(u32x4*)(dstp + ((dt * 2 + kp) * 64 + lane) * 8) = tv == 0 ? scale_frag_pre(raw, sce[kp]) : raw; }
                LDS_WAIT();
            }
            LSEC_END(10);
            LSEC_END(7);
        }
    }
#if defined(PROBE_LSEC)
    if (lsec_on && lane == 0) ((volatile LAS unsigned*)(lds + 131072))[22] += lsec_acc;
#endif
}
#if defined(PROBE_RSEC)
#define RSEC_BEGIN(k) do { if ((k) == PROBE_RSEC && rsec_on) { asm volatile("s_waitcnt lgkmcnt(0)" ::: "memory"); rsec_t0 = __builtin_amdgcn_s_memrealtime(); } } while (0)
#define RSEC_END(k) do { if ((k) == PROBE_RSEC && rsec_on) { asm volatile("s_waitcnt lgkmcnt(0)" ::: "memory"); rsec_acc += (unsigned)(__builtin_amdgcn_s_memrealtime() - rsec_t0); } } while (0)
#else
#define RSEC_BEGIN(k)
#define RSEC_END(k)
#endif
constexpr int RC_NW = 0, RC_ATT = 16384, RC_KT = 24576, RC_QP = 40960, RC_BUF = 57344;
__device__ __forceinline__ void recur_stage(LAS unsigned char* buf, const bf16* f16a  , const bf16* f8  , const bf16* f16b  , const bf16* qbase  , int qpitch, int wave, int lane) {
#pragma unroll
    for (int k = 0; k < 5; ++k) { const int bl = wave + 8 * k;
        const bf16* src = bl < 16 ? f16a + bl * 512 : (bl < 24 ? f8 + (bl - 16) * 512 : f16b + (bl - 24) * 512);
        __builtin_amdgcn_global_load_lds((const unsigned*)(src + lane * 8), (LAS unsigned*)(buf + bl * 1024), 16, 0, 0); }
#pragma unroll
    for (int k = 0; k < 8; ++k) { const int P = (wave * 8 + k) * 256 + lane * 4, f = P >> 10, lp = (P & 1023) >> 4, jj0 = ((P & 15) >> 2) * 2, it = f >> 2, ks = f & 3, xp = lp & 15, qp = lp >> 4;
        const bf16* src = qbase + (size_t)(16 * it + xp) * qpitch + kperm(ks, qp, jj0);
        __builtin_amdgcn_global_load_lds((const unsigned*)src, (LAS unsigned*)(buf + RC_QP + (wave * 8 + k) * 256), 4, 0, 0); }
}
__device__ __forceinline__ void recur_phase(LAS unsigned char* lds, const ScanBufs sb, int G, int bid, int wave, int lane) {
    const int x = lane & 15, q = lane >> 4, et = wave;
#if defined(PROBE_RSEC)
    const bool rsec_on = (bid == 0 && wave == 0); unsigned long long rsec_t0 = 0; unsigned rsec_acc = 0;
#endif
#pragma unroll 1
    for (int u = bid; u < 2 * BATCH * 4; u += G) {
        const int mixer = u >> 7, b = (u & 127) >> 2, h = u & 3;
        const size_t cid0 = (size_t)((b * 4 + h) * 32);
        if (mixer == 0) {
            f32x4 S[8];
#pragma unroll
            for (int d = 0; d < 8; ++d) S[d] = (f32x4){0.f, 0.f, 0.f, 0.f};
            recur_stage(lds, sb.NW + cid0 * 8192, sb.ATT + cid0 * 4096, sb.KT + cid0 * 8192, sb.QKVA + (size_t)(b * SEQ) * 1536 + h * 128, 1536, wave, lane);
            __syncthreads();
            u32x2 uun[4];
#pragma unroll
            for (int mt = 0; mt < 4; ++mt) uun[mt] = *(const u32x2*)(sb.UT + cid0 * 8192 + (size_t)(16 * et + x) * 64 + 16 * mt + 4 * q);
#pragma unroll 1
            for (int c = 0; c < SEQ / 64; ++c) {
                RSEC_BEGIN(1);
                const int m0 = b * SEQ + c * 64; const size_t cid = cid0 + c;
                const LAS unsigned char* buf = lds + (c & 1) * RC_BUF;
                { const int cn = c + 1 < SEQ / 64 ? c + 1 : c; const size_t cidn = cid0 + cn;
                  recur_stage(lds + ((c + 1) & 1) * RC_BUF, sb.NW + cidn * 8192, sb.ATT + cidn * 4096, sb.KT + cidn * 8192, sb.QKVA + (size_t)(b * SEQ + cn * 64) * 1536 + h * 128, 1536, wave, lane); }
                RSEC_END(1); RSEC_BEGIN(2);
                const LAS float* tab = (const LAS float*)(buf + RC_ATT + 1024);
                bf16x8 Sb[4];
#pragma unroll
                for (int ks = 0; ks < 4; ++ks) Sb[ks] = pack8(S[2 * ks], S[2 * ks + 1]);
                f32x4 vn[4];
                { bf16x8 fr[16]; u32x2 uu[4];
#pragma unroll
                  for (int i = 0; i < 16; ++i) fr[i] = *(const LAS bf16x8*)(buf + RC_NW + (i * 64 + lane) * 16);
                  { const int cn = c + 1 < SEQ / 64 ? c + 1 : c; const bf16* utn = sb.UT + (cid0 + cn) * 8192 + (size_t)(16 * et + x) * 64;
#pragma unroll
                    for (int mt = 0; mt < 4; ++mt) { uu[mt] = uun[mt]; uun[mt] = *(const u32x2*)(utn + 16 * mt + 4 * q); } }
                  __builtin_amdgcn_sched_barrier(0);
#pragma unroll
                  for (int mt = 0; mt < 4; ++mt) { f32x4 acc = {bf_lo(uu[mt].x), bf_hi(uu[mt].x), bf_lo(uu[mt].y), bf_hi(uu[mt].y)};
#pragma unroll
                    for (int ks = 0; ks < 4; ++ks) acc = MFMA16(fr[mt * 4 + ks], Sb[ks], acc);
                    vn[mt] = acc; } }
                RSEC_END(2); RSEC_BEGIN(3);
                bf16x8 vb2[2] = {pack8(vn[0], vn[1]), pack8(vn[2], vn[3])};
                bf16x8 fq[16], fa[8]; float egl[4];
#pragma unroll
                for (int i = 0; i < 16; ++i) fq[i] = *(const LAS bf16x8*)(buf + RC_QP + (i * 64 + lane) * 16);
#pragma unroll
                for (int i = 0; i < 8; ++i) if (i >= 4 || (i & 1) == 0) fa[i] = *(const LAS bf16x8*)(buf + RC_ATT + (i * 64 + lane) * 16);
#pragma unroll
                for (int it = 0; it < 4; ++it) egl[it] = tab[16 * it + x];
                __builtin_amdgcn_sched_barrier(0);
#pragma unroll
                for (int it = 0; it < 4; ++it) { f32x4 acc = {0.f, 0.f, 0.f, 0.f};
#pragma unroll
                    for (int ks = 0; ks < 4; ++ks) acc = MFMA16(Sb[ks], fq[it * 4 + ks], acc);
                    acc = acc * egl[it];
#pragma unroll
                    for (int kp = 0; kp < 2; ++kp) if (it >= 2 || kp == 0) acc = MFMA16(vb2[kp], fa[it * 2 + kp], acc);
                    *(u32x2*)(sb.QKVA + (size_t)(m0 + 16 * it + x) * 1536 + 512 + h * 128 + 16 * et + 4 * q) = (u32x2){pk2v(acc.x, acc.y), pk2v(acc.z, acc.w)}; }
                RSEC_END(3); RSEC_BEGIN(4);
                f32x4 vs[4];
#pragma unroll
                for (int mt = 0; mt < 4; ++mt) { const f32x4 kk = *(const LAS f32x4*)(tab + 64 + 16 * mt + 4 * q); vs[mt] = vn[mt] * kk; }
                const bf16x8 vsb[2] = {pack8(vs[0], vs[1]), pack8(vs[2], vs[3])};
                const float gam = tab[63];
                { bf16x8 fk[16];
#pragma unroll
                  for (int i = 0; i < 16; ++i) fk[i] = *(const LAS bf16x8*)(buf + RC_KT + (i * 64 + lane) * 16);
                  __builtin_amdgcn_sched_barrier(0);
#pragma unroll
                  for (int dt = 0; dt < 8; ++dt) { f32x4 acc = S[dt] * gam;
#pragma unroll
                    for (int kp = 0; kp < 2; ++kp) acc = MFMA16(fk[dt * 2 + kp], vsb[kp], acc);
                    S[dt] = acc; } }
                RSEC_END(4); RSEC_BEGIN(5);
                __syncthreads();
                RSEC_END(5);
            }
        } else {
            f32x4 Cs[8], Ce[8]; float mrun = 0.f;
#pragma unroll
            for (int d = 0; d < 8; ++d) { Cs[d] = (f32x4){0.f, 0.f, 0.f, 0.f}; Ce[d] = Cs[d]; }
            const short one = (x == 0) ? (short)0x3F80 : (short)0; const bf16x8 ones = {one, one, one, one, one, one, one, one};
            recur_stage(lds, sb.KWT + cid0 * 8192, sb.PT + cid0 * 4096, sb.KWT + cid0 * 8192, sb.X2 + (size_t)(b * SEQ) * 2560 + 512 + h * 128, 2560, wave, lane);
            __syncthreads();
            bf16x8 vfn[2] = {*(const bf16x8*)(sb.VT + cid0 * 8192 + ((et * 2 + 0) * 64 + lane) * 8), *(const bf16x8*)(sb.VT + cid0 * 8192 + ((et * 2 + 1) * 64 + lane) * 8)};
#pragma unroll 1
            for (int c = 0; c < SEQ / 64; ++c) {
                const int m0 = b * SEQ + c * 64; const size_t cid = cid0 + c;
                const LAS unsigned char* buf = lds + (c & 1) * RC_BUF;
                { const int cn = c + 1 < SEQ / 64 ? c + 1 : c; const size_t cidn = cid0 + cn;
                  recur_stage(lds + ((c + 1) & 1) * RC_BUF, sb.KWT + cidn * 8192, sb.PT + cidn * 4096, sb.KWT + cidn * 8192, sb.X2 + (size_t)(b * SEQ + cn * 64) * 2560 + 512 + h * 128, 2560, wave, lane); }
                const LAS float* tab = (const LAS float*)(buf + RC_ATT + 1024);
                bf16x8 Cb[4], Eb[4];
#pragma unroll
                for (int ks = 0; ks < 4; ++ks) { Cb[ks] = pack8(Cs[2 * ks], Cs[2 * ks + 1]); Eb[ks] = pack8(Ce[2 * ks], Ce[2 * ks + 1]); }
                const bf16x8 vf[2] = {vfn[0], vfn[1]};
                { const int cn = c + 1 < SEQ / 64 ? c + 1 : c; const bf16* vtn = sb.VT + (cid0 + cn) * 8192; vfn[0] = *(const bf16x8*)(vtn + ((et * 2 + 0) * 64 + lane) * 8); vfn[1] = *(const bf16x8*)(vtn + ((et * 2 + 1) * 64 + lane) * 8); }
#pragma unroll
                for (int it = 0; it < 4; ++it) {
                    bf16x8 fq[16], fp[8];
#pragma unroll
                    for (int ks = 0; ks < 4; ++ks) fq[it * 4 + ks] = *(const LAS bf16x8*)(buf + RC_QP + ((it * 4 + ks) * 64 + lane) * 16);
#pragma unroll
                    for (int kp = 0; kp < 2; ++kp) if (it >= 2 || kp == 0) fp[it * 2 + kp] = *(const LAS bf16x8*)(buf + RC_ATT + ((it * 2 + kp) * 64 + lane) * 16);
                    const float bc = tab[16 * it + x], mi = tab[64 + 16 * it + x];
                    __builtin_amdgcn_sched_barrier(0);
                    const float a = bc + mrun, mt = fmaxf(a, mi), f1 = __expf(a - mt) * 0.08838834764831845f, f2 = __expf(mi - mt);
                    f32x4 a1 = {0.f, 0.f, 0.f, 0.f}, aP = a1, e1 = a1, eP = a1;
#pragma unroll
                    for (int ks = 0; ks < 4; ++ks) { const bf16x8 qf = fq[it * 4 + ks];
                        a1 = MFMA16(Cb[ks], qf, a1); if (wave == 0) e1 = MFMA16(Eb[ks], qf, e1); }
#pragma unroll
                    for (int kp = 0; kp < 2; ++kp) if (it >= 2 || kp == 0) { const bf16x8 pf = fp[it * 2 + kp]; aP = MFMA16(vf[kp], pf, aP); if (wave == 0) eP = MFMA16(ones, pf, eP); }
                    const f32x4 nm = a1 * f1 + aP * f2;
                    *(u32x2*)(sb.X2 + (size_t)(m0 + 16 * it + x) * 2560 + 1024 + h * 128 + 16 * et + 4 * q) = (u32x2){pk2(nm.x, nm.y), pk2(nm.z, nm.w)};
                    if (wave == 0 && q == 0) sb.DEN[(size_t)(m0 + 16 * it + x) * 4 + h] = fmaxf(fabsf(e1.x * f1 + eP.x * f2), __expf(-mt));
                }
                const float blast = tab[63], wsmax = tab[127];
                const float mnew = fmaxf(blast + mrun, wsmax), sc = __expf(blast + mrun - mnew), s2 = __expf(wsmax - mnew); mrun = mnew;
                bf16x8 fk[16];
#pragma unroll
                for (int i = 0; i < 16; ++i) fk[i] = *(const LAS bf16x8*)(buf + RC_KT + (i * 64 + lane) * 16);
                __builtin_amdgcn_sched_barrier(0);
#pragma unroll
                for (int dt = 0; dt < 8; ++dt) { f32x4 dC = {0.f, 0.f, 0.f, 0.f}, dE = dC;
#pragma unroll
                    for (int kp = 0; kp < 2; ++kp) { const bf16x8 kf = fk[dt * 2 + kp]; dC = MFMA16(kf, vf[kp], dC); if (wave == 0) dE = MFMA16(kf, ones, dE); }
                    Cs[dt] = Cs[dt] * sc + dC * s2; if (wave == 0) Ce[dt] = Ce[dt] * sc + dE * s2; }
                __syncthreads();
            }
        }
    }
#if defined(PROBE_RSEC)
    if (rsec_on && lane == 0) ((volatile LAS unsigned*)(lds + 131072))[22] += rsec_acc;
#endif
}
__device__ __forceinline__ void post_phase(const ScanBufs sb, const float* norm_a, const float* norm_b, bf16* MIXED, int gw, int NGW, int lane) {
    const int hh = lane >> 3, sub = (lane & 7) * 16;
#pragma unroll 2
    for (int m = gw; m < M; m += NGW) {
        const bool isA = hh < 4; const int h = hh & 3;
        const bf16* src = isA ? sb.QKVA + (size_t)m * 1536 + 512 + h * 128 + sub : sb.X2 + (size_t)m * 2560 + 1024 + h * 128 + sub;
        const bf16* gsrc = sb.X2 + (size_t)m * 2560 + (isA ? 0 : 2048) + h * 128 + sub;
        const float* gn = (isA ? norm_a : norm_b + h * 128) + sub;
        const u32x4 r0 = *(const u32x4*)src, r1 = *(const u32x4*)(src + 8), z0 = *(const u32x4*)gsrc, z1 = *(const u32x4*)(gsrc + 8);
        float v[16] = {bf_lo(r0.x), bf_hi(r0.x), bf_lo(r0.y), bf_hi(r0.y), bf_lo(r0.z), bf_hi(r0.z), bf_lo(r0.w), bf_hi(r0.w), bf_lo(r1.x), bf_hi(r1.x), bf_lo(r1.y), bf_hi(r1.y), bf_lo(r1.z), bf_hi(r1.z), bf_lo(r1.w), bf_hi(r1.w)};
        const float z[16] = {bf_lo(z0.x), bf_hi(z0.x), bf_lo(z0.y), bf_hi(z0.y), bf_lo(z0.z), bf_hi(z0.z), bf_lo(z0.w), bf_hi(z0.w), bf_lo(z1.x), bf_hi(z1.x), bf_lo(z1.y), bf_hi(z1.y), bf_lo(z1.z), bf_hi(z1.z), bf_lo(z1.w), bf_hi(z1.w)};
        const float dinv = isA ? 1.f : 1.f / sb.DEN[(size_t)m * 4 + h];
        float ss = 0.f;
#pragma unroll
        for (int i = 0; i < 16; ++i) { v[i] *= dinv; ss += v[i] * v[i]; }
        ss += __shfl_xor(ss, 1); ss += __shfl_xor(ss, 2); ss += __shfl_xor(ss, 4);
        const float rstd = rsqrtf(ss * (1.f / 128.f) + EPS);
        float y[16];
#pragma unroll
        for (int i = 0; i < 16; ++i) { const float sg = sigmoid_f(z[i]); y[i] = v[i] * rstd * gn[i] * (isA ? z[i] * sg : sg); }
        u32x4* dst = (u32x4*)(MIXED + (size_t)m * 1024 + lane * 16);
        dst[0] = (u32x4){pk2(y[0], y[1]), pk2(y[2], y[3]), pk2(y[4], y[5]), pk2(y[6], y[7])}; dst[1] = (u32x4){pk2(y[8], y[9]), pk2(y[10], y[11]), pk2(y[12], y[13]), pk2(y[14], y[15])};
    }
}
typedef short v4i16_t __attribute__((ext_vector_type(4)));
constexpr int AT_VROW = 80;
constexpr int AT_K_BYTES = 256 * 128, AT_V_BYTES = 272 * AT_VROW * 2;
__device__ __forceinline__ void attn_phase(LAS unsigned char* lds, int tid, int wave, const bf16* QKV, const float* sinks, bf16* O, int G, int bid) {
    LAS unsigned char* KL = lds; LAS unsigned char* VL = lds + AT_K_BYTES;
    const int lane = tid & 63, x = lane & 15, q = lane >> 4, g = wave >> 1, qh = wave & 1;
    u32x4 kreg[4], vreg[4];
#define AT_LOAD_KV(uu) do { const int b_ = (uu) >> 6, kvh_ = ((uu) >> 4) & 3, jb_ = (uu) & 15; _Pragma("unroll") for (int i = 0; i < 4; ++i) { const int item = tid + 512 * i, r = item >> 3, ch = item & 7, sk = (jb_ - 1) * 128 + r; \
        kreg[i] = (u32x4){0u, 0u, 0u, 0u}; vreg[i] = kreg[i]; if (sk >= 0) { const bf16* src = QKV + (size_t)(b_ * SEQ + sk) * 1536 + 1024 + kvh_ * 64 + ch * 8; kreg[i] = *(const u32x4*)src; vreg[i] = *(const u32x4*)(src + 256); } } } while (0)
    if (bid < BATCH * 4 * 16) AT_LOAD_KV(bid);
#pragma unroll 1
    for (int u = bid; u < BATCH * 4 * 16; u += G) {
        const int b = u >> 6, kvh = (u >> 4) & 3, jb = u & 15;
#pragma unroll
        for (int i = 0; i < 4; ++i) { const int item = tid + 512 * i, r = item >> 3, ch = item & 7;
            *(LAS u32x4*)(KL + r * 128 + ((ch ^ (r & 7)) << 4)) = kreg[i]; *(LAS u32x4*)(VL + r * (AT_VROW * 2) + ch * 16) = vreg[i]; }
        if (tid < 128) { const int r = 256 + (tid >> 3), ch = tid & 7; unsigned z0 = 0u; asm volatile("" : "+v"(z0));
            *(LAS u32x4*)(VL + r * (AT_VROW * 2) + ch * 16) = (u32x4){z0, z0, z0, z0}; }
        __syncthreads();
        if (u + G < BATCH * 4 * 16) AT_LOAD_KV(u + G);
        const int hq = kvh * 4 + g; const float sink = sinks[hq];
        const size_t mq = (size_t)b * SEQ + jb * 128 + 64 * qh;
        bf16x8 Qn[2];
#pragma unroll
        for (int ks = 0; ks < 2; ++ks) Qn[ks] = *(const bf16x8*)(QKV + (mq + x) * 1536 + hq * 64 + 32 * ks + 8 * q);
#pragma unroll 1
        for (int nt = 0; nt < 4; ++nt) {
            const bf16x8 Qf[2] = {Qn[0], Qn[1]};
            { const int nn = nt < 3 ? nt + 1 : 3;
#pragma unroll
              for (int ks = 0; ks < 2; ++ks) Qn[ks] = *(const bf16x8*)(QKV + (mq + 16 * nn + x) * 1536 + hq * 64 + 32 * ks + 8 * q); }
            f32x4 s[9]; float mx = -3.0e38f;
            bf16x8 kf[9][2];
#pragma unroll
            for (int j = 0; j < 9; ++j) { const int r = 64 * qh + 16 * (nt + j) + x;
#pragma unroll
                for (int ks = 0; ks < 2; ++ks) kf[j][ks] = *(const LAS bf16x8*)(KL + r * 128 + (((4 * ks + q) ^ (r & 7)) << 4)); }
            __builtin_amdgcn_sched_barrier(0);
#pragma unroll
            for (int j = 0; j < 9; ++j) { const int kt = nt + j;
                f32x4 acc = {0.f, 0.f, 0.f, 0.f};
#pragma unroll
                for (int ks = 0; ks < 2; ++ks) acc = MFMA16(kf[j][ks], Qf[ks], acc);
#pragma unroll
                for (int rg = 0; rg < 4; ++rg) { const int diff = 16 * j + 4 * q + rg - x, ra = 64 * qh + 16 * kt + 4 * q + rg;
                    const bool valid = diff >= 1 && diff <= 128 && (jb - 1) * 128 + ra >= 0;
                    acc[rg] = valid ? acc[rg] : -3.0e38f; mx = fmaxf(mx, acc[rg]); }
                s[j] = acc; }
            mx = fmaxf(mx, __shfl_xor(mx, 16)); mx = fmaxf(mx, __shfl_xor(mx, 32)); mx = fmaxf(mx, sink);
            float sum = 0.f;
#pragma unroll
            for (int j = 0; j < 9; ++j)
#pragma unroll
                for (int rg = 0; rg < 4; ++rg) { const float p = (s[j][rg] > -1.0e38f) ? __expf(s[j][rg] - mx) : 0.f; s[j][rg] = p; sum += p; }
            sum += __shfl_xor(sum, 16); sum += __shfl_xor(sum, 32);
            const float inv = 1.f / (sum + __expf(sink - mx));
            bf16x8 Pf[5];
#pragma unroll
            for (int j2 = 0; j2 < 4; ++j2) Pf[j2] = pack8(s[2 * j2], s[2 * j2 + 1]);
            Pf[4] = pack8(s[8], (f32x4){0.f, 0.f, 0.f, 0.f});
            bf16x8 vf[4][5];
#pragma unroll
            for (int dt = 0; dt < 4; ++dt)
#pragma unroll
                for (int j2 = 0; j2 < 5; ++j2) { const int kb = 64 * qh + 16 * (nt + 2 * j2) + 4 * q + (x >> 2);
                    const LAS unsigned char* p0 = VL + kb * (AT_VROW * 2) + (16 * dt + 4 * (x & 3)) * 2;
                    const v4i16_t lo = __builtin_amdgcn_ds_read_tr16_b64_v4i16((LAS v4i16_t*)p0), hi = __builtin_amdgcn_ds_read_tr16_b64_v4i16((LAS v4i16_t*)(p0 + 16 * AT_VROW * 2));
                    vf[dt][j2] = (bf16x8){lo[0], lo[1], lo[2], lo[3], hi[0], hi[1], hi[2], hi[3]}; }
            __builtin_amdgcn_sched_barrier(0);
#pragma unroll
            for (int dt = 0; dt < 4; ++dt) { f32x4 acc = {0.f, 0.f, 0.f, 0.f};
#pragma unroll
                for (int j2 = 0; j2 < 5; ++j2) acc = MFMA16(vf[dt][j2], Pf[j2], acc);
                acc = acc * inv;
                *(u32x2*)(O + (mq + 16 * nt + x) * 1024 + hq * 64 + 16 * dt + 4 * q) = (u32x2){pk2v(acc.x, acc.y), pk2v(acc.z, acc.w)}; }
        }
        __syncthreads();
    }
}
#ifndef N_LAUNCH_MODE
#define N_LAUNCH_MODE 0
#endif
__global__ void __launch_bounds__(NTHR, 2) trunk_fwd(Args a_unused) {
    extern __shared__ __attribute__((aligned(16))) unsigned char lds_raw[];
    LAS unsigned char* lds = (LAS unsigned char*)lds_raw;
    volatile LAS unsigned* MISC = (volatile LAS unsigned*)(lds + MISC_OFF);
    if (threadIdx.x < 64) MISC[threadIdx.x] = 0u;
    __syncthreads();
    int lo, hi; XcdBarrier bar;
    int dupm = 0, dupp = 0; (void)dupm; (void)dupp;
    { KArgs a = kargs(); lo = a->ph_lo; hi = a->ph_hi; dupm = a->dup_mask; dupp = a->dup_par; unsigned* ctl = (unsigned*)(a->ws + WS_CTL);
      bar.bar = ctl + CW_BAR; bar.x = 0; bar.st = MISC + 8;
      if (hi - lo > 1) bar = xcd_barrier_post(ctl + CW_BAR, MISC + 8); }
#define IN(k) (lo <= (k) && (k) < hi)
#if defined(PROBE_STAMP)
#define PH_T0(k) do { if ((k) == PROBE_STAMP && (L & 1) == PROBE_STAMP_PAR && blockIdx.x == 0 && threadIdx.x == 0) { const unsigned long long t_ = __builtin_amdgcn_s_memrealtime(); MISC[20] = (unsigned)t_; MISC[21] = (unsigned)(t_ >> 32); } } while (0)
#define PH_T1(k) do { if ((k) == PROBE_STAMP && (L & 1) == PROBE_STAMP_PAR && blockIdx.x == 0 && threadIdx.x == 0) { const unsigned long long t_ = __builtin_amdgcn_s_memrealtime(); const unsigned long long s_ = ((unsigned long long)MISC[21] << 32) | MISC[20]; MISC[22] += (unsigned)(t_ - s_); } } while (0)
#else
#define PH_T0(k)
#define PH_T1(k)
#endif
#if defined(PROBE_DUP_MASK)
#define REP(k) _Pragma("unroll 1") for (int rep_ = 0; rep_ <= (((dupm >> (k)) & 1) && (dupp == 0 || dupp == 1 + (L & 1)) ? 1 : 0); ++rep_)
#else
#define REP(k)
#endif
#if defined(PROBE_BAR2)
#define SEAM(k) do { if (IN(k) && IN((k) + 1)) { xcd_barrier(bar); xcd_barrier(bar); } } while (0)
#else
#define SEAM(k) do { if (IN(k) && IN((k) + 1)) xcd_barrier(bar); } while (0)
#endif
#define ENV KArgs a = kargs(); const int tid = fresh_tid(), lane = tid & 63, wave = __builtin_amdgcn_readfirstlane(tid >> 6); const int G = gridDim.x, bid = blockIdx.x, gw = bid * NWAVES + wave, NGW = G * NWAVES, gtid = bid * NTHR + tid, NGT = G * NTHR; \
    unsigned char* ws = a->ws; bf16* RA = (bf16*)(ws + WS_RA); bf16* RB = (bf16*)(ws + WS_RB); bf16* RC = (bf16*)(ws + WS_RC); bf16* RD = (bf16*)(ws + WS_RD); float* Gt = (float*)(ws + WS_GT); \
    (void)lane; (void)wave; (void)gw; (void)NGW; (void)gtid; (void)NGT; (void)RA; (void)RB; (void)RC; (void)RD; (void)Gt; (void)G; (void)bid

    if (IN(0)) { ENV; prologue_phase(a, lds, gw, NGW, wave, lane, gtid, NGT);
#if defined(PROBE_DUP_MASK)
        if (dupm & (1 << 20)) prologue_phase(a, lds, gw, NGW, wave, lane, gtid, NGT);
#endif
    }
    SEAM(0);
#define SCANBUFS ScanBufs sb; sb.QKVA = (bf16*)(ws + WS_QKVA); sb.X2 = (bf16*)(ws + WS_X2); sb.Gt = Gt; sb.KT = (bf16*)(ws + WS_KT); sb.UT = (bf16*)(ws + WS_UT); sb.NW = (bf16*)(ws + WS_NW); sb.ATT = (bf16*)(ws + WS_ATT); \
    sb.KWT = (bf16*)(ws + WS_KWT); sb.VT = (bf16*)(ws + WS_VT); sb.PT = (bf16*)(ws + WS_PT); sb.DEN = (float*)(ws + WS_DEN)
#pragma unroll 1
    for (int L = 0; L < DEPTH; ++L) {
        const int pb = 1 + L * PH_PER_LAYER; const bool even = (L & 1) == 0; const int e = L >> 1;
        PH_T0(0);
        if (L == 0 && IN(pb + 0)) REP(0) { ENV; const float* hin = a->x;
            norm_phase(hin, (bf16*)a->out, (float*)(ws + WS_PS0), gw, NGW, lane); }
        if (L == 0) SEAM(pb + 0);
        PH_T1(0);
        PH_T0(1);
        if (IN(pb + 1)) REP(1) { ENV;
            const int N = even ? NINP : 1536;
            pg8::Gemm g{(const bf16*)a->out, even ? (const bf16*)(ws + WS_WIN) + (size_t)e * NINP * 1024 : (const bf16*)(ws + WS_WQKV) + (size_t)e * 1536 * 1024, M, N, DM};
            pg8::StaticOrder S; S.init(M, N, G, bid);
            if (even) { pg8::EpiInEven E{RC, (bf16*)(ws + WS_X2), (const float*)(ws + WS_PS0), Gt};
                pg8::gemm_phase<pg8::EpiInEven, pg8::StaticOrder, true, true>(lds, g, S, E); }
            else { pg8::EpiInOdd E{RC, a->b_qkv + (size_t)e * 1536, (const float*)(ws + WS_ROPE), (const float*)(ws + WS_PS0)};
                pg8::gemm_phase<pg8::EpiInOdd, pg8::StaticOrder, true, true>(lds, g, S, E); }
        }
        SEAM(pb + 1);
        PH_T1(1);
#if !ROPE_FUSED
        if (!even) { if (IN(pb + 2)) { ENV; rope_phase(RC, (const f32x2*)(ws + WS_ROPE), gw, NGW, lane); } SEAM(pb + 2); }
#endif
        if (even) {
            PH_T0(2);
            if (IN(pb + 2)) REP(2) { ENV; conv_phase((const bf16*)(ws + WS_X1), a->conv + (size_t)e * 4 * 1536, (bf16*)(ws + WS_QKVA), gw, NGW, lane); }
            SEAM(pb + 2);
            PH_T1(2);
        }
        if (even) {
            PH_T0(3);
            if (IN(pb + 3)) REP(3) { ENV; SCANBUFS; local_phase(lds, sb, a->a_log + e * 4, a->dt_bias + e * 4, a->i_bias + e * 4, a->f_bias + e * 4, (unsigned*)(ws + WS_CTL) + 64 * (1 + e), gw, NGW, wave, lane); }
            SEAM(pb + 3);
            PH_T1(3);
        }
        PH_T0(4);
        if (IN(pb + 4)) REP(4) { ENV;
            if (even) { SCANBUFS; recur_phase(lds, sb, G, bid, wave, lane); }
            else attn_phase(lds, tid, wave, RC, a->sinks + e * 16, RD, G, bid);
        }
        SEAM(pb + 4);
        PH_T1(4);
        if (even) {
            PH_T0(5);
            if (IN(pb + 5)) REP(5) { ENV; SCANBUFS; post_phase(sb, a->norm_a + e * 128, a->norm_b + e * 512, (bf16*)(ws + WS_MIXED), gw, NGW, lane); }
            SEAM(pb + 5);
            PH_T1(5);
        }
        PH_T0(6);
        if (IN(pb + 6)) REP(6) { ENV;
            pg8::Gemm g{even ? (const bf16*)(ws + WS_MIXED) : (const bf16*)RD, even ? (const bf16*)(ws + WS_WOUT) + (size_t)e * DM * DM : (const bf16*)(ws + WS_WO) + (size_t)e * DM * DM, M, DM, DM};
            pg8::StaticOrder S; S.init(M, DM, G, bid);
            pg8::EpiBf16<0> E{RA, DM, even ? nullptr : a->b_o + (size_t)e * DM, RA, 1 << 30, DM, nullptr};
            pg8::gemm_phase<pg8::EpiBf16<0>, pg8::StaticOrder, true, true>(lds, g, S, E);
        }
        SEAM(pb + 6);
        PH_T1(6);
        PH_T0(7);
        if (IN(pb + 7)) { ENV; const float* gains = a->gains + (size_t)L * 4 * DM;
            resid_a_phase(RA, (L == 0) ? a->x : nullptr, (bf16*)a->out, gains + DM, (float*)(ws + WS_RS2), gw, NGW, lane); }
        SEAM(pb + 7);
        PH_T1(7);
        PH_T0(8);
        if (IN(pb + 8)) REP(8) { ENV;
            pg8::Gemm g{(const bf16*)a->out, (const bf16*)(ws + WS_WUP) + (size_t)L * FF * DM, M, FF, DM};
#if defined(PROBE_GSEC)
            g.stamp = (PROBE_GPH == 8);
#endif
            pg8::StaticOrder S; S.init(M, FF, G, bid);
            pg8::EpiBf16<1> E{RC, FF, nullptr, RC, 1 << 30, FF, (const float*)(ws + WS_RS2)};
            pg8::gemm_phase<pg8::EpiBf16<1>, pg8::StaticOrder, true, true>(lds, g, S, E);
        }
        SEAM(pb + 8);
        PH_T1(8);
        PH_T0(9);
        if (IN(pb + 9)) REP(9) { ENV;
            pg8::Gemm g{RC, (const bf16*)(ws + WS_WDN) + (size_t)L * DM * FF, M, DM, FF};
#if defined(PROBE_GSEC)
            g.stamp = (PROBE_GPH == 9);
#endif
            pg8::StaticOrder S; S.init(M, DM, G, bid);
            pg8::EpiBf16<0> E{RA, DM, nullptr, RA, 1 << 30, DM, nullptr};
            pg8::gemm_phase<pg8::EpiBf16<0>, pg8::StaticOrder, true, true>(lds, g, S, E);
        }
        SEAM(pb + 9);
        PH_T1(9);
        PH_T0(10);
        if (IN(pb + 10)) { ENV; resid_b_phase(RA, (const bf16*)a->out, a->gains + (size_t)L * 4 * DM + 3 * DM, RD, a->p + (size_t)L * M * PLE, RC, gw, NGW, lane, gtid, NGT); }
        SEAM(pb + 10);
        PH_T1(10);
        PH_T0(11);
        if (IN(pb + 11)) REP(11) { ENV;
            pg8::Gemm g{RC, (const bf16*)(ws + WS_WPLE) + (size_t)L * DM * PLE, M, DM, PLE};
            pg8::StaticOrder S; S.init(M, DM, G, bid);
            pg8::EpiBf16<0> E{RB, DM, nullptr, RB, 1 << 30, DM, nullptr};
            pg8::gemm_phase<pg8::EpiBf16<0>, pg8::StaticOrder, true, true>(lds, g, S, E);
        }
        SEAM(pb + 11);
        PH_T1(11);
        PH_T0(12);
        if (IN(pb + 12)) { ENV; const bool has_next = L + 1 < DEPTH;
            pg8::Gemm g{RD, (const bf16*)(ws + WS_WG) + (size_t)L * DM * DM, M, DM, DM};
            pg8::StaticOrder S; S.init(M, DM, G, bid);
            pg8::EpiGate2 E{RD, RB, (bf16*)a->out, has_next ? nullptr : a->out, (float*)(ws + WS_PS0)};
            pg8::gemm_phase<pg8::EpiGate2, pg8::StaticOrder, true, true>(lds, g, S, E);
        }
        SEAM(pb + 12);
        PH_T1(12);
    }
#undef SCANBUFS
#if defined(PROBE_STAMP) || defined(PROBE_LSEC) || defined(PROBE_RSEC) || defined(PROBE_GSEC)
    __syncthreads(); if (blockIdx.x == 0 && threadIdx.x == 0) { KArgs a = kargs(); a->out[0] = (float)MISC[22] * 0.01f * PROBE_STAMP_Q; }
#endif
#undef IN
#undef SEAM
#undef ENV
}

extern "C" void kernel_launch(void* const* d_in, const int* in_sizes, int n_in, void* d_out, int out_size, void* d_ws, size_t ws_size, hipStream_t stream) {
    static int grid = 0;
    if (grid == 0) {
        if (n_in != 22 || in_sizes[0] != M * DM || out_size != M * DM || ws_size < WS_END) {
            fprintf(stderr, "kernel_launch: unexpected shapes (n_in %d, in0 %d, out %d, ws %zu; need ws >= %zu); nothing launched\n", n_in, n_in > 0 ? in_sizes[0] : -1, out_size, ws_size, (size_t)WS_END); grid = -1; return; }
        int dev = 0, cus = 0, per_cu = 0;
        if (hipGetDevice(&dev) != hipSuccess || hipDeviceGetAttribute(&cus, hipDeviceAttributeMultiprocessorCount, dev) != hipSuccess) { fprintf(stderr, "kernel_launch: device query failed\n"); grid = -1; return; }
        if (hipFuncSetAttribute((const void*)trunk_fwd, hipFuncAttributeMaxDynamicSharedMemorySize, LDS_BYTES) != hipSuccess) { fprintf(stderr, "kernel_launch: hipFuncSetAttribute failed\n"); grid = -1; return; }
        if (hipOccupancyMaxActiveBlocksPerMultiprocessor(&per_cu, (const void*)trunk_fwd, NTHR, LDS_BYTES) != hipSuccess || per_cu < 1) fprintf(stderr, "kernel_launch: note: occupancy query reports %d\n", per_cu);
        (void)hipGetLastError();
        grid = cus;
    }
    if (grid < 0) return;
    Args a{};
    a.x = (const float*)d_in[0]; a.p = (const float*)d_in[1]; a.pos = (const int*)d_in[2]; a.gains = (const float*)d_in[3]; a.w_in = (const float*)d_in[4]; a.conv = (const float*)d_in[5];
    a.a_log = (const float*)d_in[6]; a.dt_bias = (const float*)d_in[7]; a.norm_a = (const float*)d_in[8]; a.i_bias = (const float*)d_in[9]; a.f_bias = (const float*)d_in[10]; a.norm_b = (const float*)d_in[11];
    a.b_qkv = (const float*)d_in[14]; a.sinks = (const float*)d_in[15]; a.b_o = (const float*)d_in[17];
    a.out = (float*)d_out; a.ws = (unsigned char*)d_ws;
#if defined(PROBE_DUP_MASK)
    a.dup_mask = PROBE_DUP_MASK; a.dup_par = PROBE_DUP_PAR;
#endif
    a.w_out = (const float*)d_in[12]; a.w_qkv = (const float*)d_in[13]; a.w_o = (const float*)d_in[16]; a.w_up = (const float*)d_in[18]; a.w_down = (const float*)d_in[19]; a.w_ple = (const float*)d_in[20]; a.w_gate = (const float*)d_in[21];
#if N_LAUNCH_MODE == 0
    if (hipMemsetAsync((char*)d_ws + WS_CTL, 0, CTL_ZERO_BYTES, stream) != hipSuccess) { fprintf(stderr, "kernel_launch: memset failed\n"); return; }
    a.ph_lo = 0; a.ph_hi = NPHASE;
    hipLaunchKernelGGL(trunk_fwd, dim3(grid), dim3(NTHR), LDS_BYTES, stream, a);
#else
    for (int ph = 0; ph < NPHASE; ++ph) { a.ph_lo = ph; a.ph_hi = ph + 1; hipLaunchKernelGGL(trunk_fwd, dim3(grid), dim3(NTHR), LDS_BYTES, stream, a); }
#endif
    const hipError_t le = hipPeekAtLastError();
    if (le != hipSuccess) fprintf(stderr, "kernel_launch: launch failed: %s\n", hipGetErrorName(le));
}
```

```cpp
#include <hip/hip_runtime.h>
#include <cstdio>
#include <cstdint>
#define N_LAUNCH_MODE 0
namespace pg8 {
#define PG8_LAS __attribute__((address_space(3)))
typedef unsigned short bf16_t;
typedef short bf16x8 __attribute__((ext_vector_type(8)));
typedef float f32x4 __attribute__((ext_vector_type(4)));
typedef unsigned u32x4 __attribute__((ext_vector_type(4)));
constexpr int BM = 256, BK = 64, HALF = 128, HTB = HALF * BK * 2  , STAGE_BYTES = 8 * HTB, NXCD = 8, WGM = 8;

__host__ __device__ __forceinline__ int lds_byte(int r, int c) { const int st = (r >> 4) * 2 + (c >> 5), rr = r & 15, cc = c & 31, ob = rr * 64 + cc * 2; return st * 1024 + (ob ^ (((ob >> 9) & 1) << 5)); }
__host__ __device__ __forceinline__ void stage_rc(int b, int& R, int& C) { const int st = b / 1024, sb = b % 1024, swz = sb ^ (((sb >> 9) & 1) << 5); R = (st >> 1) * 16 + swz / 64; C = (st & 1) * 32 + (swz % 64) / 2; }
__host__ __device__ __forceinline__ int perm32(int rho) { const int n = rho >> 4, i = rho & 15; return 8 * (i >> 2) + 4 * n + (i & 3); }

struct Unit { int pm, pn; };
struct Gemm { const bf16_t* A; const bf16_t* Bt; int M, N, K; int stamp = 0; };

struct StaticOrder {
    int nM, nN, nwg, G, c;
    __host__ __device__ void init(int M, int N, int G_, int c_) { nM = M / BM; nN = N / BM; nwg = nM * nN; G = G_; c = c_; }
    __host__ __device__ bool next(int i, Unit& u) const {
        const long L = (long)i * G + c; if (L >= nwg) return false;
        int wgid = (int)L; { const int q = nwg / NXCD, r = nwg % NXCD, xcd = wgid % NXCD, off = wgid / NXCD; wgid = (xcd < r ? xcd * (q + 1) : r * (q + 1) + (xcd - r) * q) + off; }
        const int nig = WGM * nN, gid = wgid / nig, fm = gid * WGM, gsz = (nM - fm) < WGM ? (nM - fm) : WGM;
        u.pm = fm + ((wgid % nig) % gsz); u.pn = (wgid % nig) / gsz; return true;
    }
    __device__ __forceinline__ void a_ready(const Unit&) const {}
    __device__ __forceinline__ void done(const Unit&) const {}
};

__device__ __forceinline__ unsigned cvt_pk_bf16(float lo, float hi) { unsigned r; asm volatile("v_cvt_pk_bf16_f32 %0, %1, %2" : "=v"(r) : "v"(lo), "v"(hi)); return r; }
typedef float f32x2 __attribute__((ext_vector_type(2)));
typedef unsigned u32x2 __attribute__((ext_vector_type(2)));

template <int ACT  > struct EpiBf16 {
    static constexpr bool PERM = true, AFTER_DRAIN = false;
    bf16_t* O; int ldc; const float* bias; bf16_t* O2; int split_col, ldc2; const float* rowscale;
    __device__ __forceinline__ void operator()(const f32x4 (&acc)[2][2][4][2], const Unit& u, int wr, int wc, int fr, int fq) const {
        const int row0 = u.pm * BM + wr * 64 + fr; const int col0 = u.pn * BM + wc * 32 + 8 * fq;
        const bool second = u.pn * BM >= split_col; bf16_t* const ob = second ? O2 : O; const int ld = second ? ldc2 : ldc, oc0 = second ? col0 - split_col : col0;
        f32x4 bv[2][2];
#pragma unroll
        for (int bj = 0; bj < 2; ++bj)
#pragma unroll
            for (int n = 0; n < 2; ++n) bv[bj][n] = bias ? *(const f32x4*)(bias + col0 + bj * HALF + 4 * n) : (f32x4){0.f, 0.f, 0.f, 0.f};
        float rs8[2][4];
#pragma unroll
        for (int ai = 0; ai < 2; ++ai)
#pragma unroll
            for (int m = 0; m < 4; ++m) rs8[ai][m] = rowscale ? rowscale[row0 + ai * HALF + m * 16] : 1.f;
#pragma unroll
        for (int ai = 0; ai < 2; ++ai)
#pragma unroll
            for (int m = 0; m < 4; ++m) { bf16_t* rowp = ob + (size_t)(row0 + ai * HALF + m * 16) * ld + oc0; const float rs = rs8[ai][m];
#pragma unroll
                for (int bj = 0; bj < 2; ++bj) { f32x4 v0 = acc[ai][bj][m][0] * rs + bv[bj][0], v1 = acc[ai][bj][m][1] * rs + bv[bj][1];
                    if (ACT == 1) {
#pragma unroll
                        for (int i = 0; i < 4; ++i) { const float a = fmaxf(v0[i], 0.f), b = fmaxf(v1[i], 0.f); v0[i] = a * a; v1[i] = b * b; } }
                    u32x4 w; w.x = cvt_pk_bf16(v0[0], v0[1]); w.y = cvt_pk_bf16(v0[2], v0[3]); w.z = cvt_pk_bf16(v1[0], v1[1]); w.w = cvt_pk_bf16(v1[2], v1[3]);
                    *(u32x4*)(rowp + bj * HALF) = w; } }
    }
};
__device__ __forceinline__ float row_rstd16(const float* ps, int row) { const f32x4* p = (const f32x4*)(ps + (size_t)row * 16); const f32x4 a = p[0], b = p[1], c = p[2], d = p[3];
    return rsqrtf((((a.x + a.y) + (a.z + a.w)) + ((b.x + b.y) + (b.z + b.w)) + (((c.x + c.y) + (c.z + c.w)) + ((d.x + d.y) + (d.z + d.w)))) * (1.f / 1024.f) + 1e-6f); }
#define EPIIN_R8                                                                                                                                          \
        float r8[2][4];                                                                                                                                   \
        { float s8[2][4];                                                                                                                                 \
          _Pragma("unroll") for (int ai = 0; ai < 2; ++ai)                                                                                                \
              _Pragma("unroll") for (int m = 0; m < 4; ++m) { const f32x4 pq_ = *(const f32x4*)(ps + (size_t)(row0 + ai * HALF + m * 16) * 16 + 4 * fq); s8[ai][m] = (pq_.x + pq_.y) + (pq_.z + pq_.w); } \
          _Pragma("unroll") for (int ai = 0; ai < 2; ++ai)                                                                                                \
              _Pragma("unroll") for (int m = 0; m < 4; ++m) { float s_ = s8[ai][m]; s_ += __shfl_xor(s_, 16); s_ += __shfl_xor(s_, 32); r8[ai][m] = rsqrtf(s_ * (1.f / 1024.f) + 1e-6f); } }
struct EpiInEven {
    static constexpr bool PERM = true, AFTER_DRAIN = false;
    bf16_t* O; bf16_t* O2; const float* ps; float* gates;
    __device__ __forceinline__ void operator()(const f32x4 (&acc)[2][2][4][2], const Unit& u, int wr, int wc, int fr, int fq) const {
        const int row0 = u.pm * BM + wr * 64 + fr, colt = u.pn * BM + wc * 32 + 8 * fq;
        EPIIN_R8
        if (u.pn == 16) {
            if (wc == 0 && fq < 2) {
#pragma unroll
                for (int ai = 0; ai < 2; ++ai)
#pragma unroll
                    for (int m = 0; m < 4; ++m) { const int row = row0 + ai * HALF + m * 16;
#pragma unroll
                        for (int n = 0; n < 2; ++n) *(f32x4*)(gates + (size_t)row * 16 + 8 * fq + 4 * n) = acc[ai][0][m][n] * r8[ai][m]; } }
            return; }
        const bool second = u.pn >= 6;
        bf16_t* const ob = second ? O2 : O; const int ld = second ? 2560 : 1536, oc0 = second ? colt - 1536 : colt;
#pragma unroll
        for (int ai = 0; ai < 2; ++ai)
#pragma unroll
            for (int m = 0; m < 4; ++m) { bf16_t* rowp = ob + (size_t)(row0 + ai * HALF + m * 16) * ld + oc0; const float r = r8[ai][m];
#pragma unroll
                for (int bj = 0; bj < 2; ++bj) { const f32x4 v0 = acc[ai][bj][m][0] * r, v1 = acc[ai][bj][m][1] * r;
                    u32x4 w; w.x = cvt_pk_bf16(v0[0], v0[1]); w.y = cvt_pk_bf16(v0[2], v0[3]); w.z = cvt_pk_bf16(v1[0], v1[1]); w.w = cvt_pk_bf16(v1[2], v1[3]); *(u32x4*)(rowp + bj * HALF) = w; } }
    }
};
struct EpiInOdd {
    static constexpr bool PERM = true, AFTER_DRAIN = false;
    bf16_t* O; const float* bias; const float* rope; const float* ps;
    __device__ __forceinline__ void operator()(const f32x4 (&acc)[2][2][4][2], const Unit& u, int wr, int wc, int fr, int fq) const {
        const int row0 = u.pm * BM + wr * 64 + fr, colt = u.pn * BM + wc * 32 + 8 * fq, g = (colt & 63) >> 3;
        EPIIN_R8
        const bool rot = u.pn < 5;
        f32x4 b1[2], b2[2];
#pragma unroll
        for (int bj = 0; bj < 2; ++bj) { const int c = colt + bj * HALF, hd = c >> 6;
            b1[bj] = rot ? *(const f32x4*)(bias + hd * 64 + 4 * g) : *(const f32x4*)(bias + c); b2[bj] = rot ? *(const f32x4*)(bias + hd * 64 + 32 + 4 * g) : *(const f32x4*)(bias + c + 4); }
#pragma unroll
        for (int ai = 0; ai < 2; ++ai) {
#pragma unroll
            for (int m = 0; m < 4; ++m) { const int row = row0 + ai * HALF + m * 16; bf16_t* rowp = O + (size_t)row * 1536; const float r = r8[ai][m];
                f32x4 t0 = {1.f, 0.f, 1.f, 0.f}, t1 = t0;
                if (rot) { const float* tp = rope + (size_t)row * 64 + 8 * g; t0 = *(const f32x4*)tp; t1 = *(const f32x4*)(tp + 4); }
#pragma unroll
                for (int bj = 0; bj < 2; ++bj) { const int c = colt + bj * HALF, hd = c >> 6; const f32x4 v0 = acc[ai][bj][m][0] * r + b1[bj], v1 = acc[ai][bj][m][1] * r + b2[bj];
                    if (rot) { const float sc = c < 1024 ? 0.125f : 1.f; const f32x4 cs = {t0.x, t0.z, t1.x, t1.z}, sn = {t0.y, t0.w, t1.y, t1.w};
                        const f32x4 o1 = (v0 * cs - v1 * sn) * sc, o2 = (v1 * cs + v0 * sn) * sc;
                        u32x2 w1, w2; w1.x = cvt_pk_bf16(o1[0], o1[1]); w1.y = cvt_pk_bf16(o1[2], o1[3]); w2.x = cvt_pk_bf16(o2[0], o2[1]); w2.y = cvt_pk_bf16(o2[2], o2[3]);
                        *(u32x2*)(rowp + hd * 64 + 4 * g) = w1; *(u32x2*)(rowp + hd * 64 + 32 + 4 * g) = w2; }
                    else { u32x4 w; w.x = cvt_pk_bf16(v0[0], v0[1]); w.y = cvt_pk_bf16(v0[2], v0[3]); w.z = cvt_pk_bf16(v1[0], v1[1]); w.w = cvt_pk_bf16(v1[2], v1[3]); *(u32x4*)(rowp + colt + bj * HALF) = w; } } } }
    }
};
struct EpiF32 {
    static constexpr bool PERM = false, AFTER_DRAIN = false;
    float* C; int ldc; const float* bias;
    __device__ __forceinline__ void operator()(const f32x4 (&acc)[2][2][4][2], const Unit& u, int wr, int wc, int fr, int fq) const {
        const int row0 = u.pm * BM + wr * 64 + fr, col0 = u.pn * BM + wc * 32 + 4 * fq;
        f32x4 bv[2][2];
#pragma unroll
        for (int bj = 0; bj < 2; ++bj)
#pragma unroll
            for (int n = 0; n < 2; ++n) bv[bj][n] = bias ? *(const f32x4*)(bias + col0 + bj * HALF + n * 16) : (f32x4){0.f, 0.f, 0.f, 0.f};
#pragma unroll
        for (int ai = 0; ai < 2; ++ai)
#pragma unroll
            for (int m = 0; m < 4; ++m) { float* rowp = C + (size_t)(row0 + ai * HALF + m * 16) * ldc + col0;
#pragma unroll
                for (int bj = 0; bj < 2; ++bj)
#pragma unroll
                    for (int n = 0; n < 2; ++n) *(f32x4*)(rowp + bj * HALF + n * 16) = acc[ai][bj][m][n] + bv[bj][n]; }
    }
};
__device__ __forceinline__ float bf_lo(unsigned w) { return __builtin_bit_cast(float, w << 16); }
__device__ __forceinline__ float bf_hi(unsigned w) { return __builtin_bit_cast(float, w & 0xffff0000u); }
struct EpiGate2 {
    static constexpr bool PERM = true, AFTER_DRAIN = false;
    const bf16_t* H2; const bf16_t* PP; bf16_t* HS; float* out32; float* ps;
    __device__ __forceinline__ void operator()(const f32x4 (&acc)[2][2][4][2], const Unit& u, int wr, int wc, int fr, int fq) const {
        const int row0 = u.pm * BM + wr * 64 + fr, col0 = u.pn * BM + wc * 32 + 8 * fq;
#pragma unroll
        for (int ai = 0; ai < 2; ++ai) {
            u32x4 hw[4][2], pw[4][2];
#pragma unroll
            for (int m = 0; m < 4; ++m)
#pragma unroll
                for (int bj = 0; bj < 2; ++bj) { const size_t off = (size_t)(row0 + ai * HALF + m * 16) * 1024 + col0 + bj * HALF; hw[m][bj] = *(const u32x4*)(H2 + off); pw[m][bj] = *(const u32x4*)(PP + off); }
#pragma unroll
            for (int m = 0; m < 4; ++m) { const int row = row0 + ai * HALF + m * 16; float ss = 0.f;
#pragma unroll
                for (int bj = 0; bj < 2; ++bj) { const size_t off = (size_t)row * 1024 + col0 + bj * HALF;
                    const u32x4 h_ = hw[m][bj], p_ = pw[m][bj]; const f32x4 a0 = acc[ai][bj][m][0], a1 = acc[ai][bj][m][1];
                    f32x4 h0 = {bf_lo(h_.x), bf_hi(h_.x), bf_lo(h_.y), bf_hi(h_.y)}, h1 = {bf_lo(h_.z), bf_hi(h_.z), bf_lo(h_.w), bf_hi(h_.w)};
                    const f32x4 p0 = {bf_lo(p_.x), bf_hi(p_.x), bf_lo(p_.y), bf_hi(p_.y)}, p1 = {bf_lo(p_.z), bf_hi(p_.z), bf_lo(p_.w), bf_hi(p_.w)};
#pragma unroll
                    for (int i = 0; i < 4; ++i) { h0[i] += p0[i] * __builtin_amdgcn_rcpf(1.f + __expf(-a0[i])); h1[i] += p1[i] * __builtin_amdgcn_rcpf(1.f + __expf(-a1[i])); }
                    ss += ((h0.x * h0.x + h0.y * h0.y) + (h0.z * h0.z + h0.w * h0.w)) + ((h1.x * h1.x + h1.y * h1.y) + (h1.z * h1.z + h1.w * h1.w));
                    if (out32) { *(f32x4*)(out32 + off) = h0; *(f32x4*)(out32 + off + 4) = h1; }
                    else { u32x4 w; w.x = cvt_pk_bf16(h0[0], h0[1]); w.y = cvt_pk_bf16(h0[2], h0[3]); w.z = cvt_pk_bf16(h1[0], h1[1]); w.w = cvt_pk_bf16(h1[2], h1[3]); *(u32x4*)(HS + off) = w; } }
                ss += __shfl_xor(ss, 16); ss += __shfl_xor(ss, 32);
                if (fq == 0) ps[(size_t)row * 16 + u.pn * 4 + wc] = ss; } }
    }
};
struct EpiGate {
    static constexpr bool PERM = false, AFTER_DRAIN = false;
    float* H; const bf16_t* PP; int ldc;
    __device__ __forceinline__ void operator()(const f32x4 (&acc)[2][2][4][2], const Unit& u, int wr, int wc, int fr, int fq) const {
        const int row0 = u.pm * BM + wr * 64 + fr, col0 = u.pn * BM + wc * 32 + 4 * fq;
#pragma unroll
        for (int ai = 0; ai < 2; ++ai)
#pragma unroll
            for (int m = 0; m < 4; ++m) { const size_t ro = (size_t)(row0 + ai * HALF + m * 16) * ldc + col0;
#pragma unroll
                for (int bj = 0; bj < 2; ++bj)
#pragma unroll
                    for (int n = 0; n < 2; ++n) { const size_t off = ro + bj * HALF + n * 16;
                        f32x4 hv = *(const f32x4*)(H + off); const u32x2 pv = *(const u32x2*)(PP + off); const f32x4 a = acc[ai][bj][m][n];
                        const float p0 = bf_lo(pv.x), p1 = bf_hi(pv.x), p2 = bf_lo(pv.y), p3 = bf_hi(pv.y);
                        hv[0] += p0 / (1.f + __expf(-a[0])); hv[1] += p1 / (1.f + __expf(-a[1])); hv[2] += p2 / (1.f + __expf(-a[2])); hv[3] += p3 / (1.f + __expf(-a[3]));
                        *(f32x4*)(H + off) = hv; } }
    }
};

template <class Epi, class Sched, bool ALIGN_EPI = false, bool SP2 = false>
__device__ __forceinline__ void gemm_phase(PG8_LAS unsigned char* lds, const Gemm g, const Sched& S, const Epi& E) {
    int tid_l = threadIdx.x; asm volatile("" : "+v"(tid_l));
    const int tid = tid_l, wid = __builtin_amdgcn_readfirstlane(tid >> 6), lane = tid & 63, wr = wid >> 2, wc = wid & 3, fr = lane & 15, fq = lane >> 4;
    const int K = g.K, nt = K / BK;
    unsigned voffA[2], voffB[2];
#pragma unroll
    for (int i = 0; i < 2; ++i) { int R, C; stage_rc(tid * 16 + i * 8192, R, C); const int Rb = Epi::PERM ? ((R & ~31) + perm32(R & 31)) : R;
        voffA[i] = (unsigned)(R * K + C) * 2u; voffB[i] = (unsigned)(Rb * K + C) * 2u; }
    const size_t kstep = (size_t)(BK * 2);
    const size_t hstep = (size_t)HALF * K * 2;
    const size_t tstep = 2 * hstep;
    const unsigned ldsw = (unsigned)wid * 1024u;
    const int aoff = lds_byte(wr * 64 + fr, fq * 8), boff = lds_byte(wc * 32 + fr, fq * 8);
#define PG8_SA(b, h) (((b) * 2 + (h)) * HTB)
#define PG8_SB(b, h) ((4 + (b) * 2 + (h)) * HTB)
#define PG8_STAGE(bufoff, gbase, voff) do { _Pragma("unroll") for (int _i = 0; _i < 2; ++_i) \
        __builtin_amdgcn_global_load_lds((const unsigned*)((const char*)(gbase) + (voff)[_i]), (PG8_LAS unsigned*)(lds + (bufoff) + ldsw + _i * 8192), 16, 0, 0); } while (0)
#define PG8_LDA(dst, b, h) do { _Pragma("unroll") for (int m = 0; m < 4; ++m) _Pragma("unroll") for (int k = 0; k < 2; ++k) dst[m][k] = *(const PG8_LAS bf16x8*)(lds + PG8_SA(b, h) + aoff + m * 2048 + k * 1024); } while (0)
#define PG8_LDB(dst, b, h) do { _Pragma("unroll") for (int n = 0; n < 2; ++n) _Pragma("unroll") for (int k = 0; k < 2; ++k) dst[n][k] = *(const PG8_LAS bf16x8*)(lds + PG8_SB(b, h) + boff + n * 2048 + k * 1024); } while (0)
#define PG8_MMA(ai, bj, At, Bt) do { __builtin_amdgcn_s_setprio(1); _Pragma("unroll") for (int m = 0; m < 4; ++m) _Pragma("unroll") for (int n = 0; n < 2; ++n) _Pragma("unroll") for (int k = 0; k < 2; ++k) \
        acc[ai][bj][m][n] = __builtin_amdgcn_mfma_f32_16x16x32_bf16(Bt[n][k], At[m][k], acc[ai][bj][m][n], 0, 0, 0); __builtin_amdgcn_s_setprio(0); } while (0)
#define PG8_WAIT_V(n) asm volatile("s_waitcnt vmcnt(" #n ")" ::: "memory")
#define PG8_WAIT_L(n) asm volatile("s_waitcnt lgkmcnt(" #n ")" ::: "memory")
#define PG8_BAR __builtin_amdgcn_s_barrier()
#define PG8_SCHED __builtin_amdgcn_sched_barrier(0)
    Unit cur, nxt; int ui = 0;
    if (!S.next(0, cur)) return;
    f32x4 acc[2][2][4][2];
#pragma unroll
    for (int a = 0; a < 2; ++a)
#pragma unroll
        for (int b = 0; b < 2; ++b)
#pragma unroll
            for (int m = 0; m < 4; ++m)
#pragma unroll
                for (int n = 0; n < 2; ++n) acc[a][b][m][n] = (f32x4){0.f, 0.f, 0.f, 0.f};
    bf16x8 At[4][2], B0[2][2], B1[2][2];
    const char* cA = (const char*)g.A + (size_t)cur.pm * tstep; const char* cB = (const char*)g.Bt + (size_t)cur.pn * tstep;
    S.a_ready(cur);
    if constexpr (SP2) {
        PG8_STAGE(PG8_SB(0, 0), cB, voffB); PG8_STAGE(PG8_SB(0, 1), cB + hstep, voffB); PG8_STAGE(PG8_SA(0, 0), cA, voffA); PG8_STAGE(PG8_SA(0, 1), cA + hstep, voffA);
        if (wr == 1) PG8_BAR;
        PG8_WAIT_V(2); PG8_BAR;
        PG8_STAGE(PG8_SB(1, 0), cB + kstep, voffB); PG8_STAGE(PG8_SA(1, 0), cA + kstep, voffA); PG8_STAGE(PG8_SB(1, 1), cB + hstep + kstep, voffB);
        PG8_WAIT_V(6); PG8_BAR;
    } else {
        PG8_STAGE(PG8_SB(0, 0), cB, voffB); PG8_STAGE(PG8_SA(0, 0), cA, voffA); PG8_STAGE(PG8_SB(0, 1), cB + hstep, voffB); PG8_STAGE(PG8_SA(0, 1), cA + hstep, voffA);
        if (wr == 1) PG8_BAR;
        PG8_WAIT_V(4); PG8_BAR;
        PG8_STAGE(PG8_SB(1, 0), cB + kstep, voffB); PG8_STAGE(PG8_SA(1, 0), cA + kstep, voffA); PG8_STAGE(PG8_SB(1, 1), cB + hstep + kstep, voffB);
        PG8_WAIT_V(6); PG8_BAR;
    }
    for (;;) {
        const bool has_next = S.next(ui + 1, nxt);
        const char* nA = has_next ? (const char*)g.A + (size_t)nxt.pm * tstep : cA; const char* nB = has_next ? (const char*)g.Bt + (size_t)nxt.pn * tstep : cB;
        for (int t = 0; t < nt; t += 2) {
            const bool last = (t == nt - 2);
            const char* a1 = cA + (size_t)(t + 1) * kstep;
            const char* a2 = last ? nA : cA + (size_t)(t + 2) * kstep; const char* b2 = last ? nB : cB + (size_t)(t + 2) * kstep;
            const char* a3 = a2 + kstep; const char* b3 = b2 + kstep;
            if (last && has_next) S.a_ready(nxt);
            if constexpr (SP2) {
            PG8_LDB(B0, 0, 0); PG8_LDB(B1, 0, 1); PG8_SCHED; PG8_LDA(At, 0, 0); PG8_STAGE(PG8_SA(1, 1), a1 + hstep, voffA);
            PG8_WAIT_V(8); PG8_WAIT_L(0); PG8_BAR; PG8_MMA(0, 0, At, B0); PG8_MMA(0, 1, At, B1); PG8_BAR; PG8_SCHED;
            PG8_LDA(At, 0, 1); PG8_STAGE(PG8_SB(0, 0), b2, voffB); PG8_STAGE(PG8_SB(0, 1), b2 + hstep, voffB); PG8_STAGE(PG8_SA(0, 0), a2, voffA);
            PG8_WAIT_V(8); PG8_WAIT_L(0); PG8_BAR; PG8_MMA(1, 0, At, B0); PG8_MMA(1, 1, At, B1); PG8_BAR; PG8_SCHED;
            PG8_LDB(B0, 1, 0); PG8_LDB(B1, 1, 1); PG8_SCHED; PG8_LDA(At, 1, 0); PG8_STAGE(PG8_SA(0, 1), a2 + hstep, voffA);
            PG8_WAIT_V(8); PG8_WAIT_L(0); PG8_BAR; PG8_MMA(0, 0, At, B0); PG8_MMA(0, 1, At, B1); PG8_BAR; PG8_SCHED;
            PG8_LDA(At, 1, 1); PG8_STAGE(PG8_SB(1, 0), b3, voffB); PG8_STAGE(PG8_SB(1, 1), b3 + hstep, voffB); PG8_STAGE(PG8_SA(1, 0), a3, voffA);
            PG8_WAIT_V(8); PG8_WAIT_L(0); PG8_BAR; PG8_MMA(1, 0, At, B0); PG8_MMA(1, 1, At, B1); PG8_BAR; PG8_SCHED;
            } else {
            PG8_LDB(B0, 0, 0); PG8_SCHED; PG8_LDA(At, 0, 0); PG8_STAGE(PG8_SA(1, 1), a1 + hstep, voffA);
            PG8_WAIT_L(8); PG8_BAR; PG8_WAIT_L(0); PG8_MMA(0, 0, At, B0); PG8_BAR; PG8_SCHED;
            PG8_LDB(B1, 0, 1); PG8_STAGE(PG8_SB(0, 0), b2, voffB);
            PG8_BAR; PG8_WAIT_L(0); PG8_MMA(0, 1, At, B1); PG8_BAR;
            PG8_LDA(At, 0, 1); PG8_STAGE(PG8_SA(0, 0), a2, voffA);
            PG8_BAR; PG8_WAIT_L(0); PG8_MMA(1, 0, At, B0); PG8_BAR; PG8_SCHED;
            PG8_STAGE(PG8_SB(0, 1), b2 + hstep, voffB);
            PG8_WAIT_V(6); PG8_BAR; PG8_MMA(1, 1, At, B1); PG8_BAR;
            PG8_LDB(B0, 1, 0); PG8_SCHED; PG8_LDA(At, 1, 0); PG8_STAGE(PG8_SA(0, 1), a2 + hstep, voffA);
            PG8_WAIT_L(8); PG8_BAR; PG8_WAIT_L(0); PG8_MMA(0, 0, At, B0); PG8_BAR; PG8_SCHED;
            PG8_LDB(B1, 1, 1); PG8_STAGE(PG8_SB(1, 0), b3, voffB);
            PG8_BAR; PG8_WAIT_L(0); PG8_MMA(0, 1, At, B1); PG8_BAR;
            PG8_LDA(At, 1, 1); PG8_STAGE(PG8_SA(1, 0), a3, voffA);
            PG8_BAR; PG8_WAIT_L(0); PG8_MMA(1, 0, At, B0); PG8_BAR; PG8_SCHED;
            PG8_STAGE(PG8_SB(1, 1), b3 + hstep, voffB);
            PG8_WAIT_V(6); PG8_BAR; PG8_MMA(1, 1, At, B1); PG8_BAR;
            }
        }
        if constexpr (ALIGN_EPI) { if (wr == 0) PG8_BAR; }
#if defined(PROBE_GSEC)
        { const bool son = g.stamp && blockIdx.x == 0 && wid == 0; unsigned long long t0_ = 0;
          if (son && PROBE_GSEC == 1) { asm volatile("s_waitcnt lgkmcnt(0)" ::: "memory"); t0_ = __builtin_amdgcn_s_memrealtime(); }
          if constexpr (!Epi::AFTER_DRAIN) { E(acc, cur, wr, wc, fr, fq); S.done(cur); }
          if (son && PROBE_GSEC == 1) { asm volatile("s_waitcnt lgkmcnt(0)" ::: "memory"); const unsigned d_ = (unsigned)(__builtin_amdgcn_s_memrealtime() - t0_); if (lane == 0) ((volatile PG8_LAS unsigned*)(lds + 131072))[22] += d_; } }
#else
        if constexpr (!Epi::AFTER_DRAIN) { E(acc, cur, wr, wc, fr, fq); S.done(cur); }
#endif
        if (!has_next) break;
#pragma unroll
        for (int a = 0; a < 2; ++a)
#pragma unroll
            for (int b = 0; b < 2; ++b)
#pragma unroll
                for (int m = 0; m < 4; ++m)
#pragma unroll
                    for (int n = 0; n < 2; ++n) acc[a][b][m][n] = (f32x4){0.f, 0.f, 0.f, 0.f};
        cur = nxt; cA = nA; cB = nB; ++ui;
        if constexpr (ALIGN_EPI) { if (wr == 1) PG8_BAR; }
    }
    PG8_WAIT_V(0);
    if constexpr (!ALIGN_EPI) { if (wr == 0) PG8_BAR; }
    PG8_BAR;
    if constexpr (Epi::AFTER_DRAIN) { E.fused(acc, cur, wr, wc, fr, fq, lds, wid, lane); S.done(cur); }
#undef PG8_SA
#undef PG8_SB
#undef PG8_STAGE
#undef PG8_LDA
#undef PG8_LDB
#undef PG8_MMA
#undef PG8_WAIT_V
#undef PG8_WAIT_L
#undef PG8_BAR
#undef PG8_SCHED
}
}
constexpr int BATCH = 32, SEQ = 2048, DM = 1024, DEPTH = 4, M = BATCH * SEQ;
constexpr int FF = 4096, PLE = 256, NIN = 4112;
constexpr float EPS = 1e-6f;
constexpr int NWAVES = 8, NTHR = NWAVES * 64;
constexpr int PH_PER_LAYER = 13, NPHASE = 1 + DEPTH * PH_PER_LAYER;
constexpr size_t MiB = 1u << 20;
constexpr size_t WS_CTL = 0, CTL_ZERO_BYTES = 32768;
constexpr int NINP = 4352;
constexpr size_t WS_WIN = 1 * MiB, WS_WOUT = 18 * MiB, WS_WQKV = 22 * MiB, WS_WO = 28 * MiB, WS_WUP = 32 * MiB, WS_WDN = 64 * MiB, WS_WPLE = 96 * MiB, WS_WG = 98 * MiB;
constexpr size_t WS_WGATES = 105 * MiB, WS_GT = 106 * MiB, WS_ROPE = 110 * MiB;
constexpr size_t WS_PS0 = 128 * MiB;
constexpr size_t WS_DEN = 126 * MiB, WS_RS0 = 127 * MiB, WS_RS2 = 127 * MiB + 512 * 1024;
constexpr size_t WS_RA = 128 * MiB, WS_RB = 256 * MiB, WS_RC = 384 * MiB, WS_RD = 896 * MiB, WS_END = 1024 * MiB;
constexpr size_t WS_QKVA = 128 * MiB, WS_KWT = 320 * MiB, WS_X1 = 384 * MiB, WS_KT = 384 * MiB, WS_UT = 448 * MiB, WS_NW = 512 * MiB, WS_X2 = 576 * MiB, WS_VT = 896 * MiB, WS_ATT = 960 * MiB, WS_PT = 992 * MiB, WS_MIXED = 384 * MiB;
constexpr int CW_BAR = 4096;
constexpr int RING_BYTES = 131072, MISC_OFF = RING_BYTES, LDS_BYTES = RING_BYTES + 1024;

#define GAS __attribute__((address_space(1)))
#define LAS __attribute__((address_space(3)))
typedef unsigned short bf16;
typedef float f32x4 __attribute__((ext_vector_type(4)));
typedef float f32x2 __attribute__((ext_vector_type(2)));
typedef unsigned u32x4 __attribute__((ext_vector_type(4)));
typedef unsigned u32x2 __attribute__((ext_vector_type(2)));
#define LDS_WAIT() asm volatile("s_waitcnt lgkmcnt(0)" ::: "memory")
#define VM_WAIT() asm volatile("s_waitcnt vmcnt(0)" ::: "memory")
using pg8::bf_lo; using pg8::bf_hi;
typedef __bf16 bf16x2_t __attribute__((ext_vector_type(2)));
__device__ __forceinline__ unsigned pk2(float lo, float hi) { return pg8::cvt_pk_bf16(lo, hi); }
__device__ __forceinline__ unsigned pk2v(float lo, float hi) { const f32x2 v = {lo, hi}; const bf16x2_t b = __builtin_convertvector(v, bf16x2_t); return __builtin_bit_cast(unsigned, b); }
__device__ __forceinline__ float wave_sum(float v) {
#pragma unroll
    for (int o = 1; o < 64; o <<= 1) v += __shfl_xor(v, o);
    return v;
}
__device__ __forceinline__ float dot4(f32x4 a, f32x4 b) { return (a.x * b.x + a.y * b.y) + (a.z * b.z + a.w * b.w); }
__device__ __forceinline__ float sigmoid_f(float x) { return __builtin_amdgcn_rcpf(1.f + __expf(-x)); }
__device__ __forceinline__ float softplus_f(float x) { const float y = __expf(-fabsf(x)); const float l = y < 0.03125f ? y * (1.f - y * (0.5f - y * (0.33333334f - 0.25f * y))) : __logf(1.f + y); return fmaxf(x, 0.f) + l; }

#define XB_TMO      128
#define XB_XCNT(j)  (256  + 64 * (j))
#define XB_XSUB(j)  (1280 + 64 * (j))
#define XB_XGEN(j)  (2304 + 64 * (j))
#define XB_TOP      3328
#define XB_TOPGEN   3392
#define XCD_BAR_WORDS 3456
#define XB_SPIN_CAP (1u << 18)

__device__ __forceinline__ unsigned xb_ld(unsigned* p)              { return __hip_atomic_load(p, __ATOMIC_RELAXED, __HIP_MEMORY_SCOPE_AGENT); }
__device__ __forceinline__ unsigned xb_add(unsigned* p, unsigned v) { return __hip_atomic_fetch_add(p, v, __ATOMIC_RELAXED, __HIP_MEMORY_SCOPE_AGENT); }
__device__ __forceinline__ unsigned xb_xcc_id() { return (unsigned)__builtin_amdgcn_s_getreg((3 << 11) | 20) & 0xFu; }
#define XB_SPIN(cond, bar) do { unsigned _sp = 0; while (cond) { __builtin_amdgcn_s_sleep(1); \
    if ((++_sp & 255u) == 0u) { if (xb_ld(&(bar)[XB_TMO])) break; if (_sp > XB_SPIN_CAP) { atomicAdd(&(bar)[XB_TMO], 1u); break; } } } } while (0)

struct XcdBarrier {
    unsigned* bar; unsigned x;
    volatile LAS unsigned* st;
};

__device__ __forceinline__ XcdBarrier xcd_barrier_post(unsigned* bar, volatile LAS unsigned* st) {
    XcdBarrier b; b.bar = bar; b.x = xb_xcc_id(); b.st = st;
    if (threadIdx.x == 0) (void)xb_add(&bar[XB_XCNT(b.x)], 1u);
    return b;
}
__device__ __forceinline__ void xcd_barrier_complete(unsigned* bar, unsigned x, unsigned& nloc, unsigned& nx) {
    const unsigned G = gridDim.x * gridDim.y * gridDim.z;
    unsigned sum, cnt, mine, sp = 0u;
    for (;;) {
        sum = 0u; cnt = 0u; mine = 0u;
#pragma unroll
        for (unsigned j = 0; j < 16; ++j) { const unsigned c = xb_ld(&bar[XB_XCNT(j)]); sum += c; cnt += (c > 0u) ? 1u : 0u; mine = (j == x) ? c : mine; }
        if (sum == G) break;
        __builtin_amdgcn_s_sleep(1);
        if ((++sp & 255u) == 0u) { if (xb_ld(&bar[XB_TMO])) break; if (sp > XB_SPIN_CAP) { atomicAdd(&bar[XB_TMO], 1u); break; } }
    }
    nloc = mine > 0u ? mine : 1u; nx = cnt > 0u ? cnt : 1u;
}

__device__ __forceinline__ void xcd_barrier(const XcdBarrier& b) {
    asm volatile("s_waitcnt vmcnt(0)" ::: "memory");
    __syncthreads();
    if (threadIdx.x == 0) {
        unsigned* bar = b.bar;
        __builtin_amdgcn_s_waitcnt(0);
        unsigned nloc = b.st[0], nx = b.st[1];
        if (nloc == 0u) { xcd_barrier_complete(bar, b.x, nloc, nx); b.st[0] = nloc; b.st[1] = nx; }
        const unsigned old = xb_add(&bar[XB_XSUB(b.x)], 1u);
        const unsigned gen = old / nloc;
        if (old + 1u == (gen + 1u) * nloc) {
            __builtin_amdgcn_fence(__ATOMIC_RELEASE, "agent");
            asm volatile("s_waitcnt vmcnt(0)" ::: "memory");
            const unsigned og = xb_add(&bar[XB_TOP], 1u);
            const unsigned tg = og / nx;
            if (og + 1u == (tg + 1u) * nx) xb_add(&bar[XB_TOPGEN], 1u);
            else XB_SPIN(xb_ld(&bar[XB_TOPGEN]) == tg, bar);
            __builtin_amdgcn_fence(__ATOMIC_ACQUIRE, "agent");
            xb_add(&bar[XB_XGEN(b.x)], 1u);
            asm volatile("s_waitcnt vmcnt(0)" ::: "memory");
        } else {
            XB_SPIN(xb_ld(&bar[XB_XGEN(b.x)]) == gen, bar);
            __builtin_amdgcn_fence(__ATOMIC_ACQUIRE, "agent");
            asm volatile("s_waitcnt vmcnt(0)" ::: "memory");
        }
    }
    __syncthreads();
}
#ifndef ROPE_FUSED
#define ROPE_FUSED 1
#endif
struct Args {
    const float *x, *p; const int* pos; const float *gains, *w_in, *conv, *a_log, *dt_bias, *norm_a, *i_bias, *f_bias, *norm_b, *w_out, *w_qkv, *b_qkv, *sinks, *w_o, *b_o, *w_up, *w_down, *w_ple, *w_gate;
    float* out; unsigned char* ws;
    int ph_lo, ph_hi, dup_mask, dup_par;
};

template <bool ROPE_PERM = false> __device__ __forceinline__ void transpose_item(const float* src, int ld, int K, bf16* dst, LAS float* scr, int item, int nblk, int lane, const float* kscale = nullptr) {
    const int kb = item / nblk, nb = item % nblk, k0 = 64 * kb, n0 = 32 * nb;
#pragma unroll 8
    for (int i = 0; i < 32; ++i) { const int kk = 2 * i + (lane >> 5); scr[kk * 33 + (lane & 31)] = src[(size_t)(k0 + kk) * ld + n0 + (lane & 31)] * (kscale ? kscale[k0 + kk] : 1.f); }
    LDS_WAIT(); asm volatile("" ::: "memory");
    const int c = lane & 7;
#pragma unroll
    for (int j = 0; j < 4; ++j) { const int n = (lane >> 3) + 8 * j; const LAS float* s = scr + (8 * c) * 33 + n;
        u32x4 o; o.x = pk2(s[0 * 33], s[1 * 33]); o.y = pk2(s[2 * 33], s[3 * 33]); o.z = pk2(s[4 * 33], s[5 * 33]); o.w = pk2(s[6 * 33], s[7 * 33]);
        int nd = n0 + n;
        if (ROPE_PERM && nd < 1280) { const int i = nd & 63; nd = (nd & ~63) + (i < 32 ? 8 * (i >> 2) + (i & 3) : 8 * ((i - 32) >> 2) + 4 + (i & 3)); }
        *(u32x4*)(dst + (size_t)nd * K + k0 + 8 * c) = o; }
    LDS_WAIT(); asm volatile("" ::: "memory");
}
__device__ __forceinline__ int gate_col(int c) { return c < 8 ? 1536 + c : 3592 + (c - 8); }

typedef const __attribute__((address_space(4))) Args* KArgs;
__device__ __forceinline__ KArgs kargs() { KArgs p = (KArgs)__builtin_amdgcn_kernarg_segment_ptr(); asm volatile("" : "+s"(p)); return p; }
__device__ __forceinline__ int fresh_tid() { int t = threadIdx.x; asm volatile("" : "+v"(t)); return t; }
__device__ __forceinline__ void prologue_phase(KArgs a, LAS unsigned char* lds, int gw, int NGW, int wave, int lane, int gtid, int NGT) {
    LAS float* scr = (LAS float*)(lds + wave * 16384);
    constexpr int I_IN = 16 * 16, I_SQ = 16 * 32, I_QKV = 16 * 48, I_UP = 16 * 128, I_DN = 64 * 32, I_PLE = 4 * 32;
    constexpr int NITEMS = 16 * I_IN + 2 * I_SQ + 2 * I_QKV + 2 * I_SQ + 4 * I_UP + 4 * I_DN + 4 * I_PLE + 4 * I_SQ;
    unsigned char* ws = a->ws;
    for (int it = gw; it < NITEMS; it += NGW) {
        int r = it;
        if (r < 16 * I_IN) { const int j = r / I_IN, e = j >> 3, s = j & 7, col0 = 512 * s + (s >= 3 ? 8 : 0) + (s >= 7 ? 8 : 0);
            transpose_item(a->w_in + (size_t)e * DM * NIN + col0, NIN, DM, (bf16*)(ws + WS_WIN) + ((size_t)e * NINP + s * 512) * DM, scr, r % I_IN, 16, lane, a->gains + (size_t)(2 * e) * 4 * DM); continue; } r -= 16 * I_IN;
        if (r < 2 * I_SQ) { const int e = r / I_SQ; transpose_item(a->w_out + (size_t)e * DM * DM, DM, DM, (bf16*)(ws + WS_WOUT) + (size_t)e * DM * DM, scr, r % I_SQ, 32, lane); continue; } r -= 2 * I_SQ;
        if (r < 2 * I_QKV) { const int e = r / I_QKV; transpose_item<ROPE_FUSED != 0>(a->w_qkv + (size_t)e * DM * 1536, 1536, DM, (bf16*)(ws + WS_WQKV) + (size_t)e * 1536 * DM, scr, r % I_QKV, 48, lane, a->gains + (size_t)(2 * e + 1) * 4 * DM); continue; } r -= 2 * I_QKV;
        if (r < 2 * I_SQ) { const int e = r / I_SQ; transpose_item(a->w_o + (size_t)e * DM * DM, DM, DM, (bf16*)(ws + WS_WO) + (size_t)e * DM * DM, scr, r % I_SQ, 32, lane); continue; } r -= 2 * I_SQ;
        if (r < 4 * I_UP) { const int l = r / I_UP; transpose_item(a->w_up + (size_t)l * DM * FF, FF, DM, (bf16*)(ws + WS_WUP) + (size_t)l * FF * DM, scr, r % I_UP, 128, lane, a->gains + ((size_t)l * 4 + 2) * DM); continue; } r -= 4 * I_UP;
        if (r < 4 * I_DN) { const int l = r / I_DN; transpose_item(a->w_down + (size_t)l * FF * DM, DM, FF, (bf16*)(ws + WS_WDN) + (size_t)l * DM * FF, scr, r % I_DN, 32, lane); continue; } r -= 4 * I_DN;
        if (r < 4 * I_PLE) { const int l = r / I_PLE; transpose_item(a->w_ple + (size_t)l * PLE * DM, DM, PLE, (bf16*)(ws + WS_WPLE) + (size_t)l * DM * PLE, scr, r % I_PLE, 32, lane); continue; } r -= 4 * I_PLE;
        { const int l = r / I_SQ; transpose_item(a->w_gate + (size_t)l * DM * DM, DM, DM, (bf16*)(ws + WS_WG) + (size_t)l * DM * DM, scr, r % I_SQ, 32, lane); }
    }
    for (int i = gtid; i < 2 * 256 * 1024; i += NGT) { const int e = i >> 18, c = (i >> 10) & 255, k = i & 1023;
        const float v = c < 16 ? a->w_in[((size_t)e * 1024 + k) * NIN + gate_col(c)] * a->gains[(size_t)(2 * e) * 4 * DM + k] : 0.f;
        ((bf16*)(ws + WS_WIN))[((size_t)e * NINP + 4096 + c) * DM + k] = (bf16)(pk2(v, 0.f) & 0xffffu); }
    f32x2* rope = (f32x2*)(a->ws + WS_ROPE);
    for (int i = gtid; i < M * 32; i += NGT) { const int m = i >> 5, d = i & 31;
        const float inv = (float)pow(10000.0, -(double)d / 32.0); const float ang = (float)a->pos[m] * inv; float sn, cs; sincosf(ang, &sn, &cs); rope[i] = (f32x2){cs, sn}; }
}

__device__ __forceinline__ void norm_phase(const float* hin, bf16* HN, float* RS, int gw, int NGW, int lane) {
    for (int m = gw; m < M; m += NGW) {
        const f32x4* xr = (const f32x4*)(hin + (size_t)m * DM) + lane;
        f32x4 v[4]; float s = 0.f;
#pragma unroll
        for (int j = 0; j < 4; ++j) { v[j] = xr[64 * j]; s += dot4(v[j], v[j]); }
        u32x2* o8 = (u32x2*)(HN + (size_t)m * DM) + lane;
#pragma unroll
        for (int j = 0; j < 4; ++j) o8[64 * j] = (u32x2){pk2(v[j].x, v[j].y), pk2(v[j].z, v[j].w)};
        const float tot = wave_sum(s);
        if (lane < 16) RS[(size_t)m * 16 + lane] = lane == 0 ? tot : 0.f;
    }
}
struct Row16 { f32x4 v[4]; };
__device__ __forceinline__ Row16 ld_row_bf16(const bf16* row, int lane) { const u32x4 a = ((const u32x4*)row)[lane], b = ((const u32x4*)row)[lane + 64]; Row16 r;
    r.v[0] = (f32x4){bf_lo(a.x), bf_hi(a.x), bf_lo(a.y), bf_hi(a.y)}; r.v[1] = (f32x4){bf_lo(a.z), bf_hi(a.z), bf_lo(a.w), bf_hi(a.w)};
    r.v[2] = (f32x4){bf_lo(b.x), bf_hi(b.x), bf_lo(b.y), bf_hi(b.y)}; r.v[3] = (f32x4){bf_lo(b.z), bf_hi(b.z), bf_lo(b.w), bf_hi(b.w)}; return r; }
__device__ __forceinline__ Row16 ld_row_f32(const float* row, int lane) { const f32x4* p = (const f32x4*)row; Row16 r; r.v[0] = p[2 * lane]; r.v[1] = p[2 * lane + 1]; r.v[2] = p[128 + 2 * lane]; r.v[3] = p[128 + 2 * lane + 1]; return r; }
__device__ __forceinline__ void st_row_bf16(bf16* row, int lane, const Row16& r) {
    ((u32x4*)row)[lane] = (u32x4){pk2(r.v[0].x, r.v[0].y), pk2(r.v[0].z, r.v[0].w), pk2(r.v[1].x, r.v[1].y), pk2(r.v[1].z, r.v[1].w)};
    ((u32x4*)row)[lane + 64] = (u32x4){pk2(r.v[2].x, r.v[2].y), pk2(r.v[2].z, r.v[2].w), pk2(r.v[3].x, r.v[3].y), pk2(r.v[3].z, r.v[3].w)}; }
__device__ __forceinline__ void st_row_f32(float* row, int lane, const Row16& r) { f32x4* p = (f32x4*)row; p[2 * lane] = r.v[0]; p[2 * lane + 1] = r.v[1]; p[128 + 2 * lane] = r.v[2]; p[128 + 2 * lane + 1] = r.v[3]; }
__device__ __forceinline__ float row_sumsq(const Row16& r) { return (dot4(r.v[0], r.v[0]) + dot4(r.v[1], r.v[1])) + (dot4(r.v[2], r.v[2]) + dot4(r.v[3], r.v[3])); }
__device__ __forceinline__ void resid_a_phase(const bf16* mix, const float* hin32, bf16* hs, const float* g1, float* RS, int gw, int NGW, int lane) {
    const Row16 ga = ld_row_f32(g1, lane);
    for (int m = gw; m < M; m += NGW) {
        const Row16 v = ld_row_bf16(mix + (size_t)m * DM, lane); Row16 h = hin32 ? ld_row_f32(hin32 + (size_t)m * DM, lane) : ld_row_bf16(hs + (size_t)m * DM, lane);
        const float r1 = rsqrtf(wave_sum(row_sumsq(v)) * (1.f / DM) + EPS);
#pragma unroll
        for (int j = 0; j < 4; ++j) h.v[j] = h.v[j] + v.v[j] * r1 * ga.v[j];
        st_row_bf16(hs + (size_t)m * DM, lane, h);
        const float r2 = rsqrtf(wave_sum(row_sumsq(h)) * (1.f / DM) + EPS);
        if (lane == 0) RS[m] = r2;
    }
}
__device__ __forceinline__ void resid_b_phase(const bf16* ff, const bf16* hs, const float* g3, bf16* HB, const float* pl, bf16* PB, int gw, int NGW, int lane, int gtid, int NGT) {
    const Row16 ga = ld_row_f32(g3, lane);
    for (int m = gw; m < M; m += NGW) {
        const Row16 v = ld_row_bf16(ff + (size_t)m * DM, lane); Row16 h = ld_row_bf16(hs + (size_t)m * DM, lane);
        const float r1 = rsqrtf(wave_sum(row_sumsq(v)) * (1.f / DM) + EPS);
#pragma unroll
        for (int j = 0; j < 4; ++j) h.v[j] = h.v[j] + v.v[j] * r1 * ga.v[j];
        st_row_bf16(HB + (size_t)m * DM, lane, h);
    }
    for (int i = gtid; i < M * PLE / 8; i += NGT) { const f32x4 a = ((const f32x4*)pl)[2 * i], b = ((const f32x4*)pl)[2 * i + 1];
        ((u32x4*)PB)[i] = (u32x4){pk2(a.x, a.y), pk2(a.z, a.w), pk2(b.x, b.y), pk2(b.z, b.w)}; }
}
__device__ __forceinline__ void resid_c_phase(const bf16* gpre, const bf16* pp, const bf16* h2, bf16* hs, float* out32, bool has_next, float* RS, int gw, int NGW, int lane) {
    for (int m = gw; m < M; m += NGW) {
        const Row16 g = ld_row_bf16(gpre + (size_t)m * DM, lane), p = ld_row_bf16(pp + (size_t)m * DM, lane); Row16 h = ld_row_bf16(h2 + (size_t)m * DM, lane);
#pragma unroll
        for (int j = 0; j < 4; ++j)
#pragma unroll
            for (int i = 0; i < 4; ++i) h.v[j][i] += p.v[j][i] * sigmoid_f(g.v[j][i]);
        if (has_next) {
            st_row_bf16(hs + (size_t)m * DM, lane, h);
            const float rstd = rsqrtf(wave_sum(row_sumsq(h)) * (1.f / DM) + EPS);
            if (lane == 0) RS[m] = rstd;
        } else st_row_f32(out32 + (size_t)m * DM, lane, h);
    }
}
__device__ __forceinline__ void conv_phase(const bf16* X1, const float* convw  , bf16* QKVA, int gw, int NGW, int lane) {
    constexpr int RPW = 32;
    for (int blk = gw; blk < M / RPW; blk += NGW) {
        const int mb = blk * RPW;
#pragma unroll 1
        for (int j = 0; j < 3; ++j) {
            const int col = j * 512 + lane * 8;
            u32x4 h0, h1, h2;
            { const bool first = (mb & (SEQ - 1)) == 0; const u32x4 z = {0u, 0u, 0u, 0u};
              h0 = first ? z : *(const u32x4*)(X1 + (size_t)(mb - 3) * 1536 + col); h1 = first ? z : *(const u32x4*)(X1 + (size_t)(mb - 2) * 1536 + col); h2 = first ? z : *(const u32x4*)(X1 + (size_t)(mb - 1) * 1536 + col); }
            f32x4 w[4][2];
#pragma unroll
            for (int kk = 0; kk < 4; ++kk) { w[kk][0] = *(const f32x4*)(convw + kk * 1536 + col); w[kk][1] = *(const f32x4*)(convw + kk * 1536 + col + 4); }
#pragma unroll 1
            for (int r4 = 0; r4 < RPW; r4 += 4) {
                u32x4 cur[4];
#pragma unroll
                for (int rr = 0; rr < 4; ++rr) cur[rr] = *(const u32x4*)(X1 + (size_t)(mb + r4 + rr) * 1536 + col);
#pragma unroll
                for (int rr = 0; rr < 4; ++rr) {
                    const int m = mb + r4 + rr;
                    const u32x4 xs[4] = {rr == 0 ? h0 : (rr == 1 ? h1 : (rr == 2 ? h2 : cur[0])), rr == 0 ? h1 : (rr == 1 ? h2 : cur[rr - 2 < 0 ? 0 : rr - 2]), rr == 0 ? h2 : cur[rr - 1 < 0 ? 0 : rr - 1], cur[rr]};
                    float acc[8];
#pragma unroll
                    for (int i = 0; i < 8; ++i) acc[i] = 0.f;
#pragma unroll
                    for (int kk = 0; kk < 4; ++kk) { const u32x4 xv = xs[kk]; const f32x4 w0 = w[kk][0], w1 = w[kk][1];
                        acc[0] += bf_lo(xv.x) * w0.x; acc[1] += bf_hi(xv.x) * w0.y; acc[2] += bf_lo(xv.y) * w0.z; acc[3] += bf_hi(xv.y) * w0.w;
                        acc[4] += bf_lo(xv.z) * w1.x; acc[5] += bf_hi(xv.z) * w1.y; acc[6] += bf_lo(xv.w) * w1.z; acc[7] += bf_hi(xv.w) * w1.w; }
                    float ss = 0.f;
#pragma unroll
                    for (int i = 0; i < 8; ++i) { acc[i] = acc[i] * __builtin_amdgcn_rcpf(1.f + __expf(-acc[i])); ss += acc[i] * acc[i]; }
                    if (j < 2) { ss += __shfl_xor(ss, 1); ss += __shfl_xor(ss, 2); ss += __shfl_xor(ss, 4); ss += __shfl_xor(ss, 8);
                        const float sc = rsqrtf(ss + EPS) * (j == 0 ? 0.08838834764831845f : 1.f);
#pragma unroll
                        for (int i = 0; i < 8; ++i) acc[i] *= sc; }
                    *(u32x4*)(QKVA + (size_t)m * 1536 + col) = (u32x4){pk2(acc[0], acc[1]), pk2(acc[2], acc[3]), pk2(acc[4], acc[5]), pk2(acc[6], acc[7])};
                }
                h0 = cur[1]; h1 = cur[2]; h2 = cur[3];
            }
        }
    }
}
__device__ __forceinline__ void rope_phase(bf16* QKV, const f32x2* rope, int gw, int NGW, int lane) {
#pragma unroll 2
    for (int m = gw; m < M; m += NGW) {
        const int grp = lane & 7; const f32x4* tb = (const f32x4*)(rope + (size_t)m * 32 + grp * 4); const f32x4 t0 = tb[0], t1 = tb[1];
        const float cs[4] = {t0.x, t0.z, t1.x, t1.z}, sn[4] = {t0.y, t0.w, t1.y, t1.w};
#pragma unroll
        for (int k = 0; k < 3; ++k) {
            if (k == 2 && lane >= 32) break;
            const int hh = (k < 2) ? ((lane + 64 * k) >> 3) : (lane >> 3); const float scale = (k < 2) ? 0.125f : 1.f;
            bf16* base = QKV + (size_t)m * 1536 + (k < 2 ? 0 : 1024) + hh * 64 + grp * 4;
            const u32x2 a = *(const u32x2*)base, b = *(const u32x2*)(base + 32);
            const float x1[4] = {bf_lo(a.x), bf_hi(a.x), bf_lo(a.y), bf_hi(a.y)}, x2[4] = {bf_lo(b.x), bf_hi(b.x), bf_lo(b.y), bf_hi(b.y)};
            float o1[4], o2[4];
#pragma unroll
            for (int i = 0; i < 4; ++i) { o1[i] = (x1[i] * cs[i] - x2[i] * sn[i]) * scale; o2[i] = (x2[i] * cs[i] + x1[i] * sn[i]) * scale; }
            *(u32x2*)base = (u32x2){pk2(o1[0], o1[1]), pk2(o1[2], o1[3])}; *(u32x2*)(base + 32) = (u32x2){pk2(o2[0], o2[1]), pk2(o2[2], o2[3])};
        }
    }
}
typedef short bf16x8 __attribute__((ext_vector_type(8)));
typedef short v4i16_t __attribute__((ext_vector_type(4)));
#define MFMA16(a, b, c) __builtin_amdgcn_mfma_f32_16x16x32_bf16(a, b, c, 0, 0, 0)
__device__ __forceinline__ bf16x8 pack8(f32x4 a, f32x4 b) { const u32x4 w = {pk2v(a.x, a.y), pk2v(a.z, a.w), pk2v(b.x, b.y), pk2v(b.z, b.w)}; return __builtin_bit_cast(bf16x8, w); }
__device__ __forceinline__ float bf2f(unsigned short v) { return __builtin_bit_cast(float, (unsigned)v << 16); }
__device__ __forceinline__ float rdlane(float v, int i) { return __builtin_bit_cast(float, __builtin_amdgcn_readlane(__builtin_bit_cast(int, v), i)); }
__device__ __forceinline__ float scan_add(float v, int lane) {
#pragma unroll
    for (int o = 1; o < 64; o <<= 1) { const float t = __shfl_up(v, o); if (lane >= o) v += t; }
    return v; }
__device__ __forceinline__ float scan_max(float v, int lane) {
#pragma unroll
    for (int o = 1; o < 64; o <<= 1) { const float t = __shfl_up(v, o); if (lane >= o) v = fmaxf(v, t); }
    return v; }
__device__ __forceinline__ int kperm(int ks, int q, int jj) { return 32 * ks + (jj < 4 ? 4 * q + jj : 16 + 4 * q + jj - 4); }
template <bool SCALE> __device__ __forceinline__ u32x4 tr_gather(const bf16* src  , int ld, int ks, int q, float esc_lane) {
    unsigned w[4];
#pragma unroll
    for (int j2 = 0; j2 < 4; ++j2) { const int r0 = kperm(ks, q, 2 * j2), r1 = r0 + 1; const unsigned short a = src[(size_t)r0 * ld], b = src[(size_t)r1 * ld];
        if (SCALE) { const float s0 = __shfl(esc_lane, r0), s1 = __shfl(esc_lane, r1); w[j2] = pk2(bf2f(a) * s0, bf2f(b) * s1); } else w[j2] = (unsigned)a | ((unsigned)b << 16); }
    return (u32x4){w[0], w[1], w[2], w[3]};
}
__device__ __forceinline__ u32x4 scale_frag(u32x4 raw, int ks, int q, float esc_lane) {
    unsigned w[4] = {raw.x, raw.y, raw.z, raw.w};
#pragma unroll
    for (int j2 = 0; j2 < 4; ++j2) { const int r0 = kperm(ks, q, 2 * j2); const float s0 = __shfl(esc_lane, r0), s1 = __shfl(esc_lane, r0 + 1); w[j2] = pk2(bf_lo(w[j2]) * s0, bf_hi(w[j2]) * s1); }
    return (u32x4){w[0], w[1], w[2], w[3]};
}
__device__ __forceinline__ void load_scales(float esc_lane, int q, float (&sc)[2][8]) {
#pragma unroll
    for (int ks = 0; ks < 2; ++ks)
#pragma unroll
        for (int jj = 0; jj < 8; ++jj) sc[ks][jj] = __shfl(esc_lane, kperm(ks, q, jj));
}
__device__ __forceinline__ u32x4 scale_frag_pre(u32x4 raw, const float (&f)[8]) {
    return (u32x4){pk2(bf_lo(raw.x) * f[0], bf_hi(raw.x) * f[1]), pk2(bf_lo(raw.y) * f[2], bf_hi(raw.y) * f[3]), pk2(bf_lo(raw.z) * f[4], bf_hi(raw.z) * f[5]), pk2(bf_lo(raw.w) * f[6], bf_hi(raw.w) * f[7])};
}
__device__ __forceinline__ void stage_tile64(LAS unsigned char* Lb, const bf16* tb, int pitch, int x, int q) {
    u32x4 tl[16];
#pragma unroll
    for (int i = 0; i < 16; ++i) tl[i] = *(const u32x4*)(tb + (size_t)(4 * i + q) * pitch + x * 8);
#pragma unroll
    for (int i = 0; i < 16; ++i) *(LAS u32x4*)(Lb + (4 * i + q) * 256 + x * 16) = tl[i];
    LDS_WAIT();
}
__device__ __forceinline__ u32x4 tr_frag(const LAS unsigned char* Lb, int t, int ks, int x, int q) {
    const LAS unsigned char* p0 = Lb + (32 * ks + 4 * q + (x >> 2)) * 256 + (16 * t + 4 * (x & 3)) * 2;
    const v4i16_t lo = __builtin_amdgcn_ds_read_tr16_b64_v4i16((LAS v4i16_t*)p0), hi = __builtin_amdgcn_ds_read_tr16_b64_v4i16((LAS v4i16_t*)(p0 + 16 * 256));
    const bf16x8 fr = {lo[0], lo[1], lo[2], lo[3], hi[0], hi[1], hi[2], hi[3]}; return __builtin_bit_cast(u32x4, fr);
}
struct ScanBufs {
    bf16* QKVA;
    bf16* X2;
    float* Gt;
    bf16 *KT, *UT, *NW, *ATT;
    bf16 *KWT, *VT, *PT;
    float* DEN;
};
#if defined(PROBE_LSEC)
#define LSEC_BEGIN(k) do { if ((k) == PROBE_LSEC && lsec_on) { asm volatile("s_waitcnt vmcnt(0) lgkmcnt(0)" ::: "memory"); lsec_t0 = __builtin_amdgcn_s_memrealtime(); } } while (0)
#define LSEC_END(k) do { if ((k) == PROBE_LSEC && lsec_on) { asm volatile("s_waitcnt vmcnt(0) lgkmcnt(0)" ::: "memory"); lsec_acc += (unsigned)(__builtin_amdgcn_s_memrealtime() - lsec_t0); } } while (0)
#else
#define LSEC_BEGIN(k)
#define LSEC_END(k)
#endif
__device__ __forceinline__ void local_phase(LAS unsigned char* lds, const ScanBufs sb, const float* a_log, const float* dt_bias, const float* i_bias, const float* f_bias, unsigned* qctr, int gw, int NGW, int wave, int lane) {
    LAS float* Lw = (LAS float*)(lds + wave * 16384);
#if defined(PROBE_LSEC)
    const bool lsec_on = (gw == 0); unsigned long long lsec_t0 = 0; unsigned lsec_acc = 0;
#endif
    const int njobs = 2 * BATCH * 4 * (SEQ / 64); const int lane_in = lane;
#pragma unroll 1
    for (;;) {
        int job = 0; if (lane_in == 0) job = (int)__hip_atomic_fetch_add(qctr, 1u, __ATOMIC_RELAXED, __HIP_MEMORY_SCOPE_AGENT);
        job = __builtin_amdgcn_readfirstlane(job); if (job >= njobs) break;
        int lane = lane_in; asm volatile("" : "+v"(lane));
        const int x = lane & 15, q = lane >> 4;
        const int mixer = job >= njobs / 2 ? 1 : 0, cidx = mixer ? job - njobs / 2 : job, c = cidx & 31, h = (cidx >> 5) & 3, b = cidx >> 7;
        const int m0 = b * SEQ + c * 64; const size_t cid = (size_t)cidx;
        float* gr = sb.Gt + (size_t)(m0 + lane) * 16;
        if (mixer == 0) {
            LSEC_BEGIN(1);
            const float beta = 1.f / (1.f + __expf(-gr[h])); const float g = -__expf(a_log[h]) * softplus_f(gr[4 + h] + dt_bias[h]);
            const float gcum = scan_add(g, lane), eg = __expf(gcum), glast = __shfl(gcum, 63);
            LSEC_END(1); LSEC_BEGIN(2);
            const bf16* kb = sb.QKVA + (size_t)m0 * 1536 + 512 + h * 128; const bf16* qb = sb.QKVA + (size_t)m0 * 1536 + h * 128; const bf16* vb = kb + 512;
            bf16x8 Kf[4][4], Qf[4][4];
#pragma unroll
            for (int t = 0; t < 4; ++t)
#pragma unroll
                for (int ks = 0; ks < 4; ++ks) { Kf[t][ks] = *(const bf16x8*)(kb + (size_t)(16 * t + x) * 1536 + 32 * ks + 8 * q); Qf[t][ks] = *(const bf16x8*)(qb + (size_t)(16 * t + x) * 1536 + 32 * ks + 8 * q); }
            float gj[4][4];
#pragma unroll
            for (int jt = 0; jt < 4; ++jt)
#pragma unroll
                for (int r = 0; r < 4; ++r) gj[jt][r] = __shfl(gcum, 16 * jt + 4 * q + r);
            bf16* attp = sb.ATT + cid * 4096;
#pragma unroll
            for (int it = 0; it < 4; ++it) {
                const float gi = __shfl(gcum, 16 * it + x), bi = __shfl(beta, 16 * it + x); f32x4 d2s[4];
#pragma unroll
                for (int jt = 0; jt < 4; ++jt) {
                    if (jt <= it) { f32x4 D1 = {0.f, 0.f, 0.f, 0.f}, D2 = D1;
#pragma unroll
                        for (int ks = 0; ks < 4; ++ks) { D1 = MFMA16(Kf[jt][ks], Kf[it][ks], D1); D2 = MFMA16(Kf[jt][ks], Qf[it][ks], D2); }
                        f32x4 lv;
#pragma unroll
                        for (int r = 0; r < 4; ++r) { const int j = 16 * jt + 4 * q + r, i = 16 * it + x; const float dec = __expf(fminf(gi - gj[jt][r], 0.f));
                            lv[r] = (j < i) ? bi * D1[r] * dec : 0.f; d2s[jt][r] = (j <= i) ? D2[r] * dec : 0.f; }
#pragma unroll
                        for (int r = 0; r < 4; ++r) Lw[(16 * jt + 4 * q + r) * 64 + 16 * it + x] = lv[r];
                    } else d2s[jt] = (f32x4){0.f, 0.f, 0.f, 0.f};
                }
#pragma unroll
                for (int kp = 0; kp < 2; ++kp) if (it >= 2 || kp == 0) *(bf16x8*)(attp + ((it * 2 + kp) * 64 + lane) * 8) = pack8(d2s[2 * kp], d2s[2 * kp + 1]);
            }
            { float* tab = (float*)(attp + 512); tab[lane] = eg; tab[64 + lane] = __expf(glast - gcum); }
            bf16* ktp = sb.KT + cid * 8192;
            LDS_WAIT();
            LSEC_END(2); LSEC_BEGIN(3);
            float xv[64];
#pragma unroll
            for (int i = 0; i < 64; ++i) xv[i] = (i == lane) ? 1.f : 0.f;
#pragma unroll
            for (int j = 0; j < 63; ++j) {
#pragma unroll
                for (int g4 = (j + 1) / 4; g4 < 16; ++g4) { const f32x4 lc = *(const LAS f32x4*)(Lw + j * 64 + 4 * g4);
                    if (4 * g4 + 0 > j) xv[4 * g4 + 0] -= lc.x * xv[j]; if (4 * g4 + 1 > j) xv[4 * g4 + 1] -= lc.y * xv[j]; if (4 * g4 + 2 > j) xv[4 * g4 + 2] -= lc.z * xv[j]; if (4 * g4 + 3 > j) xv[4 * g4 + 3] -= lc.w * xv[j]; }
            }
            LDS_WAIT();
            LSEC_END(3); LSEC_BEGIN(4);
            { LAS unsigned short* TL = (LAS unsigned short*)Lw;
#pragma unroll
              for (int i = 0; i < 64; ++i) TL[i * 64 + ((((lane >> 3) ^ (i & 7)) << 3) | (lane & 7))] = (unsigned short)(pk2(xv[i], 0.f) & 0xffffu); }
            LDS_WAIT();
            bf16x8 Tf[4][2];
#pragma unroll
            for (int it = 0; it < 4; ++it)
#pragma unroll
                for (int ks = 0; ks < 2; ++ks) { const int row = 16 * it + x; const LAS unsigned char* tb = (const LAS unsigned char*)Lw + row * 128;
                    const int c0 = 32 * ks + 4 * q, c1 = c0 + 16;
                    const u32x2 lo = *(const LAS u32x2*)(tb + ((((c0 >> 3) ^ (row & 7)) << 4) | ((c0 & 7) << 1))), hi = *(const LAS u32x2*)(tb + ((((c1 >> 3) ^ (row & 7)) << 4) | ((c1 & 7) << 1)));
                    const u32x4 w = {lo.x, lo.y, hi.x, hi.y}; Tf[it][ks] = __builtin_bit_cast(bf16x8, w); }
            const float be = beta * eg;
            LSEC_END(4); LSEC_BEGIN(5);
            bf16* utp = sb.UT + cid * 8192;
            float scb[2][8], scbe[2][8]; load_scales(beta, q, scb); load_scales(be, q, scbe);
            LDS_WAIT(); stage_tile64((LAS unsigned char*)Lw, vb, 1536, x, q);
#pragma unroll 4
            for (int et = 0; et < 8; ++et) {
                bf16x8 vfr[2];
#pragma unroll
                for (int ks = 0; ks < 2; ++ks) { const u32x4 gth = scale_frag_pre(tr_frag((const LAS unsigned char*)Lw, et, ks, x, q), scb[ks]); vfr[ks] = __builtin_bit_cast(bf16x8, gth); }
#pragma unroll
                for (int mt = 0; mt < 4; ++mt) { f32x4 acc = {0.f, 0.f, 0.f, 0.f};
#pragma unroll
                    for (int ks = 0; ks < 2; ++ks) acc = MFMA16(Tf[mt][ks], vfr[ks], acc);
                    *(u32x2*)(utp + (size_t)(16 * et + x) * 64 + 16 * mt + 4 * q) = (u32x2){pk2v(acc.x, acc.y), pk2v(acc.z, acc.w)}; }
            }
            LSEC_END(5); LSEC_BEGIN(6);
            bf16* nwp = sb.NW + cid * 8192;
            LDS_WAIT(); stage_tile64((LAS unsigned char*)Lw, kb, 1536, x, q);
#pragma unroll 2
            for (int kp2 = 0; kp2 < 4; ++kp2) {
                bf16x8 kfr[2][2];
#pragma unroll
                for (int dd = 0; dd < 2; ++dd)
#pragma unroll
                    for (int ks = 0; ks < 2; ++ks) { const int dt = 2 * kp2 + dd; const u32x4 raw = tr_frag((const LAS unsigned char*)Lw, dt, ks, x, q);
                        *(u32x4*)(ktp + ((dt * 2 + ks) * 64 + lane) * 8) = raw;
                        kfr[dd][ks] = __builtin_bit_cast(bf16x8, scale_frag_pre(raw, scbe[ks])); }
#pragma unroll
                for (int it = 0; it < 4; ++it) { f32x4 a0 = {0.f, 0.f, 0.f, 0.f}, a1 = a0;
#pragma unroll
                    for (int ks = 0; ks < 2; ++ks) { a0 = MFMA16(kfr[0][ks], Tf[it][ks], a0); a1 = MFMA16(kfr[1][ks], Tf[it][ks], a1); }
                    a0 = a0 * -1.f; a1 = a1 * -1.f;
                    *(u32x4*)(nwp + ((it * 4 + kp2) * 64 + lane) * 8) = (u32x4){pk2v(a0.x, a0.y), pk2v(a0.z, a0.w), pk2v(a1.x, a1.y), pk2v(a1.z, a1.w)}; }
            }
            LDS_WAIT();
            LSEC_END(6);
        } else {
            LSEC_BEGIN(7);
            LSEC_BEGIN(8);
            const float il = gr[8 + h] + i_bias[h]; const float fl = -softplus_f(-(gr[12 + h] + f_bias[h]));
            const float bcum = scan_add(fl, lane), t = il - bcum, pm = scan_max(t, lane), pml = __shfl(pm, 63);
            const float esc = __expf(t - pml);
            LSEC_END(8);
            LSEC_BEGIN(9);
            const bf16* qb = sb.X2 + (size_t)m0 * 2560 + 512 + h * 128; const bf16* kb = qb + 512; const bf16* vb = kb + 512;
            bf16x8 Kf[4][4], Qf[4][4];
#pragma unroll
            for (int tt = 0; tt < 4; ++tt)
#pragma unroll
                for (int ks = 0; ks < 4; ++ks) { Kf[tt][ks] = *(const bf16x8*)(kb + (size_t)(16 * tt + x) * 2560 + 32 * ks + 8 * q); Qf[tt][ks] = *(const bf16x8*)(qb + (size_t)(16 * tt + x) * 2560 + 32 * ks + 8 * q); }
            float tj[4][4];
#pragma unroll
            for (int jt = 0; jt < 4; ++jt)
#pragma unroll
                for (int r = 0; r < 4; ++r) tj[jt][r] = __shfl(t, 16 * jt + 4 * q + r);
            bf16* ptp = sb.PT + cid * 4096;
#pragma unroll
            for (int it = 0; it < 4; ++it) {
                const float pmi = __shfl(pm, 16 * it + x); f32x4 d2s[4];
#pragma unroll
                for (int jt = 0; jt < 4; ++jt) {
                    if (jt <= it) { f32x4 D2 = {0.f, 0.f, 0.f, 0.f};
#pragma unroll
                        for (int ks = 0; ks < 4; ++ks) D2 = MFMA16(Kf[jt][ks], Qf[it][ks], D2);
#pragma unroll
                        for (int r = 0; r < 4; ++r) { const int j = 16 * jt + 4 * q + r, i = 16 * it + x; d2s[jt][r] = (j <= i) ? D2[r] * 0.08838834764831845f * __expf(fminf(tj[jt][r] - pmi, 0.f)) : 0.f; }
                    } else d2s[jt] = (f32x4){0.f, 0.f, 0.f, 0.f};
                }
#pragma unroll
                for (int kp = 0; kp < 2; ++kp) if (it >= 2 || kp == 0) *(bf16x8*)(ptp + ((it * 2 + kp) * 64 + lane) * 8) = pack8(d2s[2 * kp], d2s[2 * kp + 1]);
            }
            { float* tab = (float*)(ptp + 512); tab[lane] = bcum; tab[64 + lane] = bcum + pm; }
            LSEC_END(9); LSEC_BEGIN(10);
            bf16* kwp = sb.KWT + cid * 8192; bf16* vtp = sb.VT + cid * 8192;
            float sce[2][8]; load_scales(esc, q, sce);
#pragma unroll 1
            for (int tv = 0; tv < 2; ++tv) {
                const bf16* tb = tv == 0 ? kb : vb; bf16* dstp = tv == 0 ? kwp : vtp;
                stage_tile64((LAS unsigned char*)Lw, tb, 2560, x, q);
#pragma unroll
                for (int dt = 0; dt < 8; ++dt)
#pragma unroll
                    for (int kp = 0; kp < 2; ++kp) { const u32x4 raw = tr_frag((const LAS unsigned char*)Lw, dt, kp, x, q);
                        *(u32x4*)(dstp + ((dt * 2 + kp) * 64 + lane) * 8) = tv == 0 ? scale_frag_pre(raw, sce[kp]) : raw; }
                LDS_WAIT();
            }
            LSEC_END(10);
            LSEC_END(7);
        }
    }
#if defined(PROBE_LSEC)
    if (lsec_on && lane == 0) ((volatile LAS unsigned*)(lds + 131072))[22] += lsec_acc;
#endif
}
#if defined(PROBE_RSEC)
#define RSEC_BEGIN(k) do { if ((k) == PROBE_RSEC && rsec_on) { asm volatile("s_waitcnt lgkmcnt(0)" ::: "memory"); rsec_t0 = __builtin_amdgcn_s_memrealtime(); } } while (0)
#define RSEC_END(k) do { if ((k) == PROBE_RSEC && rsec_on) { asm volatile("s_waitcnt lgkmcnt(0)" ::: "memory"); rsec_acc += (unsigned)(__builtin_amdgcn_s_memrealtime() - rsec_t0); } } while (0)
#else
#define RSEC_BEGIN(k)
#define RSEC_END(k)
#endif
constexpr int RC_NW = 0, RC_ATT = 16384, RC_KT = 24576, RC_QP = 40960, RC_BUF = 57344;
__device__ __forceinline__ void recur_stage(LAS unsigned char* buf, const bf16* f16a  , const bf16* f8  , const bf16* f16b  , const bf16* qbase  , int qpitch, int wave, int lane) {
#pragma unroll
    for (int k = 0; k < 5; ++k) { const int bl = wave + 8 * k;
        const bf16* src = bl < 16 ? f16a + bl * 512 : (bl < 24 ? f8 + (bl - 16) * 512 : f16b + (bl - 24) * 512);
        __builtin_amdgcn_global_load_lds((const unsigned*)(src + lane * 8), (LAS unsigned*)(buf + bl * 1024), 16, 0, 0); }
#pragma unroll
    for (int k = 0; k < 8; ++k) { const int P = (wave * 8 + k) * 256 + lane * 4, f = P >> 10, lp = (P & 1023) >> 4, jj0 = ((P & 15) >> 2) * 2, it = f >> 2, ks = f & 3, xp = lp & 15, qp = lp >> 4;
        const bf16* src = qbase + (size_t)(16 * it + xp) * qpitch + kperm(ks, qp, jj0);
        __builtin_amdgcn_global_load_lds((const unsigned*)src, (LAS unsigned*)(buf + RC_QP + (wave * 8 + k) * 256), 4, 0, 0); }
}
__device__ __forceinline__ void recur_phase(LAS unsigned char* lds, const ScanBufs sb, int G, int bid, int wave, int lane) {
    const int x = lane & 15, q = lane >> 4, et = wave;
#if defined(PROBE_RSEC)
    const bool rsec_on = (bid == 0 && wave == 0); unsigned long long rsec_t0 = 0; unsigned rsec_acc = 0;
#endif
#pragma unroll 1
    for (int u = bid; u < 2 * BATCH * 4; u += G) {
        const int mixer = u >> 7, b = (u & 127) >> 2, h = u & 3;
        const size_t cid0 = (size_t)((b * 4 + h) * 32);
        if (mixer == 0) {
            f32x4 S[8];
#pragma unroll
            for (int d = 0; d < 8; ++d) S[d] = (f32x4){0.f, 0.f, 0.f, 0.f};
            recur_stage(lds, sb.NW + cid0 * 8192, sb.ATT + cid0 * 4096, sb.KT + cid0 * 8192, sb.QKVA + (size_t)(b * SEQ) * 1536 + h * 128, 1536, wave, lane);
            __syncthreads();
            u32x2 uun[4];
#pragma unroll
            for (int mt = 0; mt < 4; ++mt) uun[mt] = *(const u32x2*)(sb.UT + cid0 * 8192 + (size_t)(16 * et + x) * 64 + 16 * mt + 4 * q);
#pragma unroll 1
            for (int c = 0; c < SEQ / 64; ++c) {
                RSEC_BEGIN(1);
                const int m0 = b * SEQ + c * 64; const size_t cid = cid0 + c;
                const LAS unsigned char* buf = lds + (c & 1) * RC_BUF;
                { const int cn = c + 1 < SEQ / 64 ? c + 1 : c; const size_t cidn = cid0 + cn;
                  recur_stage(lds + ((c + 1) & 1) * RC_BUF, sb.NW + cidn * 8192, sb.ATT + cidn * 4096, sb.KT + cidn * 8192, sb.QKVA + (size_t)(b * SEQ + cn * 64) * 1536 + h * 128, 1536, wave, lane); }
                RSEC_END(1); RSEC_BEGIN(2);
                const LAS float* tab = (const LAS float*)(buf + RC_ATT + 1024);
                bf16x8 Sb[4];
#pragma unroll
                for (int ks = 0; ks < 4; ++ks) Sb[ks] = pack8(S[2 * ks], S[2 * ks + 1]);
                f32x4 vn[4];
                { bf16x8 fr[16]; u32x2 uu[4];
#pragma unroll
                  for (int i = 0; i < 16; ++i) fr[i] = *(const LAS bf16x8*)(buf + RC_NW + (i * 64 + lane) * 16);
                  { const int cn = c + 1 < SEQ / 64 ? c + 1 : c; const bf16* utn = sb.UT + (cid0 + cn) * 8192 + (size_t)(16 * et + x) * 64;
#pragma unroll
                    for (int mt = 0; mt < 4; ++mt) { uu[mt] = uun[mt]; uun[mt] = *(const u32x2*)(utn + 16 * mt + 4 * q); } }
                  __builtin_amdgcn_sched_barrier(0);
#pragma unroll
                  for (int mt = 0; mt < 4; ++mt) { f32x4 acc = {bf_lo(uu[mt].x), bf_hi(uu[mt].x), bf_lo(uu[mt].y), bf_hi(uu[mt].y)};
#pragma unroll
                    for (int ks = 0; ks < 4; ++ks) acc = MFMA16(fr[mt * 4 + ks], Sb[ks], acc);
                    vn[mt] = acc; } }
                RSEC_END(2); RSEC_BEGIN(3);
                bf16x8 vb2[2] = {pack8(vn[0], vn[1]), pack8(vn[2], vn[3])};
                bf16x8 fq[16], fa[8]; float egl[4];
#pragma unroll
                for (int i = 0; i < 16; ++i) fq[i] = *(const LAS bf16x8*)(buf + RC_QP + (i * 64 + lane) * 16);
#pragma unroll
                for (int i = 0; i < 8; ++i) if (i >= 4 || (i & 1) == 0) fa[i] = *(const LAS bf16x8*)(buf + RC_ATT + (i * 64 + lane) * 16);
#pragma unroll
                for (int it = 0; it < 4; ++it) egl[it] = tab[16 * it + x];
                __builtin_amdgcn_sched_barrier(0);
#pragma unroll
                for (int it = 0; it < 4; ++it) { f32x4 acc = {0.f, 0.f, 0.f, 0.f};
#pragma unroll
                    for (int ks = 0; ks < 4; ++ks) acc = MFMA16(Sb[ks], fq[it * 4 + ks], acc);
                    acc = acc * egl[it];
#pragma unroll
                    for (int kp = 0; kp < 2; ++kp) if (it >= 2 || kp == 0) acc = MFMA16(vb2[kp], fa[it * 2 + kp], acc);
                    *(u32x2*)(sb.QKVA + (size_t)(m0 + 16 * it + x) * 1536 + 512 + h * 128 + 16 * et + 4 * q) = (u32x2){pk2v(acc.x, acc.y), pk2v(acc.z, acc.w)}; }
                RSEC_END(3); RSEC_BEGIN(4);
                f32x4 vs[4];
#pragma unroll
                for (int mt = 0; mt < 4; ++mt) { const f32x4 kk = *(const LAS f32x4*)(tab + 64 + 16 * mt + 4 * q); vs[mt] = vn[mt] * kk; }
                const bf16x8 vsb[2] = {pack8(vs[0], vs[1]), pack8(vs[2], vs[3])};
                const float gam = tab[63];
                { bf16x8 fk[16];
#pragma unroll
                  for (int i = 0; i < 16; ++i) fk[i] = *(const LAS bf16x8*)(buf + RC_KT + (i * 64 + lane) * 16);
                  __builtin_amdgcn_sched_barrier(0);
#pragma unroll
                  for (int dt = 0; dt < 8; ++dt) { f32x4 acc = S[dt] * gam;
#pragma unroll
                    for (int kp = 0; kp < 2; ++kp) acc = MFMA16(fk[dt * 2 + kp], vsb[kp], acc);
                    S[dt] = acc; } }
                RSEC_END(4); RSEC_BEGIN(5);
                __syncthreads();
                RSEC_END(5);
            }
        } else {
            f32x4 Cs[8], Ce[8]; float mrun = 0.f;
#pragma unroll
            for (int d = 0; d < 8; ++d) { Cs[d] = (f32x4){0.f, 0.f, 0.f, 0.f}; Ce[d] = Cs[d]; }
            const short one = (x == 0) ? (short)0x3F80 : (short)0; const bf16x8 ones = {one, one, one, one, one, one, one, one};
            recur_stage(lds, sb.KWT + cid0 * 8192, sb.PT + cid0 * 4096, sb.KWT + cid0 * 8192, sb.X2 + (size_t)(b * SEQ) * 2560 + 512 + h * 128, 2560, wave, lane);
            __syncthreads();
            bf16x8 vfn[2] = {*(const bf16x8*)(sb.VT + cid0 * 8192 + ((et * 2 + 0) * 64 + lane) * 8), *(const bf16x8*)(sb.VT + cid0 * 8192 + ((et * 2 + 1) * 64 + lane) * 8)};
#pragma unroll 1
            for (int c = 0; c < SEQ / 64; ++c) {
                const int m0 = b * SEQ + c * 64; const size_t cid = cid0 + c;
                const LAS unsigned char* buf = lds + (c & 1) * RC_BUF;
                { const int cn = c + 1 < SEQ / 64 ? c + 1 : c; const size_t cidn = cid0 + cn;
                  recur_stage(lds + ((c + 1) & 1) * RC_BUF, sb.KWT + cidn * 8192, sb.PT + cidn * 4096, sb.KWT + cidn * 8192, sb.X2 + (size_t)(b * SEQ + cn * 64) * 2560 + 512 + h * 128, 2560, wave, lane); }
                const LAS float* tab = (const LAS float*)(buf + RC_ATT + 1024);
                bf16x8 Cb[4], Eb[4];
#pragma unroll
                for (int ks = 0; ks < 4; ++ks) { Cb[ks] = pack8(Cs[2 * ks], Cs[2 * ks + 1]); Eb[ks] = pack8(Ce[2 * ks], Ce[2 * ks + 1]); }
                const bf16x8 vf[2] = {vfn[0], vfn[1]};
                { const int cn = c + 1 < SEQ / 64 ? c + 1 : c; const bf16* vtn = sb.VT + (cid0 + cn) * 8192; vfn[0] = *(const bf16x8*)(vtn + ((et * 2 + 0) * 64 + lane) * 8); vfn[1] = *(const bf16x8*)(vtn + ((et * 2 + 1) * 64 + lane) * 8); }
#pragma unroll
                for (int it = 0; it < 4; ++it) {
                    bf16x8 fq[16], fp[8];
#pragma unroll
                    for (int ks = 0; ks < 4; ++ks) fq[it * 4 + ks] = *(const LAS bf16x8*)(buf + RC_QP + ((it * 4 + ks) * 64 + lane) * 16);
#pragma unroll
                    for (int kp = 0; kp < 2; ++kp) if (it >= 2 || kp == 0) fp[it * 2 + kp] = *(const LAS bf16x8*)(buf + RC_ATT + ((it * 2 + kp) * 64 + lane) * 16);
                    const float bc = tab[16 * it + x], mi = tab[64 + 16 * it + x];
                    __builtin_amdgcn_sched_barrier(0);
                    const float a = bc + mrun, mt = fmaxf(a, mi), f1 = __expf(a - mt) * 0.08838834764831845f, f2 = __expf(mi - mt);
                    f32x4 a1 = {0.f, 0.f, 0.f, 0.f}, aP = a1, e1 = a1, eP = a1;
#pragma unroll
                    for (int ks = 0; ks < 4; ++ks) { const bf16x8 qf = fq[it * 4 + ks];
                        a1 = MFMA16(Cb[ks], qf, a1); if (wave == 0) e1 = MFMA16(Eb[ks], qf, e1); }
#pragma unroll
                    for (int kp = 0; kp < 2; ++kp) if (it >= 2 || kp == 0) { const bf16x8 pf = fp[it * 2 + kp]; aP = MFMA16(vf[kp], pf, aP); if (wave == 0) eP = MFMA16(ones, pf, eP); }
                    const f32x4 nm = a1 * f1 + aP * f2;
                    *(u32x2*)(sb.X2 + (size_t)(m0 + 16 * it + x) * 2560 + 1024 + h * 128 + 16 * et + 4 * q) = (u32x2){pk2(nm.x, nm.y), pk2(nm.z, nm.w)};
                    if (wave == 0 && q == 0) sb.DEN[(size_t)(m0 + 16 * it + x) * 4 + h] = fmaxf(fabsf(e1.x * f1 + eP.x * f2), __expf(-mt));
                }
                const float blast = tab[63], wsmax = tab[127];
                const float mnew = fmaxf(blast + mrun, wsmax), sc = __expf(blast + mrun - mnew), s2 = __expf(wsmax - mnew); mrun = mnew;
                bf16x8 fk[16];
#pragma unroll
                for (int i = 0; i < 16; ++i) fk[i] = *(const LAS bf16x8*)(buf + RC_KT + (i * 64 + lane) * 16);
                __builtin_amdgcn_sched_barrier(0);
#pragma unroll
                for (int dt = 0; dt < 8; ++dt) { f32x4 dC = {0.f, 0.f, 0.f, 0.f}, dE = dC;
#pragma unroll
                    for (int kp = 0; kp < 2; ++kp) { const bf16x8 kf = fk[dt * 2 + kp]; dC = MFMA16(kf, vf[kp], dC); if (wave == 0) dE = MFMA16(kf, ones, dE); }
                    Cs[dt] = Cs[dt] * sc + dC * s2; if (wave == 0) Ce[dt] = Ce[dt] * sc + dE * s2; }
                __syncthreads();
            }
        }
    }
#if defined(PROBE_RSEC)
    if (rsec_on && lane == 0) ((volatile LAS unsigned*)(lds + 131072))[22] += rsec_acc;
#endif
}
__device__ __forceinline__ void post_phase(const ScanBufs sb, const float* norm_a, const float* norm_b, bf16* MIXED, int gw, int NGW, int lane) {
    const int hh = lane >> 3, sub = (lane & 7) * 16;
#pragma unroll 2
    for (int m = gw; m < M; m += NGW) {
        const bool isA = hh < 4; const int h = hh & 3;
        const bf16* src = isA ? sb.QKVA + (size_t)m * 1536 + 512 + h * 128 + sub : sb.X2 + (size_t)m * 2560 + 1024 + h * 128 + sub;
        const bf16* gsrc = sb.X2 + (size_t)m * 2560 + (isA ? 0 : 2048) + h * 128 + sub;
        const float* gn = (isA ? norm_a : norm_b + h * 128) + sub;
        const u32x4 r0 = *(const u32x4*)src, r1 = *(const u32x4*)(src + 8), z0 = *(const u32x4*)gsrc, z1 = *(const u32x4*)(gsrc + 8);
        float v[16] = {bf_lo(r0.x), bf_hi(r0.x), bf_lo(r0.y), bf_hi(r0.y), bf_lo(r0.z), bf_hi(r0.z), bf_lo(r0.w), bf_hi(r0.w), bf_lo(r1.x), bf_hi(r1.x), bf_lo(r1.y), bf_hi(r1.y), bf_lo(r1.z), bf_hi(r1.z), bf_lo(r1.w), bf_hi(r1.w)};
        const float z[16] = {bf_lo(z0.x), bf_hi(z0.x), bf_lo(z0.y), bf_hi(z0.y), bf_lo(z0.z), bf_hi(z0.z), bf_lo(z0.w), bf_hi(z0.w), bf_lo(z1.x), bf_hi(z1.x), bf_lo(z1.y), bf_hi(z1.y), bf_lo(z1.z), bf_hi(z1.z), bf_lo(z1.w), bf_hi(z1.w)};
        const float dinv = isA ? 1.f : 1.f / sb.DEN[(size_t)m * 4 + h];
        float ss = 0.f;
#pragma unroll
        for (int i = 0; i < 16; ++i) { v[i] *= dinv; ss += v[i] * v[i]; }
        ss += __shfl_xor(ss, 1); ss += __shfl_xor(ss, 2); ss += __shfl_xor(ss, 4);
        const float rstd = rsqrtf(ss * (1.f / 128.f) + EPS);
        float y[16];
#pragma unroll
        for (int i = 0; i < 16; ++i) { const float sg = sigmoid_f(z[i]); y[i] = v[i] * rstd * gn[i] * (isA ? z[i] * sg : sg); }
        u32x4* dst = (u32x4*)(MIXED + (size_t)m * 1024 + lane * 16);
        dst[0] = (u32x4){pk2(y[0], y[1]), pk2(y[2], y[3]), pk2(y[4], y[5]), pk2(y[6], y[7])}; dst[1] = (u32x4){pk2(y[8], y[9]), pk2(y[10], y[11]), pk2(y[12], y[13]), pk2(y[14], y[15])};
    }
}
typedef short v4i16_t __attribute__((ext_vector_type(4)));
constexpr int AT_VROW = 80;
constexpr int AT_K_BYTES = 256 * 128, AT_V_BYTES = 272 * AT_VROW * 2;
__device__ __forceinline__ void attn_phase(LAS unsigned char* lds, int tid, int wave, const bf16* QKV, const float* sinks, bf16* O, int G, int bid) {
    LAS unsigned char* KL = lds; LAS unsigned char* VL = lds + AT_K_BYTES;
    const int lane = tid & 63, x = lane & 15, q = lane >> 4, g = wave >> 1, qh = wave & 1;
    u32x4 kreg[4], vreg[4];
#define AT_LOAD_KV(uu) do { const int b_ = (uu) >> 6, kvh_ = ((uu) >> 4) & 3, jb_ = (uu) & 15; _Pragma("unroll") for (int i = 0; i < 4; ++i) { const int item = tid + 512 * i, r = item >> 3, ch = item & 7, sk = (jb_ - 1) * 128 + r; \
        kreg[i] = (u32x4){0u, 0u, 0u, 0u}; vreg[i] = kreg[i]; if (sk >= 0) { const bf16* src = QKV + (size_t)(b_ * SEQ + sk) * 1536 + 1024 + kvh_ * 64 + ch * 8; kreg[i] = *(const u32x4*)src; vreg[i] = *(const u32x4*)(src + 256); } } } while (0)
    if (bid < BATCH * 4 * 16) AT_LOAD_KV(bid);
#pragma unroll 1
    for (int u = bid; u < BATCH * 4 * 16; u += G) {
        const int b = u >> 6, kvh = (u >> 4) & 3, jb = u & 15;
#pragma unroll
        for (int i = 0; i < 4; ++i) { const int item = tid + 512 * i, r = item >> 3, ch = item & 7;
            *(LAS u32x4*)(KL + r * 128 + ((ch ^ (r & 7)) << 4)) = kreg[i]; *(LAS u32x4*)(VL + r * (AT_VROW * 2) + ch * 16) = vreg[i]; }
        if (tid < 128) { const int r = 256 + (tid >> 3), ch = tid & 7; unsigned z0 = 0u; asm volatile("" : "+v"(z0));
            *(LAS u32x4*)(VL + r * (AT_VROW * 2) + ch * 16) = (u32x4){z0, z0, z0, z0}; }
        __syncthreads();
        if (u + G < BATCH * 4 * 16) AT_LOAD_KV(u + G);
        const int hq = kvh * 4 + g; const float sink = sinks[hq];
        const size_t mq = (size_t)b * SEQ + jb * 128 + 64 * qh;
        bf16x8 Qn[2];
#pragma unroll
        for (int ks = 0; ks < 2; ++ks) Qn[ks] = *(const bf16x8*)(QKV + (mq + x) * 1536 + hq * 64 + 32 * ks + 8 * q);
#pragma unroll 1
        for (int nt = 0; nt < 4; ++nt) {
            const bf16x8 Qf[2] = {Qn[0], Qn[1]};
            { const int nn = nt < 3 ? nt + 1 : 3;
#pragma unroll
              for (int ks = 0; ks < 2; ++ks) Qn[ks] = *(const bf16x8*)(QKV + (mq + 16 * nn + x) * 1536 + hq * 64 + 32 * ks + 8 * q); }
            f32x4 s[9]; float mx = -3.0e38f;
            bf16x8 kf[9][2];
#pragma unroll
            for (int j = 0; j < 9; ++j) { const int r = 64 * qh + 16 * (nt + j) + x;
#pragma unroll
                for (int ks = 0; ks < 2; ++ks) kf[j][ks] = *(const LAS bf16x8*)(KL + r * 128 + (((4 * ks + q) ^ (r & 7)) << 4)); }
            __builtin_amdgcn_sched_barrier(0);
#pragma unroll
            for (int j = 0; j < 9; ++j) { const int kt = nt + j;
                f32x4 acc = {0.f, 0.f, 0.f, 0.f};
#pragma unroll
                for (int ks = 0; ks < 2; ++ks) acc = MFMA16(kf[j][ks], Qf[ks], acc);
#pragma unroll
                for (int rg = 0; rg < 4; ++rg) { const int diff = 16 * j + 4 * q + rg - x, ra = 64 * qh + 16 * kt + 4 * q + rg;
                    const bool valid = diff >= 1 && diff <= 128 && (jb - 1) * 128 + ra >= 0;
                    acc[rg] = valid ? acc[rg] : -3.0e38f; mx = fmaxf(mx, acc[rg]); }
                s[j] = acc; }
            mx = fmaxf(mx, __shfl_xor(mx, 16)); mx = fmaxf(mx, __shfl_xor(mx, 32)); mx = fmaxf(mx, sink);
            float sum = 0.f;
#pragma unroll
            for (int j = 0; j < 9; ++j)
#pragma unroll
                for (int rg = 0; rg < 4; ++rg) { const float p = (s[j][rg] > -1.0e38f) ? __expf(s[j][rg] - mx) : 0.f; s[j][rg] = p; sum += p; }
            sum += __shfl_xor(sum, 16); sum += __shfl_xor(sum, 32);
            const float inv = 1.f / (sum + __expf(sink - mx));
            bf16x8 Pf[5];
#pragma unroll
            for (int j2 = 0; j2 < 4; ++j2) Pf[j2] = pack8(s[2 * j2], s[2 * j2 + 1]);
            Pf[4] = pack8(s[8], (f32x4){0.f, 0.f, 0.f, 0.f});
            bf16x8 vf[4][5];
#pragma unroll
            for (int dt = 0; dt < 4; ++dt)
#pragma unroll
                for (int j2 = 0; j2 < 5; ++j2) { const int kb = 64 * qh + 16 * (nt + 2 * j2) + 4 * q + (x >> 2);
                    const LAS unsigned char* p0 = VL + kb * (AT_VROW * 2) + (16 * dt + 4 * (x & 3)) * 2;
                    const v4i16_t lo = __builtin_amdgcn_ds_read_tr16_b64_v4i16((LAS v4i16_t*)p0), hi = __builtin_amdgcn_ds_read_tr16_b64_v4i16((LAS v4i16_t*)(p0 + 16 * AT_VROW * 2));
                    vf[dt][j2] = (bf16x8){lo[0], lo[1], lo[2], lo[3], hi[0], hi[1], hi[2], hi[3]}; }
            __builtin_amdgcn_sched_barrier(0);
#pragma unroll
            for (int dt = 0; dt < 4; ++dt) { f32x4 acc = {0.f, 0.f, 0.f, 0.f};
#pragma unroll
                for (int j2 = 0; j2 < 5; ++j2) acc = MFMA16(vf[dt][j2], Pf[j2], acc);
                acc = acc * inv;
                *(u32x2*)(O + (mq + 16 * nt + x) * 1024 + hq * 64 + 16 * dt + 4 * q) = (u32x2){pk2v(acc.x, acc.y), pk2v(acc.z, acc.w)}; }
        }
        __syncthreads();
    }
}
#ifndef N_LAUNCH_MODE
#define N_LAUNCH_MODE 0
#endif
__global__ void __launch_bounds__(NTHR, 2) trunk_fwd(Args a_unused) {
    extern __shared__ __attribute__((aligned(16))) unsigned char lds_raw[];
    LAS unsigned char* lds = (LAS unsigned char*)lds_raw;
    volatile LAS unsigned* MISC = (volatile LAS unsigned*)(lds + MISC_OFF);
    if (threadIdx.x < 64) MISC[threadIdx.x] = 0u;
    __syncthreads();
    int lo, hi; XcdBarrier bar;
    int dupm = 0, dupp = 0; (void)dupm; (void)dupp;
    { KArgs a = kargs(); lo = a->ph_lo; hi = a->ph_hi; dupm = a->dup_mask; dupp = a->dup_par; unsigned* ctl = (unsigned*)(a->ws + WS_CTL);
      bar.bar = ctl + CW_BAR; bar.x = 0; bar.st = MISC + 8;
      if (hi - lo > 1) bar = xcd_barrier_post(ctl + CW_BAR, MISC + 8); }
#define IN(k) (lo <= (k) && (k) < hi)
#if defined(PROBE_STAMP_MASK)
#define PH_T0(k) do { if (((PROBE_STAMP_MASK >> (k)) & 1) && blockIdx.x == 0 && threadIdx.x == 0) { const unsigned long long t_ = __builtin_amdgcn_s_memrealtime(); MISC[20] = (unsigned)t_; MISC[21] = (unsigned)(t_ >> 32); } } while (0)
#define PH_T1(k) do { if (((PROBE_STAMP_MASK >> (k)) & 1) && blockIdx.x == 0 && threadIdx.x == 0) { const unsigned long long t_ = __builtin_amdgcn_s_memrealtime(); const unsigned long long s_ = ((unsigned long long)MISC[21] << 32) | MISC[20]; MISC[22] += (unsigned)(t_ - s_); } } while (0)
#elif defined(PROBE_STAMP)
#define PH_T0(k) do { if ((k) == PROBE_STAMP && (L & 1) == PROBE_STAMP_PAR && blockIdx.x == 0 && threadIdx.x == 0) { const unsigned long long t_ = __builtin_amdgcn_s_memrealtime(); MISC[20] = (unsigned)t_; MISC[21] = (unsigned)(t_ >> 32); } } while (0)
#define PH_T1(k) do { if ((k) == PROBE_STAMP && (L & 1) == PROBE_STAMP_PAR && blockIdx.x == 0 && threadIdx.x == 0) { const unsigned long long t_ = __builtin_amdgcn_s_memrealtime(); const unsigned long long s_ = ((unsigned long long)MISC[21] << 32) | MISC[20]; MISC[22] += (unsigned)(t_ - s_); } } while (0)
#else
#define PH_T0(k)
#define PH_T1(k)
#endif
#if defined(PROBE_DUP_MASK)
#define REP(k) _Pragma("unroll 1") for (int rep_ = 0; rep_ <= (((dupm >> (k)) & 1) && (dupp == 0 || dupp == 1 + (L & 1)) ? 1 : 0); ++rep_)
#else
#define REP(k)
#endif
#if defined(PROBE_BAR2)
#define SEAM(k) do { if (IN(k) && IN((k) + 1)) { xcd_barrier(bar); xcd_barrier(bar); } } while (0)
#else
#define SEAM(k) do { if (IN(k) && IN((k) + 1)) xcd_barrier(bar); } while (0)
#endif
#define ENV KArgs a = kargs(); const int tid = fresh_tid(), lane = tid & 63, wave = __builtin_amdgcn_readfirstlane(tid >> 6); const int G = gridDim.x, bid = blockIdx.x, gw = bid * NWAVES + wave, NGW = G * NWAVES, gtid = bid * NTHR + tid, NGT = G * NTHR; \
    unsigned char* ws = a->ws; bf16* RA = (bf16*)(ws + WS_RA); bf16* RB = (bf16*)(ws + WS_RB); bf16* RC = (bf16*)(ws + WS_RC); bf16* RD = (bf16*)(ws + WS_RD); float* Gt = (float*)(ws + WS_GT); \
    (void)lane; (void)wave; (void)gw; (void)NGW; (void)gtid; (void)NGT; (void)RA; (void)RB; (void)RC; (void)RD; (void)Gt; (void)G; (void)bid

    PH_T0(13);
    if (IN(0)) { ENV; prologue_phase(a, lds, gw, NGW, wave, lane, gtid, NGT);
#if defined(PROBE_DUP_MASK)
        if (dupm & (1 << 20)) prologue_phase(a, lds, gw, NGW, wave, lane, gtid, NGT);
#endif
    }
    SEAM(0);
    PH_T1(13);
#define SCANBUFS ScanBufs sb; sb.QKVA = (bf16*)(ws + WS_QKVA); sb.X2 = (bf16*)(ws + WS_X2); sb.Gt = Gt; sb.KT = (bf16*)(ws + WS_KT); sb.UT = (bf16*)(ws + WS_UT); sb.NW = (bf16*)(ws + WS_NW); sb.ATT = (bf16*)(ws + WS_ATT); \
    sb.KWT = (bf16*)(ws + WS_KWT); sb.VT = (bf16*)(ws + WS_VT); sb.PT = (bf16*)(ws + WS_PT); sb.DEN = (float*)(ws + WS_DEN)
#pragma unroll 1
    for (int L = 0; L < DEPTH; ++L) {
        const int pb = 1 + L * PH_PER_LAYER; const bool even = (L & 1) == 0; const int e = L >> 1;
        PH_T0(0);
        if (L == 0 && IN(pb + 0)) REP(0) { ENV; const float* hin = a->x;
            norm_phase(hin, (bf16*)a->out, (float*)(ws + WS_PS0), gw, NGW, lane); }
        if (L == 0) SEAM(pb + 0);
        PH_T1(0);
        PH_T0(1);
        if (IN(pb + 1)) REP(1) { ENV;
            const int N = even ? NINP : 1536;
            pg8::Gemm g{(const bf16*)a->out, even ? (const bf16*)(ws + WS_WIN) + (size_t)e * NINP * 1024 : (const bf16*)(ws + WS_WQKV) + (size_t)e * 1536 * 1024, M, N, DM};
            pg8::StaticOrder S; S.init(M, N, G, bid);
            if (even) { pg8::EpiInEven E{RC, (bf16*)(ws + WS_X2), (const float*)(ws + WS_PS0), Gt};
                pg8::gemm_phase<pg8::EpiInEven, pg8::StaticOrder, true, true>(lds, g, S, E); }
            else { pg8::EpiInOdd E{RC, a->b_qkv + (size_t)e * 1536, (const float*)(ws + WS_ROPE), (const float*)(ws + WS_PS0)};
                pg8::gemm_phase<pg8::EpiInOdd, pg8::StaticOrder, true, true>(lds, g, S, E); }
        }
        SEAM(pb + 1);
        PH_T1(1);
#if !ROPE_FUSED
        if (!even) { if (IN(pb + 2)) { ENV; rope_phase(RC, (const f32x2*)(ws + WS_ROPE), gw, NGW, lane); } SEAM(pb + 2); }
#endif
        if (even) {
            PH_T0(2);
            if (IN(pb + 2)) REP(2) { ENV; conv_phase((const bf16*)(ws + WS_X1), a->conv + (size_t)e * 4 * 1536, (bf16*)(ws + WS_QKVA), gw, NGW, lane); }
            SEAM(pb + 2);
            PH_T1(2);
        }
        if (even) {
            PH_T0(3);
            if (IN(pb + 3)) REP(3) { ENV; SCANBUFS; local_phase(lds, sb, a->a_log + e * 4, a->dt_bias + e * 4, a->i_bias + e * 4, a->f_bias + e * 4, (unsigned*)(ws + WS_CTL) + 64 * (1 + e), gw, NGW, wave, lane); }
            SEAM(pb + 3);
            PH_T1(3);
        }
        PH_T0(4);
        if (IN(pb + 4)) REP(4) { ENV;
            if (even) { SCANBUFS; recur_phase(lds, sb, G, bid, wave, lane); }
            else attn_phase(lds, tid, wave, RC, a->sinks + e * 16, RD, G, bid);
        }
        SEAM(pb + 4);
        PH_T1(4);
        if (even) {
            PH_T0(5);
            if (IN(pb + 5)) REP(5) { ENV; SCANBUFS; post_phase(sb, a->norm_a + e * 128, a->norm_b + e * 512, (bf16*)(ws + WS_MIXED), gw, NGW, lane); }
            SEAM(pb + 5);
            PH_T1(5);
        }
        PH_T0(6);
        if (IN(pb + 6)) REP(6) { ENV;
            pg8::Gemm g{even ? (const bf16*)(ws + WS_MIXED) : (const bf16*)RD, even ? (const bf16*)(ws + WS_WOUT) + (size_t)e * DM * DM : (const bf16*)(ws + WS_WO) + (size_t)e * DM * DM, M, DM, DM};
            pg8::StaticOrder S; S.init(M, DM, G, bid);
            pg8::EpiBf16<0> E{RA, DM, even ? nullptr : a->b_o + (size_t)e * DM, RA, 1 << 30, DM, nullptr};
            pg8::gemm_phase<pg8::EpiBf16<0>, pg8::StaticOrder, true, true>(lds, g, S, E);
        }
        SEAM(pb + 6);
        PH_T1(6);
        PH_T0(7);
        if (IN(pb + 7)) { ENV; const float* gains = a->gains + (size_t)L * 4 * DM;
            resid_a_phase(RA, (L == 0) ? a->x : nullptr, (bf16*)a->out, gains + DM, (float*)(ws + WS_RS2), gw, NGW, lane); }
        SEAM(pb + 7);
        PH_T1(7);
        PH_T0(8);
        if (IN(pb + 8)) REP(8) { ENV;
            pg8::Gemm g{(const bf16*)a->out, (const bf16*)(ws + WS_WUP) + (size_t)L * FF * DM, M, FF, DM};
#if defined(PROBE_GSEC)
            g.stamp = (PROBE_GPH == 8);
#endif
            pg8::StaticOrder S; S.init(M, FF, G, bid);
            pg8::EpiBf16<1> E{RC, FF, nullptr, RC, 1 << 30, FF, (const float*)(ws + WS_RS2)};
            pg8::gemm_phase<pg8::EpiBf16<1>, pg8::StaticOrder, true, true>(lds, g, S, E);
        }
        SEAM(pb + 8);
        PH_T1(8);
        PH_T0(9);
        if (IN(pb + 9)) REP(9) { ENV;
            pg8::Gemm g{RC, (const bf16*)(ws + WS_WDN) + (size_t)L * DM * FF, M, DM, FF};
#if defined(PROBE_GSEC)
            g.stamp = (PROBE_GPH == 9);
#endif
            pg8::StaticOrder S; S.init(M, DM, G, bid);
            pg8::EpiBf16<0> E{RA, DM, nullptr, RA, 1 << 30, DM, nullptr};
            pg8::gemm_phase<pg8::EpiBf16<0>, pg8::StaticOrder, true, true>(lds, g, S, E);
        }
        SEAM(pb + 9);
        PH_T1(9);
        PH_T0(10);
        if (IN(pb + 10)) { ENV; resid_b_phase(RA, (const bf16*)a->out, a->gains + (size_t)L * 4 * DM + 3 * DM, RD, a->p + (size_t)L * M * PLE, RC, gw, NGW, lane, gtid, NGT); }
        SEAM(pb + 10);
        PH_T1(10);
        PH_T0(11);
        if (IN(pb + 11)) REP(11) { ENV;
            pg8::Gemm g{RC, (const bf16*)(ws + WS_WPLE) + (size_t)L * DM * PLE, M, DM, PLE};
            pg8::StaticOrder S; S.init(M, DM, G, bid);
            pg8::EpiBf16<0> E{RB, DM, nullptr, RB, 1 << 30, DM, nullptr};
            pg8::gemm_phase<pg8::EpiBf16<0>, pg8::StaticOrder, true, true>(lds, g, S, E);
        }
        SEAM(pb + 11);
        PH_T1(11);
        PH_T0(12);
        if (IN(pb + 12)) { ENV; const bool has_next = L + 1 < DEPTH;
            pg8::Gemm g{RD, (const bf16*)(ws + WS_WG) + (size_t)L * DM * DM, M, DM, DM};
            pg8::StaticOrder S; S.init(M, DM, G, bid);
            pg8::EpiGate2 E{RD, RB, (bf16*)a->out, has_next ? nullptr : a->out, (float*)(ws + WS_PS0)};
            pg8::gemm_phase<pg8::EpiGate2, pg8::StaticOrder, true, true>(lds, g, S, E);
        }
        SEAM(pb + 12);
        PH_T1(12);
    }
#undef SCANBUFS
#if defined(PROBE_STAMP) || defined(PROBE_STAMP_MASK) || defined(PROBE_LSEC) || defined(PROBE_RSEC) || defined(PROBE_GSEC)
    __syncthreads(); if (blockIdx.x == 0 && threadIdx.x == 0) { KArgs a = kargs(); a->out[0] = (float)MISC[22] * 0.01f * PROBE_STAMP_Q; }
#endif
#undef IN
#undef SEAM
#undef ENV
}

extern "C" void kernel_launch(void* const* d_in, const int* in_sizes, int n_in, void* d_out, int out_size, void* d_ws, size_t ws_size, hipStream_t stream) {
    static int grid = 0;
    if (grid == 0) {
        if (n_in != 22 || in_sizes[0] != M * DM || out_size != M * DM || ws_size < WS_END) {
            fprintf(stderr, "kernel_launch: unexpected shapes (n_in %d, in0 %d, out %d, ws %zu; need ws >= %zu); nothing launched\n", n_in, n_in > 0 ? in_sizes[0] : -1, out_size, ws_size, (size_t)WS_END); grid = -1; return; }
        int dev = 0, cus = 0, per_cu = 0;
        if (hipGetDevice(&dev) != hipSuccess || hipDeviceGetAttribute(&cus, hipDeviceAttributeMultiprocessorCount, dev) != hipSuccess) { fprintf(stderr, "kernel_launch: device query failed\n"); grid = -1; return; }
        if (hipFuncSetAttribute((const void*)trunk_fwd, hipFuncAttributeMaxDynamicSharedMemorySize, LDS_BYTES) != hipSuccess) { fprintf(stderr, "kernel_launch: hipFuncSetAttribute failed\n"); grid = -1; return; }
        if (hipOccupancyMaxActiveBlocksPerMultiprocessor(&per_cu, (const void*)trunk_fwd, NTHR, LDS_BYTES) != hipSuccess || per_cu < 1) fprintf(stderr, "kernel_launch: note: occupancy query reports %d\n", per_cu);
        (void)hipGetLastError();
        grid = cus;
    }
    if (grid < 0) return;
    Args a{};
    a.x = (const float*)d_in[0]; a.p = (const float*)d_in[1]; a.pos = (const int*)d_in[2]; a.gains = (const float*)d_in[3]; a.w_in = (const float*)d_in[4]; a.conv = (const float*)d_in[5];
    a.a_log = (const float*)d_in[6]; a.dt_bias = (const float*)d_in[7]; a.norm_a = (const float*)d_in[8]; a.i_bias = (const float*)d_in[9]; a.f_bias = (const float*)d_in[10]; a.norm_b = (const float*)d_in[11];
    a.b_qkv = (const float*)d_in[14]; a.sinks = (const float*)d_in[15]; a.b_o = (const float*)d_in[17];
    a.out = (float*)d_out; a.ws = (unsigned char*)d_ws;
#if defined(PROBE_DUP_MASK)
    a.dup_mask = PROBE_DUP_MASK; a.dup_par = PROBE_DUP_PAR;
#endif
    a.w_out = (const float*)d_in[12]; a.w_qkv = (const float*)d_in[13]; a.w_o = (const float*)d_in[16]; a.w_up = (const float*)d_in[18]; a.w_down = (const float*)d_in[19]; a.w_ple = (const float*)d_in[20]; a.w_gate = (const float*)d_in[21];
#if N_LAUNCH_MODE == 0
    if (hipMemsetAsync((char*)d_ws + WS_CTL, 0, CTL_ZERO_BYTES, stream) != hipSuccess) { fprintf(stderr, "kernel_launch: memset failed\n"); return; }
    a.ph_lo = 0; a.ph_hi = NPHASE;
    hipLaunchKernelGGL(trunk_fwd, dim3(grid), dim3(NTHR), LDS_BYTES, stream, a);
#else
    for (int ph = 0; ph < NPHASE; ++ph) { a.ph_lo = ph; a.ph_hi = ph + 1; hipLaunchKernelGGL(trunk_fwd, dim3(grid), dim3(NTHR), LDS_BYTES, stream, a); }
#endif
    const hipError_t le = hipPeekAtLastError();
    if (le != hipSuccess) fprintf(stderr, "kernel_launch: launch failed: %s\n", hipGetErrorName(le));
}
```
